# Optimizing an MI355X kernel written in HIP

```python
import math
import jax, jax.numpy as jnp
from jax import lax
import numpy as np

D_MODEL = 1024
BATCH = 8
SEQ = 4096
DEPTH = 2

HEAD_DIM = 64
GRID_W = 64
ROPE_THETA = 10000.0
NORM_EPS = 1e-6
NEG_INF = -1e30

A_Q_HEADS = 8
A_KV_HEADS = 2
A_RADIUS = 128
B_PAIRS = ((128, 1), (512, 4), (2048, 16))
B_HEADS_PER_GROUP = 2
B_HEADS = B_HEADS_PER_GROUP * len(B_PAIRS)
C_HEADS = 4
C_QK_DIM = 32
C_V_DIM = 2 * C_QK_DIM
C_Q_BLOCK = 128
D_HEADS = 4
NA_ROWS = 8
NA_COLS = 16
D_MLP = 4 * D_MODEL
N_BRANCHES = 4

A_Q_COLS = A_Q_HEADS * HEAD_DIM
A_KV_COLS = A_KV_HEADS * HEAD_DIM
B_COLS = B_HEADS * HEAD_DIM
C_QK_COLS = C_HEADS * 2 * C_QK_DIM
C_V_COLS = C_HEADS * C_V_DIM
D_COLS = D_HEADS * HEAD_DIM
GATE_COLS = N_BRANCHES * D_MODEL
IN_SPLITS = (A_Q_COLS, A_KV_COLS, A_KV_COLS, B_COLS, B_COLS, B_COLS,
             C_QK_COLS, C_QK_COLS, C_V_COLS, D_COLS, D_COLS, D_COLS, GATE_COLS)
IN_COLS = sum(IN_SPLITS)
A_OUT = A_Q_HEADS * HEAD_DIM
B_OUT = B_HEADS_PER_GROUP * HEAD_DIM
C_OUT = C_HEADS * C_V_DIM
D_OUT = D_HEADS * HEAD_DIM

kernel_name = "hybrid_gated_parallel_attention_encoder"


def rms_norm(x, g):
    xf = x.astype(jnp.float32)
    y = xf * lax.rsqrt(jnp.mean(xf * xf, axis=-1, keepdims=True) + NORM_EPS)
    return (y * g.astype(jnp.float32)).astype(x.dtype)


def rope_tables(n, dim):
    inv = ROPE_THETA ** (-jnp.arange(0, dim, 2, dtype=jnp.float32) / dim)
    ang = jnp.arange(n, dtype=jnp.float32)[:, None] * inv[None, :]
    return jnp.cos(ang), jnp.sin(ang)


def apply_rope(x, cos, sin):
    half = x.shape[-1] // 2
    x1, x2 = x[..., :half], x[..., half:]
    c, s = cos.astype(x.dtype), sin.astype(x.dtype)
    return jnp.concatenate([x1 * c - x2 * s, x2 * c + x1 * s], axis=-1)


def split_heads(t, n):
    b, s, _ = t.shape
    return t.reshape(b, s, n, -1).transpose(0, 2, 1, 3)


def merge_heads(t):
    b, h, s, d = t.shape
    return t.transpose(0, 2, 1, 3).reshape(b, s, h * d)


def banded_attention(q, k, v, radius, sink=None):
    b, g, r, l, dh = q.shape
    dv = v.shape[-1]
    blk = radius
    nb = -(-l // blk)
    lp = nb * blk
    pad = lp - l
    qb = jnp.pad(q, ((0, 0), (0, 0), (0, 0), (0, pad), (0, 0))).reshape(b, g, r, nb, blk, dh)
    kp = jnp.pad(k, ((0, 0), (0, 0), (blk, pad + blk), (0, 0)))
    vp = jnp.pad(v, ((0, 0), (0, 0), (blk, pad + blk), (0, 0)))
    kb = jnp.concatenate([kp[:, :, o * blk:o * blk + lp].reshape(b, g, nb, blk, dh) for o in range(3)], axis=3)
    vb = jnp.concatenate([vp[:, :, o * blk:o * blk + lp].reshape(b, g, nb, blk, dv) for o in range(3)], axis=3)
    qpos = jnp.arange(lp).reshape(nb, blk)
    kpos = jnp.arange(nb)[:, None] * blk - blk + jnp.arange(3 * blk)[None, :]
    valid = ((kpos[:, None, :] >= 0) & (kpos[:, None, :] < l)
             & (jnp.abs(kpos[:, None, :] - qpos[:, :, None]) <= radius))
    s = jnp.einsum('bgrnqd,bgnkd->bgrnqk', qb, kb).astype(jnp.float32) * (dh ** -0.5)
    s = jnp.where(valid, s, NEG_INF)
    m = jnp.max(s, axis=-1, keepdims=True)
    if sink is not None:
        sk = sink.astype(jnp.float32)[None, :, :, None, None, None]
        m = jnp.maximum(m, sk)
        p = jnp.exp(s - m)
        den = jnp.sum(p, axis=-1, keepdims=True) + jnp.exp(sk - m)
    else:
        p = jnp.exp(s - m)
        den = jnp.sum(p, axis=-1, keepdims=True)
    out = jnp.einsum('bgrnqk,bgnkd->bgrnqd', (p / den).astype(v.dtype), vb)
    lse = (jnp.log(den) + m)[..., 0]
    out = out.reshape(b, g, r, lp, dv)[:, :, :, :l]
    lse = lse.reshape(b, g, r, lp)[:, :, :, :l]
    return out, lse


def mixer_window_gqa(q, k, v, qn_g, kn_g, sink, cos, sin):
    b, s, _ = q.shape
    q = apply_rope(rms_norm(split_heads(q, A_Q_HEADS), qn_g), cos, sin)
    k = apply_rope(rms_norm(split_heads(k, A_KV_HEADS), kn_g), cos, sin)
    v = split_heads(v, A_KV_HEADS)
    rep = A_Q_HEADS // A_KV_HEADS
    q = q.reshape(b, A_KV_HEADS, rep, s, HEAD_DIM)
    out, _ = banded_attention(q, k, v, A_RADIUS, sink.reshape(A_KV_HEADS, rep))
    return merge_heads(out.reshape(b, A_Q_HEADS, s, HEAD_DIM))


def to_residue_classes(t, d):
    b, h, s, dh = t.shape
    return t.reshape(b, h, s // d, d, dh).transpose(0, 1, 3, 2, 4).reshape(b, h * d, s // d, dh)


def from_residue_classes(t, h, d):
    b, _, sd = t.shape[:3]
    rest = t.shape[3:]
    t = t.reshape((b, h, d, sd) + rest)
    perm = (0, 1, 3, 2) + tuple(range(4, t.ndim))
    return t.transpose(perm).reshape((b, h, sd * d) + rest)


def mixer_dilated(q, k, v, qn_g, kn_g, cos, sin):
    q = apply_rope(rms_norm(split_heads(q, B_HEADS), qn_g), cos, sin)
    k = apply_rope(rms_norm(split_heads(k, B_HEADS), kn_g), cos, sin)
    v = split_heads(v, B_HEADS)
    hpg = B_HEADS_PER_GROUP
    outs, lses = [], []
    for gi, (window, dil) in enumerate(B_PAIRS):
        hs = slice(gi * hpg, (gi + 1) * hpg)
        qd = to_residue_classes(q[:, hs], dil)[:, :, None]
        kd = to_residue_classes(k[:, hs], dil)
        vd = to_residue_classes(v[:, hs], dil)
        o, lse = banded_attention(qd, kd, vd, window // (2 * dil))
        outs.append(from_residue_classes(o[:, :, 0], hpg, dil))
        lses.append(from_residue_classes(lse[:, :, 0], hpg, dil))
    wts = jax.nn.softmax(jnp.stack(lses, axis=0), axis=0)
    out = jnp.sum(wts[..., None] * jnp.stack(outs, axis=0).astype(jnp.float32), axis=0)
    return merge_heads(out.astype(q.dtype))


def mixer_differential(q, k, v, qn_g, kn_g, lam_p, subln_g, cos, sin, lambda_init):
    b, s, _ = q.shape
    q = q.reshape(b, s, C_HEADS, 2, C_QK_DIM).transpose(0, 2, 3, 1, 4)
    k = k.reshape(b, s, C_HEADS, 2, C_QK_DIM).transpose(0, 2, 3, 1, 4)
    q = apply_rope(rms_norm(q, qn_g), cos, sin)
    k = apply_rope(rms_norm(k, kn_g), cos, sin)
    v = split_heads(v, C_HEADS)
    lp = lam_p.astype(jnp.float32)
    lam = jnp.exp(jnp.sum(lp[0] * lp[1])) - jnp.exp(jnp.sum(lp[2] * lp[3])) + lambda_init
    nq = s // C_Q_BLOCK
    qb = q.reshape(b, C_HEADS, 2, nq, C_Q_BLOCK, C_QK_DIM).transpose(3, 0, 1, 2, 4, 5)
    scale = C_QK_DIM ** -0.5

    def block(qi):
        sc = jnp.einsum('bhcqd,bhckd->bhcqk', qi, k).astype(jnp.float32) * scale
        p = jax.nn.softmax(sc, axis=-1)
        a = p[:, :, 0] - lam * p[:, :, 1]
        return jnp.einsum('bhqk,bhkd->bhqd', a.astype(v.dtype), v)

    o = lax.map(block, qb)
    o = o.transpose(1, 2, 0, 3, 4).reshape(b, C_HEADS, s, C_V_DIM)
    o = rms_norm(o, subln_g) * (1.0 - lambda_init)
    return merge_heads(o)


def mixer_neighbourhood(q, k, v, qn_g, kn_g, rpb):
    b, s, _ = q.shape
    rows = s // GRID_W
    kr = min(NA_ROWS, rows)
    q = rms_norm(split_heads(q, D_HEADS), qn_g).reshape(b, D_HEADS, rows, GRID_W, HEAD_DIM)
    k = rms_norm(split_heads(k, D_HEADS), kn_g).reshape(b, D_HEADS, rows, GRID_W, HEAD_DIM)
    v = split_heads(v, D_HEADS).reshape(b, D_HEADS, rows, GRID_W, HEAD_DIM)
    qi = jnp.arange(rows)
    r0 = jnp.clip(qi - kr // 2, 0, rows - kr)
    ridx = r0[:, None] + jnp.arange(kr)[None, :]
    cj = jnp.arange(GRID_W)
    c0 = jnp.clip(cj - NA_COLS // 2, 0, GRID_W - NA_COLS)
    col_ok = (cj[None, :] >= c0[:, None]) & (cj[None, :] < c0[:, None] + NA_COLS)
    mask = jnp.tile(col_ok, (1, kr))
    kg = k[:, :, ridx].reshape(b, D_HEADS, rows, kr * GRID_W, HEAD_DIM)
    vg = v[:, :, ridx].reshape(b, D_HEADS, rows, kr * GRID_W, HEAD_DIM)
    dr = ridx - qi[:, None] + (NA_ROWS - 1)
    dc = jnp.clip(cj[None, :] - cj[:, None], -(NA_COLS - 1), NA_COLS - 1) + (NA_COLS - 1)
    bias = rpb[:, dr[:, None, :, None], dc[None, :, None, :]]
    bias = bias.reshape(D_HEADS, rows, GRID_W, kr * GRID_W).astype(jnp.float32)
    sc = jnp.einsum('bhiqd,bhikd->bhiqk', q, kg).astype(jnp.float32) * (HEAD_DIM ** -0.5) + bias
    sc = jnp.where(mask, sc, NEG_INF)
    p = jax.nn.softmax(sc, axis=-1)
    o = jnp.einsum('bhiqk,bhikd->bhiqd', p.astype(v.dtype), vg)
    return merge_heads(o.reshape(b, D_HEADS, s, HEAD_DIM))


def setup_inputs(seed: int = 0) -> dict:
    key = jax.random.key(seed)
    ks = jax.random.split(key, 19)
    f32 = jnp.float32
    nrm = lambda kk, shape, sc: jax.random.normal(kk, shape, f32) * sc
    gain = lambda kk, shape: 1.0 + 0.02 * jax.random.normal(kk, shape, f32)
    return {
        "x": nrm(ks[0], (BATCH, SEQ, D_MODEL), 1.0),
        "attn_norm_g": gain(ks[1], (DEPTH, D_MODEL)),
        "w_in": nrm(ks[2], (DEPTH, D_MODEL, IN_COLS), D_MODEL ** -0.5),
        "a_qk_norm_g": gain(ks[3], (DEPTH, 2, HEAD_DIM)),
        "a_sink": nrm(ks[4], (DEPTH, A_Q_HEADS), 0.5),
        "b_qk_norm_g": gain(ks[5], (DEPTH, 2, HEAD_DIM)),
        "c_qk_norm_g": gain(ks[6], (DEPTH, 2, C_QK_DIM)),
        "c_lambda": nrm(ks[7], (DEPTH, 4, C_QK_DIM), 0.1),
        "c_subln_g": gain(ks[8], (DEPTH, C_V_DIM)),
        "d_qk_norm_g": gain(ks[9], (DEPTH, 2, HEAD_DIM)),
        "d_rel_bias": nrm(ks[10], (DEPTH, D_HEADS, 2 * NA_ROWS - 1, 2 * NA_COLS - 1), 0.1),
        "w_branch_a": nrm(ks[11], (DEPTH, A_OUT, D_MODEL), A_OUT ** -0.5),
        "w_branch_b": nrm(ks[12], (DEPTH, B_OUT, D_MODEL), B_OUT ** -0.5),
        "w_branch_c": nrm(ks[13], (DEPTH, C_OUT, D_MODEL), C_OUT ** -0.5),
        "w_branch_d": nrm(ks[14], (DEPTH, D_OUT, D_MODEL), D_OUT ** -0.5),
        "w_out": nrm(ks[15], (DEPTH, D_MODEL, D_MODEL), D_MODEL ** -0.5),
        "mlp_norm_g": gain(ks[16], (DEPTH, D_MODEL)),
        "w_up": nrm(ks[17], (DEPTH, D_MODEL, D_MLP), D_MODEL ** -0.5),
        "w_down": nrm(ks[18], (DEPTH, D_MLP, D_MODEL), D_MLP ** -0.5),
    }


def reference(x, attn_norm_g, w_in, a_qk_norm_g, a_sink, b_qk_norm_g, c_qk_norm_g, c_lambda,
              c_subln_g, d_qk_norm_g, d_rel_bias, w_branch_a, w_branch_b, w_branch_c, w_branch_d,
              w_out, mlp_norm_g, w_up, w_down):
    b, s, _ = x.shape
    cos64, sin64 = rope_tables(s, HEAD_DIM)
    cos32, sin32 = rope_tables(s, C_QK_DIM)
    offsets = []
    acc = 0
    for w in IN_SPLITS[:-1]:
        acc += w
        offsets.append(acc)
    for l in range(DEPTH):
        h = rms_norm(x, attn_norm_g[l])
        proj = jnp.einsum('bsd,de->bse', h, w_in[l])
        aq, ak, av, bq, bk, bv, cq, ck, cv, dq, dk, dv, gate = jnp.split(proj, offsets, axis=-1)
        ya = mixer_window_gqa(aq, ak, av, a_qk_norm_g[l, 0], a_qk_norm_g[l, 1], a_sink[l], cos64, sin64)
        yb = mixer_dilated(bq, bk, bv, b_qk_norm_g[l, 0], b_qk_norm_g[l, 1], cos64, sin64)
        lambda_init = 0.8 - 0.6 * math.exp(-0.3 * l)
        yc = mixer_differential(cq, ck, cv, c_qk_norm_g[l, 0], c_qk_norm_g[l, 1], c_lambda[l],
                                c_subln_g[l], cos32, sin32, lambda_init)
        yd = mixer_neighbourhood(dq, dk, dv, d_qk_norm_g[l, 0], d_qk_norm_g[l, 1], d_rel_bias[l])
        g = jax.nn.sigmoid(gate.astype(jnp.float32)).astype(x.dtype).reshape(b, s, N_BRANCHES, D_MODEL)
        merged = (g[:, :, 0] * (ya @ w_branch_a[l]) + g[:, :, 1] * (yb @ w_branch_b[l])
                  + g[:, :, 2] * (yc @ w_branch_c[l]) + g[:, :, 3] * (yd @ w_branch_d[l]))
        x = x + merged @ w_out[l]
        hm = rms_norm(x, mlp_norm_g[l])
        u = jnp.square(jax.nn.relu(hm @ w_up[l]))
        x = x + u @ w_down[l]
    return x
```

```cpp
#include <hip/hip_runtime.h>
#include <hip/hip_cooperative_groups.h>
#include <cstdio>
namespace cg = cooperative_groups;

#ifndef PHMASK
#define PHMASK 255
#endif
#ifndef FUSED
#define FUSED 0
#endif

typedef unsigned short u16;
typedef short bf16x8 __attribute__((ext_vector_type(8)));
typedef float f32x16 __attribute__((ext_vector_type(16)));
typedef float f32x4 __attribute__((ext_vector_type(4)));
typedef __bf16 bf2_t __attribute__((ext_vector_type(2)));
typedef float f2_t __attribute__((ext_vector_type(2)));
typedef unsigned u32x4 __attribute__((ext_vector_type(4)));
typedef unsigned u32x2 __attribute__((ext_vector_type(2)));

#define DI __device__ __forceinline__
#define MFMA32(a, b, c) __builtin_amdgcn_mfma_f32_32x32x16_bf16((a), (b), (c), 0, 0, 0)

constexpr int DM = 1024, SEQ = 4096, NBATCH = 8, T = NBATCH * SEQ;
constexpr int NCH = 2, BC = NBATCH / NCH, TC = BC * SEQ;
constexpr int INC = 7552, QKVC = 3456, YC = 1152, DMLP = 4096;
constexpr int NGRP = QKVC / 64;
constexpr float LOG2E = 1.4426950408889634f;

constexpr size_t al256(size_t x) { return (x + 255) & ~(size_t)255; }
constexpr size_t OFF_WIN  = 0;
constexpr size_t OFF_WBR  = OFF_WIN  + al256((size_t)2 * INC * DM * 2);
constexpr size_t OFF_WOUT = OFF_WBR  + al256((size_t)2 * DM * YC * 2);
constexpr size_t OFF_WUP  = OFF_WOUT + al256((size_t)2 * DM * DM * 2);
constexpr size_t OFF_WDN  = OFF_WUP  + al256((size_t)2 * DMLP * DM * 2);
constexpr size_t OFF_ROPE = OFF_WDN  + al256((size_t)2 * DM * DMLP * 2);
constexpr size_t OFF_XB   = OFF_ROPE + al256((size_t)SEQ * 96 * 4);
constexpr size_t OFF_SSQ  = OFF_XB   + al256((size_t)T * DM * 2);
constexpr size_t OFF_QKV  = OFF_SSQ  + al256((size_t)T * 8 * 4);
constexpr size_t OFF_GATE = OFF_QKV  + al256((size_t)NGRP * TC * 64 * 2);
constexpr size_t OFF_Y    = OFF_GATE + al256((size_t)TC * 4096 * 2);
constexpr size_t OFF_BO   = OFF_Y    + al256((size_t)TC * YC * 2);
constexpr size_t OFF_LSE  = OFF_BO   + al256((size_t)TC * 384 * 2);
constexpr size_t OFF_MRG  = OFF_LSE  + al256((size_t)TC * 8 * 4);
constexpr size_t WS_END   = OFF_MRG  + al256((size_t)TC * DM * 2);
static_assert(WS_END <= (size_t)512 * 1024 * 1024, "workspace too large");

constexpr int LDS_BYTES = 73728;
constexpr int NPHASE = 1 + NCH * 2 * 7;

struct Params {
  const float* in[19];
  float* out;
  unsigned char* ws;
  int ph_lo, ph_hi;
};

DI unsigned pk2(float a, float b) { f2_t v = {a, b}; bf2_t r = __builtin_convertvector(v, bf2_t); return __builtin_bit_cast(unsigned, r); }
DI float bf_lo(unsigned u) { return __uint_as_float(u << 16); }
DI float bf_hi(unsigned u) { return __uint_as_float(u & 0xffff0000u); }
DI float fexp2(float x) { return __builtin_amdgcn_exp2f(x); }
DI int crow(int i, int h) { return (i & 3) + 8 * (i >> 2) + 4 * h; }
DI bf16x8 as_bf8(u32x4 v) { return __builtin_bit_cast(bf16x8, v); }

template <int NB>
DI void gemm_tile(const u16* __restrict__ A, int lda, const u16* __restrict__ B, int ldb, int K, f32x16 (&acc)[2][NB], u16* lds, int tid_) {
  const int tid = tid_; const int lane = tid & 63, wave = tid >> 6;
  const int wm = wave >> 1, wn = wave & 1;
  u16* sA = lds;
  u16* sB = lds + 2 * 128 * 72;
  const int lr = tid >> 3, lc = (tid & 7) * 8;
  const u16* ga = A + (size_t)lr * lda + lc;
  const u16* gb = B + (size_t)lr * ldb + lc;
  bf16x8 ra[4], rb[2 * NB];
#pragma unroll
  for (int i = 0; i < 4; ++i) ra[i] = *(const bf16x8*)(ga + (size_t)(32 * i) * lda);
#pragma unroll
  for (int i = 0; i < 2 * NB; ++i) rb[i] = *(const bf16x8*)(gb + (size_t)(32 * i) * ldb);
#pragma unroll
  for (int i = 0; i < 4; ++i) *(bf16x8*)(sA + (lr + 32 * i) * 72 + lc) = ra[i];
#pragma unroll
  for (int i = 0; i < 2 * NB; ++i) *(bf16x8*)(sB + (lr + 32 * i) * 72 + lc) = rb[i];
  __syncthreads();
  const int nk = K >> 6;
  const int fr = lane & 31, fh = lane >> 5;
#pragma unroll
  for (int mb = 0; mb < 2; ++mb)
#pragma unroll
    for (int nb = 0; nb < NB; ++nb)
#pragma unroll
      for (int i = 0; i < 16; ++i) acc[mb][nb][i] = 0.f;
  for (int kt = 0; kt < nk; ++kt) {
    const bool more = (kt + 1) < nk;
    if (more) {
      const int ko = (kt + 1) * 64;
#pragma unroll
      for (int i = 0; i < 4; ++i) ra[i] = *(const bf16x8*)(ga + (size_t)(32 * i) * lda + ko);
#pragma unroll
      for (int i = 0; i < 2 * NB; ++i) rb[i] = *(const bf16x8*)(gb + (size_t)(32 * i) * ldb + ko);
    }
    const u16* a_s = sA + (kt & 1) * (128 * 72) + (wm * 64 + fr) * 72 + fh * 8;
    const u16* b_s = sB + (kt & 1) * (128 * 72) + (wn * 32 * NB + fr) * 72 + fh * 8;
#pragma unroll
    for (int s = 0; s < 4; ++s) {
      const bf16x8 a0 = *(const bf16x8*)(a_s + s * 16);
      const bf16x8 a1 = *(const bf16x8*)(a_s + 32 * 72 + s * 16);
      const bf16x8 b0 = *(const bf16x8*)(b_s + s * 16);
      acc[0][0] = MFMA32(a0, b0, acc[0][0]);
      acc[1][0] = MFMA32(a1, b0, acc[1][0]);
      if (NB == 2) {
        const bf16x8 b1 = *(const bf16x8*)(b_s + 32 * 72 + s * 16);
        acc[0][NB - 1] = MFMA32(a0, b1, acc[0][NB - 1]);
        acc[1][NB - 1] = MFMA32(a1, b1, acc[1][NB - 1]);
      }
    }
    if (more) {
      u16* wa = sA + ((kt + 1) & 1) * (128 * 72);
      u16* wb = sB + ((kt + 1) & 1) * (128 * 72);
#pragma unroll
      for (int i = 0; i < 4; ++i) *(bf16x8*)(wa + (lr + 32 * i) * 72 + lc) = ra[i];
#pragma unroll
      for (int i = 0; i < 2 * NB; ++i) *(bf16x8*)(wb + (lr + 32 * i) * 72 + lc) = rb[i];
    }
    __syncthreads();
  }
}

DI void dump_acc(const f32x16 (&acc)[2][2], float* ct, int tid_) {
  const int lane = tid_ & 63, wave = tid_ >> 6;
  const int wm = wave >> 1, wn = wave & 1, fr = lane & 31, fh = lane >> 5;
#pragma unroll
  for (int mb = 0; mb < 2; ++mb)
#pragma unroll
    for (int nb = 0; nb < 2; ++nb)
#pragma unroll
      for (int i = 0; i < 16; ++i)
        ct[(wm * 64 + mb * 32 + crow(i, fh)) * 132 + wn * 64 + nb * 32 + fr] = acc[mb][nb][i];
}

DI void dump_acc1(const f32x16 (&acc)[2][1], float* ct, int tid_) {
  const int lane = tid_ & 63, wave = tid_ >> 6;
  const int wm = wave >> 1, wn = wave & 1, fr = lane & 31, fh = lane >> 5;
#pragma unroll
  for (int mb = 0; mb < 2; ++mb)
#pragma unroll
    for (int i = 0; i < 16; ++i) ct[(wm * 64 + mb * 32 + crow(i, fh)) * 68 + wn * 32 + fr] = acc[mb][0][i];
}

#define TILE_LOOP_BEGIN(Mt, Nt)                                                             \
  {                                                                                         \
    const int _nloc = nblk_ >> 3, _x = bid_ & 7, _l = bid_ >> 3;            \
    const int _mper = (Mt) >> 3, _per = _mper * (Nt);                                       \
    if (_l < _nloc)                                                                         \
      for (int _i = _l; _i < _per; _i += _nloc) {                                           \
        const int _mm = _i & 7, _rest = _i >> 3;                                            \
        const int tile_n = _rest % (Nt), tile_m = _x * _mper + (_rest / (Nt)) * 8 + _mm;
#define TILE_LOOP_END }}

DI float row_rscale(const float* ssq, size_t tok) {
  const f32x4 a = *(const f32x4*)(ssq + tok * 8), b = *(const f32x4*)(ssq + tok * 8 + 4);
  const float s = (a[0] + a[1]) + (a[2] + a[3]) + (b[0] + b[1]) + (b[2] + b[3]);
  return rsqrtf(s * (1.0f / 1024.0f) + 1e-6f);
}

DI void convert_tile(const float* __restrict__ src, int N, int k0, int n0, u16* __restrict__ dst, int ldk, int koff,
                     const float* __restrict__ g, float* t, int tid_) {
  const int tid = tid_;
  {
    const int c4 = (tid & 15) * 4;
#pragma unroll
    for (int i = 0; i < 4; ++i) {
      const int kk = (tid >> 4) + 16 * i;
      f32x4 v = *(const f32x4*)(src + (size_t)(k0 + kk) * N + n0 + c4);
      const float sc = g ? g[k0 + kk] : 1.0f;
      t[kk * 65 + c4 + 0] = v[0] * sc; t[kk * 65 + c4 + 1] = v[1] * sc; t[kk * 65 + c4 + 2] = v[2] * sc; t[kk * 65 + c4 + 3] = v[3] * sc;
    }
  }
  __syncthreads();
  {
    const int kc = (tid & 7) * 8;
#pragma unroll
    for (int i = 0; i < 2; ++i) {
      const int nn = (tid >> 3) + 32 * i;
      u32x4 w;
      w[0] = pk2(t[(kc + 0) * 65 + nn], t[(kc + 1) * 65 + nn]);
      w[1] = pk2(t[(kc + 2) * 65 + nn], t[(kc + 3) * 65 + nn]);
      w[2] = pk2(t[(kc + 4) * 65 + nn], t[(kc + 5) * 65 + nn]);
      w[3] = pk2(t[(kc + 6) * 65 + nn], t[(kc + 7) * 65 + nn]);
      *(u32x4*)(dst + (size_t)(n0 + nn) * ldk + koff + k0 + kc) = w;
    }
  }
  __syncthreads();
}

__device__ void phase_prep(const Params& p, int tid_, int bid_, int nblk_, unsigned char* smem) {
  float* t = (float*)smem;
  u16* WinT = (u16*)(p.ws + OFF_WIN); u16* WbrT = (u16*)(p.ws + OFF_WBR); u16* WoutT = (u16*)(p.ws + OFF_WOUT);
  u16* WupT = (u16*)(p.ws + OFF_WUP); u16* WdnT = (u16*)(p.ws + OFF_WDN);
  const int per_layer = 4480;
  for (int j = bid_; j < 2 * per_layer; j += nblk_) {
    const int l = j / per_layer; int ti = j % per_layer;
    if (ti < 1888) { convert_tile(p.in[2] + (size_t)l * DM * INC, INC, (ti / 118) * 64, (ti % 118) * 64, WinT + (size_t)l * INC * DM, DM, 0, p.in[1] + l * DM, t, tid_); continue; }
    ti -= 1888;
    if (ti < 128) { convert_tile(p.in[11] + (size_t)l * 512 * DM, DM, (ti / 16) * 64, (ti % 16) * 64, WbrT + (size_t)l * DM * YC, YC, 0, nullptr, t, tid_); continue; }
    ti -= 128;
    if (ti < 32) { convert_tile(p.in[12] + (size_t)l * 128 * DM, DM, (ti / 16) * 64, (ti % 16) * 64, WbrT + (size_t)l * DM * YC, YC, 512, nullptr, t, tid_); continue; }
    ti -= 32;
    if (ti < 64) { convert_tile(p.in[13] + (size_t)l * 256 * DM, DM, (ti / 16) * 64, (ti % 16) * 64, WbrT + (size_t)l * DM * YC, YC, 640, nullptr, t, tid_); continue; }
    ti -= 64;
    if (ti < 64) { convert_tile(p.in[14] + (size_t)l * 256 * DM, DM, (ti / 16) * 64, (ti % 16) * 64, WbrT + (size_t)l * DM * YC, YC, 896, nullptr, t, tid_); continue; }
    ti -= 64;
    if (ti < 256) { convert_tile(p.in[15] + (size_t)l * DM * DM, DM, (ti / 16) * 64, (ti % 16) * 64, WoutT + (size_t)l * DM * DM, DM, 0, nullptr, t, tid_); continue; }
    ti -= 256;
    if (ti < 1024) { convert_tile(p.in[17] + (size_t)l * DM * DMLP, DMLP, (ti / 64) * 64, (ti % 64) * 64, WupT + (size_t)l * DMLP * DM, DM, 0, p.in[16] + l * DM, t, tid_); continue; }
    ti -= 1024;
    convert_tile(p.in[18] + (size_t)l * DMLP * DM, DM, (ti / 16) * 64, (ti % 16) * 64, WdnT + (size_t)l * DM * DMLP, DMLP, 0, nullptr, t, tid_);
  }
  float* rope = (float*)(p.ws + OFF_ROPE);
  for (int e = bid_ * 256 + tid_; e < SEQ * 48; e += nblk_ * 256) {
    const int pos = e / 48, i = e % 48;
    float inv;
    if (i < 32) inv = exp2f(-13.287712379549449f * (float)(2 * i) / 64.0f);
    else inv = exp2f(-13.287712379549449f * (float)(2 * (i - 32)) / 32.0f);
    const float angf = (float)pos * inv;
    const double ang = (double)angf;
    const double n = rint(ang * 0.15915494309189535);
    const float r = (float)(ang - n * 6.283185307179586);
    const float c = cosf(r), s = sinf(r);
    if (i < 32) { rope[pos * 96 + i] = c; rope[pos * 96 + 32 + i] = s; }
    else { rope[pos * 96 + 64 + (i - 32)] = c; rope[pos * 96 + 80 + (i - 32)] = s; }
  }
  u16* XB = (u16*)(p.ws + OFF_XB); float* SSQ = (float*)(p.ws + OFF_SSQ);
  const int lane = tid_ & 63;
  const int gw = bid_ * 4 + (tid_ >> 6), nw = nblk_ * 4;
  for (int row = gw; row < T; row += nw) {
    const float* xr = p.in[0] + (size_t)row * DM;
    float ss = 0.f;
#pragma unroll
    for (int i = 0; i < 4; ++i) {
      const f32x4 v = *(const f32x4*)(xr + i * 256 + lane * 4);
      ss += v[0] * v[0] + v[1] * v[1] + v[2] * v[2] + v[3] * v[3];
      u32x2 w = {pk2(v[0], v[1]), pk2(v[2], v[3])};
      *(u32x2*)(XB + (size_t)row * DM + i * 256 + lane * 4) = w;
    }
#pragma unroll
    for (int o = 32; o >= 1; o >>= 1) ss += __shfl_xor(ss, o);
    if (lane < 8) SSQ[(size_t)row * 8 + lane] = (lane == 0) ? ss : 0.f;
  }
}

DI int dil_of(int gi) { return gi == 0 ? 1 : (gi == 1 ? 4 : 16); }

__device__ void phase_inproj(const Params& p, int tid_, int bid_, int nblk_, int chunk, int layer, unsigned char* smem) {
  const u16* XB = (const u16*)(p.ws + OFF_XB) + (size_t)chunk * TC * DM;
  const float* SSQ = (const float*)(p.ws + OFF_SSQ) + (size_t)chunk * TC * 8;
  const u16* WinT = (const u16*)(p.ws + OFF_WIN) + (size_t)layer * INC * DM;
  u16* QKV = (u16*)(p.ws + OFF_QKV);
  u16* GATE = (u16*)(p.ws + OFF_GATE);
  const float* rope = (const float*)(p.ws + OFF_ROPE);
  float* ct = (float*)smem;
  const int tid = tid_; const int lane = tid & 63, wave = tid >> 6;
  TILE_LOOP_BEGIN(TC / 128, INC / 128)
    const int m0 = tile_m * 128, n0 = tile_n * 128;
    f32x16 acc[2][2];
    gemm_tile<2>(XB + (size_t)m0 * DM, DM, WinT + (size_t)n0 * DM, DM, DM, acc, (u16*)smem, tid_);
    dump_acc(acc, ct, tid_);
    __syncthreads();
    if (n0 < QKVC) {
      const int t = tid & 127, grp = tid >> 7;
      const int g = (n0 >> 6) + grp;
      const int tok = m0 + t;
      const int bl = tok >> 12, pos = tok & 4095;
      const float rs = row_rscale(SSQ, tok);
      float v[64];
#pragma unroll
      for (int q = 0; q < 16; ++q) {
        const f32x4 x4 = *(const f32x4*)(ct + t * 132 + grp * 64 + q * 4);
        v[q * 4 + 0] = x4[0] * rs; v[q * 4 + 1] = x4[1] * rs; v[q * 4 + 2] = x4[2] * rs; v[q * 4 + 3] = x4[3] * rs;
      }
      int kind, dil = 1; const float* gain = nullptr;
      if (g < 8) { kind = 0; gain = p.in[3] + layer * 128; }
      else if (g < 10) { kind = 0; gain = p.in[3] + layer * 128 + 64; }
      else if (g < 12) { kind = 3; }
      else if (g < 18) { kind = 0; gain = p.in[5] + layer * 128; dil = dil_of((g - 12) >> 1); }
      else if (g < 24) { kind = 0; gain = p.in[5] + layer * 128 + 64; dil = dil_of((g - 18) >> 1); }
      else if (g < 30) { kind = 3; dil = dil_of((g - 24) >> 1); }
      else if (g < 34) { kind = 2; gain = p.in[6] + layer * 64; }
      else if (g < 38) { kind = 2; gain = p.in[6] + layer * 64 + 32; }
      else if (g < 42) { kind = 3; }
      else if (g < 46) { kind = 1; gain = p.in[9] + layer * 128; }
      else if (g < 50) { kind = 1; gain = p.in[9] + layer * 128 + 64; }
      else { kind = 3; }
      const int pdom = (dil == 1) ? pos : ((pos % dil) * (SEQ / dil) + pos / dil);
      const int blk = pdom >> 5, r = pdom & 31;
      u16* base = QKV + (size_t)g * TC * 64 + (size_t)bl * SEQ * 64;
      if (kind == 0 || kind == 1) {
        float ss = 0.f;
#pragma unroll
        for (int d = 0; d < 64; ++d) ss += v[d] * v[d];
        const float rn = rsqrtf(ss * (1.0f / 64.0f) + 1e-6f);
#pragma unroll
        for (int d = 0; d < 64; ++d) v[d] = v[d] * rn * gain[d];
        if (kind == 0) {
          const float* cs = rope + pos * 96;
#pragma unroll
          for (int i = 0; i < 32; ++i) {
            const float c = cs[i], s = cs[32 + i];
            const float a = v[i], b = v[i + 32];
            v[i] = a * c - b * s; v[i + 32] = b * c + a * s;
          }
        }
#pragma unroll
        for (int s = 0; s < 4; ++s)
#pragma unroll
          for (int h = 0; h < 2; ++h) {
            const int d0 = 16 * s + 8 * h;
            u32x4 w = {pk2(v[d0], v[d0 + 1]), pk2(v[d0 + 2], v[d0 + 3]), pk2(v[d0 + 4], v[d0 + 5]), pk2(v[d0 + 6], v[d0 + 7])};
            *(u32x4*)(base + ((size_t)(blk * 4 + s) * 64 + h * 32 + r) * 8) = w;
          }
      } else if (kind == 2) {
        const float* cs = rope + pos * 96 + 64;
#pragma unroll
        for (int c = 0; c < 2; ++c) {
          float ss = 0.f;
#pragma unroll
          for (int d = 0; d < 32; ++d) ss += v[c * 32 + d] * v[c * 32 + d];
          const float rn = rsqrtf(ss * (1.0f / 32.0f) + 1e-6f);
#pragma unroll
          for (int d = 0; d < 32; ++d) v[c * 32 + d] = v[c * 32 + d] * rn * gain[d];
#pragma unroll
          for (int i = 0; i < 16; ++i) {
            const float cc = cs[i], sn = cs[16 + i];
            const float a = v[c * 32 + i], b = v[c * 32 + i + 16];
            v[c * 32 + i] = a * cc - b * sn; v[c * 32 + i + 16] = b * cc + a * sn;
          }
          u16* sb = base + (size_t)c * SEQ * 32;
#pragma unroll
          for (int s = 0; s < 2; ++s)
#pragma unroll
            for (int h = 0; h < 2; ++h) {
              const int d0 = c * 32 + 16 * s + 8 * h;
              u32x4 w = {pk2(v[d0], v[d0 + 1]), pk2(v[d0 + 2], v[d0 + 3]), pk2(v[d0 + 4], v[d0 + 5]), pk2(v[d0 + 6], v[d0 + 7])};
              *(u32x4*)(sb + ((size_t)(blk * 2 + s) * 64 + h * 32 + r) * 8) = w;
            }
        }
      } else {
        const int key = r, s = key >> 4, hh = (key >> 2) & 1, j = ((key >> 3) & 1) * 4 + (key & 3);
#pragma unroll
        for (int dv = 0; dv < 64; ++dv) {
          const unsigned w = pk2(v[dv], 0.f);
          base[((size_t)((blk * 2 + (dv >> 5)) * 2 + s) * 64 + hh * 32 + (dv & 31)) * 8 + j] = (u16)(w & 0xffffu);
        }
      }
    } else {
      const int gc0 = n0 - QKVC;
#pragma unroll 4
      for (int it = 0; it < 16; ++it) {
        const int row = it * 8 + wave * 2 + (lane >> 5), c4 = (lane & 31) * 4;
        const int tok = m0 + row;
        const float rs = row_rscale(SSQ, tok);
        const f32x4 x4 = *(const f32x4*)(ct + row * 132 + c4);
        float o[4];
#pragma unroll
        for (int e = 0; e < 4; ++e) o[e] = 1.0f / (1.0f + __expf(-x4[e] * rs));
        u32x2 w = {pk2(o[0], o[1]), pk2(o[2], o[3])};
        *(u32x2*)(GATE + (size_t)tok * 4096 + gc0 + c4) = w;
      }
    }
    __syncthreads();
  TILE_LOOP_END
}

DI void attn_softmax_pv(f32x16& S, float& m, float& l, f32x16& O0, f32x16& O1, const bf16x8 (&vf)[2][2]) {
  float mx = S[0];
#pragma unroll
  for (int i = 1; i < 16; ++i) mx = fmaxf(mx, S[i]);
  mx = fmaxf(mx, __shfl_xor(mx, 32));
  const float mn = fmaxf(m, mx);
  const float alpha = fexp2(m - mn);
  m = mn;
  float sum = 0.f;
#pragma unroll
  for (int i = 0; i < 16; ++i) { S[i] = fexp2(S[i] - mn); sum += S[i]; }
  l = l * alpha + sum;
  const u32x4 p0 = {pk2(S[0], S[1]), pk2(S[2], S[3]), pk2(S[4], S[5]), pk2(S[6], S[7])};
  const u32x4 p1 = {pk2(S[8], S[9]), pk2(S[10], S[11]), pk2(S[12], S[13]), pk2(S[14], S[15])};
#pragma unroll
  for (int i = 0; i < 16; ++i) { O0[i] *= alpha; O1[i] *= alpha; }
  O0 = MFMA32(vf[0][0], as_bf8(p0), O0);
  O0 = MFMA32(vf[0][1], as_bf8(p1), O0);
  O1 = MFMA32(vf[1][0], as_bf8(p0), O1);
  O1 = MFMA32(vf[1][1], as_bf8(p1), O1);
}
DI void load_vf(bf16x8 (&vf)[2][2], const u16* V, int kb, int lane) {
#pragma unroll
  for (int rb = 0; rb < 2; ++rb)
#pragma unroll
    for (int s = 0; s < 2; ++s) vf[rb][s] = *(const bf16x8*)(V + ((size_t)((kb * 2 + rb) * 2 + s) * 64 + lane) * 8);
}
DI void load_kf4(bf16x8 (&kf)[4], const u16* K, int kb, int lane) {
#pragma unroll
  for (int s = 0; s < 4; ++s) kf[s] = *(const bf16x8*)(K + ((size_t)(kb * 4 + s) * 64 + lane) * 8);
}
DI void load_kf2(bf16x8 (&kf)[2], const u16* K, int kb, int lane) {
#pragma unroll
  for (int s = 0; s < 2; ++s) kf[s] = *(const bf16x8*)(K + ((size_t)(kb * 2 + s) * 64 + lane) * 8);
}
DI void zero16(f32x16& a) {
#pragma unroll
  for (int i = 0; i < 16; ++i) a[i] = 0.f;
}
DI void store_o(u16* yrow, const f32x16& O0, const f32x16& O1, float sc, int h) {
#pragma unroll
  for (int g4 = 0; g4 < 4; ++g4) {
    u32x2 w0 = {pk2(O0[4 * g4] * sc, O0[4 * g4 + 1] * sc), pk2(O0[4 * g4 + 2] * sc, O0[4 * g4 + 3] * sc)};
    *(u32x2*)(yrow + 8 * g4 + 4 * h) = w0;
    u32x2 w1 = {pk2(O1[4 * g4] * sc, O1[4 * g4 + 1] * sc), pk2(O1[4 * g4 + 2] * sc, O1[4 * g4 + 3] * sc)};
    *(u32x2*)(yrow + 32 + 8 * g4 + 4 * h) = w1;
  }
}

__device__ void phase_attn(const Params& p, int tid_, int bid_, int nblk_, int layer) {
  const u16* QKV = (const u16*)(p.ws + OFF_QKV);
  u16* Y = (u16*)(p.ws + OFF_Y);
  u16* BO = (u16*)(p.ws + OFF_BO);
  float* LSE = (float*)(p.ws + OFF_LSE);
  const int lane = tid_ & 63, wave = tid_ >> 6;
  const int fr = lane & 31, fh = lane >> 5;
  const int nloc = nblk_ >> 3;
  if ((int)(bid_ >> 3) >= nloc) return;
  const int vw = ((bid_ & 7) * nloc + (bid_ >> 3)) * 4 + wave, NW = nloc * 32;
  const size_t GS = (size_t)TC * 64;
  const size_t BS = (size_t)SEQ * 64;

  {
    const float* lp = p.in[7] + layer * 128;
    float d01 = 0.f, d23 = 0.f;
    for (int i = 0; i < 32; ++i) { d01 += lp[i] * lp[32 + i]; d23 += lp[64 + i] * lp[96 + i]; }
    const float lambda_init = (layer == 0) ? 0.2f : 0.35550907f;
    const float lam = __expf(d01) - __expf(d23) + lambda_init;
    const float* subg = p.in[8] + layer * 64;
    const float sc = 0.17677669529663687f * LOG2E;
    for (int it = vw; it < BC * 4 * 128; it += NW) {
      const int bl = it >> 9, head = (it >> 7) & 3, qblk = it & 127;
      const u16* Q0 = QKV + (30 + head) * GS + bl * BS; const u16* Q1 = Q0 + SEQ * 32;
      const u16* K0 = QKV + (34 + head) * GS + bl * BS; const u16* K1 = K0 + SEQ * 32;
      const u16* V = QKV + (38 + head) * GS + bl * BS;
      bf16x8 q0[2], q1[2];
      load_kf2(q0, Q0, qblk, lane); load_kf2(q1, Q1, qblk, lane);
      float m0 = -1e30f, l0 = 0.f, m1 = -1e30f, l1 = 0.f;
      f32x16 O00, O01, O10, O11; zero16(O00); zero16(O01); zero16(O10); zero16(O11);
      bf16x8 k0[2], k1[2], vf[2][2];
      load_kf2(k0, K0, 0, lane); load_kf2(k1, K1, 0, lane); load_vf(vf, V, 0, lane);
      for (int kb = 0; kb < 128; ++kb) {
        bf16x8 nk0[2], nk1[2], nvf[2][2];
        const int kn = (kb + 1 < 128) ? kb + 1 : kb;
        load_kf2(nk0, K0, kn, lane); load_kf2(nk1, K1, kn, lane); load_vf(nvf, V, kn, lane);
        f32x16 S0, S1; zero16(S0); zero16(S1);
        S0 = MFMA32(k0[0], q0[0], S0); S0 = MFMA32(k0[1], q0[1], S0);
        S1 = MFMA32(k1[0], q1[0], S1); S1 = MFMA32(k1[1], q1[1], S1);
#pragma unroll
        for (int i = 0; i < 16; ++i) { S0[i] *= sc; S1[i] *= sc; }
        attn_softmax_pv(S0, m0, l0, O00, O01, vf);
        attn_softmax_pv(S1, m1, l1, O10, O11, vf);
#pragma unroll
        for (int s = 0; s < 2; ++s) { k0[s] = nk0[s]; k1[s] = nk1[s]; vf[0][s] = nvf[0][s]; vf[1][s] = nvf[1][s]; }
      }
      const float i0 = 1.0f / (l0 + __shfl_xor(l0, 32));
      const float i1 = lam / (l1 + __shfl_xor(l1, 32));
      float ss = 0.f;
#pragma unroll
      for (int i = 0; i < 16; ++i) {
        O00[i] = O00[i] * i0 - O10[i] * i1; O01[i] = O01[i] * i0 - O11[i] * i1;
        ss += O00[i] * O00[i] + O01[i] * O01[i];
      }
      ss += __shfl_xor(ss, 32);
      const float rn = rsqrtf(ss * (1.0f / 64.0f) + 1e-6f) * (1.0f - lambda_init);
#pragma unroll
      for (int g4 = 0; g4 < 4; ++g4) {
        const f32x4 ga = *(const f32x4*)(subg + 8 * g4 + 4 * fh);
        const f32x4 gb = *(const f32x4*)(subg + 32 + 8 * g4 + 4 * fh);
#pragma unroll
        for (int e = 0; e < 4; ++e) { O00[4 * g4 + e] *= ga[e]; O01[4 * g4 + e] *= gb[e]; }
      }
      const size_t tok = (size_t)bl * SEQ + qblk * 32 + fr;
      store_o(Y + tok * YC + 640 + head * 64, O00, O01, rn, fh);
    }
  }
  {
    const float sc = 0.125f * LOG2E;
    for (int it = vw; it < BC * 8 * 128; it += NW) {
      const int bl = it >> 10, hq = (it >> 7) & 7, qblk = it & 127;
      const int kvh = hq >> 2;
      const u16* Q = QKV + (size_t)hq * GS + bl * BS;
      const u16* K = QKV + (size_t)(8 + kvh) * GS + bl * BS;
      const u16* V = QKV + (size_t)(10 + kvh) * GS + bl * BS;
      bf16x8 qf[4]; load_kf4(qf, Q, qblk, lane);
      float m = p.in[4][layer * 8 + hq] * LOG2E, l = (fh == 0) ? 1.0f : 0.0f;
      f32x16 O0, O1; zero16(O0); zero16(O1);
      const int kb_lo = (qblk - 4 < 0) ? 0 : qblk - 4, kb_hi = (qblk + 4 > 127) ? 127 : qblk + 4;
      const int qpos = qblk * 32 + fr;
      for (int kb = kb_lo; kb <= kb_hi; ++kb) {
        bf16x8 kf[4], vf[2][2];
        load_kf4(kf, K, kb, lane); load_vf(vf, V, kb, lane);
        f32x16 S; zero16(S);
#pragma unroll
        for (int s = 0; s < 4; ++s) S = MFMA32(kf[s], qf[s], S);
#pragma unroll
        for (int i = 0; i < 16; ++i) {
          const int dlt = kb * 32 + crow(i, fh) - qpos;
          S[i] = (dlt <= 128 && dlt >= -128) ? S[i] * sc : -1e30f;
        }
        attn_softmax_pv(S, m, l, O0, O1, vf);
      }
      const float inv = 1.0f / (l + __shfl_xor(l, 32));
      const size_t tok = (size_t)bl * SEQ + qpos;
      store_o(Y + tok * YC + hq * 64, O0, O1, inv, fh);
    }
  }
  {
    const float sc = 0.125f;
    for (int it = vw; it < BC * 4 * 128; it += NW) {
      const int bl = it >> 9, head = (it >> 7) & 3, qblk = it & 127;
      const u16* Q = QKV + (size_t)(42 + head) * GS + bl * BS;
      const u16* K = QKV + (size_t)(46 + head) * GS + bl * BS;
      const u16* V = QKV + (size_t)(50 + head) * GS + bl * BS;
      const float* rpb = p.in[10] + (size_t)(layer * 4 + head) * 15 * 31;
      bf16x8 qf[4]; load_kf4(qf, Q, qblk, lane);
      float m = -1e30f, l = 0.f;
      f32x16 O0, O1; zero16(O0); zero16(O1);
      const int qrow = qblk >> 1, qc = (qblk & 1) * 32 + fr;
      int r0 = qrow - 4; r0 = r0 < 0 ? 0 : (r0 > 56 ? 56 : r0);
      int c0 = qc - 8; c0 = c0 < 0 ? 0 : (c0 > 48 ? 48 : c0);
      for (int kk = 0; kk < 16; ++kk) {
        const int krow_ = r0 + (kk >> 1), hb = kk & 1, kb = krow_ * 2 + hb;
        bf16x8 kf[4], vf[2][2];
        load_kf4(kf, K, kb, lane); load_vf(vf, V, kb, lane);
        f32x16 S; zero16(S);
#pragma unroll
        for (int s = 0; s < 4; ++s) S = MFMA32(kf[s], qf[s], S);
        const float* brow = rpb + (krow_ - qrow + 7) * 31;
#pragma unroll
        for (int i = 0; i < 16; ++i) {
          const int kc = hb * 32 + crow(i, fh);
          int dc = kc - qc; dc = dc < -15 ? -15 : (dc > 15 ? 15 : dc);
          const float bias = brow[dc + 15];
          S[i] = (kc >= c0 && kc < c0 + 16) ? (S[i] * sc + bias) * LOG2E : -1e30f;
        }
        attn_softmax_pv(S, m, l, O0, O1, vf);
      }
      const float inv = 1.0f / (l + __shfl_xor(l, 32));
      const size_t tok = (size_t)bl * SEQ + qblk * 32 + fr;
      store_o(Y + tok * YC + 896 + head * 64, O0, O1, inv, fh);
    }
  }
  {
    const float sc = 0.125f * LOG2E;
    for (int it = vw; it < BC * 6 * 128; it += NW) {
      const int bl = it / 768, rem = it % 768, head = rem >> 7, qblk = rem & 127;
      const int dil = dil_of(head >> 1), L = SEQ / dil, LB = L >> 5;
      const u16* Q = QKV + (size_t)(12 + head) * GS + bl * BS;
      const u16* K = QKV + (size_t)(18 + head) * GS + bl * BS;
      const u16* V = QKV + (size_t)(24 + head) * GS + bl * BS;
      bf16x8 qf[4]; load_kf4(qf, Q, qblk, lane);
      float m = -1e30f, l = 0.f;
      f32x16 O0, O1; zero16(O0); zero16(O1);
      const int rsub = qblk / LB;
      const int lo = rsub * LB, hi = lo + LB - 1;
      const int kb_lo = (qblk - 2 < lo) ? lo : qblk - 2, kb_hi = (qblk + 2 > hi) ? hi : qblk + 2;
      const int qd = qblk * 32 + fr;
      for (int kb = kb_lo; kb <= kb_hi; ++kb) {
        bf16x8 kf[4], vf[2][2];
        load_kf4(kf, K, kb, lane); load_vf(vf, V, kb, lane);
        f32x16 S; zero16(S);
#pragma unroll
        for (int s = 0; s < 4; ++s) S = MFMA32(kf[s], qf[s], S);
#pragma unroll
        for (int i = 0; i < 16; ++i) {
          const int dlt = kb * 32 + crow(i, fh) - qd;
          S[i] = (dlt <= 64 && dlt >= -64) ? S[i] * sc : -1e30f;
        }
        attn_softmax_pv(S, m, l, O0, O1, vf);
      }
      const float lt = l + __shfl_xor(l, 32);
      const float inv = 1.0f / lt;
      const int msub = qd - rsub * L;
      const int pos = msub * dil + rsub;
      const size_t tok = (size_t)bl * SEQ + pos;
      store_o(BO + tok * 384 + head * 64, O0, O1, inv, fh);
      if (fh == 0) LSE[tok * 8 + head] = __log2f(lt) + m;
    }
  }
}

__device__ void phase_bcombine(const Params& p, int tid_, int bid_, int nblk_) {
  const u16* BO = (const u16*)(p.ws + OFF_BO);
  const float* LSE = (const float*)(p.ws + OFF_LSE);
  u16* Y = (u16*)(p.ws + OFF_Y);
  for (int e = bid_ * 256 + tid_; e < TC * 16; e += nblk_ * 256) {
    const int tok = e >> 4, j = (e >> 3) & 1, c8 = (e & 7) * 8;
    const float a0 = LSE[(size_t)tok * 8 + j], a1 = LSE[(size_t)tok * 8 + 2 + j], a2 = LSE[(size_t)tok * 8 + 4 + j];
    const float mx = fmaxf(a0, fmaxf(a1, a2));
    float w0 = fexp2(a0 - mx), w1 = fexp2(a1 - mx), w2 = fexp2(a2 - mx);
    const float inv = 1.0f / (w0 + w1 + w2);
    w0 *= inv; w1 *= inv; w2 *= inv;
    const u32x4 x0 = *(const u32x4*)(BO + (size_t)tok * 384 + (0 + j) * 64 + c8);
    const u32x4 x1 = *(const u32x4*)(BO + (size_t)tok * 384 + (2 + j) * 64 + c8);
    const u32x4 x2 = *(const u32x4*)(BO + (size_t)tok * 384 + (4 + j) * 64 + c8);
    u32x4 o;
#pragma unroll
    for (int q = 0; q < 4; ++q) {
      const float lo = w0 * bf_lo(x0[q]) + w1 * bf_lo(x1[q]) + w2 * bf_lo(x2[q]);
      const float hi = w0 * bf_hi(x0[q]) + w1 * bf_hi(x1[q]) + w2 * bf_hi(x2[q]);
      o[q] = pk2(lo, hi);
    }
    *(u32x4*)(Y + (size_t)tok * YC + 512 + j * 64 + c8) = o;
  }
}

__device__ void phase_merge(const Params& p, int tid_, int bid_, int nblk_, int layer, unsigned char* smem) {
  const u16* Y = (const u16*)(p.ws + OFF_Y);
  const u16* GATE = (const u16*)(p.ws + OFF_GATE);
  const u16* WbrT = (const u16*)(p.ws + OFF_WBR) + (size_t)layer * DM * YC;
  u16* MRG = (u16*)(p.ws + OFF_MRG);
  float* ct = (float*)smem;
  const int lane = tid_ & 63, wave = tid_ >> 6;
  TILE_LOOP_BEGIN(TC / 128, DM / 64)
    const int m0 = tile_m * 128, n0 = tile_n * 64;
    f32x4 mg[8];
#pragma unroll
    for (int it = 0; it < 8; ++it) mg[it] = f32x4{0.f, 0.f, 0.f, 0.f};
#pragma unroll 1
    for (int seg = 0; seg < 4; ++seg) {
      const int koff = (seg == 0) ? 0 : (seg == 1 ? 512 : (seg == 2 ? 640 : 896));
      const int kl = (seg == 0) ? 512 : (seg == 1 ? 128 : 256);
      f32x16 acc[2][1];
      gemm_tile<1>(Y + (size_t)m0 * YC + koff, YC, WbrT + (size_t)n0 * YC + koff, YC, kl, acc, (u16*)smem, tid_);
      dump_acc1(acc, ct, tid_);
      __syncthreads();
#pragma unroll
      for (int it = 0; it < 8; ++it) {
        const int row = it * 16 + wave * 4 + (lane >> 4), c4 = (lane & 15) * 4;
        const f32x4 x4 = *(const f32x4*)(ct + row * 68 + c4);
        const u32x2 gq = *(const u32x2*)(GATE + (size_t)(m0 + row) * 4096 + seg * 1024 + n0 + c4);
        mg[it][0] += bf_lo(gq[0]) * x4[0]; mg[it][1] += bf_hi(gq[0]) * x4[1];
        mg[it][2] += bf_lo(gq[1]) * x4[2]; mg[it][3] += bf_hi(gq[1]) * x4[3];
      }
      __syncthreads();
    }
#pragma unroll
    for (int it = 0; it < 8; ++it) {
      const int row = it * 16 + wave * 4 + (lane >> 4), c4 = (lane & 15) * 4;
      u32x2 w = {pk2(mg[it][0], mg[it][1]), pk2(mg[it][2], mg[it][3])};
      *(u32x2*)(MRG + (size_t)(m0 + row) * DM + n0 + c4) = w;
    }
  TILE_LOOP_END
}

__device__ void phase_resid(const Params& p, int tid_, int bid_, int nblk_, int chunk, const u16* A, int K, const u16* Wt, const float* xold, unsigned char* smem) {
  float* xout = p.out + (size_t)chunk * TC * DM;
  u16* XB = (u16*)(p.ws + OFF_XB) + (size_t)chunk * TC * DM;
  float* SSQ = (float*)(p.ws + OFF_SSQ) + (size_t)chunk * TC * 8;
  float* ct = (float*)smem;
  const int lane = tid_ & 63, wave = tid_ >> 6;
  TILE_LOOP_BEGIN(TC / 128, DM / 128)
    const int m0 = tile_m * 128, n0 = tile_n * 128;
    f32x16 acc[2][2];
    gemm_tile<2>(A + (size_t)m0 * K, K, Wt + (size_t)n0 * K, K, K, acc, (u16*)smem, tid_);
    dump_acc(acc, ct, tid_);
    __syncthreads();
#pragma unroll 4
    for (int it = 0; it < 16; ++it) {
      const int row = it * 8 + wave * 2 + (lane >> 5), c4 = (lane & 31) * 4;
      const size_t o = (size_t)(m0 + row) * DM + n0 + c4;
      const f32x4 x4 = *(const f32x4*)(ct + row * 132 + c4);
      f32x4 xo = *(const f32x4*)(xold + o);
      xo[0] += x4[0]; xo[1] += x4[1]; xo[2] += x4[2]; xo[3] += x4[3];
      *(f32x4*)(xout + o) = xo;
      u32x2 w = {pk2(xo[0], xo[1]), pk2(xo[2], xo[3])};
      *(u32x2*)(XB + o) = w;
      float ss = xo[0] * xo[0] + xo[1] * xo[1] + xo[2] * xo[2] + xo[3] * xo[3];
#pragma unroll
      for (int d = 16; d >= 1; d >>= 1) ss += __shfl_xor(ss, d);
      if ((lane & 31) == 0) SSQ[(size_t)(m0 + row) * 8 + tile_n] = ss;
    }
    __syncthreads();
  TILE_LOOP_END
}

__device__ void phase_up(const Params& p, int tid_, int bid_, int nblk_, int chunk, int layer, unsigned char* smem) {
  const u16* XB = (const u16*)(p.ws + OFF_XB) + (size_t)chunk * TC * DM;
  const float* SSQ = (const float*)(p.ws + OFF_SSQ) + (size_t)chunk * TC * 8;
  const u16* WupT = (const u16*)(p.ws + OFF_WUP) + (size_t)layer * DMLP * DM;
  u16* U = (u16*)(p.ws + OFF_GATE);
  float* ct = (float*)smem;
  const int lane = tid_ & 63, wave = tid_ >> 6;
  TILE_LOOP_BEGIN(TC / 128, DMLP / 128)
    const int m0 = tile_m * 128, n0 = tile_n * 128;
    f32x16 acc[2][2];
    gemm_tile<2>(XB + (size_t)m0 * DM, DM, WupT + (size_t)n0 * DM, DM, DM, acc, (u16*)smem, tid_);
    dump_acc(acc, ct, tid_);
    __syncthreads();
#pragma unroll 4
    for (int it = 0; it < 16; ++it) {
      const int row = it * 8 + wave * 2 + (lane >> 5), c4 = (lane & 31) * 4;
      const float rs = row_rscale(SSQ, m0 + row);
      const f32x4 x4 = *(const f32x4*)(ct + row * 132 + c4);
      float o[4];
#pragma unroll
      for (int e = 0; e < 4; ++e) { const float z = fmaxf(x4[e] * rs, 0.f); o[e] = z * z; }
      u32x2 w = {pk2(o[0], o[1]), pk2(o[2], o[3])};
      *(u32x2*)(U + (size_t)(m0 + row) * DMLP + n0 + c4) = w;
    }
    __syncthreads();
  TILE_LOOP_END
}

__global__ void __launch_bounds__(256, 2) mk_forward(Params p) {
  __shared__ __attribute__((aligned(16))) unsigned char smem[LDS_BYTES];
  cg::grid_group grid = cg::this_grid();
  for (int ph = p.ph_lo; ph < p.ph_hi; ++ph) {
    int tid_ = threadIdx.x, bid_ = blockIdx.x, nblk_ = gridDim.x;
    asm volatile("" : "+v"(tid_));
    asm volatile("" : "+s"(bid_));
    asm volatile("" : "+s"(nblk_));
    Params pp = p;
    asm volatile("" : "+s"(pp.ws));
    asm volatile("" : "+s"(pp.out));
    if (ph == 0) {
      if (PHMASK & 128) phase_prep(pp, tid_, bid_, nblk_, smem);
    } else {
      const int q = ph - 1, chunk = q / 14, layer = (q % 14) / 7, k = q % 7;
      if (k == 0) { if (PHMASK & 1) phase_inproj(pp, tid_, bid_, nblk_, chunk, layer, smem); }
      else if (k == 1) { if (PHMASK & 2) phase_attn(pp, tid_, bid_, nblk_, layer); }
      else if (k == 2) { if (PHMASK & 4) phase_bcombine(pp, tid_, bid_, nblk_); }
      else if (k == 3) { if (PHMASK & 8) phase_merge(pp, tid_, bid_, nblk_, layer, smem); }
      else if (k == 4) { if (PHMASK & 16) phase_resid(pp, tid_, bid_, nblk_, chunk, (const u16*)(pp.ws + OFF_MRG), DM, (const u16*)(pp.ws + OFF_WOUT) + (size_t)layer * DM * DM,
                                   (layer == 0) ? (pp.in[0] + (size_t)chunk * TC * DM) : (pp.out + (size_t)chunk * TC * DM), smem); }
      else if (k == 5) { if (PHMASK & 32) phase_up(pp, tid_, bid_, nblk_, chunk, layer, smem); }
      else { if (PHMASK & 64) phase_resid(pp, tid_, bid_, nblk_, chunk, (const u16*)(pp.ws + OFF_GATE), DMLP, (const u16*)(pp.ws + OFF_WDN) + (size_t)layer * DM * DMLP,
                       pp.out + (size_t)chunk * TC * DM, smem); }
    }
    if (ph + 1 < p.ph_hi) grid.sync();
  }
}

extern "C" void kernel_launch(void* const* d_in, const int* in_sizes, int n_in, void* d_out, int out_size, void* d_ws, size_t ws_size,
                              hipStream_t stream) {
  static int grid_blocks = 0;
  if (grid_blocks == 0) {
    if (n_in != 19 || out_size != T * DM || ws_size < WS_END) {
      fprintf(stderr, "kernel_launch: unexpected problem (n_in %d out %d ws %zu need %zu)\n", n_in, out_size, ws_size, (size_t)WS_END);
      grid_blocks = -1;
      return;
    }
    int dev = 0, cus = 0, per_cu = 0;
    hipGetDevice(&dev);
    hipDeviceGetAttribute(&cus, hipDeviceAttributeMultiprocessorCount, dev);
    hipOccupancyMaxActiveBlocksPerMultiprocessor(&per_cu, mk_forward, 256, 0);
    if (per_cu < 1) per_cu = 1;
    if (per_cu > 2) per_cu = 2;
    grid_blocks = cus * per_cu;
  }
  if (grid_blocks < 0) return;
  Params p{};
  for (int i = 0; i < 19; ++i) p.in[i] = (const float*)d_in[i];
  p.out = (float*)d_out;
  p.ws = (unsigned char*)d_ws;
#if FUSED
  p.ph_lo = 0; p.ph_hi = NPHASE;
  void* args[] = {&p};
  hipError_t e = hipLaunchCooperativeKernel((const void*)mk_forward, dim3(grid_blocks), dim3(256), args, 0, stream);
  if (e != hipSuccess) fprintf(stderr, "cooperative launch failed: %s (grid %d)\n", hipGetErrorString(e), grid_blocks);
#else
  for (int ph = 0; ph < NPHASE; ++ph) {
    p.ph_lo = ph; p.ph_hi = ph + 1;
    hipLaunchKernelGGL(mk_forward, dim3(grid_blocks), dim3(256), 0, stream, p);
  }
#endif
}
```

```cpp
#include <hip/hip_runtime.h>
#include <hip/hip_cooperative_groups.h>
#include <cstdio>
namespace cg = cooperative_groups;

#ifndef PHMASK
#define PHMASK 255
#endif
#ifndef FUSED
#define FUSED 1
#endif

typedef unsigned short u16;
typedef short bf16x8 __attribute__((ext_vector_type(8)));
typedef float f32x16 __attribute__((ext_vector_type(16)));
typedef float f32x4 __attribute__((ext_vector_type(4)));
typedef __bf16 bf2_t __attribute__((ext_vector_type(2)));
typedef float f2_t __attribute__((ext_vector_type(2)));
typedef unsigned u32x4 __attribute__((ext_vector_type(4)));
typedef unsigned u32x2 __attribute__((ext_vector_type(2)));

#define DI __device__ __forceinline__
#define MFMA32(a, b, c) __builtin_amdgcn_mfma_f32_32x32x16_bf16((a), (b), (c), 0, 0, 0)

constexpr int DM = 1024, SEQ = 4096, NBATCH = 8, T = NBATCH * SEQ;
constexpr int NCH = 2, BC = NBATCH / NCH, TC = BC * SEQ;
constexpr int INC = 7552, QKVC = 3456, YC = 1152, DMLP = 4096;
constexpr int NGRP = QKVC / 64;
constexpr float LOG2E = 1.4426950408889634f;

constexpr size_t al256(size_t x) { return (x + 255) & ~(size_t)255; }
constexpr size_t OFF_WIN  = 0;
constexpr size_t OFF_WBR  = OFF_WIN  + al256((size_t)2 * INC * DM * 2);
constexpr size_t OFF_WOUT = OFF_WBR  + al256((size_t)2 * DM * YC * 2);
constexpr size_t OFF_WUP  = OFF_WOUT + al256((size_t)2 * DM * DM * 2);
constexpr size_t OFF_WDN  = OFF_WUP  + al256((size_t)2 * DMLP * DM * 2);
constexpr size_t OFF_ROPE = OFF_WDN  + al256((size_t)2 * DM * DMLP * 2);
constexpr size_t OFF_XB   = OFF_ROPE + al256((size_t)SEQ * 96 * 4);
constexpr size_t OFF_SSQ  = OFF_XB   + al256((size_t)T * DM * 2);
constexpr size_t OFF_QKV  = OFF_SSQ  + al256((size_t)T * 8 * 4);
constexpr size_t OFF_GATE = OFF_QKV  + al256((size_t)NGRP * TC * 64 * 2);
constexpr size_t OFF_Y    = OFF_GATE + al256((size_t)TC * 4096 * 2);
constexpr size_t OFF_BO   = OFF_Y    + al256((size_t)TC * YC * 2);
constexpr size_t OFF_LSE  = OFF_BO   + al256((size_t)TC * 384 * 2);
constexpr size_t OFF_MRG  = OFF_LSE  + al256((size_t)TC * 8 * 4);
constexpr size_t WS_END   = OFF_MRG  + al256((size_t)TC * DM * 2);
static_assert(WS_END <= (size_t)512 * 1024 * 1024, "workspace too large");

constexpr int LDS_BYTES = 73728;
constexpr int NPHASE = 1 + NCH * 2 * 7;

struct Params {
  const float* in[19];
  float* out;
  unsigned char* ws;
  int ph_lo, ph_hi;
};

DI unsigned pk2(float a, float b) { f2_t v = {a, b}; bf2_t r = __builtin_convertvector(v, bf2_t); return __builtin_bit_cast(unsigned, r); }
DI float bf_lo(unsigned u) { return __uint_as_float(u << 16); }
DI float bf_hi(unsigned u) { return __uint_as_float(u & 0xffff0000u); }
DI float fexp2(float x) { return __builtin_amdgcn_exp2f(x); }
DI int crow(int i, int h) { return (i & 3) + 8 * (i >> 2) + 4 * h; }
DI bf16x8 as_bf8(u32x4 v) { return __builtin_bit_cast(bf16x8, v); }

template <int NB>
DI void gemm_tile(const u16* __restrict__ A, int lda, const u16* __restrict__ B, int ldb, int K, f32x16 (&acc)[2][NB], u16* lds, int tid_) {
  const int tid = tid_; const int lane = tid & 63, wave = tid >> 6;
  const int wm = wave >> 1, wn = wave & 1;
  u16* sA = lds;
  u16* sB = lds + 2 * 128 * 72;
  const int lr = tid >> 3, lc = (tid & 7) * 8;
  const u16* ga = A + (size_t)lr * lda + lc;
  const u16* gb = B + (size_t)lr * ldb + lc;
  bf16x8 ra[4], rb[2 * NB];
#pragma unroll
  for (int i = 0; i < 4; ++i) ra[i] = *(const bf16x8*)(ga + (size_t)(32 * i) * lda);
#pragma unroll
  for (int i = 0; i < 2 * NB; ++i) rb[i] = *(const bf16x8*)(gb + (size_t)(32 * i) * ldb);
#pragma unroll
  for (int i = 0; i < 4; ++i) *(bf16x8*)(sA + (lr + 32 * i) * 72 + lc) = ra[i];
#pragma unroll
  for (int i = 0; i < 2 * NB; ++i) *(bf16x8*)(sB + (lr + 32 * i) * 72 + lc) = rb[i];
  __syncthreads();
  const int nk = K >> 6;
  const int fr = lane & 31, fh = lane >> 5;
#pragma unroll
  for (int mb = 0; mb < 2; ++mb)
#pragma unroll
    for (int nb = 0; nb < NB; ++nb)
#pragma unroll
      for (int i = 0; i < 16; ++i) acc[mb][nb][i] = 0.f;
  for (int kt = 0; kt < nk; ++kt) {
    const bool more = (kt + 1) < nk;
    if (more) {
      const int ko = (kt + 1) * 64;
#pragma unroll
      for (int i = 0; i < 4; ++i) ra[i] = *(const bf16x8*)(ga + (size_t)(32 * i) * lda + ko);
#pragma unroll
      for (int i = 0; i < 2 * NB; ++i) rb[i] = *(const bf16x8*)(gb + (size_t)(32 * i) * ldb + ko);
    }
    const u16* a_s = sA + (kt & 1) * (128 * 72) + (wm * 64 + fr) * 72 + fh * 8;
    const u16* b_s = sB + (kt & 1) * (128 * 72) + (wn * 32 * NB + fr) * 72 + fh * 8;
#pragma unroll
    for (int s = 0; s < 4; ++s) {
      const bf16x8 a0 = *(const bf16x8*)(a_s + s * 16);
      const bf16x8 a1 = *(const bf16x8*)(a_s + 32 * 72 + s * 16);
      const bf16x8 b0 = *(const bf16x8*)(b_s + s * 16);
      acc[0][0] = MFMA32(a0, b0, acc[0][0]);
      acc[1][0] = MFMA32(a1, b0, acc[1][0]);
      if (NB == 2) {
        const bf16x8 b1 = *(const bf16x8*)(b_s + 32 * 72 + s * 16);
        acc[0][NB - 1] = MFMA32(a0, b1, acc[0][NB - 1]);
        acc[1][NB - 1] = MFMA32(a1, b1, acc[1][NB - 1]);
      }
    }
    if (more) {
      u16* wa = sA + ((kt + 1) & 1) * (128 * 72);
      u16* wb = sB + ((kt + 1) & 1) * (128 * 72);
#pragma unroll
      for (int i = 0; i < 4; ++i) *(bf16x8*)(wa + (lr + 32 * i) * 72 + lc) = ra[i];
#pragma unroll
      for (int i = 0; i < 2 * NB; ++i) *(bf16x8*)(wb + (lr + 32 * i) * 72 + lc) = rb[i];
    }
    __syncthreads();
  }
}

DI void dump_acc(const f32x16 (&acc)[2][2], float* ct, int tid_) {
  const int lane = tid_ & 63, wave = tid_ >> 6;
  const int wm = wave >> 1, wn = wave & 1, fr = lane & 31, fh = lane >> 5;
#pragma unroll
  for (int mb = 0; mb < 2; ++mb)
#pragma unroll
    for (int nb = 0; nb < 2; ++nb)
#pragma unroll
      for (int i = 0; i < 16; ++i)
        ct[(wm * 64 + mb * 32 + crow(i, fh)) * 132 + wn * 64 + nb * 32 + fr] = acc[mb][nb][i];
}

DI void dump_acc1(const f32x16 (&acc)[2][1], float* ct, int tid_) {
  const int lane = tid_ & 63, wave = tid_ >> 6;
  const int wm = wave >> 1, wn = wave & 1, fr = lane & 31, fh = lane >> 5;
#pragma unroll
  for (int mb = 0; mb < 2; ++mb)
#pragma unroll
    for (int i = 0; i < 16; ++i) ct[(wm * 64 + mb * 32 + crow(i, fh)) * 68 + wn * 32 + fr] = acc[mb][0][i];
}

#define TILE_LOOP_BEGIN(Mt, Nt)                                                             \
  {                                                                                         \
    const int _nloc = nblk_ >> 3, _x = bid_ & 7, _l = bid_ >> 3;            \
    const int _mper = (Mt) >> 3, _per = _mper * (Nt);                                       \
    if (_l < _nloc)                                                                         \
      for (int _i = _l; _i < _per; _i += _nloc) {                                           \
        const int _mm = _i & 7, _rest = _i >> 3;                                            \
        const int tile_n = _rest % (Nt), tile_m = _x * _mper + (_rest / (Nt)) * 8 + _mm;
#define TILE_LOOP_END }}

DI float row_rscale(const float* ssq, size_t tok) {
  const f32x4 a = *(const f32x4*)(ssq + tok * 8), b = *(const f32x4*)(ssq + tok * 8 + 4);
  const float s = (a[0] + a[1]) + (a[2] + a[3]) + (b[0] + b[1]) + (b[2] + b[3]);
  return rsqrtf(s * (1.0f / 1024.0f) + 1e-6f);
}

DI void convert_tile(const float* __restrict__ src, int N, int k0, int n0, u16* __restrict__ dst, int ldk, int koff,
                     const float* __restrict__ g, float* t, int tid_) {
  const int tid = tid_;
  {
    const int c4 = (tid & 15) * 4;
#pragma unroll
    for (int i = 0; i < 4; ++i) {
      const int kk = (tid >> 4) + 16 * i;
      f32x4 v = *(const f32x4*)(src + (size_t)(k0 + kk) * N + n0 + c4);
      const float sc = g ? g[k0 + kk] : 1.0f;
      t[kk * 65 + c4 + 0] = v[0] * sc; t[kk * 65 + c4 + 1] = v[1] * sc; t[kk * 65 + c4 + 2] = v[2] * sc; t[kk * 65 + c4 + 3] = v[3] * sc;
    }
  }
  __syncthreads();
  {
    const int kc = (tid & 7) * 8;
#pragma unroll
    for (int i = 0; i < 2; ++i) {
      const int nn = (tid >> 3) + 32 * i;
      u32x4 w;
      w[0] = pk2(t[(kc + 0) * 65 + nn], t[(kc + 1) * 65 + nn]);
      w[1] = pk2(t[(kc + 2) * 65 + nn], t[(kc + 3) * 65 + nn]);
      w[2] = pk2(t[(kc + 4) * 65 + nn], t[(kc + 5) * 65 + nn]);
      w[3] = pk2(t[(kc + 6) * 65 + nn], t[(kc + 7) * 65 + nn]);
      *(u32x4*)(dst + (size_t)(n0 + nn) * ldk + koff + k0 + kc) = w;
    }
  }
  __syncthreads();
}

__device__ void phase_prep(const Params& p, int tid_, int bid_, int nblk_, unsigned char* smem) {
  float* t = (float*)smem;
  u16* WinT = (u16*)(p.ws + OFF_WIN); u16* WbrT = (u16*)(p.ws + OFF_WBR); u16* WoutT = (u16*)(p.ws + OFF_WOUT);
  u16* WupT = (u16*)(p.ws + OFF_WUP); u16* WdnT = (u16*)(p.ws + OFF_WDN);
  const int per_layer = 4480;
  for (int j = bid_; j < 2 * per_layer; j += nblk_) {
    const int l = j / per_layer; int ti = j % per_layer;
    if (ti < 1888) { convert_tile(p.in[2] + (size_t)l * DM * INC, INC, (ti / 118) * 64, (ti % 118) * 64, WinT + (size_t)l * INC * DM, DM, 0, p.in[1] + l * DM, t, tid_); continue; }
    ti -= 1888;
    if (ti < 128) { convert_tile(p.in[11] + (size_t)l * 512 * DM, DM, (ti / 16) * 64, (ti % 16) * 64, WbrT + (size_t)l * DM * YC, YC, 0, nullptr, t, tid_); continue; }
    ti -= 128;
    if (ti < 32) { convert_tile(p.in[12] + (size_t)l * 128 * DM, DM, (ti / 16) * 64, (ti % 16) * 64, WbrT + (size_t)l * DM * YC, YC, 512, nullptr, t, tid_); continue; }
    ti -= 32;
    if (ti < 64) { convert_tile(p.in[13] + (size_t)l * 256 * DM, DM, (ti / 16) * 64, (ti % 16) * 64, WbrT + (size_t)l * DM * YC, YC, 640, nullptr, t, tid_); continue; }
    ti -= 64;
    if (ti < 64) { convert_tile(p.in[14] + (size_t)l * 256 * DM, DM, (ti / 16) * 64, (ti % 16) * 64, WbrT + (size_t)l * DM * YC, YC, 896, nullptr, t, tid_); continue; }
    ti -= 64;
    if (ti < 256) { convert_tile(p.in[15] + (size_t)l * DM * DM, DM, (ti / 16) * 64, (ti % 16) * 64, WoutT + (size_t)l * DM * DM, DM, 0, nullptr, t, tid_); continue; }
    ti -= 256;
    if (ti < 1024) { convert_tile(p.in[17] + (size_t)l * DM * DMLP, DMLP, (ti / 64) * 64, (ti % 64) * 64, WupT + (size_t)l * DMLP * DM, DM, 0, p.in[16] + l * DM, t, tid_); continue; }
    ti -= 1024;
    convert_tile(p.in[18] + (size_t)l * DMLP * DM, DM, (ti / 16) * 64, (ti % 16) * 64, WdnT + (size_t)l * DM * DMLP, DMLP, 0, nullptr, t, tid_);
  }
  float* rope = (float*)(p.ws + OFF_ROPE);
  for (int e = bid_ * 256 + tid_; e < SEQ * 48; e += nblk_ * 256) {
    const int pos = e / 48, i = e % 48;
    float inv;
    if (i < 32) inv = exp2f(-13.287712379549449f * (float)(2 * i) / 64.0f);
    else inv = exp2f(-13.287712379549449f * (float)(2 * (i - 32)) / 32.0f);
    const float angf = (float)pos * inv;
    const double ang = (double)angf;
    const double n = rint(ang * 0.15915494309189535);
    const float r = (float)(ang - n * 6.283185307179586);
    const float c = cosf(r), s = sinf(r);
    if (i < 32) { rope[pos * 96 + i] = c; rope[pos * 96 + 32 + i] = s; }
    else { rope[pos * 96 + 64 + (i - 32)] = c; rope[pos * 96 + 80 + (i - 32)] = s; }
  }
  u16* XB = (u16*)(p.ws + OFF_XB); float* SSQ = (float*)(p.ws + OFF_SSQ);
  const int lane = tid_ & 63;
  const int gw = bid_ * 4 + (tid_ >> 6), nw = nblk_ * 4;
  for (int row = gw; row < T; row += nw) {
    const float* xr = p.in[0] + (size_t)row * DM;
    float ss = 0.f;
#pragma unroll
    for (int i = 0; i < 4; ++i) {
      const f32x4 v = *(const f32x4*)(xr + i * 256 + lane * 4);
      ss += v[0] * v[0] + v[1] * v[1] + v[2] * v[2] + v[3] * v[3];
      u32x2 w = {pk2(v[0], v[1]), pk2(v[2], v[3])};
      *(u32x2*)(XB + (size_t)row * DM + i * 256 + lane * 4) = w;
    }
#pragma unroll
    for (int o = 32; o >= 1; o >>= 1) ss += __shfl_xor(ss, o);
    if (lane < 8) SSQ[(size_t)row * 8 + lane] = (lane == 0) ? ss : 0.f;
  }
}

DI int dil_of(int gi) { return gi == 0 ? 1 : (gi == 1 ? 4 : 16); }

__device__ void phase_inproj(const Params& p, int tid_, int bid_, int nblk_, int chunk, int layer, unsigned char* smem) {
  const u16* XB = (const u16*)(p.ws + OFF_XB) + (size_t)chunk * TC * DM;
  const float* SSQ = (const float*)(p.ws + OFF_SSQ) + (size_t)chunk * TC * 8;
  const u16* WinT = (const u16*)(p.ws + OFF_WIN) + (size_t)layer * INC * DM;
  u16* QKV = (u16*)(p.ws + OFF_QKV);
  u16* GATE = (u16*)(p.ws + OFF_GATE);
  const float* rope = (const float*)(p.ws + OFF_ROPE);
  float* ct = (float*)smem;
  const int tid = tid_; const int lane = tid & 63, wave = tid >> 6;
  TILE_LOOP_BEGIN(TC / 128, INC / 128)
    const int m0 = tile_m * 128, n0 = tile_n * 128;
    f32x16 acc[2][2];
    gemm_tile<2>(XB + (size_t)m0 * DM, DM, WinT + (size_t)n0 * DM, DM, DM, acc, (u16*)smem, tid_);
    dump_acc(acc, ct, tid_);
    __syncthreads();
    if (n0 < QKVC) {
      const int t = tid & 127, grp = tid >> 7;
      const int g = (n0 >> 6) + grp;
      const int tok = m0 + t;
      const int bl = tok >> 12, pos = tok & 4095;
      const float rs = row_rscale(SSQ, tok);
      float v[64];
#pragma unroll
      for (int q = 0; q < 16; ++q) {
        const f32x4 x4 = *(const f32x4*)(ct + t * 132 + grp * 64 + q * 4);
        v[q * 4 + 0] = x4[0] * rs; v[q * 4 + 1] = x4[1] * rs; v[q * 4 + 2] = x4[2] * rs; v[q * 4 + 3] = x4[3] * rs;
      }
      int kind, dil = 1; const float* gain = nullptr;
      if (g < 8) { kind = 0; gain = p.in[3] + layer * 128; }
      else if (g < 10) { kind = 0; gain = p.in[3] + layer * 128 + 64; }
      else if (g < 12) { kind = 3; }
      else if (g < 18) { kind = 0; gain = p.in[5] + layer * 128; dil = dil_of((g - 12) >> 1); }
      else if (g < 24) { kind = 0; gain = p.in[5] + layer * 128 + 64; dil = dil_of((g - 18) >> 1); }
      else if (g < 30) { kind = 3; dil = dil_of((g - 24) >> 1); }
      else if (g < 34) { kind = 2; gain = p.in[6] + layer * 64; }
      else if (g < 38) { kind = 2; gain = p.in[6] + layer * 64 + 32; }
      else if (g < 42) { kind = 3; }
      else if (g < 46) { kind = 1; gain = p.in[9] + layer * 128; }
      else if (g < 50) { kind = 1; gain = p.in[9] + layer * 128 + 64; }
      else { kind = 3; }
      const int pdom = (dil == 1) ? pos : ((pos % dil) * (SEQ / dil) + pos / dil);
      const int blk = pdom >> 5, r = pdom & 31;
      u16* base = QKV + (size_t)g * TC * 64 + (size_t)bl * SEQ * 64;
      if (kind == 0 || kind == 1) {
        float ss = 0.f;
#pragma unroll
        for (int d = 0; d < 64; ++d) ss += v[d] * v[d];
        const float rn = rsqrtf(ss * (1.0f / 64.0f) + 1e-6f);
#pragma unroll
        for (int d = 0; d < 64; ++d) v[d] = v[d] * rn * gain[d];
        if (kind == 0) {
          const float* cs = rope + pos * 96;
#pragma unroll
          for (int i = 0; i < 32; ++i) {
            const float c = cs[i], s = cs[32 + i];
            const float a = v[i], b = v[i + 32];
            v[i] = a * c - b * s; v[i + 32] = b * c + a * s;
          }
        }
#pragma unroll
        for (int s = 0; s < 4; ++s)
#pragma unroll
          for (int h = 0; h < 2; ++h) {
            const int d0 = 16 * s + 8 * h;
            u32x4 w = {pk2(v[d0], v[d0 + 1]), pk2(v[d0 + 2], v[d0 + 3]), pk2(v[d0 + 4], v[d0 + 5]), pk2(v[d0 + 6], v[d0 + 7])};
            *(u32x4*)(base + ((size_t)(blk * 4 + s) * 64 + h * 32 + r) * 8) = w;
          }
      } else if (kind == 2) {
        const float* cs = rope + pos * 96 + 64;
#pragma unroll
        for (int c = 0; c < 2; ++c) {
          float ss = 0.f;
#pragma unroll
          for (int d = 0; d < 32; ++d) ss += v[c * 32 + d] * v[c * 32 + d];
          const float rn = rsqrtf(ss * (1.0f / 32.0f) + 1e-6f);
#pragma unroll
          for (int d = 0; d < 32; ++d) v[c * 32 + d] = v[c * 32 + d] * rn * gain[d];
#pragma unroll
          for (int i = 0; i < 16; ++i) {
            const float cc = cs[i], sn = cs[16 + i];
            const float a = v[c * 32 + i], b = v[c * 32 + i + 16];
            v[c * 32 + i] = a * cc - b * sn; v[c * 32 + i + 16] = b * cc + a * sn;
          }
          u16* sb = base + (size_t)c * SEQ * 32;
#pragma unroll
          for (int s = 0; s < 2; ++s)
#pragma unroll
            for (int h = 0; h < 2; ++h) {
              const int d0 = c * 32 + 16 * s + 8 * h;
              u32x4 w = {pk2(v[d0], v[d0 + 1]), pk2(v[d0 + 2], v[d0 + 3]), pk2(v[d0 + 4], v[d0 + 5]), pk2(v[d0 + 6], v[d0 + 7])};
              *(u32x4*)(sb + ((size_t)(blk * 2 + s) * 64 + h * 32 + r) * 8) = w;
            }
        }
      } else {
        const int key = r, s = key >> 4, hh = (key >> 2) & 1, j = ((key >> 3) & 1) * 4 + (key & 3);
#pragma unroll
        for (int dv = 0; dv < 64; ++dv) {
          const unsigned w = pk2(v[dv], 0.f);
          base[((size_t)((blk * 2 + (dv >> 5)) * 2 + s) * 64 + hh * 32 + (dv & 31)) * 8 + j] = (u16)(w & 0xffffu);
        }
      }
    } else {
      const int gc0 = n0 - QKVC;
#pragma unroll 4
      for (int it = 0; it < 16; ++it) {
        const int row = it * 8 + wave * 2 + (lane >> 5), c4 = (lane & 31) * 4;
        const int tok = m0 + row;
        const float rs = row_rscale(SSQ, tok);
        const f32x4 x4 = *(const f32x4*)(ct + row * 132 + c4);
        float o[4];
#pragma unroll
        for (int e = 0; e < 4; ++e) o[e] = 1.0f / (1.0f + __expf(-x4[e] * rs));
        u32x2 w = {pk2(o[0], o[1]), pk2(o[2], o[3])};
        *(u32x2*)(GATE + (size_t)tok * 4096 + gc0 + c4) = w;
      }
    }
    __syncthreads();
  TILE_LOOP_END
}

DI void attn_softmax_pv(f32x16& S, float& m, float& l, f32x16& O0, f32x16& O1, const bf16x8 (&vf)[2][2]) {
  float mx = S[0];
#pragma unroll
  for (int i = 1; i < 16; ++i) mx = fmaxf(mx, S[i]);
  mx = fmaxf(mx, __shfl_xor(mx, 32));
  const float mn = fmaxf(m, mx);
  const float alpha = fexp2(m - mn);
  m = mn;
  float sum = 0.f;
#pragma unroll
  for (int i = 0; i < 16; ++i) { S[i] = fexp2(S[i] - mn); sum += S[i]; }
  l = l * alpha + sum;
  const u32x4 p0 = {pk2(S[0], S[1]), pk2(S[2], S[3]), pk2(S[4], S[5]), pk2(S[6], S[7])};
  const u32x4 p1 = {pk2(S[8], S[9]), pk2(S[10], S[11]), pk2(S[12], S[13]), pk2(S[14], S[15])};
#pragma unroll
  for (int i = 0; i < 16; ++i) { O0[i] *= alpha; O1[i] *= alpha; }
  O0 = MFMA32(vf[0][0], as_bf8(p0), O0);
  O0 = MFMA32(vf[0][1], as_bf8(p1), O0);
  O1 = MFMA32(vf[1][0], as_bf8(p0), O1);
  O1 = MFMA32(vf[1][1], as_bf8(p1), O1);
}
DI void load_vf(bf16x8 (&vf)[2][2], const u16* V, int kb, int lane) {
#pragma unroll
  for (int rb = 0; rb < 2; ++rb)
#pragma unroll
    for (int s = 0; s < 2; ++s) vf[rb][s] = *(const bf16x8*)(V + ((size_t)((kb * 2 + rb) * 2 + s) * 64 + lane) * 8);
}
DI void load_kf4(bf16x8 (&kf)[4], const u16* K, int kb, int lane) {
#pragma unroll
  for (int s = 0; s < 4; ++s) kf[s] = *(const bf16x8*)(K + ((size_t)(kb * 4 + s) * 64 + lane) * 8);
}
DI void load_kf2(bf16x8 (&kf)[2], const u16* K, int kb, int lane) {
#pragma unroll
  for (int s = 0; s < 2; ++s) kf[s] = *(const bf16x8*)(K + ((size_t)(kb * 2 + s) * 64 + lane) * 8);
}
DI void zero16(f32x16& a) {
#pragma unroll
  for (int i = 0; i < 16; ++i) a[i] = 0.f;
}
DI void store_o(u16* yrow, const f32x16& O0, const f32x16& O1, float sc, int h) {
#pragma unroll
  for (int g4 = 0; g4 < 4; ++g4) {
    u32x2 w0 = {pk2(O0[4 * g4] * sc, O0[4 * g4 + 1] * sc), pk2(O0[4 * g4 + 2] * sc, O0[4 * g4 + 3] * sc)};
    *(u32x2*)(yrow + 8 * g4 + 4 * h) = w0;
    u32x2 w1 = {pk2(O1[4 * g4] * sc, O1[4 * g4 + 1] * sc), pk2(O1[4 * g4 + 2] * sc, O1[4 * g4 + 3] * sc)};
    *(u32x2*)(yrow + 32 + 8 * g4 + 4 * h) = w1;
  }
}

__device__ void phase_attn(const Params& p, int tid_, int bid_, int nblk_, int layer) {
  const u16* QKV = (const u16*)(p.ws + OFF_QKV);
  u16* Y = (u16*)(p.ws + OFF_Y);
  u16* BO = (u16*)(p.ws + OFF_BO);
  float* LSE = (float*)(p.ws + OFF_LSE);
  const int lane = tid_ & 63, wave = tid_ >> 6;
  const int fr = lane & 31, fh = lane >> 5;
  const int nloc = nblk_ >> 3;
  if ((int)(bid_ >> 3) >= nloc) return;
  const int vw = ((bid_ & 7) * nloc + (bid_ >> 3)) * 4 + wave, NW = nloc * 32;
  const size_t GS = (size_t)TC * 64;
  const size_t BS = (size_t)SEQ * 64;

  {
    const float* lp = p.in[7] + layer * 128;
    float d01 = 0.f, d23 = 0.f;
    for (int i = 0; i < 32; ++i) { d01 += lp[i] * lp[32 + i]; d23 += lp[64 + i] * lp[96 + i]; }
    const float lambda_init = (layer == 0) ? 0.2f : 0.35550907f;
    const float lam = __expf(d01) - __expf(d23) + lambda_init;
    const float* subg = p.in[8] + layer * 64;
    const float sc = 0.17677669529663687f * LOG2E;
    for (int it = vw; it < BC * 4 * 128; it += NW) {
      const int bl = it >> 9, head = (it >> 7) & 3, qblk = it & 127;
      const u16* Q0 = QKV + (30 + head) * GS + bl * BS; const u16* Q1 = Q0 + SEQ * 32;
      const u16* K0 = QKV + (34 + head) * GS + bl * BS; const u16* K1 = K0 + SEQ * 32;
      const u16* V = QKV + (38 + head) * GS + bl * BS;
      bf16x8 q0[2], q1[2];
      load_kf2(q0, Q0, qblk, lane); load_kf2(q1, Q1, qblk, lane);
      float m0 = -1e30f, l0 = 0.f, m1 = -1e30f, l1 = 0.f;
      f32x16 O00, O01, O10, O11; zero16(O00); zero16(O01); zero16(O10); zero16(O11);
      bf16x8 k0[2], k1[2], vf[2][2];
      load_kf2(k0, K0, 0, lane); load_kf2(k1, K1, 0, lane); load_vf(vf, V, 0, lane);
      for (int kb = 0; kb < 128; ++kb) {
        bf16x8 nk0[2], nk1[2], nvf[2][2];
        const int kn = (kb + 1 < 128) ? kb + 1 : kb;
        load_kf2(nk0, K0, kn, lane); load_kf2(nk1, K1, kn, lane); load_vf(nvf, V, kn, lane);
        f32x16 S0, S1; zero16(S0); zero16(S1);
        S0 = MFMA32(k0[0], q0[0], S0); S0 = MFMA32(k0[1], q0[1], S0);
        S1 = MFMA32(k1[0], q1[0], S1); S1 = MFMA32(k1[1], q1[1], S1);
#pragma unroll
        for (int i = 0; i < 16; ++i) { S0[i] *= sc; S1[i] *= sc; }
        attn_softmax_pv(S0, m0, l0, O00, O01, vf);
        attn_softmax_pv(S1, m1, l1, O10, O11, vf);
#pragma unroll
        for (int s = 0; s < 2; ++s) { k0[s] = nk0[s]; k1[s] = nk1[s]; vf[0][s] = nvf[0][s]; vf[1][s] = nvf[1][s]; }
      }
      const float i0 = 1.0f / (l0 + __shfl_xor(l0, 32));
      const float i1 = lam / (l1 + __shfl_xor(l1, 32));
      float ss = 0.f;
#pragma unroll
      for (int i = 0; i < 16; ++i) {
        O00[i] = O00[i] * i0 - O10[i] * i1; O01[i] = O01[i] * i0 - O11[i] * i1;
        ss += O00[i] * O00[i] + O01[i] * O01[i];
      }
      ss += __shfl_xor(ss, 32);
      const float rn = rsqrtf(ss * (1.0f / 64.0f) + 1e-6f) * (1.0f - lambda_init);
#pragma unroll
      for (int g4 = 0; g4 < 4; ++g4) {
        const f32x4 ga = *(const f32x4*)(subg + 8 * g4 + 4 * fh);
        const f32x4 gb = *(const f32x4*)(subg + 32 + 8 * g4 + 4 * fh);
#pragma unroll
        for (int e = 0; e < 4; ++e) { O00[4 * g4 + e] *= ga[e]; O01[4 * g4 + e] *= gb[e]; }
      }
      const size_t tok = (size_t)bl * SEQ + qblk * 32 + fr;
      store_o(Y + tok * YC + 640 + head * 64, O00, O01, rn, fh);
    }
  }
  {
    const float sc = 0.125f * LOG2E;
    for (int it = vw; it < BC * 8 * 128; it += NW) {
      const int bl = it >> 10, hq = (it >> 7) & 7, qblk = it & 127;
      const int kvh = hq >> 2;
      const u16* Q = QKV + (size_t)hq * GS + bl * BS;
      const u16* K = QKV + (size_t)(8 + kvh) * GS + bl * BS;
      const u16* V = QKV + (size_t)(10 + kvh) * GS + bl * BS;
      bf16x8 qf[4]; load_kf4(qf, Q, qblk, lane);
      float m = p.in[4][layer * 8 + hq] * LOG2E, l = (fh == 0) ? 1.0f : 0.0f;
      f32x16 O0, O1; zero16(O0); zero16(O1);
      const int kb_lo = (qblk - 4 < 0) ? 0 : qblk - 4, kb_hi = (qblk + 4 > 127) ? 127 : qblk + 4;
      const int qpos = qblk * 32 + fr;
      for (int kb = kb_lo; kb <= kb_hi; ++kb) {
        bf16x8 kf[4], vf[2][2];
        load_kf4(kf, K, kb, lane); load_vf(vf, V, kb, lane);
        f32x16 S; zero16(S);
#pragma unroll
        for (int s = 0; s < 4; ++s) S = MFMA32(kf[s], qf[s], S);
#pragma unroll
        for (int i = 0; i < 16; ++i) {
          const int dlt = kb * 32 + crow(i, fh) - qpos;
          S[i] = (dlt <= 128 && dlt >= -128) ? S[i] * sc : -1e30f;
        }
        attn_softmax_pv(S, m, l, O0, O1, vf);
      }
      const float inv = 1.0f / (l + __shfl_xor(l, 32));
      const size_t tok = (size_t)bl * SEQ + qpos;
      store_o(Y + tok * YC + hq * 64, O0, O1, inv, fh);
    }
  }
  {
    const float sc = 0.125f;
    for (int it = vw; it < BC * 4 * 128; it += NW) {
      const int bl = it >> 9, head = (it >> 7) & 3, qblk = it & 127;
      const u16* Q = QKV + (size_t)(42 + head) * GS + bl * BS;
      const u16* K = QKV + (size_t)(46 + head) * GS + bl * BS;
      const u16* V = QKV + (size_t)(50 + head) * GS + bl * BS;
      const float* rpb = p.in[10] + (size_t)(layer * 4 + head) * 15 * 31;
      bf16x8 qf[4]; load_kf4(qf, Q, qblk, lane);
      float m = -1e30f, l = 0.f;
      f32x16 O0, O1; zero16(O0); zero16(O1);
      const int qrow = qblk >> 1, qc = (qblk & 1) * 32 + fr;
      int r0 = qrow - 4; r0 = r0 < 0 ? 0 : (r0 > 56 ? 56 : r0);
      int c0 = qc - 8; c0 = c0 < 0 ? 0 : (c0 > 48 ? 48 : c0);
      for (int kk = 0; kk < 16; ++kk) {
        const int krow_ = r0 + (kk >> 1), hb = kk & 1, kb = krow_ * 2 + hb;
        bf16x8 kf[4], vf[2][2];
        load_kf4(kf, K, kb, lane); load_vf(vf, V, kb, lane);
        f32x16 S; zero16(S);
#pragma unroll
        for (int s = 0; s < 4; ++s) S = MFMA32(kf[s], qf[s], S);
        const float* brow = rpb + (krow_ - qrow + 7) * 31;
#pragma unroll
        for (int i = 0; i < 16; ++i) {
          const int kc = hb * 32 + crow(i, fh);
          int dc = kc - qc; dc = dc < -15 ? -15 : (dc > 15 ? 15 : dc);
          const float bias = brow[dc + 15];
          S[i] = (kc >= c0 && kc < c0 + 16) ? (S[i] * sc + bias) * LOG2E : -1e30f;
        }
        attn_softmax_pv(S, m, l, O0, O1, vf);
      }
      const float inv = 1.0f / (l + __shfl_xor(l, 32));
      const size_t tok = (size_t)bl * SEQ + qblk * 32 + fr;
      store_o(Y + tok * YC + 896 + head * 64, O0, O1, inv, fh);
    }
  }
  {
    const float sc = 0.125f * LOG2E;
    for (int it = vw; it < BC * 6 * 128; it += NW) {
      const int bl = it / 768, rem = it % 768, head = rem >> 7, qblk = rem & 127;
      const int dil = dil_of(head >> 1), L = SEQ / dil, LB = L >> 5;
      const u16* Q = QKV + (size_t)(12 + head) * GS + bl * BS;
      const u16* K = QKV + (size_t)(18 + head) * GS + bl * BS;
      const u16* V = QKV + (size_t)(24 + head) * GS + bl * BS;
      bf16x8 qf[4]; load_kf4(qf, Q, qblk, lane);
      float m = -1e30f, l = 0.f;
      f32x16 O0, O1; zero16(O0); zero16(O1);
      const int rsub = qblk / LB;
      const int lo = rsub * LB, hi = lo + LB - 1;
      const int kb_lo = (qblk - 2 < lo) ? lo : qblk - 2, kb_hi = (qblk + 2 > hi) ? hi : qblk + 2;
      const int qd = qblk * 32 + fr;
      for (int kb = kb_lo; kb <= kb_hi; ++kb) {
        bf16x8 kf[4], vf[2][2];
        load_kf4(kf, K, kb, lane); load_vf(vf, V, kb, lane);
        f32x16 S; zero16(S);
#pragma unroll
        for (int s = 0; s < 4; ++s) S = MFMA32(kf[s], qf[s], S);
#pragma unroll
        for (int i = 0; i < 16; ++i) {
          const int dlt = kb * 32 + crow(i, fh) - qd;
          S[i] = (dlt <= 64 && dlt >= -64) ? S[i] * sc : -1e30f;
        }
        attn_softmax_pv(S, m, l, O0, O1, vf);
      }
      const float lt = l + __shfl_xor(l, 32);
      const float inv = 1.0f / lt;
      const int msub = qd - rsub * L;
      const int pos = msub * dil + rsub;
      const size_t tok = (size_t)bl * SEQ + pos;
      store_o(BO + tok * 384 + head * 64, O0, O1, inv, fh);
      if (fh == 0) LSE[tok * 8 + head] = __log2f(lt) + m;
    }
  }
}

__device__ void phase_bcombine(const Params& p, int tid_, int bid_, int nblk_) {
  const u16* BO = (const u16*)(p.ws + OFF_BO);
  const float* LSE = (const float*)(p.ws + OFF_LSE);
  u16* Y = (u16*)(p.ws + OFF_Y);
  for (int e = bid_ * 256 + tid_; e < TC * 16; e += nblk_ * 256) {
    const int tok = e >> 4, j = (e >> 3) & 1, c8 = (e & 7) * 8;
    const float a0 = LSE[(size_t)tok * 8 + j], a1 = LSE[(size_t)tok * 8 + 2 + j], a2 = LSE[(size_t)tok * 8 + 4 + j];
    const float mx = fmaxf(a0, fmaxf(a1, a2));
    float w0 = fexp2(a0 - mx), w1 = fexp2(a1 - mx), w2 = fexp2(a2 - mx);
    const float inv = 1.0f / (w0 + w1 + w2);
    w0 *= inv; w1 *= inv; w2 *= inv;
    const u32x4 x0 = *(const u32x4*)(BO + (size_t)tok * 384 + (0 + j) * 64 + c8);
    const u32x4 x1 = *(const u32x4*)(BO + (size_t)tok * 384 + (2 + j) * 64 + c8);
    const u32x4 x2 = *(const u32x4*)(BO + (size_t)tok * 384 + (4 + j) * 64 + c8);
    u32x4 o;
#pragma unroll
    for (int q = 0; q < 4; ++q) {
      const float lo = w0 * bf_lo(x0[q]) + w1 * bf_lo(x1[q]) + w2 * bf_lo(x2[q]);
      const float hi = w0 * bf_hi(x0[q]) + w1 * bf_hi(x1[q]) + w2 * bf_hi(x2[q]);
      o[q] = pk2(lo, hi);
    }
    *(u32x4*)(Y + (size_t)tok * YC + 512 + j * 64 + c8) = o;
  }
}

__device__ void phase_merge(const Params& p, int tid_, int bid_, int nblk_, int layer, unsigned char* smem) {
  const u16* Y = (const u16*)(p.ws + OFF_Y);
  const u16* GATE = (const u16*)(p.ws + OFF_GATE);
  const u16* WbrT = (const u16*)(p.ws + OFF_WBR) + (size_t)layer * DM * YC;
  u16* MRG = (u16*)(p.ws + OFF_MRG);
  float* ct = (float*)smem;
  const int lane = tid_ & 63, wave = tid_ >> 6;
  TILE_LOOP_BEGIN(TC / 128, DM / 64)
    const int m0 = tile_m * 128, n0 = tile_n * 64;
    f32x4 mg[8];
#pragma unroll
    for (int it = 0; it < 8; ++it) mg[it] = f32x4{0.f, 0.f, 0.f, 0.f};
#pragma unroll 1
    for (int seg = 0; seg < 4; ++seg) {
      const int koff = (seg == 0) ? 0 : (seg == 1 ? 512 : (seg == 2 ? 640 : 896));
      const int kl = (seg == 0) ? 512 : (seg == 1 ? 128 : 256);
      f32x16 acc[2][1];
      gemm_tile<1>(Y + (size_t)m0 * YC + koff, YC, WbrT + (size_t)n0 * YC + koff, YC, kl, acc, (u16*)smem, tid_);
      dump_acc1(acc, ct, tid_);
      __syncthreads();
#pragma unroll
      for (int it = 0; it < 8; ++it) {
        const int row = it * 16 + wave * 4 + (lane >> 4), c4 = (lane & 15) * 4;
        const f32x4 x4 = *(const f32x4*)(ct + row * 68 + c4);
        const u32x2 gq = *(const u32x2*)(GATE + (size_t)(m0 + row) * 4096 + seg * 1024 + n0 + c4);
        mg[it][0] += bf_lo(gq[0]) * x4[0]; mg[it][1] += bf_hi(gq[0]) * x4[1];
        mg[it][2] += bf_lo(gq[1]) * x4[2]; mg[it][3] += bf_hi(gq[1]) * x4[3];
      }
      __syncthreads();
    }
#pragma unroll
    for (int it = 0; it < 8; ++it) {
      const int row = it * 16 + wave * 4 + (lane >> 4), c4 = (lane & 15) * 4;
      u32x2 w = {pk2(mg[it][0], mg[it][1]), pk2(mg[it][2], mg[it][3])};
      *(u32x2*)(MRG + (size_t)(m0 + row) * DM + n0 + c4) = w;
    }
  TILE_LOOP_END
}

__device__ void phase_resid(const Params& p, int tid_, int bid_, int nblk_, int chunk, const u16* A, int K, const u16* Wt, const float* xold, unsigned char* smem) {
  float* xout = p.out + (size_t)chunk * TC * DM;
  u16* XB = (u16*)(p.ws + OFF_XB) + (size_t)chunk * TC * DM;
  float* SSQ = (float*)(p.ws + OFF_SSQ) + (size_t)chunk * TC * 8;
  float* ct = (float*)smem;
  const int lane = tid_ & 63, wave = tid_ >> 6;
  TILE_LOOP_BEGIN(TC / 128, DM / 128)
    const int m0 = tile_m * 128, n0 = tile_n * 128;
    f32x16 acc[2][2];
    gemm_tile<2>(A + (size_t)m0 * K, K, Wt + (size_t)n0 * K, K, K, acc, (u16*)smem, tid_);
    dump_acc(acc, ct, tid_);
    __syncthreads();
#pragma unroll 4
    for (int it = 0; it < 16; ++it) {
      const int row = it * 8 + wave * 2 + (lane >> 5), c4 = (lane & 31) * 4;
      const size_t o = (size_t)(m0 + row) * DM + n0 + c4;
      const f32x4 x4 = *(const f32x4*)(ct + row * 132 + c4);
      f32x4 xo = *(const f32x4*)(xold + o);
      xo[0] += x4[0]; xo[1] += x4[1]; xo[2] += x4[2]; xo[3] += x4[3];
      *(f32x4*)(xout + o) = xo;
      u32x2 w = {pk2(xo[0], xo[1]), pk2(xo[2], xo[3])};
      *(u32x2*)(XB + o) = w;
      float ss = xo[0] * xo[0] + xo[1] * xo[1] + xo[2] * xo[2] + xo[3] * xo[3];
#pragma unroll
      for (int d = 16; d >= 1; d >>= 1) ss += __shfl_xor(ss, d);
      if ((lane & 31) == 0) SSQ[(size_t)(m0 + row) * 8 + tile_n] = ss;
    }
    __syncthreads();
  TILE_LOOP_END
}

__device__ void phase_up(const Params& p, int tid_, int bid_, int nblk_, int chunk, int layer, unsigned char* smem) {
  const u16* XB = (const u16*)(p.ws + OFF_XB) + (size_t)chunk * TC * DM;
  const float* SSQ = (const float*)(p.ws + OFF_SSQ) + (size_t)chunk * TC * 8;
  const u16* WupT = (const u16*)(p.ws + OFF_WUP) + (size_t)layer * DMLP * DM;
  u16* U = (u16*)(p.ws + OFF_GATE);
  float* ct = (float*)smem;
  const int lane = tid_ & 63, wave = tid_ >> 6;
  TILE_LOOP_BEGIN(TC / 128, DMLP / 128)
    const int m0 = tile_m * 128, n0 = tile_n * 128;
    f32x16 acc[2][2];
    gemm_tile<2>(XB + (size_t)m0 * DM, DM, WupT + (size_t)n0 * DM, DM, DM, acc, (u16*)smem, tid_);
    dump_acc(acc, ct, tid_);
    __syncthreads();
#pragma unroll 4
    for (int it = 0; it < 16; ++it) {
      const int row = it * 8 + wave * 2 + (lane >> 5), c4 = (lane & 31) * 4;
      const float rs = row_rscale(SSQ, m0 + row);
      const f32x4 x4 = *(const f32x4*)(ct + row * 132 + c4);
      float o[4];
#pragma unroll
      for (int e = 0; e < 4; ++e) { const float z = fmaxf(x4[e] * rs, 0.f); o[e] = z * z; }
      u32x2 w = {pk2(o[0], o[1]), pk2(o[2], o[3])};
      *(u32x2*)(U + (size_t)(m0 + row) * DMLP + n0 + c4) = w;
    }
    __syncthreads();
  TILE_LOOP_END
}

__global__ void __launch_bounds__(256, 2) mk_forward(Params p) {
  __shared__ __attribute__((aligned(16))) unsigned char smem[LDS_BYTES];
  cg::grid_group grid = cg::this_grid();
  for (int ph = p.ph_lo; ph < p.ph_hi; ++ph) {
    int tid_ = threadIdx.x, bid_ = blockIdx.x, nblk_ = gridDim.x;
    asm volatile("" : "+v"(tid_));
    asm volatile("" : "+s"(bid_));
    asm volatile("" : "+s"(nblk_));
    Params pp = p;
    asm volatile("" : "+s"(pp.ws));
    asm volatile("" : "+s"(pp.out));
    if (ph == 0) {
      if (PHMASK & 128) phase_prep(pp, tid_, bid_, nblk_, smem);
    } else {
      const int q = ph - 1, chunk = q / 14, layer = (q % 14) / 7, k = q % 7;
      if (k == 0) { if (PHMASK & 1) phase_inproj(pp, tid_, bid_, nblk_, chunk, layer, smem); }
      else if (k == 1) { if (PHMASK & 2) phase_attn(pp, tid_, bid_, nblk_, layer); }
      else if (k == 2) { if (PHMASK & 4) phase_bcombine(pp, tid_, bid_, nblk_); }
      else if (k == 3) { if (PHMASK & 8) phase_merge(pp, tid_, bid_, nblk_, layer, smem); }
      else if (k == 4) { if (PHMASK & 16) phase_resid(pp, tid_, bid_, nblk_, chunk, (const u16*)(pp.ws + OFF_MRG), DM, (const u16*)(pp.ws + OFF_WOUT) + (size_t)layer * DM * DM,
                                   (layer == 0) ? (pp.in[0] + (size_t)chunk * TC * DM) : (pp.out + (size_t)chunk * TC * DM), smem); }
      else if (k == 5) { if (PHMASK & 32) phase_up(pp, tid_, bid_, nblk_, chunk, layer, smem); }
      else { if (PHMASK & 64) phase_resid(pp, tid_, bid_, nblk_, chunk, (const u16*)(pp.ws + OFF_GATE), DMLP, (const u16*)(pp.ws + OFF_WDN) + (size_t)layer * DM * DMLP,
                       pp.out + (size_t)chunk * TC * DM, smem); }
    }
    if (ph + 1 < p.ph_hi) grid.sync();
  }
}

extern "C" void kernel_launch(void* const* d_in, const int* in_sizes, int n_in, void* d_out, int out_size, void* d_ws, size_t ws_size,
                              hipStream_t stream) {
  static int grid_blocks = 0;
  if (grid_blocks == 0) {
    if (n_in != 19 || out_size != T * DM || ws_size < WS_END) {
      fprintf(stderr, "kernel_launch: unexpected problem (n_in %d out %d ws %zu need %zu)\n", n_in, out_size, ws_size, (size_t)WS_END);
      grid_blocks = -1;
      return;
    }
    int dev = 0, cus = 0, per_cu = 0;
    hipGetDevice(&dev);
    hipDeviceGetAttribute(&cus, hipDeviceAttributeMultiprocessorCount, dev);
    hipOccupancyMaxActiveBlocksPerMultiprocessor(&per_cu, mk_forward, 256, 0);
    if (per_cu < 1) per_cu = 1;
    if (per_cu > 2) per_cu = 2;
    grid_blocks = cus * per_cu;
  }
  if (grid_blocks < 0) return;
  Params p{};
  for (int i = 0; i < 19; ++i) p.in[i] = (const float*)d_in[i];
  p.out = (float*)d_out;
  p.ws = (unsigned char*)d_ws;
#if FUSED
  p.ph_lo = 0; p.ph_hi = NPHASE;
  void* args[] = {&p};
  hipError_t e = hipLaunchCooperativeKernel((const void*)mk_forward, dim3(grid_blocks), dim3(256), args, 0, stream);
  if (e != hipSuccess) fprintf(stderr, "cooperative launch failed: %s (grid %d)\n", hipGetErrorString(e), grid_blocks);
#else
  for (int ph = 0; ph < NPHASE; ++ph) {
    p.ph_lo = ph; p.ph_hi = ph + 1;
    hipLaunchKernelGGL(mk_forward, dim3(grid_blocks), dim3(256), 0, stream, p);
  }
#endif
}
```

```cpp
#include <hip/hip_runtime.h>
#include <hip/hip_cooperative_groups.h>
#include <cstdio>
namespace cg = cooperative_groups;

#ifndef PHMASK
#define PHMASK 255
#endif
#ifndef DUPMASK
#define DUPMASK 0
#endif
#ifndef FUSED
#define FUSED 1
#endif

typedef unsigned short u16;
typedef short bf16x8 __attribute__((ext_vector_type(8)));
typedef float f32x16 __attribute__((ext_vector_type(16)));
typedef float f32x4 __attribute__((ext_vector_type(4)));
typedef __bf16 bf2_t __attribute__((ext_vector_type(2)));
typedef float f2_t __attribute__((ext_vector_type(2)));
typedef unsigned u32x4 __attribute__((ext_vector_type(4)));
typedef unsigned u32x2 __attribute__((ext_vector_type(2)));

#define DI __device__ __forceinline__
#define MFMA32(a, b, c) __builtin_amdgcn_mfma_f32_32x32x16_bf16((a), (b), (c), 0, 0, 0)

constexpr int DM = 1024, SEQ = 4096, NBATCH = 8, T = NBATCH * SEQ;
constexpr int NCH = 2, BC = NBATCH / NCH, TC = BC * SEQ;
constexpr int INC = 7552, QKVC = 3456, YC = 1152, DMLP = 4096;
constexpr int NGRP = QKVC / 64;
constexpr float LOG2E = 1.4426950408889634f;

constexpr size_t al256(size_t x) { return (x + 255) & ~(size_t)255; }
constexpr size_t OFF_WIN  = 0;
constexpr size_t OFF_WBR  = OFF_WIN  + al256((size_t)2 * INC * DM * 2);
constexpr size_t OFF_WOUT = OFF_WBR  + al256((size_t)2 * DM * YC * 2);
constexpr size_t OFF_WUP  = OFF_WOUT + al256((size_t)2 * DM * DM * 2);
constexpr size_t OFF_WDN  = OFF_WUP  + al256((size_t)2 * DMLP * DM * 2);
constexpr size_t OFF_ROPE = OFF_WDN  + al256((size_t)2 * DM * DMLP * 2);
constexpr size_t OFF_XB   = OFF_ROPE + al256((size_t)SEQ * 96 * 4);
constexpr size_t OFF_SSQ  = OFF_XB   + al256((size_t)T * DM * 2);
constexpr size_t OFF_QKV  = OFF_SSQ  + al256((size_t)T * 8 * 4);
constexpr size_t OFF_GATE = OFF_QKV  + al256((size_t)NGRP * TC * 64 * 2);
constexpr size_t OFF_Y    = OFF_GATE + al256((size_t)TC * 4096 * 2);
constexpr size_t OFF_BO   = OFF_Y    + al256((size_t)TC * YC * 2);
constexpr size_t OFF_LSE  = OFF_BO   + al256((size_t)TC * 384 * 2);
constexpr size_t OFF_MRG  = OFF_LSE  + al256((size_t)TC * 8 * 4);
constexpr size_t OFF_BAR  = OFF_MRG  + al256((size_t)TC * DM * 2);
constexpr size_t WS_END   = OFF_BAR  + 16384;
static_assert(WS_END <= (size_t)512 * 1024 * 1024, "workspace too large");

constexpr int LDS_BYTES = 73728;
constexpr int NPHASE = 1 + NCH * 2 * 7;

struct Params {
  const float* in[19];
  float* out;
  unsigned char* ws;
  int ph_lo, ph_hi;
};

DI unsigned pk2(float a, float b) { f2_t v = {a, b}; bf2_t r = __builtin_convertvector(v, bf2_t); return __builtin_bit_cast(unsigned, r); }
DI float bf_lo(unsigned u) { return __uint_as_float(u << 16); }
DI float bf_hi(unsigned u) { return __uint_as_float(u & 0xffff0000u); }
DI float fexp2(float x) { return __builtin_amdgcn_exp2f(x); }
DI int crow(int i, int h) { return (i & 3) + 8 * (i >> 2) + 4 * h; }
DI bf16x8 as_bf8(u32x4 v) { return __builtin_bit_cast(bf16x8, v); }

template <int NB>
DI void gemm_tile(const u16* __restrict__ A, int lda, const u16* __restrict__ B, int ldb, int K, f32x16 (&acc)[2][NB], u16* lds, int tid_) {
  const int tid = tid_; const int lane = tid & 63, wave = tid >> 6;
  const int wm = wave >> 1, wn = wave & 1;
  u16* sA = lds;
  u16* sB = lds + 2 * 128 * 72;
  const int lr = tid >> 3, lc = (tid & 7) * 8;
  const u16* ga = A + (size_t)lr * lda + lc;
  const u16* gb = B + (size_t)lr * ldb + lc;
  bf16x8 ra[4], rb[2 * NB];
#pragma unroll
  for (int i = 0; i < 4; ++i) ra[i] = *(const bf16x8*)(ga + (size_t)(32 * i) * lda);
#pragma unroll
  for (int i = 0; i < 2 * NB; ++i) rb[i] = *(const bf16x8*)(gb + (size_t)(32 * i) * ldb);
#pragma unroll
  for (int i = 0; i < 4; ++i) *(bf16x8*)(sA + (lr + 32 * i) * 72 + lc) = ra[i];
#pragma unroll
  for (int i = 0; i < 2 * NB; ++i) *(bf16x8*)(sB + (lr + 32 * i) * 72 + lc) = rb[i];
  __syncthreads();
  const int nk = K >> 6;
  const int fr = lane & 31, fh = lane >> 5;
#pragma unroll
  for (int mb = 0; mb < 2; ++mb)
#pragma unroll
    for (int nb = 0; nb < NB; ++nb)
#pragma unroll
      for (int i = 0; i < 16; ++i) acc[mb][nb][i] = 0.f;
  for (int kt = 0; kt < nk; ++kt) {
    const bool more = (kt + 1) < nk;
    if (more) {
      const int ko = (kt + 1) * 64;
#pragma unroll
      for (int i = 0; i < 4; ++i) ra[i] = *(const bf16x8*)(ga + (size_t)(32 * i) * lda + ko);
#pragma unroll
      for (int i = 0; i < 2 * NB; ++i) rb[i] = *(const bf16x8*)(gb + (size_t)(32 * i) * ldb + ko);
    }
    const u16* a_s = sA + (kt & 1) * (128 * 72) + (wm * 64 + fr) * 72 + fh * 8;
    const u16* b_s = sB + (kt & 1) * (128 * 72) + (wn * 32 * NB + fr) * 72 + fh * 8;
#pragma unroll
    for (int s = 0; s < 4; ++s) {
      const bf16x8 a0 = *(const bf16x8*)(a_s + s * 16);
      const bf16x8 a1 = *(const bf16x8*)(a_s + 32 * 72 + s * 16);
      const bf16x8 b0 = *(const bf16x8*)(b_s + s * 16);
      acc[0][0] = MFMA32(a0, b0, acc[0][0]);
      acc[1][0] = MFMA32(a1, b0, acc[1][0]);
      if (NB == 2) {
        const bf16x8 b1 = *(const bf16x8*)(b_s + 32 * 72 + s * 16);
        acc[0][NB - 1] = MFMA32(a0, b1, acc[0][NB - 1]);
        acc[1][NB - 1] = MFMA32(a1, b1, acc[1][NB - 1]);
      }
    }
    if (more) {
      u16* wa = sA + ((kt + 1) & 1) * (128 * 72);
      u16* wb = sB + ((kt + 1) & 1) * (128 * 72);
#pragma unroll
      for (int i = 0; i < 4; ++i) *(bf16x8*)(wa + (lr + 32 * i) * 72 + lc) = ra[i];
#pragma unroll
      for (int i = 0; i < 2 * NB; ++i) *(bf16x8*)(wb + (lr + 32 * i) * 72 + lc) = rb[i];
    }
    __syncthreads();
  }
}

DI void dump_acc(const f32x16 (&acc)[2][2], float* ct, int tid_) {
  const int lane = tid_ & 63, wave = tid_ >> 6;
  const int wm = wave >> 1, wn = wave & 1, fr = lane & 31, fh = lane >> 5;
#pragma unroll
  for (int mb = 0; mb < 2; ++mb)
#pragma unroll
    for (int nb = 0; nb < 2; ++nb)
#pragma unroll
      for (int i = 0; i < 16; ++i)
        ct[(wm * 64 + mb * 32 + crow(i, fh)) * 132 + wn * 64 + nb * 32 + fr] = acc[mb][nb][i];
}

DI void dump_acc1(const f32x16 (&acc)[2][1], float* ct, int tid_) {
  const int lane = tid_ & 63, wave = tid_ >> 6;
  const int wm = wave >> 1, wn = wave & 1, fr = lane & 31, fh = lane >> 5;
#pragma unroll
  for (int mb = 0; mb < 2; ++mb)
#pragma unroll
    for (int i = 0; i < 16; ++i) ct[(wm * 64 + mb * 32 + crow(i, fh)) * 68 + wn * 32 + fr] = acc[mb][0][i];
}

#define TILE_LOOP_BEGIN(Mt, Nt)                                                             \
  {                                                                                         \
    const int _nloc = nblk_ >> 3, _x = bid_ & 7, _l = bid_ >> 3;            \
    const int _mper = (Mt) >> 3, _per = _mper * (Nt);                                       \
    if (_l < _nloc)                                                                         \
      for (int _i = _l; _i < _per; _i += _nloc) {                                           \
        const int _mm = _i & 7, _rest = _i >> 3;                                            \
        const int tile_n = _rest % (Nt), tile_m = _x * _mper + (_rest / (Nt)) * 8 + _mm;
#define TILE_LOOP_END }}

DI float row_rscale(const float* ssq, size_t tok) {
  const f32x4 a = *(const f32x4*)(ssq + tok * 8), b = *(const f32x4*)(ssq + tok * 8 + 4);
  const float s = (a[0] + a[1]) + (a[2] + a[3]) + (b[0] + b[1]) + (b[2] + b[3]);
  return rsqrtf(s * (1.0f / 1024.0f) + 1e-6f);
}

DI void convert_tile(const float* __restrict__ src, int N, int k0, int n0, u16* __restrict__ dst, int ldk, int koff,
                     const float* __restrict__ g, float* t, int tid_) {
  const int tid = tid_;
  {
    const int c4 = (tid & 15) * 4;
#pragma unroll
    for (int i = 0; i < 4; ++i) {
      const int kk = (tid >> 4) + 16 * i;
      f32x4 v = *(const f32x4*)(src + (size_t)(k0 + kk) * N + n0 + c4);
      const float sc = g ? g[k0 + kk] : 1.0f;
      t[kk * 65 + c4 + 0] = v[0] * sc; t[kk * 65 + c4 + 1] = v[1] * sc; t[kk * 65 + c4 + 2] = v[2] * sc; t[kk * 65 + c4 + 3] = v[3] * sc;
    }
  }
  __syncthreads();
  {
    const int kc = (tid & 7) * 8;
#pragma unroll
    for (int i = 0; i < 2; ++i) {
      const int nn = (tid >> 3) + 32 * i;
      u32x4 w;
      w[0] = pk2(t[(kc + 0) * 65 + nn], t[(kc + 1) * 65 + nn]);
      w[1] = pk2(t[(kc + 2) * 65 + nn], t[(kc + 3) * 65 + nn]);
      w[2] = pk2(t[(kc + 4) * 65 + nn], t[(kc + 5) * 65 + nn]);
      w[3] = pk2(t[(kc + 6) * 65 + nn], t[(kc + 7) * 65 + nn]);
      *(u32x4*)(dst + (size_t)(n0 + nn) * ldk + koff + k0 + kc) = w;
    }
  }
  __syncthreads();
}

__device__ void phase_prep(const Params& p, int tid_, int bid_, int nblk_, unsigned char* smem) {
  float* t = (float*)smem;
  u16* WinT = (u16*)(p.ws + OFF_WIN); u16* WbrT = (u16*)(p.ws + OFF_WBR); u16* WoutT = (u16*)(p.ws + OFF_WOUT);
  u16* WupT = (u16*)(p.ws + OFF_WUP); u16* WdnT = (u16*)(p.ws + OFF_WDN);
  const int per_layer = 4480;
  for (int j = bid_; j < 2 * per_layer; j += nblk_) {
    const int l = j / per_layer; int ti = j % per_layer;
    if (ti < 1888) { convert_tile(p.in[2] + (size_t)l * DM * INC, INC, (ti / 118) * 64, (ti % 118) * 64, WinT + (size_t)l * INC * DM, DM, 0, p.in[1] + l * DM, t, tid_); continue; }
    ti -= 1888;
    if (ti < 128) { convert_tile(p.in[11] + (size_t)l * 512 * DM, DM, (ti / 16) * 64, (ti % 16) * 64, WbrT + (size_t)l * DM * YC, YC, 0, nullptr, t, tid_); continue; }
    ti -= 128;
    if (ti < 32) { convert_tile(p.in[12] + (size_t)l * 128 * DM, DM, (ti / 16) * 64, (ti % 16) * 64, WbrT + (size_t)l * DM * YC, YC, 512, nullptr, t, tid_); continue; }
    ti -= 32;
    if (ti < 64) { convert_tile(p.in[13] + (size_t)l * 256 * DM, DM, (ti / 16) * 64, (ti % 16) * 64, WbrT + (size_t)l * DM * YC, YC, 640, nullptr, t, tid_); continue; }
    ti -= 64;
    if (ti < 64) { convert_tile(p.in[14] + (size_t)l * 256 * DM, DM, (ti / 16) * 64, (ti % 16) * 64, WbrT + (size_t)l * DM * YC, YC, 896, nullptr, t, tid_); continue; }
    ti -= 64;
    if (ti < 256) { convert_tile(p.in[15] + (size_t)l * DM * DM, DM, (ti / 16) * 64, (ti % 16) * 64, WoutT + (size_t)l * DM * DM, DM, 0, nullptr, t, tid_); continue; }
    ti -= 256;
    if (ti < 1024) { convert_tile(p.in[17] + (size_t)l * DM * DMLP, DMLP, (ti / 64) * 64, (ti % 64) * 64, WupT + (size_t)l * DMLP * DM, DM, 0, p.in[16] + l * DM, t, tid_); continue; }
    ti -= 1024;
    convert_tile(p.in[18] + (size_t)l * DMLP * DM, DM, (ti / 16) * 64, (ti % 16) * 64, WdnT + (size_t)l * DM * DMLP, DMLP, 0, nullptr, t, tid_);
  }
  float* rope = (float*)(p.ws + OFF_ROPE);
  for (int e = bid_ * 256 + tid_; e < SEQ * 48; e += nblk_ * 256) {
    const int pos = e / 48, i = e % 48;
    float inv;
    if (i < 32) inv = exp2f(-13.287712379549449f * (float)(2 * i) / 64.0f);
    else inv = exp2f(-13.287712379549449f * (float)(2 * (i - 32)) / 32.0f);
    const float angf = (float)pos * inv;
    const double ang = (double)angf;
    const double n = rint(ang * 0.15915494309189535);
    const float r = (float)(ang - n * 6.283185307179586);
    const float c = cosf(r), s = sinf(r);
    if (i < 32) { rope[pos * 96 + i] = c; rope[pos * 96 + 32 + i] = s; }
    else { rope[pos * 96 + 64 + (i - 32)] = c; rope[pos * 96 + 80 + (i - 32)] = s; }
  }
  u16* XB = (u16*)(p.ws + OFF_XB); float* SSQ = (float*)(p.ws + OFF_SSQ);
  const int lane = tid_ & 63;
  const int gw = bid_ * 4 + (tid_ >> 6), nw = nblk_ * 4;
  for (int row = gw; row < T; row += nw) {
    const float* xr = p.in[0] + (size_t)row * DM;
    float ss = 0.f;
#pragma unroll
    for (int i = 0; i < 4; ++i) {
      const f32x4 v = *(const f32x4*)(xr + i * 256 + lane * 4);
      ss += v[0] * v[0] + v[1] * v[1] + v[2] * v[2] + v[3] * v[3];
      u32x2 w = {pk2(v[0], v[1]), pk2(v[2], v[3])};
      *(u32x2*)(XB + (size_t)row * DM + i * 256 + lane * 4) = w;
    }
#pragma unroll
    for (int o = 32; o >= 1; o >>= 1) ss += __shfl_xor(ss, o);
    if (lane < 8) SSQ[(size_t)row * 8 + lane] = (lane == 0) ? ss : 0.f;
  }
}

DI int dil_of(int gi) { return gi == 0 ? 1 : (gi == 1 ? 4 : 16); }

__device__ void phase_inproj(const Params& p, int tid_, int bid_, int nblk_, int chunk, int layer, unsigned char* smem) {
  const u16* XB = (const u16*)(p.ws + OFF_XB) + (size_t)chunk * TC * DM;
  const float* SSQ = (const float*)(p.ws + OFF_SSQ) + (size_t)chunk * TC * 8;
  const u16* WinT = (const u16*)(p.ws + OFF_WIN) + (size_t)layer * INC * DM;
  u16* QKV = (u16*)(p.ws + OFF_QKV);
  u16* GATE = (u16*)(p.ws + OFF_GATE);
  const float* rope = (const float*)(p.ws + OFF_ROPE);
  float* ct = (float*)smem;
  const int tid = tid_; const int lane = tid & 63, wave = tid >> 6;
  TILE_LOOP_BEGIN(TC / 128, INC / 128)
    const int m0 = tile_m * 128, n0 = tile_n * 128;
    f32x16 acc[2][2];
    gemm_tile<2>(XB + (size_t)m0 * DM, DM, WinT + (size_t)n0 * DM, DM, DM, acc, (u16*)smem, tid_);
    dump_acc(acc, ct, tid_);
    __syncthreads();
    if (n0 < QKVC) {
      const int t = tid & 127, grp = tid >> 7;
      const int g = (n0 >> 6) + grp;
      const int tok = m0 + t;
      const int bl = tok >> 12, pos = tok & 4095;
      const float rs = row_rscale(SSQ, tok);
      float v[64];
#pragma unroll
      for (int q = 0; q < 16; ++q) {
        const f32x4 x4 = *(const f32x4*)(ct + t * 132 + grp * 64 + q * 4);
        v[q * 4 + 0] = x4[0] * rs; v[q * 4 + 1] = x4[1] * rs; v[q * 4 + 2] = x4[2] * rs; v[q * 4 + 3] = x4[3] * rs;
      }
      int kind, dil = 1; const float* gain = nullptr;
      if (g < 8) { kind = 0; gain = p.in[3] + layer * 128; }
      else if (g < 10) { kind = 0; gain = p.in[3] + layer * 128 + 64; }
      else if (g < 12) { kind = 3; }
      else if (g < 18) { kind = 0; gain = p.in[5] + layer * 128; dil = dil_of((g - 12) >> 1); }
      else if (g < 24) { kind = 0; gain = p.in[5] + layer * 128 + 64; dil = dil_of((g - 18) >> 1); }
      else if (g < 30) { kind = 3; dil = dil_of((g - 24) >> 1); }
      else if (g < 34) { kind = 2; gain = p.in[6] + layer * 64; }
      else if (g < 38) { kind = 2; gain = p.in[6] + layer * 64 + 32; }
      else if (g < 42) { kind = 3; }
      else if (g < 46) { kind = 1; gain = p.in[9] + layer * 128; }
      else if (g < 50) { kind = 1; gain = p.in[9] + layer * 128 + 64; }
      else { kind = 3; }
      const int pdom = (dil == 1) ? pos : ((pos % dil) * (SEQ / dil) + pos / dil);
      const int blk = pdom >> 5, r = pdom & 31;
      u16* base = QKV + (size_t)g * TC * 64 + (size_t)bl * SEQ * 64;
      if (kind == 0 || kind == 1) {
        float ss = 0.f;
#pragma unroll
        for (int d = 0; d < 64; ++d) ss += v[d] * v[d];
        const float rn = rsqrtf(ss * (1.0f / 64.0f) + 1e-6f);
#pragma unroll
        for (int d = 0; d < 64; ++d) v[d] = v[d] * rn * gain[d];
        if (kind == 0) {
          const float* cs = rope + pos * 96;
#pragma unroll
          for (int i = 0; i < 32; ++i) {
            const float c = cs[i], s = cs[32 + i];
            const float a = v[i], b = v[i + 32];
            v[i] = a * c - b * s; v[i + 32] = b * c + a * s;
          }
        }
#pragma unroll
        for (int s = 0; s < 4; ++s)
#pragma unroll
          for (int h = 0; h < 2; ++h) {
            const int d0 = 16 * s + 8 * h;
            u32x4 w = {pk2(v[d0], v[d0 + 1]), pk2(v[d0 + 2], v[d0 + 3]), pk2(v[d0 + 4], v[d0 + 5]), pk2(v[d0 + 6], v[d0 + 7])};
            *(u32x4*)(base + ((size_t)(blk * 4 + s) * 64 + h * 32 + r) * 8) = w;
          }
      } else if (kind == 2) {
        const float* cs = rope + pos * 96 + 64;
#pragma unroll
        for (int c = 0; c < 2; ++c) {
          float ss = 0.f;
#pragma unroll
          for (int d = 0; d < 32; ++d) ss += v[c * 32 + d] * v[c * 32 + d];
          const float rn = rsqrtf(ss * (1.0f / 32.0f) + 1e-6f);
#pragma unroll
          for (int d = 0; d < 32; ++d) v[c * 32 + d] = v[c * 32 + d] * rn * gain[d];
#pragma unroll
          for (int i = 0; i < 16; ++i) {
            const float cc = cs[i], sn = cs[16 + i];
            const float a = v[c * 32 + i], b = v[c * 32 + i + 16];
            v[c * 32 + i] = a * cc - b * sn; v[c * 32 + i + 16] = b * cc + a * sn;
          }
          u16* sb = base + (size_t)c * SEQ * 32;
#pragma unroll
          for (int s = 0; s < 2; ++s)
#pragma unroll
            for (int h = 0; h < 2; ++h) {
              const int d0 = c * 32 + 16 * s + 8 * h;
              u32x4 w = {pk2(v[d0], v[d0 + 1]), pk2(v[d0 + 2], v[d0 + 3]), pk2(v[d0 + 4], v[d0 + 5]), pk2(v[d0 + 6], v[d0 + 7])};
              *(u32x4*)(sb + ((size_t)(blk * 2 + s) * 64 + h * 32 + r) * 8) = w;
            }
        }
      } else {
        const int key = r, s = key >> 4, hh = (key >> 2) & 1, j = ((key >> 3) & 1) * 4 + (key & 3);
#pragma unroll
        for (int dv = 0; dv < 64; ++dv) {
          const unsigned w = pk2(v[dv], 0.f);
          base[((size_t)((blk * 2 + (dv >> 5)) * 2 + s) * 64 + hh * 32 + (dv & 31)) * 8 + j] = (u16)(w & 0xffffu);
        }
      }
    } else {
      const int gc0 = n0 - QKVC;
#pragma unroll 4
      for (int it = 0; it < 16; ++it) {
        const int row = it * 8 + wave * 2 + (lane >> 5), c4 = (lane & 31) * 4;
        const int tok = m0 + row;
        const float rs = row_rscale(SSQ, tok);
        const f32x4 x4 = *(const f32x4*)(ct + row * 132 + c4);
        float o[4];
#pragma unroll
        for (int e = 0; e < 4; ++e) o[e] = 1.0f / (1.0f + __expf(-x4[e] * rs));
        u32x2 w = {pk2(o[0], o[1]), pk2(o[2], o[3])};
        *(u32x2*)(GATE + (size_t)tok * 4096 + gc0 + c4) = w;
      }
    }
    __syncthreads();
  TILE_LOOP_END
}

DI void attn_softmax_pv(f32x16& S, float& m, float& l, f32x16& O0, f32x16& O1, const bf16x8 (&vf)[2][2]) {
  float mx = S[0];
#pragma unroll
  for (int i = 1; i < 16; ++i) mx = fmaxf(mx, S[i]);
  mx = fmaxf(mx, __shfl_xor(mx, 32));
  const float mn = fmaxf(m, mx);
  const float alpha = fexp2(m - mn);
  m = mn;
  float sum = 0.f;
#pragma unroll
  for (int i = 0; i < 16; ++i) { S[i] = fexp2(S[i] - mn); sum += S[i]; }
  l = l * alpha + sum;
  const u32x4 p0 = {pk2(S[0], S[1]), pk2(S[2], S[3]), pk2(S[4], S[5]), pk2(S[6], S[7])};
  const u32x4 p1 = {pk2(S[8], S[9]), pk2(S[10], S[11]), pk2(S[12], S[13]), pk2(S[14], S[15])};
#pragma unroll
  for (int i = 0; i < 16; ++i) { O0[i] *= alpha; O1[i] *= alpha; }
  O0 = MFMA32(vf[0][0], as_bf8(p0), O0);
  O0 = MFMA32(vf[0][1], as_bf8(p1), O0);
  O1 = MFMA32(vf[1][0], as_bf8(p0), O1);
  O1 = MFMA32(vf[1][1], as_bf8(p1), O1);
}
DI void load_vf(bf16x8 (&vf)[2][2], const u16* V, int kb, int lane) {
#pragma unroll
  for (int rb = 0; rb < 2; ++rb)
#pragma unroll
    for (int s = 0; s < 2; ++s) vf[rb][s] = *(const bf16x8*)(V + ((size_t)((kb * 2 + rb) * 2 + s) * 64 + lane) * 8);
}
DI void load_kf4(bf16x8 (&kf)[4], const u16* K, int kb, int lane) {
#pragma unroll
  for (int s = 0; s < 4; ++s) kf[s] = *(const bf16x8*)(K + ((size_t)(kb * 4 + s) * 64 + lane) * 8);
}
DI void load_kf2(bf16x8 (&kf)[2], const u16* K, int kb, int lane) {
#pragma unroll
  for (int s = 0; s < 2; ++s) kf[s] = *(const bf16x8*)(K + ((size_t)(kb * 2 + s) * 64 + lane) * 8);
}
DI void zero16(f32x16& a) {
#pragma unroll
  for (int i = 0; i < 16; ++i) a[i] = 0.f;
}
DI void store_o(u16* yrow, const f32x16& O0, const f32x16& O1, float sc, int h) {
#pragma unroll
  for (int g4 = 0; g4 < 4; ++g4) {
    u32x2 w0 = {pk2(O0[4 * g4] * sc, O0[4 * g4 + 1] * sc), pk2(O0[4 * g4 + 2] * sc, O0[4 * g4 + 3] * sc)};
    *(u32x2*)(yrow + 8 * g4 + 4 * h) = w0;
    u32x2 w1 = {pk2(O1[4 * g4] * sc, O1[4 * g4 + 1] * sc), pk2(O1[4 * g4 + 2] * sc, O1[4 * g4 + 3] * sc)};
    *(u32x2*)(yrow + 32 + 8 * g4 + 4 * h) = w1;
  }
}

__device__ void phase_attn(const Params& p, int tid_, int bid_, int nblk_, int layer) {
  const u16* QKV = (const u16*)(p.ws + OFF_QKV);
  u16* Y = (u16*)(p.ws + OFF_Y);
  u16* BO = (u16*)(p.ws + OFF_BO);
  float* LSE = (float*)(p.ws + OFF_LSE);
  const int lane = tid_ & 63, wave = tid_ >> 6;
  const int fr = lane & 31, fh = lane >> 5;
  const int nloc = nblk_ >> 3;
  if ((int)(bid_ >> 3) >= nloc) return;
  const int vw = ((bid_ & 7) * nloc + (bid_ >> 3)) * 4 + wave, NW = nloc * 32;
  const size_t GS = (size_t)TC * 64;
  const size_t BS = (size_t)SEQ * 64;

  {
    const float* lp = p.in[7] + layer * 128;
    float d01 = 0.f, d23 = 0.f;
    for (int i = 0; i < 32; ++i) { d01 += lp[i] * lp[32 + i]; d23 += lp[64 + i] * lp[96 + i]; }
    const float lambda_init = (layer == 0) ? 0.2f : 0.35550907f;
    const float lam = __expf(d01) - __expf(d23) + lambda_init;
    const float* subg = p.in[8] + layer * 64;
    const float sc = 0.17677669529663687f * LOG2E;
    for (int it = vw; it < BC * 4 * 128; it += NW) {
      const int bl = it >> 9, head = (it >> 7) & 3, qblk = it & 127;
      const u16* Q0 = QKV + (30 + head) * GS + bl * BS; const u16* Q1 = Q0 + SEQ * 32;
      const u16* K0 = QKV + (34 + head) * GS + bl * BS; const u16* K1 = K0 + SEQ * 32;
      const u16* V = QKV + (38 + head) * GS + bl * BS;
      bf16x8 q0[2], q1[2];
      load_kf2(q0, Q0, qblk, lane); load_kf2(q1, Q1, qblk, lane);
      float m0 = -1e30f, l0 = 0.f, m1 = -1e30f, l1 = 0.f;
      f32x16 O00, O01, O10, O11; zero16(O00); zero16(O01); zero16(O10); zero16(O11);
      bf16x8 k0[2], k1[2], vf[2][2];
      load_kf2(k0, K0, 0, lane); load_kf2(k1, K1, 0, lane); load_vf(vf, V, 0, lane);
      for (int kb = 0; kb < 128; ++kb) {
        bf16x8 nk0[2], nk1[2], nvf[2][2];
        const int kn = (kb + 1 < 128) ? kb + 1 : kb;
        load_kf2(nk0, K0, kn, lane); load_kf2(nk1, K1, kn, lane); load_vf(nvf, V, kn, lane);
        f32x16 S0, S1; zero16(S0); zero16(S1);
        S0 = MFMA32(k0[0], q0[0], S0); S0 = MFMA32(k0[1], q0[1], S0);
        S1 = MFMA32(k1[0], q1[0], S1); S1 = MFMA32(k1[1], q1[1], S1);
#pragma unroll
        for (int i = 0; i < 16; ++i) { S0[i] *= sc; S1[i] *= sc; }
        attn_softmax_pv(S0, m0, l0, O00, O01, vf);
        attn_softmax_pv(S1, m1, l1, O10, O11, vf);
#pragma unroll
        for (int s = 0; s < 2; ++s) { k0[s] = nk0[s]; k1[s] = nk1[s]; vf[0][s] = nvf[0][s]; vf[1][s] = nvf[1][s]; }
      }
      const float i0 = 1.0f / (l0 + __shfl_xor(l0, 32));
      const float i1 = lam / (l1 + __shfl_xor(l1, 32));
      float ss = 0.f;
#pragma unroll
      for (int i = 0; i < 16; ++i) {
        O00[i] = O00[i] * i0 - O10[i] * i1; O01[i] = O01[i] * i0 - O11[i] * i1;
        ss += O00[i] * O00[i] + O01[i] * O01[i];
      }
      ss += __shfl_xor(ss, 32);
      const float rn = rsqrtf(ss * (1.0f / 64.0f) + 1e-6f) * (1.0f - lambda_init);
#pragma unroll
      for (int g4 = 0; g4 < 4; ++g4) {
        const f32x4 ga = *(const f32x4*)(subg + 8 * g4 + 4 * fh);
        const f32x4 gb = *(const f32x4*)(subg + 32 + 8 * g4 + 4 * fh);
#pragma unroll
        for (int e = 0; e < 4; ++e) { O00[4 * g4 + e] *= ga[e]; O01[4 * g4 + e] *= gb[e]; }
      }
      const size_t tok = (size_t)bl * SEQ + qblk * 32 + fr;
      store_o(Y + tok * YC + 640 + head * 64, O00, O01, rn, fh);
    }
  }
  {
    const float sc = 0.125f * LOG2E;
    for (int it = vw; it < BC * 8 * 128; it += NW) {
      const int bl = it >> 10, hq = (it >> 7) & 7, qblk = it & 127;
      const int kvh = hq >> 2;
      const u16* Q = QKV + (size_t)hq * GS + bl * BS;
      const u16* K = QKV + (size_t)(8 + kvh) * GS + bl * BS;
      const u16* V = QKV + (size_t)(10 + kvh) * GS + bl * BS;
      bf16x8 qf[4]; load_kf4(qf, Q, qblk, lane);
      float m = p.in[4][layer * 8 + hq] * LOG2E, l = (fh == 0) ? 1.0f : 0.0f;
      f32x16 O0, O1; zero16(O0); zero16(O1);
      const int kb_lo = (qblk - 4 < 0) ? 0 : qblk - 4, kb_hi = (qblk + 4 > 127) ? 127 : qblk + 4;
      const int qpos = qblk * 32 + fr;
      for (int kb = kb_lo; kb <= kb_hi; ++kb) {
        bf16x8 kf[4], vf[2][2];
        load_kf4(kf, K, kb, lane); load_vf(vf, V, kb, lane);
        f32x16 S; zero16(S);
#pragma unroll
        for (int s = 0; s < 4; ++s) S = MFMA32(kf[s], qf[s], S);
#pragma unroll
        for (int i = 0; i < 16; ++i) {
          const int dlt = kb * 32 + crow(i, fh) - qpos;
          S[i] = (dlt <= 128 && dlt >= -128) ? S[i] * sc : -1e30f;
        }
        attn_softmax_pv(S, m, l, O0, O1, vf);
      }
      const float inv = 1.0f / (l + __shfl_xor(l, 32));
      const size_t tok = (size_t)bl * SEQ + qpos;
      store_o(Y + tok * YC + hq * 64, O0, O1, inv, fh);
    }
  }
  {
    const float sc = 0.125f;
    for (int it = vw; it < BC * 4 * 128; it += NW) {
      const int bl = it >> 9, head = (it >> 7) & 3, qblk = it & 127;
      const u16* Q = QKV + (size_t)(42 + head) * GS + bl * BS;
      const u16* K = QKV + (size_t)(46 + head) * GS + bl * BS;
      const u16* V = QKV + (size_t)(50 + head) * GS + bl * BS;
      const float* rpb = p.in[10] + (size_t)(layer * 4 + head) * 15 * 31;
      bf16x8 qf[4]; load_kf4(qf, Q, qblk, lane);
      float m = -1e30f, l = 0.f;
      f32x16 O0, O1; zero16(O0); zero16(O1);
      const int qrow = qblk >> 1, qc = (qblk & 1) * 32 + fr;
      int r0 = qrow - 4; r0 = r0 < 0 ? 0 : (r0 > 56 ? 56 : r0);
      int c0 = qc - 8; c0 = c0 < 0 ? 0 : (c0 > 48 ? 48 : c0);
      for (int kk = 0; kk < 16; ++kk) {
        const int krow_ = r0 + (kk >> 1), hb = kk & 1, kb = krow_ * 2 + hb;
        bf16x8 kf[4], vf[2][2];
        load_kf4(kf, K, kb, lane); load_vf(vf, V, kb, lane);
        f32x16 S; zero16(S);
#pragma unroll
        for (int s = 0; s < 4; ++s) S = MFMA32(kf[s], qf[s], S);
        const float* brow = rpb + (krow_ - qrow + 7) * 31;
#pragma unroll
        for (int i = 0; i < 16; ++i) {
          const int kc = hb * 32 + crow(i, fh);
          int dc = kc - qc; dc = dc < -15 ? -15 : (dc > 15 ? 15 : dc);
          const float bias = brow[dc + 15];
          S[i] = (kc >= c0 && kc < c0 + 16) ? (S[i] * sc + bias) * LOG2E : -1e30f;
        }
        attn_softmax_pv(S, m, l, O0, O1, vf);
      }
      const float inv = 1.0f / (l + __shfl_xor(l, 32));
      const size_t tok = (size_t)bl * SEQ + qblk * 32 + fr;
      store_o(Y + tok * YC + 896 + head * 64, O0, O1, inv, fh);
    }
  }
  {
    const float sc = 0.125f * LOG2E;
    for (int it = vw; it < BC * 6 * 128; it += NW) {
      const int bl = it / 768, rem = it % 768, head = rem >> 7, qblk = rem & 127;
      const int dil = dil_of(head >> 1), L = SEQ / dil, LB = L >> 5;
      const u16* Q = QKV + (size_t)(12 + head) * GS + bl * BS;
      const u16* K = QKV + (size_t)(18 + head) * GS + bl * BS;
      const u16* V = QKV + (size_t)(24 + head) * GS + bl * BS;
      bf16x8 qf[4]; load_kf4(qf, Q, qblk, lane);
      float m = -1e30f, l = 0.f;
      f32x16 O0, O1; zero16(O0); zero16(O1);
      const int rsub = qblk / LB;
      const int lo = rsub * LB, hi = lo + LB - 1;
      const int kb_lo = (qblk - 2 < lo) ? lo : qblk - 2, kb_hi = (qblk + 2 > hi) ? hi : qblk + 2;
      const int qd = qblk * 32 + fr;
      for (int kb = kb_lo; kb <= kb_hi; ++kb) {
        bf16x8 kf[4], vf[2][2];
        load_kf4(kf, K, kb, lane); load_vf(vf, V, kb, lane);
        f32x16 S; zero16(S);
#pragma unroll
        for (int s = 0; s < 4; ++s) S = MFMA32(kf[s], qf[s], S);
#pragma unroll
        for (int i = 0; i < 16; ++i) {
          const int dlt = kb * 32 + crow(i, fh) - qd;
          S[i] = (dlt <= 64 && dlt >= -64) ? S[i] * sc : -1e30f;
        }
        attn_softmax_pv(S, m, l, O0, O1, vf);
      }
      const float lt = l + __shfl_xor(l, 32);
      const float inv = 1.0f / lt;
      const int msub = qd - rsub * L;
      const int pos = msub * dil + rsub;
      const size_t tok = (size_t)bl * SEQ + pos;
      store_o(BO + tok * 384 + head * 64, O0, O1, inv, fh);
      if (fh == 0) LSE[tok * 8 + head] = __log2f(lt) + m;
    }
  }
}

__device__ void phase_bcombine(const Params& p, int tid_, int bid_, int nblk_) {
  const u16* BO = (const u16*)(p.ws + OFF_BO);
  const float* LSE = (const float*)(p.ws + OFF_LSE);
  u16* Y = (u16*)(p.ws + OFF_Y);
  for (int e = bid_ * 256 + tid_; e < TC * 16; e += nblk_ * 256) {
    const int tok = e >> 4, j = (e >> 3) & 1, c8 = (e & 7) * 8;
    const float a0 = LSE[(size_t)tok * 8 + j], a1 = LSE[(size_t)tok * 8 + 2 + j], a2 = LSE[(size_t)tok * 8 + 4 + j];
    const float mx = fmaxf(a0, fmaxf(a1, a2));
    float w0 = fexp2(a0 - mx), w1 = fexp2(a1 - mx), w2 = fexp2(a2 - mx);
    const float inv = 1.0f / (w0 + w1 + w2);
    w0 *= inv; w1 *= inv; w2 *= inv;
    const u32x4 x0 = *(const u32x4*)(BO + (size_t)tok * 384 + (0 + j) * 64 + c8);
    const u32x4 x1 = *(const u32x4*)(BO + (size_t)tok * 384 + (2 + j) * 64 + c8);
    const u32x4 x2 = *(const u32x4*)(BO + (size_t)tok * 384 + (4 + j) * 64 + c8);
    u32x4 o;
#pragma unroll
    for (int q = 0; q < 4; ++q) {
      const float lo = w0 * bf_lo(x0[q]) + w1 * bf_lo(x1[q]) + w2 * bf_lo(x2[q]);
      const float hi = w0 * bf_hi(x0[q]) + w1 * bf_hi(x1[q]) + w2 * bf_hi(x2[q]);
      o[q] = pk2(lo, hi);
    }
    *(u32x4*)(Y + (size_t)tok * YC + 512 + j * 64 + c8) = o;
  }
}

__device__ void phase_merge(const Params& p, int tid_, int bid_, int nblk_, int layer, unsigned char* smem) {
  const u16* Y = (const u16*)(p.ws + OFF_Y);
  const u16* GATE = (const u16*)(p.ws + OFF_GATE);
  const u16* WbrT = (const u16*)(p.ws + OFF_WBR) + (size_t)layer * DM * YC;
  u16* MRG = (u16*)(p.ws + OFF_MRG);
  float* ct = (float*)smem;
  const int lane = tid_ & 63, wave = tid_ >> 6;
  TILE_LOOP_BEGIN(TC / 128, DM / 64)
    const int m0 = tile_m * 128, n0 = tile_n * 64;
    f32x4 mg[8];
#pragma unroll
    for (int it = 0; it < 8; ++it) mg[it] = f32x4{0.f, 0.f, 0.f, 0.f};
#pragma unroll 1
    for (int seg = 0; seg < 4; ++seg) {
      const int koff = (seg == 0) ? 0 : (seg == 1 ? 512 : (seg == 2 ? 640 : 896));
      const int kl = (seg == 0) ? 512 : (seg == 1 ? 128 : 256);
      f32x16 acc[2][1];
      gemm_tile<1>(Y + (size_t)m0 * YC + koff, YC, WbrT + (size_t)n0 * YC + koff, YC, kl, acc, (u16*)smem, tid_);
      dump_acc1(acc, ct, tid_);
      __syncthreads();
#pragma unroll
      for (int it = 0; it < 8; ++it) {
        const int row = it * 16 + wave * 4 + (lane >> 4), c4 = (lane & 15) * 4;
        const f32x4 x4 = *(const f32x4*)(ct + row * 68 + c4);
        const u32x2 gq = *(const u32x2*)(GATE + (size_t)(m0 + row) * 4096 + seg * 1024 + n0 + c4);
        mg[it][0] += bf_lo(gq[0]) * x4[0]; mg[it][1] += bf_hi(gq[0]) * x4[1];
        mg[it][2] += bf_lo(gq[1]) * x4[2]; mg[it][3] += bf_hi(gq[1]) * x4[3];
      }
      __syncthreads();
    }
#pragma unroll
    for (int it = 0; it < 8; ++it) {
      const int row = it * 16 + wave * 4 + (lane >> 4), c4 = (lane & 15) * 4;
      u32x2 w = {pk2(mg[it][0], mg[it][1]), pk2(mg[it][2], mg[it][3])};
      *(u32x2*)(MRG + (size_t)(m0 + row) * DM + n0 + c4) = w;
    }
  TILE_LOOP_END
}

__device__ void phase_resid(const Params& p, int tid_, int bid_, int nblk_, int chunk, const u16* A, int K, const u16* Wt, const float* xold, unsigned char* smem) {
  float* xout = p.out + (size_t)chunk * TC * DM;
  u16* XB = (u16*)(p.ws + OFF_XB) + (size_t)chunk * TC * DM;
  float* SSQ = (float*)(p.ws + OFF_SSQ) + (size_t)chunk * TC * 8;
  float* ct = (float*)smem;
  const int lane = tid_ & 63, wave = tid_ >> 6;
  TILE_LOOP_BEGIN(TC / 128, DM / 128)
    const int m0 = tile_m * 128, n0 = tile_n * 128;
    f32x16 acc[2][2];
    gemm_tile<2>(A + (size_t)m0 * K, K, Wt + (size_t)n0 * K, K, K, acc, (u16*)smem, tid_);
    dump_acc(acc, ct, tid_);
    __syncthreads();
#pragma unroll 4
    for (int it = 0; it < 16; ++it) {
      const int row = it * 8 + wave * 2 + (lane >> 5), c4 = (lane & 31) * 4;
      const size_t o = (size_t)(m0 + row) * DM + n0 + c4;
      const f32x4 x4 = *(const f32x4*)(ct + row * 132 + c4);
      f32x4 xo = *(const f32x4*)(xold + o);
      xo[0] += x4[0]; xo[1] += x4[1]; xo[2] += x4[2]; xo[3] += x4[3];
      *(f32x4*)(xout + o) = xo;
      u32x2 w = {pk2(xo[0], xo[1]), pk2(xo[2], xo[3])};
      *(u32x2*)(XB + o) = w;
      float ss = xo[0] * xo[0] + xo[1] * xo[1] + xo[2] * xo[2] + xo[3] * xo[3];
#pragma unroll
      for (int d = 16; d >= 1; d >>= 1) ss += __shfl_xor(ss, d);
      if ((lane & 31) == 0) SSQ[(size_t)(m0 + row) * 8 + tile_n] = ss;
    }
    __syncthreads();
  TILE_LOOP_END
}

__device__ void phase_up(const Params& p, int tid_, int bid_, int nblk_, int chunk, int layer, unsigned char* smem) {
  const u16* XB = (const u16*)(p.ws + OFF_XB) + (size_t)chunk * TC * DM;
  const float* SSQ = (const float*)(p.ws + OFF_SSQ) + (size_t)chunk * TC * 8;
  const u16* WupT = (const u16*)(p.ws + OFF_WUP) + (size_t)layer * DMLP * DM;
  u16* U = (u16*)(p.ws + OFF_GATE);
  float* ct = (float*)smem;
  const int lane = tid_ & 63, wave = tid_ >> 6;
  TILE_LOOP_BEGIN(TC / 128, DMLP / 128)
    const int m0 = tile_m * 128, n0 = tile_n * 128;
    f32x16 acc[2][2];
    gemm_tile<2>(XB + (size_t)m0 * DM, DM, WupT + (size_t)n0 * DM, DM, DM, acc, (u16*)smem, tid_);
    dump_acc(acc, ct, tid_);
    __syncthreads();
#pragma unroll 4
    for (int it = 0; it < 16; ++it) {
      const int row = it * 8 + wave * 2 + (lane >> 5), c4 = (lane & 31) * 4;
      const float rs = row_rscale(SSQ, m0 + row);
      const f32x4 x4 = *(const f32x4*)(ct + row * 132 + c4);
      float o[4];
#pragma unroll
      for (int e = 0; e < 4; ++e) { const float z = fmaxf(x4[e] * rs, 0.f); o[e] = z * z; }
      u32x2 w = {pk2(o[0], o[1]), pk2(o[2], o[3])};
      *(u32x2*)(U + (size_t)(m0 + row) * DMLP + n0 + c4) = w;
    }
    __syncthreads();
  TILE_LOOP_END
}

#define XB_TMO      128
#define XB_XCNT(j)  (256  + 64 * (j))
#define XB_XSUB(j)  (1280 + 64 * (j))
#define XB_XGEN(j)  (2304 + 64 * (j))
#define XB_TOP      3328
#define XB_TOPGEN   3392
#define XCD_BAR_WORDS 3456
#define XB_SPIN_CAP (1u << 22)
#define LAS __attribute__((address_space(3)))
DI unsigned xb_ld(unsigned* p)              { return __hip_atomic_load(p, __ATOMIC_RELAXED, __HIP_MEMORY_SCOPE_AGENT); }
DI unsigned xb_add(unsigned* p, unsigned v) { return __hip_atomic_fetch_add(p, v, __ATOMIC_RELAXED, __HIP_MEMORY_SCOPE_AGENT); }
DI unsigned xb_xcc_id() { return (unsigned)__builtin_amdgcn_s_getreg((3 << 11) | 20) & 0xFu; }
#define XB_SPIN(cond, bar) do { unsigned _sp = 0; while (cond) { __builtin_amdgcn_s_sleep(1); \
    if ((++_sp & 255u) == 0u) { if (xb_ld(&(bar)[XB_TMO])) break; if (_sp > XB_SPIN_CAP) { atomicAdd(&(bar)[XB_TMO], 1u); break; } } } } while (0)
struct XcdBarrier { unsigned* bar; unsigned x; volatile LAS unsigned* st; };
DI XcdBarrier xcd_barrier_post(unsigned* bar, volatile LAS unsigned* st) {
  XcdBarrier b; b.bar = bar; b.x = xb_xcc_id(); b.st = st;
  if (threadIdx.x == 0) (void)xb_add(&bar[XB_XCNT(b.x)], 1u);
  return b;
}
DI void xcd_barrier_complete(unsigned* bar, unsigned x, unsigned& nloc, unsigned& nx) {
  const unsigned G = gridDim.x * gridDim.y * gridDim.z;
  unsigned sum, cnt, mine, sp = 0u;
  for (;;) {
    sum = 0u; cnt = 0u; mine = 0u;
#pragma unroll
    for (unsigned j = 0; j < 16; ++j) { const unsigned c = xb_ld(&bar[XB_XCNT(j)]); sum += c; cnt += (c > 0u) ? 1u : 0u; mine = (j == x) ? c : mine; }
    if (sum == G) break;
    __builtin_amdgcn_s_sleep(1);
    if ((++sp & 255u) == 0u) { if (xb_ld(&bar[XB_TMO])) break; if (sp > XB_SPIN_CAP) { atomicAdd(&bar[XB_TMO], 1u); break; } }
  }
  nloc = mine > 0u ? mine : 1u; nx = cnt > 0u ? cnt : 1u;
}
DI void xcd_barrier(const XcdBarrier& b) {
  asm volatile("s_waitcnt vmcnt(0)" ::: "memory");
  __syncthreads();
  if (threadIdx.x == 0) {
    unsigned* bar = b.bar;
    __builtin_amdgcn_s_waitcnt(0);
    unsigned nloc = b.st[0], nx = b.st[1];
    if (nloc == 0u) { xcd_barrier_complete(bar, b.x, nloc, nx); b.st[0] = nloc; b.st[1] = nx; }
    const unsigned old = xb_add(&bar[XB_XSUB(b.x)], 1u);
    const unsigned gen = old / nloc;
    if (old + 1u == (gen + 1u) * nloc) {
      __builtin_amdgcn_fence(__ATOMIC_RELEASE, "agent");
      asm volatile("s_waitcnt vmcnt(0)" ::: "memory");
      const unsigned og = xb_add(&bar[XB_TOP], 1u);
      const unsigned tg = og / nx;
      if (og + 1u == (tg + 1u) * nx) xb_add(&bar[XB_TOPGEN], 1u);
      else XB_SPIN(xb_ld(&bar[XB_TOPGEN]) == tg, bar);
      __builtin_amdgcn_fence(__ATOMIC_ACQUIRE, "agent");
      xb_add(&bar[XB_XGEN(b.x)], 1u);
      asm volatile("s_waitcnt vmcnt(0)" ::: "memory");
    } else {
      XB_SPIN(xb_ld(&bar[XB_XGEN(b.x)]) == gen, bar);
      __builtin_amdgcn_fence(__ATOMIC_ACQUIRE, "agent");
      asm volatile("s_waitcnt vmcnt(0)" ::: "memory");
    }
  }
  __syncthreads();
}

__global__ void __launch_bounds__(256, 2) mk_forward(Params p) {
  __shared__ __attribute__((aligned(16))) unsigned char smem[LDS_BYTES];
  __shared__ uint4 xb_words;
  cg::grid_group grid = cg::this_grid();
  if (threadIdx.x == 0) xb_words = make_uint4(0u, 0u, 0u, 0u);
  __syncthreads();
  XcdBarrier xb;
  if (FUSED) xb = xcd_barrier_post((unsigned*)(p.ws + OFF_BAR), (volatile LAS unsigned*)&xb_words);
  for (int ph = p.ph_lo; ph < p.ph_hi; ++ph) {
   for (int rep = 0; rep < ((ph > 0 && ((DUPMASK >> ((ph - 1) % 7)) & 1)) ? 2 : 1); ++rep) {
    int tid_ = threadIdx.x, bid_ = blockIdx.x, nblk_ = gridDim.x;
    asm volatile("" : "+v"(tid_));
    asm volatile("" : "+s"(bid_));
    asm volatile("" : "+s"(nblk_));
    Params pp = p;
    asm volatile("" : "+s"(pp.ws));
    asm volatile("" : "+s"(pp.out));
    if (ph == 0) {
      if (PHMASK & 128) phase_prep(pp, tid_, bid_, nblk_, smem);
    } else {
      const int q = ph - 1, chunk = q / 14, layer = (q % 14) / 7, k = q % 7;
      if (k == 0) { if (PHMASK & 1) phase_inproj(pp, tid_, bid_, nblk_, chunk, layer, smem); }
      else if (k == 1) { if (PHMASK & 2) phase_attn(pp, tid_, bid_, nblk_, layer); }
      else if (k == 2) { if (PHMASK & 4) phase_bcombine(pp, tid_, bid_, nblk_); }
      else if (k == 3) { if (PHMASK & 8) phase_merge(pp, tid_, bid_, nblk_, layer, smem); }
      else if (k == 4) { if (PHMASK & 16) phase_resid(pp, tid_, bid_, nblk_, chunk, (const u16*)(pp.ws + OFF_MRG), DM, (const u16*)(pp.ws + OFF_WOUT) + (size_t)layer * DM * DM,
                                   (layer == 0) ? (pp.in[0] + (size_t)chunk * TC * DM) : (pp.out + (size_t)chunk * TC * DM), smem); }
      else if (k == 5) { if (PHMASK & 32) phase_up(pp, tid_, bid_, nblk_, chunk, layer, smem); }
      else { if (PHMASK & 64) phase_resid(pp, tid_, bid_, nblk_, chunk, (const u16*)(pp.ws + OFF_GATE), DMLP, (const u16*)(pp.ws + OFF_WDN) + (size_t)layer * DM * DMLP,
                       pp.out + (size_t)chunk * TC * DM, smem); }
    }
   }
    if (ph + 1 < p.ph_hi) {
      if (ph == 0) grid.sync();
      else xcd_barrier(xb);
    }
  }
}

extern "C" void kernel_launch(void* const* d_in, const int* in_sizes, int n_in, void* d_out, int out_size, void* d_ws, size_t ws_size,
                              hipStream_t stream) {
  static int grid_blocks = 0;
  if (grid_blocks == 0) {
    if (n_in != 19 || out_size != T * DM || ws_size < WS_END) {
      fprintf(stderr, "kernel_launch: unexpected problem (n_in %d out %d ws %zu need %zu)\n", n_in, out_size, ws_size, (size_t)WS_END);
      grid_blocks = -1;
      return;
    }
    int dev = 0, cus = 0, per_cu = 0;
    hipGetDevice(&dev);
    hipDeviceGetAttribute(&cus, hipDeviceAttributeMultiprocessorCount, dev);
    hipOccupancyMaxActiveBlocksPerMultiprocessor(&per_cu, mk_forward, 256, 0);
    if (per_cu < 1) per_cu = 1;
    if (per_cu > 2) per_cu = 2;
    grid_blocks = cus * per_cu;
  }
  if (grid_blocks < 0) return;
  Params p{};
  for (int i = 0; i < 19; ++i) p.in[i] = (const float*)d_in[i];
  p.out = (float*)d_out;
  p.ws = (unsigned char*)d_ws;
#if FUSED
  hipMemsetAsync((unsigned char*)d_ws + OFF_BAR, 0, XCD_BAR_WORDS * 4, stream);
  p.ph_lo = 0; p.ph_hi = NPHASE;
  void* args[] = {&p};
  hipError_t e = hipLaunchCooperativeKernel((const void*)mk_forward, dim3(grid_blocks), dim3(256), args, 0, stream);
  if (e != hipSuccess) fprintf(stderr, "cooperative launch failed: %s (grid %d)\n", hipGetErrorString(e), grid_blocks);
#else
  for (int ph = 0; ph < NPHASE; ++ph) {
    p.ph_lo = ph; p.ph_hi = ph + 1;
    hipLaunchKernelGGL(mk_forward, dim3(grid_blocks), dim3(256), 0, stream, p);
  }
#endif
}
```

```cpp
#include <hip/hip_runtime.h>
#include <hip/hip_cooperative_groups.h>
#include <cstdio>
namespace cg = cooperative_groups;

#ifndef PHMASK
#define PHMASK 255
#endif
#ifndef DUPMASK
#define DUPMASK 0
#endif
#ifndef FUSED
#define FUSED 1
#endif

typedef unsigned short u16;
typedef short bf16x8 __attribute__((ext_vector_type(8)));
typedef float f32x16 __attribute__((ext_vector_type(16)));
typedef float f32x4 __attribute__((ext_vector_type(4)));
typedef __bf16 bf2_t __attribute__((ext_vector_type(2)));
typedef float f2_t __attribute__((ext_vector_type(2)));
typedef unsigned u32x4 __attribute__((ext_vector_type(4)));
typedef unsigned u32x2 __attribute__((ext_vector_type(2)));

#define DI __device__ __forceinline__
#define MFMA32(a, b, c) __builtin_amdgcn_mfma_f32_32x32x16_bf16((a), (b), (c), 0, 0, 0)

constexpr int DM = 1024, SEQ = 4096, NBATCH = 8, T = NBATCH * SEQ;
constexpr int NCH = 2, BC = NBATCH / NCH, TC = BC * SEQ;
constexpr int INC = 7552, QKVC = 3456, YC = 1152, DMLP = 4096;
constexpr int NGRP = QKVC / 64;
constexpr float LOG2E = 1.4426950408889634f;

constexpr size_t al256(size_t x) { return (x + 255) & ~(size_t)255; }
constexpr size_t OFF_WIN  = 0;
constexpr size_t OFF_WBR  = OFF_WIN  + al256((size_t)2 * INC * DM * 2);
constexpr size_t OFF_WOUT = OFF_WBR  + al256((size_t)2 * DM * YC * 2);
constexpr size_t OFF_WUP  = OFF_WOUT + al256((size_t)2 * DM * DM * 2);
constexpr size_t OFF_WDN  = OFF_WUP  + al256((size_t)2 * DMLP * DM * 2);
constexpr size_t OFF_ROPE = OFF_WDN  + al256((size_t)2 * DM * DMLP * 2);
constexpr size_t OFF_XB   = OFF_ROPE + al256((size_t)SEQ * 96 * 4);
constexpr size_t OFF_SSQ  = OFF_XB   + al256((size_t)T * DM * 2);
constexpr size_t OFF_QKV  = OFF_SSQ  + al256((size_t)T * 8 * 4);
constexpr size_t OFF_GATE = OFF_QKV  + al256((size_t)NGRP * TC * 64 * 2);
constexpr size_t OFF_Y    = OFF_GATE + al256((size_t)TC * 4096 * 2);
constexpr size_t OFF_BO   = OFF_Y    + al256((size_t)TC * YC * 2);
constexpr size_t OFF_LSE  = OFF_BO   + al256((size_t)TC * 384 * 2);
constexpr size_t OFF_MRG  = OFF_LSE  + al256((size_t)TC * 8 * 4);
constexpr size_t OFF_BAR  = OFF_MRG  + al256((size_t)TC * DM * 2);
constexpr size_t WS_END   = OFF_BAR  + 16384;
static_assert(WS_END <= (size_t)512 * 1024 * 1024, "workspace too large");

constexpr int LDS_BYTES = 73728;
constexpr int NPHASE = 1 + NCH * 2 * 7;

struct Params {
  const float* in[19];
  float* out;
  unsigned char* ws;
  int ph_lo, ph_hi;
};

DI unsigned pk2(float a, float b) { f2_t v = {a, b}; bf2_t r = __builtin_convertvector(v, bf2_t); return __builtin_bit_cast(unsigned, r); }
DI float bf_lo(unsigned u) { return __uint_as_float(u << 16); }
DI float bf_hi(unsigned u) { return __uint_as_float(u & 0xffff0000u); }
DI float fexp2(float x) { return __builtin_amdgcn_exp2f(x); }
DI int crow(int i, int h) { return (i & 3) + 8 * (i >> 2) + 4 * h; }
DI bf16x8 as_bf8(u32x4 v) { return __builtin_bit_cast(bf16x8, v); }

template <int NB>
DI void gemm_tile(const u16* __restrict__ A, int lda, const u16* __restrict__ B, int ldb, int K, f32x16 (&acc)[2][NB], u16* lds, int tid_) {
  const int tid = tid_; const int lane = tid & 63, wave = tid >> 6;
  const int wm = wave >> 1, wn = wave & 1;
  u16* sA = lds;
  u16* sB = lds + 2 * 128 * 72;
  const int lr = tid >> 3, lc = (tid & 7) * 8;
  const u16* ga = A + (size_t)lr * lda + lc;
  const u16* gb = B + (size_t)lr * ldb + lc;
  bf16x8 ra[4], rb[2 * NB];
#pragma unroll
  for (int i = 0; i < 4; ++i) ra[i] = *(const bf16x8*)(ga + (size_t)(32 * i) * lda);
#pragma unroll
  for (int i = 0; i < 2 * NB; ++i) rb[i] = *(const bf16x8*)(gb + (size_t)(32 * i) * ldb);
#pragma unroll
  for (int i = 0; i < 4; ++i) *(bf16x8*)(sA + (lr + 32 * i) * 72 + lc) = ra[i];
#pragma unroll
  for (int i = 0; i < 2 * NB; ++i) *(bf16x8*)(sB + (lr + 32 * i) * 72 + lc) = rb[i];
  const int nk = K >> 6;
  if (nk > 1) {
#pragma unroll
    for (int i = 0; i < 4; ++i) ra[i] = *(const bf16x8*)(ga + (size_t)(32 * i) * lda + 64);
#pragma unroll
    for (int i = 0; i < 2 * NB; ++i) rb[i] = *(const bf16x8*)(gb + (size_t)(32 * i) * ldb + 64);
  }
  __syncthreads();
  const int fr = lane & 31, fh = lane >> 5;
#pragma unroll
  for (int mb = 0; mb < 2; ++mb)
#pragma unroll
    for (int nb = 0; nb < NB; ++nb)
#pragma unroll
      for (int i = 0; i < 16; ++i) acc[mb][nb][i] = 0.f;
  for (int kt = 0; kt < nk; ++kt) {
    if (kt + 1 < nk) {
      u16* wa = sA + ((kt + 1) & 1) * (128 * 72);
      u16* wb = sB + ((kt + 1) & 1) * (128 * 72);
#pragma unroll
      for (int i = 0; i < 4; ++i) *(bf16x8*)(wa + (lr + 32 * i) * 72 + lc) = ra[i];
#pragma unroll
      for (int i = 0; i < 2 * NB; ++i) *(bf16x8*)(wb + (lr + 32 * i) * 72 + lc) = rb[i];
      if (kt + 2 < nk) {
        const int ko = (kt + 2) * 64;
#pragma unroll
        for (int i = 0; i < 4; ++i) ra[i] = *(const bf16x8*)(ga + (size_t)(32 * i) * lda + ko);
#pragma unroll
        for (int i = 0; i < 2 * NB; ++i) rb[i] = *(const bf16x8*)(gb + (size_t)(32 * i) * ldb + ko);
      }
    }
    const u16* a_s = sA + (kt & 1) * (128 * 72) + (wm * 64 + fr) * 72 + fh * 8;
    const u16* b_s = sB + (kt & 1) * (128 * 72) + (wn * 32 * NB + fr) * 72 + fh * 8;
#pragma unroll
    for (int s = 0; s < 4; ++s) {
      const bf16x8 a0 = *(const bf16x8*)(a_s + s * 16);
      const bf16x8 a1 = *(const bf16x8*)(a_s + 32 * 72 + s * 16);
      const bf16x8 b0 = *(const bf16x8*)(b_s + s * 16);
      acc[0][0] = MFMA32(a0, b0, acc[0][0]);
      acc[1][0] = MFMA32(a1, b0, acc[1][0]);
      if (NB == 2) {
        const bf16x8 b1 = *(const bf16x8*)(b_s + 32 * 72 + s * 16);
        acc[0][NB - 1] = MFMA32(a0, b1, acc[0][NB - 1]);
        acc[1][NB - 1] = MFMA32(a1, b1, acc[1][NB - 1]);
      }
    }
    __syncthreads();
  }
}

DI void dump_acc(const f32x16 (&acc)[2][2], float* ct, int tid_) {
  const int lane = tid_ & 63, wave = tid_ >> 6;
  const int wm = wave >> 1, wn = wave & 1, fr = lane & 31, fh = lane >> 5;
#pragma unroll
  for (int mb = 0; mb < 2; ++mb)
#pragma unroll
    for (int nb = 0; nb < 2; ++nb)
#pragma unroll
      for (int i = 0; i < 16; ++i)
        ct[(wm * 64 + mb * 32 + crow(i, fh)) * 132 + wn * 64 + nb * 32 + fr] = acc[mb][nb][i];
}

DI void dump_acc1(const f32x16 (&acc)[2][1], float* ct, int tid_) {
  const int lane = tid_ & 63, wave = tid_ >> 6;
  const int wm = wave >> 1, wn = wave & 1, fr = lane & 31, fh = lane >> 5;
#pragma unroll
  for (int mb = 0; mb < 2; ++mb)
#pragma unroll
    for (int i = 0; i < 16; ++i) ct[(wm * 64 + mb * 32 + crow(i, fh)) * 68 + wn * 32 + fr] = acc[mb][0][i];
}

#define TILE_LOOP_BEGIN(Mt, Nt)                                                             \
  {                                                                                         \
    const int _nloc = nblk_ >> 3, _x = bid_ & 7, _l = bid_ >> 3;            \
    const int _mper = (Mt) >> 3, _per = _mper * (Nt);                                       \
    if (_l < _nloc)                                                                         \
      for (int _i = _l; _i < _per; _i += _nloc) {                                           \
        const int _mm = _i & 7, _rest = _i >> 3;                                            \
        const int tile_n = _rest % (Nt), tile_m = _x * _mper + (_rest / (Nt)) * 8 + _mm;
#define TILE_LOOP_END }}

DI float row_rscale(const float* ssq, size_t tok) {
  const f32x4 a = *(const f32x4*)(ssq + tok * 8), b = *(const f32x4*)(ssq + tok * 8 + 4);
  const float s = (a[0] + a[1]) + (a[2] + a[3]) + (b[0] + b[1]) + (b[2] + b[3]);
  return rsqrtf(s * (1.0f / 1024.0f) + 1e-6f);
}

DI void convert_tile(const float* __restrict__ src, int N, int k0, int n0, u16* __restrict__ dst, int ldk, int koff,
                     const float* __restrict__ g, float* t, int tid_) {
  const int tid = tid_;
  {
    const int c4 = (tid & 15) * 4;
#pragma unroll
    for (int i = 0; i < 4; ++i) {
      const int kk = (tid >> 4) + 16 * i;
      f32x4 v = *(const f32x4*)(src + (size_t)(k0 + kk) * N + n0 + c4);
      const float sc = g ? g[k0 + kk] : 1.0f;
      t[kk * 65 + c4 + 0] = v[0] * sc; t[kk * 65 + c4 + 1] = v[1] * sc; t[kk * 65 + c4 + 2] = v[2] * sc; t[kk * 65 + c4 + 3] = v[3] * sc;
    }
  }
  __syncthreads();
  {
    const int kc = (tid & 7) * 8;
#pragma unroll
    for (int i = 0; i < 2; ++i) {
      const int nn = (tid >> 3) + 32 * i;
      u32x4 w;
      w[0] = pk2(t[(kc + 0) * 65 + nn], t[(kc + 1) * 65 + nn]);
      w[1] = pk2(t[(kc + 2) * 65 + nn], t[(kc + 3) * 65 + nn]);
      w[2] = pk2(t[(kc + 4) * 65 + nn], t[(kc + 5) * 65 + nn]);
      w[3] = pk2(t[(kc + 6) * 65 + nn], t[(kc + 7) * 65 + nn]);
      *(u32x4*)(dst + (size_t)(n0 + nn) * ldk + koff + k0 + kc) = w;
    }
  }
  __syncthreads();
}

__device__ void phase_prep(const Params& p, int tid_, int bid_, int nblk_, unsigned char* smem) {
  float* t = (float*)smem;
  u16* WinT = (u16*)(p.ws + OFF_WIN); u16* WbrT = (u16*)(p.ws + OFF_WBR); u16* WoutT = (u16*)(p.ws + OFF_WOUT);
  u16* WupT = (u16*)(p.ws + OFF_WUP); u16* WdnT = (u16*)(p.ws + OFF_WDN);
  const int per_layer = 4480;
  for (int j = bid_; j < 2 * per_layer; j += nblk_) {
    const int l = j / per_layer; int ti = j % per_layer;
    if (ti < 1888) { convert_tile(p.in[2] + (size_t)l * DM * INC, INC, (ti / 118) * 64, (ti % 118) * 64, WinT + (size_t)l * INC * DM, DM, 0, p.in[1] + l * DM, t, tid_); continue; }
    ti -= 1888;
    if (ti < 128) { convert_tile(p.in[11] + (size_t)l * 512 * DM, DM, (ti / 16) * 64, (ti % 16) * 64, WbrT + (size_t)l * DM * YC, YC, 0, nullptr, t, tid_); continue; }
    ti -= 128;
    if (ti < 32) { convert_tile(p.in[12] + (size_t)l * 128 * DM, DM, (ti / 16) * 64, (ti % 16) * 64, WbrT + (size_t)l * DM * YC, YC, 512, nullptr, t, tid_); continue; }
    ti -= 32;
    if (ti < 64) { convert_tile(p.in[13] + (size_t)l * 256 * DM, DM, (ti / 16) * 64, (ti % 16) * 64, WbrT + (size_t)l * DM * YC, YC, 640, nullptr, t, tid_); continue; }
    ti -= 64;
    if (ti < 64) { convert_tile(p.in[14] + (size_t)l * 256 * DM, DM, (ti / 16) * 64, (ti % 16) * 64, WbrT + (size_t)l * DM * YC, YC, 896, nullptr, t, tid_); continue; }
    ti -= 64;
    if (ti < 256) { convert_tile(p.in[15] + (size_t)l * DM * DM, DM, (ti / 16) * 64, (ti % 16) * 64, WoutT + (size_t)l * DM * DM, DM, 0, nullptr, t, tid_); continue; }
    ti -= 256;
    if (ti < 1024) { convert_tile(p.in[17] + (size_t)l * DM * DMLP, DMLP, (ti / 64) * 64, (ti % 64) * 64, WupT + (size_t)l * DMLP * DM, DM, 0, p.in[16] + l * DM, t, tid_); continue; }
    ti -= 1024;
    convert_tile(p.in[18] + (size_t)l * DMLP * DM, DM, (ti / 16) * 64, (ti % 16) * 64, WdnT + (size_t)l * DM * DMLP, DMLP, 0, nullptr, t, tid_);
  }
  float* rope = (float*)(p.ws + OFF_ROPE);
  for (int e = bid_ * 256 + tid_; e < SEQ * 48; e += nblk_ * 256) {
    const int pos = e / 48, i = e % 48;
    float inv;
    if (i < 32) inv = exp2f(-13.287712379549449f * (float)(2 * i) / 64.0f);
    else inv = exp2f(-13.287712379549449f * (float)(2 * (i - 32)) / 32.0f);
    const float angf = (float)pos * inv;
    const double ang = (double)angf;
    const double n = rint(ang * 0.15915494309189535);
    const float r = (float)(ang - n * 6.283185307179586);
    const float c = cosf(r), s = sinf(r);
    if (i < 32) { rope[pos * 96 + i] = c; rope[pos * 96 + 32 + i] = s; }
    else { rope[pos * 96 + 64 + (i - 32)] = c; rope[pos * 96 + 80 + (i - 32)] = s; }
  }
  u16* XB = (u16*)(p.ws + OFF_XB); float* SSQ = (float*)(p.ws + OFF_SSQ);
  const int lane = tid_ & 63;
  const int gw = bid_ * 4 + (tid_ >> 6), nw = nblk_ * 4;
  for (int row = gw; row < T; row += nw) {
    const float* xr = p.in[0] + (size_t)row * DM;
    float ss = 0.f;
#pragma unroll
    for (int i = 0; i < 4; ++i) {
      const f32x4 v = *(const f32x4*)(xr + i * 256 + lane * 4);
      ss += v[0] * v[0] + v[1] * v[1] + v[2] * v[2] + v[3] * v[3];
      u32x2 w = {pk2(v[0], v[1]), pk2(v[2], v[3])};
      *(u32x2*)(XB + (size_t)row * DM + i * 256 + lane * 4) = w;
    }
#pragma unroll
    for (int o = 32; o >= 1; o >>= 1) ss += __shfl_xor(ss, o);
    if (lane < 8) SSQ[(size_t)row * 8 + lane] = (lane == 0) ? ss : 0.f;
  }
}

DI int dil_of(int gi) { return gi == 0 ? 1 : (gi == 1 ? 4 : 16); }

__device__ void phase_inproj(const Params& p, int tid_, int bid_, int nblk_, int chunk, int layer, unsigned char* smem) {
  const u16* XB = (const u16*)(p.ws + OFF_XB) + (size_t)chunk * TC * DM;
  const float* SSQ = (const float*)(p.ws + OFF_SSQ) + (size_t)chunk * TC * 8;
  const u16* WinT = (const u16*)(p.ws + OFF_WIN) + (size_t)layer * INC * DM;
  u16* QKV = (u16*)(p.ws + OFF_QKV);
  u16* GATE = (u16*)(p.ws + OFF_GATE);
  const float* rope = (const float*)(p.ws + OFF_ROPE);
  float* ct = (float*)smem;
  const int tid = tid_; const int lane = tid & 63, wave = tid >> 6;
  TILE_LOOP_BEGIN(TC / 128, INC / 128)
    const int m0 = tile_m * 128, n0 = tile_n * 128;
    f32x16 acc[2][2];
    gemm_tile<2>(XB + (size_t)m0 * DM, DM, WinT + (size_t)n0 * DM, DM, DM, acc, (u16*)smem, tid_);
    dump_acc(acc, ct, tid_);
    __syncthreads();
    if (n0 < QKVC) {
      const int t = tid & 127, grp = tid >> 7;
      const int g = (n0 >> 6) + grp;
      const int tok = m0 + t;
      const int bl = tok >> 12, pos = tok & 4095;
      const float rs = row_rscale(SSQ, tok);
      float v[64];
#pragma unroll
      for (int q = 0; q < 16; ++q) {
        const f32x4 x4 = *(const f32x4*)(ct + t * 132 + grp * 64 + q * 4);
        v[q * 4 + 0] = x4[0] * rs; v[q * 4 + 1] = x4[1] * rs; v[q * 4 + 2] = x4[2] * rs; v[q * 4 + 3] = x4[3] * rs;
      }
      int kind, dil = 1; const float* gain = nullptr;
      if (g < 8) { kind = 0; gain = p.in[3] + layer * 128; }
      else if (g < 10) { kind = 0; gain = p.in[3] + layer * 128 + 64; }
      else if (g < 12) { kind = 3; }
      else if (g < 18) { kind = 0; gain = p.in[5] + layer * 128; dil = dil_of((g - 12) >> 1); }
      else if (g < 24) { kind = 0; gain = p.in[5] + layer * 128 + 64; dil = dil_of((g - 18) >> 1); }
      else if (g < 30) { kind = 3; dil = dil_of((g - 24) >> 1); }
      else if (g < 34) { kind = 2; gain = p.in[6] + layer * 64; }
      else if (g < 38) { kind = 2; gain = p.in[6] + layer * 64 + 32; }
      else if (g < 42) { kind = 3; }
      else if (g < 46) { kind = 1; gain = p.in[9] + layer * 128; }
      else if (g < 50) { kind = 1; gain = p.in[9] + layer * 128 + 64; }
      else { kind = 3; }
      const int pdom = (dil == 1) ? pos : ((pos % dil) * (SEQ / dil) + pos / dil);
      const int blk = pdom >> 5, r = pdom & 31;
      u16* base = QKV + (size_t)g * TC * 64 + (size_t)bl * SEQ * 64;
      if (kind == 0 || kind == 1) {
        float ss = 0.f;
#pragma unroll
        for (int d = 0; d < 64; ++d) ss += v[d] * v[d];
        const float rn = rsqrtf(ss * (1.0f / 64.0f) + 1e-6f);
#pragma unroll
        for (int d = 0; d < 64; ++d) v[d] = v[d] * rn * gain[d];
        if (kind == 0) {
          const float* cs = rope + pos * 96;
#pragma unroll
          for (int i = 0; i < 32; ++i) {
            const float c = cs[i], s = cs[32 + i];
            const float a = v[i], b = v[i + 32];
            v[i] = a * c - b * s; v[i + 32] = b * c + a * s;
          }
        }
#pragma unroll
        for (int s = 0; s < 4; ++s)
#pragma unroll
          for (int h = 0; h < 2; ++h) {
            const int d0 = 16 * s + 8 * h;
            u32x4 w = {pk2(v[d0], v[d0 + 1]), pk2(v[d0 + 2], v[d0 + 3]), pk2(v[d0 + 4], v[d0 + 5]), pk2(v[d0 + 6], v[d0 + 7])};
            *(u32x4*)(base + ((size_t)(blk * 4 + s) * 64 + h * 32 + r) * 8) = w;
          }
      } else if (kind == 2) {
        const float* cs = rope + pos * 96 + 64;
#pragma unroll
        for (int c = 0; c < 2; ++c) {
          float ss = 0.f;
#pragma unroll
          for (int d = 0; d < 32; ++d) ss += v[c * 32 + d] * v[c * 32 + d];
          const float rn = rsqrtf(ss * (1.0f / 32.0f) + 1e-6f);
#pragma unroll
          for (int d = 0; d < 32; ++d) v[c * 32 + d] = v[c * 32 + d] * rn * gain[d];
#pragma unroll
          for (int i = 0; i < 16; ++i) {
            const float cc = cs[i], sn = cs[16 + i];
            const float a = v[c * 32 + i], b = v[c * 32 + i + 16];
            v[c * 32 + i] = a * cc - b * sn; v[c * 32 + i + 16] = b * cc + a * sn;
          }
          u16* sb = base + (size_t)c * SEQ * 32;
#pragma unroll
          for (int s = 0; s < 2; ++s)
#pragma unroll
            for (int h = 0; h < 2; ++h) {
              const int d0 = c * 32 + 16 * s + 8 * h;
              u32x4 w = {pk2(v[d0], v[d0 + 1]), pk2(v[d0 + 2], v[d0 + 3]), pk2(v[d0 + 4], v[d0 + 5]), pk2(v[d0 + 6], v[d0 + 7])};
              *(u32x4*)(sb + ((size_t)(blk * 2 + s) * 64 + h * 32 + r) * 8) = w;
            }
        }
      } else {
        const int key = r, s = key >> 4, hh = (key >> 2) & 1, j = ((key >> 3) & 1) * 4 + (key & 3);
#pragma unroll
        for (int dv = 0; dv < 64; ++dv) {
          const unsigned w = pk2(v[dv], 0.f);
          base[((size_t)((blk * 2 + (dv >> 5)) * 2 + s) * 64 + hh * 32 + (dv & 31)) * 8 + j] = (u16)(w & 0xffffu);
        }
      }
    } else {
      const int gc0 = n0 - QKVC;
#pragma unroll 4
      for (int it = 0; it < 16; ++it) {
        const int row = it * 8 + wave * 2 + (lane >> 5), c4 = (lane & 31) * 4;
        const int tok = m0 + row;
        const float rs = row_rscale(SSQ, tok);
        const f32x4 x4 = *(const f32x4*)(ct + row * 132 + c4);
        float o[4];
#pragma unroll
        for (int e = 0; e < 4; ++e) o[e] = 1.0f / (1.0f + __expf(-x4[e] * rs));
        u32x2 w = {pk2(o[0], o[1]), pk2(o[2], o[3])};
        *(u32x2*)(GATE + (size_t)tok * 4096 + gc0 + c4) = w;
      }
    }
    __syncthreads();
  TILE_LOOP_END
}

DI void attn_softmax_pv(f32x16& S, float& m, float& l, f32x16& O0, f32x16& O1, const bf16x8 (&vf)[2][2]) {
  float mx = S[0];
#pragma unroll
  for (int i = 1; i < 16; ++i) mx = fmaxf(mx, S[i]);
  mx = fmaxf(mx, __shfl_xor(mx, 32));
  const float mn = fmaxf(m, mx);
  const float alpha = fexp2(m - mn);
  m = mn;
  float sum = 0.f;
#pragma unroll
  for (int i = 0; i < 16; ++i) { S[i] = fexp2(S[i] - mn); sum += S[i]; }
  l = l * alpha + sum;
  const u32x4 p0 = {pk2(S[0], S[1]), pk2(S[2], S[3]), pk2(S[4], S[5]), pk2(S[6], S[7])};
  const u32x4 p1 = {pk2(S[8], S[9]), pk2(S[10], S[11]), pk2(S[12], S[13]), pk2(S[14], S[15])};
#pragma unroll
  for (int i = 0; i < 16; ++i) { O0[i] *= alpha; O1[i] *= alpha; }
  O0 = MFMA32(vf[0][0], as_bf8(p0), O0);
  O0 = MFMA32(vf[0][1], as_bf8(p1), O0);
  O1 = MFMA32(vf[1][0], as_bf8(p0), O1);
  O1 = MFMA32(vf[1][1], as_bf8(p1), O1);
}
DI void load_vf(bf16x8 (&vf)[2][2], const u16* V, int kb, int lane) {
#pragma unroll
  for (int rb = 0; rb < 2; ++rb)
#pragma unroll
    for (int s = 0; s < 2; ++s) vf[rb][s] = *(const bf16x8*)(V + ((size_t)((kb * 2 + rb) * 2 + s) * 64 + lane) * 8);
}
DI void load_kf4(bf16x8 (&kf)[4], const u16* K, int kb, int lane) {
#pragma unroll
  for (int s = 0; s < 4; ++s) kf[s] = *(const bf16x8*)(K + ((size_t)(kb * 4 + s) * 64 + lane) * 8);
}
DI void load_kf2(bf16x8 (&kf)[2], const u16* K, int kb, int lane) {
#pragma unroll
  for (int s = 0; s < 2; ++s) kf[s] = *(const bf16x8*)(K + ((size_t)(kb * 2 + s) * 64 + lane) * 8);
}
DI void zero16(f32x16& a) {
#pragma unroll
  for (int i = 0; i < 16; ++i) a[i] = 0.f;
}
DI void store_o(u16* yrow, const f32x16& O0, const f32x16& O1, float sc, int h) {
#pragma unroll
  for (int g4 = 0; g4 < 4; ++g4) {
    u32x2 w0 = {pk2(O0[4 * g4] * sc, O0[4 * g4 + 1] * sc), pk2(O0[4 * g4 + 2] * sc, O0[4 * g4 + 3] * sc)};
    *(u32x2*)(yrow + 8 * g4 + 4 * h) = w0;
    u32x2 w1 = {pk2(O1[4 * g4] * sc, O1[4 * g4 + 1] * sc), pk2(O1[4 * g4 + 2] * sc, O1[4 * g4 + 3] * sc)};
    *(u32x2*)(yrow + 32 + 8 * g4 + 4 * h) = w1;
  }
}

__device__ void phase_attn(const Params& p, int tid_, int bid_, int nblk_, int layer) {
  const u16* QKV = (const u16*)(p.ws + OFF_QKV);
  u16* Y = (u16*)(p.ws + OFF_Y);
  u16* BO = (u16*)(p.ws + OFF_BO);
  float* LSE = (float*)(p.ws + OFF_LSE);
  const int lane = tid_ & 63, wave = tid_ >> 6;
  const int fr = lane & 31, fh = lane >> 5;
  const int nloc = nblk_ >> 3;
  if ((int)(bid_ >> 3) >= nloc) return;
  const int vw = ((bid_ & 7) * nloc + (bid_ >> 3)) * 4 + wave, NW = nloc * 32;
  const size_t GS = (size_t)TC * 64;
  const size_t BS = (size_t)SEQ * 64;

  {
    const float* lp = p.in[7] + layer * 128;
    float d01 = 0.f, d23 = 0.f;
    for (int i = 0; i < 32; ++i) { d01 += lp[i] * lp[32 + i]; d23 += lp[64 + i] * lp[96 + i]; }
    const float lambda_init = (layer == 0) ? 0.2f : 0.35550907f;
    const float lam = __expf(d01) - __expf(d23) + lambda_init;
    const float* subg = p.in[8] + layer * 64;
    const float sc = 0.17677669529663687f * LOG2E;
    for (int it = vw; it < BC * 4 * 128; it += NW) {
      const int bl = it >> 9, head = (it >> 7) & 3, qblk = it & 127;
      const u16* Q0 = QKV + (30 + head) * GS + bl * BS; const u16* Q1 = Q0 + SEQ * 32;
      const u16* K0 = QKV + (34 + head) * GS + bl * BS; const u16* K1 = K0 + SEQ * 32;
      const u16* V = QKV + (38 + head) * GS + bl * BS;
      bf16x8 q0[2], q1[2];
      load_kf2(q0, Q0, qblk, lane); load_kf2(q1, Q1, qblk, lane);
      float m0 = -1e30f, l0 = 0.f, m1 = -1e30f, l1 = 0.f;
      f32x16 O00, O01, O10, O11; zero16(O00); zero16(O01); zero16(O10); zero16(O11);
      bf16x8 k0[2], k1[2], vf[2][2];
      load_kf2(k0, K0, 0, lane); load_kf2(k1, K1, 0, lane); load_vf(vf, V, 0, lane);
      for (int kb = 0; kb < 128; ++kb) {
        bf16x8 nk0[2], nk1[2], nvf[2][2];
        const int kn = (kb + 1 < 128) ? kb + 1 : kb;
        load_kf2(nk0, K0, kn, lane); load_kf2(nk1, K1, kn, lane); load_vf(nvf, V, kn, lane);
        f32x16 S0, S1; zero16(S0); zero16(S1);
        S0 = MFMA32(k0[0], q0[0], S0); S0 = MFMA32(k0[1], q0[1], S0);
        S1 = MFMA32(k1[0], q1[0], S1); S1 = MFMA32(k1[1], q1[1], S1);
#pragma unroll
        for (int i = 0; i < 16; ++i) { S0[i] *= sc; S1[i] *= sc; }
        attn_softmax_pv(S0, m0, l0, O00, O01, vf);
        attn_softmax_pv(S1, m1, l1, O10, O11, vf);
#pragma unroll
        for (int s = 0; s < 2; ++s) { k0[s] = nk0[s]; k1[s] = nk1[s]; vf[0][s] = nvf[0][s]; vf[1][s] = nvf[1][s]; }
      }
      const float i0 = 1.0f / (l0 + __shfl_xor(l0, 32));
      const float i1 = lam / (l1 + __shfl_xor(l1, 32));
      float ss = 0.f;
#pragma unroll
      for (int i = 0; i < 16; ++i) {
        O00[i] = O00[i] * i0 - O10[i] * i1; O01[i] = O01[i] * i0 - O11[i] * i1;
        ss += O00[i] * O00[i] + O01[i] * O01[i];
      }
      ss += __shfl_xor(ss, 32);
      const float rn = rsqrtf(ss * (1.0f / 64.0f) + 1e-6f) * (1.0f - lambda_init);
#pragma unroll
      for (int g4 = 0; g4 < 4; ++g4) {
        const f32x4 ga = *(const f32x4*)(subg + 8 * g4 + 4 * fh);
        const f32x4 gb = *(const f32x4*)(subg + 32 + 8 * g4 + 4 * fh);
#pragma unroll
        for (int e = 0; e < 4; ++e) { O00[4 * g4 + e] *= ga[e]; O01[4 * g4 + e] *= gb[e]; }
      }
      const size_t tok = (size_t)bl * SEQ + qblk * 32 + fr;
      store_o(Y + tok * YC + 640 + head * 64, O00, O01, rn, fh);
    }
  }
  {
    const float sc = 0.125f * LOG2E;
    for (int it = vw; it < BC * 8 * 128; it += NW) {
      const int bl = it >> 10, hq = (it >> 7) & 7, qblk = it & 127;
      const int kvh = hq >> 2;
      const u16* Q = QKV + (size_t)hq * GS + bl * BS;
      const u16* K = QKV + (size_t)(8 + kvh) * GS + bl * BS;
      const u16* V = QKV + (size_t)(10 + kvh) * GS + bl * BS;
      bf16x8 qf[4]; load_kf4(qf, Q, qblk, lane);
      float m = p.in[4][layer * 8 + hq] * LOG2E, l = (fh == 0) ? 1.0f : 0.0f;
      f32x16 O0, O1; zero16(O0); zero16(O1);
      const int kb_lo = (qblk - 4 < 0) ? 0 : qblk - 4, kb_hi = (qblk + 4 > 127) ? 127 : qblk + 4;
      const int qpos = qblk * 32 + fr;
      for (int kb = kb_lo; kb <= kb_hi; ++kb) {
        bf16x8 kf[4], vf[2][2];
        load_kf4(kf, K, kb, lane); load_vf(vf, V, kb, lane);
        f32x16 S; zero16(S);
#pragma unroll
        for (int s = 0; s < 4; ++s) S = MFMA32(kf[s], qf[s], S);
#pragma unroll
        for (int i = 0; i < 16; ++i) {
          const int dlt = kb * 32 + crow(i, fh) - qpos;
          S[i] = (dlt <= 128 && dlt >= -128) ? S[i] * sc : -1e30f;
        }
        attn_softmax_pv(S, m, l, O0, O1, vf);
      }
      const float inv = 1.0f / (l + __shfl_xor(l, 32));
      const size_t tok = (size_t)bl * SEQ + qpos;
      store_o(Y + tok * YC + hq * 64, O0, O1, inv, fh);
    }
  }
  {
    const float sc = 0.125f;
    for (int it = vw; it < BC * 4 * 128; it += NW) {
      const int bl = it >> 9, head = (it >> 7) & 3, qblk = it & 127;
      const u16* Q = QKV + (size_t)(42 + head) * GS + bl * BS;
      const u16* K = QKV + (size_t)(46 + head) * GS + bl * BS;
      const u16* V = QKV + (size_t)(50 + head) * GS + bl * BS;
      const float* rpb = p.in[10] + (size_t)(layer * 4 + head) * 15 * 31;
      bf16x8 qf[4]; load_kf4(qf, Q, qblk, lane);
      float m = -1e30f, l = 0.f;
      f32x16 O0, O1; zero16(O0); zero16(O1);
      const int qrow = qblk >> 1, qc = (qblk & 1) * 32 + fr;
      int r0 = qrow - 4; r0 = r0 < 0 ? 0 : (r0 > 56 ? 56 : r0);
      int c0 = qc - 8; c0 = c0 < 0 ? 0 : (c0 > 48 ? 48 : c0);
      for (int kk = 0; kk < 16; ++kk) {
        const int krow_ = r0 + (kk >> 1), hb = kk & 1, kb = krow_ * 2 + hb;
        bf16x8 kf[4], vf[2][2];
        load_kf4(kf, K, kb, lane); load_vf(vf, V, kb, lane);
        f32x16 S; zero16(S);
#pragma unroll
        for (int s = 0; s < 4; ++s) S = MFMA32(kf[s], qf[s], S);
        const float* brow = rpb + (krow_ - qrow + 7) * 31;
#pragma unroll
        for (int i = 0; i < 16; ++i) {
          const int kc = hb * 32 + crow(i, fh);
          int dc = kc - qc; dc = dc < -15 ? -15 : (dc > 15 ? 15 : dc);
          const float bias = brow[dc + 15];
          S[i] = (kc >= c0 && kc < c0 + 16) ? (S[i] * sc + bias) * LOG2E : -1e30f;
        }
        attn_softmax_pv(S, m, l, O0, O1, vf);
      }
      const float inv = 1.0f / (l + __shfl_xor(l, 32));
      const size_t tok = (size_t)bl * SEQ + qblk * 32 + fr;
      store_o(Y + tok * YC + 896 + head * 64, O0, O1, inv, fh);
    }
  }
  {
    const float sc = 0.125f * LOG2E;
    for (int it = vw; it < BC * 6 * 128; it += NW) {
      const int bl = it / 768, rem = it % 768, head = rem >> 7, qblk = rem & 127;
      const int dil = dil_of(head >> 1), L = SEQ / dil, LB = L >> 5;
      const u16* Q = QKV + (size_t)(12 + head) * GS + bl * BS;
      const u16* K = QKV + (size_t)(18 + head) * GS + bl * BS;
      const u16* V = QKV + (size_t)(24 + head) * GS + bl * BS;
      bf16x8 qf[4]; load_kf4(qf, Q, qblk, lane);
      float m = -1e30f, l = 0.f;
      f32x16 O0, O1; zero16(O0); zero16(O1);
      const int rsub = qblk / LB;
      const int lo = rsub * LB, hi = lo + LB - 1;
      const int kb_lo = (qblk - 2 < lo) ? lo : qblk - 2, kb_hi = (qblk + 2 > hi) ? hi : qblk + 2;
      const int qd = qblk * 32 + fr;
      for (int kb = kb_lo; kb <= kb_hi; ++kb) {
        bf16x8 kf[4], vf[2][2];
        load_kf4(kf, K, kb, lane); load_vf(vf, V, kb, lane);
        f32x16 S; zero16(S);
#pragma unroll
        for (int s = 0; s < 4; ++s) S = MFMA32(kf[s], qf[s], S);
#pragma unroll
        for (int i = 0; i < 16; ++i) {
          const int dlt = kb * 32 + crow(i, fh) - qd;
          S[i] = (dlt <= 64 && dlt >= -64) ? S[i] * sc : -1e30f;
        }
        attn_softmax_pv(S, m, l, O0, O1, vf);
      }
      const float lt = l + __shfl_xor(l, 32);
      const float inv = 1.0f / lt;
      const int msub = qd - rsub * L;
      const int pos = msub * dil + rsub;
      const size_t tok = (size_t)bl * SEQ + pos;
      store_o(BO + tok * 384 + head * 64, O0, O1, inv, fh);
      if (fh == 0) LSE[tok * 8 + head] = __log2f(lt) + m;
    }
  }
}

__device__ void phase_bcombine(const Params& p, int tid_, int bid_, int nblk_) {
  const u16* BO = (const u16*)(p.ws + OFF_BO);
  const float* LSE = (const float*)(p.ws + OFF_LSE);
  u16* Y = (u16*)(p.ws + OFF_Y);
  for (int e = bid_ * 256 + tid_; e < TC * 16; e += nblk_ * 256) {
    const int tok = e >> 4, j = (e >> 3) & 1, c8 = (e & 7) * 8;
    const float a0 = LSE[(size_t)tok * 8 + j], a1 = LSE[(size_t)tok * 8 + 2 + j], a2 = LSE[(size_t)tok * 8 + 4 + j];
    const float mx = fmaxf(a0, fmaxf(a1, a2));
    float w0 = fexp2(a0 - mx), w1 = fexp2(a1 - mx), w2 = fexp2(a2 - mx);
    const float inv = 1.0f / (w0 + w1 + w2);
    w0 *= inv; w1 *= inv; w2 *= inv;
    const u32x4 x0 = *(const u32x4*)(BO + (size_t)tok * 384 + (0 + j) * 64 + c8);
    const u32x4 x1 = *(const u32x4*)(BO + (size_t)tok * 384 + (2 + j) * 64 + c8);
    const u32x4 x2 = *(const u32x4*)(BO + (size_t)tok * 384 + (4 + j) * 64 + c8);
    u32x4 o;
#pragma unroll
    for (int q = 0; q < 4; ++q) {
      const float lo = w0 * bf_lo(x0[q]) + w1 * bf_lo(x1[q]) + w2 * bf_lo(x2[q]);
      const float hi = w0 * bf_hi(x0[q]) + w1 * bf_hi(x1[q]) + w2 * bf_hi(x2[q]);
      o[q] = pk2(lo, hi);
    }
    *(u32x4*)(Y + (size_t)tok * YC + 512 + j * 64 + c8) = o;
  }
}

__device__ void phase_merge(const Params& p, int tid_, int bid_, int nblk_, int layer, unsigned char* smem) {
  const u16* Y = (const u16*)(p.ws + OFF_Y);
  const u16* GATE = (const u16*)(p.ws + OFF_GATE);
  const u16* WbrT = (const u16*)(p.ws + OFF_WBR) + (size_t)layer * DM * YC;
  u16* MRG = (u16*)(p.ws + OFF_MRG);
  float* ct = (float*)smem;
  const int lane = tid_ & 63, wave = tid_ >> 6;
  TILE_LOOP_BEGIN(TC / 128, DM / 64)
    const int m0 = tile_m * 128, n0 = tile_n * 64;
    f32x4 mg[8];
#pragma unroll
    for (int it = 0; it < 8; ++it) mg[it] = f32x4{0.f, 0.f, 0.f, 0.f};
#pragma unroll 1
    for (int seg = 0; seg < 4; ++seg) {
      const int koff = (seg == 0) ? 0 : (seg == 1 ? 512 : (seg == 2 ? 640 : 896));
      const int kl = (seg == 0) ? 512 : (seg == 1 ? 128 : 256);
      f32x16 acc[2][1];
      gemm_tile<1>(Y + (size_t)m0 * YC + koff, YC, WbrT + (size_t)n0 * YC + koff, YC, kl, acc, (u16*)smem, tid_);
      dump_acc1(acc, ct, tid_);
      __syncthreads();
#pragma unroll
      for (int it = 0; it < 8; ++it) {
        const int row = it * 16 + wave * 4 + (lane >> 4), c4 = (lane & 15) * 4;
        const f32x4 x4 = *(const f32x4*)(ct + row * 68 + c4);
        const u32x2 gq = *(const u32x2*)(GATE + (size_t)(m0 + row) * 4096 + seg * 1024 + n0 + c4);
        mg[it][0] += bf_lo(gq[0]) * x4[0]; mg[it][1] += bf_hi(gq[0]) * x4[1];
        mg[it][2] += bf_lo(gq[1]) * x4[2]; mg[it][3] += bf_hi(gq[1]) * x4[3];
      }
      __syncthreads();
    }
#pragma unroll
    for (int it = 0; it < 8; ++it) {
      const int row = it * 16 + wave * 4 + (lane >> 4), c4 = (lane & 15) * 4;
      u32x2 w = {pk2(mg[it][0], mg[it][1]), pk2(mg[it][2], mg[it][3])};
      *(u32x2*)(MRG + (size_t)(m0 + row) * DM + n0 + c4) = w;
    }
  TILE_LOOP_END
}

__device__ void phase_resid(const Params& p, int tid_, int bid_, int nblk_, int chunk, const u16* A, int K, const u16* Wt, const float* xold, unsigned char* smem) {
  float* xout = p.out + (size_t)chunk * TC * DM;
  u16* XB = (u16*)(p.ws + OFF_XB) + (size_t)chunk * TC * DM;
  float* SSQ = (float*)(p.ws + OFF_SSQ) + (size_t)chunk * TC * 8;
  float* ct = (float*)smem;
  const int lane = tid_ & 63, wave = tid_ >> 6;
  TILE_LOOP_BEGIN(TC / 128, DM / 128)
    const int m0 = tile_m * 128, n0 = tile_n * 128;
    f32x16 acc[2][2];
    gemm_tile<2>(A + (size_t)m0 * K, K, Wt + (size_t)n0 * K, K, K, acc, (u16*)smem, tid_);
    dump_acc(acc, ct, tid_);
    __syncthreads();
#pragma unroll 4
    for (int it = 0; it < 16; ++it) {
      const int row = it * 8 + wave * 2 + (lane >> 5), c4 = (lane & 31) * 4;
      const size_t o = (size_t)(m0 + row) * DM + n0 + c4;
      const f32x4 x4 = *(const f32x4*)(ct + row * 132 + c4);
      f32x4 xo = *(const f32x4*)(xold + o);
      xo[0] += x4[0]; xo[1] += x4[1]; xo[2] += x4[2]; xo[3] += x4[3];
      *(f32x4*)(xout + o) = xo;
      u32x2 w = {pk2(xo[0], xo[1]), pk2(xo[2], xo[3])};
      *(u32x2*)(XB + o) = w;
      float ss = xo[0] * xo[0] + xo[1] * xo[1] + xo[2] * xo[2] + xo[3] * xo[3];
#pragma unroll
      for (int d = 16; d >= 1; d >>= 1) ss += __shfl_xor(ss, d);
      if ((lane & 31) == 0) SSQ[(size_t)(m0 + row) * 8 + tile_n] = ss;
    }
    __syncthreads();
  TILE_LOOP_END
}

__device__ void phase_up(const Params& p, int tid_, int bid_, int nblk_, int chunk, int layer, unsigned char* smem) {
  const u16* XB = (const u16*)(p.ws + OFF_XB) + (size_t)chunk * TC * DM;
  const float* SSQ = (const float*)(p.ws + OFF_SSQ) + (size_t)chunk * TC * 8;
  const u16* WupT = (const u16*)(p.ws + OFF_WUP) + (size_t)layer * DMLP * DM;
  u16* U = (u16*)(p.ws + OFF_GATE);
  float* ct = (float*)smem;
  const int lane = tid_ & 63, wave = tid_ >> 6;
  TILE_LOOP_BEGIN(TC / 128, DMLP / 128)
    const int m0 = tile_m * 128, n0 = tile_n * 128;
    f32x16 acc[2][2];
    gemm_tile<2>(XB + (size_t)m0 * DM, DM, WupT + (size_t)n0 * DM, DM, DM, acc, (u16*)smem, tid_);
    dump_acc(acc, ct, tid_);
    __syncthreads();
#pragma unroll 4
    for (int it = 0; it < 16; ++it) {
      const int row = it * 8 + wave * 2 + (lane >> 5), c4 = (lane & 31) * 4;
      const float rs = row_rscale(SSQ, m0 + row);
      const f32x4 x4 = *(const f32x4*)(ct + row * 132 + c4);
      float o[4];
#pragma unroll
      for (int e = 0; e < 4; ++e) { const float z = fmaxf(x4[e] * rs, 0.f); o[e] = z * z; }
      u32x2 w = {pk2(o[0], o[1]), pk2(o[2], o[3])};
      *(u32x2*)(U + (size_t)(m0 + row) * DMLP + n0 + c4) = w;
    }
    __syncthreads();
  TILE_LOOP_END
}

#define XB_TMO      128
#define XB_XCNT(j)  (256  + 64 * (j))
#define XB_XSUB(j)  (1280 + 64 * (j))
#define XB_XGEN(j)  (2304 + 64 * (j))
#define XB_TOP      3328
#define XB_TOPGEN   3392
#define XCD_BAR_WORDS 3456
#define XB_SPIN_CAP (1u << 22)
#define LAS __attribute__((address_space(3)))
DI unsigned xb_ld(unsigned* p)              { return __hip_atomic_load(p, __ATOMIC_RELAXED, __HIP_MEMORY_SCOPE_AGENT); }
DI unsigned xb_add(unsigned* p, unsigned v) { return __hip_atomic_fetch_add(p, v, __ATOMIC_RELAXED, __HIP_MEMORY_SCOPE_AGENT); }
DI unsigned xb_xcc_id() { return (unsigned)__builtin_amdgcn_s_getreg((3 << 11) | 20) & 0xFu; }
#define XB_SPIN(cond, bar) do { unsigned _sp = 0; while (cond) { __builtin_amdgcn_s_sleep(1); \
    if ((++_sp & 255u) == 0u) { if (xb_ld(&(bar)[XB_TMO])) break; if (_sp > XB_SPIN_CAP) { atomicAdd(&(bar)[XB_TMO], 1u); break; } } } } while (0)
struct XcdBarrier { unsigned* bar; unsigned x; volatile LAS unsigned* st; };
DI XcdBarrier xcd_barrier_post(unsigned* bar, volatile LAS unsigned* st) {
  XcdBarrier b; b.bar = bar; b.x = xb_xcc_id(); b.st = st;
  if (threadIdx.x == 0) (void)xb_add(&bar[XB_XCNT(b.x)], 1u);
  return b;
}
DI void xcd_barrier_complete(unsigned* bar, unsigned x, unsigned& nloc, unsigned& nx) {
  const unsigned G = gridDim.x * gridDim.y * gridDim.z;
  unsigned sum, cnt, mine, sp = 0u;
  for (;;) {
    sum = 0u; cnt = 0u; mine = 0u;
#pragma unroll
    for (unsigned j = 0; j < 16; ++j) { const unsigned c = xb_ld(&bar[XB_XCNT(j)]); sum += c; cnt += (c > 0u) ? 1u : 0u; mine = (j == x) ? c : mine; }
    if (sum == G) break;
    __builtin_amdgcn_s_sleep(1);
    if ((++sp & 255u) == 0u) { if (xb_ld(&bar[XB_TMO])) break; if (sp > XB_SPIN_CAP) { atomicAdd(&bar[XB_TMO], 1u); break; } }
  }
  nloc = mine > 0u ? mine : 1u; nx = cnt > 0u ? cnt : 1u;
}
DI void xcd_barrier(const XcdBarrier& b) {
  asm volatile("s_waitcnt vmcnt(0)" ::: "memory");
  __syncthreads();
  if (threadIdx.x == 0) {
    unsigned* bar = b.bar;
    __builtin_amdgcn_s_waitcnt(0);
    unsigned nloc = b.st[0], nx = b.st[1];
    if (nloc == 0u) { xcd_barrier_complete(bar, b.x, nloc, nx); b.st[0] = nloc; b.st[1] = nx; }
    const unsigned old = xb_add(&bar[XB_XSUB(b.x)], 1u);
    const unsigned gen = old / nloc;
    if (old + 1u == (gen + 1u) * nloc) {
      __builtin_amdgcn_fence(__ATOMIC_RELEASE, "agent");
      asm volatile("s_waitcnt vmcnt(0)" ::: "memory");
      const unsigned og = xb_add(&bar[XB_TOP], 1u);
      const unsigned tg = og / nx;
      if (og + 1u == (tg + 1u) * nx) xb_add(&bar[XB_TOPGEN], 1u);
      else XB_SPIN(xb_ld(&bar[XB_TOPGEN]) == tg, bar);
      __builtin_amdgcn_fence(__ATOMIC_ACQUIRE, "agent");
      xb_add(&bar[XB_XGEN(b.x)], 1u);
      asm volatile("s_waitcnt vmcnt(0)" ::: "memory");
    } else {
      XB_SPIN(xb_ld(&bar[XB_XGEN(b.x)]) == gen, bar);
      __builtin_amdgcn_fence(__ATOMIC_ACQUIRE, "agent");
      asm volatile("s_waitcnt vmcnt(0)" ::: "memory");
    }
  }
  __syncthreads();
}

__global__ void __launch_bounds__(256, 2) mk_forward(Params p) {
  __shared__ __attribute__((aligned(16))) unsigned char smem[LDS_BYTES];
  __shared__ uint4 xb_words;
  cg::grid_group grid = cg::this_grid();
  if (threadIdx.x == 0) xb_words = make_uint4(0u, 0u, 0u, 0u);
  __syncthreads();
  XcdBarrier xb;
  if (FUSED) xb = xcd_barrier_post((unsigned*)(p.ws + OFF_BAR), (volatile LAS unsigned*)&xb_words);
  for (int ph = p.ph_lo; ph < p.ph_hi; ++ph) {
   for (int rep = 0; rep < ((ph > 0 && ((DUPMASK >> ((ph - 1) % 7)) & 1)) ? 2 : 1); ++rep) {
    int tid_ = threadIdx.x, bid_ = blockIdx.x, nblk_ = gridDim.x;
    asm volatile("" : "+v"(tid_));
    asm volatile("" : "+s"(bid_));
    asm volatile("" : "+s"(nblk_));
    Params pp = p;
    asm volatile("" : "+s"(pp.ws));
    asm volatile("" : "+s"(pp.out));
    if (ph == 0) {
      if (PHMASK & 128) phase_prep(pp, tid_, bid_, nblk_, smem);
    } else {
      const int q = ph - 1, chunk = q / 14, layer = (q % 14) / 7, k = q % 7;
      if (k == 0) { if (PHMASK & 1) phase_inproj(pp, tid_, bid_, nblk_, chunk, layer, smem); }
      else if (k == 1) { if (PHMASK & 2) phase_attn(pp, tid_, bid_, nblk_, layer); }
      else if (k == 2) { if (PHMASK & 4) phase_bcombine(pp, tid_, bid_, nblk_); }
      else if (k == 3) { if (PHMASK & 8) phase_merge(pp, tid_, bid_, nblk_, layer, smem); }
      else if (k == 4) { if (PHMASK & 16) phase_resid(pp, tid_, bid_, nblk_, chunk, (const u16*)(pp.ws + OFF_MRG), DM, (const u16*)(pp.ws + OFF_WOUT) + (size_t)layer * DM * DM,
                                   (layer == 0) ? (pp.in[0] + (size_t)chunk * TC * DM) : (pp.out + (size_t)chunk * TC * DM), smem); }
      else if (k == 5) { if (PHMASK & 32) phase_up(pp, tid_, bid_, nblk_, chunk, layer, smem); }
      else { if (PHMASK & 64) phase_resid(pp, tid_, bid_, nblk_, chunk, (const u16*)(pp.ws + OFF_GATE), DMLP, (const u16*)(pp.ws + OFF_WDN) + (size_t)layer * DM * DMLP,
                       pp.out + (size_t)chunk * TC * DM, smem); }
    }
   }
    if (ph + 1 < p.ph_hi) {
      if (ph == 0) grid.sync();
      else xcd_barrier(xb);
    }
  }
}

extern "C" void kernel_launch(void* const* d_in, const int* in_sizes, int n_in, void* d_out, int out_size, void* d_ws, size_t ws_size,
                              hipStream_t stream) {
  static int grid_blocks = 0;
  if (grid_blocks == 0) {
    if (n_in != 19 || out_size != T * DM || ws_size < WS_END) {
      fprintf(stderr, "kernel_launch: unexpected problem (n_in %d out %d ws %zu need %zu)\n", n_in, out_size, ws_size, (size_t)WS_END);
      grid_blocks = -1;
      return;
    }
    int dev = 0, cus = 0, per_cu = 0;
    hipGetDevice(&dev);
    hipDeviceGetAttribute(&cus, hipDeviceAttributeMultiprocessorCount, dev);
    hipOccupancyMaxActiveBlocksPerMultiprocessor(&per_cu, mk_forward, 256, 0);
    if (per_cu < 1) per_cu = 1;
    if (per_cu > 2) per_cu = 2;
    grid_blocks = cus * per_cu;
  }
  if (grid_blocks < 0) return;
  Params p{};
  for (int i = 0; i < 19; ++i) p.in[i] = (const float*)d_in[i];
  p.out = (float*)d_out;
  p.ws = (unsigned char*)d_ws;
#if FUSED
  hipMemsetAsync((unsigned char*)d_ws + OFF_BAR, 0, XCD_BAR_WORDS * 4, stream);
  p.ph_lo = 0; p.ph_hi = NPHASE;
  void* args[] = {&p};
  hipError_t e = hipLaunchCooperativeKernel((const void*)mk_forward, dim3(grid_blocks), dim3(256), args, 0, stream);
  if (e != hipSuccess) fprintf(stderr, "cooperative launch failed: %s (grid %d)\n", hipGetErrorString(e), grid_blocks);
#else
  for (int ph = 0; ph < NPHASE; ++ph) {
    p.ph_lo = ph; p.ph_hi = ph + 1;
    hipLaunchKernelGGL(mk_forward, dim3(grid_blocks), dim3(256), 0, stream, p);
  }
#endif
}
```

```cpp
#include <hip/hip_runtime.h>
#include <hip/hip_cooperative_groups.h>
#include <cstdio>
namespace cg = cooperative_groups;

#ifndef PHMASK
#define PHMASK 255
#endif
#ifndef DUPMASK
#define DUPMASK 0
#endif
#ifndef FUSED
#define FUSED 1
#endif

namespace pg8 {
#define PG8_LAS __attribute__((address_space(3)))
typedef unsigned short bf16_t;
typedef short bf16x8 __attribute__((ext_vector_type(8)));
typedef float f32x4 __attribute__((ext_vector_type(4)));
typedef unsigned u32x4 __attribute__((ext_vector_type(4)));
constexpr int BM = 256, BK = 64, HALF = 128, HTB = HALF * BK * 2  , STAGE_BYTES = 8 * HTB, NXCD = 8, WGM = 8;

__host__ __device__ __forceinline__ int lds_byte(int r, int c) { const int st = (r >> 4) * 2 + (c >> 5), rr = r & 15, cc = c & 31, ob = rr * 64 + cc * 2; return st * 1024 + (ob ^ (((ob >> 9) & 1) << 5)); }
__host__ __device__ __forceinline__ void stage_rc(int b, int& R, int& C) { const int st = b / 1024, sb = b % 1024, swz = sb ^ (((sb >> 9) & 1) << 5); R = (st >> 1) * 16 + swz / 64; C = (st & 1) * 32 + (swz % 64) / 2; }
__host__ __device__ __forceinline__ int perm32(int rho) { const int n = rho >> 4, i = rho & 15; return 8 * (i >> 2) + 4 * n + (i & 3); }

struct Unit { int pm, pn; };
struct Gemm { const bf16_t* A; const bf16_t* Bt; int M, N, K; };

struct StaticOrder {
    int nM, nN, nwg, G, c;
    __host__ __device__ void init(int M, int N, int G_, int c_) { nM = M / BM; nN = N / BM; nwg = nM * nN; G = G_; c = c_; }
    __host__ __device__ bool next(int i, Unit& u) const {
        const long L = (long)i * G + c; if (L >= nwg) return false;
        int wgid = (int)L; { const int q = nwg / NXCD, r = nwg % NXCD, xcd = wgid % NXCD, off = wgid / NXCD; wgid = (xcd < r ? xcd * (q + 1) : r * (q + 1) + (xcd - r) * q) + off; }
        const int nig = WGM * nN, gid = wgid / nig, fm = gid * WGM, gsz = (nM - fm) < WGM ? (nM - fm) : WGM;
        u.pm = fm + ((wgid % nig) % gsz); u.pn = (wgid % nig) / gsz; return true;
    }
    __device__ __forceinline__ void a_ready(const Unit&) const {}
    __device__ __forceinline__ void done(const Unit&) const {}
};

template <class Epi, class Sched, bool STAMP = false>
__device__ __forceinline__ void gemm_phase(PG8_LAS unsigned char* lds, const Gemm g, const Sched& S, const Epi& E, unsigned long long* stamps) {
    int tid = threadIdx.x; asm volatile("" : "+v"(tid));
    const int wid = __builtin_amdgcn_readfirstlane(tid >> 6), lane = tid & 63, wr = wid >> 2, wc = wid & 3, fr = lane & 15, fq = lane >> 4;
    const int K = g.K, nt = K / BK;
    int ts_lo = 0, ts_hi = 0, nts = 0; const unsigned long long rt_entry = STAMP ? (unsigned long long)wall_clock64() : 0ull;
#define PG8_STAMP() do { if (STAMP && wid == 0 && nts < 64) { const unsigned long long _c = (unsigned long long)clock64(); \
        ts_lo = (lane == nts) ? (int)(unsigned)_c : ts_lo; ts_hi = (lane == nts) ? (int)(unsigned)(_c >> 32) : ts_hi; ++nts; } } while (0)
    PG8_STAMP();
    unsigned voffA[2], voffB[2];
#pragma unroll
    for (int i = 0; i < 2; ++i) { int R, C; stage_rc(tid * 16 + i * 8192, R, C); const int Rb = Epi::PERM ? ((R & ~31) + perm32(R & 31)) : R;
        voffA[i] = (unsigned)(R * K + C) * 2u; voffB[i] = (unsigned)(Rb * K + C) * 2u; }
    const size_t kstep = (size_t)(BK * 2);
    const size_t hstep = (size_t)HALF * K * 2;
    const size_t tstep = 2 * hstep;
    const unsigned ldsw = (unsigned)wid * 1024u;
    const int aoff = lds_byte(wr * 64 + fr, fq * 8), boff = lds_byte(wc * 32 + fr, fq * 8);
#define PG8_SA(b, h) (((b) * 2 + (h)) * HTB)
#define PG8_SB(b, h) ((4 + (b) * 2 + (h)) * HTB)
#define PG8_STAGE(bufoff, gbase, voff) do { _Pragma("unroll") for (int _i = 0; _i < 2; ++_i) \
        __builtin_amdgcn_global_load_lds((const unsigned*)((const char*)(gbase) + (voff)[_i]), (PG8_LAS unsigned*)(lds + (bufoff) + ldsw + _i * 8192), 16, 0, 0); } while (0)
#define PG8_LDA(dst, b, h) do { _Pragma("unroll") for (int m = 0; m < 4; ++m) _Pragma("unroll") for (int k = 0; k < 2; ++k) dst[m][k] = *(const PG8_LAS bf16x8*)(lds + PG8_SA(b, h) + aoff + m * 2048 + k * 1024); } while (0)
#define PG8_LDB(dst, b, h) do { _Pragma("unroll") for (int n = 0; n < 2; ++n) _Pragma("unroll") for (int k = 0; k < 2; ++k) dst[n][k] = *(const PG8_LAS bf16x8*)(lds + PG8_SB(b, h) + boff + n * 2048 + k * 1024); } while (0)
#define PG8_MMA(ai, bj, At, Bt) do { __builtin_amdgcn_s_setprio(1); _Pragma("unroll") for (int m = 0; m < 4; ++m) _Pragma("unroll") for (int n = 0; n < 2; ++n) _Pragma("unroll") for (int k = 0; k < 2; ++k) \
        acc[ai][bj][m][n] = __builtin_amdgcn_mfma_f32_16x16x32_bf16(Bt[n][k], At[m][k], acc[ai][bj][m][n], 0, 0, 0); __builtin_amdgcn_s_setprio(0); } while (0)
#define PG8_WAIT_V(n) asm volatile("s_waitcnt vmcnt(" #n ")" ::: "memory")
#define PG8_WAIT_L(n) asm volatile("s_waitcnt lgkmcnt(" #n ")" ::: "memory")
#define PG8_BAR __builtin_amdgcn_s_barrier()
#define PG8_SCHED __builtin_amdgcn_sched_barrier(0)
    Unit cur, nxt; int ui = 0;
    if (!S.next(0, cur)) return;
    f32x4 acc[2][2][4][2];
#pragma unroll
    for (int a = 0; a < 2; ++a)
#pragma unroll
        for (int b = 0; b < 2; ++b)
#pragma unroll
            for (int m = 0; m < 4; ++m)
#pragma unroll
                for (int n = 0; n < 2; ++n) acc[a][b][m][n] = (f32x4){0.f, 0.f, 0.f, 0.f};
    bf16x8 At[4][2], B0[2][2], B1[2][2];
    const char* cA = (const char*)g.A + (size_t)cur.pm * tstep; const char* cB = (const char*)g.Bt + (size_t)cur.pn * tstep;
    S.a_ready(cur);
    PG8_STAGE(PG8_SB(0, 0), cB, voffB); PG8_STAGE(PG8_SA(0, 0), cA, voffA); PG8_STAGE(PG8_SB(0, 1), cB + hstep, voffB); PG8_STAGE(PG8_SA(0, 1), cA + hstep, voffA);
    if (wr == 1) PG8_BAR;
    PG8_WAIT_V(4); PG8_BAR;
    PG8_STAGE(PG8_SB(1, 0), cB + kstep, voffB); PG8_STAGE(PG8_SA(1, 0), cA + kstep, voffA); PG8_STAGE(PG8_SB(1, 1), cB + hstep + kstep, voffB);
    PG8_WAIT_V(6); PG8_BAR;
    PG8_STAMP();
    for (;;) {
        const bool has_next = S.next(ui + 1, nxt);
        const char* nA = has_next ? (const char*)g.A + (size_t)nxt.pm * tstep : cA; const char* nB = has_next ? (const char*)g.Bt + (size_t)nxt.pn * tstep : cB;
        for (int t = 0; t < nt; t += 2) {
            const bool last = (t == nt - 2);
            const char* a1 = cA + (size_t)(t + 1) * kstep;
            const char* a2 = last ? nA : cA + (size_t)(t + 2) * kstep; const char* b2 = last ? nB : cB + (size_t)(t + 2) * kstep;
            const char* a3 = a2 + kstep; const char* b3 = b2 + kstep;
            if (last && has_next) S.a_ready(nxt);
            PG8_LDB(B0, 0, 0); PG8_SCHED; PG8_LDA(At, 0, 0); PG8_STAGE(PG8_SA(1, 1), a1 + hstep, voffA);
            PG8_WAIT_L(8); PG8_BAR; PG8_WAIT_L(0); PG8_MMA(0, 0, At, B0); PG8_BAR; PG8_SCHED;
            PG8_LDB(B1, 0, 1); PG8_STAGE(PG8_SB(0, 0), b2, voffB);
            PG8_BAR; PG8_WAIT_L(0); PG8_MMA(0, 1, At, B1); PG8_BAR;
            PG8_LDA(At, 0, 1); PG8_STAGE(PG8_SA(0, 0), a2, voffA);
            PG8_BAR; PG8_WAIT_L(0); PG8_MMA(1, 0, At, B0); PG8_BAR; PG8_SCHED;
            PG8_STAGE(PG8_SB(0, 1), b2 + hstep, voffB);
            PG8_WAIT_V(6); PG8_BAR; PG8_MMA(1, 1, At, B1); PG8_BAR;
            PG8_LDB(B0, 1, 0); PG8_SCHED; PG8_LDA(At, 1, 0); PG8_STAGE(PG8_SA(0, 1), a2 + hstep, voffA);
            PG8_WAIT_L(8); PG8_BAR; PG8_WAIT_L(0); PG8_MMA(0, 0, At, B0); PG8_BAR; PG8_SCHED;
            PG8_LDB(B1, 1, 1); PG8_STAGE(PG8_SB(1, 0), b3, voffB);
            PG8_BAR; PG8_WAIT_L(0); PG8_MMA(0, 1, At, B1); PG8_BAR;
            PG8_LDA(At, 1, 1); PG8_STAGE(PG8_SA(1, 0), a3, voffA);
            PG8_BAR; PG8_WAIT_L(0); PG8_MMA(1, 0, At, B0); PG8_BAR; PG8_SCHED;
            PG8_STAGE(PG8_SB(1, 1), b3 + hstep, voffB);
            PG8_WAIT_V(6); PG8_BAR; PG8_MMA(1, 1, At, B1); PG8_BAR;
        }
        PG8_STAMP();
        if constexpr (!Epi::AFTER_DRAIN) { E(acc, cur, wr, wc, fr, fq); S.done(cur); }
        PG8_STAMP();
        if (!has_next) break;
#pragma unroll
        for (int a = 0; a < 2; ++a)
#pragma unroll
            for (int b = 0; b < 2; ++b)
#pragma unroll
                for (int m = 0; m < 4; ++m)
#pragma unroll
                    for (int n = 0; n < 2; ++n) acc[a][b][m][n] = (f32x4){0.f, 0.f, 0.f, 0.f};
        cur = nxt; cA = nA; cB = nB; ++ui;
    }
    PG8_WAIT_V(0);
    if (wr == 0) PG8_BAR;
    PG8_BAR;
    if constexpr (Epi::AFTER_DRAIN) { E.fused(acc, cur, wr, wc, fr, fq, lds, wid, lane); S.done(cur); }
    PG8_STAMP();
    if (STAMP && wid == 0) { stamps[lane] = lane < nts ? (((unsigned long long)(unsigned)ts_hi << 32) | (unsigned)ts_lo) : 0ull;
        if (lane == 62) stamps[62] = rt_entry; if (lane == 63) stamps[63] = (unsigned long long)wall_clock64(); }
#undef PG8_STAMP
#undef PG8_SA
#undef PG8_SB
#undef PG8_STAGE
#undef PG8_LDA
#undef PG8_LDB
#undef PG8_MMA
#undef PG8_WAIT_V
#undef PG8_WAIT_L
#undef PG8_BAR
#undef PG8_SCHED
}
}

typedef unsigned short u16;
typedef short bf16x8 __attribute__((ext_vector_type(8)));
typedef float f32x16 __attribute__((ext_vector_type(16)));
typedef float f32x4 __attribute__((ext_vector_type(4)));
typedef __bf16 bf2_t __attribute__((ext_vector_type(2)));
typedef float f2_t __attribute__((ext_vector_type(2)));
typedef unsigned u32x4 __attribute__((ext_vector_type(4)));
typedef unsigned u32x2 __attribute__((ext_vector_type(2)));
using pg8::Unit;

#define DI __device__ __forceinline__
#define MFMA32(a, b, c) __builtin_amdgcn_mfma_f32_32x32x16_bf16((a), (b), (c), 0, 0, 0)

constexpr int DM = 1024, SEQ = 4096, NBATCH = 8, T = NBATCH * SEQ;
constexpr int NCH = 2, BC = NBATCH / NCH, TC = BC * SEQ;
constexpr int INC = 7552, DMLP = 4096;
constexpr int NQKG = 6656;
constexpr int NQKH = 38, NVH = 16;
constexpr float LOG2E = 1.4426950408889634f;
constexpr int NTHR = 512;

constexpr size_t al256(size_t x) { return (x + 255) & ~(size_t)255; }
constexpr size_t OFF_WQKG = 0;
constexpr size_t OFF_WV   = OFF_WQKG + al256((size_t)2 * NQKG * DM * 2);
constexpr size_t OFF_WBA  = OFF_WV   + al256((size_t)2 * DM * DM * 2);
constexpr size_t OFF_WBB  = OFF_WBA  + al256((size_t)2 * DM * 512 * 2);
constexpr size_t OFF_WBC  = OFF_WBB  + al256((size_t)2 * DM * 256 * 2);
constexpr size_t OFF_WBD  = OFF_WBC  + al256((size_t)2 * DM * 256 * 2);
constexpr size_t OFF_WOUT = OFF_WBD  + al256((size_t)2 * DM * 256 * 2);
constexpr size_t OFF_WUP  = OFF_WOUT + al256((size_t)2 * DM * DM * 2);
constexpr size_t OFF_WDN  = OFF_WUP  + al256((size_t)2 * DMLP * DM * 2);
constexpr size_t OFF_ROPE = OFF_WDN  + al256((size_t)2 * DM * DMLP * 2);
constexpr size_t OFF_XB   = OFF_ROPE + al256((size_t)SEQ * 96 * 4);
constexpr size_t OFF_SSQ  = OFF_XB   + al256((size_t)T * DM * 2);
constexpr size_t OFF_QK   = OFF_SSQ  + al256((size_t)T * 16 * 4);
constexpr size_t OFF_V    = OFF_QK   + al256((size_t)NQKH * TC * 64 * 2);
constexpr size_t OFF_GATE = OFF_V    + al256((size_t)NVH * TC * 64 * 2);
constexpr size_t OFF_YA   = OFF_GATE + al256((size_t)TC * 4096 * 2);
constexpr size_t OFF_YB   = OFF_YA   + al256((size_t)TC * 512 * 2);
constexpr size_t OFF_YC   = OFF_YB   + al256((size_t)TC * 256 * 2);
constexpr size_t OFF_YD   = OFF_YC   + al256((size_t)TC * 256 * 2);
constexpr size_t OFF_BO   = OFF_YD   + al256((size_t)TC * 256 * 2);
constexpr size_t OFF_LSE  = OFF_BO   + al256((size_t)TC * 384 * 2);
constexpr size_t OFF_MRG  = OFF_LSE  + al256((size_t)TC * 8 * 4);
constexpr size_t OFF_BAR  = OFF_MRG  + al256((size_t)TC * DM * 2);
constexpr size_t WS_END   = OFF_BAR  + 16384;
constexpr size_t OFF_MRGF = OFF_QK;
static_assert((size_t)TC * DM * 4 <= (size_t)NQKH * TC * 64 * 2, "MRGF alias too large");
static_assert(WS_END <= (size_t)512 * 1024 * 1024, "workspace too large");

constexpr int LDS_STAGE = 131072;
constexpr int LDS_BYTES = LDS_STAGE + 64;
constexpr int NPHASE = 1 + NCH * 2 * 7;

struct Params {
  const float* in[19];
  float* out;
  unsigned char* ws;
  int ph_lo, ph_hi;
};

DI unsigned pk2(float a, float b) { f2_t v = {a, b}; bf2_t r = __builtin_convertvector(v, bf2_t); return __builtin_bit_cast(unsigned, r); }
DI float bf_lo(unsigned u) { return __uint_as_float(u << 16); }
DI float bf_hi(unsigned u) { return __uint_as_float(u & 0xffff0000u); }
DI float fexp2(float x) { return __builtin_amdgcn_exp2f(x); }
DI int crow(int i, int h) { return (i & 3) + 8 * (i >> 2) + 4 * h; }
DI bf16x8 as_bf8(u32x4 v) { return __builtin_bit_cast(bf16x8, v); }
DI int dil_of(int gi) { return gi == 0 ? 1 : (gi == 1 ? 4 : 16); }
DI int dlg_of(int gi) { return gi * 2; }
DI float row_rscale(const float* ssq, size_t tok) {
  const f32x4 a = *(const f32x4*)(ssq + tok * 16), b = *(const f32x4*)(ssq + tok * 16 + 4);
  const f32x4 c = *(const f32x4*)(ssq + tok * 16 + 8), d = *(const f32x4*)(ssq + tok * 16 + 12);
  const float s = ((a[0] + a[1]) + (a[2] + a[3])) + ((b[0] + b[1]) + (b[2] + b[3])) + ((c[0] + c[1]) + (c[2] + c[3])) + ((d[0] + d[1]) + (d[2] + d[3]));
  return rsqrtf(s * (1.0f / 1024.0f) + 1e-6f);
}
DI int qk_head_col(int h) {
  if (h < 8) return 64 * h;
  if (h < 10) return 512 + 64 * (h - 8);
  if (h < 16) return 768 + 64 * (h - 10);
  if (h < 22) return 1152 + 64 * (h - 16);
  if (h < 26) return 1920 + 64 * (h - 22);
  if (h < 30) return 2176 + 64 * (h - 26);
  if (h < 34) return 2688 + 64 * (h - 30);
  return 2944 + 64 * (h - 34);
}
DI int v_head_col(int vh) {
  if (vh < 2) return 640 + 64 * vh;
  if (vh < 8) return 1536 + 64 * (vh - 2);
  if (vh < 12) return 2432 + 64 * (vh - 8);
  return 3200 + 64 * (vh - 12);
}

struct EpiQKG {
  static constexpr bool PERM = false, AFTER_DRAIN = false;
  const float* ssq; u16* qk; const float* rope; const float* gA; const float* gB; const float* gC; const float* gD;
  DI void operator()(const f32x4 (&acc)[2][2][4][2], const Unit& u, int wr, int wc, int fr, int fq) const {
    const int hidx = u.pn * 4 + wc;
    if (hidx >= NQKH) return;
    int kind, dlg = 0; const float* gain;
    if (hidx < 8) { kind = 0; gain = gA; }
    else if (hidx < 10) { kind = 0; gain = gA + 64; }
    else if (hidx < 16) { kind = 0; gain = gB; dlg = dlg_of((hidx - 10) >> 1); }
    else if (hidx < 22) { kind = 0; gain = gB + 64; dlg = dlg_of((hidx - 16) >> 1); }
    else if (hidx < 26) { kind = 2; gain = gC; }
    else if (hidx < 30) { kind = 2; gain = gC + 32; }
    else if (hidx < 34) { kind = 1; gain = gD; }
    else { kind = 1; gain = gD + 64; }
    u16* gbase = qk + (size_t)hidx * TC * 64;
    const float* gainl = gain + 4 * fq;
#pragma unroll
    for (int ai = 0; ai < 2; ++ai)
#pragma unroll
      for (int m = 0; m < 4; ++m) {
        const int tok = u.pm * 256 + 128 * ai + 64 * wr + 16 * m + fr;
        const int bl = tok >> 12, pos = tok & 4095;
        const float rs = row_rscale(ssq, tok);
        const int pdom = ((pos & ((1 << dlg) - 1)) << (12 - dlg)) + (pos >> dlg);
        const int blk = pdom >> 5, rr = pdom & 31;
        u16* base = gbase + (size_t)bl * SEQ * 64;
        if (kind != 2) {
          float ss = 0.f;
#pragma unroll
          for (int bj = 0; bj < 2; ++bj)
#pragma unroll
            for (int n = 0; n < 2; ++n)
#pragma unroll
              for (int e = 0; e < 4; ++e) ss += acc[ai][bj][m][n][e] * acc[ai][bj][m][n][e];
          ss += __shfl_xor(ss, 16); ss += __shfl_xor(ss, 32);
          const float sc = rs * rsqrtf(ss * rs * rs * (1.0f / 64.0f) + 1e-6f);
#pragma unroll
          for (int n = 0; n < 2; ++n) {
            f32x4 xa = acc[ai][0][m][n] * sc * *(const f32x4*)(gainl + 16 * n);
            f32x4 xb2 = acc[ai][1][m][n] * sc * *(const f32x4*)(gainl + 32 + 16 * n);
            if (kind == 0) {
              const f32x4 c4 = *(const f32x4*)(rope + pos * 96 + 16 * n + 4 * fq);
              const f32x4 s4 = *(const f32x4*)(rope + pos * 96 + 32 + 16 * n + 4 * fq);
              const f32x4 ta = xa * c4 - xb2 * s4, tb = xb2 * c4 + xa * s4;
              xa = ta; xb2 = tb;
            }
            u32x2 w0 = {pk2(xa[0], xa[1]), pk2(xa[2], xa[3])};
            *(u32x2*)(base + ((size_t)(blk * 4 + n) * 64 + (fq >> 1) * 32 + rr) * 8 + 4 * (fq & 1)) = w0;
            u32x2 w1 = {pk2(xb2[0], xb2[1]), pk2(xb2[2], xb2[3])};
            *(u32x2*)(base + ((size_t)(blk * 4 + 2 + n) * 64 + (fq >> 1) * 32 + rr) * 8 + 4 * (fq & 1)) = w1;
          }
        } else {
          const f32x4 c4 = *(const f32x4*)(rope + pos * 96 + 64 + 4 * fq);
          const f32x4 s4 = *(const f32x4*)(rope + pos * 96 + 80 + 4 * fq);
#pragma unroll
          for (int bj = 0; bj < 2; ++bj) {
            float ss = 0.f;
#pragma unroll
            for (int n = 0; n < 2; ++n)
#pragma unroll
              for (int e = 0; e < 4; ++e) ss += acc[ai][bj][m][n][e] * acc[ai][bj][m][n][e];
            ss += __shfl_xor(ss, 16); ss += __shfl_xor(ss, 32);
            const float sc = rs * rsqrtf(ss * rs * rs * (1.0f / 32.0f) + 1e-6f);
            const f32x4 xa = acc[ai][bj][m][0] * sc * *(const f32x4*)(gainl);
            const f32x4 xb2 = acc[ai][bj][m][1] * sc * *(const f32x4*)(gainl + 16);
            const f32x4 ta = xa * c4 - xb2 * s4, tb = xb2 * c4 + xa * s4;
            u16* sb = base + (size_t)bj * SEQ * 32;
            u32x2 w0 = {pk2(ta[0], ta[1]), pk2(ta[2], ta[3])};
            *(u32x2*)(sb + ((size_t)(blk * 2 + 0) * 64 + (fq >> 1) * 32 + rr) * 8 + 4 * (fq & 1)) = w0;
            u32x2 w1 = {pk2(tb[0], tb[1]), pk2(tb[2], tb[3])};
            *(u32x2*)(sb + ((size_t)(blk * 2 + 1) * 64 + (fq >> 1) * 32 + rr) * 8 + 4 * (fq & 1)) = w1;
          }
        }
        asm volatile("" ::: "memory");
      }
  }
};

struct EpiGate {
  static constexpr bool PERM = false, AFTER_DRAIN = false;
  const float* ssq; u16* gate;
  DI void operator()(const f32x4 (&acc)[2][2][4][2], const Unit& u, int wr, int wc, int fr, int fq) const {
    {
      const int c0 = u.pn * 256 + 32 * wc + 4 * fq;
#pragma unroll
      for (int ai = 0; ai < 2; ++ai)
#pragma unroll
        for (int m = 0; m < 4; ++m) {
          const size_t tok = (size_t)u.pm * 256 + 128 * ai + 64 * wr + 16 * m + fr;
          const float rs = row_rscale(ssq, tok);
#pragma unroll
          for (int bj = 0; bj < 2; ++bj)
#pragma unroll
            for (int n = 0; n < 2; ++n) {
              const f32x4 v = acc[ai][bj][m][n] * rs;
              float o[4];
#pragma unroll
              for (int e = 0; e < 4; ++e) o[e] = 1.0f / (1.0f + __expf(-v[e]));
              u32x2 w = {pk2(o[0], o[1]), pk2(o[2], o[3])};
              *(u32x2*)(gate + tok * 4096 + c0 + 128 * bj + 16 * n) = w;
            }
          asm volatile("" ::: "memory");
        }
    }
  }
};

struct EpiVT {
  static constexpr bool PERM = false, AFTER_DRAIN = false;
  const float* ssq; u16* vbuf;
  DI void operator()(const f32x4 (&acc)[2][2][4][2], const Unit& u, int wr, int wc, int fr, int fq) const {
    f32x4 rs4[2][2];
#pragma unroll
    for (int bj = 0; bj < 2; ++bj)
#pragma unroll
      for (int n = 0; n < 2; ++n) {
        const size_t t0 = (size_t)u.pn * 256 + 128 * bj + 32 * wc + 16 * n + 4 * fq;
#pragma unroll
        for (int e = 0; e < 4; ++e) { rs4[bj][n][e] = row_rscale(ssq, t0 + e); asm volatile("" ::: "memory"); }
      }
#pragma unroll
    for (int ai = 0; ai < 2; ++ai) {
      const int vgrp = u.pm * 4 + 2 * ai + wr;
      const int dlg = (vgrp >= 2 && vgrp < 8) ? dlg_of((vgrp - 2) >> 1) : 0;
      u16* gbase = vbuf + (size_t)vgrp * TC * 64;
      const int bl = (u.pn * 256) >> 12;
      u16* base = gbase + (size_t)bl * SEQ * 64;
      const unsigned es = (dlg == 0) ? 1u : (unsigned)(128 >> dlg) * 2048u;
#pragma unroll
      for (int m = 0; m < 4; ++m) {
        const int dv = 16 * m + fr;
        const unsigned dvo = (unsigned)((dv >> 5) * 1024 + (dv & 31) * 8);
#pragma unroll
        for (int bj = 0; bj < 2; ++bj)
#pragma unroll
          for (int n = 0; n < 2; ++n) {
            const int pos0 = (u.pn * 256 + 128 * bj + 32 * wc + 16 * n + 4 * fq) & 4095;
            const f32x4 v = acc[ai][bj][m][n] * rs4[bj][n];
            const int pd0 = ((pos0 & ((1 << dlg) - 1)) << (12 - dlg)) + (pos0 >> dlg);
            const int blk = pd0 >> 5, key = pd0 & 31;
            const unsigned off = (unsigned)blk * 2048u + (unsigned)(key >> 4) * 512u + (unsigned)((key >> 2) & 1) * 256u + dvo + 4u * ((key >> 3) & 1);
            const unsigned w0 = pk2(v[0], v[1]), w1 = pk2(v[2], v[3]);
            const unsigned o2 = off + (key & 3);
            base[o2] = (u16)(w0 & 0xffffu); base[o2 + es] = (u16)(w0 >> 16); base[o2 + 2 * es] = (u16)(w1 & 0xffffu); base[o2 + 3 * es] = (u16)(w1 >> 16);
            asm volatile("" ::: "memory");
          }
      }
    }
  }
};

template <int SEG> struct EpiMerge {
  static constexpr bool PERM = false, AFTER_DRAIN = false;
  const u16* gate; float* mrgf; u16* mrg;
  DI void operator()(const f32x4 (&acc)[2][2][4][2], const Unit& u, int wr, int wc, int fr, int fq) const {
#pragma unroll
    for (int ai = 0; ai < 2; ++ai)
#pragma unroll
      for (int m = 0; m < 4; ++m) {
        const size_t tok = (size_t)u.pm * 256 + 128 * ai + 64 * wr + 16 * m + fr;
#pragma unroll
        for (int bj = 0; bj < 2; ++bj)
#pragma unroll
          for (int n = 0; n < 2; ++n) {
            const int c = u.pn * 256 + 128 * bj + 32 * wc + 16 * n + 4 * fq;
            const u32x2 g = *(const u32x2*)(gate + tok * 4096 + SEG * 1024 + c);
            f32x4 v = acc[ai][bj][m][n];
            v[0] *= bf_lo(g[0]); v[1] *= bf_hi(g[0]); v[2] *= bf_lo(g[1]); v[3] *= bf_hi(g[1]);
            if (SEG > 0) v += *(const f32x4*)(mrgf + tok * DM + c);
            if (SEG < 3) *(f32x4*)(mrgf + tok * DM + c) = v;
            else { u32x2 w = {pk2(v[0], v[1]), pk2(v[2], v[3])}; *(u32x2*)(mrg + tok * DM + c) = w; }
            asm volatile("" ::: "memory");
          }
        asm volatile("" ::: "memory");
      }
  }
};

struct EpiResid {
  static constexpr bool PERM = false, AFTER_DRAIN = false;
  const float* xold; float* xout; u16* xb; float* ssq;
  DI void operator()(const f32x4 (&acc)[2][2][4][2], const Unit& u, int wr, int wc, int fr, int fq) const {
#pragma unroll
    for (int ai = 0; ai < 2; ++ai)
#pragma unroll
      for (int m = 0; m < 4; ++m) {
        const size_t tok = (size_t)u.pm * 256 + 128 * ai + 64 * wr + 16 * m + fr;
        float ss = 0.f;
#pragma unroll
        for (int bj = 0; bj < 2; ++bj)
#pragma unroll
          for (int n = 0; n < 2; ++n) {
            const size_t o = tok * DM + u.pn * 256 + 128 * bj + 32 * wc + 16 * n + 4 * fq;
            f32x4 v = *(const f32x4*)(xold + o) + acc[ai][bj][m][n];
            *(f32x4*)(xout + o) = v;
            u32x2 w = {pk2(v[0], v[1]), pk2(v[2], v[3])};
            *(u32x2*)(xb + o) = w;
            ss += (v[0] * v[0] + v[1] * v[1]) + (v[2] * v[2] + v[3] * v[3]);
          }
        ss += __shfl_xor(ss, 16); ss += __shfl_xor(ss, 32);
        if (fq == 0) ssq[tok * 16 + u.pn * 4 + wc] = ss;
        asm volatile("" ::: "memory");
      }
  }
};

struct EpiUp {
  static constexpr bool PERM = false, AFTER_DRAIN = false;
  const float* ssq; u16* uo;
  DI void operator()(const f32x4 (&acc)[2][2][4][2], const Unit& u, int wr, int wc, int fr, int fq) const {
#pragma unroll
    for (int ai = 0; ai < 2; ++ai)
#pragma unroll
      for (int m = 0; m < 4; ++m) {
        const size_t tok = (size_t)u.pm * 256 + 128 * ai + 64 * wr + 16 * m + fr;
        const float rs = row_rscale(ssq, tok);
#pragma unroll
        for (int bj = 0; bj < 2; ++bj)
#pragma unroll
          for (int n = 0; n < 2; ++n) {
            const f32x4 v = acc[ai][bj][m][n] * rs;
            float o[4];
#pragma unroll
            for (int e = 0; e < 4; ++e) { const float z = fmaxf(v[e], 0.f); o[e] = z * z; }
            u32x2 w = {pk2(o[0], o[1]), pk2(o[2], o[3])};
            *(u32x2*)(uo + tok * DMLP + u.pn * 256 + 128 * bj + 32 * wc + 16 * n + 4 * fq) = w;
          }
        asm volatile("" ::: "memory");
      }
  }
};

template <class Epi>
DI void run_gemm(PG8_LAS unsigned char* lds, const u16* A, const u16* Bt, int M, int N, int K, const Epi& E) {
  asm volatile("" : "+s"(K));
  pg8::Gemm g; g.A = A; g.Bt = Bt; g.M = M; g.N = N; g.K = K;
  pg8::StaticOrder S; S.init(M, N, (int)gridDim.x, (int)blockIdx.x);
  pg8::gemm_phase<Epi, pg8::StaticOrder, false>(lds, g, S, E, nullptr);
}

DI void cvt_load(const float* __restrict__ src, int N, int k0, int n0, const float* __restrict__ g, float* t, int ht) {
  const int c4 = (ht & 15) * 4;
#pragma unroll
  for (int i = 0; i < 4; ++i) {
    const int kk = (ht >> 4) + 16 * i;
    f32x4 v = *(const f32x4*)(src + (size_t)(k0 + kk) * N + n0 + c4);
    const float sc = g ? g[k0 + kk] : 1.0f;
    t[kk * 65 + c4 + 0] = v[0] * sc; t[kk * 65 + c4 + 1] = v[1] * sc; t[kk * 65 + c4 + 2] = v[2] * sc; t[kk * 65 + c4 + 3] = v[3] * sc;
  }
}
DI void cvt_store(u16* __restrict__ dst, int ldk, int kdst, int d0, int d1, const float* t, int ht) {
  const int kc = (ht & 7) * 8, nn = ht >> 3;
#pragma unroll
  for (int i = 0; i < 2; ++i) {
    const int tn = nn + 32 * i, row = (i == 0) ? d0 + nn : d1 + nn;
    u32x4 w;
    w[0] = pk2(t[(kc + 0) * 65 + tn], t[(kc + 1) * 65 + tn]);
    w[1] = pk2(t[(kc + 2) * 65 + tn], t[(kc + 3) * 65 + tn]);
    w[2] = pk2(t[(kc + 4) * 65 + tn], t[(kc + 5) * 65 + tn]);
    w[3] = pk2(t[(kc + 6) * 65 + tn], t[(kc + 7) * 65 + tn]);
    *(u32x4*)(dst + (size_t)row * ldk + kdst + kc) = w;
  }
}
struct CvtJob { const float* src; int N, k0, n0; const float* g; u16* dst; int ldk, d0, d1; };
DI CvtJob cvt_job(const Params& p, int l, int ti) {
  CvtJob j; j.g = nullptr;
  const float* attn_g = p.in[1] + l * DM;
  if (ti < 608) { const int h = ti >> 4, kt = ti & 15; j.src = p.in[2] + (size_t)l * DM * INC; j.N = INC; j.k0 = kt * 64; j.n0 = qk_head_col(h); j.g = attn_g;
    j.dst = (u16*)(p.ws + OFF_WQKG) + (size_t)l * NQKG * DM; j.ldk = DM; j.d0 = (h >> 2) * 256 + (h & 3) * 32; j.d1 = j.d0 + 128; return j; }
  ti -= 608;
  if (ti < 1024) { const int c = ti >> 4, kt = ti & 15; j.src = p.in[2] + (size_t)l * DM * INC; j.N = INC; j.k0 = kt * 64; j.n0 = 3456 + 64 * c; j.g = attn_g;
    j.dst = (u16*)(p.ws + OFF_WQKG) + (size_t)l * NQKG * DM; j.ldk = DM; j.d0 = 2560 + 64 * c; j.d1 = j.d0 + 32; return j; }
  ti -= 1024;
  if (ti < 256) { const int vh = ti >> 4, kt = ti & 15; j.src = p.in[2] + (size_t)l * DM * INC; j.N = INC; j.k0 = kt * 64; j.n0 = v_head_col(vh); j.g = attn_g;
    j.dst = (u16*)(p.ws + OFF_WV) + (size_t)l * DM * DM; j.ldk = DM; j.d0 = vh * 64; j.d1 = j.d0 + 32; return j; }
  ti -= 256;
  if (ti < 128) { j.src = p.in[11] + (size_t)l * 512 * DM; j.N = DM; j.k0 = (ti >> 4) * 64; j.n0 = (ti & 15) * 64; j.dst = (u16*)(p.ws + OFF_WBA) + (size_t)l * DM * 512; j.ldk = 512; j.d0 = j.n0; j.d1 = j.n0 + 32; return j; }
  ti -= 128;
  if (ti < 32) { j.src = p.in[12] + (size_t)l * 128 * DM; j.N = DM; j.k0 = (ti >> 4) * 64; j.n0 = (ti & 15) * 64; j.dst = (u16*)(p.ws + OFF_WBB) + (size_t)l * DM * 256; j.ldk = 256; j.d0 = j.n0; j.d1 = j.n0 + 32; return j; }
  ti -= 32;
  if (ti < 64) { j.src = p.in[13] + (size_t)l * 256 * DM; j.N = DM; j.k0 = (ti >> 4) * 64; j.n0 = (ti & 15) * 64; j.dst = (u16*)(p.ws + OFF_WBC) + (size_t)l * DM * 256; j.ldk = 256; j.d0 = j.n0; j.d1 = j.n0 + 32; return j; }
  ti -= 64;
  if (ti < 64) { j.src = p.in[14] + (size_t)l * 256 * DM; j.N = DM; j.k0 = (ti >> 4) * 64; j.n0 = (ti & 15) * 64; j.dst = (u16*)(p.ws + OFF_WBD) + (size_t)l * DM * 256; j.ldk = 256; j.d0 = j.n0; j.d1 = j.n0 + 32; return j; }
  ti -= 64;
  if (ti < 256) { j.src = p.in[15] + (size_t)l * DM * DM; j.N = DM; j.k0 = (ti >> 4) * 64; j.n0 = (ti & 15) * 64; j.dst = (u16*)(p.ws + OFF_WOUT) + (size_t)l * DM * DM; j.ldk = DM; j.d0 = j.n0; j.d1 = j.n0 + 32; return j; }
  ti -= 256;
  if (ti < 1024) { j.src = p.in[17] + (size_t)l * DM * DMLP; j.N = DMLP; j.k0 = (ti >> 6) * 64; j.n0 = (ti & 63) * 64; j.g = p.in[16] + l * DM;
    j.dst = (u16*)(p.ws + OFF_WUP) + (size_t)l * DMLP * DM; j.ldk = DM; j.d0 = j.n0; j.d1 = j.n0 + 32; return j; }
  ti -= 1024;
  j.src = p.in[18] + (size_t)l * DMLP * DM; j.N = DM; j.k0 = (ti >> 4) * 64; j.n0 = (ti & 15) * 64; j.dst = (u16*)(p.ws + OFF_WDN) + (size_t)l * DM * DMLP; j.ldk = DMLP; j.d0 = j.n0; j.d1 = j.n0 + 32; return j;
}

__device__ void phase_prep(const Params& p, int tid_, int bid_, int nblk_, unsigned char* smem) {
  const int half = tid_ >> 8, ht = tid_ & 255;
  float* t = (float*)smem + half * (64 * 65);
  const int per_layer = 4480, total = 2 * per_layer;
  for (int jp = bid_; jp * 2 < total; jp += nblk_) {
    const int j = jp * 2 + half;
    const bool on = j < total;
    CvtJob job;
    if (on) { job = cvt_job(p, j / per_layer, j % per_layer); cvt_load(job.src, job.N, job.k0, job.n0, job.g, t, ht); }
    __syncthreads();
    if (on) cvt_store(job.dst, job.ldk, job.k0, job.d0, job.d1, t, ht);
    __syncthreads();
  }
  {
    const u32x4 z = {0u, 0u, 0u, 0u};
    for (int e = bid_ * NTHR + tid_; e < 2 * 128 * 128; e += nblk_ * NTHR) {
      const int l = e >> 14, r = (e >> 7) & 127, c = (e & 127) * 8;
      const int row = 9 * 256 + ((r < 64) ? 64 + r : 128 + r);
      *(u32x4*)((u16*)(p.ws + OFF_WQKG) + ((size_t)l * NQKG + row) * DM + c) = z;
    }
    for (int e = bid_ * NTHR + tid_; e < 2 * 1024 * 16; e += nblk_ * NTHR) {
      const int l = e >> 14, r = (e >> 4) & 1023, c = 128 + (e & 15) * 8;
      *(u32x4*)((u16*)(p.ws + OFF_WBB) + ((size_t)l * DM + r) * 256 + c) = z;
    }
  }
  float* rope = (float*)(p.ws + OFF_ROPE);
  for (int e = bid_ * NTHR + tid_; e < SEQ * 48; e += nblk_ * NTHR) {
    const int pos = e / 48, i = e % 48;
    float inv;
    if (i < 32) inv = exp2f(-13.287712379549449f * (float)(2 * i) / 64.0f);
    else inv = exp2f(-13.287712379549449f * (float)(2 * (i - 32)) / 32.0f);
    const float angf = (float)pos * inv;
    const double ang = (double)angf;
    const double n = rint(ang * 0.15915494309189535);
    const float r = (float)(ang - n * 6.283185307179586);
    const float c = cosf(r), s = sinf(r);
    if (i < 32) { rope[pos * 96 + i] = c; rope[pos * 96 + 32 + i] = s; }
    else { rope[pos * 96 + 64 + (i - 32)] = c; rope[pos * 96 + 80 + (i - 32)] = s; }
  }
  u16* XB = (u16*)(p.ws + OFF_XB); float* SSQ = (float*)(p.ws + OFF_SSQ);
  const int lane = tid_ & 63;
  const int gw = bid_ * 8 + (tid_ >> 6), nw = nblk_ * 8;
  for (int row = gw; row < T; row += nw) {
    const float* xr = p.in[0] + (size_t)row * DM;
    float ss = 0.f;
#pragma unroll
    for (int i = 0; i < 4; ++i) {
      const f32x4 v = *(const f32x4*)(xr + i * 256 + lane * 4);
      ss += v[0] * v[0] + v[1] * v[1] + v[2] * v[2] + v[3] * v[3];
      u32x2 w = {pk2(v[0], v[1]), pk2(v[2], v[3])};
      *(u32x2*)(XB + (size_t)row * DM + i * 256 + lane * 4) = w;
    }
#pragma unroll
    for (int o = 32; o >= 1; o >>= 1) ss += __shfl_xor(ss, o);
    if (lane < 16) SSQ[(size_t)row * 16 + lane] = (lane == 0) ? ss : 0.f;
  }
}

DI void attn_softmax_pv(f32x16& S, float& m, float& l, f32x16& O0, f32x16& O1, const bf16x8 (&vf)[2][2]) {
  float mx = S[0];
#pragma unroll
  for (int i = 1; i < 16; ++i) mx = fmaxf(mx, S[i]);
  mx = fmaxf(mx, __shfl_xor(mx, 32));
  const float mn = fmaxf(m, mx);
  const float alpha = fexp2(m - mn);
  m = mn;
  float sum = 0.f;
#pragma unroll
  for (int i = 0; i < 16; ++i) { S[i] = fexp2(S[i] - mn); sum += S[i]; }
  l = l * alpha + sum;
  const u32x4 p0 = {pk2(S[0], S[1]), pk2(S[2], S[3]), pk2(S[4], S[5]), pk2(S[6], S[7])};
  const u32x4 p1 = {pk2(S[8], S[9]), pk2(S[10], S[11]), pk2(S[12], S[13]), pk2(S[14], S[15])};
#pragma unroll
  for (int i = 0; i < 16; ++i) { O0[i] *= alpha; O1[i] *= alpha; }
  O0 = MFMA32(vf[0][0], as_bf8(p0), O0);
  O0 = MFMA32(vf[0][1], as_bf8(p1), O0);
  O1 = MFMA32(vf[1][0], as_bf8(p0), O1);
  O1 = MFMA32(vf[1][1], as_bf8(p1), O1);
}
DI void load_vf(bf16x8 (&vf)[2][2], const u16* V, int kb, int lane) {
#pragma unroll
  for (int rb = 0; rb < 2; ++rb)
#pragma unroll
    for (int s = 0; s < 2; ++s) vf[rb][s] = *(const bf16x8*)(V + ((size_t)((kb * 2 + rb) * 2 + s) * 64 + lane) * 8);
}
DI void load_kf4(bf16x8 (&kf)[4], const u16* K, int kb, int lane) {
#pragma unroll
  for (int s = 0; s < 4; ++s) kf[s] = *(const bf16x8*)(K + ((size_t)(kb * 4 + s) * 64 + lane) * 8);
}
DI void load_kf2(bf16x8 (&kf)[2], const u16* K, int kb, int lane) {
#pragma unroll
  for (int s = 0; s < 2; ++s) kf[s] = *(const bf16x8*)(K + ((size_t)(kb * 2 + s) * 64 + lane) * 8);
}
DI void zero16(f32x16& a) {
#pragma unroll
  for (int i = 0; i < 16; ++i) a[i] = 0.f;
}
DI void store_o(u16* yrow, const f32x16& O0, const f32x16& O1, float sc, int h) {
#pragma unroll
  for (int g4 = 0; g4 < 4; ++g4) {
    u32x2 w0 = {pk2(O0[4 * g4] * sc, O0[4 * g4 + 1] * sc), pk2(O0[4 * g4 + 2] * sc, O0[4 * g4 + 3] * sc)};
    *(u32x2*)(yrow + 8 * g4 + 4 * h) = w0;
    u32x2 w1 = {pk2(O1[4 * g4] * sc, O1[4 * g4 + 1] * sc), pk2(O1[4 * g4 + 2] * sc, O1[4 * g4 + 3] * sc)};
    *(u32x2*)(yrow + 32 + 8 * g4 + 4 * h) = w1;
  }
}

__device__ void phase_attn(const Params& p, int tid_, int bid_, int nblk_, int layer) {
  const u16* QK = (const u16*)(p.ws + OFF_QK);
  const u16* VB = (const u16*)(p.ws + OFF_V);
  u16* YA = (u16*)(p.ws + OFF_YA); u16* YCc = (u16*)(p.ws + OFF_YC); u16* YD = (u16*)(p.ws + OFF_YD);
  u16* BO = (u16*)(p.ws + OFF_BO);
  float* LSE = (float*)(p.ws + OFF_LSE);
  const int lane = tid_ & 63, wave = tid_ >> 6;
  const int fr = lane & 31, fh = lane >> 5;
  const int nloc = nblk_ >> 3;
  if ((int)(bid_ >> 3) >= nloc) return;
  const int vw = ((bid_ & 7) * nloc + (bid_ >> 3)) * 8 + wave, NW = nloc * 64;
  const size_t GS = (size_t)TC * 64;
  const size_t BS = (size_t)SEQ * 64;

  {
    const float* lp = p.in[7] + layer * 128;
    float d01 = 0.f, d23 = 0.f;
    for (int i = 0; i < 32; ++i) { d01 += lp[i] * lp[32 + i]; d23 += lp[64 + i] * lp[96 + i]; }
    const float lambda_init = (layer == 0) ? 0.2f : 0.35550907f;
    const float lam = __expf(d01) - __expf(d23) + lambda_init;
    const float* subg = p.in[8] + layer * 64;
    const float sc = 0.17677669529663687f * LOG2E;
    for (int it = vw; it < BC * 4 * 128; it += NW) {
      const int bl = it >> 9, head = (it >> 7) & 3, qblk = it & 127;
      const u16* Q0 = QK + (22 + head) * GS + bl * BS; const u16* Q1 = Q0 + SEQ * 32;
      const u16* K0 = QK + (26 + head) * GS + bl * BS; const u16* K1 = K0 + SEQ * 32;
      const u16* V = VB + (8 + head) * GS + bl * BS;
      bf16x8 q0[2], q1[2];
      load_kf2(q0, Q0, qblk, lane); load_kf2(q1, Q1, qblk, lane);
      float m0 = -1e30f, l0 = 0.f, m1 = -1e30f, l1 = 0.f;
      f32x16 O00, O01, O10, O11; zero16(O00); zero16(O01); zero16(O10); zero16(O11);
      bf16x8 k0[2], k1[2], vf[2][2];
      load_kf2(k0, K0, 0, lane); load_kf2(k1, K1, 0, lane); load_vf(vf, V, 0, lane);
      for (int kb = 0; kb < 128; ++kb) {
        bf16x8 nk0[2], nk1[2], nvf[2][2];
        const int kn = (kb + 1 < 128) ? kb + 1 : kb;
        load_kf2(nk0, K0, kn, lane); load_kf2(nk1, K1, kn, lane); load_vf(nvf, V, kn, lane);
        f32x16 S0, S1; zero16(S0); zero16(S1);
        S0 = MFMA32(k0[0], q0[0], S0); S0 = MFMA32(k0[1], q0[1], S0);
        S1 = MFMA32(k1[0], q1[0], S1); S1 = MFMA32(k1[1], q1[1], S1);
#pragma unroll
        for (int i = 0; i < 16; ++i) { S0[i] *= sc; S1[i] *= sc; }
        attn_softmax_pv(S0, m0, l0, O00, O01, vf);
        attn_softmax_pv(S1, m1, l1, O10, O11, vf);
#pragma unroll
        for (int s = 0; s < 2; ++s) { k0[s] = nk0[s]; k1[s] = nk1[s]; vf[0][s] = nvf[0][s]; vf[1][s] = nvf[1][s]; }
      }
      const float i0 = 1.0f / (l0 + __shfl_xor(l0, 32));
      const float i1 = lam / (l1 + __shfl_xor(l1, 32));
      float ss = 0.f;
#pragma unroll
      for (int i = 0; i < 16; ++i) {
        O00[i] = O00[i] * i0 - O10[i] * i1; O01[i] = O01[i] * i0 - O11[i] * i1;
        ss += O00[i] * O00[i] + O01[i] * O01[i];
      }
      ss += __shfl_xor(ss, 32);
      const float rn = rsqrtf(ss * (1.0f / 64.0f) + 1e-6f) * (1.0f - lambda_init);
#pragma unroll
      for (int g4 = 0; g4 < 4; ++g4) {
        const f32x4 ga = *(const f32x4*)(subg + 8 * g4 + 4 * fh);
        const f32x4 gb = *(const f32x4*)(subg + 32 + 8 * g4 + 4 * fh);
#pragma unroll
        for (int e = 0; e < 4; ++e) { O00[4 * g4 + e] *= ga[e]; O01[4 * g4 + e] *= gb[e]; }
      }
      const size_t tok = (size_t)bl * SEQ + qblk * 32 + fr;
      store_o(YCc + tok * 256 + head * 64, O00, O01, rn, fh);
    }
  }
  {
    const float sc = 0.125f * LOG2E;
    for (int it = vw; it < BC * 8 * 128; it += NW) {
      const int bl = it >> 10, hq = (it >> 7) & 7, qblk = it & 127;
      const int kvh = hq >> 2;
      const u16* Q = QK + (size_t)hq * GS + bl * BS;
      const u16* K = QK + (size_t)(8 + kvh) * GS + bl * BS;
      const u16* V = VB + (size_t)kvh * GS + bl * BS;
      bf16x8 qf[4]; load_kf4(qf, Q, qblk, lane);
      float m = p.in[4][layer * 8 + hq] * LOG2E, l = (fh == 0) ? 1.0f : 0.0f;
      f32x16 O0, O1; zero16(O0); zero16(O1);
      const int kb_lo = (qblk - 4 < 0) ? 0 : qblk - 4, kb_hi = (qblk + 4 > 127) ? 127 : qblk + 4;
      const int qpos = qblk * 32 + fr;
      for (int kb = kb_lo; kb <= kb_hi; ++kb) {
        bf16x8 kf[4], vf[2][2];
        load_kf4(kf, K, kb, lane); load_vf(vf, V, kb, lane);
        f32x16 S; zero16(S);
#pragma unroll
        for (int s = 0; s < 4; ++s) S = MFMA32(kf[s], qf[s], S);
#pragma unroll
        for (int i = 0; i < 16; ++i) {
          const int dlt = kb * 32 + crow(i, fh) - qpos;
          S[i] = (dlt <= 128 && dlt >= -128) ? S[i] * sc : -1e30f;
        }
        attn_softmax_pv(S, m, l, O0, O1, vf);
      }
      const float inv = 1.0f / (l + __shfl_xor(l, 32));
      const size_t tok = (size_t)bl * SEQ + qpos;
      store_o(YA + tok * 512 + hq * 64, O0, O1, inv, fh);
    }
  }
  {
    const float sc = 0.125f;
    for (int it = vw; it < BC * 4 * 128; it += NW) {
      const int bl = it >> 9, head = (it >> 7) & 3, qblk = it & 127;
      const u16* Q = QK + (size_t)(30 + head) * GS + bl * BS;
      const u16* K = QK + (size_t)(34 + head) * GS + bl * BS;
      const u16* V = VB + (size_t)(12 + head) * GS + bl * BS;
      const float* rpb = p.in[10] + (size_t)(layer * 4 + head) * 15 * 31;
      bf16x8 qf[4]; load_kf4(qf, Q, qblk, lane);
      float m = -1e30f, l = 0.f;
      f32x16 O0, O1; zero16(O0); zero16(O1);
      const int qrow = qblk >> 1, qc = (qblk & 1) * 32 + fr;
      int r0 = qrow - 4; r0 = r0 < 0 ? 0 : (r0 > 56 ? 56 : r0);
      int c0 = qc - 8; c0 = c0 < 0 ? 0 : (c0 > 48 ? 48 : c0);
      for (int kk = 0; kk < 16; ++kk) {
        const int krow_ = r0 + (kk >> 1), hb = kk & 1, kb = krow_ * 2 + hb;
        bf16x8 kf[4], vf[2][2];
        load_kf4(kf, K, kb, lane); load_vf(vf, V, kb, lane);
        f32x16 S; zero16(S);
#pragma unroll
        for (int s = 0; s < 4; ++s) S = MFMA32(kf[s], qf[s], S);
        const float* brow = rpb + (krow_ - qrow + 7) * 31;
#pragma unroll
        for (int i = 0; i < 16; ++i) {
          const int kc = hb * 32 + crow(i, fh);
          int dc = kc - qc; dc = dc < -15 ? -15 : (dc > 15 ? 15 : dc);
          const float bias = brow[dc + 15];
          S[i] = (kc >= c0 && kc < c0 + 16) ? (S[i] * sc + bias) * LOG2E : -1e30f;
        }
        attn_softmax_pv(S, m, l, O0, O1, vf);
      }
      const float inv = 1.0f / (l + __shfl_xor(l, 32));
      const size_t tok = (size_t)bl * SEQ + qblk * 32 + fr;
      store_o(YD + tok * 256 + head * 64, O0, O1, inv, fh);
    }
  }
  {
    const float sc = 0.125f * LOG2E;
    for (int it = vw; it < BC * 6 * 128; it += NW) {
      const int bl = it / 768, rem = it % 768, head = rem >> 7, qblk = rem & 127;
      const int dil = dil_of(head >> 1), L = SEQ / dil, LB = L >> 5;
      const u16* Q = QK + (size_t)(10 + head) * GS + bl * BS;
      const u16* K = QK + (size_t)(16 + head) * GS + bl * BS;
      const u16* V = VB + (size_t)(2 + head) * GS + bl * BS;
      bf16x8 qf[4]; load_kf4(qf, Q, qblk, lane);
      float m = -1e30f, l = 0.f;
      f32x16 O0, O1; zero16(O0); zero16(O1);
      const int rsub = qblk / LB;
      const int lo = rsub * LB, hi = lo + LB - 1;
      const int kb_lo = (qblk - 2 < lo) ? lo : qblk - 2, kb_hi = (qblk + 2 > hi) ? hi : qblk + 2;
      const int qd = qblk * 32 + fr;
      for (int kb = kb_lo; kb <= kb_hi; ++kb) {
        bf16x8 kf[4], vf[2][2];
        load_kf4(kf, K, kb, lane); load_vf(vf, V, kb, lane);
        f32x16 S; zero16(S);
#pragma unroll
        for (int s = 0; s < 4; ++s) S = MFMA32(kf[s], qf[s], S);
#pragma unroll
        for (int i = 0; i < 16; ++i) {
          const int dlt = kb * 32 + crow(i, fh) - qd;
          S[i] = (dlt <= 64 && dlt >= -64) ? S[i] * sc : -1e30f;
        }
        attn_softmax_pv(S, m, l, O0, O1, vf);
      }
      const float lt = l + __shfl_xor(l, 32);
      const float inv = 1.0f / lt;
      const int msub = qd - rsub * L;
      const int pos = msub * dil + rsub;
      const size_t tok = (size_t)bl * SEQ + pos;
      store_o(BO + tok * 384 + head * 64, O0, O1, inv, fh);
      if (fh == 0) LSE[tok * 8 + head] = __log2f(lt) + m;
    }
  }
}


__device__ void phase_bcombine(const Params& p, int tid_, int bid_, int nblk_) {
  const u16* BO = (const u16*)(p.ws + OFF_BO);
  const float* LSE = (const float*)(p.ws + OFF_LSE);
  u16* YB = (u16*)(p.ws + OFF_YB);
  for (int e = bid_ * NTHR + tid_; e < TC * 16; e += nblk_ * NTHR) {
    const int tok = e >> 4, j = (e >> 3) & 1, c8 = (e & 7) * 8;
    const float a0 = LSE[(size_t)tok * 8 + j], a1 = LSE[(size_t)tok * 8 + 2 + j], a2 = LSE[(size_t)tok * 8 + 4 + j];
    const float mx = fmaxf(a0, fmaxf(a1, a2));
    float w0 = fexp2(a0 - mx), w1 = fexp2(a1 - mx), w2 = fexp2(a2 - mx);
    const float inv = 1.0f / (w0 + w1 + w2);
    w0 *= inv; w1 *= inv; w2 *= inv;
    const u32x4 x0 = *(const u32x4*)(BO + (size_t)tok * 384 + (0 + j) * 64 + c8);
    const u32x4 x1 = *(const u32x4*)(BO + (size_t)tok * 384 + (2 + j) * 64 + c8);
    const u32x4 x2 = *(const u32x4*)(BO + (size_t)tok * 384 + (4 + j) * 64 + c8);
    u32x4 o;
#pragma unroll
    for (int q = 0; q < 4; ++q) {
      const float lo = w0 * bf_lo(x0[q]) + w1 * bf_lo(x1[q]) + w2 * bf_lo(x2[q]);
      const float hi = w0 * bf_hi(x0[q]) + w1 * bf_hi(x1[q]) + w2 * bf_hi(x2[q]);
      o[q] = pk2(lo, hi);
    }
    *(u32x4*)(YB + (size_t)tok * 256 + j * 64 + c8) = o;
    const u32x4 z = {0u, 0u, 0u, 0u};
    *(u32x4*)(YB + (size_t)tok * 256 + 128 + (e & 15) * 8) = z;
  }
}

#define XB_TMO      128
#define XB_XCNT(j)  (256  + 64 * (j))
#define XB_XSUB(j)  (1280 + 64 * (j))
#define XB_XGEN(j)  (2304 + 64 * (j))
#define XB_TOP      3328
#define XB_TOPGEN   3392
#define XCD_BAR_WORDS 3456
#define XB_SPIN_CAP (1u << 22)
#define LAS __attribute__((address_space(3)))
DI unsigned xb_ld(unsigned* p)              { return __hip_atomic_load(p, __ATOMIC_RELAXED, __HIP_MEMORY_SCOPE_AGENT); }
DI unsigned xb_add(unsigned* p, unsigned v) { return __hip_atomic_fetch_add(p, v, __ATOMIC_RELAXED, __HIP_MEMORY_SCOPE_AGENT); }
DI unsigned xb_xcc_id() { return (unsigned)__builtin_amdgcn_s_getreg((3 << 11) | 20) & 0xFu; }
#define XB_SPIN(cond, bar) do { unsigned _sp = 0; while (cond) { __builtin_amdgcn_s_sleep(1); \
    if ((++_sp & 255u) == 0u) { if (xb_ld(&(bar)[XB_TMO])) break; if (_sp > XB_SPIN_CAP) { atomicAdd(&(bar)[XB_TMO], 1u); break; } } } } while (0)
struct XcdBarrier { unsigned* bar; unsigned x; volatile LAS unsigned* st; };
DI XcdBarrier xcd_barrier_post(unsigned* bar, volatile LAS unsigned* st) {
  XcdBarrier b; b.bar = bar; b.x = xb_xcc_id(); b.st = st;
  if (threadIdx.x == 0) (void)xb_add(&bar[XB_XCNT(b.x)], 1u);
  return b;
}
DI void xcd_barrier_complete(unsigned* bar, unsigned x, unsigned& nloc, unsigned& nx) {
  const unsigned G = gridDim.x * gridDim.y * gridDim.z;
  unsigned sum, cnt, mine, sp = 0u;
  for (;;) {
    sum = 0u; cnt = 0u; mine = 0u;
#pragma unroll
    for (unsigned j = 0; j < 16; ++j) { const unsigned c = xb_ld(&bar[XB_XCNT(j)]); sum += c; cnt += (c > 0u) ? 1u : 0u; mine = (j == x) ? c : mine; }
    if (sum == G) break;
    __builtin_amdgcn_s_sleep(1);
    if ((++sp & 255u) == 0u) { if (xb_ld(&bar[XB_TMO])) break; if (sp > XB_SPIN_CAP) { atomicAdd(&bar[XB_TMO], 1u); break; } }
  }
  nloc = mine > 0u ? mine : 1u; nx = cnt > 0u ? cnt : 1u;
}
DI void xcd_barrier(const XcdBarrier& b) {
  asm volatile("s_waitcnt vmcnt(0)" ::: "memory");
  __syncthreads();
  if (threadIdx.x == 0) {
    unsigned* bar = b.bar;
    __builtin_amdgcn_s_waitcnt(0);
    unsigned nloc = b.st[0], nx = b.st[1];
    if (nloc == 0u) { xcd_barrier_complete(bar, b.x, nloc, nx); b.st[0] = nloc; b.st[1] = nx; }
    const unsigned old = xb_add(&bar[XB_XSUB(b.x)], 1u);
    const unsigned gen = old / nloc;
    if (old + 1u == (gen + 1u) * nloc) {
      __builtin_amdgcn_fence(__ATOMIC_RELEASE, "agent");
      asm volatile("s_waitcnt vmcnt(0)" ::: "memory");
      const unsigned og = xb_add(&bar[XB_TOP], 1u);
      const unsigned tg = og / nx;
      if (og + 1u == (tg + 1u) * nx) xb_add(&bar[XB_TOPGEN], 1u);
      else XB_SPIN(xb_ld(&bar[XB_TOPGEN]) == tg, bar);
      __builtin_amdgcn_fence(__ATOMIC_ACQUIRE, "agent");
      xb_add(&bar[XB_XGEN(b.x)], 1u);
      asm volatile("s_waitcnt vmcnt(0)" ::: "memory");
    } else {
      XB_SPIN(xb_ld(&bar[XB_XGEN(b.x)]) == gen, bar);
      __builtin_amdgcn_fence(__ATOMIC_ACQUIRE, "agent");
      asm volatile("s_waitcnt vmcnt(0)" ::: "memory");
    }
  }
  __syncthreads();
}

__global__ void __launch_bounds__(NTHR, 2) mk_forward(Params p) {
  extern __shared__ __attribute__((aligned(16))) unsigned char smem[];
  cg::grid_group grid = cg::this_grid();
  volatile LAS unsigned* xbw = (volatile LAS unsigned*)(smem + LDS_STAGE);
  if (threadIdx.x < 4) xbw[threadIdx.x] = 0u;
  __syncthreads();
  XcdBarrier xb;
  if (FUSED) xb = xcd_barrier_post((unsigned*)(p.ws + OFF_BAR), xbw);
  PG8_LAS unsigned char* lds = (PG8_LAS unsigned char*)smem;
  for (int ph = p.ph_lo; ph < p.ph_hi; ++ph) {
#if DUPMASK
   for (int rep = 0; rep < ((ph > 0 && ((DUPMASK >> ((ph - 1) % 7)) & 1)) ? 2 : 1); ++rep)
#endif
   {
    int tid_ = threadIdx.x, bid_ = blockIdx.x, nblk_ = gridDim.x;
    asm volatile("" : "+v"(tid_));
    asm volatile("" : "+s"(bid_));
    asm volatile("" : "+s"(nblk_));
    Params pp = p;
    asm volatile("" : "+s"(pp.ws));
    asm volatile("" : "+s"(pp.out));
    unsigned char* ws = pp.ws;
    if (ph == 0) {
      if (PHMASK & 128) phase_prep(pp, tid_, bid_, nblk_, smem);
    } else {
      const int q = ph - 1, chunk = q / 14, layer = (q % 14) / 7, k = q % 7;
      const u16* XBc = (const u16*)(ws + OFF_XB) + (size_t)chunk * TC * DM;
      float* SSQc = (float*)(ws + OFF_SSQ) + (size_t)chunk * TC * 16;
      float* xc = pp.out + (size_t)chunk * TC * DM;
      if (k == 0 && (PHMASK & 1)) {
        EpiQKG e; e.ssq = SSQc; e.qk = (u16*)(ws + OFF_QK); e.rope = (const float*)(ws + OFF_ROPE);
        e.gA = pp.in[3] + layer * 128; e.gB = pp.in[5] + layer * 128; e.gC = pp.in[6] + layer * 64; e.gD = pp.in[9] + layer * 128;
#ifndef NO_QKG
        run_gemm(lds, XBc, (const u16*)(ws + OFF_WQKG) + (size_t)layer * NQKG * DM, TC, 2560, DM, e);
        EpiGate eg; eg.ssq = SSQc; eg.gate = (u16*)(ws + OFF_GATE);
#ifndef NO_GATE
        run_gemm(lds, XBc, (const u16*)(ws + OFF_WQKG) + ((size_t)layer * NQKG + 2560) * DM, TC, 4096, DM, eg);
#endif
#endif
        EpiVT ev; ev.ssq = SSQc; ev.vbuf = (u16*)(ws + OFF_V);
#ifndef NO_VT
        run_gemm(lds, (const u16*)(ws + OFF_WV) + (size_t)layer * DM * DM, XBc, DM, TC, DM, ev);
#endif
      } else if (k == 1 && (PHMASK & 2)) {
        phase_attn(pp, tid_, bid_, nblk_, layer);
      } else if (k == 2 && (PHMASK & 4)) {
        phase_bcombine(pp, tid_, bid_, nblk_);
      } else if (k == 3 && (PHMASK & 8)) {
        const u16* gate = (const u16*)(ws + OFF_GATE); float* mrgf = (float*)(ws + OFF_MRGF); u16* mrg = (u16*)(ws + OFF_MRG);
        { EpiMerge<0> e; e.gate = gate; e.mrgf = mrgf; e.mrg = mrg; run_gemm(lds, (const u16*)(ws + OFF_YA), (const u16*)(ws + OFF_WBA) + (size_t)layer * DM * 512, TC, DM, 512, e); }
        { EpiMerge<1> e; e.gate = gate; e.mrgf = mrgf; e.mrg = mrg; run_gemm(lds, (const u16*)(ws + OFF_YB), (const u16*)(ws + OFF_WBB) + (size_t)layer * DM * 256, TC, DM, 256, e); }
        { EpiMerge<2> e; e.gate = gate; e.mrgf = mrgf; e.mrg = mrg; run_gemm(lds, (const u16*)(ws + OFF_YC), (const u16*)(ws + OFF_WBC) + (size_t)layer * DM * 256, TC, DM, 256, e); }
        { EpiMerge<3> e; e.gate = gate; e.mrgf = mrgf; e.mrg = mrg; run_gemm(lds, (const u16*)(ws + OFF_YD), (const u16*)(ws + OFF_WBD) + (size_t)layer * DM * 256, TC, DM, 256, e); }
      } else if ((k == 4 && (PHMASK & 16)) || (k == 6 && (PHMASK & 64))) {
        const bool dn = (k == 6);
        EpiResid e; e.xold = (!dn && layer == 0) ? (pp.in[0] + (size_t)chunk * TC * DM) : xc; e.xout = xc; e.xb = (u16*)XBc; e.ssq = SSQc;
        const u16* A = dn ? (const u16*)(ws + OFF_GATE) : (const u16*)(ws + OFF_MRG);
        const u16* W = dn ? (const u16*)(ws + OFF_WDN) + (size_t)layer * DM * DMLP : (const u16*)(ws + OFF_WOUT) + (size_t)layer * DM * DM;
        run_gemm(lds, A, W, TC, DM, dn ? DMLP : DM, e);
      } else if (k == 5 && (PHMASK & 32)) {
        EpiUp e; e.ssq = SSQc; e.uo = (u16*)(ws + OFF_GATE);
        run_gemm(lds, XBc, (const u16*)(ws + OFF_WUP) + (size_t)layer * DMLP * DM, TC, DMLP, DM, e);
      }
    }
   }
    if (ph + 1 < p.ph_hi) {
      if (ph == 0) grid.sync();
      else xcd_barrier(xb);
    }
  }
}

extern "C" void kernel_launch(void* const* d_in, const int* in_sizes, int n_in, void* d_out, int out_size, void* d_ws, size_t ws_size,
                              hipStream_t stream) {
  static int grid_blocks = 0;
  if (grid_blocks == 0) {
    if (n_in != 19 || out_size != T * DM || ws_size < WS_END) {
      fprintf(stderr, "kernel_launch: unexpected problem (n_in %d out %d ws %zu need %zu)\n", n_in, out_size, ws_size, (size_t)WS_END);
      grid_blocks = -1;
      return;
    }
    int dev = 0, cus = 0, per_cu = 0;
    (void)hipGetDevice(&dev);
    (void)hipDeviceGetAttribute(&cus, hipDeviceAttributeMultiprocessorCount, dev);
    if (hipFuncSetAttribute((const void*)mk_forward, hipFuncAttributeMaxDynamicSharedMemorySize, LDS_BYTES) != hipSuccess) {
      fprintf(stderr, "kernel_launch: hipFuncSetAttribute failed\n"); grid_blocks = -1; return;
    }
    (void)hipOccupancyMaxActiveBlocksPerMultiprocessor(&per_cu, mk_forward, NTHR, LDS_BYTES);
    if (per_cu < 1) fprintf(stderr, "kernel_launch: occupancy query says %d blocks per CU\n", per_cu);
    (void)hipGetLastError();
    grid_blocks = cus;
  }
  if (grid_blocks < 0) return;
  Params p{};
  for (int i = 0; i < 19; ++i) p.in[i] = (const float*)d_in[i];
  p.out = (float*)d_out;
  p.ws = (unsigned char*)d_ws;
#if FUSED
  (void)hipMemsetAsync((unsigned char*)d_ws + OFF_BAR, 0, XCD_BAR_WORDS * 4, stream);
  p.ph_lo = 0; p.ph_hi = NPHASE;
  void* args[] = {&p};
  hipError_t e = hipLaunchCooperativeKernel((const void*)mk_forward, dim3(grid_blocks), dim3(NTHR), args, LDS_BYTES, stream);
  if (e != hipSuccess) fprintf(stderr, "cooperative launch failed: %s (grid %d)\n", hipGetErrorString(e), grid_blocks);
#else
  for (int ph = 0; ph < NPHASE; ++ph) {
    p.ph_lo = ph; p.ph_hi = ph + 1;
    hipLaunchKernelGGL(mk_forward, dim3(grid_blocks), dim3(NTHR), LDS_BYTES, stream, p);
  }
#endif
}
```

```cpp
#include <hip/hip_runtime.h>
#include <hip/hip_cooperative_groups.h>
#include <cstdio>
namespace cg = cooperative_groups;

#ifndef PHMASK
#define PHMASK 255
#endif
#ifndef DUPMASK
#define DUPMASK 0
#endif
#ifndef DUPK
#define DUPK -1
#endif
#ifndef FUSED
#define FUSED 1
#endif

namespace pg8 {
#define PG8_LAS __attribute__((address_space(3)))
typedef unsigned short bf16_t;
typedef short bf16x8 __attribute__((ext_vector_type(8)));
typedef float f32x4 __attribute__((ext_vector_type(4)));
typedef unsigned u32x4 __attribute__((ext_vector_type(4)));
constexpr int BM = 256, BK = 64, HALF = 128, HTB = HALF * BK * 2  , STAGE_BYTES = 8 * HTB, NXCD = 8, WGM = 8;

__host__ __device__ __forceinline__ int lds_byte(int r, int c) { const int st = (r >> 4) * 2 + (c >> 5), rr = r & 15, cc = c & 31, ob = rr * 64 + cc * 2; return st * 1024 + (ob ^ (((ob >> 9) & 1) << 5)); }
__host__ __device__ __forceinline__ void stage_rc(int b, int& R, int& C) { const int st = b / 1024, sb = b % 1024, swz = sb ^ (((sb >> 9) & 1) << 5); R = (st >> 1) * 16 + swz / 64; C = (st & 1) * 32 + (swz % 64) / 2; }
__host__ __device__ __forceinline__ int perm32(int rho) { const int n = rho >> 4, i = rho & 15; return 8 * (i >> 2) + 4 * n + (i & 3); }

struct Unit { int pm, pn, seg; };
struct Gemm { const bf16_t* A; const bf16_t* Bt; int M, N, K; };

struct StaticOrder {
    int nM, nN, nwg, G, c;
    __host__ __device__ void init(int M, int N, int G_, int c_) { nM = M / BM; nN = N / BM; nwg = nM * nN; G = G_; c = c_; }
    __host__ __device__ bool next(int i, Unit& u) const {
        const long L = (long)i * G + c; if (L >= nwg) return false;
        int wgid = (int)L; { const int q = nwg / NXCD, r = nwg % NXCD, xcd = wgid % NXCD, off = wgid / NXCD; wgid = (xcd < r ? xcd * (q + 1) : r * (q + 1) + (xcd - r) * q) + off; }
        const int nig = WGM * nN, gid = wgid / nig, fm = gid * WGM, gsz = (nM - fm) < WGM ? (nM - fm) : WGM;
        u.pm = fm + ((wgid % nig) % gsz); u.pn = (wgid % nig) / gsz; u.seg = 0; return true;
    }
    __device__ __forceinline__ void a_ready(const Unit&) const {}
    __device__ __forceinline__ void done(const Unit&) const {}
    __device__ __forceinline__ const char* baseA(const Gemm& g, const Unit& u, size_t tstep) const { return (const char*)g.A + (size_t)u.pm * tstep; }
    __device__ __forceinline__ const char* baseB(const Gemm& g, const Unit& u, size_t tstep) const { return (const char*)g.Bt + (size_t)u.pn * tstep; }
    __device__ __forceinline__ bool zero_after(const Unit&) const { return true; }
};

template <class Epi, class Sched, bool STAMP = false>
__device__ __forceinline__ void gemm_phase(PG8_LAS unsigned char* lds, const Gemm g, const Sched& S, const Epi& E, unsigned long long* stamps) {
    int tid = threadIdx.x; asm volatile("" : "+v"(tid));
    const int wid = __builtin_amdgcn_readfirstlane(tid >> 6), lane = tid & 63, wr = wid >> 2, wc = wid & 3, fr = lane & 15, fq = lane >> 4;
    const int K = g.K, nt = K / BK;
    int ts_lo = 0, ts_hi = 0, nts = 0; const unsigned long long rt_entry = STAMP ? (unsigned long long)wall_clock64() : 0ull;
#define PG8_STAMP() do { if (STAMP && wid == 0 && nts < 64) { const unsigned long long _c = (unsigned long long)clock64(); \
        ts_lo = (lane == nts) ? (int)(unsigned)_c : ts_lo; ts_hi = (lane == nts) ? (int)(unsigned)(_c >> 32) : ts_hi; ++nts; } } while (0)
    PG8_STAMP();
    unsigned voffA[2], voffB[2];
#pragma unroll
    for (int i = 0; i < 2; ++i) { int R, C; stage_rc(tid * 16 + i * 8192, R, C); const int Rb = Epi::PERM ? ((R & ~31) + perm32(R & 31)) : R;
        voffA[i] = (unsigned)(R * K + C) * 2u; voffB[i] = (unsigned)(Rb * K + C) * 2u; }
    const size_t kstep = (size_t)(BK * 2);
    const size_t hstep = (size_t)HALF * K * 2;
    const size_t tstep = 2 * hstep;
    const unsigned ldsw = (unsigned)wid * 1024u;
    const int aoff = lds_byte(wr * 64 + fr, fq * 8), boff = lds_byte(wc * 32 + fr, fq * 8);
#define PG8_SA(b, h) (((b) * 2 + (h)) * HTB)
#define PG8_SB(b, h) ((4 + (b) * 2 + (h)) * HTB)
#define PG8_STAGE(bufoff, gbase, voff) do { _Pragma("unroll") for (int _i = 0; _i < 2; ++_i) \
        __builtin_amdgcn_global_load_lds((const unsigned*)((const char*)(gbase) + (voff)[_i]), (PG8_LAS unsigned*)(lds + (bufoff) + ldsw + _i * 8192), 16, 0, 0); } while (0)
#define PG8_LDA(dst, b, h) do { _Pragma("unroll") for (int m = 0; m < 4; ++m) _Pragma("unroll") for (int k = 0; k < 2; ++k) dst[m][k] = *(const PG8_LAS bf16x8*)(lds + PG8_SA(b, h) + aoff + m * 2048 + k * 1024); } while (0)
#define PG8_LDB(dst, b, h) do { _Pragma("unroll") for (int n = 0; n < 2; ++n) _Pragma("unroll") for (int k = 0; k < 2; ++k) dst[n][k] = *(const PG8_LAS bf16x8*)(lds + PG8_SB(b, h) + boff + n * 2048 + k * 1024); } while (0)
#define PG8_MMA(ai, bj, At, Bt) do { __builtin_amdgcn_s_setprio(1); _Pragma("unroll") for (int m = 0; m < 4; ++m) _Pragma("unroll") for (int n = 0; n < 2; ++n) _Pragma("unroll") for (int k = 0; k < 2; ++k) \
        acc[ai][bj][m][n] = __builtin_amdgcn_mfma_f32_16x16x32_bf16(Bt[n][k], At[m][k], acc[ai][bj][m][n], 0, 0, 0); __builtin_amdgcn_s_setprio(0); } while (0)
#define PG8_WAIT_V(n) asm volatile("s_waitcnt vmcnt(" #n ")" ::: "memory")
#define PG8_WAIT_L(n) asm volatile("s_waitcnt lgkmcnt(" #n ")" ::: "memory")
#define PG8_BAR __builtin_amdgcn_s_barrier()
#define PG8_SCHED __builtin_amdgcn_sched_barrier(0)
    Unit cur, nxt; int ui = 0;
    if (!S.next(0, cur)) return;
    f32x4 acc[2][2][4][2];
#pragma unroll
    for (int a = 0; a < 2; ++a)
#pragma unroll
        for (int b = 0; b < 2; ++b)
#pragma unroll
            for (int m = 0; m < 4; ++m)
#pragma unroll
                for (int n = 0; n < 2; ++n) acc[a][b][m][n] = (f32x4){0.f, 0.f, 0.f, 0.f};
    bf16x8 At[4][2], B0[2][2], B1[2][2];
    const char* cA = S.baseA(g, cur, tstep); const char* cB = S.baseB(g, cur, tstep);
    S.a_ready(cur);
    PG8_STAGE(PG8_SB(0, 0), cB, voffB); PG8_STAGE(PG8_SA(0, 0), cA, voffA); PG8_STAGE(PG8_SB(0, 1), cB + hstep, voffB); PG8_STAGE(PG8_SA(0, 1), cA + hstep, voffA);
    if (wr == 1) PG8_BAR;
    PG8_WAIT_V(4); PG8_BAR;
    PG8_STAGE(PG8_SB(1, 0), cB + kstep, voffB); PG8_STAGE(PG8_SA(1, 0), cA + kstep, voffA); PG8_STAGE(PG8_SB(1, 1), cB + hstep + kstep, voffB);
    PG8_WAIT_V(6); PG8_BAR;
    PG8_STAMP();
    for (;;) {
        const bool has_next = S.next(ui + 1, nxt);
        const char* nA = has_next ? S.baseA(g, nxt, tstep) : cA; const char* nB = has_next ? S.baseB(g, nxt, tstep) : cB;
        for (int t = 0; t < nt; t += 2) {
            const bool last = (t == nt - 2);
            const char* a1 = cA + (size_t)(t + 1) * kstep;
            const char* a2 = last ? nA : cA + (size_t)(t + 2) * kstep; const char* b2 = last ? nB : cB + (size_t)(t + 2) * kstep;
            const char* a3 = a2 + kstep; const char* b3 = b2 + kstep;
            if (last && has_next) S.a_ready(nxt);
            PG8_LDB(B0, 0, 0); PG8_SCHED; PG8_LDA(At, 0, 0); PG8_STAGE(PG8_SA(1, 1), a1 + hstep, voffA);
            PG8_WAIT_L(8); PG8_BAR; PG8_WAIT_L(0); PG8_MMA(0, 0, At, B0); PG8_BAR; PG8_SCHED;
            PG8_LDB(B1, 0, 1); PG8_STAGE(PG8_SB(0, 0), b2, voffB);
            PG8_BAR; PG8_WAIT_L(0); PG8_MMA(0, 1, At, B1); PG8_BAR;
            PG8_LDA(At, 0, 1); PG8_STAGE(PG8_SA(0, 0), a2, voffA);
            PG8_BAR; PG8_WAIT_L(0); PG8_MMA(1, 0, At, B0); PG8_BAR; PG8_SCHED;
            PG8_STAGE(PG8_SB(0, 1), b2 + hstep, voffB);
            PG8_WAIT_V(6); PG8_BAR; PG8_MMA(1, 1, At, B1); PG8_BAR;
            PG8_LDB(B0, 1, 0); PG8_SCHED; PG8_LDA(At, 1, 0); PG8_STAGE(PG8_SA(0, 1), a2 + hstep, voffA);
            PG8_WAIT_L(8); PG8_BAR; PG8_WAIT_L(0); PG8_MMA(0, 0, At, B0); PG8_BAR; PG8_SCHED;
            PG8_LDB(B1, 1, 1); PG8_STAGE(PG8_SB(1, 0), b3, voffB);
            PG8_BAR; PG8_WAIT_L(0); PG8_MMA(0, 1, At, B1); PG8_BAR;
            PG8_LDA(At, 1, 1); PG8_STAGE(PG8_SA(1, 0), a3, voffA);
            PG8_BAR; PG8_WAIT_L(0); PG8_MMA(1, 0, At, B0); PG8_BAR; PG8_SCHED;
            PG8_STAGE(PG8_SB(1, 1), b3 + hstep, voffB);
            PG8_WAIT_V(6); PG8_BAR; PG8_MMA(1, 1, At, B1); PG8_BAR;
        }
        PG8_STAMP();
        if constexpr (!Epi::AFTER_DRAIN) { E(acc, cur, wr, wc, fr, fq); S.done(cur); }
        PG8_STAMP();
        if (!has_next) break;
        if (S.zero_after(cur))
#pragma unroll
        for (int a = 0; a < 2; ++a)
#pragma unroll
            for (int b = 0; b < 2; ++b)
#pragma unroll
                for (int m = 0; m < 4; ++m)
#pragma unroll
                    for (int n = 0; n < 2; ++n) acc[a][b][m][n] = (f32x4){0.f, 0.f, 0.f, 0.f};
        cur = nxt; cA = nA; cB = nB; ++ui;
    }
    PG8_WAIT_V(0);
    if (wr == 0) PG8_BAR;
    PG8_BAR;
    if constexpr (Epi::AFTER_DRAIN) { E.fused(acc, cur, wr, wc, fr, fq, lds, wid, lane); S.done(cur); }
    PG8_STAMP();
    if (STAMP && wid == 0) { stamps[lane] = lane < nts ? (((unsigned long long)(unsigned)ts_hi << 32) | (unsigned)ts_lo) : 0ull;
        if (lane == 62) stamps[62] = rt_entry; if (lane == 63) stamps[63] = (unsigned long long)wall_clock64(); }
#undef PG8_STAMP
#undef PG8_SA
#undef PG8_SB
#undef PG8_STAGE
#undef PG8_LDA
#undef PG8_LDB
#undef PG8_MMA
#undef PG8_WAIT_V
#undef PG8_WAIT_L
#undef PG8_BAR
#undef PG8_SCHED
}
}

typedef unsigned short u16;
typedef short bf16x8 __attribute__((ext_vector_type(8)));
typedef float f32x16 __attribute__((ext_vector_type(16)));
typedef float f32x4 __attribute__((ext_vector_type(4)));
typedef __bf16 bf2_t __attribute__((ext_vector_type(2)));
typedef float f2_t __attribute__((ext_vector_type(2)));
typedef unsigned u32x4 __attribute__((ext_vector_type(4)));
typedef unsigned u32x2 __attribute__((ext_vector_type(2)));
using pg8::Unit;

#define DI __device__ __forceinline__
#define MFMA32(a, b, c) __builtin_amdgcn_mfma_f32_32x32x16_bf16((a), (b), (c), 0, 0, 0)

constexpr int DM = 1024, SEQ = 4096, NBATCH = 8, T = NBATCH * SEQ;
constexpr int NCH = 2, BC = NBATCH / NCH, TC = BC * SEQ;
constexpr int INC = 7552, DMLP = 4096;
constexpr int NQKG = 6656;
constexpr int NQKH = 38, NVH = 16;
constexpr float LOG2E = 1.4426950408889634f;
constexpr int NTHR = 512;

constexpr size_t al256(size_t x) { return (x + 255) & ~(size_t)255; }
constexpr size_t OFF_WQKG = 0;
constexpr size_t OFF_WV   = OFF_WQKG + al256((size_t)2 * NQKG * DM * 2);
constexpr size_t OFF_WBR5 = OFF_WV   + al256((size_t)2 * DM * DM * 2);
constexpr size_t OFF_WOUT = OFF_WBR5 + al256((size_t)2 * 5 * DM * 256 * 2);
constexpr size_t OFF_WUP  = OFF_WOUT + al256((size_t)2 * DM * DM * 2);
constexpr size_t OFF_WDN  = OFF_WUP  + al256((size_t)2 * DMLP * DM * 2);
constexpr size_t OFF_ROPE = OFF_WDN  + al256((size_t)2 * DM * DMLP * 2);
constexpr size_t OFF_XB   = OFF_ROPE + al256((size_t)SEQ * 96 * 4);
constexpr size_t OFF_SSQ  = OFF_XB   + al256((size_t)T * DM * 2);
constexpr size_t OFF_QK   = OFF_SSQ  + al256((size_t)T * 16 * 4);
constexpr size_t OFF_V    = OFF_QK   + al256((size_t)NQKH * TC * 64 * 2);
constexpr size_t OFF_GATE = OFF_V    + al256((size_t)NVH * TC * 64 * 2);
constexpr size_t OFF_Y5   = OFF_GATE + al256((size_t)TC * 4096 * 2);
constexpr size_t OFF_BO   = OFF_Y5   + al256((size_t)5 * TC * 256 * 2);
constexpr size_t OFF_LSE  = OFF_BO   + al256((size_t)TC * 384 * 2);
constexpr size_t OFF_MRG  = OFF_LSE  + al256((size_t)TC * 8 * 4);
constexpr size_t OFF_BAR  = OFF_MRG  + al256((size_t)TC * DM * 2);
constexpr size_t WS_END   = OFF_BAR  + 16384;
static_assert(WS_END <= (size_t)512 * 1024 * 1024, "workspace too large");

constexpr int LDS_STAGE = 131072;
constexpr int LDS_BYTES = LDS_STAGE + 64;
constexpr int PPL = (DUPK >= 0) ? 8 : 7;
constexpr int NPHASE = 1 + NCH * 2 * PPL;

struct Params {
  const float* in[19];
  float* out;
  unsigned char* ws;
  int ph_lo, ph_hi;
};

DI unsigned pk2(float a, float b) { f2_t v = {a, b}; bf2_t r = __builtin_convertvector(v, bf2_t); return __builtin_bit_cast(unsigned, r); }
DI float bf_lo(unsigned u) { return __uint_as_float(u << 16); }
DI float bf_hi(unsigned u) { return __uint_as_float(u & 0xffff0000u); }
DI float fexp2(float x) { return __builtin_amdgcn_exp2f(x); }
DI int crow(int i, int h) { return (i & 3) + 8 * (i >> 2) + 4 * h; }
DI bf16x8 as_bf8(u32x4 v) { return __builtin_bit_cast(bf16x8, v); }
DI int dil_of(int gi) { return gi == 0 ? 1 : (gi == 1 ? 4 : 16); }
DI int dlg_of(int gi) { return gi * 2; }
DI float row_rscale(const float* ssq, size_t tok) {
  const f32x4 a = *(const f32x4*)(ssq + tok * 16), b = *(const f32x4*)(ssq + tok * 16 + 4);
  const f32x4 c = *(const f32x4*)(ssq + tok * 16 + 8), d = *(const f32x4*)(ssq + tok * 16 + 12);
  const float s = ((a[0] + a[1]) + (a[2] + a[3])) + ((b[0] + b[1]) + (b[2] + b[3])) + ((c[0] + c[1]) + (c[2] + c[3])) + ((d[0] + d[1]) + (d[2] + d[3]));
  return rsqrtf(s * (1.0f / 1024.0f) + 1e-6f);
}
DI int qk_head_col(int h) {
  if (h < 8) return 64 * h;
  if (h < 10) return 512 + 64 * (h - 8);
  if (h < 16) return 768 + 64 * (h - 10);
  if (h < 22) return 1152 + 64 * (h - 16);
  if (h < 26) return 1920 + 64 * (h - 22);
  if (h < 30) return 2176 + 64 * (h - 26);
  if (h < 34) return 2688 + 64 * (h - 30);
  return 2944 + 64 * (h - 34);
}
DI int v_head_col(int vh) {
  if (vh < 2) return 640 + 64 * vh;
  if (vh < 8) return 1536 + 64 * (vh - 2);
  if (vh < 12) return 2432 + 64 * (vh - 8);
  return 3200 + 64 * (vh - 12);
}

struct EpiQKG {
  static constexpr bool PERM = false, AFTER_DRAIN = false;
  const float* ssq; u16* qk; const float* rope; const float* gA; const float* gB; const float* gC; const float* gD;
  DI void operator()(const f32x4 (&acc)[2][2][4][2], const Unit& u, int wr, int wc, int fr, int fq) const {
    const int hidx = u.pn * 4 + wc;
    if (hidx >= NQKH) return;
    int kind, dlg = 0; const float* gain;
    if (hidx < 8) { kind = 0; gain = gA; }
    else if (hidx < 10) { kind = 0; gain = gA + 64; }
    else if (hidx < 16) { kind = 0; gain = gB; dlg = dlg_of((hidx - 10) >> 1); }
    else if (hidx < 22) { kind = 0; gain = gB + 64; dlg = dlg_of((hidx - 16) >> 1); }
    else if (hidx < 26) { kind = 2; gain = gC; }
    else if (hidx < 30) { kind = 2; gain = gC + 32; }
    else if (hidx < 34) { kind = 1; gain = gD; }
    else { kind = 1; gain = gD + 64; }
    u16* gbase = qk + (size_t)hidx * TC * 64;
    const float* gainl = gain + 4 * fq;
#pragma unroll
    for (int ai = 0; ai < 2; ++ai)
#pragma unroll
      for (int m = 0; m < 4; ++m) {
        const int tok = u.pm * 256 + 128 * ai + 64 * wr + 16 * m + fr;
        const int bl = tok >> 12, pos = tok & 4095;
        const float rs = row_rscale(ssq, tok);
        const int pdom = ((pos & ((1 << dlg) - 1)) << (12 - dlg)) + (pos >> dlg);
        const int blk = pdom >> 5, rr = pdom & 31;
        u16* base = gbase + (size_t)bl * SEQ * 64;
        if (kind != 2) {
          float ss = 0.f;
#pragma unroll
          for (int bj = 0; bj < 2; ++bj)
#pragma unroll
            for (int n = 0; n < 2; ++n)
#pragma unroll
              for (int e = 0; e < 4; ++e) ss += acc[ai][bj][m][n][e] * acc[ai][bj][m][n][e];
          ss += __shfl_xor(ss, 16); ss += __shfl_xor(ss, 32);
          const float sc = rs * rsqrtf(ss * rs * rs * (1.0f / 64.0f) + 1e-6f);
#pragma unroll
          for (int n = 0; n < 2; ++n) {
            f32x4 xa = acc[ai][0][m][n] * sc * *(const f32x4*)(gainl + 16 * n);
            f32x4 xb2 = acc[ai][1][m][n] * sc * *(const f32x4*)(gainl + 32 + 16 * n);
            if (kind == 0) {
              const f32x4 c4 = *(const f32x4*)(rope + pos * 96 + 16 * n + 4 * fq);
              const f32x4 s4 = *(const f32x4*)(rope + pos * 96 + 32 + 16 * n + 4 * fq);
              const f32x4 ta = xa * c4 - xb2 * s4, tb = xb2 * c4 + xa * s4;
              xa = ta; xb2 = tb;
            }
            u32x2 w0 = {pk2(xa[0], xa[1]), pk2(xa[2], xa[3])};
            *(u32x2*)(base + ((size_t)(blk * 4 + n) * 64 + (fq >> 1) * 32 + rr) * 8 + 4 * (fq & 1)) = w0;
            u32x2 w1 = {pk2(xb2[0], xb2[1]), pk2(xb2[2], xb2[3])};
            *(u32x2*)(base + ((size_t)(blk * 4 + 2 + n) * 64 + (fq >> 1) * 32 + rr) * 8 + 4 * (fq & 1)) = w1;
          }
        } else {
          const f32x4 c4 = *(const f32x4*)(rope + pos * 96 + 64 + 4 * fq);
          const f32x4 s4 = *(const f32x4*)(rope + pos * 96 + 80 + 4 * fq);
#pragma unroll
          for (int bj = 0; bj < 2; ++bj) {
            float ss = 0.f;
#pragma unroll
            for (int n = 0; n < 2; ++n)
#pragma unroll
              for (int e = 0; e < 4; ++e) ss += acc[ai][bj][m][n][e] * acc[ai][bj][m][n][e];
            ss += __shfl_xor(ss, 16); ss += __shfl_xor(ss, 32);
            const float sc = rs * rsqrtf(ss * rs * rs * (1.0f / 32.0f) + 1e-6f);
            const f32x4 xa = acc[ai][bj][m][0] * sc * *(const f32x4*)(gainl);
            const f32x4 xb2 = acc[ai][bj][m][1] * sc * *(const f32x4*)(gainl + 16);
            const f32x4 ta = xa * c4 - xb2 * s4, tb = xb2 * c4 + xa * s4;
            u16* sb = base + (size_t)bj * SEQ * 32;
            u32x2 w0 = {pk2(ta[0], ta[1]), pk2(ta[2], ta[3])};
            *(u32x2*)(sb + ((size_t)(blk * 2 + 0) * 64 + (fq >> 1) * 32 + rr) * 8 + 4 * (fq & 1)) = w0;
            u32x2 w1 = {pk2(tb[0], tb[1]), pk2(tb[2], tb[3])};
            *(u32x2*)(sb + ((size_t)(blk * 2 + 1) * 64 + (fq >> 1) * 32 + rr) * 8 + 4 * (fq & 1)) = w1;
          }
        }
        asm volatile("" ::: "memory");
      }
  }
};

struct EpiGateUp {
  static constexpr bool PERM = false, AFTER_DRAIN = false;
  const float* ssq; u16* o; int mode;
  DI void operator()(const f32x4 (&acc)[2][2][4][2], const Unit& u, int wr, int wc, int fr, int fq) const {
    const int c0 = u.pn * 256 + 32 * wc + 4 * fq;
    const bool up = mode != 0;
#pragma unroll
    for (int ai = 0; ai < 2; ++ai)
#pragma unroll
      for (int m = 0; m < 4; ++m) {
        const size_t tok = (size_t)u.pm * 256 + 128 * ai + 64 * wr + 16 * m + fr;
        const float rs = row_rscale(ssq, tok);
#pragma unroll
        for (int bj = 0; bj < 2; ++bj)
#pragma unroll
          for (int n = 0; n < 2; ++n) {
            const f32x4 v = acc[ai][bj][m][n] * rs;
            float r[4];
#pragma unroll
            for (int e = 0; e < 4; ++e) {
              const float z = fmaxf(v[e], 0.f);
              const float sg = __builtin_amdgcn_rcpf(1.0f + __expf(-v[e]));
              r[e] = up ? z * z : sg;
            }
            u32x2 w = {pk2(r[0], r[1]), pk2(r[2], r[3])};
            *(u32x2*)(o + tok * 4096 + c0 + 128 * bj + 16 * n) = w;
          }
        asm volatile("" ::: "memory");
      }
  }
};

struct EpiVT {
  static constexpr bool PERM = false, AFTER_DRAIN = false;
  const float* ssq; u16* vbuf;
  DI void operator()(const f32x4 (&acc)[2][2][4][2], const Unit& u, int wr, int wc, int fr, int fq) const {
    f32x4 rs4[2][2];
#pragma unroll
    for (int bj = 0; bj < 2; ++bj)
#pragma unroll
      for (int n = 0; n < 2; ++n) {
        const size_t t0 = (size_t)u.pn * 256 + 128 * bj + 32 * wc + 16 * n + 4 * fq;
#pragma unroll
        for (int e = 0; e < 4; ++e) { rs4[bj][n][e] = row_rscale(ssq, t0 + e); asm volatile("" ::: "memory"); }
      }
#pragma unroll
    for (int ai = 0; ai < 2; ++ai) {
      const int vgrp = u.pm * 4 + 2 * ai + wr;
      const int dlg = (vgrp >= 2 && vgrp < 8) ? dlg_of((vgrp - 2) >> 1) : 0;
      u16* gbase = vbuf + (size_t)vgrp * TC * 64;
      const int bl = (u.pn * 256) >> 12;
      u16* base = gbase + (size_t)bl * SEQ * 64;
      const unsigned es = (dlg == 0) ? 1u : (unsigned)(128 >> dlg) * 2048u;
#pragma unroll
      for (int m = 0; m < 4; ++m) {
        const int dv = 16 * m + fr;
        const unsigned dvo = (unsigned)((dv >> 5) * 1024 + (dv & 31) * 8);
#pragma unroll
        for (int bj = 0; bj < 2; ++bj)
#pragma unroll
          for (int n = 0; n < 2; ++n) {
            const int pos0 = (u.pn * 256 + 128 * bj + 32 * wc + 16 * n + 4 * fq) & 4095;
            const f32x4 v = acc[ai][bj][m][n] * rs4[bj][n];
            const int pd0 = ((pos0 & ((1 << dlg) - 1)) << (12 - dlg)) + (pos0 >> dlg);
            const int blk = pd0 >> 5, key = pd0 & 31;
            const unsigned off = (unsigned)blk * 2048u + (unsigned)(key >> 4) * 512u + (unsigned)((key >> 2) & 1) * 256u + dvo + 4u * ((key >> 3) & 1);
            const unsigned w0 = pk2(v[0], v[1]), w1 = pk2(v[2], v[3]);
            const unsigned o2 = off + (key & 3);
            base[o2] = (u16)(w0 & 0xffffu); base[o2 + es] = (u16)(w0 >> 16); base[o2 + 2 * es] = (u16)(w1 & 0xffffu); base[o2 + 3 * es] = (u16)(w1 >> 16);
            asm volatile("" ::: "memory");
          }
      }
    }
  }
};

struct MergeOrder : pg8::StaticOrder {
  const u16* ybase; const u16* wbase;
  DI bool next(int i, Unit& u) const { if (i >= 5) return false; if (!pg8::StaticOrder::next(0, u)) return false; u.seg = i; return true; }
  DI const char* baseA(const pg8::Gemm&, const Unit& u, size_t tstep) const { return (const char*)(ybase + (size_t)u.seg * TC * 256) + (size_t)u.pm * tstep; }
  DI const char* baseB(const pg8::Gemm&, const Unit& u, size_t tstep) const { return (const char*)(wbase + (size_t)u.seg * DM * 256) + (size_t)u.pn * tstep; }
  DI bool zero_after(const Unit& u) const { return u.seg == 4; }
};
struct EpiMerge {
  static constexpr bool PERM = false, AFTER_DRAIN = false;
  const u16* gate; u16* mrg;
  DI void operator()(f32x4 (&acc)[2][2][4][2], const Unit& u, int wr, int wc, int fr, int fq) const {
    const int seg = u.seg;
    if (seg == 0) return;
    const bool last = (seg == 4);
    const int gnum = last ? 3 : seg - 1, gden = last ? 3 : seg;
#pragma unroll
    for (int ai = 0; ai < 2; ++ai)
#pragma unroll
      for (int m = 0; m < 4; ++m) {
        const size_t tok = (size_t)u.pm * 256 + 128 * ai + 64 * wr + 16 * m + fr;
#pragma unroll
        for (int bj = 0; bj < 2; ++bj)
#pragma unroll
          for (int n = 0; n < 2; ++n) {
            const int c = u.pn * 256 + 128 * bj + 32 * wc + 16 * n + 4 * fq;
            const u32x2 gn = *(const u32x2*)(gate + tok * 4096 + gnum * 1024 + c);
            const u32x2 gd = *(const u32x2*)(gate + tok * 4096 + gden * 1024 + c);
            f32x4 f;
            f[0] = bf_lo(gn[0]); f[1] = bf_hi(gn[0]); f[2] = bf_lo(gn[1]); f[3] = bf_hi(gn[1]);
            if (!last) {
              f[0] *= __builtin_amdgcn_rcpf(bf_lo(gd[0])); f[1] *= __builtin_amdgcn_rcpf(bf_hi(gd[0]));
              f[2] *= __builtin_amdgcn_rcpf(bf_lo(gd[1])); f[3] *= __builtin_amdgcn_rcpf(bf_hi(gd[1]));
            }
            acc[ai][bj][m][n] *= f;
            if (last) { const f32x4 v = acc[ai][bj][m][n]; u32x2 w = {pk2(v[0], v[1]), pk2(v[2], v[3])}; *(u32x2*)(mrg + tok * DM + c) = w; }
          }
        asm volatile("" ::: "memory");
      }
  }
};

struct EpiResid {
  static constexpr bool PERM = false, AFTER_DRAIN = false;
  const float* xold; float* xout; u16* xb; float* ssq;
  DI void operator()(const f32x4 (&acc)[2][2][4][2], const Unit& u, int wr, int wc, int fr, int fq) const {
#pragma unroll
    for (int ai = 0; ai < 2; ++ai)
#pragma unroll
      for (int m = 0; m < 4; ++m) {
        const size_t tok = (size_t)u.pm * 256 + 128 * ai + 64 * wr + 16 * m + fr;
        float ss = 0.f;
#pragma unroll
        for (int bj = 0; bj < 2; ++bj)
#pragma unroll
          for (int n = 0; n < 2; ++n) {
            const size_t o = tok * DM + u.pn * 256 + 128 * bj + 32 * wc + 16 * n + 4 * fq;
            f32x4 v = *(const f32x4*)(xold + o) + acc[ai][bj][m][n];
            *(f32x4*)(xout + o) = v;
            u32x2 w = {pk2(v[0], v[1]), pk2(v[2], v[3])};
            *(u32x2*)(xb + o) = w;
            ss += (v[0] * v[0] + v[1] * v[1]) + (v[2] * v[2] + v[3] * v[3]);
          }
        ss += __shfl_xor(ss, 16); ss += __shfl_xor(ss, 32);
        if (fq == 0) ssq[tok * 16 + u.pn * 4 + wc] = ss;
        asm volatile("" ::: "memory");
      }
  }
};

template <class Epi>
DI void run_merge(PG8_LAS unsigned char* lds, const u16* ybase, const u16* wbase, const Epi& E) {
  int K = 256; asm volatile("" : "+s"(K));
  pg8::Gemm g; g.A = ybase; g.Bt = wbase; g.M = TC; g.N = DM; g.K = K;
  MergeOrder S; S.init(TC, DM, (int)gridDim.x, (int)blockIdx.x); S.ybase = ybase; S.wbase = wbase;
  pg8::gemm_phase<Epi, MergeOrder, false>(lds, g, S, E, nullptr);
}
template <class Epi>
DI void run_gemm(PG8_LAS unsigned char* lds, const u16* A, const u16* Bt, int M, int N, int K, const Epi& E) {
  asm volatile("" : "+s"(K));
  pg8::Gemm g; g.A = A; g.Bt = Bt; g.M = M; g.N = N; g.K = K;
  pg8::StaticOrder S; S.init(M, N, (int)gridDim.x, (int)blockIdx.x);
  pg8::gemm_phase<Epi, pg8::StaticOrder, false>(lds, g, S, E, nullptr);
}

DI void cvt_load(const float* __restrict__ src, int N, int k0, int n0, const float* __restrict__ g, float* t, int ht) {
  const int c4 = (ht & 15) * 4;
#pragma unroll
  for (int i = 0; i < 4; ++i) {
    const int kk = (ht >> 4) + 16 * i;
    f32x4 v = *(const f32x4*)(src + (size_t)(k0 + kk) * N + n0 + c4);
    const float sc = g ? g[k0 + kk] : 1.0f;
    t[kk * 65 + c4 + 0] = v[0] * sc; t[kk * 65 + c4 + 1] = v[1] * sc; t[kk * 65 + c4 + 2] = v[2] * sc; t[kk * 65 + c4 + 3] = v[3] * sc;
  }
}
DI void cvt_store(u16* __restrict__ dst, int ldk, int kdst, int d0, int d1, const float* t, int ht) {
  const int kc = (ht & 7) * 8, nn = ht >> 3;
#pragma unroll
  for (int i = 0; i < 2; ++i) {
    const int tn = nn + 32 * i, row = (i == 0) ? d0 + nn : d1 + nn;
    u32x4 w;
    w[0] = pk2(t[(kc + 0) * 65 + tn], t[(kc + 1) * 65 + tn]);
    w[1] = pk2(t[(kc + 2) * 65 + tn], t[(kc + 3) * 65 + tn]);
    w[2] = pk2(t[(kc + 4) * 65 + tn], t[(kc + 5) * 65 + tn]);
    w[3] = pk2(t[(kc + 6) * 65 + tn], t[(kc + 7) * 65 + tn]);
    *(u32x4*)(dst + (size_t)row * ldk + kdst + kc) = w;
  }
}
struct CvtJob { const float* src; int N, k0, n0; const float* g; u16* dst; int ldk, d0, d1, kd; };
DI CvtJob cvt_job(const Params& p, int l, int ti) {
  CvtJob j; j.g = nullptr; j.kd = -1;
  const float* attn_g = p.in[1] + l * DM;
  if (ti < 608) { const int h = ti >> 4, kt = ti & 15; j.src = p.in[2] + (size_t)l * DM * INC; j.N = INC; j.k0 = kt * 64; j.n0 = qk_head_col(h); j.g = attn_g;
    j.dst = (u16*)(p.ws + OFF_WQKG) + (size_t)l * NQKG * DM; j.ldk = DM; j.d0 = (h >> 2) * 256 + (h & 3) * 32; j.d1 = j.d0 + 128; return j; }
  ti -= 608;
  if (ti < 1024) { const int c = ti >> 4, kt = ti & 15; j.src = p.in[2] + (size_t)l * DM * INC; j.N = INC; j.k0 = kt * 64; j.n0 = 3456 + 64 * c; j.g = attn_g;
    j.dst = (u16*)(p.ws + OFF_WQKG) + (size_t)l * NQKG * DM; j.ldk = DM; j.d0 = 2560 + 64 * c; j.d1 = j.d0 + 32; return j; }
  ti -= 1024;
  if (ti < 256) { const int vh = ti >> 4, kt = ti & 15; j.src = p.in[2] + (size_t)l * DM * INC; j.N = INC; j.k0 = kt * 64; j.n0 = v_head_col(vh); j.g = attn_g;
    j.dst = (u16*)(p.ws + OFF_WV) + (size_t)l * DM * DM; j.ldk = DM; j.d0 = vh * 64; j.d1 = j.d0 + 32; return j; }
  ti -= 256;
  if (ti < 128) { j.src = p.in[11] + (size_t)l * 512 * DM; j.N = DM; j.k0 = (ti >> 4) * 64; j.n0 = (ti & 15) * 64; j.dst = (u16*)(p.ws + OFF_WBR5) + ((size_t)l * 5 + (j.k0 >> 8)) * DM * 256; j.ldk = 256; j.kd = j.k0 & 255; j.d0 = j.n0; j.d1 = j.n0 + 32; return j; }
  ti -= 128;
  if (ti < 32) { j.src = p.in[12] + (size_t)l * 128 * DM; j.N = DM; j.k0 = (ti >> 4) * 64; j.n0 = (ti & 15) * 64; j.dst = (u16*)(p.ws + OFF_WBR5) + ((size_t)l * 5 + 2) * DM * 256; j.ldk = 256; j.kd = j.k0; j.d0 = j.n0; j.d1 = j.n0 + 32; return j; }
  ti -= 32;
  if (ti < 64) { j.src = p.in[13] + (size_t)l * 256 * DM; j.N = DM; j.k0 = (ti >> 4) * 64; j.n0 = (ti & 15) * 64; j.dst = (u16*)(p.ws + OFF_WBR5) + ((size_t)l * 5 + 3) * DM * 256; j.ldk = 256; j.kd = j.k0; j.d0 = j.n0; j.d1 = j.n0 + 32; return j; }
  ti -= 64;
  if (ti < 64) { j.src = p.in[14] + (size_t)l * 256 * DM; j.N = DM; j.k0 = (ti >> 4) * 64; j.n0 = (ti & 15) * 64; j.dst = (u16*)(p.ws + OFF_WBR5) + ((size_t)l * 5 + 4) * DM * 256; j.ldk = 256; j.kd = j.k0; j.d0 = j.n0; j.d1 = j.n0 + 32; return j; }
  ti -= 64;
  if (ti < 256) { j.src = p.in[15] + (size_t)l * DM * DM; j.N = DM; j.k0 = (ti >> 4) * 64; j.n0 = (ti & 15) * 64; j.dst = (u16*)(p.ws + OFF_WOUT) + (size_t)l * DM * DM; j.ldk = DM; j.d0 = j.n0; j.d1 = j.n0 + 32; return j; }
  ti -= 256;
  if (ti < 1024) { j.src = p.in[17] + (size_t)l * DM * DMLP; j.N = DMLP; j.k0 = (ti >> 6) * 64; j.n0 = (ti & 63) * 64; j.g = p.in[16] + l * DM;
    j.dst = (u16*)(p.ws + OFF_WUP) + (size_t)l * DMLP * DM; j.ldk = DM; j.d0 = j.n0; j.d1 = j.n0 + 32; return j; }
  ti -= 1024;
  j.src = p.in[18] + (size_t)l * DMLP * DM; j.N = DM; j.k0 = (ti >> 4) * 64; j.n0 = (ti & 15) * 64; j.dst = (u16*)(p.ws + OFF_WDN) + (size_t)l * DM * DMLP; j.ldk = DMLP; j.d0 = j.n0; j.d1 = j.n0 + 32; return j;
}

__device__ void phase_prep(const Params& p, int tid_, int bid_, int nblk_, unsigned char* smem) {
  const int half = tid_ >> 8, ht = tid_ & 255;
  float* t = (float*)smem + half * (64 * 65);
  const int per_layer = 4480, total = 2 * per_layer;
  for (int jp = bid_; jp * 2 < total; jp += nblk_) {
    const int j = jp * 2 + half;
    const bool on = j < total;
    CvtJob job;
    if (on) { job = cvt_job(p, j / per_layer, j % per_layer); cvt_load(job.src, job.N, job.k0, job.n0, job.g, t, ht); }
    __syncthreads();
    if (on) cvt_store(job.dst, job.ldk, (job.kd >= 0) ? job.kd : job.k0, job.d0, job.d1, t, ht);
    __syncthreads();
  }
  {
    const u32x4 z = {0u, 0u, 0u, 0u};
    for (int e = bid_ * NTHR + tid_; e < 2 * 128 * 128; e += nblk_ * NTHR) {
      const int l = e >> 14, r = (e >> 7) & 127, c = (e & 127) * 8;
      const int row = 9 * 256 + ((r < 64) ? 64 + r : 128 + r);
      *(u32x4*)((u16*)(p.ws + OFF_WQKG) + ((size_t)l * NQKG + row) * DM + c) = z;
    }
    for (int e = bid_ * NTHR + tid_; e < 2 * 1024 * 16; e += nblk_ * NTHR) {
      const int l = e >> 14, r = (e >> 4) & 1023, c = 128 + (e & 15) * 8;
      *(u32x4*)((u16*)(p.ws + OFF_WBR5) + (((size_t)l * 5 + 2) * DM + r) * 256 + c) = z;
    }
  }
  float* rope = (float*)(p.ws + OFF_ROPE);
  for (int e = bid_ * NTHR + tid_; e < SEQ * 48; e += nblk_ * NTHR) {
    const int pos = e / 48, i = e % 48;
    float inv;
    if (i < 32) inv = exp2f(-13.287712379549449f * (float)(2 * i) / 64.0f);
    else inv = exp2f(-13.287712379549449f * (float)(2 * (i - 32)) / 32.0f);
    const float angf = (float)pos * inv;
    const double ang = (double)angf;
    const double n = rint(ang * 0.15915494309189535);
    const float r = (float)(ang - n * 6.283185307179586);
    const float c = cosf(r), s = sinf(r);
    if (i < 32) { rope[pos * 96 + i] = c; rope[pos * 96 + 32 + i] = s; }
    else { rope[pos * 96 + 64 + (i - 32)] = c; rope[pos * 96 + 80 + (i - 32)] = s; }
  }
  u16* XB = (u16*)(p.ws + OFF_XB); float* SSQ = (float*)(p.ws + OFF_SSQ);
  const int lane = tid_ & 63;
  const int gw = bid_ * 8 + (tid_ >> 6), nw = nblk_ * 8;
  for (int row = gw; row < T; row += nw) {
    const float* xr = p.in[0] + (size_t)row * DM;
    float ss = 0.f;
#pragma unroll
    for (int i = 0; i < 4; ++i) {
      const f32x4 v = *(const f32x4*)(xr + i * 256 + lane * 4);
      ss += v[0] * v[0] + v[1] * v[1] + v[2] * v[2] + v[3] * v[3];
      u32x2 w = {pk2(v[0], v[1]), pk2(v[2], v[3])};
      *(u32x2*)(XB + (size_t)row * DM + i * 256 + lane * 4) = w;
    }
#pragma unroll
    for (int o = 32; o >= 1; o >>= 1) ss += __shfl_xor(ss, o);
    if (lane < 16) SSQ[(size_t)row * 16 + lane] = (lane == 0) ? ss : 0.f;
  }
}

DI void attn_softmax_pv(f32x16& S, float& m, float& l, f32x16& O0, f32x16& O1, const bf16x8 (&vf)[2][2]) {
  float mx = S[0];
#pragma unroll
  for (int i = 1; i < 16; ++i) mx = fmaxf(mx, S[i]);
  mx = fmaxf(mx, __shfl_xor(mx, 32));
  const float mn = fmaxf(m, mx);
  const float alpha = fexp2(m - mn);
  m = mn;
  float sum = 0.f;
#pragma unroll
  for (int i = 0; i < 16; ++i) { S[i] = fexp2(S[i] - mn); sum += S[i]; }
  l = l * alpha + sum;
  const u32x4 p0 = {pk2(S[0], S[1]), pk2(S[2], S[3]), pk2(S[4], S[5]), pk2(S[6], S[7])};
  const u32x4 p1 = {pk2(S[8], S[9]), pk2(S[10], S[11]), pk2(S[12], S[13]), pk2(S[14], S[15])};
#pragma unroll
  for (int i = 0; i < 16; ++i) { O0[i] *= alpha; O1[i] *= alpha; }
  O0 = MFMA32(vf[0][0], as_bf8(p0), O0);
  O0 = MFMA32(vf[0][1], as_bf8(p1), O0);
  O1 = MFMA32(vf[1][0], as_bf8(p0), O1);
  O1 = MFMA32(vf[1][1], as_bf8(p1), O1);
}
DI void load_vf(bf16x8 (&vf)[2][2], const u16* V, int kb, int lane) {
#pragma unroll
  for (int rb = 0; rb < 2; ++rb)
#pragma unroll
    for (int s = 0; s < 2; ++s) vf[rb][s] = *(const bf16x8*)(V + ((size_t)((kb * 2 + rb) * 2 + s) * 64 + lane) * 8);
}
DI void load_kf4(bf16x8 (&kf)[4], const u16* K, int kb, int lane) {
#pragma unroll
  for (int s = 0; s < 4; ++s) kf[s] = *(const bf16x8*)(K + ((size_t)(kb * 4 + s) * 64 + lane) * 8);
}
DI void load_kf2(bf16x8 (&kf)[2], const u16* K, int kb, int lane) {
#pragma unroll
  for (int s = 0; s < 2; ++s) kf[s] = *(const bf16x8*)(K + ((size_t)(kb * 2 + s) * 64 + lane) * 8);
}
DI void zero16(f32x16& a) {
#pragma unroll
  for (int i = 0; i < 16; ++i) a[i] = 0.f;
}
DI void store_o(u16* yrow, const f32x16& O0, const f32x16& O1, float sc, int h) {
#pragma unroll
  for (int g4 = 0; g4 < 4; ++g4) {
    u32x2 w0 = {pk2(O0[4 * g4] * sc, O0[4 * g4 + 1] * sc), pk2(O0[4 * g4 + 2] * sc, O0[4 * g4 + 3] * sc)};
    *(u32x2*)(yrow + 8 * g4 + 4 * h) = w0;
    u32x2 w1 = {pk2(O1[4 * g4] * sc, O1[4 * g4 + 1] * sc), pk2(O1[4 * g4 + 2] * sc, O1[4 * g4 + 3] * sc)};
    *(u32x2*)(yrow + 32 + 8 * g4 + 4 * h) = w1;
  }
}

__device__ void phase_attn(const Params& p, int tid_, int bid_, int nblk_, int layer) {
  const u16* QK = (const u16*)(p.ws + OFF_QK);
  const u16* VB = (const u16*)(p.ws + OFF_V);
  u16* Y5 = (u16*)(p.ws + OFF_Y5);
  u16* BO = (u16*)(p.ws + OFF_BO);
  float* LSE = (float*)(p.ws + OFF_LSE);
  const int lane = tid_ & 63, wave = tid_ >> 6;
  const int fr = lane & 31, fh = lane >> 5;
  const int nloc = nblk_ >> 3;
  if ((int)(bid_ >> 3) >= nloc) return;
  const int vw = ((bid_ & 7) * nloc + (bid_ >> 3)) * 8 + wave, NW = nloc * 64;
  const size_t GS = (size_t)TC * 64;
  const size_t BS = (size_t)SEQ * 64;

  {
    const float* lp = p.in[7] + layer * 128;
    float d01 = 0.f, d23 = 0.f;
    for (int i = 0; i < 32; ++i) { d01 += lp[i] * lp[32 + i]; d23 += lp[64 + i] * lp[96 + i]; }
    const float lambda_init = (layer == 0) ? 0.2f : 0.35550907f;
    const float lam = __expf(d01) - __expf(d23) + lambda_init;
    const float* subg = p.in[8] + layer * 64;
    const float sc = 0.17677669529663687f * LOG2E;
    for (int it = vw; it < BC * 4 * 128; it += NW) {
      const int bl = it >> 9, head = (it >> 7) & 3, qblk = it & 127;
      const u16* Q0 = QK + (22 + head) * GS + bl * BS; const u16* Q1 = Q0 + SEQ * 32;
      const u16* K0 = QK + (26 + head) * GS + bl * BS; const u16* K1 = K0 + SEQ * 32;
      const u16* V = VB + (8 + head) * GS + bl * BS;
      bf16x8 q0[2], q1[2];
      load_kf2(q0, Q0, qblk, lane); load_kf2(q1, Q1, qblk, lane);
      float m0 = -1e30f, l0 = 0.f, m1 = -1e30f, l1 = 0.f;
      f32x16 O00, O01, O10, O11; zero16(O00); zero16(O01); zero16(O10); zero16(O11);
      bf16x8 k0[2], k1[2], vf[2][2];
      load_kf2(k0, K0, 0, lane); load_kf2(k1, K1, 0, lane); load_vf(vf, V, 0, lane);
      for (int kb = 0; kb < 128; ++kb) {
        bf16x8 nk0[2], nk1[2], nvf[2][2];
        const int kn = (kb + 1 < 128) ? kb + 1 : kb;
        load_kf2(nk0, K0, kn, lane); load_kf2(nk1, K1, kn, lane); load_vf(nvf, V, kn, lane);
        f32x16 S0, S1; zero16(S0); zero16(S1);
        S0 = MFMA32(k0[0], q0[0], S0); S0 = MFMA32(k0[1], q0[1], S0);
        S1 = MFMA32(k1[0], q1[0], S1); S1 = MFMA32(k1[1], q1[1], S1);
#pragma unroll
        for (int i = 0; i < 16; ++i) { S0[i] *= sc; S1[i] *= sc; }
        attn_softmax_pv(S0, m0, l0, O00, O01, vf);
        attn_softmax_pv(S1, m1, l1, O10, O11, vf);
#pragma unroll
        for (int s = 0; s < 2; ++s) { k0[s] = nk0[s]; k1[s] = nk1[s]; vf[0][s] = nvf[0][s]; vf[1][s] = nvf[1][s]; }
      }
      const float i0 = 1.0f / (l0 + __shfl_xor(l0, 32));
      const float i1 = lam / (l1 + __shfl_xor(l1, 32));
      float ss = 0.f;
#pragma unroll
      for (int i = 0; i < 16; ++i) {
        O00[i] = O00[i] * i0 - O10[i] * i1; O01[i] = O01[i] * i0 - O11[i] * i1;
        ss += O00[i] * O00[i] + O01[i] * O01[i];
      }
      ss += __shfl_xor(ss, 32);
      const float rn = rsqrtf(ss * (1.0f / 64.0f) + 1e-6f) * (1.0f - lambda_init);
#pragma unroll
      for (int g4 = 0; g4 < 4; ++g4) {
        const f32x4 ga = *(const f32x4*)(subg + 8 * g4 + 4 * fh);
        const f32x4 gb = *(const f32x4*)(subg + 32 + 8 * g4 + 4 * fh);
#pragma unroll
        for (int e = 0; e < 4; ++e) { O00[4 * g4 + e] *= ga[e]; O01[4 * g4 + e] *= gb[e]; }
      }
      const size_t tok = (size_t)bl * SEQ + qblk * 32 + fr;
      store_o(Y5 + (size_t)3 * TC * 256 + tok * 256 + head * 64, O00, O01, rn, fh);
    }
  }
  {
    const float sc = 0.125f * LOG2E;
    for (int it = vw; it < BC * 8 * 128; it += NW) {
      const int bl = it >> 10, hq = (it >> 7) & 7, qblk = it & 127;
      const int kvh = hq >> 2;
      const u16* Q = QK + (size_t)hq * GS + bl * BS;
      const u16* K = QK + (size_t)(8 + kvh) * GS + bl * BS;
      const u16* V = VB + (size_t)kvh * GS + bl * BS;
      bf16x8 qf[4]; load_kf4(qf, Q, qblk, lane);
      float m = p.in[4][layer * 8 + hq] * LOG2E, l = (fh == 0) ? 1.0f : 0.0f;
      f32x16 O0, O1; zero16(O0); zero16(O1);
      const int kb_lo = (qblk - 4 < 0) ? 0 : qblk - 4, kb_hi = (qblk + 4 > 127) ? 127 : qblk + 4;
      const int qpos = qblk * 32 + fr;
      for (int kb = kb_lo; kb <= kb_hi; ++kb) {
        bf16x8 kf[4], vf[2][2];
        load_kf4(kf, K, kb, lane); load_vf(vf, V, kb, lane);
        f32x16 S; zero16(S);
#pragma unroll
        for (int s = 0; s < 4; ++s) S = MFMA32(kf[s], qf[s], S);
#pragma unroll
        for (int i = 0; i < 16; ++i) {
          const int dlt = kb * 32 + crow(i, fh) - qpos;
          S[i] = (dlt <= 128 && dlt >= -128) ? S[i] * sc : -1e30f;
        }
        attn_softmax_pv(S, m, l, O0, O1, vf);
      }
      const float inv = 1.0f / (l + __shfl_xor(l, 32));
      const size_t tok = (size_t)bl * SEQ + qpos;
      store_o(Y5 + (size_t)(hq >> 2) * TC * 256 + tok * 256 + (hq & 3) * 64, O0, O1, inv, fh);
    }
  }
  {
    const float sc = 0.125f;
    for (int it = vw; it < BC * 4 * 128; it += NW) {
      const int bl = it >> 9, head = (it >> 7) & 3, qblk = it & 127;
      const u16* Q = QK + (size_t)(30 + head) * GS + bl * BS;
      const u16* K = QK + (size_t)(34 + head) * GS + bl * BS;
      const u16* V = VB + (size_t)(12 + head) * GS + bl * BS;
      const float* rpb = p.in[10] + (size_t)(layer * 4 + head) * 15 * 31;
      bf16x8 qf[4]; load_kf4(qf, Q, qblk, lane);
      float m = -1e30f, l = 0.f;
      f32x16 O0, O1; zero16(O0); zero16(O1);
      const int qrow = qblk >> 1, qc = (qblk & 1) * 32 + fr;
      int r0 = qrow - 4; r0 = r0 < 0 ? 0 : (r0 > 56 ? 56 : r0);
      int c0 = qc - 8; c0 = c0 < 0 ? 0 : (c0 > 48 ? 48 : c0);
      for (int kk = 0; kk < 16; ++kk) {
        const int krow_ = r0 + (kk >> 1), hb = kk & 1, kb = krow_ * 2 + hb;
        bf16x8 kf[4], vf[2][2];
        load_kf4(kf, K, kb, lane); load_vf(vf, V, kb, lane);
        f32x16 S; zero16(S);
#pragma unroll
        for (int s = 0; s < 4; ++s) S = MFMA32(kf[s], qf[s], S);
        const float* brow = rpb + (krow_ - qrow + 7) * 31;
#pragma unroll
        for (int i = 0; i < 16; ++i) {
          const int kc = hb * 32 + crow(i, fh);
          int dc = kc - qc; dc = dc < -15 ? -15 : (dc > 15 ? 15 : dc);
          const float bias = brow[dc + 15];
          S[i] = (kc >= c0 && kc < c0 + 16) ? (S[i] * sc + bias) * LOG2E : -1e30f;
        }
        attn_softmax_pv(S, m, l, O0, O1, vf);
      }
      const float inv = 1.0f / (l + __shfl_xor(l, 32));
      const size_t tok = (size_t)bl * SEQ + qblk * 32 + fr;
      store_o(Y5 + (size_t)4 * TC * 256 + tok * 256 + head * 64, O0, O1, inv, fh);
    }
  }
  {
    const float sc = 0.125f * LOG2E;
    for (int it = vw; it < BC * 6 * 128; it += NW) {
      const int bl = it / 768, rem = it % 768, head = rem >> 7, qblk = rem & 127;
      const int dil = dil_of(head >> 1), L = SEQ / dil, LB = L >> 5;
      const u16* Q = QK + (size_t)(10 + head) * GS + bl * BS;
      const u16* K = QK + (size_t)(16 + head) * GS + bl * BS;
      const u16* V = VB + (size_t)(2 + head) * GS + bl * BS;
      bf16x8 qf[4]; load_kf4(qf, Q, qblk, lane);
      float m = -1e30f, l = 0.f;
      f32x16 O0, O1; zero16(O0); zero16(O1);
      const int rsub = qblk / LB;
      const int lo = rsub * LB, hi = lo + LB - 1;
      const int kb_lo = (qblk - 2 < lo) ? lo : qblk - 2, kb_hi = (qblk + 2 > hi) ? hi : qblk + 2;
      const int qd = qblk * 32 + fr;
      for (int kb = kb_lo; kb <= kb_hi; ++kb) {
        bf16x8 kf[4], vf[2][2];
        load_kf4(kf, K, kb, lane); load_vf(vf, V, kb, lane);
        f32x16 S; zero16(S);
#pragma unroll
        for (int s = 0; s < 4; ++s) S = MFMA32(kf[s], qf[s], S);
#pragma unroll
        for (int i = 0; i < 16; ++i) {
          const int dlt = kb * 32 + crow(i, fh) - qd;
          S[i] = (dlt <= 64 && dlt >= -64) ? S[i] * sc : -1e30f;
        }
        attn_softmax_pv(S, m, l, O0, O1, vf);
      }
      const float lt = l + __shfl_xor(l, 32);
      const float inv = 1.0f / lt;
      const int msub = qd - rsub * L;
      const int pos = msub * dil + rsub;
      const size_t tok = (size_t)bl * SEQ + pos;
      store_o(BO + tok * 384 + head * 64, O0, O1, inv, fh);
      if (fh == 0) LSE[tok * 8 + head] = __log2f(lt) + m;
    }
  }
}


__device__ void phase_bcombine(const Params& p, int tid_, int bid_, int nblk_) {
  const u16* BO = (const u16*)(p.ws + OFF_BO);
  const float* LSE = (const float*)(p.ws + OFF_LSE);
  u16* YB = (u16*)(p.ws + OFF_Y5) + (size_t)2 * TC * 256;
  for (int e = bid_ * NTHR + tid_; e < TC * 16; e += nblk_ * NTHR) {
    const int tok = e >> 4, j = (e >> 3) & 1, c8 = (e & 7) * 8;
    const float a0 = LSE[(size_t)tok * 8 + j], a1 = LSE[(size_t)tok * 8 + 2 + j], a2 = LSE[(size_t)tok * 8 + 4 + j];
    const float mx = fmaxf(a0, fmaxf(a1, a2));
    float w0 = fexp2(a0 - mx), w1 = fexp2(a1 - mx), w2 = fexp2(a2 - mx);
    const float inv = 1.0f / (w0 + w1 + w2);
    w0 *= inv; w1 *= inv; w2 *= inv;
    const u32x4 x0 = *(const u32x4*)(BO + (size_t)tok * 384 + (0 + j) * 64 + c8);
    const u32x4 x1 = *(const u32x4*)(BO + (size_t)tok * 384 + (2 + j) * 64 + c8);
    const u32x4 x2 = *(const u32x4*)(BO + (size_t)tok * 384 + (4 + j) * 64 + c8);
    u32x4 o;
#pragma unroll
    for (int q = 0; q < 4; ++q) {
      const float lo = w0 * bf_lo(x0[q]) + w1 * bf_lo(x1[q]) + w2 * bf_lo(x2[q]);
      const float hi = w0 * bf_hi(x0[q]) + w1 * bf_hi(x1[q]) + w2 * bf_hi(x2[q]);
      o[q] = pk2(lo, hi);
    }
    *(u32x4*)(YB + (size_t)tok * 256 + j * 64 + c8) = o;
    const u32x4 z = {0u, 0u, 0u, 0u};
    *(u32x4*)(YB + (size_t)tok * 256 + 128 + (e & 15) * 8) = z;
  }
}

#define XB_TMO      128
#define XB_XCNT(j)  (256  + 64 * (j))
#define XB_XSUB(j)  (1280 + 64 * (j))
#define XB_XGEN(j)  (2304 + 64 * (j))
#define XB_TOP      3328
#define XB_TOPGEN   3392
#define XCD_BAR_WORDS 3456
#define XB_SPIN_CAP (1u << 22)
#define LAS __attribute__((address_space(3)))
DI unsigned xb_ld(unsigned* p)              { return __hip_atomic_load(p, __ATOMIC_RELAXED, __HIP_MEMORY_SCOPE_AGENT); }
DI unsigned xb_add(unsigned* p, unsigned v) { return __hip_atomic_fetch_add(p, v, __ATOMIC_RELAXED, __HIP_MEMORY_SCOPE_AGENT); }
DI unsigned xb_xcc_id() { return (unsigned)__builtin_amdgcn_s_getreg((3 << 11) | 20) & 0xFu; }
#define XB_SPIN(cond, bar) do { unsigned _sp = 0; while (cond) { __builtin_amdgcn_s_sleep(1); \
    if ((++_sp & 255u) == 0u) { if (xb_ld(&(bar)[XB_TMO])) break; if (_sp > XB_SPIN_CAP) { atomicAdd(&(bar)[XB_TMO], 1u); break; } } } } while (0)
struct XcdBarrier { unsigned* bar; unsigned x; volatile LAS unsigned* st; };
DI XcdBarrier xcd_barrier_post(unsigned* bar, volatile LAS unsigned* st) {
  XcdBarrier b; b.bar = bar; b.x = xb_xcc_id(); b.st = st;
  if (threadIdx.x == 0) (void)xb_add(&bar[XB_XCNT(b.x)], 1u);
  return b;
}
DI void xcd_barrier_complete(unsigned* bar, unsigned x, unsigned& nloc, unsigned& nx) {
  const unsigned G = gridDim.x * gridDim.y * gridDim.z;
  unsigned sum, cnt, mine, sp = 0u;
  for (;;) {
    sum = 0u; cnt = 0u; mine = 0u;
#pragma unroll
    for (unsigned j = 0; j < 16; ++j) { const unsigned c = xb_ld(&bar[XB_XCNT(j)]); sum += c; cnt += (c > 0u) ? 1u : 0u; mine = (j == x) ? c : mine; }
    if (sum == G) break;
    __builtin_amdgcn_s_sleep(1);
    if ((++sp & 255u) == 0u) { if (xb_ld(&bar[XB_TMO])) break; if (sp > XB_SPIN_CAP) { atomicAdd(&bar[XB_TMO], 1u); break; } }
  }
  nloc = mine > 0u ? mine : 1u; nx = cnt > 0u ? cnt : 1u;
}
DI void xcd_barrier(const XcdBarrier& b) {
  asm volatile("s_waitcnt vmcnt(0)" ::: "memory");
  __syncthreads();
  if (threadIdx.x == 0) {
    unsigned* bar = b.bar;
    __builtin_amdgcn_s_waitcnt(0);
    unsigned nloc = b.st[0], nx = b.st[1];
    if (nloc == 0u) { xcd_barrier_complete(bar, b.x, nloc, nx); b.st[0] = nloc; b.st[1] = nx; }
    const unsigned old = xb_add(&bar[XB_XSUB(b.x)], 1u);
    const unsigned gen = old / nloc;
    if (old + 1u == (gen + 1u) * nloc) {
      __builtin_amdgcn_fence(__ATOMIC_RELEASE, "agent");
      asm volatile("s_waitcnt vmcnt(0)" ::: "memory");
      const unsigned og = xb_add(&bar[XB_TOP], 1u);
      const unsigned tg = og / nx;
      if (og + 1u == (tg + 1u) * nx) xb_add(&bar[XB_TOPGEN], 1u);
      else XB_SPIN(xb_ld(&bar[XB_TOPGEN]) == tg, bar);
      __builtin_amdgcn_fence(__ATOMIC_ACQUIRE, "agent");
      xb_add(&bar[XB_XGEN(b.x)], 1u);
      asm volatile("s_waitcnt vmcnt(0)" ::: "memory");
    } else {
      XB_SPIN(xb_ld(&bar[XB_XGEN(b.x)]) == gen, bar);
      __builtin_amdgcn_fence(__ATOMIC_ACQUIRE, "agent");
      asm volatile("s_waitcnt vmcnt(0)" ::: "memory");
    }
  }
  __syncthreads();
}

__global__ void __launch_bounds__(NTHR, 2) mk_forward(Params p) {
  extern __shared__ __attribute__((aligned(16))) unsigned char smem[];
  cg::grid_group grid = cg::this_grid();
  volatile LAS unsigned* xbw = (volatile LAS unsigned*)(smem + LDS_STAGE);
  if (threadIdx.x < 4) xbw[threadIdx.x] = 0u;
  __syncthreads();
  XcdBarrier xb;
  if (FUSED) xb = xcd_barrier_post((unsigned*)(p.ws + OFF_BAR), xbw);
  PG8_LAS unsigned char* lds = (PG8_LAS unsigned char*)smem;
  for (int ph = p.ph_lo; ph < p.ph_hi; ++ph) {
#if DUPMASK
   for (int rep = 0; rep < ((ph > 0 && ((DUPMASK >> ((ph - 1) % 7)) & 1)) ? 2 : 1); ++rep)
#endif
   {
    int tid_ = threadIdx.x, bid_ = blockIdx.x, nblk_ = gridDim.x;
    asm volatile("" : "+v"(tid_));
    asm volatile("" : "+s"(bid_));
    asm volatile("" : "+s"(nblk_));
    Params pp = p;
    asm volatile("" : "+s"(pp.ws));
    asm volatile("" : "+s"(pp.out));
    unsigned char* ws = pp.ws;
    if (ph == 0) {
      if (PHMASK & 128) phase_prep(pp, tid_, bid_, nblk_, smem);
    } else {
      const int q = ph - 1, chunk = q / (2 * PPL), layer = (q % (2 * PPL)) / PPL, kk = q % PPL, k = (kk == 7) ? DUPK : kk;
      const u16* XBc = (const u16*)(ws + OFF_XB) + (size_t)chunk * TC * DM;
      float* SSQc = (float*)(ws + OFF_SSQ) + (size_t)chunk * TC * 16;
      float* xc = pp.out + (size_t)chunk * TC * DM;
      if ((k == 0 && (PHMASK & 1)) || (k == 5 && (PHMASK & 32))) {
        const bool up = (k == 5);
        if (!up) {
          EpiQKG e; e.ssq = SSQc; e.qk = (u16*)(ws + OFF_QK); e.rope = (const float*)(ws + OFF_ROPE);
          e.gA = pp.in[3] + layer * 128; e.gB = pp.in[5] + layer * 128; e.gC = pp.in[6] + layer * 64; e.gD = pp.in[9] + layer * 128;
          run_gemm(lds, XBc, (const u16*)(ws + OFF_WQKG) + (size_t)layer * NQKG * DM, TC, 2560, DM, e);
        }
        {
          EpiGateUp e; e.ssq = SSQc; e.o = (u16*)(ws + OFF_GATE); e.mode = up ? 1 : 0;
          const u16* W = up ? (const u16*)(ws + OFF_WUP) + (size_t)layer * DMLP * DM : (const u16*)(ws + OFF_WQKG) + ((size_t)layer * NQKG + 2560) * DM;
          run_gemm(lds, XBc, W, TC, 4096, DM, e);
        }
        if (!up) {
          EpiVT ev; ev.ssq = SSQc; ev.vbuf = (u16*)(ws + OFF_V);
          run_gemm(lds, (const u16*)(ws + OFF_WV) + (size_t)layer * DM * DM, XBc, DM, TC, DM, ev);
        }
      } else if (k == 1 && (PHMASK & 2)) {
        phase_attn(pp, tid_, bid_, nblk_, layer);
      } else if (k == 2 && (PHMASK & 4)) {
        phase_bcombine(pp, tid_, bid_, nblk_);
      } else if (k == 3 && (PHMASK & 8)) {
        EpiMerge e; e.gate = (const u16*)(ws + OFF_GATE); e.mrg = (u16*)(ws + OFF_MRG);
        run_merge(lds, (const u16*)(ws + OFF_Y5), (const u16*)(ws + OFF_WBR5) + (size_t)layer * 5 * DM * 256, e);
      } else if ((k == 4 && (PHMASK & 16)) || (k == 6 && (PHMASK & 64))) {
        const bool dn = (k == 6);
        EpiResid e; e.xold = (!dn && layer == 0) ? (pp.in[0] + (size_t)chunk * TC * DM) : xc; e.xout = xc; e.xb = (u16*)XBc; e.ssq = SSQc;
        const u16* A = dn ? (const u16*)(ws + OFF_GATE) : (const u16*)(ws + OFF_MRG);
        const u16* W = dn ? (const u16*)(ws + OFF_WDN) + (size_t)layer * DM * DMLP : (const u16*)(ws + OFF_WOUT) + (size_t)layer * DM * DM;
        run_gemm(lds, A, W, TC, DM, dn ? DMLP : DM, e);
      }
    }
   }
    if (ph + 1 < p.ph_hi) {
      if (ph == 0) grid.sync();
      else xcd_barrier(xb);
    }
  }
}

extern "C" void kernel_launch(void* const* d_in, const int* in_sizes, int n_in, void* d_out, int out_size, void* d_ws, size_t ws_size,
                              hipStream_t stream) {
  static int grid_blocks = 0;
  if (grid_blocks == 0) {
    if (n_in != 19 || out_size != T * DM || ws_size < WS_END) {
      fprintf(stderr, "kernel_launch: unexpected problem (n_in %d out %d ws %zu need %zu)\n", n_in, out_size, ws_size, (size_t)WS_END);
      grid_blocks = -1;
      return;
    }
    int dev = 0, cus = 0, per_cu = 0;
    (void)hipGetDevice(&dev);
    (void)hipDeviceGetAttribute(&cus, hipDeviceAttributeMultiprocessorCount, dev);
    if (hipFuncSetAttribute((const void*)mk_forward, hipFuncAttributeMaxDynamicSharedMemorySize, LDS_BYTES) != hipSuccess) {
      fprintf(stderr, "kernel_launch: hipFuncSetAttribute failed\n"); grid_blocks = -1; return;
    }
    (void)hipOccupancyMaxActiveBlocksPerMultiprocessor(&per_cu, mk_forward, NTHR, LDS_BYTES);
    if (per_cu < 1) fprintf(stderr, "kernel_launch: occupancy query says %d blocks per CU\n", per_cu);
    (void)hipGetLastError();
    grid_blocks = cus;
  }
  if (grid_blocks < 0) return;
  Params p{};
  for (int i = 0; i < 19; ++i) p.in[i] = (const float*)d_in[i];
  p.out = (float*)d_out;
  p.ws = (unsigned char*)d_ws;
#if FUSED
  (void)hipMemsetAsync((unsigned char*)d_ws + OFF_BAR, 0, XCD_BAR_WORDS * 4, stream);
  p.ph_lo = 0; p.ph_hi = NPHASE;
  void* args[] = {&p};
  hipError_t e = hipLaunchCooperativeKernel((const void*)mk_forward, dim3(grid_blocks), dim3(NTHR), args, LDS_BYTES, stream);
  if (e != hipSuccess) fprintf(stderr, "cooperative launch failed: %s (grid %d)\n", hipGetErrorString(e), grid_blocks);
#else
  for (int ph = 0; ph < NPHASE; ++ph) {
    p.ph_lo = ph; p.ph_hi = ph + 1;
    hipLaunchKernelGGL(mk_forward, dim3(grid_blocks), dim3(NTHR), LDS_BYTES, stream, p);
  }
#endif
}
```

```cpp
#include <hip/hip_runtime.h>
#include <hip/hip_cooperative_groups.h>
#include <cstdio>
namespace cg = cooperative_groups;

#ifndef PHMASK
#define PHMASK 255
#endif
#ifndef DUPMASK
#define DUPMASK 0
#endif
#ifndef DUPK
#define DUPK -1
#endif
#ifndef PROBE_NOEPI
#define PROBE_NOEPI 0
#endif
#ifndef FUSED
#define FUSED 1
#endif

namespace pg8 {
#define PG8_LAS __attribute__((address_space(3)))
typedef unsigned short bf16_t;
typedef short bf16x8 __attribute__((ext_vector_type(8)));
typedef float f32x4 __attribute__((ext_vector_type(4)));
typedef unsigned u32x4 __attribute__((ext_vector_type(4)));
constexpr int BM = 256, BK = 64, HALF = 128, HTB = HALF * BK * 2  , STAGE_BYTES = 8 * HTB, NXCD = 8, WGM = 8;

__host__ __device__ __forceinline__ int lds_byte(int r, int c) { const int st = (r >> 4) * 2 + (c >> 5), rr = r & 15, cc = c & 31, ob = rr * 64 + cc * 2; return st * 1024 + (ob ^ (((ob >> 9) & 1) << 5)); }
__host__ __device__ __forceinline__ void stage_rc(int b, int& R, int& C) { const int st = b / 1024, sb = b % 1024, swz = sb ^ (((sb >> 9) & 1) << 5); R = (st >> 1) * 16 + swz / 64; C = (st & 1) * 32 + (swz % 64) / 2; }
__host__ __device__ __forceinline__ int perm32(int rho) { const int n = rho >> 4, i = rho & 15; return 8 * (i >> 2) + 4 * n + (i & 3); }

struct Unit { int pm, pn, seg; };
struct Gemm { const bf16_t* A; const bf16_t* Bt; int M, N, K; };

struct StaticOrder {
    int nM, nN, nwg, G, c, probe = 0;
    __host__ __device__ void init(int M, int N, int G_, int c_) { nM = M / BM; nN = N / BM; nwg = nM * nN; G = G_; c = c_; }
    __host__ __device__ bool next(int i, Unit& u) const {
        const long L = (long)i * G + c; if (L >= nwg) return false;
        int wgid = (int)L; { const int q = nwg / NXCD, r = nwg % NXCD, xcd = wgid % NXCD, off = wgid / NXCD; wgid = (xcd < r ? xcd * (q + 1) : r * (q + 1) + (xcd - r) * q) + off; }
        const int nig = WGM * nN, gid = wgid / nig, fm = gid * WGM, gsz = (nM - fm) < WGM ? (nM - fm) : WGM;
        u.pm = fm + ((wgid % nig) % gsz); u.pn = (wgid % nig) / gsz; u.seg = 0; if (probe) { u.pm = 0; u.pn = 0; } return true;
    }
    __device__ __forceinline__ void a_ready(const Unit&) const {}
    __device__ __forceinline__ void done(const Unit&) const {}
    __device__ __forceinline__ const char* baseA(const Gemm& g, const Unit& u, size_t tstep) const { return (const char*)g.A + (size_t)u.pm * tstep; }
    __device__ __forceinline__ const char* baseB(const Gemm& g, const Unit& u, size_t tstep) const { return (const char*)g.Bt + (size_t)u.pn * tstep; }
    __device__ __forceinline__ bool zero_after(const Unit&) const { return true; }
};

template <class Epi, class Sched, bool STAMP = false>
__device__ __forceinline__ void gemm_phase(PG8_LAS unsigned char* lds, const Gemm g, const Sched& S, const Epi& E, unsigned long long* stamps) {
    int tid = threadIdx.x; asm volatile("" : "+v"(tid));
    const int wid = __builtin_amdgcn_readfirstlane(tid >> 6), lane = tid & 63, wr = wid >> 2, wc = wid & 3, fr = lane & 15, fq = lane >> 4;
    const int K = g.K, nt = K / BK;
    int ts_lo = 0, ts_hi = 0, nts = 0; const unsigned long long rt_entry = STAMP ? (unsigned long long)wall_clock64() : 0ull;
#define PG8_STAMP() do { if (STAMP && wid == 0 && nts < 64) { const unsigned long long _c = (unsigned long long)clock64(); \
        ts_lo = (lane == nts) ? (int)(unsigned)_c : ts_lo; ts_hi = (lane == nts) ? (int)(unsigned)(_c >> 32) : ts_hi; ++nts; } } while (0)
    PG8_STAMP();
    unsigned voffA[2], voffB[2];
#pragma unroll
    for (int i = 0; i < 2; ++i) { int R, C; stage_rc(tid * 16 + i * 8192, R, C); const int Rb = Epi::PERM ? ((R & ~31) + perm32(R & 31)) : R;
        voffA[i] = (unsigned)(R * K + C) * 2u; voffB[i] = (unsigned)(Rb * K + C) * 2u; }
    const size_t kstep = (size_t)(BK * 2);
    const size_t hstep = (size_t)HALF * K * 2;
    const size_t tstep = 2 * hstep;
    const unsigned ldsw = (unsigned)wid * 1024u;
    const int aoff = lds_byte(wr * 64 + fr, fq * 8), boff = lds_byte(wc * 32 + fr, fq * 8);
#define PG8_SA(b, h) (((b) * 2 + (h)) * HTB)
#define PG8_SB(b, h) ((4 + (b) * 2 + (h)) * HTB)
#define PG8_STAGE(bufoff, gbase, voff) do { _Pragma("unroll") for (int _i = 0; _i < 2; ++_i) \
        __builtin_amdgcn_global_load_lds((const unsigned*)((const char*)(gbase) + (voff)[_i]), (PG8_LAS unsigned*)(lds + (bufoff) + ldsw + _i * 8192), 16, 0, 0); } while (0)
#define PG8_LDA(dst, b, h) do { _Pragma("unroll") for (int m = 0; m < 4; ++m) _Pragma("unroll") for (int k = 0; k < 2; ++k) dst[m][k] = *(const PG8_LAS bf16x8*)(lds + PG8_SA(b, h) + aoff + m * 2048 + k * 1024); } while (0)
#define PG8_LDB(dst, b, h) do { _Pragma("unroll") for (int n = 0; n < 2; ++n) _Pragma("unroll") for (int k = 0; k < 2; ++k) dst[n][k] = *(const PG8_LAS bf16x8*)(lds + PG8_SB(b, h) + boff + n * 2048 + k * 1024); } while (0)
#define PG8_MMA(ai, bj, At, Bt) do { __builtin_amdgcn_s_setprio(1); _Pragma("unroll") for (int m = 0; m < 4; ++m) _Pragma("unroll") for (int n = 0; n < 2; ++n) _Pragma("unroll") for (int k = 0; k < 2; ++k) \
        acc[ai][bj][m][n] = __builtin_amdgcn_mfma_f32_16x16x32_bf16(Bt[n][k], At[m][k], acc[ai][bj][m][n], 0, 0, 0); __builtin_amdgcn_s_setprio(0); } while (0)
#define PG8_WAIT_V(n) asm volatile("s_waitcnt vmcnt(" #n ")" ::: "memory")
#define PG8_WAIT_L(n) asm volatile("s_waitcnt lgkmcnt(" #n ")" ::: "memory")
#define PG8_BAR __builtin_amdgcn_s_barrier()
#define PG8_SCHED __builtin_amdgcn_sched_barrier(0)
    Unit cur, nxt; int ui = 0;
    if (!S.next(0, cur)) return;
    f32x4 acc[2][2][4][2];
#pragma unroll
    for (int a = 0; a < 2; ++a)
#pragma unroll
        for (int b = 0; b < 2; ++b)
#pragma unroll
            for (int m = 0; m < 4; ++m)
#pragma unroll
                for (int n = 0; n < 2; ++n) acc[a][b][m][n] = (f32x4){0.f, 0.f, 0.f, 0.f};
    bf16x8 At[4][2], B0[2][2], B1[2][2];
    const char* cA = S.baseA(g, cur, tstep); const char* cB = S.baseB(g, cur, tstep);
    S.a_ready(cur);
    PG8_STAGE(PG8_SB(0, 0), cB, voffB); PG8_STAGE(PG8_SA(0, 0), cA, voffA); PG8_STAGE(PG8_SB(0, 1), cB + hstep, voffB); PG8_STAGE(PG8_SA(0, 1), cA + hstep, voffA);
    if (wr == 1) PG8_BAR;
    PG8_WAIT_V(4); PG8_BAR;
    PG8_STAGE(PG8_SB(1, 0), cB + kstep, voffB); PG8_STAGE(PG8_SA(1, 0), cA + kstep, voffA); PG8_STAGE(PG8_SB(1, 1), cB + hstep + kstep, voffB);
    PG8_WAIT_V(6); PG8_BAR;
    PG8_STAMP();
    for (;;) {
        const bool has_next = S.next(ui + 1, nxt);
        const char* nA = has_next ? S.baseA(g, nxt, tstep) : cA; const char* nB = has_next ? S.baseB(g, nxt, tstep) : cB;
        for (int t = 0; t < nt; t += 2) {
            const bool last = (t == nt - 2);
            const char* a1 = cA + (size_t)(t + 1) * kstep;
            const char* a2 = last ? nA : cA + (size_t)(t + 2) * kstep; const char* b2 = last ? nB : cB + (size_t)(t + 2) * kstep;
            const char* a3 = a2 + kstep; const char* b3 = b2 + kstep;
            if (last && has_next) S.a_ready(nxt);
            PG8_LDB(B0, 0, 0); PG8_SCHED; PG8_LDA(At, 0, 0); PG8_STAGE(PG8_SA(1, 1), a1 + hstep, voffA);
            PG8_WAIT_L(8); PG8_BAR; PG8_WAIT_L(0); PG8_MMA(0, 0, At, B0); PG8_BAR; PG8_SCHED;
            PG8_LDB(B1, 0, 1); PG8_STAGE(PG8_SB(0, 0), b2, voffB);
            PG8_BAR; PG8_WAIT_L(0); PG8_MMA(0, 1, At, B1); PG8_BAR;
            PG8_LDA(At, 0, 1); PG8_STAGE(PG8_SA(0, 0), a2, voffA);
            PG8_BAR; PG8_WAIT_L(0); PG8_MMA(1, 0, At, B0); PG8_BAR; PG8_SCHED;
            PG8_STAGE(PG8_SB(0, 1), b2 + hstep, voffB);
            PG8_WAIT_V(6); PG8_BAR; PG8_MMA(1, 1, At, B1); PG8_BAR;
            PG8_LDB(B0, 1, 0); PG8_SCHED; PG8_LDA(At, 1, 0); PG8_STAGE(PG8_SA(0, 1), a2 + hstep, voffA);
            PG8_WAIT_L(8); PG8_BAR; PG8_WAIT_L(0); PG8_MMA(0, 0, At, B0); PG8_BAR; PG8_SCHED;
            PG8_LDB(B1, 1, 1); PG8_STAGE(PG8_SB(1, 0), b3, voffB);
            PG8_BAR; PG8_WAIT_L(0); PG8_MMA(0, 1, At, B1); PG8_BAR;
            PG8_LDA(At, 1, 1); PG8_STAGE(PG8_SA(1, 0), a3, voffA);
            PG8_BAR; PG8_WAIT_L(0); PG8_MMA(1, 0, At, B0); PG8_BAR; PG8_SCHED;
            PG8_STAGE(PG8_SB(1, 1), b3 + hstep, voffB);
            PG8_WAIT_V(6); PG8_BAR; PG8_MMA(1, 1, At, B1); PG8_BAR;
        }
        PG8_STAMP();
        if constexpr (!Epi::AFTER_DRAIN) { E(acc, cur, wr, wc, fr, fq); S.done(cur); }
        PG8_STAMP();
        if (!has_next) break;
        if (S.zero_after(cur))
#pragma unroll
        for (int a = 0; a < 2; ++a)
#pragma unroll
            for (int b = 0; b < 2; ++b)
#pragma unroll
                for (int m = 0; m < 4; ++m)
#pragma unroll
                    for (int n = 0; n < 2; ++n) acc[a][b][m][n] = (f32x4){0.f, 0.f, 0.f, 0.f};
        cur = nxt; cA = nA; cB = nB; ++ui;
    }
    PG8_WAIT_V(0);
    if (wr == 0) PG8_BAR;
    PG8_BAR;
    if constexpr (Epi::AFTER_DRAIN) { E.fused(acc, cur, wr, wc, fr, fq, lds, wid, lane); S.done(cur); }
    PG8_STAMP();
    if (STAMP && wid == 0) { stamps[lane] = lane < nts ? (((unsigned long long)(unsigned)ts_hi << 32) | (unsigned)ts_lo) : 0ull;
        if (lane == 62) stamps[62] = rt_entry; if (lane == 63) stamps[63] = (unsigned long long)wall_clock64(); }
#undef PG8_STAMP
#undef PG8_SA
#undef PG8_SB
#undef PG8_STAGE
#undef PG8_LDA
#undef PG8_LDB
#undef PG8_MMA
#undef PG8_WAIT_V
#undef PG8_WAIT_L
#undef PG8_BAR
#undef PG8_SCHED
}
}

typedef unsigned short u16;
typedef short bf16x8 __attribute__((ext_vector_type(8)));
typedef float f32x16 __attribute__((ext_vector_type(16)));
typedef float f32x4 __attribute__((ext_vector_type(4)));
typedef __bf16 bf2_t __attribute__((ext_vector_type(2)));
typedef float f2_t __attribute__((ext_vector_type(2)));
typedef unsigned u32x4 __attribute__((ext_vector_type(4)));
typedef unsigned u32x2 __attribute__((ext_vector_type(2)));
using pg8::Unit;

#define DI __device__ __forceinline__
#define MFMA32(a, b, c) __builtin_amdgcn_mfma_f32_32x32x16_bf16((a), (b), (c), 0, 0, 0)

constexpr int DM = 1024, SEQ = 4096, NBATCH = 8, T = NBATCH * SEQ;
constexpr int NCH = 2, BC = NBATCH / NCH, TC = BC * SEQ;
constexpr int INC = 7552, DMLP = 4096;
constexpr int NQKG = 6656;
constexpr int NQKH = 38, NVH = 16;
constexpr float LOG2E = 1.4426950408889634f;
constexpr int NTHR = 512;

constexpr size_t al256(size_t x) { return (x + 255) & ~(size_t)255; }
constexpr size_t OFF_WQKG = 0;
constexpr size_t OFF_WV   = OFF_WQKG + al256((size_t)2 * NQKG * DM * 2);
constexpr size_t OFF_WBR5 = OFF_WV   + al256((size_t)2 * DM * DM * 2);
constexpr size_t OFF_WOUT = OFF_WBR5 + al256((size_t)2 * 5 * DM * 256 * 2);
constexpr size_t OFF_WUP  = OFF_WOUT + al256((size_t)2 * DM * DM * 2);
constexpr size_t OFF_WDN  = OFF_WUP  + al256((size_t)2 * DMLP * DM * 2);
constexpr size_t OFF_ROPE = OFF_WDN  + al256((size_t)2 * DM * DMLP * 2);
constexpr size_t OFF_XB   = OFF_ROPE + al256((size_t)SEQ * 96 * 4);
constexpr size_t OFF_SSQ  = OFF_XB   + al256((size_t)T * DM * 2);
constexpr size_t OFF_QK   = OFF_SSQ  + al256((size_t)T * 16 * 4);
constexpr size_t OFF_V    = OFF_QK   + al256((size_t)NQKH * TC * 64 * 2);
constexpr size_t OFF_GATE = OFF_V    + al256((size_t)NVH * TC * 64 * 2);
constexpr size_t OFF_Y5   = OFF_GATE + al256((size_t)TC * 4096 * 2);
constexpr size_t OFF_BO   = OFF_Y5   + al256((size_t)5 * TC * 256 * 2);
constexpr size_t OFF_LSE  = OFF_BO   + al256((size_t)TC * 384 * 2);
constexpr size_t OFF_MRG  = OFF_LSE  + al256((size_t)TC * 8 * 4);
constexpr size_t OFF_BAR  = OFF_MRG  + al256((size_t)TC * DM * 2);
constexpr size_t WS_END   = OFF_BAR  + 16384;
static_assert(WS_END <= (size_t)512 * 1024 * 1024, "workspace too large");

constexpr int LDS_STAGE = 131072;
constexpr int LDS_BYTES = LDS_STAGE + 64;
constexpr int PPL = (DUPK >= 0) ? 8 : 7;
constexpr int NPHASE = 1 + NCH * 2 * PPL;

struct Params {
  const float* in[19];
  float* out;
  unsigned char* ws;
  int ph_lo, ph_hi;
};

DI unsigned pk2(float a, float b) { f2_t v = {a, b}; bf2_t r = __builtin_convertvector(v, bf2_t); return __builtin_bit_cast(unsigned, r); }
DI float bf_lo(unsigned u) { return __uint_as_float(u << 16); }
DI float bf_hi(unsigned u) { return __uint_as_float(u & 0xffff0000u); }
DI float fexp2(float x) { return __builtin_amdgcn_exp2f(x); }
DI int crow(int i, int h) { return (i & 3) + 8 * (i >> 2) + 4 * h; }
DI bf16x8 as_bf8(u32x4 v) { return __builtin_bit_cast(bf16x8, v); }
DI int dil_of(int gi) { return gi == 0 ? 1 : (gi == 1 ? 4 : 16); }
DI int dlg_of(int gi) { return gi * 2; }
DI float row_rscale(const float* ssq, size_t tok) {
  const f32x4 a = *(const f32x4*)(ssq + tok * 16), b = *(const f32x4*)(ssq + tok * 16 + 4);
  const f32x4 c = *(const f32x4*)(ssq + tok * 16 + 8), d = *(const f32x4*)(ssq + tok * 16 + 12);
  const float s = ((a[0] + a[1]) + (a[2] + a[3])) + ((b[0] + b[1]) + (b[2] + b[3])) + ((c[0] + c[1]) + (c[2] + c[3])) + ((d[0] + d[1]) + (d[2] + d[3]));
  return rsqrtf(s * (1.0f / 1024.0f) + 1e-6f);
}
DI int qk_head_col(int h) {
  if (h < 8) return 64 * h;
  if (h < 10) return 512 + 64 * (h - 8);
  if (h < 16) return 768 + 64 * (h - 10);
  if (h < 22) return 1152 + 64 * (h - 16);
  if (h < 26) return 1920 + 64 * (h - 22);
  if (h < 30) return 2176 + 64 * (h - 26);
  if (h < 34) return 2688 + 64 * (h - 30);
  return 2944 + 64 * (h - 34);
}
DI int v_head_col(int vh) {
  if (vh < 2) return 640 + 64 * vh;
  if (vh < 8) return 1536 + 64 * (vh - 2);
  if (vh < 12) return 2432 + 64 * (vh - 8);
  return 3200 + 64 * (vh - 12);
}

struct EpiQKG {
  static constexpr bool PERM = false, AFTER_DRAIN = false;
  const float* ssq; u16* qk; const float* rope; const float* gA; const float* gB; const float* gC; const float* gD;
  DI void operator()(const f32x4 (&acc)[2][2][4][2], const Unit& u, int wr, int wc, int fr, int fq) const {
    const int hidx = u.pn * 4 + wc;
    if (hidx >= NQKH) return;
    int kind, dlg = 0; const float* gain;
    if (hidx < 8) { kind = 0; gain = gA; }
    else if (hidx < 10) { kind = 0; gain = gA + 64; }
    else if (hidx < 16) { kind = 0; gain = gB; dlg = dlg_of((hidx - 10) >> 1); }
    else if (hidx < 22) { kind = 0; gain = gB + 64; dlg = dlg_of((hidx - 16) >> 1); }
    else if (hidx < 26) { kind = 2; gain = gC; }
    else if (hidx < 30) { kind = 2; gain = gC + 32; }
    else if (hidx < 34) { kind = 1; gain = gD; }
    else { kind = 1; gain = gD + 64; }
    u16* gbase = qk + (size_t)hidx * TC * 64;
    const float* gainl = gain + 4 * fq;
#pragma unroll
    for (int ai = 0; ai < 2; ++ai)
#pragma unroll
      for (int m = 0; m < 4; ++m) {
        const int tok = u.pm * 256 + 128 * ai + 64 * wr + 16 * m + fr;
        const int bl = tok >> 12, pos = tok & 4095;
        const float rs = row_rscale(ssq, tok);
        const int pdom = ((pos & ((1 << dlg) - 1)) << (12 - dlg)) + (pos >> dlg);
        const int blk = pdom >> 5, rr = pdom & 31;
        u16* base = gbase + (size_t)bl * SEQ * 64;
        if (kind != 2) {
          float ss = 0.f;
#pragma unroll
          for (int bj = 0; bj < 2; ++bj)
#pragma unroll
            for (int n = 0; n < 2; ++n)
#pragma unroll
              for (int e = 0; e < 4; ++e) ss += acc[ai][bj][m][n][e] * acc[ai][bj][m][n][e];
          ss += __shfl_xor(ss, 16); ss += __shfl_xor(ss, 32);
          const float sc = rs * rsqrtf(ss * rs * rs * (1.0f / 64.0f) + 1e-6f);
#pragma unroll
          for (int n = 0; n < 2; ++n) {
            f32x4 xa = acc[ai][0][m][n] * sc * *(const f32x4*)(gainl + 16 * n);
            f32x4 xb2 = acc[ai][1][m][n] * sc * *(const f32x4*)(gainl + 32 + 16 * n);
            if (kind == 0) {
              const f32x4 c4 = *(const f32x4*)(rope + pos * 96 + 16 * n + 4 * fq);
              const f32x4 s4 = *(const f32x4*)(rope + pos * 96 + 32 + 16 * n + 4 * fq);
              const f32x4 ta = xa * c4 - xb2 * s4, tb = xb2 * c4 + xa * s4;
              xa = ta; xb2 = tb;
            }
            u32x2 w0 = {pk2(xa[0], xa[1]), pk2(xa[2], xa[3])};
            *(u32x2*)(base + ((size_t)(blk * 4 + n) * 64 + (fq >> 1) * 32 + rr) * 8 + 4 * (fq & 1)) = w0;
            u32x2 w1 = {pk2(xb2[0], xb2[1]), pk2(xb2[2], xb2[3])};
            *(u32x2*)(base + ((size_t)(blk * 4 + 2 + n) * 64 + (fq >> 1) * 32 + rr) * 8 + 4 * (fq & 1)) = w1;
          }
        } else {
          const f32x4 c4 = *(const f32x4*)(rope + pos * 96 + 64 + 4 * fq);
          const f32x4 s4 = *(const f32x4*)(rope + pos * 96 + 80 + 4 * fq);
#pragma unroll
          for (int bj = 0; bj < 2; ++bj) {
            float ss = 0.f;
#pragma unroll
            for (int n = 0; n < 2; ++n)
#pragma unroll
              for (int e = 0; e < 4; ++e) ss += acc[ai][bj][m][n][e] * acc[ai][bj][m][n][e];
            ss += __shfl_xor(ss, 16); ss += __shfl_xor(ss, 32);
            const float sc = rs * rsqrtf(ss * rs * rs * (1.0f / 32.0f) + 1e-6f);
            const f32x4 xa = acc[ai][bj][m][0] * sc * *(const f32x4*)(gainl);
            const f32x4 xb2 = acc[ai][bj][m][1] * sc * *(const f32x4*)(gainl + 16);
            const f32x4 ta = xa * c4 - xb2 * s4, tb = xb2 * c4 + xa * s4;
            u16* sb = base + (size_t)bj * SEQ * 32;
            u32x2 w0 = {pk2(ta[0], ta[1]), pk2(ta[2], ta[3])};
            *(u32x2*)(sb + ((size_t)(blk * 2 + 0) * 64 + (fq >> 1) * 32 + rr) * 8 + 4 * (fq & 1)) = w0;
            u32x2 w1 = {pk2(tb[0], tb[1]), pk2(tb[2], tb[3])};
            *(u32x2*)(sb + ((size_t)(blk * 2 + 1) * 64 + (fq >> 1) * 32 + rr) * 8 + 4 * (fq & 1)) = w1;
          }
        }
        asm volatile("" ::: "memory");
      }
  }
};

struct EpiGateUp {
  static constexpr bool PERM = false, AFTER_DRAIN = false;
  const float* ssq; u16* o; int mode;
  DI void operator()(const f32x4 (&acc)[2][2][4][2], const Unit& u, int wr, int wc, int fr, int fq) const {
    if (mode == 2) return;
    const int c0 = u.pn * 256 + 32 * wc + 4 * fq;
    const bool up = mode != 0;
#pragma unroll
    for (int ai = 0; ai < 2; ++ai)
#pragma unroll
      for (int m = 0; m < 4; ++m) {
        const size_t tok = (size_t)u.pm * 256 + 128 * ai + 64 * wr + 16 * m + fr;
        const float rs = row_rscale(ssq, tok);
#pragma unroll
        for (int bj = 0; bj < 2; ++bj)
#pragma unroll
          for (int n = 0; n < 2; ++n) {
            const f32x4 v = acc[ai][bj][m][n] * rs;
            float r[4];
#pragma unroll
            for (int e = 0; e < 4; ++e) {
              const float z = fmaxf(v[e], 0.f);
              const float sg = __builtin_amdgcn_rcpf(1.0f + __expf(-v[e]));
              r[e] = up ? z * z : sg;
            }
            u32x2 w = {pk2(r[0], r[1]), pk2(r[2], r[3])};
            *(u32x2*)(o + tok * 4096 + c0 + 128 * bj + 16 * n) = w;
          }
        asm volatile("" ::: "memory");
      }
  }
};

struct EpiVT {
  static constexpr bool PERM = false, AFTER_DRAIN = false;
  const float* ssq; u16* vbuf;
  DI void operator()(const f32x4 (&acc)[2][2][4][2], const Unit& u, int wr, int wc, int fr, int fq) const {
    f32x4 rs4[2][2];
#pragma unroll
    for (int bj = 0; bj < 2; ++bj)
#pragma unroll
      for (int n = 0; n < 2; ++n) {
        const size_t t0 = (size_t)u.pn * 256 + 128 * bj + 32 * wc + 16 * n + 4 * fq;
#pragma unroll
        for (int e = 0; e < 4; ++e) { rs4[bj][n][e] = row_rscale(ssq, t0 + e); asm volatile("" ::: "memory"); }
      }
#pragma unroll
    for (int ai = 0; ai < 2; ++ai) {
      const int vgrp = u.pm * 4 + 2 * ai + wr;
      const int dlg = (vgrp >= 2 && vgrp < 8) ? dlg_of((vgrp - 2) >> 1) : 0;
      u16* gbase = vbuf + (size_t)vgrp * TC * 64;
      const int bl = (u.pn * 256) >> 12;
      u16* base = gbase + (size_t)bl * SEQ * 64;
      const unsigned es = (dlg == 0) ? 1u : (unsigned)(128 >> dlg) * 2048u;
#pragma unroll
      for (int m = 0; m < 4; ++m) {
        const int dv = 16 * m + fr;
        const unsigned dvo = (unsigned)((dv >> 5) * 1024 + (dv & 31) * 8);
#pragma unroll
        for (int bj = 0; bj < 2; ++bj)
#pragma unroll
          for (int n = 0; n < 2; ++n) {
            const int pos0 = (u.pn * 256 + 128 * bj + 32 * wc + 16 * n + 4 * fq) & 4095;
            const f32x4 v = acc[ai][bj][m][n] * rs4[bj][n];
            const int pd0 = ((pos0 & ((1 << dlg) - 1)) << (12 - dlg)) + (pos0 >> dlg);
            const int blk = pd0 >> 5, key = pd0 & 31;
            const unsigned off = (unsigned)blk * 2048u + (unsigned)(key >> 4) * 512u + (unsigned)((key >> 2) & 1) * 256u + dvo + 4u * ((key >> 3) & 1);
            const unsigned w0 = pk2(v[0], v[1]), w1 = pk2(v[2], v[3]);
            const unsigned o2 = off + (key & 3);
            base[o2] = (u16)(w0 & 0xffffu); base[o2 + es] = (u16)(w0 >> 16); base[o2 + 2 * es] = (u16)(w1 & 0xffffu); base[o2 + 3 * es] = (u16)(w1 >> 16);
            asm volatile("" ::: "memory");
          }
      }
    }
  }
};

struct MergeOrder : pg8::StaticOrder {
  const u16* ybase; const u16* wbase;
  DI bool next(int i, Unit& u) const { if (i >= 5) return false; if (!pg8::StaticOrder::next(0, u)) return false; u.seg = i; return true; }
  DI const char* baseA(const pg8::Gemm&, const Unit& u, size_t tstep) const { return (const char*)(ybase + (size_t)u.seg * TC * 256) + (size_t)u.pm * tstep; }
  DI const char* baseB(const pg8::Gemm&, const Unit& u, size_t tstep) const { return (const char*)(wbase + (size_t)u.seg * DM * 256) + (size_t)u.pn * tstep; }
  DI bool zero_after(const Unit& u) const { return u.seg == 4; }
};
struct EpiMerge {
  static constexpr bool PERM = false, AFTER_DRAIN = false;
  const u16* gate; u16* mrg;
  DI void operator()(f32x4 (&acc)[2][2][4][2], const Unit& u, int wr, int wc, int fr, int fq) const {
    const int seg = u.seg;
    if (seg == 0) return;
    const bool last = (seg == 4);
    const int gnum = last ? 3 : seg - 1, gden = last ? 3 : seg;
#pragma unroll
    for (int ai = 0; ai < 2; ++ai)
#pragma unroll
      for (int m = 0; m < 4; ++m) {
        const size_t tok = (size_t)u.pm * 256 + 128 * ai + 64 * wr + 16 * m + fr;
#pragma unroll
        for (int bj = 0; bj < 2; ++bj)
#pragma unroll
          for (int n = 0; n < 2; ++n) {
            const int c = u.pn * 256 + 128 * bj + 32 * wc + 16 * n + 4 * fq;
            const u32x2 gn = *(const u32x2*)(gate + tok * 4096 + gnum * 1024 + c);
            const u32x2 gd = *(const u32x2*)(gate + tok * 4096 + gden * 1024 + c);
            f32x4 f;
            f[0] = bf_lo(gn[0]); f[1] = bf_hi(gn[0]); f[2] = bf_lo(gn[1]); f[3] = bf_hi(gn[1]);
            if (!last) {
              f[0] *= __builtin_amdgcn_rcpf(bf_lo(gd[0])); f[1] *= __builtin_amdgcn_rcpf(bf_hi(gd[0]));
              f[2] *= __builtin_amdgcn_rcpf(bf_lo(gd[1])); f[3] *= __builtin_amdgcn_rcpf(bf_hi(gd[1]));
            }
            acc[ai][bj][m][n] *= f;
            if (last) { const f32x4 v = acc[ai][bj][m][n]; u32x2 w = {pk2(v[0], v[1]), pk2(v[2], v[3])}; *(u32x2*)(mrg + tok * DM + c) = w; }
          }
        asm volatile("" ::: "memory");
      }
  }
};

struct EpiResid {
  static constexpr bool PERM = false, AFTER_DRAIN = false;
  const float* xold; float* xout; u16* xb; float* ssq;
  DI void operator()(const f32x4 (&acc)[2][2][4][2], const Unit& u, int wr, int wc, int fr, int fq) const {
#pragma unroll
    for (int ai = 0; ai < 2; ++ai)
#pragma unroll
      for (int m = 0; m < 4; ++m) {
        const size_t tok = (size_t)u.pm * 256 + 128 * ai + 64 * wr + 16 * m + fr;
        float ss = 0.f;
#pragma unroll
        for (int bj = 0; bj < 2; ++bj)
#pragma unroll
          for (int n = 0; n < 2; ++n) {
            const size_t o = tok * DM + u.pn * 256 + 128 * bj + 32 * wc + 16 * n + 4 * fq;
            f32x4 v = *(const f32x4*)(xold + o) + acc[ai][bj][m][n];
            *(f32x4*)(xout + o) = v;
            u32x2 w = {pk2(v[0], v[1]), pk2(v[2], v[3])};
            *(u32x2*)(xb + o) = w;
            ss += (v[0] * v[0] + v[1] * v[1]) + (v[2] * v[2] + v[3] * v[3]);
          }
        ss += __shfl_xor(ss, 16); ss += __shfl_xor(ss, 32);
        if (fq == 0) ssq[tok * 16 + u.pn * 4 + wc] = ss;
        asm volatile("" ::: "memory");
      }
  }
};

template <class Epi>
DI void run_merge(PG8_LAS unsigned char* lds, const u16* ybase, const u16* wbase, const Epi& E) {
  int K = 256; asm volatile("" : "+s"(K));
  pg8::Gemm g; g.A = ybase; g.Bt = wbase; g.M = TC; g.N = DM; g.K = K;
  MergeOrder S; S.init(TC, DM, (int)gridDim.x, (int)blockIdx.x); S.ybase = ybase; S.wbase = wbase;
  pg8::gemm_phase<Epi, MergeOrder, false>(lds, g, S, E, nullptr);
}
template <class Epi>
DI void run_gemm(PG8_LAS unsigned char* lds, const u16* A, const u16* Bt, int M, int N, int K, const Epi& E, int probe = 0) {
  asm volatile("" : "+s"(K));
  pg8::Gemm g; g.A = A; g.Bt = Bt; g.M = M; g.N = N; g.K = K;
  pg8::StaticOrder S; S.init(M, N, (int)gridDim.x, (int)blockIdx.x); S.probe = probe;
  pg8::gemm_phase<Epi, pg8::StaticOrder, false>(lds, g, S, E, nullptr);
}

DI void cvt_load(const float* __restrict__ src, int N, int k0, int n0, const float* __restrict__ g, float* t, int ht) {
  const int c4 = (ht & 15) * 4;
#pragma unroll
  for (int i = 0; i < 4; ++i) {
    const int kk = (ht >> 4) + 16 * i;
    f32x4 v = *(const f32x4*)(src + (size_t)(k0 + kk) * N + n0 + c4);
    const float sc = g ? g[k0 + kk] : 1.0f;
    t[kk * 65 + c4 + 0] = v[0] * sc; t[kk * 65 + c4 + 1] = v[1] * sc; t[kk * 65 + c4 + 2] = v[2] * sc; t[kk * 65 + c4 + 3] = v[3] * sc;
  }
}
DI void cvt_store(u16* __restrict__ dst, int ldk, int kdst, int d0, int d1, const float* t, int ht) {
  const int kc = (ht & 7) * 8, nn = ht >> 3;
#pragma unroll
  for (int i = 0; i < 2; ++i) {
    const int tn = nn + 32 * i, row = (i == 0) ? d0 + nn : d1 + nn;
    u32x4 w;
    w[0] = pk2(t[(kc + 0) * 65 + tn], t[(kc + 1) * 65 + tn]);
    w[1] = pk2(t[(kc + 2) * 65 + tn], t[(kc + 3) * 65 + tn]);
    w[2] = pk2(t[(kc + 4) * 65 + tn], t[(kc + 5) * 65 + tn]);
    w[3] = pk2(t[(kc + 6) * 65 + tn], t[(kc + 7) * 65 + tn]);
    *(u32x4*)(dst + (size_t)row * ldk + kdst + kc) = w;
  }
}
struct CvtJob { const float* src; int N, k0, n0; const float* g; u16* dst; int ldk, d0, d1, kd; };
DI CvtJob cvt_job(const Params& p, int l, int ti) {
  CvtJob j; j.g = nullptr; j.kd = -1;
  const float* attn_g = p.in[1] + l * DM;
  if (ti < 608) { const int h = ti >> 4, kt = ti & 15; j.src = p.in[2] + (size_t)l * DM * INC; j.N = INC; j.k0 = kt * 64; j.n0 = qk_head_col(h); j.g = attn_g;
    j.dst = (u16*)(p.ws + OFF_WQKG) + (size_t)l * NQKG * DM; j.ldk = DM; j.d0 = (h >> 2) * 256 + (h & 3) * 32; j.d1 = j.d0 + 128; return j; }
  ti -= 608;
  if (ti < 1024) { const int c = ti >> 4, kt = ti & 15; j.src = p.in[2] + (size_t)l * DM * INC; j.N = INC; j.k0 = kt * 64; j.n0 = 3456 + 64 * c; j.g = attn_g;
    j.dst = (u16*)(p.ws + OFF_WQKG) + (size_t)l * NQKG * DM; j.ldk = DM; j.d0 = 2560 + 64 * c; j.d1 = j.d0 + 32; return j; }
  ti -= 1024;
  if (ti < 256) { const int vh = ti >> 4, kt = ti & 15; j.src = p.in[2] + (size_t)l * DM * INC; j.N = INC; j.k0 = kt * 64; j.n0 = v_head_col(vh); j.g = attn_g;
    j.dst = (u16*)(p.ws + OFF_WV) + (size_t)l * DM * DM; j.ldk = DM; j.d0 = vh * 64; j.d1 = j.d0 + 32; return j; }
  ti -= 256;
  if (ti < 128) { j.src = p.in[11] + (size_t)l * 512 * DM; j.N = DM; j.k0 = (ti >> 4) * 64; j.n0 = (ti & 15) * 64; j.dst = (u16*)(p.ws + OFF_WBR5) + ((size_t)l * 5 + (j.k0 >> 8)) * DM * 256; j.ldk = 256; j.kd = j.k0 & 255; j.d0 = j.n0; j.d1 = j.n0 + 32; return j; }
  ti -= 128;
  if (ti < 32) { j.src = p.in[12] + (size_t)l * 128 * DM; j.N = DM; j.k0 = (ti >> 4) * 64; j.n0 = (ti & 15) * 64; j.dst = (u16*)(p.ws + OFF_WBR5) + ((size_t)l * 5 + 2) * DM * 256; j.ldk = 256; j.kd = j.k0; j.d0 = j.n0; j.d1 = j.n0 + 32; return j; }
  ti -= 32;
  if (ti < 64) { j.src = p.in[13] + (size_t)l * 256 * DM; j.N = DM; j.k0 = (ti >> 4) * 64; j.n0 = (ti & 15) * 64; j.dst = (u16*)(p.ws + OFF_WBR5) + ((size_t)l * 5 + 3) * DM * 256; j.ldk = 256; j.kd = j.k0; j.d0 = j.n0; j.d1 = j.n0 + 32; return j; }
  ti -= 64;
  if (ti < 64) { j.src = p.in[14] + (size_t)l * 256 * DM; j.N = DM; j.k0 = (ti >> 4) * 64; j.n0 = (ti & 15) * 64; j.dst = (u16*)(p.ws + OFF_WBR5) + ((size_t)l * 5 + 4) * DM * 256; j.ldk = 256; j.kd = j.k0; j.d0 = j.n0; j.d1 = j.n0 + 32; return j; }
  ti -= 64;
  if (ti < 256) { j.src = p.in[15] + (size_t)l * DM * DM; j.N = DM; j.k0 = (ti >> 4) * 64; j.n0 = (ti & 15) * 64; j.dst = (u16*)(p.ws + OFF_WOUT) + (size_t)l * DM * DM; j.ldk = DM; j.d0 = j.n0; j.d1 = j.n0 + 32; return j; }
  ti -= 256;
  if (ti < 1024) { j.src = p.in[17] + (size_t)l * DM * DMLP; j.N = DMLP; j.k0 = (ti >> 6) * 64; j.n0 = (ti & 63) * 64; j.g = p.in[16] + l * DM;
    j.dst = (u16*)(p.ws + OFF_WUP) + (size_t)l * DMLP * DM; j.ldk = DM; j.d0 = j.n0; j.d1 = j.n0 + 32; return j; }
  ti -= 1024;
  j.src = p.in[18] + (size_t)l * DMLP * DM; j.N = DM; j.k0 = (ti >> 4) * 64; j.n0 = (ti & 15) * 64; j.dst = (u16*)(p.ws + OFF_WDN) + (size_t)l * DM * DMLP; j.ldk = DMLP; j.d0 = j.n0; j.d1 = j.n0 + 32; return j;
}

__device__ void phase_prep(const Params& p, int tid_, int bid_, int nblk_, unsigned char* smem) {
  const int half = tid_ >> 8, ht = tid_ & 255;
  float* t = (float*)smem + half * (64 * 65);
  const int per_layer = 4480, total = 2 * per_layer;
  for (int jp = bid_; jp * 2 < total; jp += nblk_) {
    const int j = jp * 2 + half;
    const bool on = j < total;
    CvtJob job;
    if (on) { job = cvt_job(p, j / per_layer, j % per_layer); cvt_load(job.src, job.N, job.k0, job.n0, job.g, t, ht); }
    __syncthreads();
    if (on) cvt_store(job.dst, job.ldk, (job.kd >= 0) ? job.kd : job.k0, job.d0, job.d1, t, ht);
    __syncthreads();
  }
  {
    const u32x4 z = {0u, 0u, 0u, 0u};
    for (int e = bid_ * NTHR + tid_; e < 2 * 128 * 128; e += nblk_ * NTHR) {
      const int l = e >> 14, r = (e >> 7) & 127, c = (e & 127) * 8;
      const int row = 9 * 256 + ((r < 64) ? 64 + r : 128 + r);
      *(u32x4*)((u16*)(p.ws + OFF_WQKG) + ((size_t)l * NQKG + row) * DM + c) = z;
    }
    for (int e = bid_ * NTHR + tid_; e < 2 * 1024 * 16; e += nblk_ * NTHR) {
      const int l = e >> 14, r = (e >> 4) & 1023, c = 128 + (e & 15) * 8;
      *(u32x4*)((u16*)(p.ws + OFF_WBR5) + (((size_t)l * 5 + 2) * DM + r) * 256 + c) = z;
    }
  }
  float* rope = (float*)(p.ws + OFF_ROPE);
  for (int e = bid_ * NTHR + tid_; e < SEQ * 48; e += nblk_ * NTHR) {
    const int pos = e / 48, i = e % 48;
    float inv;
    if (i < 32) inv = exp2f(-13.287712379549449f * (float)(2 * i) / 64.0f);
    else inv = exp2f(-13.287712379549449f * (float)(2 * (i - 32)) / 32.0f);
    const float angf = (float)pos * inv;
    const double ang = (double)angf;
    const double n = rint(ang * 0.15915494309189535);
    const float r = (float)(ang - n * 6.283185307179586);
    const float c = cosf(r), s = sinf(r);
    if (i < 32) { rope[pos * 96 + i] = c; rope[pos * 96 + 32 + i] = s; }
    else { rope[pos * 96 + 64 + (i - 32)] = c; rope[pos * 96 + 80 + (i - 32)] = s; }
  }
  u16* XB = (u16*)(p.ws + OFF_XB); float* SSQ = (float*)(p.ws + OFF_SSQ);
  const int lane = tid_ & 63;
  const int gw = bid_ * 8 + (tid_ >> 6), nw = nblk_ * 8;
  for (int row = gw; row < T; row += nw) {
    const float* xr = p.in[0] + (size_t)row * DM;
    float ss = 0.f;
#pragma unroll
    for (int i = 0; i < 4; ++i) {
      const f32x4 v = *(const f32x4*)(xr + i * 256 + lane * 4);
      ss += v[0] * v[0] + v[1] * v[1] + v[2] * v[2] + v[3] * v[3];
      u32x2 w = {pk2(v[0], v[1]), pk2(v[2], v[3])};
      *(u32x2*)(XB + (size_t)row * DM + i * 256 + lane * 4) = w;
    }
#pragma unroll
    for (int o = 32; o >= 1; o >>= 1) ss += __shfl_xor(ss, o);
    if (lane < 16) SSQ[(size_t)row * 16 + lane] = (lane == 0) ? ss : 0.f;
  }
}

DI void attn_softmax_pv(f32x16& S, float& m, float& l, f32x16& O0, f32x16& O1, const bf16x8 (&vf)[2][2]) {
  float mx = S[0];
#pragma unroll
  for (int i = 1; i < 16; ++i) mx = fmaxf(mx, S[i]);
  mx = fmaxf(mx, __shfl_xor(mx, 32));
  const float mn = fmaxf(m, mx);
  const float alpha = fexp2(m - mn);
  m = mn;
  float sum = 0.f;
#pragma unroll
  for (int i = 0; i < 16; ++i) { S[i] = fexp2(S[i] - mn); sum += S[i]; }
  l = l * alpha + sum;
  const u32x4 p0 = {pk2(S[0], S[1]), pk2(S[2], S[3]), pk2(S[4], S[5]), pk2(S[6], S[7])};
  const u32x4 p1 = {pk2(S[8], S[9]), pk2(S[10], S[11]), pk2(S[12], S[13]), pk2(S[14], S[15])};
#pragma unroll
  for (int i = 0; i < 16; ++i) { O0[i] *= alpha; O1[i] *= alpha; }
  O0 = MFMA32(vf[0][0], as_bf8(p0), O0);
  O0 = MFMA32(vf[0][1], as_bf8(p1), O0);
  O1 = MFMA32(vf[1][0], as_bf8(p0), O1);
  O1 = MFMA32(vf[1][1], as_bf8(p1), O1);
}
DI void attn_fixed_pv(f32x16& S, float sc2, float mb2, float& l, f32x16& O0, f32x16& O1, const bf16x8 (&vf)[2][2]) {
  float sum = 0.f;
#pragma unroll
  for (int i = 0; i < 16; ++i) { S[i] = fexp2(__builtin_fmaf(S[i], sc2, -mb2)); sum += S[i]; }
  l += sum;
  const u32x4 p0 = {pk2(S[0], S[1]), pk2(S[2], S[3]), pk2(S[4], S[5]), pk2(S[6], S[7])};
  const u32x4 p1 = {pk2(S[8], S[9]), pk2(S[10], S[11]), pk2(S[12], S[13]), pk2(S[14], S[15])};
  O0 = MFMA32(vf[0][0], as_bf8(p0), O0);
  O0 = MFMA32(vf[0][1], as_bf8(p1), O0);
  O1 = MFMA32(vf[1][0], as_bf8(p0), O1);
  O1 = MFMA32(vf[1][1], as_bf8(p1), O1);
}
DI void load_vf(bf16x8 (&vf)[2][2], const u16* V, int kb, int lane) {
#pragma unroll
  for (int rb = 0; rb < 2; ++rb)
#pragma unroll
    for (int s = 0; s < 2; ++s) vf[rb][s] = *(const bf16x8*)(V + ((size_t)((kb * 2 + rb) * 2 + s) * 64 + lane) * 8);
}
DI void load_kf4(bf16x8 (&kf)[4], const u16* K, int kb, int lane) {
#pragma unroll
  for (int s = 0; s < 4; ++s) kf[s] = *(const bf16x8*)(K + ((size_t)(kb * 4 + s) * 64 + lane) * 8);
}
DI void load_kf2(bf16x8 (&kf)[2], const u16* K, int kb, int lane) {
#pragma unroll
  for (int s = 0; s < 2; ++s) kf[s] = *(const bf16x8*)(K + ((size_t)(kb * 2 + s) * 64 + lane) * 8);
}
DI void zero16(f32x16& a) {
#pragma unroll
  for (int i = 0; i < 16; ++i) a[i] = 0.f;
}
DI void store_o(u16* yrow, const f32x16& O0, const f32x16& O1, float sc, int h) {
#pragma unroll
  for (int g4 = 0; g4 < 4; ++g4) {
    u32x2 w0 = {pk2(O0[4 * g4] * sc, O0[4 * g4 + 1] * sc), pk2(O0[4 * g4 + 2] * sc, O0[4 * g4 + 3] * sc)};
    *(u32x2*)(yrow + 8 * g4 + 4 * h) = w0;
    u32x2 w1 = {pk2(O1[4 * g4] * sc, O1[4 * g4 + 1] * sc), pk2(O1[4 * g4 + 2] * sc, O1[4 * g4 + 3] * sc)};
    *(u32x2*)(yrow + 32 + 8 * g4 + 4 * h) = w1;
  }
}

__device__ void phase_attn(const Params& p, int tid_, int bid_, int nblk_, int layer) {
  const u16* QK = (const u16*)(p.ws + OFF_QK);
  const u16* VB = (const u16*)(p.ws + OFF_V);
  u16* Y5 = (u16*)(p.ws + OFF_Y5);
  u16* BO = (u16*)(p.ws + OFF_BO);
  float* LSE = (float*)(p.ws + OFF_LSE);
  const int lane = tid_ & 63, wave = tid_ >> 6;
  const int fr = lane & 31, fh = lane >> 5;
  const int nloc = nblk_ >> 3;
  if ((int)(bid_ >> 3) >= nloc) return;
  const int vw = ((bid_ & 7) * nloc + (bid_ >> 3)) * 8 + wave, NW = nloc * 64;
  const size_t GS = (size_t)TC * 64;
  const size_t BS = (size_t)SEQ * 64;

  {
    const float* lp = p.in[7] + layer * 128;
    float d01 = 0.f, d23 = 0.f;
    for (int i = 0; i < 32; ++i) { d01 += lp[i] * lp[32 + i]; d23 += lp[64 + i] * lp[96 + i]; }
    const float lambda_init = (layer == 0) ? 0.2f : 0.35550907f;
    const float lam = __expf(d01) - __expf(d23) + lambda_init;
    const float* subg = p.in[8] + layer * 64;
    const float sc = 0.17677669529663687f * LOG2E;
    float gqm = 0.f, gkm = 0.f;
    for (int i = 0; i < 32; ++i) { gqm = fmaxf(gqm, fabsf(p.in[6][layer * 64 + i])); gkm = fmaxf(gkm, fabsf(p.in[6][layer * 64 + 32 + i])); }
    const float cbound = 5.6568542f * gqm * gkm * 1.02f + 0.05f;
    for (int it = vw; it < BC * 4 * 128; it += NW) {
      const int bl = it >> 9, head = (it >> 7) & 3, qblk = it & 127;
      const u16* Q0 = QK + (22 + head) * GS + bl * BS; const u16* Q1 = Q0 + SEQ * 32;
      const u16* K0 = QK + (26 + head) * GS + bl * BS; const u16* K1 = K0 + SEQ * 32;
      const u16* V = VB + (8 + head) * GS + bl * BS;
      bf16x8 q0[2], q1[2];
      load_kf2(q0, Q0, qblk, lane); load_kf2(q1, Q1, qblk, lane);
      float l0 = 0.f, l1 = 0.f;
      f32x16 O00, O01, O10, O11; zero16(O00); zero16(O01); zero16(O10); zero16(O11);
      bf16x8 k0[2], k1[2], vf[2][2];
      load_kf2(k0, K0, 0, lane); load_kf2(k1, K1, 0, lane); load_vf(vf, V, 0, lane);
      {
        const float mb2 = fminf(cbound, 40.0f) * LOG2E;
        for (int kb = 0; kb < 128; ++kb) {
          bf16x8 nk0[2], nk1[2], nvf[2][2];
          const int kn = (kb + 1 < 128) ? kb + 1 : kb;
          load_kf2(nk0, K0, kn, lane); load_kf2(nk1, K1, kn, lane); load_vf(nvf, V, kn, lane);
          f32x16 S0, S1; zero16(S0); zero16(S1);
          S0 = MFMA32(k0[0], q0[0], S0); S0 = MFMA32(k0[1], q0[1], S0);
          S1 = MFMA32(k1[0], q1[0], S1); S1 = MFMA32(k1[1], q1[1], S1);
          attn_fixed_pv(S0, sc, mb2, l0, O00, O01, vf);
          attn_fixed_pv(S1, sc, mb2, l1, O10, O11, vf);
#pragma unroll
          for (int s = 0; s < 2; ++s) { k0[s] = nk0[s]; k1[s] = nk1[s]; vf[0][s] = nvf[0][s]; vf[1][s] = nvf[1][s]; }
        }
      }
      const float i0 = 1.0f / (l0 + __shfl_xor(l0, 32));
      const float i1 = lam / (l1 + __shfl_xor(l1, 32));
      float ss = 0.f;
#pragma unroll
      for (int i = 0; i < 16; ++i) {
        O00[i] = O00[i] * i0 - O10[i] * i1; O01[i] = O01[i] * i0 - O11[i] * i1;
        ss += O00[i] * O00[i] + O01[i] * O01[i];
      }
      ss += __shfl_xor(ss, 32);
      const float rn = rsqrtf(ss * (1.0f / 64.0f) + 1e-6f) * (1.0f - lambda_init);
#pragma unroll
      for (int g4 = 0; g4 < 4; ++g4) {
        const f32x4 ga = *(const f32x4*)(subg + 8 * g4 + 4 * fh);
        const f32x4 gb = *(const f32x4*)(subg + 32 + 8 * g4 + 4 * fh);
#pragma unroll
        for (int e = 0; e < 4; ++e) { O00[4 * g4 + e] *= ga[e]; O01[4 * g4 + e] *= gb[e]; }
      }
      const size_t tok = (size_t)bl * SEQ + qblk * 32 + fr;
      store_o(Y5 + (size_t)3 * TC * 256 + tok * 256 + head * 64, O00, O01, rn, fh);
    }
  }
  {
    const float sc = 0.125f * LOG2E;
    for (int it = vw; it < BC * 8 * 128; it += NW) {
      const int bl = it >> 10, hq = (it >> 7) & 7, qblk = it & 127;
      const int kvh = hq >> 2;
      const u16* Q = QK + (size_t)hq * GS + bl * BS;
      const u16* K = QK + (size_t)(8 + kvh) * GS + bl * BS;
      const u16* V = VB + (size_t)kvh * GS + bl * BS;
      bf16x8 qf[4]; load_kf4(qf, Q, qblk, lane);
      float m = p.in[4][layer * 8 + hq] * LOG2E, l = (fh == 0) ? 1.0f : 0.0f;
      f32x16 O0, O1; zero16(O0); zero16(O1);
      const int kb_lo = (qblk - 4 < 0) ? 0 : qblk - 4, kb_hi = (qblk + 4 > 127) ? 127 : qblk + 4;
      const int qpos = qblk * 32 + fr;
      for (int kb = kb_lo; kb <= kb_hi; ++kb) {
        bf16x8 kf[4], vf[2][2];
        load_kf4(kf, K, kb, lane); load_vf(vf, V, kb, lane);
        f32x16 S; zero16(S);
#pragma unroll
        for (int s = 0; s < 4; ++s) S = MFMA32(kf[s], qf[s], S);
#pragma unroll
        for (int i = 0; i < 16; ++i) {
          const int dlt = kb * 32 + crow(i, fh) - qpos;
          S[i] = (dlt <= 128 && dlt >= -128) ? S[i] * sc : -1e30f;
        }
        attn_softmax_pv(S, m, l, O0, O1, vf);
      }
      const float inv = 1.0f / (l + __shfl_xor(l, 32));
      const size_t tok = (size_t)bl * SEQ + qpos;
      store_o(Y5 + (size_t)(hq >> 2) * TC * 256 + tok * 256 + (hq & 3) * 64, O0, O1, inv, fh);
    }
  }
  {
    const float sc = 0.125f;
    for (int it = vw; it < BC * 4 * 128; it += NW) {
      const int bl = it >> 9, head = (it >> 7) & 3, qblk = it & 127;
      const u16* Q = QK + (size_t)(30 + head) * GS + bl * BS;
      const u16* K = QK + (size_t)(34 + head) * GS + bl * BS;
      const u16* V = VB + (size_t)(12 + head) * GS + bl * BS;
      const float* rpb = p.in[10] + (size_t)(layer * 4 + head) * 15 * 31;
      bf16x8 qf[4]; load_kf4(qf, Q, qblk, lane);
      float m = -1e30f, l = 0.f;
      f32x16 O0, O1; zero16(O0); zero16(O1);
      const int qrow = qblk >> 1, qc = (qblk & 1) * 32 + fr;
      int r0 = qrow - 4; r0 = r0 < 0 ? 0 : (r0 > 56 ? 56 : r0);
      int c0 = qc - 8; c0 = c0 < 0 ? 0 : (c0 > 48 ? 48 : c0);
      for (int kk = 0; kk < 16; ++kk) {
        const int krow_ = r0 + (kk >> 1), hb = kk & 1, kb = krow_ * 2 + hb;
        bf16x8 kf[4], vf[2][2];
        load_kf4(kf, K, kb, lane); load_vf(vf, V, kb, lane);
        f32x16 S; zero16(S);
#pragma unroll
        for (int s = 0; s < 4; ++s) S = MFMA32(kf[s], qf[s], S);
        const float* brow = rpb + (krow_ - qrow + 7) * 31;
#pragma unroll
        for (int i = 0; i < 16; ++i) {
          const int kc = hb * 32 + crow(i, fh);
          int dc = kc - qc; dc = dc < -15 ? -15 : (dc > 15 ? 15 : dc);
          const float bias = brow[dc + 15];
          S[i] = (kc >= c0 && kc < c0 + 16) ? (S[i] * sc + bias) * LOG2E : -1e30f;
        }
        attn_softmax_pv(S, m, l, O0, O1, vf);
      }
      const float inv = 1.0f / (l + __shfl_xor(l, 32));
      const size_t tok = (size_t)bl * SEQ + qblk * 32 + fr;
      store_o(Y5 + (size_t)4 * TC * 256 + tok * 256 + head * 64, O0, O1, inv, fh);
    }
  }
  {
    const float sc = 0.125f * LOG2E;
    for (int it = vw; it < BC * 6 * 128; it += NW) {
      const int bl = it / 768, rem = it % 768, head = rem >> 7, qblk = rem & 127;
      const int dil = dil_of(head >> 1), L = SEQ / dil, LB = L >> 5;
      const u16* Q = QK + (size_t)(10 + head) * GS + bl * BS;
      const u16* K = QK + (size_t)(16 + head) * GS + bl * BS;
      const u16* V = VB + (size_t)(2 + head) * GS + bl * BS;
      bf16x8 qf[4]; load_kf4(qf, Q, qblk, lane);
      float m = -1e30f, l = 0.f;
      f32x16 O0, O1; zero16(O0); zero16(O1);
      const int rsub = qblk / LB;
      const int lo = rsub * LB, hi = lo + LB - 1;
      const int kb_lo = (qblk - 2 < lo) ? lo : qblk - 2, kb_hi = (qblk + 2 > hi) ? hi : qblk + 2;
      const int qd = qblk * 32 + fr;
      for (int kb = kb_lo; kb <= kb_hi; ++kb) {
        bf16x8 kf[4], vf[2][2];
        load_kf4(kf, K, kb, lane); load_vf(vf, V, kb, lane);
        f32x16 S; zero16(S);
#pragma unroll
        for (int s = 0; s < 4; ++s) S = MFMA32(kf[s], qf[s], S);
#pragma unroll
        for (int i = 0; i < 16; ++i) {
          const int dlt = kb * 32 + crow(i, fh) - qd;
          S[i] = (dlt <= 64 && dlt >= -64) ? S[i] * sc : -1e30f;
        }
        attn_softmax_pv(S, m, l, O0, O1, vf);
      }
      const float lt = l + __shfl_xor(l, 32);
      const float inv = 1.0f / lt;
      const int msub = qd - rsub * L;
      const int pos = msub * dil + rsub;
      const size_t tok = (size_t)bl * SEQ + pos;
      store_o(BO + tok * 384 + head * 64, O0, O1, inv, fh);
      if (fh == 0) LSE[tok * 8 + head] = __log2f(lt) + m;
    }
  }
}


__device__ void phase_bcombine(const Params& p, int tid_, int bid_, int nblk_) {
  const u16* BO = (const u16*)(p.ws + OFF_BO);
  const float* LSE = (const float*)(p.ws + OFF_LSE);
  u16* YB = (u16*)(p.ws + OFF_Y5) + (size_t)2 * TC * 256;
  for (int e = bid_ * NTHR + tid_; e < TC * 16; e += nblk_ * NTHR) {
    const int tok = e >> 4, j = (e >> 3) & 1, c8 = (e & 7) * 8;
    const float a0 = LSE[(size_t)tok * 8 + j], a1 = LSE[(size_t)tok * 8 + 2 + j], a2 = LSE[(size_t)tok * 8 + 4 + j];
    const float mx = fmaxf(a0, fmaxf(a1, a2));
    float w0 = fexp2(a0 - mx), w1 = fexp2(a1 - mx), w2 = fexp2(a2 - mx);
    const float inv = 1.0f / (w0 + w1 + w2);
    w0 *= inv; w1 *= inv; w2 *= inv;
    const u32x4 x0 = *(const u32x4*)(BO + (size_t)tok * 384 + (0 + j) * 64 + c8);
    const u32x4 x1 = *(const u32x4*)(BO + (size_t)tok * 384 + (2 + j) * 64 + c8);
    const u32x4 x2 = *(const u32x4*)(BO + (size_t)tok * 384 + (4 + j) * 64 + c8);
    u32x4 o;
#pragma unroll
    for (int q = 0; q < 4; ++q) {
      const float lo = w0 * bf_lo(x0[q]) + w1 * bf_lo(x1[q]) + w2 * bf_lo(x2[q]);
      const float hi = w0 * bf_hi(x0[q]) + w1 * bf_hi(x1[q]) + w2 * bf_hi(x2[q]);
      o[q] = pk2(lo, hi);
    }
    *(u32x4*)(YB + (size_t)tok * 256 + j * 64 + c8) = o;
    const u32x4 z = {0u, 0u, 0u, 0u};
    *(u32x4*)(YB + (size_t)tok * 256 + 128 + (e & 15) * 8) = z;
  }
}

#define XB_TMO      128
#define XB_XCNT(j)  (256  + 64 * (j))
#define XB_XSUB(j)  (1280 + 64 * (j))
#define XB_XGEN(j)  (2304 + 64 * (j))
#define XB_TOP      3328
#define XB_TOPGEN   3392
#define XCD_BAR_WORDS 3456
#define XB_SPIN_CAP (1u << 22)
#define LAS __attribute__((address_space(3)))
DI unsigned xb_ld(unsigned* p)              { return __hip_atomic_load(p, __ATOMIC_RELAXED, __HIP_MEMORY_SCOPE_AGENT); }
DI unsigned xb_add(unsigned* p, unsigned v) { return __hip_atomic_fetch_add(p, v, __ATOMIC_RELAXED, __HIP_MEMORY_SCOPE_AGENT); }
DI unsigned xb_xcc_id() { return (unsigned)__builtin_amdgcn_s_getreg((3 << 11) | 20) & 0xFu; }
#define XB_SPIN(cond, bar) do { unsigned _sp = 0; while (cond) { __builtin_amdgcn_s_sleep(1); \
    if ((++_sp & 255u) == 0u) { if (xb_ld(&(bar)[XB_TMO])) break; if (_sp > XB_SPIN_CAP) { atomicAdd(&(bar)[XB_TMO], 1u); break; } } } } while (0)
struct XcdBarrier { unsigned* bar; unsigned x; volatile LAS unsigned* st; };
DI XcdBarrier xcd_barrier_post(unsigned* bar, volatile LAS unsigned* st) {
  XcdBarrier b; b.bar = bar; b.x = xb_xcc_id(); b.st = st;
  if (threadIdx.x == 0) (void)xb_add(&bar[XB_XCNT(b.x)], 1u);
  return b;
}
DI void xcd_barrier_complete(unsigned* bar, unsigned x, unsigned& nloc, unsigned& nx) {
  const unsigned G = gridDim.x * gridDim.y * gridDim.z;
  unsigned sum, cnt, mine, sp = 0u;
  for (;;) {
    sum = 0u; cnt = 0u; mine = 0u;
#pragma unroll
    for (unsigned j = 0; j < 16; ++j) { const unsigned c = xb_ld(&bar[XB_XCNT(j)]); sum += c; cnt += (c > 0u) ? 1u : 0u; mine = (j == x) ? c : mine; }
    if (sum == G) break;
    __builtin_amdgcn_s_sleep(1);
    if ((++sp & 255u) == 0u) { if (xb_ld(&bar[XB_TMO])) break; if (sp > XB_SPIN_CAP) { atomicAdd(&bar[XB_TMO], 1u); break; } }
  }
  nloc = mine > 0u ? mine : 1u; nx = cnt > 0u ? cnt : 1u;
}
DI void xcd_barrier(const XcdBarrier& b) {
  asm volatile("s_waitcnt vmcnt(0)" ::: "memory");
  __syncthreads();
  if (threadIdx.x == 0) {
    unsigned* bar = b.bar;
    __builtin_amdgcn_s_waitcnt(0);
    unsigned nloc = b.st[0], nx = b.st[1];
    if (nloc == 0u) { xcd_barrier_complete(bar, b.x, nloc, nx); b.st[0] = nloc; b.st[1] = nx; }
    const unsigned old = xb_add(&bar[XB_XSUB(b.x)], 1u);
    const unsigned gen = old / nloc;
    if (old + 1u == (gen + 1u) * nloc) {
      __builtin_amdgcn_fence(__ATOMIC_RELEASE, "agent");
      asm volatile("s_waitcnt vmcnt(0)" ::: "memory");
      const unsigned og = xb_add(&bar[XB_TOP], 1u);
      const unsigned tg = og / nx;
      if (og + 1u == (tg + 1u) * nx) xb_add(&bar[XB_TOPGEN], 1u);
      else XB_SPIN(xb_ld(&bar[XB_TOPGEN]) == tg, bar);
      __builtin_amdgcn_fence(__ATOMIC_ACQUIRE, "agent");
      xb_add(&bar[XB_XGEN(b.x)], 1u);
      asm volatile("s_waitcnt vmcnt(0)" ::: "memory");
    } else {
      XB_SPIN(xb_ld(&bar[XB_XGEN(b.x)]) == gen, bar);
      __builtin_amdgcn_fence(__ATOMIC_ACQUIRE, "agent");
      asm volatile("s_waitcnt vmcnt(0)" ::: "memory");
    }
  }
  __syncthreads();
}

__global__ void __launch_bounds__(NTHR, 2) mk_forward(Params p) {
  extern __shared__ __attribute__((aligned(16))) unsigned char smem[];
  cg::grid_group grid = cg::this_grid();
  volatile LAS unsigned* xbw = (volatile LAS unsigned*)(smem + LDS_STAGE);
  if (threadIdx.x < 4) xbw[threadIdx.x] = 0u;
  __syncthreads();
  XcdBarrier xb;
  if (FUSED) xb = xcd_barrier_post((unsigned*)(p.ws + OFF_BAR), xbw);
  PG8_LAS unsigned char* lds = (PG8_LAS unsigned char*)smem;
  for (int ph = p.ph_lo; ph < p.ph_hi; ++ph) {
#if DUPMASK
   for (int rep = 0; rep < ((ph > 0 && ((DUPMASK >> ((ph - 1) % 7)) & 1)) ? 2 : 1); ++rep)
#endif
   {
    int tid_ = threadIdx.x, bid_ = blockIdx.x, nblk_ = gridDim.x;
    asm volatile("" : "+v"(tid_));
    asm volatile("" : "+s"(bid_));
    asm volatile("" : "+s"(nblk_));
    Params pp = p;
    asm volatile("" : "+s"(pp.ws));
    asm volatile("" : "+s"(pp.out));
    unsigned char* ws = pp.ws;
    if (ph == 0) {
      if (PHMASK & 128) phase_prep(pp, tid_, bid_, nblk_, smem);
    } else {
      const int q = ph - 1, chunk = q / (2 * PPL), layer = (q % (2 * PPL)) / PPL, kk = q % PPL, k = (kk == 7) ? DUPK : kk;
      const u16* XBc = (const u16*)(ws + OFF_XB) + (size_t)chunk * TC * DM;
      float* SSQc = (float*)(ws + OFF_SSQ) + (size_t)chunk * TC * 16;
      float* xc = pp.out + (size_t)chunk * TC * DM;
      if ((k == 0 && (PHMASK & 1)) || (k == 5 && (PHMASK & 32))) {
        const bool up = (k == 5);
        if (!up) {
          EpiQKG e; e.ssq = SSQc; e.qk = (u16*)(ws + OFF_QK); e.rope = (const float*)(ws + OFF_ROPE);
          e.gA = pp.in[3] + layer * 128; e.gB = pp.in[5] + layer * 128; e.gC = pp.in[6] + layer * 64; e.gD = pp.in[9] + layer * 128;
          run_gemm(lds, XBc, (const u16*)(ws + OFF_WQKG) + (size_t)layer * NQKG * DM, TC, 2560, DM, e);
        }
        {
          EpiGateUp e; e.ssq = SSQc; e.o = (u16*)(ws + OFF_GATE); e.mode = up ? ((PROBE_NOEPI && kk == 7) ? 2 : 1) : 0;
          const u16* W = up ? (const u16*)(ws + OFF_WUP) + (size_t)layer * DMLP * DM : (const u16*)(ws + OFF_WQKG) + ((size_t)layer * NQKG + 2560) * DM;
          run_gemm(lds, XBc, W, TC, 4096, DM, e, (PROBE_NOEPI && kk == 7) ? 1 : 0);
        }
        if (!up) {
          EpiVT ev; ev.ssq = SSQc; ev.vbuf = (u16*)(ws + OFF_V);
          run_gemm(lds, (const u16*)(ws + OFF_WV) + (size_t)layer * DM * DM, XBc, DM, TC, DM, ev);
        }
      } else if (k == 1 && (PHMASK & 2)) {
        phase_attn(pp, tid_, bid_, nblk_, layer);
      } else if (k == 2 && (PHMASK & 4)) {
        phase_bcombine(pp, tid_, bid_, nblk_);
      } else if (k == 3 && (PHMASK & 8)) {
        EpiMerge e; e.gate = (const u16*)(ws + OFF_GATE); e.mrg = (u16*)(ws + OFF_MRG);
        run_merge(lds, (const u16*)(ws + OFF_Y5), (const u16*)(ws + OFF_WBR5) + (size_t)layer * 5 * DM * 256, e);
      } else if ((k == 4 && (PHMASK & 16)) || (k == 6 && (PHMASK & 64))) {
        const bool dn = (k == 6);
        EpiResid e; e.xold = (!dn && layer == 0) ? (pp.in[0] + (size_t)chunk * TC * DM) : xc; e.xout = xc; e.xb = (u16*)XBc; e.ssq = SSQc;
        const u16* A = dn ? (const u16*)(ws + OFF_GATE) : (const u16*)(ws + OFF_MRG);
        const u16* W = dn ? (const u16*)(ws + OFF_WDN) + (size_t)layer * DM * DMLP : (const u16*)(ws + OFF_WOUT) + (size_t)layer * DM * DM;
        run_gemm(lds, A, W, TC, DM, dn ? DMLP : DM, e);
      }
    }
   }
    if (ph + 1 < p.ph_hi) {
      if (ph == 0) grid.sync();
      else xcd_barrier(xb);
    }
  }
}

extern "C" void kernel_launch(void* const* d_in, const int* in_sizes, int n_in, void* d_out, int out_size, void* d_ws, size_t ws_size,
                              hipStream_t stream) {
  static int grid_blocks = 0;
  if (grid_blocks == 0) {
    if (n_in != 19 || out_size != T * DM || ws_size < WS_END) {
      fprintf(stderr, "kernel_launch: unexpected problem (n_in %d out %d ws %zu need %zu)\n", n_in, out_size, ws_size, (size_t)WS_END);
      grid_blocks = -1;
      return;
    }
    int dev = 0, cus = 0, per_cu = 0;
    (void)hipGetDevice(&dev);
    (void)hipDeviceGetAttribute(&cus, hipDeviceAttributeMultiprocessorCount, dev);
    if (hipFuncSetAttribute((const void*)mk_forward, hipFuncAttributeMaxDynamicSharedMemorySize, LDS_BYTES) != hipSuccess) {
      fprintf(stderr, "kernel_launch: hipFuncSetAttribute failed\n"); grid_blocks = -1; return;
    }
    (void)hipOccupancyMaxActiveBlocksPerMultiprocessor(&per_cu, mk_forward, NTHR, LDS_BYTES);
    if (per_cu < 1) fprintf(stderr, "kernel_launch: occupancy query says %d blocks per CU\n", per_cu);
    (void)hipGetLastError();
    grid_blocks = cus;
  }
  if (grid_blocks < 0) return;
  Params p{};
  for (int i = 0; i < 19; ++i) p.in[i] = (const float*)d_in[i];
  p.out = (float*)d_out;
  p.ws = (unsigned char*)d_ws;
#if FUSED
  (void)hipMemsetAsync((unsigned char*)d_ws + OFF_BAR, 0, XCD_BAR_WORDS * 4, stream);
  p.ph_lo = 0; p.ph_hi = NPHASE;
  void* args[] = {&p};
  hipError_t e = hipLaunchCooperativeKernel((const void*)mk_forward, dim3(grid_blocks), dim3(NTHR), args, LDS_BYTES, stream);
  if (e != hipSuccess) fprintf(stderr, "cooperative launch failed: %s (grid %d)\n", hipGetErrorString(e), grid_blocks);
#else
  for (int ph = 0; ph < NPHASE; ++ph) {
    p.ph_lo = ph; p.ph_hi = ph + 1;
    hipLaunchKernelGGL(mk_forward, dim3(grid_blocks), dim3(NTHR), LDS_BYTES, stream, p);
  }
#endif
}
```

```cpp
#include <hip/hip_runtime.h>
#include <hip/hip_cooperative_groups.h>
#include <cstdio>
namespace cg = cooperative_groups;

#ifndef PHMASK
#define PHMASK 255
#endif
#ifndef DUPMASK
#define DUPMASK 0
#endif
#ifndef DUPK
#define DUPK -1
#endif
#ifndef PROBE_NOEPI
#define PROBE_NOEPI 0
#endif
#ifndef FUSED
#define FUSED 1
#endif

namespace pg8 {
#define PG8_LAS __attribute__((address_space(3)))
typedef unsigned short bf16_t;
typedef short bf16x8 __attribute__((ext_vector_type(8)));
typedef float f32x4 __attribute__((ext_vector_type(4)));
typedef unsigned u32x4 __attribute__((ext_vector_type(4)));
constexpr int BM = 256, BK = 64, HALF = 128, HTB = HALF * BK * 2  , STAGE_BYTES = 8 * HTB, NXCD = 8, WGM = 8;

__host__ __device__ __forceinline__ int lds_byte(int r, int c) { const int st = (r >> 4) * 2 + (c >> 5), rr = r & 15, cc = c & 31, ob = rr * 64 + cc * 2; return st * 1024 + (ob ^ (((ob >> 9) & 1) << 5)); }
__host__ __device__ __forceinline__ void stage_rc(int b, int& R, int& C) { const int st = b / 1024, sb = b % 1024, swz = sb ^ (((sb >> 9) & 1) << 5); R = (st >> 1) * 16 + swz / 64; C = (st & 1) * 32 + (swz % 64) / 2; }
__host__ __device__ __forceinline__ int perm32(int rho) { const int n = rho >> 4, i = rho & 15; return 8 * (i >> 2) + 4 * n + (i & 3); }

struct Unit { int pm, pn, seg; };
struct Gemm { const bf16_t* A; const bf16_t* Bt; int M, N, K; };

struct StaticOrder {
    int nM, nN, nwg, G, c, probe = 0;
    __host__ __device__ void init(int M, int N, int G_, int c_) { nM = M / BM; nN = N / BM; nwg = nM * nN; G = G_; c = c_; }
    __host__ __device__ bool next(int i, Unit& u) const {
        const long L = (long)i * G + c; if (L >= nwg) return false;
        int wgid = (int)L; { const int q = nwg / NXCD, r = nwg % NXCD, xcd = wgid % NXCD, off = wgid / NXCD; wgid = (xcd < r ? xcd * (q + 1) : r * (q + 1) + (xcd - r) * q) + off; }
        const int nig = WGM * nN, gid = wgid / nig, fm = gid * WGM, gsz = (nM - fm) < WGM ? (nM - fm) : WGM;
        u.pm = fm + ((wgid % nig) % gsz); u.pn = (wgid % nig) / gsz; u.seg = 0; if (probe) { u.pm = 0; u.pn = 0; } return true;
    }
    __device__ __forceinline__ void a_ready(const Unit&) const {}
    __device__ __forceinline__ void done(const Unit&) const {}
    __device__ __forceinline__ const char* baseA(const Gemm& g, const Unit& u, size_t tstep) const { return (const char*)g.A + (size_t)u.pm * tstep; }
    __device__ __forceinline__ const char* baseB(const Gemm& g, const Unit& u, size_t tstep) const { return (const char*)g.Bt + (size_t)u.pn * tstep; }
    __device__ __forceinline__ bool zero_after(const Unit&) const { return true; }
};

template <class Epi, class Sched, bool STAMP = false>
__device__ __forceinline__ void gemm_phase(PG8_LAS unsigned char* lds, const Gemm g, const Sched& S, const Epi& E, unsigned long long* stamps) {
    int tid = threadIdx.x; asm volatile("" : "+v"(tid));
    const int wid = __builtin_amdgcn_readfirstlane(tid >> 6), lane = tid & 63, wr = wid >> 2, wc = wid & 3, fr = lane & 15, fq = lane >> 4;
    const int K = g.K, nt = K / BK;
    int ts_lo = 0, ts_hi = 0, nts = 0; const unsigned long long rt_entry = STAMP ? (unsigned long long)wall_clock64() : 0ull;
#define PG8_STAMP() do { if (STAMP && wid == 0 && nts < 64) { const unsigned long long _c = (unsigned long long)clock64(); \
        ts_lo = (lane == nts) ? (int)(unsigned)_c : ts_lo; ts_hi = (lane == nts) ? (int)(unsigned)(_c >> 32) : ts_hi; ++nts; } } while (0)
    PG8_STAMP();
    unsigned voffA[2], voffB[2];
#pragma unroll
    for (int i = 0; i < 2; ++i) { int R, C; stage_rc(tid * 16 + i * 8192, R, C); const int Rb = Epi::PERM ? ((R & ~31) + perm32(R & 31)) : R;
        voffA[i] = (unsigned)(R * K + C) * 2u; voffB[i] = (unsigned)(Rb * K + C) * 2u; }
    const size_t kstep = (size_t)(BK * 2);
    const size_t hstep = (size_t)HALF * K * 2;
    const size_t tstep = 2 * hstep;
    const unsigned ldsw = (unsigned)wid * 1024u;
    const int aoff = lds_byte(wr * 64 + fr, fq * 8), boff = lds_byte(wc * 32 + fr, fq * 8);
#define PG8_SA(b, h) (((b) * 2 + (h)) * HTB)
#define PG8_SB(b, h) ((4 + (b) * 2 + (h)) * HTB)
#define PG8_STAGE(bufoff, gbase, voff) do { _Pragma("unroll") for (int _i = 0; _i < 2; ++_i) \
        __builtin_amdgcn_global_load_lds((const unsigned*)((const char*)(gbase) + (voff)[_i]), (PG8_LAS unsigned*)(lds + (bufoff) + ldsw + _i * 8192), 16, 0, 0); } while (0)
#define PG8_LDA(dst, b, h) do { _Pragma("unroll") for (int m = 0; m < 4; ++m) _Pragma("unroll") for (int k = 0; k < 2; ++k) dst[m][k] = *(const PG8_LAS bf16x8*)(lds + PG8_SA(b, h) + aoff + m * 2048 + k * 1024); } while (0)
#define PG8_LDB(dst, b, h) do { _Pragma("unroll") for (int n = 0; n < 2; ++n) _Pragma("unroll") for (int k = 0; k < 2; ++k) dst[n][k] = *(const PG8_LAS bf16x8*)(lds + PG8_SB(b, h) + boff + n * 2048 + k * 1024); } while (0)
#define PG8_MMA(ai, bj, At, Bt) do { __builtin_amdgcn_s_setprio(1); _Pragma("unroll") for (int m = 0; m < 4; ++m) _Pragma("unroll") for (int n = 0; n < 2; ++n) _Pragma("unroll") for (int k = 0; k < 2; ++k) \
        acc[ai][bj][m][n] = __builtin_amdgcn_mfma_f32_16x16x32_bf16(Bt[n][k], At[m][k], acc[ai][bj][m][n], 0, 0, 0); __builtin_amdgcn_s_setprio(0); } while (0)
#define PG8_WAIT_V(n) asm volatile("s_waitcnt vmcnt(" #n ")" ::: "memory")
#define PG8_WAIT_L(n) asm volatile("s_waitcnt lgkmcnt(" #n ")" ::: "memory")
#define PG8_BAR __builtin_amdgcn_s_barrier()
#define PG8_SCHED __builtin_amdgcn_sched_barrier(0)
    Unit cur, nxt; int ui = 0;
    if (!S.next(0, cur)) return;
    f32x4 acc[2][2][4][2];
#pragma unroll
    for (int a = 0; a < 2; ++a)
#pragma unroll
        for (int b = 0; b < 2; ++b)
#pragma unroll
            for (int m = 0; m < 4; ++m)
#pragma unroll
                for (int n = 0; n < 2; ++n) acc[a][b][m][n] = (f32x4){0.f, 0.f, 0.f, 0.f};
    bf16x8 At[4][2], B0[2][2], B1[2][2];
    const char* cA = S.baseA(g, cur, tstep); const char* cB = S.baseB(g, cur, tstep);
    S.a_ready(cur);
    PG8_STAGE(PG8_SB(0, 0), cB, voffB); PG8_STAGE(PG8_SA(0, 0), cA, voffA); PG8_STAGE(PG8_SB(0, 1), cB + hstep, voffB); PG8_STAGE(PG8_SA(0, 1), cA + hstep, voffA);
    if (wr == 1) PG8_BAR;
    PG8_WAIT_V(4); PG8_BAR;
    PG8_STAGE(PG8_SB(1, 0), cB + kstep, voffB); PG8_STAGE(PG8_SA(1, 0), cA + kstep, voffA); PG8_STAGE(PG8_SB(1, 1), cB + hstep + kstep, voffB);
    PG8_WAIT_V(6); PG8_BAR;
    PG8_STAMP();
    for (;;) {
        const bool has_next = S.next(ui + 1, nxt);
        const char* nA = has_next ? S.baseA(g, nxt, tstep) : cA; const char* nB = has_next ? S.baseB(g, nxt, tstep) : cB;
        for (int t = 0; t < nt; t += 2) {
            const bool last = (t == nt - 2);
            const char* a1 = cA + (size_t)(t + 1) * kstep;
            const char* a2 = last ? nA : cA + (size_t)(t + 2) * kstep; const char* b2 = last ? nB : cB + (size_t)(t + 2) * kstep;
            const char* a3 = a2 + kstep; const char* b3 = b2 + kstep;
            if (last && has_next) S.a_ready(nxt);
            PG8_LDB(B0, 0, 0); PG8_SCHED; PG8_LDA(At, 0, 0); PG8_STAGE(PG8_SA(1, 1), a1 + hstep, voffA);
            PG8_WAIT_L(8); PG8_BAR; PG8_WAIT_L(0); PG8_MMA(0, 0, At, B0); PG8_BAR; PG8_SCHED;
            PG8_LDB(B1, 0, 1); PG8_STAGE(PG8_SB(0, 0), b2, voffB);
            PG8_BAR; PG8_WAIT_L(0); PG8_MMA(0, 1, At, B1); PG8_BAR;
            PG8_LDA(At, 0, 1); PG8_STAGE(PG8_SA(0, 0), a2, voffA);
            PG8_BAR; PG8_WAIT_L(0); PG8_MMA(1, 0, At, B0); PG8_BAR; PG8_SCHED;
            PG8_STAGE(PG8_SB(0, 1), b2 + hstep, voffB);
            PG8_WAIT_V(6); PG8_BAR; PG8_MMA(1, 1, At, B1); PG8_BAR;
            PG8_LDB(B0, 1, 0); PG8_SCHED; PG8_LDA(At, 1, 0); PG8_STAGE(PG8_SA(0, 1), a2 + hstep, voffA);
            PG8_WAIT_L(8); PG8_BAR; PG8_WAIT_L(0); PG8_MMA(0, 0, At, B0); PG8_BAR; PG8_SCHED;
            PG8_LDB(B1, 1, 1); PG8_STAGE(PG8_SB(1, 0), b3, voffB);
            PG8_BAR; PG8_WAIT_L(0); PG8_MMA(0, 1, At, B1); PG8_BAR;
            PG8_LDA(At, 1, 1); PG8_STAGE(PG8_SA(1, 0), a3, voffA);
            PG8_BAR; PG8_WAIT_L(0); PG8_MMA(1, 0, At, B0); PG8_BAR; PG8_SCHED;
            PG8_STAGE(PG8_SB(1, 1), b3 + hstep, voffB);
            PG8_WAIT_V(6); PG8_BAR; PG8_MMA(1, 1, At, B1); PG8_BAR;
        }
        PG8_STAMP();
        if constexpr (!Epi::AFTER_DRAIN) { E(acc, cur, wr, wc, fr, fq); S.done(cur); }
        PG8_STAMP();
        if (!has_next) break;
        if (S.zero_after(cur))
#pragma unroll
        for (int a = 0; a < 2; ++a)
#pragma unroll
            for (int b = 0; b < 2; ++b)
#pragma unroll
                for (int m = 0; m < 4; ++m)
#pragma unroll
                    for (int n = 0; n < 2; ++n) acc[a][b][m][n] = (f32x4){0.f, 0.f, 0.f, 0.f};
        cur = nxt; cA = nA; cB = nB; ++ui;
    }
    PG8_WAIT_V(0);
    if (wr == 0) PG8_BAR;
    PG8_BAR;
    if constexpr (Epi::AFTER_DRAIN) { E.fused(acc, cur, wr, wc, fr, fq, lds, wid, lane); S.done(cur); }
    PG8_STAMP();
    if (STAMP && wid == 0) { stamps[lane] = lane < nts ? (((unsigned long long)(unsigned)ts_hi << 32) | (unsigned)ts_lo) : 0ull;
        if (lane == 62) stamps[62] = rt_entry; if (lane == 63) stamps[63] = (unsigned long long)wall_clock64(); }
#undef PG8_STAMP
#undef PG8_SA
#undef PG8_SB
#undef PG8_STAGE
#undef PG8_LDA
#undef PG8_LDB
#undef PG8_MMA
#undef PG8_WAIT_V
#undef PG8_WAIT_L
#undef PG8_BAR
#undef PG8_SCHED
}
}

typedef unsigned short u16;
typedef short bf16x8 __attribute__((ext_vector_type(8)));
typedef float f32x16 __attribute__((ext_vector_type(16)));
typedef float f32x4 __attribute__((ext_vector_type(4)));
typedef __bf16 bf2_t __attribute__((ext_vector_type(2)));
typedef float f2_t __attribute__((ext_vector_type(2)));
typedef unsigned u32x4 __attribute__((ext_vector_type(4)));
typedef unsigned u32x2 __attribute__((ext_vector_type(2)));
using pg8::Unit;

#define DI __device__ __forceinline__
#define MFMA32(a, b, c) __builtin_amdgcn_mfma_f32_32x32x16_bf16((a), (b), (c), 0, 0, 0)

constexpr int DM = 1024, SEQ = 4096, NBATCH = 8, T = NBATCH * SEQ;
constexpr int NCH = 2, BC = NBATCH / NCH, TC = BC * SEQ;
constexpr int INC = 7552, DMLP = 4096;
constexpr int NQKG = 6656;
constexpr int NQKH = 38, NVH = 16;
constexpr float LOG2E = 1.4426950408889634f;
constexpr int NTHR = 512;

constexpr size_t al256(size_t x) { return (x + 255) & ~(size_t)255; }
constexpr size_t OFF_WQKG = 0;
constexpr size_t OFF_WV   = OFF_WQKG + al256((size_t)2 * NQKG * DM * 2);
constexpr size_t OFF_WBR5 = OFF_WV   + al256((size_t)2 * DM * DM * 2);
constexpr size_t OFF_WOUT = OFF_WBR5 + al256((size_t)2 * 5 * DM * 256 * 2);
constexpr size_t OFF_WUP  = OFF_WOUT + al256((size_t)2 * DM * DM * 2);
constexpr size_t OFF_WDN  = OFF_WUP  + al256((size_t)2 * DMLP * DM * 2);
constexpr size_t OFF_ROPE = OFF_WDN  + al256((size_t)2 * DM * DMLP * 2);
constexpr size_t OFF_XB   = OFF_ROPE + al256((size_t)SEQ * 96 * 4);
constexpr size_t OFF_SSQ  = OFF_XB   + al256((size_t)T * DM * 2);
constexpr size_t OFF_QK   = OFF_SSQ  + al256((size_t)T * 16 * 4);
constexpr size_t OFF_V    = OFF_QK   + al256((size_t)NQKH * TC * 64 * 2);
constexpr size_t OFF_GATE = OFF_V    + al256((size_t)NVH * TC * 64 * 2);
constexpr size_t OFF_Y5   = OFF_GATE + al256((size_t)TC * 4096 * 2);
constexpr size_t OFF_BO   = OFF_Y5   + al256((size_t)5 * TC * 256 * 2);
constexpr size_t OFF_LSE  = OFF_BO   + al256((size_t)TC * 384 * 2);
constexpr size_t OFF_MRG  = OFF_LSE  + al256((size_t)TC * 8 * 4);
constexpr size_t OFF_BAR  = OFF_MRG  + al256((size_t)TC * DM * 2);
constexpr size_t WS_END   = OFF_BAR  + 16384;
static_assert(WS_END <= (size_t)512 * 1024 * 1024, "workspace too large");

constexpr int LDS_STAGE = 131072;
constexpr int LDS_BYTES = LDS_STAGE + 64;
constexpr int PPL = (DUPK >= 0) ? 8 : 7;
constexpr int NPHASE = 1 + NCH * 2 * PPL;

struct Params {
  const float* in[19];
  float* out;
  unsigned char* ws;
  int ph_lo, ph_hi;
};

DI unsigned pk2(float a, float b) { f2_t v = {a, b}; bf2_t r = __builtin_convertvector(v, bf2_t); return __builtin_bit_cast(unsigned, r); }
DI float bf_lo(unsigned u) { return __uint_as_float(u << 16); }
DI float bf_hi(unsigned u) { return __uint_as_float(u & 0xffff0000u); }
DI float fexp2(float x) { return __builtin_amdgcn_exp2f(x); }
DI int crow(int i, int h) { return (i & 3) + 8 * (i >> 2) + 4 * h; }
DI bf16x8 as_bf8(u32x4 v) { return __builtin_bit_cast(bf16x8, v); }
DI int dil_of(int gi) { return gi == 0 ? 1 : (gi == 1 ? 4 : 16); }
DI int dlg_of(int gi) { return gi * 2; }
DI float row_rscale(const float* ssq, size_t tok) {
  const f32x4 a = *(const f32x4*)(ssq + tok * 16), b = *(const f32x4*)(ssq + tok * 16 + 4);
  const f32x4 c = *(const f32x4*)(ssq + tok * 16 + 8), d = *(const f32x4*)(ssq + tok * 16 + 12);
  const float s = ((a[0] + a[1]) + (a[2] + a[3])) + ((b[0] + b[1]) + (b[2] + b[3])) + ((c[0] + c[1]) + (c[2] + c[3])) + ((d[0] + d[1]) + (d[2] + d[3]));
  return rsqrtf(s * (1.0f / 1024.0f) + 1e-6f);
}
DI int qk_head_col(int h) {
  if (h < 8) return 64 * h;
  if (h < 10) return 512 + 64 * (h - 8);
  if (h < 16) return 768 + 64 * (h - 10);
  if (h < 22) return 1152 + 64 * (h - 16);
  if (h < 26) return 1920 + 64 * (h - 22);
  if (h < 30) return 2176 + 64 * (h - 26);
  if (h < 34) return 2688 + 64 * (h - 30);
  return 2944 + 64 * (h - 34);
}
DI int v_head_col(int vh) {
  if (vh < 2) return 640 + 64 * vh;
  if (vh < 8) return 1536 + 64 * (vh - 2);
  if (vh < 12) return 2432 + 64 * (vh - 8);
  return 3200 + 64 * (vh - 12);
}

struct EpiQKG {
  static constexpr bool PERM = false, AFTER_DRAIN = false;
  const float* ssq; u16* qk; const float* rope; const float* gA; const float* gB; const float* gC; const float* gD;
  DI void operator()(const f32x4 (&acc)[2][2][4][2], const Unit& u, int wr, int wc, int fr, int fq) const {
    const int hidx = u.pn * 4 + wc;
    if (hidx >= NQKH) return;
    int kind, dlg = 0; const float* gain;
    if (hidx < 8) { kind = 0; gain = gA; }
    else if (hidx < 10) { kind = 0; gain = gA + 64; }
    else if (hidx < 16) { kind = 0; gain = gB; dlg = dlg_of((hidx - 10) >> 1); }
    else if (hidx < 22) { kind = 0; gain = gB + 64; dlg = dlg_of((hidx - 16) >> 1); }
    else if (hidx < 26) { kind = 2; gain = gC; }
    else if (hidx < 30) { kind = 2; gain = gC + 32; }
    else if (hidx < 34) { kind = 1; gain = gD; }
    else { kind = 1; gain = gD + 64; }
    u16* gbase = qk + (size_t)hidx * TC * 64;
    const float* gainl = gain + 4 * fq;
#pragma unroll
    for (int ai = 0; ai < 2; ++ai)
#pragma unroll
      for (int m = 0; m < 4; ++m) {
        const int tok = u.pm * 256 + 128 * ai + 64 * wr + 16 * m + fr;
        const int bl = tok >> 12, pos = tok & 4095;
        const float rs = row_rscale(ssq, tok);
        const int pdom = ((pos & ((1 << dlg) - 1)) << (12 - dlg)) + (pos >> dlg);
        const int blk = pdom >> 5, rr = pdom & 31;
        u16* base = gbase + (size_t)bl * SEQ * 64;
        if (kind != 2) {
          float ss = 0.f;
#pragma unroll
          for (int bj = 0; bj < 2; ++bj)
#pragma unroll
            for (int n = 0; n < 2; ++n)
#pragma unroll
              for (int e = 0; e < 4; ++e) ss += acc[ai][bj][m][n][e] * acc[ai][bj][m][n][e];
          ss += __shfl_xor(ss, 16); ss += __shfl_xor(ss, 32);
          const float sc = rs * rsqrtf(ss * rs * rs * (1.0f / 64.0f) + 1e-6f);
#pragma unroll
          for (int n = 0; n < 2; ++n) {
            f32x4 xa = acc[ai][0][m][n] * sc * *(const f32x4*)(gainl + 16 * n);
            f32x4 xb2 = acc[ai][1][m][n] * sc * *(const f32x4*)(gainl + 32 + 16 * n);
            if (kind == 0) {
              const f32x4 c4 = *(const f32x4*)(rope + pos * 96 + 16 * n + 4 * fq);
              const f32x4 s4 = *(const f32x4*)(rope + pos * 96 + 32 + 16 * n + 4 * fq);
              const f32x4 ta = xa * c4 - xb2 * s4, tb = xb2 * c4 + xa * s4;
              xa = ta; xb2 = tb;
            }
            u32x2 w0 = {pk2(xa[0], xa[1]), pk2(xa[2], xa[3])};
            *(u32x2*)(base + ((size_t)(blk * 4 + n) * 64 + (fq >> 1) * 32 + rr) * 8 + 4 * (fq & 1)) = w0;
            u32x2 w1 = {pk2(xb2[0], xb2[1]), pk2(xb2[2], xb2[3])};
            *(u32x2*)(base + ((size_t)(blk * 4 + 2 + n) * 64 + (fq >> 1) * 32 + rr) * 8 + 4 * (fq & 1)) = w1;
          }
        } else {
          const f32x4 c4 = *(const f32x4*)(rope + pos * 96 + 64 + 4 * fq);
          const f32x4 s4 = *(const f32x4*)(rope + pos * 96 + 80 + 4 * fq);
#pragma unroll
          for (int bj = 0; bj < 2; ++bj) {
            float ss = 0.f;
#pragma unroll
            for (int n = 0; n < 2; ++n)
#pragma unroll
              for (int e = 0; e < 4; ++e) ss += acc[ai][bj][m][n][e] * acc[ai][bj][m][n][e];
            ss += __shfl_xor(ss, 16); ss += __shfl_xor(ss, 32);
            const float sc = rs * rsqrtf(ss * rs * rs * (1.0f / 32.0f) + 1e-6f);
            const f32x4 xa = acc[ai][bj][m][0] * sc * *(const f32x4*)(gainl);
            const f32x4 xb2 = acc[ai][bj][m][1] * sc * *(const f32x4*)(gainl + 16);
            const f32x4 ta = xa * c4 - xb2 * s4, tb = xb2 * c4 + xa * s4;
            u16* sb = base + (size_t)bj * SEQ * 32;
            u32x2 w0 = {pk2(ta[0], ta[1]), pk2(ta[2], ta[3])};
            *(u32x2*)(sb + ((size_t)(blk * 2 + 0) * 64 + (fq >> 1) * 32 + rr) * 8 + 4 * (fq & 1)) = w0;
            u32x2 w1 = {pk2(tb[0], tb[1]), pk2(tb[2], tb[3])};
            *(u32x2*)(sb + ((size_t)(blk * 2 + 1) * 64 + (fq >> 1) * 32 + rr) * 8 + 4 * (fq & 1)) = w1;
          }
        }
        asm volatile("" ::: "memory");
      }
  }
};

struct EpiGateUp {
  static constexpr bool PERM = true, AFTER_DRAIN = false;
  const float* ssq; u16* o; int mode;
  DI void operator()(const f32x4 (&acc)[2][2][4][2], const Unit& u, int wr, int wc, int fr, int fq) const {
    if (mode == 2) return;
    const int c0 = u.pn * 256 + 32 * wc + 8 * fq;
    const bool up = mode != 0;
#pragma unroll
    for (int ai = 0; ai < 2; ++ai)
#pragma unroll
      for (int m = 0; m < 4; ++m) {
        const size_t tok = (size_t)u.pm * 256 + 128 * ai + 64 * wr + 16 * m + fr;
        const float rs = row_rscale(ssq, tok);
#pragma unroll
        for (int bj = 0; bj < 2; ++bj) {
          float r[8];
#pragma unroll
          for (int n = 0; n < 2; ++n) {
            const f32x4 v = acc[ai][bj][m][n] * rs;
#pragma unroll
            for (int e = 0; e < 4; ++e) {
              const float z = fmaxf(v[e], 0.f);
              const float sg = __builtin_amdgcn_rcpf(1.0f + __expf(-v[e]));
              r[4 * n + e] = up ? z * z : sg;
            }
          }
          u32x4 w = {pk2(r[0], r[1]), pk2(r[2], r[3]), pk2(r[4], r[5]), pk2(r[6], r[7])};
          *(u32x4*)(o + tok * 4096 + c0 + 128 * bj) = w;
        }
        asm volatile("" ::: "memory");
      }
  }
};

struct EpiVT {
  static constexpr bool PERM = false, AFTER_DRAIN = false;
  const float* ssq; u16* vbuf;
  DI void operator()(const f32x4 (&acc)[2][2][4][2], const Unit& u, int wr, int wc, int fr, int fq) const {
    f32x4 rs4[2][2];
#pragma unroll
    for (int bj = 0; bj < 2; ++bj)
#pragma unroll
      for (int n = 0; n < 2; ++n) {
        const size_t t0 = (size_t)u.pn * 256 + 128 * bj + 32 * wc + 16 * n + 4 * fq;
#pragma unroll
        for (int e = 0; e < 4; ++e) { rs4[bj][n][e] = row_rscale(ssq, t0 + e); asm volatile("" ::: "memory"); }
      }
#pragma unroll
    for (int ai = 0; ai < 2; ++ai) {
      const int vgrp = u.pm * 4 + 2 * ai + wr;
      const int dlg = (vgrp >= 2 && vgrp < 8) ? dlg_of((vgrp - 2) >> 1) : 0;
      u16* gbase = vbuf + (size_t)vgrp * TC * 64;
      const int bl = (u.pn * 256) >> 12;
      u16* base = gbase + (size_t)bl * SEQ * 64;
      const unsigned es = (dlg == 0) ? 1u : (unsigned)(128 >> dlg) * 2048u;
#pragma unroll
      for (int m = 0; m < 4; ++m) {
        const int dv = 16 * m + fr;
        const unsigned dvo = (unsigned)((dv >> 5) * 1024 + (dv & 31) * 8);
#pragma unroll
        for (int bj = 0; bj < 2; ++bj)
#pragma unroll
          for (int n = 0; n < 2; ++n) {
            const int pos0 = (u.pn * 256 + 128 * bj + 32 * wc + 16 * n + 4 * fq) & 4095;
            const f32x4 v = acc[ai][bj][m][n] * rs4[bj][n];
            const int pd0 = ((pos0 & ((1 << dlg) - 1)) << (12 - dlg)) + (pos0 >> dlg);
            const int blk = pd0 >> 5, key = pd0 & 31;
            const unsigned off = (unsigned)blk * 2048u + (unsigned)(key >> 4) * 512u + (unsigned)((key >> 2) & 1) * 256u + dvo + 4u * ((key >> 3) & 1);
            const unsigned w0 = pk2(v[0], v[1]), w1 = pk2(v[2], v[3]);
            const unsigned o2 = off + (key & 3);
            base[o2] = (u16)(w0 & 0xffffu); base[o2 + es] = (u16)(w0 >> 16); base[o2 + 2 * es] = (u16)(w1 & 0xffffu); base[o2 + 3 * es] = (u16)(w1 >> 16);
            asm volatile("" ::: "memory");
          }
      }
    }
  }
};

struct MergeOrder : pg8::StaticOrder {
  const u16* ybase; const u16* wbase;
  DI bool next(int i, Unit& u) const { if (i >= 5) return false; if (!pg8::StaticOrder::next(0, u)) return false; u.seg = i; return true; }
  DI const char* baseA(const pg8::Gemm&, const Unit& u, size_t tstep) const { return (const char*)(ybase + (size_t)u.seg * TC * 256) + (size_t)u.pm * tstep; }
  DI const char* baseB(const pg8::Gemm&, const Unit& u, size_t tstep) const { return (const char*)(wbase + (size_t)u.seg * DM * 256) + (size_t)u.pn * tstep; }
  DI bool zero_after(const Unit& u) const { return u.seg == 4; }
};
struct EpiMerge {
  static constexpr bool PERM = true, AFTER_DRAIN = false;
  const u16* gate; u16* mrg;
  DI void operator()(f32x4 (&acc)[2][2][4][2], const Unit& u, int wr, int wc, int fr, int fq) const {
    const int seg = u.seg;
    if (seg == 0) return;
    const bool last = (seg == 4);
    const int gnum = last ? 3 : seg - 1, gden = last ? 3 : seg;
#pragma unroll
    for (int ai = 0; ai < 2; ++ai)
#pragma unroll
      for (int m = 0; m < 4; ++m) {
        const size_t tok = (size_t)u.pm * 256 + 128 * ai + 64 * wr + 16 * m + fr;
#pragma unroll
        for (int bj = 0; bj < 2; ++bj) {
          const int c = u.pn * 256 + 128 * bj + 32 * wc + 8 * fq;
          const u32x4 gn = *(const u32x4*)(gate + tok * 4096 + gnum * 1024 + c);
          const u32x4 gd = *(const u32x4*)(gate + tok * 4096 + gden * 1024 + c);
#pragma unroll
          for (int n = 0; n < 2; ++n) {
            f32x4 f;
            f[0] = bf_lo(gn[2 * n]); f[1] = bf_hi(gn[2 * n]); f[2] = bf_lo(gn[2 * n + 1]); f[3] = bf_hi(gn[2 * n + 1]);
            if (!last) {
              f[0] *= __builtin_amdgcn_rcpf(bf_lo(gd[2 * n])); f[1] *= __builtin_amdgcn_rcpf(bf_hi(gd[2 * n]));
              f[2] *= __builtin_amdgcn_rcpf(bf_lo(gd[2 * n + 1])); f[3] *= __builtin_amdgcn_rcpf(bf_hi(gd[2 * n + 1]));
            }
            acc[ai][bj][m][n] *= f;
          }
          if (last) {
            const f32x4 v0 = acc[ai][bj][m][0], v1 = acc[ai][bj][m][1];
            u32x4 w = {pk2(v0[0], v0[1]), pk2(v0[2], v0[3]), pk2(v1[0], v1[1]), pk2(v1[2], v1[3])};
            *(u32x4*)(mrg + tok * DM + c) = w;
          }
        }
        asm volatile("" ::: "memory");
      }
  }
};

struct EpiResid {
  static constexpr bool PERM = true, AFTER_DRAIN = false;
  const float* xold; float* xout; u16* xb; float* ssq;
  DI void operator()(const f32x4 (&acc)[2][2][4][2], const Unit& u, int wr, int wc, int fr, int fq) const {
#pragma unroll
    for (int ai = 0; ai < 2; ++ai)
#pragma unroll
      for (int m = 0; m < 4; ++m) {
        const size_t tok = (size_t)u.pm * 256 + 128 * ai + 64 * wr + 16 * m + fr;
        float ss = 0.f;
#pragma unroll
        for (int bj = 0; bj < 2; ++bj) {
          const size_t o = tok * DM + u.pn * 256 + 128 * bj + 32 * wc + 8 * fq;
          const f32x4 v0 = *(const f32x4*)(xold + o) + acc[ai][bj][m][0];
          const f32x4 v1 = *(const f32x4*)(xold + o + 4) + acc[ai][bj][m][1];
          *(f32x4*)(xout + o) = v0;
          *(f32x4*)(xout + o + 4) = v1;
          u32x4 w = {pk2(v0[0], v0[1]), pk2(v0[2], v0[3]), pk2(v1[0], v1[1]), pk2(v1[2], v1[3])};
          *(u32x4*)(xb + o) = w;
          ss += ((v0[0] * v0[0] + v0[1] * v0[1]) + (v0[2] * v0[2] + v0[3] * v0[3])) + ((v1[0] * v1[0] + v1[1] * v1[1]) + (v1[2] * v1[2] + v1[3] * v1[3]));
        }
        ss += __shfl_xor(ss, 16); ss += __shfl_xor(ss, 32);
        if (fq == 0) ssq[tok * 16 + u.pn * 4 + wc] = ss;
        asm volatile("" ::: "memory");
      }
  }
};

template <class Epi>
DI void run_merge(PG8_LAS unsigned char* lds, const u16* ybase, const u16* wbase, const Epi& E) {
  int K = 256; asm volatile("" : "+s"(K));
  pg8::Gemm g; g.A = ybase; g.Bt = wbase; g.M = TC; g.N = DM; g.K = K;
  MergeOrder S; S.init(TC, DM, (int)gridDim.x, (int)blockIdx.x); S.ybase = ybase; S.wbase = wbase;
  pg8::gemm_phase<Epi, MergeOrder, false>(lds, g, S, E, nullptr);
}
template <class Epi>
DI void run_gemm(PG8_LAS unsigned char* lds, const u16* A, const u16* Bt, int M, int N, int K, const Epi& E, int probe = 0) {
  asm volatile("" : "+s"(K));
  pg8::Gemm g; g.A = A; g.Bt = Bt; g.M = M; g.N = N; g.K = K;
  pg8::StaticOrder S; S.init(M, N, (int)gridDim.x, (int)blockIdx.x); S.probe = probe;
  pg8::gemm_phase<Epi, pg8::StaticOrder, false>(lds, g, S, E, nullptr);
}

DI void cvt_load(const float* __restrict__ src, int N, int k0, int n0, const float* __restrict__ g, float* t, int ht) {
  const int c4 = (ht & 15) * 4;
#pragma unroll
  for (int i = 0; i < 4; ++i) {
    const int kk = (ht >> 4) + 16 * i;
    f32x4 v = *(const f32x4*)(src + (size_t)(k0 + kk) * N + n0 + c4);
    const float sc = g ? g[k0 + kk] : 1.0f;
    t[kk * 65 + c4 + 0] = v[0] * sc; t[kk * 65 + c4 + 1] = v[1] * sc; t[kk * 65 + c4 + 2] = v[2] * sc; t[kk * 65 + c4 + 3] = v[3] * sc;
  }
}
DI void cvt_store(u16* __restrict__ dst, int ldk, int kdst, int d0, int d1, const float* t, int ht) {
  const int kc = (ht & 7) * 8, nn = ht >> 3;
#pragma unroll
  for (int i = 0; i < 2; ++i) {
    const int tn = nn + 32 * i, row = (i == 0) ? d0 + nn : d1 + nn;
    u32x4 w;
    w[0] = pk2(t[(kc + 0) * 65 + tn], t[(kc + 1) * 65 + tn]);
    w[1] = pk2(t[(kc + 2) * 65 + tn], t[(kc + 3) * 65 + tn]);
    w[2] = pk2(t[(kc + 4) * 65 + tn], t[(kc + 5) * 65 + tn]);
    w[3] = pk2(t[(kc + 6) * 65 + tn], t[(kc + 7) * 65 + tn]);
    *(u32x4*)(dst + (size_t)row * ldk + kdst + kc) = w;
  }
}
struct CvtJob { const float* src; int N, k0, n0; const float* g; u16* dst; int ldk, d0, d1, kd; };
DI CvtJob cvt_job(const Params& p, int l, int ti) {
  CvtJob j; j.g = nullptr; j.kd = -1;
  const float* attn_g = p.in[1] + l * DM;
  if (ti < 608) { const int h = ti >> 4, kt = ti & 15; j.src = p.in[2] + (size_t)l * DM * INC; j.N = INC; j.k0 = kt * 64; j.n0 = qk_head_col(h); j.g = attn_g;
    j.dst = (u16*)(p.ws + OFF_WQKG) + (size_t)l * NQKG * DM; j.ldk = DM; j.d0 = (h >> 2) * 256 + (h & 3) * 32; j.d1 = j.d0 + 128; return j; }
  ti -= 608;
  if (ti < 1024) { const int c = ti >> 4, kt = ti & 15; j.src = p.in[2] + (size_t)l * DM * INC; j.N = INC; j.k0 = kt * 64; j.n0 = 3456 + 64 * c; j.g = attn_g;
    j.dst = (u16*)(p.ws + OFF_WQKG) + (size_t)l * NQKG * DM; j.ldk = DM; j.d0 = 2560 + 64 * c; j.d1 = j.d0 + 32; return j; }
  ti -= 1024;
  if (ti < 256) { const int vh = ti >> 4, kt = ti & 15; j.src = p.in[2] + (size_t)l * DM * INC; j.N = INC; j.k0 = kt * 64; j.n0 = v_head_col(vh); j.g = attn_g;
    j.dst = (u16*)(p.ws + OFF_WV) + (size_t)l * DM * DM; j.ldk = DM; j.d0 = vh * 64; j.d1 = j.d0 + 32; return j; }
  ti -= 256;
  if (ti < 128) { j.src = p.in[11] + (size_t)l * 512 * DM; j.N = DM; j.k0 = (ti >> 4) * 64; j.n0 = (ti & 15) * 64; j.dst = (u16*)(p.ws + OFF_WBR5) + ((size_t)l * 5 + (j.k0 >> 8)) * DM * 256; j.ldk = 256; j.kd = j.k0 & 255; j.d0 = j.n0; j.d1 = j.n0 + 32; return j; }
  ti -= 128;
  if (ti < 32) { j.src = p.in[12] + (size_t)l * 128 * DM; j.N = DM; j.k0 = (ti >> 4) * 64; j.n0 = (ti & 15) * 64; j.dst = (u16*)(p.ws + OFF_WBR5) + ((size_t)l * 5 + 2) * DM * 256; j.ldk = 256; j.kd = j.k0; j.d0 = j.n0; j.d1 = j.n0 + 32; return j; }
  ti -= 32;
  if (ti < 64) { j.src = p.in[13] + (size_t)l * 256 * DM; j.N = DM; j.k0 = (ti >> 4) * 64; j.n0 = (ti & 15) * 64; j.dst = (u16*)(p.ws + OFF_WBR5) + ((size_t)l * 5 + 3) * DM * 256; j.ldk = 256; j.kd = j.k0; j.d0 = j.n0; j.d1 = j.n0 + 32; return j; }
  ti -= 64;
  if (ti < 64) { j.src = p.in[14] + (size_t)l * 256 * DM; j.N = DM; j.k0 = (ti >> 4) * 64; j.n0 = (ti & 15) * 64; j.dst = (u16*)(p.ws + OFF_WBR5) + ((size_t)l * 5 + 4) * DM * 256; j.ldk = 256; j.kd = j.k0; j.d0 = j.n0; j.d1 = j.n0 + 32; return j; }
  ti -= 64;
  if (ti < 256) { j.src = p.in[15] + (size_t)l * DM * DM; j.N = DM; j.k0 = (ti >> 4) * 64; j.n0 = (ti & 15) * 64; j.dst = (u16*)(p.ws + OFF_WOUT) + (size_t)l * DM * DM; j.ldk = DM; j.d0 = j.n0; j.d1 = j.n0 + 32; return j; }
  ti -= 256;
  if (ti < 1024) { j.src = p.in[17] + (size_t)l * DM * DMLP; j.N = DMLP; j.k0 = (ti >> 6) * 64; j.n0 = (ti & 63) * 64; j.g = p.in[16] + l * DM;
    j.dst = (u16*)(p.ws + OFF_WUP) + (size_t)l * DMLP * DM; j.ldk = DM; j.d0 = j.n0; j.d1 = j.n0 + 32; return j; }
  ti -= 1024;
  j.src = p.in[18] + (size_t)l * DMLP * DM; j.N = DM; j.k0 = (ti >> 4) * 64; j.n0 = (ti & 15) * 64; j.dst = (u16*)(p.ws + OFF_WDN) + (size_t)l * DM * DMLP; j.ldk = DMLP; j.d0 = j.n0; j.d1 = j.n0 + 32; return j;
}

__device__ void phase_prep(const Params& p, int tid_, int bid_, int nblk_, unsigned char* smem) {
  const int half = tid_ >> 8, ht = tid_ & 255;
  float* t = (float*)smem + half * (64 * 65);
  const int per_layer = 4480, total = 2 * per_layer;
  for (int jp = bid_; jp * 2 < total; jp += nblk_) {
    const int j = jp * 2 + half;
    const bool on = j < total;
    CvtJob job;
    if (on) { job = cvt_job(p, j / per_layer, j % per_layer); cvt_load(job.src, job.N, job.k0, job.n0, job.g, t, ht); }
    __syncthreads();
    if (on) cvt_store(job.dst, job.ldk, (job.kd >= 0) ? job.kd : job.k0, job.d0, job.d1, t, ht);
    __syncthreads();
  }
  {
    const u32x4 z = {0u, 0u, 0u, 0u};
    for (int e = bid_ * NTHR + tid_; e < 2 * 128 * 128; e += nblk_ * NTHR) {
      const int l = e >> 14, r = (e >> 7) & 127, c = (e & 127) * 8;
      const int row = 9 * 256 + ((r < 64) ? 64 + r : 128 + r);
      *(u32x4*)((u16*)(p.ws + OFF_WQKG) + ((size_t)l * NQKG + row) * DM + c) = z;
    }
    for (int e = bid_ * NTHR + tid_; e < 2 * 1024 * 16; e += nblk_ * NTHR) {
      const int l = e >> 14, r = (e >> 4) & 1023, c = 128 + (e & 15) * 8;
      *(u32x4*)((u16*)(p.ws + OFF_WBR5) + (((size_t)l * 5 + 2) * DM + r) * 256 + c) = z;
    }
  }
  float* rope = (float*)(p.ws + OFF_ROPE);
  for (int e = bid_ * NTHR + tid_; e < SEQ * 48; e += nblk_ * NTHR) {
    const int pos = e / 48, i = e % 48;
    float inv;
    if (i < 32) inv = exp2f(-13.287712379549449f * (float)(2 * i) / 64.0f);
    else inv = exp2f(-13.287712379549449f * (float)(2 * (i - 32)) / 32.0f);
    const float angf = (float)pos * inv;
    const double ang = (double)angf;
    const double n = rint(ang * 0.15915494309189535);
    const float r = (float)(ang - n * 6.283185307179586);
    const float c = cosf(r), s = sinf(r);
    if (i < 32) { rope[pos * 96 + i] = c; rope[pos * 96 + 32 + i] = s; }
    else { rope[pos * 96 + 64 + (i - 32)] = c; rope[pos * 96 + 80 + (i - 32)] = s; }
  }
  u16* XB = (u16*)(p.ws + OFF_XB); float* SSQ = (float*)(p.ws + OFF_SSQ);
  const int lane = tid_ & 63;
  const int gw = bid_ * 8 + (tid_ >> 6), nw = nblk_ * 8;
  for (int row = gw; row < T; row += nw) {
    const float* xr = p.in[0] + (size_t)row * DM;
    float ss = 0.f;
#pragma unroll
    for (int i = 0; i < 4; ++i) {
      const f32x4 v = *(const f32x4*)(xr + i * 256 + lane * 4);
      ss += v[0] * v[0] + v[1] * v[1] + v[2] * v[2] + v[3] * v[3];
      u32x2 w = {pk2(v[0], v[1]), pk2(v[2], v[3])};
      *(u32x2*)(XB + (size_t)row * DM + i * 256 + lane * 4) = w;
    }
#pragma unroll
    for (int o = 32; o >= 1; o >>= 1) ss += __shfl_xor(ss, o);
    if (lane < 16) SSQ[(size_t)row * 16 + lane] = (lane == 0) ? ss : 0.f;
  }
}

DI void attn_softmax_pv(f32x16& S, float& m, float& l, f32x16& O0, f32x16& O1, const bf16x8 (&vf)[2][2]) {
  float mx = S[0];
#pragma unroll
  for (int i = 1; i < 16; ++i) mx = fmaxf(mx, S[i]);
  mx = fmaxf(mx, __shfl_xor(mx, 32));
  const float mn = fmaxf(m, mx);
  const float alpha = fexp2(m - mn);
  m = mn;
  float sum = 0.f;
#pragma unroll
  for (int i = 0; i < 16; ++i) { S[i] = fexp2(S[i] - mn); sum += S[i]; }
  l = l * alpha + sum;
  const u32x4 p0 = {pk2(S[0], S[1]), pk2(S[2], S[3]), pk2(S[4], S[5]), pk2(S[6], S[7])};
  const u32x4 p1 = {pk2(S[8], S[9]), pk2(S[10], S[11]), pk2(S[12], S[13]), pk2(S[14], S[15])};
#pragma unroll
  for (int i = 0; i < 16; ++i) { O0[i] *= alpha; O1[i] *= alpha; }
  O0 = MFMA32(vf[0][0], as_bf8(p0), O0);
  O0 = MFMA32(vf[0][1], as_bf8(p1), O0);
  O1 = MFMA32(vf[1][0], as_bf8(p0), O1);
  O1 = MFMA32(vf[1][1], as_bf8(p1), O1);
}
DI void attn_fixed_pv(f32x16& S, float sc2, float mb2, float& l, f32x16& O0, f32x16& O1, const bf16x8 (&vf)[2][2]) {
  float sum = 0.f;
#pragma unroll
  for (int i = 0; i < 16; ++i) { S[i] = fexp2(__builtin_fmaf(S[i], sc2, -mb2)); sum += S[i]; }
  l += sum;
  const u32x4 p0 = {pk2(S[0], S[1]), pk2(S[2], S[3]), pk2(S[4], S[5]), pk2(S[6], S[7])};
  const u32x4 p1 = {pk2(S[8], S[9]), pk2(S[10], S[11]), pk2(S[12], S[13]), pk2(S[14], S[15])};
  O0 = MFMA32(vf[0][0], as_bf8(p0), O0);
  O0 = MFMA32(vf[0][1], as_bf8(p1), O0);
  O1 = MFMA32(vf[1][0], as_bf8(p0), O1);
  O1 = MFMA32(vf[1][1], as_bf8(p1), O1);
}
DI void load_vf(bf16x8 (&vf)[2][2], const u16* V, int kb, int lane) {
#pragma unroll
  for (int rb = 0; rb < 2; ++rb)
#pragma unroll
    for (int s = 0; s < 2; ++s) vf[rb][s] = *(const bf16x8*)(V + ((size_t)((kb * 2 + rb) * 2 + s) * 64 + lane) * 8);
}
DI void load_kf4(bf16x8 (&kf)[4], const u16* K, int kb, int lane) {
#pragma unroll
  for (int s = 0; s < 4; ++s) kf[s] = *(const bf16x8*)(K + ((size_t)(kb * 4 + s) * 64 + lane) * 8);
}
DI void load_kf2(bf16x8 (&kf)[2], const u16* K, int kb, int lane) {
#pragma unroll
  for (int s = 0; s < 2; ++s) kf[s] = *(const bf16x8*)(K + ((size_t)(kb * 2 + s) * 64 + lane) * 8);
}
DI void zero16(f32x16& a) {
#pragma unroll
  for (int i = 0; i < 16; ++i) a[i] = 0.f;
}
DI void store_o(u16* yrow, const f32x16& O0, const f32x16& O1, float sc, int h) {
#pragma unroll
  for (int g4 = 0; g4 < 4; ++g4) {
    u32x2 w0 = {pk2(O0[4 * g4] * sc, O0[4 * g4 + 1] * sc), pk2(O0[4 * g4 + 2] * sc, O0[4 * g4 + 3] * sc)};
    *(u32x2*)(yrow + 8 * g4 + 4 * h) = w0;
    u32x2 w1 = {pk2(O1[4 * g4] * sc, O1[4 * g4 + 1] * sc), pk2(O1[4 * g4 + 2] * sc, O1[4 * g4 + 3] * sc)};
    *(u32x2*)(yrow + 32 + 8 * g4 + 4 * h) = w1;
  }
}

__device__ void phase_attn(const Params& p, int tid_, int bid_, int nblk_, int layer) {
  const u16* QK = (const u16*)(p.ws + OFF_QK);
  const u16* VB = (const u16*)(p.ws + OFF_V);
  u16* Y5 = (u16*)(p.ws + OFF_Y5);
  u16* BO = (u16*)(p.ws + OFF_BO);
  float* LSE = (float*)(p.ws + OFF_LSE);
  const int lane = tid_ & 63, wave = tid_ >> 6;
  const int fr = lane & 31, fh = lane >> 5;
  const int nloc = nblk_ >> 3;
  if ((int)(bid_ >> 3) >= nloc) return;
  const int vw = ((bid_ & 7) * nloc + (bid_ >> 3)) * 8 + wave, NW = nloc * 64;
  const size_t GS = (size_t)TC * 64;
  const size_t BS = (size_t)SEQ * 64;

  {
    const float* lp = p.in[7] + layer * 128;
    float d01 = 0.f, d23 = 0.f;
    for (int i = 0; i < 32; ++i) { d01 += lp[i] * lp[32 + i]; d23 += lp[64 + i] * lp[96 + i]; }
    const float lambda_init = (layer == 0) ? 0.2f : 0.35550907f;
    const float lam = __expf(d01) - __expf(d23) + lambda_init;
    const float* subg = p.in[8] + layer * 64;
    const float sc = 0.17677669529663687f * LOG2E;
    float gqm = 0.f, gkm = 0.f;
    for (int i = 0; i < 32; ++i) { gqm = fmaxf(gqm, fabsf(p.in[6][layer * 64 + i])); gkm = fmaxf(gkm, fabsf(p.in[6][layer * 64 + 32 + i])); }
    const float cbound = 5.6568542f * gqm * gkm * 1.02f + 0.05f;
    for (int it = vw; it < BC * 4 * 128; it += NW) {
      const int bl = it >> 9, head = (it >> 7) & 3, qblk = it & 127;
      const u16* Q0 = QK + (22 + head) * GS + bl * BS; const u16* Q1 = Q0 + SEQ * 32;
      const u16* K0 = QK + (26 + head) * GS + bl * BS; const u16* K1 = K0 + SEQ * 32;
      const u16* V = VB + (8 + head) * GS + bl * BS;
      bf16x8 q0[2], q1[2];
      load_kf2(q0, Q0, qblk, lane); load_kf2(q1, Q1, qblk, lane);
      float l0 = 0.f, l1 = 0.f;
      f32x16 O00, O01, O10, O11; zero16(O00); zero16(O01); zero16(O10); zero16(O11);
      bf16x8 k0[2], k1[2], vf[2][2];
      load_kf2(k0, K0, 0, lane); load_kf2(k1, K1, 0, lane); load_vf(vf, V, 0, lane);
      {
        const float mb2 = fminf(cbound, 40.0f) * LOG2E;
        for (int kb = 0; kb < 128; ++kb) {
          bf16x8 nk0[2], nk1[2], nvf[2][2];
          const int kn = (kb + 1 < 128) ? kb + 1 : kb;
          load_kf2(nk0, K0, kn, lane); load_kf2(nk1, K1, kn, lane); load_vf(nvf, V, kn, lane);
          f32x16 S0, S1; zero16(S0); zero16(S1);
          S0 = MFMA32(k0[0], q0[0], S0); S0 = MFMA32(k0[1], q0[1], S0);
          S1 = MFMA32(k1[0], q1[0], S1); S1 = MFMA32(k1[1], q1[1], S1);
          attn_fixed_pv(S0, sc, mb2, l0, O00, O01, vf);
          attn_fixed_pv(S1, sc, mb2, l1, O10, O11, vf);
#pragma unroll
          for (int s = 0; s < 2; ++s) { k0[s] = nk0[s]; k1[s] = nk1[s]; vf[0][s] = nvf[0][s]; vf[1][s] = nvf[1][s]; }
        }
      }
      const float i0 = 1.0f / (l0 + __shfl_xor(l0, 32));
      const float i1 = lam / (l1 + __shfl_xor(l1, 32));
      float ss = 0.f;
#pragma unroll
      for (int i = 0; i < 16; ++i) {
        O00[i] = O00[i] * i0 - O10[i] * i1; O01[i] = O01[i] * i0 - O11[i] * i1;
        ss += O00[i] * O00[i] + O01[i] * O01[i];
      }
      ss += __shfl_xor(ss, 32);
      const float rn = rsqrtf(ss * (1.0f / 64.0f) + 1e-6f) * (1.0f - lambda_init);
#pragma unroll
      for (int g4 = 0; g4 < 4; ++g4) {
        const f32x4 ga = *(const f32x4*)(subg + 8 * g4 + 4 * fh);
        const f32x4 gb = *(const f32x4*)(subg + 32 + 8 * g4 + 4 * fh);
#pragma unroll
        for (int e = 0; e < 4; ++e) { O00[4 * g4 + e] *= ga[e]; O01[4 * g4 + e] *= gb[e]; }
      }
      const size_t tok = (size_t)bl * SEQ + qblk * 32 + fr;
      store_o(Y5 + (size_t)3 * TC * 256 + tok * 256 + head * 64, O00, O01, rn, fh);
    }
  }
  {
    const float sc = 0.125f * LOG2E;
    for (int it = vw; it < BC * 8 * 128; it += NW) {
      const int bl = it >> 10, hq = (it >> 7) & 7, qblk = it & 127;
      const int kvh = hq >> 2;
      const u16* Q = QK + (size_t)hq * GS + bl * BS;
      const u16* K = QK + (size_t)(8 + kvh) * GS + bl * BS;
      const u16* V = VB + (size_t)kvh * GS + bl * BS;
      bf16x8 qf[4]; load_kf4(qf, Q, qblk, lane);
      float m = p.in[4][layer * 8 + hq] * LOG2E, l = (fh == 0) ? 1.0f : 0.0f;
      f32x16 O0, O1; zero16(O0); zero16(O1);
      const int kb_lo = (qblk - 4 < 0) ? 0 : qblk - 4, kb_hi = (qblk + 4 > 127) ? 127 : qblk + 4;
      const int qpos = qblk * 32 + fr;
      for (int kb = kb_lo; kb <= kb_hi; ++kb) {
        bf16x8 kf[4], vf[2][2];
        load_kf4(kf, K, kb, lane); load_vf(vf, V, kb, lane);
        f32x16 S; zero16(S);
#pragma unroll
        for (int s = 0; s < 4; ++s) S = MFMA32(kf[s], qf[s], S);
#pragma unroll
        for (int i = 0; i < 16; ++i) {
          const int dlt = kb * 32 + crow(i, fh) - qpos;
          S[i] = (dlt <= 128 && dlt >= -128) ? S[i] * sc : -1e30f;
        }
        attn_softmax_pv(S, m, l, O0, O1, vf);
      }
      const float inv = 1.0f / (l + __shfl_xor(l, 32));
      const size_t tok = (size_t)bl * SEQ + qpos;
      store_o(Y5 + (size_t)(hq >> 2) * TC * 256 + tok * 256 + (hq & 3) * 64, O0, O1, inv, fh);
    }
  }
  {
    const float sc = 0.125f;
    for (int it = vw; it < BC * 4 * 128; it += NW) {
      const int bl = it >> 9, head = (it >> 7) & 3, qblk = it & 127;
      const u16* Q = QK + (size_t)(30 + head) * GS + bl * BS;
      const u16* K = QK + (size_t)(34 + head) * GS + bl * BS;
      const u16* V = VB + (size_t)(12 + head) * GS + bl * BS;
      const float* rpb = p.in[10] + (size_t)(layer * 4 + head) * 15 * 31;
      bf16x8 qf[4]; load_kf4(qf, Q, qblk, lane);
      float m = -1e30f, l = 0.f;
      f32x16 O0, O1; zero16(O0); zero16(O1);
      const int qrow = qblk >> 1, qc = (qblk & 1) * 32 + fr;
      int r0 = qrow - 4; r0 = r0 < 0 ? 0 : (r0 > 56 ? 56 : r0);
      int c0 = qc - 8; c0 = c0 < 0 ? 0 : (c0 > 48 ? 48 : c0);
      for (int kk = 0; kk < 16; ++kk) {
        const int krow_ = r0 + (kk >> 1), hb = kk & 1, kb = krow_ * 2 + hb;
        bf16x8 kf[4], vf[2][2];
        load_kf4(kf, K, kb, lane); load_vf(vf, V, kb, lane);
        f32x16 S; zero16(S);
#pragma unroll
        for (int s = 0; s < 4; ++s) S = MFMA32(kf[s], qf[s], S);
        const float* brow = rpb + (krow_ - qrow + 7) * 31;
#pragma unroll
        for (int i = 0; i < 16; ++i) {
          const int kc = hb * 32 + crow(i, fh);
          int dc = kc - qc; dc = dc < -15 ? -15 : (dc > 15 ? 15 : dc);
          const float bias = brow[dc + 15];
          S[i] = (kc >= c0 && kc < c0 + 16) ? (S[i] * sc + bias) * LOG2E : -1e30f;
        }
        attn_softmax_pv(S, m, l, O0, O1, vf);
      }
      const float inv = 1.0f / (l + __shfl_xor(l, 32));
      const size_t tok = (size_t)bl * SEQ + qblk * 32 + fr;
      store_o(Y5 + (size_t)4 * TC * 256 + tok * 256 + head * 64, O0, O1, inv, fh);
    }
  }
  {
    const float sc = 0.125f * LOG2E;
    for (int it = vw; it < BC * 6 * 128; it += NW) {
      const int bl = it / 768, rem = it % 768, head = rem >> 7, qblk = rem & 127;
      const int dil = dil_of(head >> 1), L = SEQ / dil, LB = L >> 5;
      const u16* Q = QK + (size_t)(10 + head) * GS + bl * BS;
      const u16* K = QK + (size_t)(16 + head) * GS + bl * BS;
      const u16* V = VB + (size_t)(2 + head) * GS + bl * BS;
      bf16x8 qf[4]; load_kf4(qf, Q, qblk, lane);
      float m = -1e30f, l = 0.f;
      f32x16 O0, O1; zero16(O0); zero16(O1);
      const int rsub = qblk / LB;
      const int lo = rsub * LB, hi = lo + LB - 1;
      const int kb_lo = (qblk - 2 < lo) ? lo : qblk - 2, kb_hi = (qblk + 2 > hi) ? hi : qblk + 2;
      const int qd = qblk * 32 + fr;
      for (int kb = kb_lo; kb <= kb_hi; ++kb) {
        bf16x8 kf[4], vf[2][2];
        load_kf4(kf, K, kb, lane); load_vf(vf, V, kb, lane);
        f32x16 S; zero16(S);
#pragma unroll
        for (int s = 0; s < 4; ++s) S = MFMA32(kf[s], qf[s], S);
#pragma unroll
        for (int i = 0; i < 16; ++i) {
          const int dlt = kb * 32 + crow(i, fh) - qd;
          S[i] = (dlt <= 64 && dlt >= -64) ? S[i] * sc : -1e30f;
        }
        attn_softmax_pv(S, m, l, O0, O1, vf);
      }
      const float lt = l + __shfl_xor(l, 32);
      const float inv = 1.0f / lt;
      const int msub = qd - rsub * L;
      const int pos = msub * dil + rsub;
      const size_t tok = (size_t)bl * SEQ + pos;
      store_o(BO + tok * 384 + head * 64, O0, O1, inv, fh);
      if (fh == 0) LSE[tok * 8 + head] = __log2f(lt) + m;
    }
  }
}


__device__ void phase_bcombine(const Params& p, int tid_, int bid_, int nblk_) {
  const u16* BO = (const u16*)(p.ws + OFF_BO);
  const float* LSE = (const float*)(p.ws + OFF_LSE);
  u16* YB = (u16*)(p.ws + OFF_Y5) + (size_t)2 * TC * 256;
  for (int e = bid_ * NTHR + tid_; e < TC * 16; e += nblk_ * NTHR) {
    const int tok = e >> 4, j = (e >> 3) & 1, c8 = (e & 7) * 8;
    const float a0 = LSE[(size_t)tok * 8 + j], a1 = LSE[(size_t)tok * 8 + 2 + j], a2 = LSE[(size_t)tok * 8 + 4 + j];
    const float mx = fmaxf(a0, fmaxf(a1, a2));
    float w0 = fexp2(a0 - mx), w1 = fexp2(a1 - mx), w2 = fexp2(a2 - mx);
    const float inv = 1.0f / (w0 + w1 + w2);
    w0 *= inv; w1 *= inv; w2 *= inv;
    const u32x4 x0 = *(const u32x4*)(BO + (size_t)tok * 384 + (0 + j) * 64 + c8);
    const u32x4 x1 = *(const u32x4*)(BO + (size_t)tok * 384 + (2 + j) * 64 + c8);
    const u32x4 x2 = *(const u32x4*)(BO + (size_t)tok * 384 + (4 + j) * 64 + c8);
    u32x4 o;
#pragma unroll
    for (int q = 0; q < 4; ++q) {
      const float lo = w0 * bf_lo(x0[q]) + w1 * bf_lo(x1[q]) + w2 * bf_lo(x2[q]);
      const float hi = w0 * bf_hi(x0[q]) + w1 * bf_hi(x1[q]) + w2 * bf_hi(x2[q]);
      o[q] = pk2(lo, hi);
    }
    *(u32x4*)(YB + (size_t)tok * 256 + j * 64 + c8) = o;
    const u32x4 z = {0u, 0u, 0u, 0u};
    *(u32x4*)(YB + (size_t)tok * 256 + 128 + (e & 15) * 8) = z;
  }
}

#define XB_TMO      128
#define XB_XCNT(j)  (256  + 64 * (j))
#define XB_XSUB(j)  (1280 + 64 * (j))
#define XB_XGEN(j)  (2304 + 64 * (j))
#define XB_TOP      3328
#define XB_TOPGEN   3392
#define XCD_BAR_WORDS 3456
#define XB_SPIN_CAP (1u << 22)
#define LAS __attribute__((address_space(3)))
DI unsigned xb_ld(unsigned* p)              { return __hip_atomic_load(p, __ATOMIC_RELAXED, __HIP_MEMORY_SCOPE_AGENT); }
DI unsigned xb_add(unsigned* p, unsigned v) { return __hip_atomic_fetch_add(p, v, __ATOMIC_RELAXED, __HIP_MEMORY_SCOPE_AGENT); }
DI unsigned xb_xcc_id() { return (unsigned)__builtin_amdgcn_s_getreg((3 << 11) | 20) & 0xFu; }
#define XB_SPIN(cond, bar) do { unsigned _sp = 0; while (cond) { __builtin_amdgcn_s_sleep(1); \
    if ((++_sp & 255u) == 0u) { if (xb_ld(&(bar)[XB_TMO])) break; if (_sp > XB_SPIN_CAP) { atomicAdd(&(bar)[XB_TMO], 1u); break; } } } } while (0)
struct XcdBarrier { unsigned* bar; unsigned x; volatile LAS unsigned* st; };
DI XcdBarrier xcd_barrier_post(unsigned* bar, volatile LAS unsigned* st) {
  XcdBarrier b; b.bar = bar; b.x = xb_xcc_id(); b.st = st;
  if (threadIdx.x == 0) (void)xb_add(&bar[XB_XCNT(b.x)], 1u);
  return b;
}
DI void xcd_barrier_complete(unsigned* bar, unsigned x, unsigned& nloc, unsigned& nx) {
  const unsigned G = gridDim.x * gridDim.y * gridDim.z;
  unsigned sum, cnt, mine, sp = 0u;
  for (;;) {
    sum = 0u; cnt = 0u; mine = 0u;
#pragma unroll
    for (unsigned j = 0; j < 16; ++j) { const unsigned c = xb_ld(&bar[XB_XCNT(j)]); sum += c; cnt += (c > 0u) ? 1u : 0u; mine = (j == x) ? c : mine; }
    if (sum == G) break;
    __builtin_amdgcn_s_sleep(1);
    if ((++sp & 255u) == 0u) { if (xb_ld(&bar[XB_TMO])) break; if (sp > XB_SPIN_CAP) { atomicAdd(&bar[XB_TMO], 1u); break; } }
  }
  nloc = mine > 0u ? mine : 1u; nx = cnt > 0u ? cnt : 1u;
}
DI void xcd_barrier(const XcdBarrier& b) {
  asm volatile("s_waitcnt vmcnt(0)" ::: "memory");
  __syncthreads();
  if (threadIdx.x == 0) {
    unsigned* bar = b.bar;
    __builtin_amdgcn_s_waitcnt(0);
    unsigned nloc = b.st[0], nx = b.st[1];
    if (nloc == 0u) { xcd_barrier_complete(bar, b.x, nloc, nx); b.st[0] = nloc; b.st[1] = nx; }
    const unsigned old = xb_add(&bar[XB_XSUB(b.x)], 1u);
    const unsigned gen = old / nloc;
    if (old + 1u == (gen + 1u) * nloc) {
      __builtin_amdgcn_fence(__ATOMIC_RELEASE, "agent");
      asm volatile("s_waitcnt vmcnt(0)" ::: "memory");
      const unsigned og = xb_add(&bar[XB_TOP], 1u);
      const unsigned tg = og / nx;
      if (og + 1u == (tg + 1u) * nx) xb_add(&bar[XB_TOPGEN], 1u);
      else XB_SPIN(xb_ld(&bar[XB_TOPGEN]) == tg, bar);
      __builtin_amdgcn_fence(__ATOMIC_ACQUIRE, "agent");
      xb_add(&bar[XB_XGEN(b.x)], 1u);
      asm volatile("s_waitcnt vmcnt(0)" ::: "memory");
    } else {
      XB_SPIN(xb_ld(&bar[XB_XGEN(b.x)]) == gen, bar);
      __builtin_amdgcn_fence(__ATOMIC_ACQUIRE, "agent");
      asm volatile("s_waitcnt vmcnt(0)" ::: "memory");
    }
  }
  __syncthreads();
}

__global__ void __launch_bounds__(NTHR, 2) mk_forward(Params p) {
  extern __shared__ __attribute__((aligned(16))) unsigned char smem[];
  cg::grid_group grid = cg::this_grid();
  volatile LAS unsigned* xbw = (volatile LAS unsigned*)(smem + LDS_STAGE);
  if (threadIdx.x < 4) xbw[threadIdx.x] = 0u;
  __syncthreads();
  XcdBarrier xb;
  if (FUSED) xb = xcd_barrier_post((unsigned*)(p.ws + OFF_BAR), xbw);
  PG8_LAS unsigned char* lds = (PG8_LAS unsigned char*)smem;
  for (int ph = p.ph_lo; ph < p.ph_hi; ++ph) {
#if DUPMASK
   for (int rep = 0; rep < ((ph > 0 && ((DUPMASK >> ((ph - 1) % 7)) & 1)) ? 2 : 1); ++rep)
#endif
   {
    int tid_ = threadIdx.x, bid_ = blockIdx.x, nblk_ = gridDim.x;
    asm volatile("" : "+v"(tid_));
    asm volatile("" : "+s"(bid_));
    asm volatile("" : "+s"(nblk_));
    Params pp = p;
    asm volatile("" : "+s"(pp.ws));
    asm volatile("" : "+s"(pp.out));
    unsigned char* ws = pp.ws;
    if (ph == 0) {
      if (PHMASK & 128) phase_prep(pp, tid_, bid_, nblk_, smem);
    } else {
      const int q = ph - 1, chunk = q / (2 * PPL), layer = (q % (2 * PPL)) / PPL, kk = q % PPL, k = (kk == 7) ? DUPK : kk;
      const u16* XBc = (const u16*)(ws + OFF_XB) + (size_t)chunk * TC * DM;
      float* SSQc = (float*)(ws + OFF_SSQ) + (size_t)chunk * TC * 16;
      float* xc = pp.out + (size_t)chunk * TC * DM;
      if ((k == 0 && (PHMASK & 1)) || (k == 5 && (PHMASK & 32))) {
        const bool up = (k == 5);
        if (!up) {
          EpiQKG e; e.ssq = SSQc; e.qk = (u16*)(ws + OFF_QK); e.rope = (const float*)(ws + OFF_ROPE);
          e.gA = pp.in[3] + layer * 128; e.gB = pp.in[5] + layer * 128; e.gC = pp.in[6] + layer * 64; e.gD = pp.in[9] + layer * 128;
          run_gemm(lds, XBc, (const u16*)(ws + OFF_WQKG) + (size_t)layer * NQKG * DM, TC, 2560, DM, e);
        }
        {
          EpiGateUp e; e.ssq = SSQc; e.o = (u16*)(ws + OFF_GATE); e.mode = up ? ((PROBE_NOEPI && kk == 7) ? 2 : 1) : 0;
          const u16* W = up ? (const u16*)(ws + OFF_WUP) + (size_t)layer * DMLP * DM : (const u16*)(ws + OFF_WQKG) + ((size_t)layer * NQKG + 2560) * DM;
          run_gemm(lds, XBc, W, TC, 4096, DM, e, (PROBE_NOEPI && kk == 7) ? 1 : 0);
        }
        if (!up) {
          EpiVT ev; ev.ssq = SSQc; ev.vbuf = (u16*)(ws + OFF_V);
          run_gemm(lds, (const u16*)(ws + OFF_WV) + (size_t)layer * DM * DM, XBc, DM, TC, DM, ev);
        }
      } else if (k == 1 && (PHMASK & 2)) {
        phase_attn(pp, tid_, bid_, nblk_, layer);
      } else if (k == 2 && (PHMASK & 4)) {
        phase_bcombine(pp, tid_, bid_, nblk_);
      } else if (k == 3 && (PHMASK & 8)) {
        EpiMerge e; e.gate = (const u16*)(ws + OFF_GATE); e.mrg = (u16*)(ws + OFF_MRG);
        run_merge(lds, (const u16*)(ws + OFF_Y5), (const u16*)(ws + OFF_WBR5) + (size_t)layer * 5 * DM * 256, e);
      } else if ((k == 4 && (PHMASK & 16)) || (k == 6 && (PHMASK & 64))) {
        const bool dn = (k == 6);
        EpiResid e; e.xold = (!dn && layer == 0) ? (pp.in[0] + (size_t)chunk * TC * DM) : xc; e.xout = xc; e.xb = (u16*)XBc; e.ssq = SSQc;
        const u16* A = dn ? (const u16*)(ws + OFF_GATE) : (const u16*)(ws + OFF_MRG);
        const u16* W = dn ? (const u16*)(ws + OFF_WDN) + (size_t)layer * DM * DMLP : (const u16*)(ws + OFF_WOUT) + (size_t)layer * DM * DM;
        run_gemm(lds, A, W, TC, DM, dn ? DMLP : DM, e);
      }
    }
   }
    if (ph + 1 < p.ph_hi) {
      if (ph == 0) grid.sync();
      else xcd_barrier(xb);
    }
  }
}

extern "C" void kernel_launch(void* const* d_in, const int* in_sizes, int n_in, void* d_out, int out_size, void* d_ws, size_t ws_size,
                              hipStream_t stream) {
  static int grid_blocks = 0;
  if (grid_blocks == 0) {
    if (n_in != 19 || out_size != T * DM || ws_size < WS_END) {
      fprintf(stderr, "kernel_launch: unexpected problem (n_in %d out %d ws %zu need %zu)\n", n_in, out_size, ws_size, (size_t)WS_END);
      grid_blocks = -1;
      return;
    }
    int dev = 0, cus = 0, per_cu = 0;
    (void)hipGetDevice(&dev);
    (void)hipDeviceGetAttribute(&cus, hipDeviceAttributeMultiprocessorCount, dev);
    if (hipFuncSetAttribute((const void*)mk_forward, hipFuncAttributeMaxDynamicSharedMemorySize, LDS_BYTES) != hipSuccess) {
      fprintf(stderr, "kernel_launch: hipFuncSetAttribute failed\n"); grid_blocks = -1; return;
    }
    (void)hipOccupancyMaxActiveBlocksPerMultiprocessor(&per_cu, mk_forward, NTHR, LDS_BYTES);
    if (per_cu < 1) fprintf(stderr, "kernel_launch: occupancy query says %d blocks per CU\n", per_cu);
    (void)hipGetLastError();
    grid_blocks = cus;
  }
  if (grid_blocks < 0) return;
  Params p{};
  for (int i = 0; i < 19; ++i) p.in[i] = (const float*)d_in[i];
  p.out = (float*)d_out;
  p.ws = (unsigned char*)d_ws;
#if FUSED
  (void)hipMemsetAsync((unsigned char*)d_ws + OFF_BAR, 0, XCD_BAR_WORDS * 4, stream);
  p.ph_lo = 0; p.ph_hi = NPHASE;
  void* args[] = {&p};
  hipError_t e = hipLaunchCooperativeKernel((const void*)mk_forward, dim3(grid_blocks), dim3(NTHR), args, LDS_BYTES, stream);
  if (e != hipSuccess) fprintf(stderr, "cooperative launch failed: %s (grid %d)\n", hipGetErrorString(e), grid_blocks);
#else
  for (int ph = 0; ph < NPHASE; ++ph) {
    p.ph_lo = ph; p.ph_hi = ph + 1;
    hipLaunchKernelGGL(mk_forward, dim3(grid_blocks), dim3(NTHR), LDS_BYTES, stream, p);
  }
#endif
}
```

```cpp
#include <hip/hip_runtime.h>
#include <hip/hip_cooperative_groups.h>
#include <cstdio>
namespace cg = cooperative_groups;

#ifndef PHMASK
#define PHMASK 255
#endif
#ifndef DUPMASK
#define DUPMASK 0
#endif
#ifndef DUPK
#define DUPK -1
#endif
#ifndef PROBE_NOEPI
#define PROBE_NOEPI 0
#endif
#ifndef FUSED
#define FUSED 1
#endif

namespace pg8 {
#define PG8_LAS __attribute__((address_space(3)))
typedef unsigned short bf16_t;
typedef short bf16x8 __attribute__((ext_vector_type(8)));
typedef float f32x4 __attribute__((ext_vector_type(4)));
typedef unsigned u32x4 __attribute__((ext_vector_type(4)));
constexpr int BM = 256, BK = 64, HALF = 128, HTB = HALF * BK * 2  , STAGE_BYTES = 8 * HTB, NXCD = 8, WGM = 8;

__host__ __device__ __forceinline__ int lds_byte(int r, int c) { const int st = (r >> 4) * 2 + (c >> 5), rr = r & 15, cc = c & 31, ob = rr * 64 + cc * 2; return st * 1024 + (ob ^ (((ob >> 9) & 1) << 5)); }
__host__ __device__ __forceinline__ void stage_rc(int b, int& R, int& C) { const int st = b / 1024, sb = b % 1024, swz = sb ^ (((sb >> 9) & 1) << 5); R = (st >> 1) * 16 + swz / 64; C = (st & 1) * 32 + (swz % 64) / 2; }
__host__ __device__ __forceinline__ int perm32(int rho) { const int n = rho >> 4, i = rho & 15; return 8 * (i >> 2) + 4 * n + (i & 3); }

struct Unit { int pm, pn, seg; };
struct Gemm { const bf16_t* A; const bf16_t* Bt; int M, N, K; };

struct StaticOrder {
    int nM, nN, nwg, G, c, probe = 0;
    __host__ __device__ void init(int M, int N, int G_, int c_) { nM = M / BM; nN = N / BM; nwg = nM * nN; G = G_; c = c_; }
    __host__ __device__ bool next(int i, Unit& u) const {
        const long L = (long)i * G + c; if (L >= nwg) return false;
        int wgid = (int)L; { const int q = nwg / NXCD, r = nwg % NXCD, xcd = wgid % NXCD, off = wgid / NXCD; wgid = (xcd < r ? xcd * (q + 1) : r * (q + 1) + (xcd - r) * q) + off; }
        const int nig = WGM * nN, gid = wgid / nig, fm = gid * WGM, gsz = (nM - fm) < WGM ? (nM - fm) : WGM;
        u.pm = fm + ((wgid % nig) % gsz); u.pn = (wgid % nig) / gsz; u.seg = 0; if (probe) { u.pm = 0; u.pn = 0; } return true;
    }
    __device__ __forceinline__ void a_ready(const Unit&) const {}
    __device__ __forceinline__ void done(const Unit&) const {}
    __device__ __forceinline__ const char* baseA(const Gemm& g, const Unit& u, size_t tstep) const { return (const char*)g.A + (size_t)u.pm * tstep; }
    __device__ __forceinline__ const char* baseB(const Gemm& g, const Unit& u, size_t tstep) const { return (const char*)g.Bt + (size_t)u.pn * tstep; }
    __device__ __forceinline__ bool zero_after(const Unit&) const { return true; }
};

template <class Epi, class Sched, bool STAMP = false>
__device__ __forceinline__ void gemm_phase(PG8_LAS unsigned char* lds, const Gemm g, const Sched& S, const Epi& E, unsigned long long* stamps) {
    int tid = threadIdx.x; asm volatile("" : "+v"(tid));
    const int wid = __builtin_amdgcn_readfirstlane(tid >> 6), lane = tid & 63, wr = wid >> 2, wc = wid & 3, fr = lane & 15, fq = lane >> 4;
    const int K = g.K, nt = K / BK;
    int ts_lo = 0, ts_hi = 0, nts = 0; const unsigned long long rt_entry = STAMP ? (unsigned long long)wall_clock64() : 0ull;
#define PG8_STAMP() do { if (STAMP && wid == 0 && nts < 64) { const unsigned long long _c = (unsigned long long)clock64(); \
        ts_lo = (lane == nts) ? (int)(unsigned)_c : ts_lo; ts_hi = (lane == nts) ? (int)(unsigned)(_c >> 32) : ts_hi; ++nts; } } while (0)
    PG8_STAMP();
    unsigned voffA[2], voffB[2];
#pragma unroll
    for (int i = 0; i < 2; ++i) { int R, C; stage_rc(tid * 16 + i * 8192, R, C); const int Rb = Epi::PERM ? ((R & ~31) + perm32(R & 31)) : R;
        voffA[i] = (unsigned)(R * K + C) * 2u; voffB[i] = (unsigned)(Rb * K + C) * 2u; }
    const size_t kstep = (size_t)(BK * 2);
    const size_t hstep = (size_t)HALF * K * 2;
    const size_t tstep = 2 * hstep;
    const unsigned ldsw = (unsigned)wid * 1024u;
    const int aoff = lds_byte(wr * 64 + fr, fq * 8), boff = lds_byte(wc * 32 + fr, fq * 8);
#define PG8_SA(b, h) (((b) * 2 + (h)) * HTB)
#define PG8_SB(b, h) ((4 + (b) * 2 + (h)) * HTB)
#define PG8_STAGE(bufoff, gbase, voff) do { _Pragma("unroll") for (int _i = 0; _i < 2; ++_i) \
        __builtin_amdgcn_global_load_lds((const unsigned*)((const char*)(gbase) + (voff)[_i]), (PG8_LAS unsigned*)(lds + (bufoff) + ldsw + _i * 8192), 16, 0, 0); } while (0)
#define PG8_LDA(dst, b, h) do { _Pragma("unroll") for (int m = 0; m < 4; ++m) _Pragma("unroll") for (int k = 0; k < 2; ++k) dst[m][k] = *(const PG8_LAS bf16x8*)(lds + PG8_SA(b, h) + aoff + m * 2048 + k * 1024); } while (0)
#define PG8_LDB(dst, b, h) do { _Pragma("unroll") for (int n = 0; n < 2; ++n) _Pragma("unroll") for (int k = 0; k < 2; ++k) dst[n][k] = *(const PG8_LAS bf16x8*)(lds + PG8_SB(b, h) + boff + n * 2048 + k * 1024); } while (0)
#define PG8_MMA(ai, bj, At, Bt) do { __builtin_amdgcn_s_setprio(1); _Pragma("unroll") for (int m = 0; m < 4; ++m) _Pragma("unroll") for (int n = 0; n < 2; ++n) _Pragma("unroll") for (int k = 0; k < 2; ++k) \
        acc[ai][bj][m][n] = __builtin_amdgcn_mfma_f32_16x16x32_bf16(Bt[n][k], At[m][k], acc[ai][bj][m][n], 0, 0, 0); __builtin_amdgcn_s_setprio(0); } while (0)
#define PG8_WAIT_V(n) asm volatile("s_waitcnt vmcnt(" #n ")" ::: "memory")
#define PG8_WAIT_L(n) asm volatile("s_waitcnt lgkmcnt(" #n ")" ::: "memory")
#define PG8_BAR __builtin_amdgcn_s_barrier()
#define PG8_SCHED __builtin_amdgcn_sched_barrier(0)
    Unit cur, nxt; int ui = 0;
    if (!S.next(0, cur)) return;
    f32x4 acc[2][2][4][2];
#pragma unroll
    for (int a = 0; a < 2; ++a)
#pragma unroll
        for (int b = 0; b < 2; ++b)
#pragma unroll
            for (int m = 0; m < 4; ++m)
#pragma unroll
                for (int n = 0; n < 2; ++n) acc[a][b][m][n] = (f32x4){0.f, 0.f, 0.f, 0.f};
    bf16x8 At[4][2], B0[2][2], B1[2][2];
    const char* cA = S.baseA(g, cur, tstep); const char* cB = S.baseB(g, cur, tstep);
    S.a_ready(cur);
    PG8_STAGE(PG8_SB(0, 0), cB, voffB); PG8_STAGE(PG8_SA(0, 0), cA, voffA); PG8_STAGE(PG8_SB(0, 1), cB + hstep, voffB); PG8_STAGE(PG8_SA(0, 1), cA + hstep, voffA);
    if (wr == 1) PG8_BAR;
    PG8_WAIT_V(4); PG8_BAR;
    PG8_STAGE(PG8_SB(1, 0), cB + kstep, voffB); PG8_STAGE(PG8_SA(1, 0), cA + kstep, voffA); PG8_STAGE(PG8_SB(1, 1), cB + hstep + kstep, voffB);
    PG8_WAIT_V(6); PG8_BAR;
    PG8_STAMP();
    for (;;) {
        const bool has_next = S.next(ui + 1, nxt);
        const char* nA = has_next ? S.baseA(g, nxt, tstep) : cA; const char* nB = has_next ? S.baseB(g, nxt, tstep) : cB;
        for (int t = 0; t < nt; t += 2) {
            const bool last = (t == nt - 2);
            const char* a1 = cA + (size_t)(t + 1) * kstep;
            const char* a2 = last ? nA : cA + (size_t)(t + 2) * kstep; const char* b2 = last ? nB : cB + (size_t)(t + 2) * kstep;
            const char* a3 = a2 + kstep; const char* b3 = b2 + kstep;
            if (last && has_next) S.a_ready(nxt);
            PG8_LDB(B0, 0, 0); PG8_SCHED; PG8_LDA(At, 0, 0); PG8_STAGE(PG8_SA(1, 1), a1 + hstep, voffA);
            PG8_WAIT_L(8); PG8_BAR; PG8_WAIT_L(0); PG8_MMA(0, 0, At, B0); PG8_BAR; PG8_SCHED;
            PG8_LDB(B1, 0, 1); PG8_STAGE(PG8_SB(0, 0), b2, voffB);
            PG8_BAR; PG8_WAIT_L(0); PG8_MMA(0, 1, At, B1); PG8_BAR;
            PG8_LDA(At, 0, 1); PG8_STAGE(PG8_SA(0, 0), a2, voffA);
            PG8_BAR; PG8_WAIT_L(0); PG8_MMA(1, 0, At, B0); PG8_BAR; PG8_SCHED;
            PG8_STAGE(PG8_SB(0, 1), b2 + hstep, voffB);
            PG8_WAIT_V(6); PG8_BAR; PG8_MMA(1, 1, At, B1); PG8_BAR;
            PG8_LDB(B0, 1, 0); PG8_SCHED; PG8_LDA(At, 1, 0); PG8_STAGE(PG8_SA(0, 1), a2 + hstep, voffA);
            PG8_WAIT_L(8); PG8_BAR; PG8_WAIT_L(0); PG8_MMA(0, 0, At, B0); PG8_BAR; PG8_SCHED;
            PG8_LDB(B1, 1, 1); PG8_STAGE(PG8_SB(1, 0), b3, voffB);
            PG8_BAR; PG8_WAIT_L(0); PG8_MMA(0, 1, At, B1); PG8_BAR;
            PG8_LDA(At, 1, 1); PG8_STAGE(PG8_SA(1, 0), a3, voffA);
            PG8_BAR; PG8_WAIT_L(0); PG8_MMA(1, 0, At, B0); PG8_BAR; PG8_SCHED;
            PG8_STAGE(PG8_SB(1, 1), b3 + hstep, voffB);
            PG8_WAIT_V(6); PG8_BAR; PG8_MMA(1, 1, At, B1); PG8_BAR;
        }
        PG8_STAMP();
        if constexpr (!Epi::AFTER_DRAIN) { E(acc, cur, wr, wc, fr, fq); S.done(cur); }
        PG8_STAMP();
        if (!has_next) break;
        if (S.zero_after(cur))
#pragma unroll
        for (int a = 0; a < 2; ++a)
#pragma unroll
            for (int b = 0; b < 2; ++b)
#pragma unroll
                for (int m = 0; m < 4; ++m)
#pragma unroll
                    for (int n = 0; n < 2; ++n) acc[a][b][m][n] = (f32x4){0.f, 0.f, 0.f, 0.f};
        cur = nxt; cA = nA; cB = nB; ++ui;
    }
    PG8_WAIT_V(0);
    if (wr == 0) PG8_BAR;
    PG8_BAR;
    if constexpr (Epi::AFTER_DRAIN) { E.fused(acc, cur, wr, wc, fr, fq, lds, wid, lane); S.done(cur); }
    PG8_STAMP();
    if (STAMP && wid == 0) { stamps[lane] = lane < nts ? (((unsigned long long)(unsigned)ts_hi << 32) | (unsigned)ts_lo) : 0ull;
        if (lane == 62) stamps[62] = rt_entry; if (lane == 63) stamps[63] = (unsigned long long)wall_clock64(); }
#undef PG8_STAMP
#undef PG8_SA
#undef PG8_SB
#undef PG8_STAGE
#undef PG8_LDA
#undef PG8_LDB
#undef PG8_MMA
#undef PG8_WAIT_V
#undef PG8_WAIT_L
#undef PG8_BAR
#undef PG8_SCHED
}
}

typedef unsigned short u16;
typedef short bf16x8 __attribute__((ext_vector_type(8)));
typedef float f32x16 __attribute__((ext_vector_type(16)));
typedef float f32x4 __attribute__((ext_vector_type(4)));
typedef __bf16 bf2_t __attribute__((ext_vector_type(2)));
typedef float f2_t __attribute__((ext_vector_type(2)));
typedef unsigned u32x4 __attribute__((ext_vector_type(4)));
typedef unsigned u32x2 __attribute__((ext_vector_type(2)));
using pg8::Unit;

#define DI __device__ __forceinline__
#define MFMA32(a, b, c) __builtin_amdgcn_mfma_f32_32x32x16_bf16((a), (b), (c), 0, 0, 0)

constexpr int DM = 1024, SEQ = 4096, NBATCH = 8, T = NBATCH * SEQ;
constexpr int NCH = 2, BC = NBATCH / NCH, TC = BC * SEQ;
constexpr int INC = 7552, DMLP = 4096;
constexpr int NQKG = 6656;
constexpr int NQKH = 38, NVH = 16;
constexpr float LOG2E = 1.4426950408889634f;
constexpr int NTHR = 512;

constexpr size_t al256(size_t x) { return (x + 255) & ~(size_t)255; }
constexpr size_t OFF_WQKG = 0;
constexpr size_t OFF_WV   = OFF_WQKG + al256((size_t)2 * NQKG * DM * 2);
constexpr size_t OFF_WBR5 = OFF_WV   + al256((size_t)2 * DM * DM * 2);
constexpr size_t OFF_WOUT = OFF_WBR5 + al256((size_t)2 * 5 * DM * 256 * 2);
constexpr size_t OFF_WUP  = OFF_WOUT + al256((size_t)2 * DM * DM * 2);
constexpr size_t OFF_WDN  = OFF_WUP  + al256((size_t)2 * DMLP * DM * 2);
constexpr size_t OFF_ROPE = OFF_WDN  + al256((size_t)2 * DM * DMLP * 2);
constexpr size_t OFF_XB   = OFF_ROPE + al256((size_t)SEQ * 96 * 4);
constexpr size_t OFF_SSQ  = OFF_XB   + al256((size_t)T * DM * 2);
constexpr size_t OFF_QK   = OFF_SSQ  + al256((size_t)T * 16 * 4);
constexpr size_t OFF_V    = OFF_QK   + al256((size_t)NQKH * TC * 64 * 2);
constexpr size_t OFF_GATE = OFF_V    + al256((size_t)NVH * TC * 64 * 2);
constexpr size_t OFF_Y5   = OFF_GATE + al256((size_t)TC * 4096 * 2);
constexpr size_t OFF_BO   = OFF_Y5   + al256((size_t)5 * TC * 256 * 2);
constexpr size_t OFF_LSE  = OFF_BO   + al256((size_t)TC * 384 * 2);
constexpr size_t OFF_MRG  = OFF_LSE  + al256((size_t)TC * 8 * 4);
constexpr size_t OFF_BAR  = OFF_MRG  + al256((size_t)TC * DM * 2);
constexpr size_t WS_END   = OFF_BAR  + 16384;
static_assert(WS_END <= (size_t)512 * 1024 * 1024, "workspace too large");

constexpr int LDS_STAGE = 131072;
constexpr int LDS_BYTES = LDS_STAGE + 64;
constexpr int PPL = (DUPK >= 0) ? 8 : 7;
constexpr int NPHASE = 1 + NCH * 2 * PPL;

struct Params {
  const float* in[19];
  float* out;
  unsigned char* ws;
  int ph_lo, ph_hi;
};

DI unsigned pk2(float a, float b) { f2_t v = {a, b}; bf2_t r = __builtin_convertvector(v, bf2_t); return __builtin_bit_cast(unsigned, r); }
DI float bf_lo(unsigned u) { return __uint_as_float(u << 16); }
DI float bf_hi(unsigned u) { return __uint_as_float(u & 0xffff0000u); }
DI float fexp2(float x) { return __builtin_amdgcn_exp2f(x); }
DI int crow(int i, int h) { return (i & 3) + 8 * (i >> 2) + 4 * h; }
DI bf16x8 as_bf8(u32x4 v) { return __builtin_bit_cast(bf16x8, v); }
DI int dil_of(int gi) { return gi == 0 ? 1 : (gi == 1 ? 4 : 16); }
DI int dlg_of(int gi) { return gi * 2; }
DI float row_rscale(const float* ssq, size_t tok) {
  const f32x4 a = *(const f32x4*)(ssq + tok * 16), b = *(const f32x4*)(ssq + tok * 16 + 4);
  const f32x4 c = *(const f32x4*)(ssq + tok * 16 + 8), d = *(const f32x4*)(ssq + tok * 16 + 12);
  const float s = ((a[0] + a[1]) + (a[2] + a[3])) + ((b[0] + b[1]) + (b[2] + b[3])) + ((c[0] + c[1]) + (c[2] + c[3])) + ((d[0] + d[1]) + (d[2] + d[3]));
  return rsqrtf(s * (1.0f / 1024.0f) + 1e-6f);
}
DI int qk_head_col(int h) {
  if (h < 8) return 64 * h;
  if (h < 10) return 512 + 64 * (h - 8);
  if (h < 16) return 768 + 64 * (h - 10);
  if (h < 22) return 1152 + 64 * (h - 16);
  if (h < 26) return 1920 + 64 * (h - 22);
  if (h < 30) return 2176 + 64 * (h - 26);
  if (h < 34) return 2688 + 64 * (h - 30);
  return 2944 + 64 * (h - 34);
}
DI int v_head_col(int vh) {
  if (vh < 2) return 640 + 64 * vh;
  if (vh < 8) return 1536 + 64 * (vh - 2);
  if (vh < 12) return 2432 + 64 * (vh - 8);
  return 3200 + 64 * (vh - 12);
}

struct EpiQKG {
  static constexpr bool PERM = false, AFTER_DRAIN = false;
  const float* ssq; u16* qk; const float* rope; const float* gA; const float* gB; const float* gC; const float* gD;
  DI void operator()(const f32x4 (&acc)[2][2][4][2], const Unit& u, int wr, int wc, int fr, int fq) const {
    const int hidx = u.pn * 4 + wc;
    if (hidx >= NQKH) return;
    int kind, dlg = 0; const float* gain;
    if (hidx < 8) { kind = 0; gain = gA; }
    else if (hidx < 10) { kind = 0; gain = gA + 64; }
    else if (hidx < 16) { kind = 0; gain = gB; dlg = dlg_of((hidx - 10) >> 1); }
    else if (hidx < 22) { kind = 0; gain = gB + 64; dlg = dlg_of((hidx - 16) >> 1); }
    else if (hidx < 26) { kind = 2; gain = gC; }
    else if (hidx < 30) { kind = 2; gain = gC + 32; }
    else if (hidx < 34) { kind = 1; gain = gD; }
    else { kind = 1; gain = gD + 64; }
    u16* gbase = qk + (size_t)hidx * TC * 64;
    const float* gainl = gain + 4 * fq;
    const float qpre = (hidx >= 22 && hidx < 26) ? (0.17677669529663687f * LOG2E) : 1.0f;
#pragma unroll
    for (int ai = 0; ai < 2; ++ai)
#pragma unroll
      for (int m = 0; m < 4; ++m) {
        const int tok = u.pm * 256 + 128 * ai + 64 * wr + 16 * m + fr;
        const int bl = tok >> 12, pos = tok & 4095;
        const float rs = row_rscale(ssq, tok);
        const int pdom = ((pos & ((1 << dlg) - 1)) << (12 - dlg)) + (pos >> dlg);
        const int blk = pdom >> 5, rr = pdom & 31;
        u16* base = gbase + (size_t)bl * SEQ * 64;
        if (kind != 2) {
          float ss = 0.f;
#pragma unroll
          for (int bj = 0; bj < 2; ++bj)
#pragma unroll
            for (int n = 0; n < 2; ++n)
#pragma unroll
              for (int e = 0; e < 4; ++e) ss += acc[ai][bj][m][n][e] * acc[ai][bj][m][n][e];
          ss += __shfl_xor(ss, 16); ss += __shfl_xor(ss, 32);
          const float sc = rs * rsqrtf(ss * rs * rs * (1.0f / 64.0f) + 1e-6f);
#pragma unroll
          for (int n = 0; n < 2; ++n) {
            f32x4 xa = acc[ai][0][m][n] * sc * *(const f32x4*)(gainl + 16 * n);
            f32x4 xb2 = acc[ai][1][m][n] * sc * *(const f32x4*)(gainl + 32 + 16 * n);
            if (kind == 0) {
              const f32x4 c4 = *(const f32x4*)(rope + pos * 96 + 16 * n + 4 * fq);
              const f32x4 s4 = *(const f32x4*)(rope + pos * 96 + 32 + 16 * n + 4 * fq);
              const f32x4 ta = xa * c4 - xb2 * s4, tb = xb2 * c4 + xa * s4;
              xa = ta; xb2 = tb;
            }
            u32x2 w0 = {pk2(xa[0], xa[1]), pk2(xa[2], xa[3])};
            *(u32x2*)(base + ((size_t)(blk * 4 + n) * 64 + (fq >> 1) * 32 + rr) * 8 + 4 * (fq & 1)) = w0;
            u32x2 w1 = {pk2(xb2[0], xb2[1]), pk2(xb2[2], xb2[3])};
            *(u32x2*)(base + ((size_t)(blk * 4 + 2 + n) * 64 + (fq >> 1) * 32 + rr) * 8 + 4 * (fq & 1)) = w1;
          }
        } else {
          const f32x4 c4 = *(const f32x4*)(rope + pos * 96 + 64 + 4 * fq);
          const f32x4 s4 = *(const f32x4*)(rope + pos * 96 + 80 + 4 * fq);
#pragma unroll
          for (int bj = 0; bj < 2; ++bj) {
            float ss = 0.f;
#pragma unroll
            for (int n = 0; n < 2; ++n)
#pragma unroll
              for (int e = 0; e < 4; ++e) ss += acc[ai][bj][m][n][e] * acc[ai][bj][m][n][e];
            ss += __shfl_xor(ss, 16); ss += __shfl_xor(ss, 32);
            const float sc = rs * rsqrtf(ss * rs * rs * (1.0f / 32.0f) + 1e-6f) * qpre;
            const f32x4 xa = acc[ai][bj][m][0] * sc * *(const f32x4*)(gainl);
            const f32x4 xb2 = acc[ai][bj][m][1] * sc * *(const f32x4*)(gainl + 16);
            const f32x4 ta = xa * c4 - xb2 * s4, tb = xb2 * c4 + xa * s4;
            u16* sb = base + (size_t)bj * SEQ * 32;
            u32x2 w0 = {pk2(ta[0], ta[1]), pk2(ta[2], ta[3])};
            *(u32x2*)(sb + ((size_t)(blk * 2 + 0) * 64 + (fq >> 1) * 32 + rr) * 8 + 4 * (fq & 1)) = w0;
            u32x2 w1 = {pk2(tb[0], tb[1]), pk2(tb[2], tb[3])};
            *(u32x2*)(sb + ((size_t)(blk * 2 + 1) * 64 + (fq >> 1) * 32 + rr) * 8 + 4 * (fq & 1)) = w1;
          }
        }
        asm volatile("" ::: "memory");
      }
  }
};

struct EpiGateUp {
  static constexpr bool PERM = true, AFTER_DRAIN = false;
  const float* ssq; u16* o; int mode;
  DI void operator()(const f32x4 (&acc)[2][2][4][2], const Unit& u, int wr, int wc, int fr, int fq) const {
    if (mode == 2) return;
    const int c0 = u.pn * 256 + 32 * wc + 8 * fq;
    const bool up = mode != 0;
#pragma unroll
    for (int ai = 0; ai < 2; ++ai)
#pragma unroll
      for (int m = 0; m < 4; ++m) {
        const size_t tok = (size_t)u.pm * 256 + 128 * ai + 64 * wr + 16 * m + fr;
        const float rs = row_rscale(ssq, tok);
#pragma unroll
        for (int bj = 0; bj < 2; ++bj) {
          float r[8];
#pragma unroll
          for (int n = 0; n < 2; ++n) {
            const f32x4 v = acc[ai][bj][m][n] * rs;
#pragma unroll
            for (int e = 0; e < 4; ++e) {
              const float z = fmaxf(v[e], 0.f);
              const float sg = __builtin_amdgcn_rcpf(1.0f + __expf(-v[e]));
              r[4 * n + e] = up ? z * z : sg;
            }
          }
          u32x4 w = {pk2(r[0], r[1]), pk2(r[2], r[3]), pk2(r[4], r[5]), pk2(r[6], r[7])};
          *(u32x4*)(o + tok * 4096 + c0 + 128 * bj) = w;
        }
        asm volatile("" ::: "memory");
      }
  }
};

struct EpiVT {
  static constexpr bool PERM = false, AFTER_DRAIN = false;
  const float* ssq; u16* vbuf;
  DI void operator()(const f32x4 (&acc)[2][2][4][2], const Unit& u, int wr, int wc, int fr, int fq) const {
    f32x4 rs4[2][2];
#pragma unroll
    for (int bj = 0; bj < 2; ++bj)
#pragma unroll
      for (int n = 0; n < 2; ++n) {
        const size_t t0 = (size_t)u.pn * 256 + 128 * bj + 32 * wc + 16 * n + 4 * fq;
#pragma unroll
        for (int e = 0; e < 4; ++e) { rs4[bj][n][e] = row_rscale(ssq, t0 + e); asm volatile("" ::: "memory"); }
      }
#pragma unroll
    for (int ai = 0; ai < 2; ++ai) {
      const int vgrp = u.pm * 4 + 2 * ai + wr;
      const int dlg = (vgrp >= 2 && vgrp < 8) ? dlg_of((vgrp - 2) >> 1) : 0;
      u16* gbase = vbuf + (size_t)vgrp * TC * 64;
      const int bl = (u.pn * 256) >> 12;
      u16* base = gbase + (size_t)bl * SEQ * 64;
      const unsigned es = (dlg == 0) ? 1u : (unsigned)(128 >> dlg) * 2048u;
#pragma unroll
      for (int m = 0; m < 4; ++m) {
        const int dv = 16 * m + fr;
        const unsigned dvo = (unsigned)((dv >> 5) * 1024 + (dv & 31) * 8);
#pragma unroll
        for (int bj = 0; bj < 2; ++bj)
#pragma unroll
          for (int n = 0; n < 2; ++n) {
            const int pos0 = (u.pn * 256 + 128 * bj + 32 * wc + 16 * n + 4 * fq) & 4095;
            const f32x4 v = acc[ai][bj][m][n] * rs4[bj][n];
            const int pd0 = ((pos0 & ((1 << dlg) - 1)) << (12 - dlg)) + (pos0 >> dlg);
            const int blk = pd0 >> 5, key = pd0 & 31;
            const unsigned off = (unsigned)blk * 2048u + (unsigned)(key >> 4) * 512u + (unsigned)((key >> 2) & 1) * 256u + dvo + 4u * ((key >> 3) & 1);
            const unsigned w0 = pk2(v[0], v[1]), w1 = pk2(v[2], v[3]);
            const unsigned o2 = off + (key & 3);
            base[o2] = (u16)(w0 & 0xffffu); base[o2 + es] = (u16)(w0 >> 16); base[o2 + 2 * es] = (u16)(w1 & 0xffffu); base[o2 + 3 * es] = (u16)(w1 >> 16);
            asm volatile("" ::: "memory");
          }
      }
    }
  }
};

struct MergeOrder : pg8::StaticOrder {
  const u16* ybase; const u16* wbase;
  DI bool next(int i, Unit& u) const { if (i >= 5) return false; if (!pg8::StaticOrder::next(0, u)) return false; u.seg = i; return true; }
  DI const char* baseA(const pg8::Gemm&, const Unit& u, size_t tstep) const { return (const char*)(ybase + (size_t)u.seg * TC * 256) + (size_t)u.pm * tstep; }
  DI const char* baseB(const pg8::Gemm&, const Unit& u, size_t tstep) const { return (const char*)(wbase + (size_t)u.seg * DM * 256) + (size_t)u.pn * tstep; }
  DI bool zero_after(const Unit& u) const { return u.seg == 4; }
};
struct EpiMerge {
  static constexpr bool PERM = true, AFTER_DRAIN = false;
  const u16* gate; u16* mrg;
  DI void operator()(f32x4 (&acc)[2][2][4][2], const Unit& u, int wr, int wc, int fr, int fq) const {
    const int seg = u.seg;
    if (seg == 0) return;
    const bool last = (seg == 4);
    const int gnum = last ? 3 : seg - 1, gden = last ? 3 : seg;
#pragma unroll
    for (int ai = 0; ai < 2; ++ai)
#pragma unroll
      for (int m = 0; m < 4; ++m) {
        const size_t tok = (size_t)u.pm * 256 + 128 * ai + 64 * wr + 16 * m + fr;
#pragma unroll
        for (int bj = 0; bj < 2; ++bj) {
          const int c = u.pn * 256 + 128 * bj + 32 * wc + 8 * fq;
          const u32x4 gn = *(const u32x4*)(gate + tok * 4096 + gnum * 1024 + c);
          const u32x4 gd = *(const u32x4*)(gate + tok * 4096 + gden * 1024 + c);
#pragma unroll
          for (int n = 0; n < 2; ++n) {
            f32x4 f;
            f[0] = bf_lo(gn[2 * n]); f[1] = bf_hi(gn[2 * n]); f[2] = bf_lo(gn[2 * n + 1]); f[3] = bf_hi(gn[2 * n + 1]);
            if (!last) {
              f[0] *= __builtin_amdgcn_rcpf(bf_lo(gd[2 * n])); f[1] *= __builtin_amdgcn_rcpf(bf_hi(gd[2 * n]));
              f[2] *= __builtin_amdgcn_rcpf(bf_lo(gd[2 * n + 1])); f[3] *= __builtin_amdgcn_rcpf(bf_hi(gd[2 * n + 1]));
            }
            acc[ai][bj][m][n] *= f;
          }
          if (last) {
            const f32x4 v0 = acc[ai][bj][m][0], v1 = acc[ai][bj][m][1];
            u32x4 w = {pk2(v0[0], v0[1]), pk2(v0[2], v0[3]), pk2(v1[0], v1[1]), pk2(v1[2], v1[3])};
            *(u32x4*)(mrg + tok * DM + c) = w;
          }
        }
        asm volatile("" ::: "memory");
      }
  }
};

struct EpiResid {
  static constexpr bool PERM = true, AFTER_DRAIN = false;
  const float* xold; float* xout; u16* xb; float* ssq;
  DI void operator()(const f32x4 (&acc)[2][2][4][2], const Unit& u, int wr, int wc, int fr, int fq) const {
#pragma unroll
    for (int ai = 0; ai < 2; ++ai)
#pragma unroll
      for (int m = 0; m < 4; ++m) {
        const size_t tok = (size_t)u.pm * 256 + 128 * ai + 64 * wr + 16 * m + fr;
        float ss = 0.f;
#pragma unroll
        for (int bj = 0; bj < 2; ++bj) {
          const size_t o = tok * DM + u.pn * 256 + 128 * bj + 32 * wc + 8 * fq;
          const f32x4 v0 = *(const f32x4*)(xold + o) + acc[ai][bj][m][0];
          const f32x4 v1 = *(const f32x4*)(xold + o + 4) + acc[ai][bj][m][1];
          *(f32x4*)(xout + o) = v0;
          *(f32x4*)(xout + o + 4) = v1;
          u32x4 w = {pk2(v0[0], v0[1]), pk2(v0[2], v0[3]), pk2(v1[0], v1[1]), pk2(v1[2], v1[3])};
          *(u32x4*)(xb + o) = w;
          ss += ((v0[0] * v0[0] + v0[1] * v0[1]) + (v0[2] * v0[2] + v0[3] * v0[3])) + ((v1[0] * v1[0] + v1[1] * v1[1]) + (v1[2] * v1[2] + v1[3] * v1[3]));
        }
        ss += __shfl_xor(ss, 16); ss += __shfl_xor(ss, 32);
        if (fq == 0) ssq[tok * 16 + u.pn * 4 + wc] = ss;
        asm volatile("" ::: "memory");
      }
  }
};

template <class Epi>
DI void run_merge(PG8_LAS unsigned char* lds, const u16* ybase, const u16* wbase, const Epi& E) {
  int K = 256; asm volatile("" : "+s"(K));
  pg8::Gemm g; g.A = ybase; g.Bt = wbase; g.M = TC; g.N = DM; g.K = K;
  MergeOrder S; S.init(TC, DM, (int)gridDim.x, (int)blockIdx.x); S.ybase = ybase; S.wbase = wbase;
  pg8::gemm_phase<Epi, MergeOrder, false>(lds, g, S, E, nullptr);
}
template <class Epi>
DI void run_gemm(PG8_LAS unsigned char* lds, const u16* A, const u16* Bt, int M, int N, int K, const Epi& E, int probe = 0) {
  asm volatile("" : "+s"(K));
  pg8::Gemm g; g.A = A; g.Bt = Bt; g.M = M; g.N = N; g.K = K;
  pg8::StaticOrder S; S.init(M, N, (int)gridDim.x, (int)blockIdx.x); S.probe = probe;
  pg8::gemm_phase<Epi, pg8::StaticOrder, false>(lds, g, S, E, nullptr);
}

DI void cvt_load(const float* __restrict__ src, int N, int k0, int n0, const float* __restrict__ g, float* t, int ht) {
  const int c4 = (ht & 15) * 4;
#pragma unroll
  for (int i = 0; i < 4; ++i) {
    const int kk = (ht >> 4) + 16 * i;
    f32x4 v = *(const f32x4*)(src + (size_t)(k0 + kk) * N + n0 + c4);
    const float sc = g ? g[k0 + kk] : 1.0f;
    t[kk * 65 + c4 + 0] = v[0] * sc; t[kk * 65 + c4 + 1] = v[1] * sc; t[kk * 65 + c4 + 2] = v[2] * sc; t[kk * 65 + c4 + 3] = v[3] * sc;
  }
}
DI void cvt_store(u16* __restrict__ dst, int ldk, int kdst, int d0, int d1, const float* t, int ht) {
  const int kc = (ht & 7) * 8, nn = ht >> 3;
#pragma unroll
  for (int i = 0; i < 2; ++i) {
    const int tn = nn + 32 * i, row = (i == 0) ? d0 + nn : d1 + nn;
    u32x4 w;
    w[0] = pk2(t[(kc + 0) * 65 + tn], t[(kc + 1) * 65 + tn]);
    w[1] = pk2(t[(kc + 2) * 65 + tn], t[(kc + 3) * 65 + tn]);
    w[2] = pk2(t[(kc + 4) * 65 + tn], t[(kc + 5) * 65 + tn]);
    w[3] = pk2(t[(kc + 6) * 65 + tn], t[(kc + 7) * 65 + tn]);
    *(u32x4*)(dst + (size_t)row * ldk + kdst + kc) = w;
  }
}
struct CvtJob { const float* src; int N, k0, n0; const float* g; u16* dst; int ldk, d0, d1, kd; };
DI CvtJob cvt_job(const Params& p, int l, int ti) {
  CvtJob j; j.g = nullptr; j.kd = -1;
  const float* attn_g = p.in[1] + l * DM;
  if (ti < 608) { const int h = ti >> 4, kt = ti & 15; j.src = p.in[2] + (size_t)l * DM * INC; j.N = INC; j.k0 = kt * 64; j.n0 = qk_head_col(h); j.g = attn_g;
    j.dst = (u16*)(p.ws + OFF_WQKG) + (size_t)l * NQKG * DM; j.ldk = DM; j.d0 = (h >> 2) * 256 + (h & 3) * 32; j.d1 = j.d0 + 128; return j; }
  ti -= 608;
  if (ti < 1024) { const int c = ti >> 4, kt = ti & 15; j.src = p.in[2] + (size_t)l * DM * INC; j.N = INC; j.k0 = kt * 64; j.n0 = 3456 + 64 * c; j.g = attn_g;
    j.dst = (u16*)(p.ws + OFF_WQKG) + (size_t)l * NQKG * DM; j.ldk = DM; j.d0 = 2560 + 64 * c; j.d1 = j.d0 + 32; return j; }
  ti -= 1024;
  if (ti < 256) { const int vh = ti >> 4, kt = ti & 15; j.src = p.in[2] + (size_t)l * DM * INC; j.N = INC; j.k0 = kt * 64; j.n0 = v_head_col(vh); j.g = attn_g;
    j.dst = (u16*)(p.ws + OFF_WV) + (size_t)l * DM * DM; j.ldk = DM; j.d0 = vh * 64; j.d1 = j.d0 + 32; return j; }
  ti -= 256;
  if (ti < 128) { j.src = p.in[11] + (size_t)l * 512 * DM; j.N = DM; j.k0 = (ti >> 4) * 64; j.n0 = (ti & 15) * 64; j.dst = (u16*)(p.ws + OFF_WBR5) + ((size_t)l * 5 + (j.k0 >> 8)) * DM * 256; j.ldk = 256; j.kd = j.k0 & 255; j.d0 = j.n0; j.d1 = j.n0 + 32; return j; }
  ti -= 128;
  if (ti < 32) { j.src = p.in[12] + (size_t)l * 128 * DM; j.N = DM; j.k0 = (ti >> 4) * 64; j.n0 = (ti & 15) * 64; j.dst = (u16*)(p.ws + OFF_WBR5) + ((size_t)l * 5 + 2) * DM * 256; j.ldk = 256; j.kd = j.k0; j.d0 = j.n0; j.d1 = j.n0 + 32; return j; }
  ti -= 32;
  if (ti < 64) { j.src = p.in[13] + (size_t)l * 256 * DM; j.N = DM; j.k0 = (ti >> 4) * 64; j.n0 = (ti & 15) * 64; j.dst = (u16*)(p.ws + OFF_WBR5) + ((size_t)l * 5 + 3) * DM * 256; j.ldk = 256; j.kd = j.k0; j.d0 = j.n0; j.d1 = j.n0 + 32; return j; }
  ti -= 64;
  if (ti < 64) { j.src = p.in[14] + (size_t)l * 256 * DM; j.N = DM; j.k0 = (ti >> 4) * 64; j.n0 = (ti & 15) * 64; j.dst = (u16*)(p.ws + OFF_WBR5) + ((size_t)l * 5 + 4) * DM * 256; j.ldk = 256; j.kd = j.k0; j.d0 = j.n0; j.d1 = j.n0 + 32; return j; }
  ti -= 64;
  if (ti < 256) { j.src = p.in[15] + (size_t)l * DM * DM; j.N = DM; j.k0 = (ti >> 4) * 64; j.n0 = (ti & 15) * 64; j.dst = (u16*)(p.ws + OFF_WOUT) + (size_t)l * DM * DM; j.ldk = DM; j.d0 = j.n0; j.d1 = j.n0 + 32; return j; }
  ti -= 256;
  if (ti < 1024) { j.src = p.in[17] + (size_t)l * DM * DMLP; j.N = DMLP; j.k0 = (ti >> 6) * 64; j.n0 = (ti & 63) * 64; j.g = p.in[16] + l * DM;
    j.dst = (u16*)(p.ws + OFF_WUP) + (size_t)l * DMLP * DM; j.ldk = DM; j.d0 = j.n0; j.d1 = j.n0 + 32; return j; }
  ti -= 1024;
  j.src = p.in[18] + (size_t)l * DMLP * DM; j.N = DM; j.k0 = (ti >> 4) * 64; j.n0 = (ti & 15) * 64; j.dst = (u16*)(p.ws + OFF_WDN) + (size_t)l * DM * DMLP; j.ldk = DMLP; j.d0 = j.n0; j.d1 = j.n0 + 32; return j;
}

__device__ void phase_prep(const Params& p, int tid_, int bid_, int nblk_, unsigned char* smem) {
  const int half = tid_ >> 8, ht = tid_ & 255;
  float* t = (float*)smem + half * (64 * 65);
  const int per_layer = 4480, total = 2 * per_layer;
  for (int jp = bid_; jp * 2 < total; jp += nblk_) {
    const int j = jp * 2 + half;
    const bool on = j < total;
    CvtJob job;
    if (on) { job = cvt_job(p, j / per_layer, j % per_layer); cvt_load(job.src, job.N, job.k0, job.n0, job.g, t, ht); }
    __syncthreads();
    if (on) cvt_store(job.dst, job.ldk, (job.kd >= 0) ? job.kd : job.k0, job.d0, job.d1, t, ht);
    __syncthreads();
  }
  {
    const u32x4 z = {0u, 0u, 0u, 0u};
    for (int e = bid_ * NTHR + tid_; e < 2 * 128 * 128; e += nblk_ * NTHR) {
      const int l = e >> 14, r = (e >> 7) & 127, c = (e & 127) * 8;
      const int row = 9 * 256 + ((r < 64) ? 64 + r : 128 + r);
      *(u32x4*)((u16*)(p.ws + OFF_WQKG) + ((size_t)l * NQKG + row) * DM + c) = z;
    }
    for (int e = bid_ * NTHR + tid_; e < 2 * 1024 * 16; e += nblk_ * NTHR) {
      const int l = e >> 14, r = (e >> 4) & 1023, c = 128 + (e & 15) * 8;
      *(u32x4*)((u16*)(p.ws + OFF_WBR5) + (((size_t)l * 5 + 2) * DM + r) * 256 + c) = z;
    }
  }
  float* rope = (float*)(p.ws + OFF_ROPE);
  for (int e = bid_ * NTHR + tid_; e < SEQ * 48; e += nblk_ * NTHR) {
    const int pos = e / 48, i = e % 48;
    float inv;
    if (i < 32) inv = exp2f(-13.287712379549449f * (float)(2 * i) / 64.0f);
    else inv = exp2f(-13.287712379549449f * (float)(2 * (i - 32)) / 32.0f);
    const float angf = (float)pos * inv;
    const double ang = (double)angf;
    const double n = rint(ang * 0.15915494309189535);
    const float r = (float)(ang - n * 6.283185307179586);
    const float c = cosf(r), s = sinf(r);
    if (i < 32) { rope[pos * 96 + i] = c; rope[pos * 96 + 32 + i] = s; }
    else { rope[pos * 96 + 64 + (i - 32)] = c; rope[pos * 96 + 80 + (i - 32)] = s; }
  }
  u16* XB = (u16*)(p.ws + OFF_XB); float* SSQ = (float*)(p.ws + OFF_SSQ);
  const int lane = tid_ & 63;
  const int gw = bid_ * 8 + (tid_ >> 6), nw = nblk_ * 8;
  for (int row = gw; row < T; row += nw) {
    const float* xr = p.in[0] + (size_t)row * DM;
    float ss = 0.f;
#pragma unroll
    for (int i = 0; i < 4; ++i) {
      const f32x4 v = *(const f32x4*)(xr + i * 256 + lane * 4);
      ss += v[0] * v[0] + v[1] * v[1] + v[2] * v[2] + v[3] * v[3];
      u32x2 w = {pk2(v[0], v[1]), pk2(v[2], v[3])};
      *(u32x2*)(XB + (size_t)row * DM + i * 256 + lane * 4) = w;
    }
#pragma unroll
    for (int o = 32; o >= 1; o >>= 1) ss += __shfl_xor(ss, o);
    if (lane < 16) SSQ[(size_t)row * 16 + lane] = (lane == 0) ? ss : 0.f;
  }
}

DI void attn_softmax_pv(f32x16& S, float& m, float& l, f32x16& O0, f32x16& O1, const bf16x8 (&vf)[2][2]) {
  float mx = S[0];
#pragma unroll
  for (int i = 1; i < 16; ++i) mx = fmaxf(mx, S[i]);
  mx = fmaxf(mx, __shfl_xor(mx, 32));
  const float mn = fmaxf(m, mx);
  const float alpha = fexp2(m - mn);
  m = mn;
  float sum = 0.f;
#pragma unroll
  for (int i = 0; i < 16; ++i) { S[i] = fexp2(S[i] - mn); sum += S[i]; }
  l = l * alpha + sum;
  const u32x4 p0 = {pk2(S[0], S[1]), pk2(S[2], S[3]), pk2(S[4], S[5]), pk2(S[6], S[7])};
  const u32x4 p1 = {pk2(S[8], S[9]), pk2(S[10], S[11]), pk2(S[12], S[13]), pk2(S[14], S[15])};
#pragma unroll
  for (int i = 0; i < 16; ++i) { O0[i] *= alpha; O1[i] *= alpha; }
  O0 = MFMA32(vf[0][0], as_bf8(p0), O0);
  O0 = MFMA32(vf[0][1], as_bf8(p1), O0);
  O1 = MFMA32(vf[1][0], as_bf8(p0), O1);
  O1 = MFMA32(vf[1][1], as_bf8(p1), O1);
}
DI void attn_fixed_pv(f32x16& S, f32x16& L, f32x16& O0, f32x16& O1, const bf16x8 (&vf)[2][2], const bf16x8 ones) {
#pragma unroll
  for (int i = 0; i < 16; ++i) S[i] = fexp2(S[i]);
  const u32x4 p0 = {pk2(S[0], S[1]), pk2(S[2], S[3]), pk2(S[4], S[5]), pk2(S[6], S[7])};
  const u32x4 p1 = {pk2(S[8], S[9]), pk2(S[10], S[11]), pk2(S[12], S[13]), pk2(S[14], S[15])};
  O0 = MFMA32(vf[0][0], as_bf8(p0), O0);
  O0 = MFMA32(vf[0][1], as_bf8(p1), O0);
  O1 = MFMA32(vf[1][0], as_bf8(p0), O1);
  O1 = MFMA32(vf[1][1], as_bf8(p1), O1);
  L = MFMA32(ones, as_bf8(p0), L);
  L = MFMA32(ones, as_bf8(p1), L);
}
DI void load_vf(bf16x8 (&vf)[2][2], const u16* V, int kb, int lane) {
#pragma unroll
  for (int rb = 0; rb < 2; ++rb)
#pragma unroll
    for (int s = 0; s < 2; ++s) vf[rb][s] = *(const bf16x8*)(V + ((size_t)((kb * 2 + rb) * 2 + s) * 64 + lane) * 8);
}
DI void load_kf4(bf16x8 (&kf)[4], const u16* K, int kb, int lane) {
#pragma unroll
  for (int s = 0; s < 4; ++s) kf[s] = *(const bf16x8*)(K + ((size_t)(kb * 4 + s) * 64 + lane) * 8);
}
DI void load_kf2(bf16x8 (&kf)[2], const u16* K, int kb, int lane) {
#pragma unroll
  for (int s = 0; s < 2; ++s) kf[s] = *(const bf16x8*)(K + ((size_t)(kb * 2 + s) * 64 + lane) * 8);
}
DI void zero16(f32x16& a) {
#pragma unroll
  for (int i = 0; i < 16; ++i) a[i] = 0.f;
}
DI void store_o(u16* yrow, const f32x16& O0, const f32x16& O1, float sc, int h) {
#pragma unroll
  for (int g4 = 0; g4 < 4; ++g4) {
    u32x2 w0 = {pk2(O0[4 * g4] * sc, O0[4 * g4 + 1] * sc), pk2(O0[4 * g4 + 2] * sc, O0[4 * g4 + 3] * sc)};
    *(u32x2*)(yrow + 8 * g4 + 4 * h) = w0;
    u32x2 w1 = {pk2(O1[4 * g4] * sc, O1[4 * g4 + 1] * sc), pk2(O1[4 * g4 + 2] * sc, O1[4 * g4 + 3] * sc)};
    *(u32x2*)(yrow + 32 + 8 * g4 + 4 * h) = w1;
  }
}

__device__ void phase_attn(const Params& p, int tid_, int bid_, int nblk_, int layer) {
  const u16* QK = (const u16*)(p.ws + OFF_QK);
  const u16* VB = (const u16*)(p.ws + OFF_V);
  u16* Y5 = (u16*)(p.ws + OFF_Y5);
  u16* BO = (u16*)(p.ws + OFF_BO);
  float* LSE = (float*)(p.ws + OFF_LSE);
  const int lane = tid_ & 63, wave = tid_ >> 6;
  const int fr = lane & 31, fh = lane >> 5;
  const int nloc = nblk_ >> 3;
  if ((int)(bid_ >> 3) >= nloc) return;
  const int vw = ((bid_ & 7) * nloc + (bid_ >> 3)) * 8 + wave, NW = nloc * 64;
  const size_t GS = (size_t)TC * 64;
  const size_t BS = (size_t)SEQ * 64;

  {
    const float* lp = p.in[7] + layer * 128;
    float d01 = 0.f, d23 = 0.f;
    for (int i = 0; i < 32; ++i) { d01 += lp[i] * lp[32 + i]; d23 += lp[64 + i] * lp[96 + i]; }
    const float lambda_init = (layer == 0) ? 0.2f : 0.35550907f;
    const float lam = __expf(d01) - __expf(d23) + lambda_init;
    const float* subg = p.in[8] + layer * 64;
    const float sc = 0.17677669529663687f * LOG2E;
    float gqm = 0.f, gkm = 0.f;
    for (int i = 0; i < 32; ++i) { gqm = fmaxf(gqm, fabsf(p.in[6][layer * 64 + i])); gkm = fmaxf(gkm, fabsf(p.in[6][layer * 64 + 32 + i])); }
    const unsigned onev = ((fr & 27) == 0) ? 0x3f803f80u : 0u;
    const u32x4 ones4 = {onev, onev, onev, onev};
    const bf16x8 ones = as_bf8(ones4);
    const float cbound = 5.6568542f * gqm * gkm * 1.02f + 0.05f;
    for (int it = vw; it < BC * 4 * 128; it += NW) {
      const int bl = it >> 9, head = (it >> 7) & 3, qblk = it & 127;
      const u16* Q0 = QK + (22 + head) * GS + bl * BS; const u16* Q1 = Q0 + SEQ * 32;
      const u16* K0 = QK + (26 + head) * GS + bl * BS; const u16* K1 = K0 + SEQ * 32;
      const u16* V = VB + (8 + head) * GS + bl * BS;
      bf16x8 q0[2], q1[2];
      load_kf2(q0, Q0, qblk, lane); load_kf2(q1, Q1, qblk, lane);
      f32x16 L0, L1; zero16(L0); zero16(L1);
      f32x16 O00, O01, O10, O11; zero16(O00); zero16(O01); zero16(O10); zero16(O11);
      bf16x8 k0[2], k1[2], vf[2][2];
      load_kf2(k0, K0, 0, lane); load_kf2(k1, K1, 0, lane); load_vf(vf, V, 0, lane);
      {
        const float mb2 = fminf(cbound, 40.0f) * LOG2E;
        f32x16 sinit;
#pragma unroll
        for (int i = 0; i < 16; ++i) sinit[i] = -mb2;
        for (int kb = 0; kb < 128; ++kb) {
          bf16x8 nk0[2], nk1[2], nvf[2][2];
          const int kn = (kb + 1 < 128) ? kb + 1 : kb;
          load_kf2(nk0, K0, kn, lane); load_kf2(nk1, K1, kn, lane); load_vf(nvf, V, kn, lane);
          f32x16 S0 = sinit, S1 = sinit;
          S0 = MFMA32(k0[0], q0[0], S0); S0 = MFMA32(k0[1], q0[1], S0);
          S1 = MFMA32(k1[0], q1[0], S1); S1 = MFMA32(k1[1], q1[1], S1);
          attn_fixed_pv(S0, L0, O00, O01, vf, ones);
          attn_fixed_pv(S1, L1, O10, O11, vf, ones);
#pragma unroll
          for (int s = 0; s < 2; ++s) { k0[s] = nk0[s]; k1[s] = nk1[s]; vf[0][s] = nvf[0][s]; vf[1][s] = nvf[1][s]; }
        }
      }
      const float i0 = 1.0f / L0[0];
      const float i1 = lam / L1[0];
      float ss = 0.f;
#pragma unroll
      for (int i = 0; i < 16; ++i) {
        O00[i] = O00[i] * i0 - O10[i] * i1; O01[i] = O01[i] * i0 - O11[i] * i1;
        ss += O00[i] * O00[i] + O01[i] * O01[i];
      }
      ss += __shfl_xor(ss, 32);
      const float rn = rsqrtf(ss * (1.0f / 64.0f) + 1e-6f) * (1.0f - lambda_init);
#pragma unroll
      for (int g4 = 0; g4 < 4; ++g4) {
        const f32x4 ga = *(const f32x4*)(subg + 8 * g4 + 4 * fh);
        const f32x4 gb = *(const f32x4*)(subg + 32 + 8 * g4 + 4 * fh);
#pragma unroll
        for (int e = 0; e < 4; ++e) { O00[4 * g4 + e] *= ga[e]; O01[4 * g4 + e] *= gb[e]; }
      }
      const size_t tok = (size_t)bl * SEQ + qblk * 32 + fr;
      store_o(Y5 + (size_t)3 * TC * 256 + tok * 256 + head * 64, O00, O01, rn, fh);
    }
  }
  {
    const float sc = 0.125f * LOG2E;
    for (int it = vw; it < BC * 8 * 128; it += NW) {
      const int bl = it >> 10, hq = (it >> 7) & 7, qblk = it & 127;
      const int kvh = hq >> 2;
      const u16* Q = QK + (size_t)hq * GS + bl * BS;
      const u16* K = QK + (size_t)(8 + kvh) * GS + bl * BS;
      const u16* V = VB + (size_t)kvh * GS + bl * BS;
      bf16x8 qf[4]; load_kf4(qf, Q, qblk, lane);
      float m = p.in[4][layer * 8 + hq] * LOG2E, l = (fh == 0) ? 1.0f : 0.0f;
      f32x16 O0, O1; zero16(O0); zero16(O1);
      const int kb_lo = (qblk - 4 < 0) ? 0 : qblk - 4, kb_hi = (qblk + 4 > 127) ? 127 : qblk + 4;
      const int qpos = qblk * 32 + fr;
      for (int kb = kb_lo; kb <= kb_hi; ++kb) {
        bf16x8 kf[4], vf[2][2];
        load_kf4(kf, K, kb, lane); load_vf(vf, V, kb, lane);
        f32x16 S; zero16(S);
#pragma unroll
        for (int s = 0; s < 4; ++s) S = MFMA32(kf[s], qf[s], S);
#pragma unroll
        for (int i = 0; i < 16; ++i) {
          const int dlt = kb * 32 + crow(i, fh) - qpos;
          S[i] = (dlt <= 128 && dlt >= -128) ? S[i] * sc : -1e30f;
        }
        attn_softmax_pv(S, m, l, O0, O1, vf);
      }
      const float inv = 1.0f / (l + __shfl_xor(l, 32));
      const size_t tok = (size_t)bl * SEQ + qpos;
      store_o(Y5 + (size_t)(hq >> 2) * TC * 256 + tok * 256 + (hq & 3) * 64, O0, O1, inv, fh);
    }
  }
  {
    const float sc = 0.125f;
    for (int it = vw; it < BC * 4 * 128; it += NW) {
      const int bl = it >> 9, head = (it >> 7) & 3, qblk = it & 127;
      const u16* Q = QK + (size_t)(30 + head) * GS + bl * BS;
      const u16* K = QK + (size_t)(34 + head) * GS + bl * BS;
      const u16* V = VB + (size_t)(12 + head) * GS + bl * BS;
      const float* rpb = p.in[10] + (size_t)(layer * 4 + head) * 15 * 31;
      bf16x8 qf[4]; load_kf4(qf, Q, qblk, lane);
      float m = -1e30f, l = 0.f;
      f32x16 O0, O1; zero16(O0); zero16(O1);
      const int qrow = qblk >> 1, qc = (qblk & 1) * 32 + fr;
      int r0 = qrow - 4; r0 = r0 < 0 ? 0 : (r0 > 56 ? 56 : r0);
      int c0 = qc - 8; c0 = c0 < 0 ? 0 : (c0 > 48 ? 48 : c0);
      for (int kk = 0; kk < 16; ++kk) {
        const int krow_ = r0 + (kk >> 1), hb = kk & 1, kb = krow_ * 2 + hb;
        bf16x8 kf[4], vf[2][2];
        load_kf4(kf, K, kb, lane); load_vf(vf, V, kb, lane);
        f32x16 S; zero16(S);
#pragma unroll
        for (int s = 0; s < 4; ++s) S = MFMA32(kf[s], qf[s], S);
        const float* brow = rpb + (krow_ - qrow + 7) * 31;
#pragma unroll
        for (int i = 0; i < 16; ++i) {
          const int kc = hb * 32 + crow(i, fh);
          int dc = kc - qc; dc = dc < -15 ? -15 : (dc > 15 ? 15 : dc);
          const float bias = brow[dc + 15];
          S[i] = (kc >= c0 && kc < c0 + 16) ? (S[i] * sc + bias) * LOG2E : -1e30f;
        }
        attn_softmax_pv(S, m, l, O0, O1, vf);
      }
      const float inv = 1.0f / (l + __shfl_xor(l, 32));
      const size_t tok = (size_t)bl * SEQ + qblk * 32 + fr;
      store_o(Y5 + (size_t)4 * TC * 256 + tok * 256 + head * 64, O0, O1, inv, fh);
    }
  }
  {
    const float sc = 0.125f * LOG2E;
    for (int it = vw; it < BC * 6 * 128; it += NW) {
      const int bl = it / 768, rem = it % 768, head = rem >> 7, qblk = rem & 127;
      const int dil = dil_of(head >> 1), L = SEQ / dil, LB = L >> 5;
      const u16* Q = QK + (size_t)(10 + head) * GS + bl * BS;
      const u16* K = QK + (size_t)(16 + head) * GS + bl * BS;
      const u16* V = VB + (size_t)(2 + head) * GS + bl * BS;
      bf16x8 qf[4]; load_kf4(qf, Q, qblk, lane);
      float m = -1e30f, l = 0.f;
      f32x16 O0, O1; zero16(O0); zero16(O1);
      const int rsub = qblk / LB;
      const int lo = rsub * LB, hi = lo + LB - 1;
      const int kb_lo = (qblk - 2 < lo) ? lo : qblk - 2, kb_hi = (qblk + 2 > hi) ? hi : qblk + 2;
      const int qd = qblk * 32 + fr;
      for (int kb = kb_lo; kb <= kb_hi; ++kb) {
        bf16x8 kf[4], vf[2][2];
        load_kf4(kf, K, kb, lane); load_vf(vf, V, kb, lane);
        f32x16 S; zero16(S);
#pragma unroll
        for (int s = 0; s < 4; ++s) S = MFMA32(kf[s], qf[s], S);
#pragma unroll
        for (int i = 0; i < 16; ++i) {
          const int dlt = kb * 32 + crow(i, fh) - qd;
          S[i] = (dlt <= 64 && dlt >= -64) ? S[i] * sc : -1e30f;
        }
        attn_softmax_pv(S, m, l, O0, O1, vf);
      }
      const float lt = l + __shfl_xor(l, 32);
      const float inv = 1.0f / lt;
      const int msub = qd - rsub * L;
      const int pos = msub * dil + rsub;
      const size_t tok = (size_t)bl * SEQ + pos;
      store_o(BO + tok * 384 + head * 64, O0, O1, inv, fh);
      if (fh == 0) LSE[tok * 8 + head] = __log2f(lt) + m;
    }
  }
}


__device__ void phase_bcombine(const Params& p, int tid_, int bid_, int nblk_) {
  const u16* BO = (const u16*)(p.ws + OFF_BO);
  const float* LSE = (const float*)(p.ws + OFF_LSE);
  u16* YB = (u16*)(p.ws + OFF_Y5) + (size_t)2 * TC * 256;
  for (int e = bid_ * NTHR + tid_; e < TC * 16; e += nblk_ * NTHR) {
    const int tok = e >> 4, j = (e >> 3) & 1, c8 = (e & 7) * 8;
    const float a0 = LSE[(size_t)tok * 8 + j], a1 = LSE[(size_t)tok * 8 + 2 + j], a2 = LSE[(size_t)tok * 8 + 4 + j];
    const float mx = fmaxf(a0, fmaxf(a1, a2));
    float w0 = fexp2(a0 - mx), w1 = fexp2(a1 - mx), w2 = fexp2(a2 - mx);
    const float inv = 1.0f / (w0 + w1 + w2);
    w0 *= inv; w1 *= inv; w2 *= inv;
    const u32x4 x0 = *(const u32x4*)(BO + (size_t)tok * 384 + (0 + j) * 64 + c8);
    const u32x4 x1 = *(const u32x4*)(BO + (size_t)tok * 384 + (2 + j) * 64 + c8);
    const u32x4 x2 = *(const u32x4*)(BO + (size_t)tok * 384 + (4 + j) * 64 + c8);
    u32x4 o;
#pragma unroll
    for (int q = 0; q < 4; ++q) {
      const float lo = w0 * bf_lo(x0[q]) + w1 * bf_lo(x1[q]) + w2 * bf_lo(x2[q]);
      const float hi = w0 * bf_hi(x0[q]) + w1 * bf_hi(x1[q]) + w2 * bf_hi(x2[q]);
      o[q] = pk2(lo, hi);
    }
    *(u32x4*)(YB + (size_t)tok * 256 + j * 64 + c8) = o;
    const u32x4 z = {0u, 0u, 0u, 0u};
    *(u32x4*)(YB + (size_t)tok * 256 + 128 + (e & 15) * 8) = z;
  }
}

#define XB_TMO      128
#define XB_XCNT(j)  (256  + 64 * (j))
#define XB_XSUB(j)  (1280 + 64 * (j))
#define XB_XGEN(j)  (2304 + 64 * (j))
#define XB_TOP      3328
#define XB_TOPGEN   3392
#define XCD_BAR_WORDS 3456
#define XB_SPIN_CAP (1u << 22)
#define LAS __attribute__((address_space(3)))
DI unsigned xb_ld(unsigned* p)              { return __hip_atomic_load(p, __ATOMIC_RELAXED, __HIP_MEMORY_SCOPE_AGENT); }
DI unsigned xb_add(unsigned* p, unsigned v) { return __hip_atomic_fetch_add(p, v, __ATOMIC_RELAXED, __HIP_MEMORY_SCOPE_AGENT); }
DI unsigned xb_xcc_id() { return (unsigned)__builtin_amdgcn_s_getreg((3 << 11) | 20) & 0xFu; }
#define XB_SPIN(cond, bar) do { unsigned _sp = 0; while (cond) { __builtin_amdgcn_s_sleep(1); \
    if ((++_sp & 255u) == 0u) { if (xb_ld(&(bar)[XB_TMO])) break; if (_sp > XB_SPIN_CAP) { atomicAdd(&(bar)[XB_TMO], 1u); break; } } } } while (0)
struct XcdBarrier { unsigned* bar; unsigned x; volatile LAS unsigned* st; };
DI XcdBarrier xcd_barrier_post(unsigned* bar, volatile LAS unsigned* st) {
  XcdBarrier b; b.bar = bar; b.x = xb_xcc_id(); b.st = st;
  if (threadIdx.x == 0) (void)xb_add(&bar[XB_XCNT(b.x)], 1u);
  return b;
}
DI void xcd_barrier_complete(unsigned* bar, unsigned x, unsigned& nloc, unsigned& nx) {
  const unsigned G = gridDim.x * gridDim.y * gridDim.z;
  unsigned sum, cnt, mine, sp = 0u;
  for (;;) {
    sum = 0u; cnt = 0u; mine = 0u;
#pragma unroll
    for (unsigned j = 0; j < 16; ++j) { const unsigned c = xb_ld(&bar[XB_XCNT(j)]); sum += c; cnt += (c > 0u) ? 1u : 0u; mine = (j == x) ? c : mine; }
    if (sum == G) break;
    __builtin_amdgcn_s_sleep(1);
    if ((++sp & 255u) == 0u) { if (xb_ld(&bar[XB_TMO])) break; if (sp > XB_SPIN_CAP) { atomicAdd(&bar[XB_TMO], 1u); break; } }
  }
  nloc = mine > 0u ? mine : 1u; nx = cnt > 0u ? cnt : 1u;
}
DI void xcd_barrier(const XcdBarrier& b) {
  asm volatile("s_waitcnt vmcnt(0)" ::: "memory");
  __syncthreads();
  if (threadIdx.x == 0) {
    unsigned* bar = b.bar;
    __builtin_amdgcn_s_waitcnt(0);
    unsigned nloc = b.st[0], nx = b.st[1];
    if (nloc == 0u) { xcd_barrier_complete(bar, b.x, nloc, nx); b.st[0] = nloc; b.st[1] = nx; }
    const unsigned old = xb_add(&bar[XB_XSUB(b.x)], 1u);
    const unsigned gen = old / nloc;
    if (old + 1u == (gen + 1u) * nloc) {
      __builtin_amdgcn_fence(__ATOMIC_RELEASE, "agent");
      asm volatile("s_waitcnt vmcnt(0)" ::: "memory");
      const unsigned og = xb_add(&bar[XB_TOP], 1u);
      const unsigned tg = og / nx;
      if (og + 1u == (tg + 1u) * nx) xb_add(&bar[XB_TOPGEN], 1u);
      else XB_SPIN(xb_ld(&bar[XB_TOPGEN]) == tg, bar);
      __builtin_amdgcn_fence(__ATOMIC_ACQUIRE, "agent");
      xb_add(&bar[XB_XGEN(b.x)], 1u);
      asm volatile("s_waitcnt vmcnt(0)" ::: "memory");
    } else {
      XB_SPIN(xb_ld(&bar[XB_XGEN(b.x)]) == gen, bar);
      __builtin_amdgcn_fence(__ATOMIC_ACQUIRE, "agent");
      asm volatile("s_waitcnt vmcnt(0)" ::: "memory");
    }
  }
  __syncthreads();
}

__global__ void __launch_bounds__(NTHR, 2) mk_forward(Params p) {
  extern __shared__ __attribute__((aligned(16))) unsigned char smem[];
  cg::grid_group grid = cg::this_grid();
  volatile LAS unsigned* xbw = (volatile LAS unsigned*)(smem + LDS_STAGE);
  if (threadIdx.x < 4) xbw[threadIdx.x] = 0u;
  __syncthreads();
  XcdBarrier xb;
  if (FUSED) xb = xcd_barrier_post((unsigned*)(p.ws + OFF_BAR), xbw);
  PG8_LAS unsigned char* lds = (PG8_LAS unsigned char*)smem;
  for (int ph = p.ph_lo; ph < p.ph_hi; ++ph) {
#if DUPMASK
   for (int rep = 0; rep < ((ph > 0 && ((DUPMASK >> ((ph - 1) % 7)) & 1)) ? 2 : 1); ++rep)
#endif
   {
    int tid_ = threadIdx.x, bid_ = blockIdx.x, nblk_ = gridDim.x;
    asm volatile("" : "+v"(tid_));
    asm volatile("" : "+s"(bid_));
    asm volatile("" : "+s"(nblk_));
    Params pp = p;
    asm volatile("" : "+s"(pp.ws));
    asm volatile("" : "+s"(pp.out));
    unsigned char* ws = pp.ws;
    if (ph == 0 || (DUPK == 7 && ((ph - 1) % PPL) == 7)) {
      if (PHMASK & 128) phase_prep(pp, tid_, bid_, nblk_, smem);
    } else {
      const int q = ph - 1, chunk = q / (2 * PPL), layer = (q % (2 * PPL)) / PPL, kk = q % PPL, k = (kk == 7) ? DUPK : kk;
      const u16* XBc = (const u16*)(ws + OFF_XB) + (size_t)chunk * TC * DM;
      float* SSQc = (float*)(ws + OFF_SSQ) + (size_t)chunk * TC * 16;
      float* xc = pp.out + (size_t)chunk * TC * DM;
      if ((k == 0 && (PHMASK & 1)) || (k == 5 && (PHMASK & 32))) {
        const bool up = (k == 5);
        if (!up) {
          EpiQKG e; e.ssq = SSQc; e.qk = (u16*)(ws + OFF_QK); e.rope = (const float*)(ws + OFF_ROPE);
          e.gA = pp.in[3] + layer * 128; e.gB = pp.in[5] + layer * 128; e.gC = pp.in[6] + layer * 64; e.gD = pp.in[9] + layer * 128;
          run_gemm(lds, XBc, (const u16*)(ws + OFF_WQKG) + (size_t)layer * NQKG * DM, TC, 2560, DM, e);
        }
        {
          EpiGateUp e; e.ssq = SSQc; e.o = (u16*)(ws + OFF_GATE); e.mode = up ? ((PROBE_NOEPI && kk == 7) ? 2 : 1) : 0;
          const u16* W = up ? (const u16*)(ws + OFF_WUP) + (size_t)layer * DMLP * DM : (const u16*)(ws + OFF_WQKG) + ((size_t)layer * NQKG + 2560) * DM;
          run_gemm(lds, XBc, W, TC, 4096, DM, e, (PROBE_NOEPI && kk == 7) ? 1 : 0);
        }
        if (!up) {
          EpiVT ev; ev.ssq = SSQc; ev.vbuf = (u16*)(ws + OFF_V);
          run_gemm(lds, (const u16*)(ws + OFF_WV) + (size_t)layer * DM * DM, XBc, DM, TC, DM, ev);
        }
      } else if (k == 1 && (PHMASK & 2)) {
        phase_attn(pp, tid_, bid_, nblk_, layer);
      } else if (k == 2 && (PHMASK & 4)) {
        phase_bcombine(pp, tid_, bid_, nblk_);
      } else if (k == 3 && (PHMASK & 8)) {
        EpiMerge e; e.gate = (const u16*)(ws + OFF_GATE); e.mrg = (u16*)(ws + OFF_MRG);
        run_merge(lds, (const u16*)(ws + OFF_Y5), (const u16*)(ws + OFF_WBR5) + (size_t)layer * 5 * DM * 256, e);
      } else if ((k == 4 && (PHMASK & 16)) || (k == 6 && (PHMASK & 64))) {
        const bool dn = (k == 6);
        EpiResid e; e.xold = (!dn && layer == 0) ? (pp.in[0] + (size_t)chunk * TC * DM) : xc; e.xout = xc; e.xb = (u16*)XBc; e.ssq = SSQc;
        const u16* A = dn ? (const u16*)(ws + OFF_GATE) : (const u16*)(ws + OFF_MRG);
        const u16* W = dn ? (const u16*)(ws + OFF_WDN) + (size_t)layer * DM * DMLP : (const u16*)(ws + OFF_WOUT) + (size_t)layer * DM * DM;
        run_gemm(lds, A, W, TC, DM, dn ? DMLP : DM, e);
      }
    }
   }
    if (ph + 1 < p.ph_hi) {
      if (ph == 0) grid.sync();
      else xcd_barrier(xb);
    }
  }
}

extern "C" void kernel_launch(void* const* d_in, const int* in_sizes, int n_in, void* d_out, int out_size, void* d_ws, size_t ws_size,
                              hipStream_t stream) {
  static int grid_blocks = 0;
  if (grid_blocks == 0) {
    if (n_in != 19 || out_size != T * DM || ws_size < WS_END) {
      fprintf(stderr, "kernel_launch: unexpected problem (n_in %d out %d ws %zu need %zu)\n", n_in, out_size, ws_size, (size_t)WS_END);
      grid_blocks = -1;
      return;
    }
    int dev = 0, cus = 0, per_cu = 0;
    (void)hipGetDevice(&dev);
    (void)hipDeviceGetAttribute(&cus, hipDeviceAttributeMultiprocessorCount, dev);
    if (hipFuncSetAttribute((const void*)mk_forward, hipFuncAttributeMaxDynamicSharedMemorySize, LDS_BYTES) != hipSuccess) {
      fprintf(stderr, "kernel_launch: hipFuncSetAttribute failed\n"); grid_blocks = -1; return;
    }
    (void)hipOccupancyMaxActiveBlocksPerMultiprocessor(&per_cu, mk_forward, NTHR, LDS_BYTES);
    if (per_cu < 1) fprintf(stderr, "kernel_launch: occupancy query says %d blocks per CU\n", per_cu);
    (void)hipGetLastError();
    grid_blocks = cus;
  }
  if (grid_blocks < 0) return;
  Params p{};
  for (int i = 0; i < 19; ++i) p.in[i] = (const float*)d_in[i];
  p.out = (float*)d_out;
  p.ws = (unsigned char*)d_ws;
#if FUSED
  (void)hipMemsetAsync((unsigned char*)d_ws + OFF_BAR, 0, XCD_BAR_WORDS * 4, stream);
  p.ph_lo = 0; p.ph_hi = NPHASE;
  void* args[] = {&p};
  hipError_t e = hipLaunchCooperativeKernel((const void*)mk_forward, dim3(grid_blocks), dim3(NTHR), args, LDS_BYTES, stream);
  if (e != hipSuccess) fprintf(stderr, "cooperative launch failed: %s (grid %d)\n", hipGetErrorString(e), grid_blocks);
#else
  for (int ph = 0; ph < NPHASE; ++ph) {
    p.ph_lo = ph; p.ph_hi = ph + 1;
    hipLaunchKernelGGL(mk_forward, dim3(grid_blocks), dim3(NTHR), LDS_BYTES, stream, p);
  }
#endif
}
```

```cpp
#include <hip/hip_runtime.h>
#include <hip/hip_cooperative_groups.h>
#include <cstdio>
namespace cg = cooperative_groups;

#ifndef PHMASK
#define PHMASK 255
#endif
#ifndef DUPMASK
#define DUPMASK 0
#endif
#ifndef DUPK
#define DUPK -1
#endif
#ifndef PROBE_CLOCK
#define PROBE_CLOCK 0
#endif
#ifndef PROBE_NOEPI
#define PROBE_NOEPI 0
#endif
#ifndef FUSED
#define FUSED 1
#endif

namespace pg8 {
#define PG8_LAS __attribute__((address_space(3)))
typedef unsigned short bf16_t;
typedef short bf16x8 __attribute__((ext_vector_type(8)));
typedef float f32x4 __attribute__((ext_vector_type(4)));
typedef unsigned u32x4 __attribute__((ext_vector_type(4)));
constexpr int BM = 256, BK = 64, HALF = 128, HTB = HALF * BK * 2  , STAGE_BYTES = 8 * HTB, NXCD = 8, WGM = 8;

__host__ __device__ __forceinline__ int lds_byte(int r, int c) { const int st = (r >> 4) * 2 + (c >> 5), rr = r & 15, cc = c & 31, ob = rr * 64 + cc * 2; return st * 1024 + (ob ^ (((ob >> 9) & 1) << 5)); }
__host__ __device__ __forceinline__ void stage_rc(int b, int& R, int& C) { const int st = b / 1024, sb = b % 1024, swz = sb ^ (((sb >> 9) & 1) << 5); R = (st >> 1) * 16 + swz / 64; C = (st & 1) * 32 + (swz % 64) / 2; }
__host__ __device__ __forceinline__ int perm32(int rho) { const int n = rho >> 4, i = rho & 15; return 8 * (i >> 2) + 4 * n + (i & 3); }

struct Unit { int pm, pn, seg; };
struct Gemm { const bf16_t* A; const bf16_t* Bt; int M, N, K; };

struct StaticOrder {
    int nM, nN, nwg, G, c, probe = 0;
    __host__ __device__ void init(int M, int N, int G_, int c_) { nM = M / BM; nN = N / BM; nwg = nM * nN; G = G_; c = c_; }
    __host__ __device__ bool next(int i, Unit& u) const {
        const long L = (long)i * G + c; if (L >= nwg) return false;
        int wgid = (int)L; { const int q = nwg / NXCD, r = nwg % NXCD, xcd = wgid % NXCD, off = wgid / NXCD; wgid = (xcd < r ? xcd * (q + 1) : r * (q + 1) + (xcd - r) * q) + off; }
        const int nig = WGM * nN, gid = wgid / nig, fm = gid * WGM, gsz = (nM - fm) < WGM ? (nM - fm) : WGM;
        u.pm = fm + ((wgid % nig) % gsz); u.pn = (wgid % nig) / gsz; u.seg = 0; if (probe) { u.pm = 0; u.pn = 0; } return true;
    }
    __device__ __forceinline__ void a_ready(const Unit&) const {}
    __device__ __forceinline__ void done(const Unit&) const {}
    __device__ __forceinline__ const char* baseA(const Gemm& g, const Unit& u, size_t tstep) const { return (const char*)g.A + (size_t)u.pm * tstep; }
    __device__ __forceinline__ const char* baseB(const Gemm& g, const Unit& u, size_t tstep) const { return (const char*)g.Bt + (size_t)u.pn * tstep; }
    __device__ __forceinline__ bool zero_after(const Unit&) const { return true; }
};

template <class Epi, class Sched, bool STAMP = false>
__device__ __forceinline__ void gemm_phase(PG8_LAS unsigned char* lds, const Gemm g, const Sched& S, const Epi& E, unsigned long long* stamps) {
    int tid = threadIdx.x; asm volatile("" : "+v"(tid));
    const int wid = __builtin_amdgcn_readfirstlane(tid >> 6), lane = tid & 63, wr = wid >> 2, wc = wid & 3, fr = lane & 15, fq = lane >> 4;
    const int K = g.K, nt = K / BK;
    int ts_lo = 0, ts_hi = 0, nts = 0; const unsigned long long rt_entry = STAMP ? (unsigned long long)wall_clock64() : 0ull;
#define PG8_STAMP() do { if (STAMP && wid == 0 && nts < 64) { const unsigned long long _c = (unsigned long long)clock64(); \
        ts_lo = (lane == nts) ? (int)(unsigned)_c : ts_lo; ts_hi = (lane == nts) ? (int)(unsigned)(_c >> 32) : ts_hi; ++nts; } } while (0)
    PG8_STAMP();
    unsigned voffA[2], voffB[2];
#pragma unroll
    for (int i = 0; i < 2; ++i) { int R, C; stage_rc(tid * 16 + i * 8192, R, C); const int Rb = Epi::PERM ? ((R & ~31) + perm32(R & 31)) : R;
        voffA[i] = (unsigned)(R * K + C) * 2u; voffB[i] = (unsigned)(Rb * K + C) * 2u; }
    const size_t kstep = (size_t)(BK * 2);
    const size_t hstep = (size_t)HALF * K * 2;
    const size_t tstep = 2 * hstep;
    const unsigned ldsw = (unsigned)wid * 1024u;
    const int aoff = lds_byte(wr * 64 + fr, fq * 8), boff = lds_byte(wc * 32 + fr, fq * 8);
#define PG8_SA(b, h) (((b) * 2 + (h)) * HTB)
#define PG8_SB(b, h) ((4 + (b) * 2 + (h)) * HTB)
#define PG8_STAGE(bufoff, gbase, voff) do { _Pragma("unroll") for (int _i = 0; _i < 2; ++_i) \
        __builtin_amdgcn_global_load_lds((const unsigned*)((const char*)(gbase) + (voff)[_i]), (PG8_LAS unsigned*)(lds + (bufoff) + ldsw + _i * 8192), 16, 0, 0); } while (0)
#define PG8_LDA(dst, b, h) do { _Pragma("unroll") for (int m = 0; m < 4; ++m) _Pragma("unroll") for (int k = 0; k < 2; ++k) dst[m][k] = *(const PG8_LAS bf16x8*)(lds + PG8_SA(b, h) + aoff + m * 2048 + k * 1024); } while (0)
#define PG8_LDB(dst, b, h) do { _Pragma("unroll") for (int n = 0; n < 2; ++n) _Pragma("unroll") for (int k = 0; k < 2; ++k) dst[n][k] = *(const PG8_LAS bf16x8*)(lds + PG8_SB(b, h) + boff + n * 2048 + k * 1024); } while (0)
#define PG8_MMA(ai, bj, At, Bt) do { __builtin_amdgcn_s_setprio(1); _Pragma("unroll") for (int m = 0; m < 4; ++m) _Pragma("unroll") for (int n = 0; n < 2; ++n) _Pragma("unroll") for (int k = 0; k < 2; ++k) \
        acc[ai][bj][m][n] = __builtin_amdgcn_mfma_f32_16x16x32_bf16(Bt[n][k], At[m][k], acc[ai][bj][m][n], 0, 0, 0); __builtin_amdgcn_s_setprio(0); } while (0)
#define PG8_WAIT_V(n) asm volatile("s_waitcnt vmcnt(" #n ")" ::: "memory")
#define PG8_WAIT_L(n) asm volatile("s_waitcnt lgkmcnt(" #n ")" ::: "memory")
#define PG8_BAR __builtin_amdgcn_s_barrier()
#define PG8_SCHED __builtin_amdgcn_sched_barrier(0)
    Unit cur, nxt; int ui = 0;
    if (!S.next(0, cur)) return;
    f32x4 acc[2][2][4][2];
#pragma unroll
    for (int a = 0; a < 2; ++a)
#pragma unroll
        for (int b = 0; b < 2; ++b)
#pragma unroll
            for (int m = 0; m < 4; ++m)
#pragma unroll
                for (int n = 0; n < 2; ++n) acc[a][b][m][n] = (f32x4){0.f, 0.f, 0.f, 0.f};
    bf16x8 At[4][2], B0[2][2], B1[2][2];
    const char* cA = S.baseA(g, cur, tstep); const char* cB = S.baseB(g, cur, tstep);
    S.a_ready(cur);
    PG8_STAGE(PG8_SB(0, 0), cB, voffB); PG8_STAGE(PG8_SA(0, 0), cA, voffA); PG8_STAGE(PG8_SB(0, 1), cB + hstep, voffB); PG8_STAGE(PG8_SA(0, 1), cA + hstep, voffA);
    if (wr == 1) PG8_BAR;
    PG8_WAIT_V(4); PG8_BAR;
    PG8_STAGE(PG8_SB(1, 0), cB + kstep, voffB); PG8_STAGE(PG8_SA(1, 0), cA + kstep, voffA); PG8_STAGE(PG8_SB(1, 1), cB + hstep + kstep, voffB);
    PG8_WAIT_V(6); PG8_BAR;
    PG8_STAMP();
    for (;;) {
        const bool has_next = S.next(ui + 1, nxt);
        const char* nA = has_next ? S.baseA(g, nxt, tstep) : cA; const char* nB = has_next ? S.baseB(g, nxt, tstep) : cB;
        for (int t = 0; t < nt; t += 2) {
            const bool last = (t == nt - 2);
            const char* a1 = cA + (size_t)(t + 1) * kstep;
            const char* a2 = last ? nA : cA + (size_t)(t + 2) * kstep; const char* b2 = last ? nB : cB + (size_t)(t + 2) * kstep;
            const char* a3 = a2 + kstep; const char* b3 = b2 + kstep;
            if (last && has_next) S.a_ready(nxt);
            PG8_LDB(B0, 0, 0); PG8_SCHED; PG8_LDA(At, 0, 0); PG8_STAGE(PG8_SA(1, 1), a1 + hstep, voffA);
            PG8_WAIT_L(8); PG8_BAR; PG8_WAIT_L(0); PG8_MMA(0, 0, At, B0); PG8_BAR; PG8_SCHED;
            PG8_LDB(B1, 0, 1); PG8_STAGE(PG8_SB(0, 0), b2, voffB);
            PG8_BAR; PG8_WAIT_L(0); PG8_MMA(0, 1, At, B1); PG8_BAR;
            PG8_LDA(At, 0, 1); PG8_STAGE(PG8_SA(0, 0), a2, voffA);
            PG8_BAR; PG8_WAIT_L(0); PG8_MMA(1, 0, At, B0); PG8_BAR; PG8_SCHED;
            PG8_STAGE(PG8_SB(0, 1), b2 + hstep, voffB);
            PG8_WAIT_V(6); PG8_BAR; PG8_MMA(1, 1, At, B1); PG8_BAR;
            PG8_LDB(B0, 1, 0); PG8_SCHED; PG8_LDA(At, 1, 0); PG8_STAGE(PG8_SA(0, 1), a2 + hstep, voffA);
            PG8_WAIT_L(8); PG8_BAR; PG8_WAIT_L(0); PG8_MMA(0, 0, At, B0); PG8_BAR; PG8_SCHED;
            PG8_LDB(B1, 1, 1); PG8_STAGE(PG8_SB(1, 0), b3, voffB);
            PG8_BAR; PG8_WAIT_L(0); PG8_MMA(0, 1, At, B1); PG8_BAR;
            PG8_LDA(At, 1, 1); PG8_STAGE(PG8_SA(1, 0), a3, voffA);
            PG8_BAR; PG8_WAIT_L(0); PG8_MMA(1, 0, At, B0); PG8_BAR; PG8_SCHED;
            PG8_STAGE(PG8_SB(1, 1), b3 + hstep, voffB);
            PG8_WAIT_V(6); PG8_BAR; PG8_MMA(1, 1, At, B1); PG8_BAR;
        }
        PG8_STAMP();
        if constexpr (!Epi::AFTER_DRAIN) { E(acc, cur, wr, wc, fr, fq); S.done(cur); }
        PG8_STAMP();
        if (!has_next) break;
        if (S.zero_after(cur))
#pragma unroll
        for (int a = 0; a < 2; ++a)
#pragma unroll
            for (int b = 0; b < 2; ++b)
#pragma unroll
                for (int m = 0; m < 4; ++m)
#pragma unroll
                    for (int n = 0; n < 2; ++n) acc[a][b][m][n] = (f32x4){0.f, 0.f, 0.f, 0.f};
        cur = nxt; cA = nA; cB = nB; ++ui;
    }
    PG8_WAIT_V(0);
    if (wr == 0) PG8_BAR;
    PG8_BAR;
    if constexpr (Epi::AFTER_DRAIN) { E.fused(acc, cur, wr, wc, fr, fq, lds, wid, lane); S.done(cur); }
    PG8_STAMP();
    if (STAMP && wid == 0) { stamps[lane] = lane < nts ? (((unsigned long long)(unsigned)ts_hi << 32) | (unsigned)ts_lo) : 0ull;
        if (lane == 62) stamps[62] = rt_entry; if (lane == 63) stamps[63] = (unsigned long long)wall_clock64(); }
#undef PG8_STAMP
#undef PG8_SA
#undef PG8_SB
#undef PG8_STAGE
#undef PG8_LDA
#undef PG8_LDB
#undef PG8_MMA
#undef PG8_WAIT_V
#undef PG8_WAIT_L
#undef PG8_BAR
#undef PG8_SCHED
}
}

typedef unsigned short u16;
typedef short bf16x8 __attribute__((ext_vector_type(8)));
typedef float f32x16 __attribute__((ext_vector_type(16)));
typedef float f32x4 __attribute__((ext_vector_type(4)));
typedef __bf16 bf2_t __attribute__((ext_vector_type(2)));
typedef float f2_t __attribute__((ext_vector_type(2)));
typedef unsigned u32x4 __attribute__((ext_vector_type(4)));
typedef unsigned u32x2 __attribute__((ext_vector_type(2)));
using pg8::Unit;

#define DI __device__ __forceinline__
#define MFMA32(a, b, c) __builtin_amdgcn_mfma_f32_32x32x16_bf16((a), (b), (c), 0, 0, 0)

constexpr int DM = 1024, SEQ = 4096, NBATCH = 8, T = NBATCH * SEQ;
constexpr int NCH = 2, BC = NBATCH / NCH, TC = BC * SEQ;
constexpr int INC = 7552, DMLP = 4096;
constexpr int NQKG = 6656;
constexpr int NQKH = 38, NVH = 16;
constexpr float LOG2E = 1.4426950408889634f;
constexpr int NTHR = 512;

constexpr size_t al256(size_t x) { return (x + 255) & ~(size_t)255; }
constexpr size_t OFF_WQKG = 0;
constexpr size_t OFF_WV   = OFF_WQKG + al256((size_t)2 * NQKG * DM * 2);
constexpr size_t OFF_WBR5 = OFF_WV   + al256((size_t)2 * DM * DM * 2);
constexpr size_t OFF_WOUT = OFF_WBR5 + al256((size_t)2 * 5 * DM * 256 * 2);
constexpr size_t OFF_WUP  = OFF_WOUT + al256((size_t)2 * DM * DM * 2);
constexpr size_t OFF_WDN  = OFF_WUP  + al256((size_t)2 * DMLP * DM * 2);
constexpr size_t OFF_ROPE = OFF_WDN  + al256((size_t)2 * DM * DMLP * 2);
constexpr size_t OFF_XB   = OFF_ROPE + al256((size_t)SEQ * 96 * 4);
constexpr size_t OFF_SSQ  = OFF_XB   + al256((size_t)T * DM * 2);
constexpr size_t OFF_QK   = OFF_SSQ  + al256((size_t)T * 16 * 4);
constexpr size_t OFF_V    = OFF_QK   + al256((size_t)NQKH * TC * 64 * 2);
constexpr size_t OFF_GATE = OFF_V    + al256((size_t)NVH * TC * 64 * 2);
constexpr size_t OFF_Y5   = OFF_GATE + al256((size_t)TC * 4096 * 2);
constexpr size_t OFF_BO   = OFF_Y5   + al256((size_t)5 * TC * 256 * 2);
constexpr size_t OFF_LSE  = OFF_BO   + al256((size_t)TC * 384 * 2);
constexpr size_t OFF_MRG  = OFF_LSE  + al256((size_t)TC * 8 * 4);
constexpr size_t OFF_BAR  = OFF_MRG  + al256((size_t)TC * DM * 2);
constexpr size_t WS_END   = OFF_BAR  + 16384;
static_assert(WS_END <= (size_t)512 * 1024 * 1024, "workspace too large");

constexpr int LDS_STAGE = 131072;
constexpr int LDS_BYTES = LDS_STAGE + 64;
constexpr int PPL = (DUPK >= 0) ? 7 : 6;
constexpr int NPHASE = 1 + NCH * 2 * PPL;

struct Params {
  const float* in[19];
  float* out;
  unsigned char* ws;
  int ph_lo, ph_hi;
};

DI unsigned pk2(float a, float b) { f2_t v = {a, b}; bf2_t r = __builtin_convertvector(v, bf2_t); return __builtin_bit_cast(unsigned, r); }
DI float bf_lo(unsigned u) { return __uint_as_float(u << 16); }
DI float bf_hi(unsigned u) { return __uint_as_float(u & 0xffff0000u); }
DI float fexp2(float x) { return __builtin_amdgcn_exp2f(x); }
DI int crow(int i, int h) { return (i & 3) + 8 * (i >> 2) + 4 * h; }
DI bf16x8 as_bf8(u32x4 v) { return __builtin_bit_cast(bf16x8, v); }
DI int dil_of(int gi) { return gi == 0 ? 1 : (gi == 1 ? 4 : 16); }
DI int dlg_of(int gi) { return gi * 2; }
DI float row_rscale(const float* ssq, size_t tok) {
  const f32x4 a = *(const f32x4*)(ssq + tok * 16), b = *(const f32x4*)(ssq + tok * 16 + 4);
  const f32x4 c = *(const f32x4*)(ssq + tok * 16 + 8), d = *(const f32x4*)(ssq + tok * 16 + 12);
  const float s = ((a[0] + a[1]) + (a[2] + a[3])) + ((b[0] + b[1]) + (b[2] + b[3])) + ((c[0] + c[1]) + (c[2] + c[3])) + ((d[0] + d[1]) + (d[2] + d[3]));
  return rsqrtf(s * (1.0f / 1024.0f) + 1e-6f);
}
DI int qk_head_col(int h) {
  if (h < 8) return 64 * h;
  if (h < 10) return 512 + 64 * (h - 8);
  if (h < 16) return 768 + 64 * (h - 10);
  if (h < 22) return 1152 + 64 * (h - 16);
  if (h < 26) return 1920 + 64 * (h - 22);
  if (h < 30) return 2176 + 64 * (h - 26);
  if (h < 34) return 2688 + 64 * (h - 30);
  return 2944 + 64 * (h - 34);
}
DI int v_head_col(int vh) {
  if (vh < 2) return 640 + 64 * vh;
  if (vh < 8) return 1536 + 64 * (vh - 2);
  if (vh < 12) return 2432 + 64 * (vh - 8);
  return 3200 + 64 * (vh - 12);
}

struct EpiQKG {
  static constexpr bool PERM = false, AFTER_DRAIN = false;
  const float* ssq; u16* qk; const float* rope; const float* gA; const float* gB; const float* gC; const float* gD;
  DI void operator()(const f32x4 (&acc)[2][2][4][2], const Unit& u, int wr, int wc, int fr, int fq) const {
    const int hidx = u.pn * 4 + wc;
    if (hidx >= NQKH) return;
    int kind, dlg = 0; const float* gain;
    if (hidx < 8) { kind = 0; gain = gA; }
    else if (hidx < 10) { kind = 0; gain = gA + 64; }
    else if (hidx < 16) { kind = 0; gain = gB; dlg = dlg_of((hidx - 10) >> 1); }
    else if (hidx < 22) { kind = 0; gain = gB + 64; dlg = dlg_of((hidx - 16) >> 1); }
    else if (hidx < 26) { kind = 2; gain = gC; }
    else if (hidx < 30) { kind = 2; gain = gC + 32; }
    else if (hidx < 34) { kind = 1; gain = gD; }
    else { kind = 1; gain = gD + 64; }
    u16* gbase = qk + (size_t)hidx * TC * 64;
    const float* gainl = gain + 4 * fq;
    const float qpre = (hidx >= 22 && hidx < 26) ? (0.17677669529663687f * LOG2E)
                     : ((hidx < 8 || (hidx >= 10 && hidx < 16) || (hidx >= 30 && hidx < 34)) ? (0.125f * LOG2E) : 1.0f);
#pragma unroll
    for (int ai = 0; ai < 2; ++ai)
#pragma unroll
      for (int m = 0; m < 4; ++m) {
        const int tok = u.pm * 256 + 128 * ai + 64 * wr + 16 * m + fr;
        const int bl = tok >> 12, pos = tok & 4095;
        const float rs = row_rscale(ssq, tok);
        const int pdom = ((pos & ((1 << dlg) - 1)) << (12 - dlg)) + (pos >> dlg);
        const int blk = pdom >> 5, rr = pdom & 31;
        u16* base = gbase + (size_t)bl * SEQ * 64;
        if (kind != 2) {
          float ss = 0.f;
#pragma unroll
          for (int bj = 0; bj < 2; ++bj)
#pragma unroll
            for (int n = 0; n < 2; ++n)
#pragma unroll
              for (int e = 0; e < 4; ++e) ss += acc[ai][bj][m][n][e] * acc[ai][bj][m][n][e];
          ss += __shfl_xor(ss, 16); ss += __shfl_xor(ss, 32);
          const float sc = rs * rsqrtf(ss * rs * rs * (1.0f / 64.0f) + 1e-6f) * qpre;
#pragma unroll
          for (int n = 0; n < 2; ++n) {
            f32x4 xa = acc[ai][0][m][n] * sc * *(const f32x4*)(gainl + 16 * n);
            f32x4 xb2 = acc[ai][1][m][n] * sc * *(const f32x4*)(gainl + 32 + 16 * n);
            if (kind == 0) {
              const f32x4 c4 = *(const f32x4*)(rope + pos * 96 + 16 * n + 4 * fq);
              const f32x4 s4 = *(const f32x4*)(rope + pos * 96 + 32 + 16 * n + 4 * fq);
              const f32x4 ta = xa * c4 - xb2 * s4, tb = xb2 * c4 + xa * s4;
              xa = ta; xb2 = tb;
            }
            u32x2 w0 = {pk2(xa[0], xa[1]), pk2(xa[2], xa[3])};
            *(u32x2*)(base + ((size_t)(blk * 4 + n) * 64 + (fq >> 1) * 32 + rr) * 8 + 4 * (fq & 1)) = w0;
            u32x2 w1 = {pk2(xb2[0], xb2[1]), pk2(xb2[2], xb2[3])};
            *(u32x2*)(base + ((size_t)(blk * 4 + 2 + n) * 64 + (fq >> 1) * 32 + rr) * 8 + 4 * (fq & 1)) = w1;
          }
        } else {
          const f32x4 c4 = *(const f32x4*)(rope + pos * 96 + 64 + 4 * fq);
          const f32x4 s4 = *(const f32x4*)(rope + pos * 96 + 80 + 4 * fq);
#pragma unroll
          for (int bj = 0; bj < 2; ++bj) {
            float ss = 0.f;
#pragma unroll
            for (int n = 0; n < 2; ++n)
#pragma unroll
              for (int e = 0; e < 4; ++e) ss += acc[ai][bj][m][n][e] * acc[ai][bj][m][n][e];
            ss += __shfl_xor(ss, 16); ss += __shfl_xor(ss, 32);
            const float sc = rs * rsqrtf(ss * rs * rs * (1.0f / 32.0f) + 1e-6f) * qpre;
            const f32x4 xa = acc[ai][bj][m][0] * sc * *(const f32x4*)(gainl);
            const f32x4 xb2 = acc[ai][bj][m][1] * sc * *(const f32x4*)(gainl + 16);
            const f32x4 ta = xa * c4 - xb2 * s4, tb = xb2 * c4 + xa * s4;
            u16* sb = base + (size_t)bj * SEQ * 32;
            u32x2 w0 = {pk2(ta[0], ta[1]), pk2(ta[2], ta[3])};
            *(u32x2*)(sb + ((size_t)(blk * 2 + 0) * 64 + (fq >> 1) * 32 + rr) * 8 + 4 * (fq & 1)) = w0;
            u32x2 w1 = {pk2(tb[0], tb[1]), pk2(tb[2], tb[3])};
            *(u32x2*)(sb + ((size_t)(blk * 2 + 1) * 64 + (fq >> 1) * 32 + rr) * 8 + 4 * (fq & 1)) = w1;
          }
        }
        asm volatile("" ::: "memory");
      }
  }
};

struct EpiGateUp {
  static constexpr bool PERM = true, AFTER_DRAIN = false;
  const float* ssq; u16* o; int mode;
  DI void operator()(const f32x4 (&acc)[2][2][4][2], const Unit& u, int wr, int wc, int fr, int fq) const {
    if (mode == 2) return;
    const int c0 = u.pn * 256 + 32 * wc + 8 * fq;
    const bool up = mode != 0;
#pragma unroll
    for (int ai = 0; ai < 2; ++ai)
#pragma unroll
      for (int m = 0; m < 4; ++m) {
        const size_t tok = (size_t)u.pm * 256 + 128 * ai + 64 * wr + 16 * m + fr;
        const float rs = row_rscale(ssq, tok);
#pragma unroll
        for (int bj = 0; bj < 2; ++bj) {
          float r[8];
#pragma unroll
          for (int n = 0; n < 2; ++n) {
            const f32x4 v = acc[ai][bj][m][n] * rs;
#pragma unroll
            for (int e = 0; e < 4; ++e) {
              const float z = fmaxf(v[e], 0.f);
              const float sg = __builtin_amdgcn_rcpf(1.0f + __expf(-v[e]));
              r[4 * n + e] = up ? z * z : sg;
            }
          }
          u32x4 w = {pk2(r[0], r[1]), pk2(r[2], r[3]), pk2(r[4], r[5]), pk2(r[6], r[7])};
          *(u32x4*)(o + tok * 4096 + c0 + 128 * bj) = w;
        }
        asm volatile("" ::: "memory");
      }
  }
};

struct EpiVT {
  static constexpr bool PERM = false, AFTER_DRAIN = false;
  const float* ssq; u16* vbuf;
  DI void operator()(const f32x4 (&acc)[2][2][4][2], const Unit& u, int wr, int wc, int fr, int fq) const {
    f32x4 rs4[2][2];
#pragma unroll
    for (int bj = 0; bj < 2; ++bj)
#pragma unroll
      for (int n = 0; n < 2; ++n) {
        const size_t t0 = (size_t)u.pn * 256 + 128 * bj + 32 * wc + 16 * n + 4 * fq;
#pragma unroll
        for (int e = 0; e < 4; ++e) { rs4[bj][n][e] = row_rscale(ssq, t0 + e); asm volatile("" ::: "memory"); }
      }
#pragma unroll
    for (int ai = 0; ai < 2; ++ai) {
      const int vgrp = u.pm * 4 + 2 * ai + wr;
      const int dlg = (vgrp >= 2 && vgrp < 8) ? dlg_of((vgrp - 2) >> 1) : 0;
      u16* gbase = vbuf + (size_t)vgrp * TC * 64;
      const int bl = (u.pn * 256) >> 12;
      u16* base = gbase + (size_t)bl * SEQ * 64;
      const unsigned es = (dlg == 0) ? 1u : (unsigned)(128 >> dlg) * 2048u;
#pragma unroll
      for (int m = 0; m < 4; ++m) {
        const int dv = 16 * m + fr;
        const unsigned dvo = (unsigned)((dv >> 5) * 1024 + (dv & 31) * 8);
#pragma unroll
        for (int bj = 0; bj < 2; ++bj)
#pragma unroll
          for (int n = 0; n < 2; ++n) {
            const int pos0 = (u.pn * 256 + 128 * bj + 32 * wc + 16 * n + 4 * fq) & 4095;
            const f32x4 v = acc[ai][bj][m][n] * rs4[bj][n];
            const int pd0 = ((pos0 & ((1 << dlg) - 1)) << (12 - dlg)) + (pos0 >> dlg);
            const int blk = pd0 >> 5, key = pd0 & 31;
            const unsigned off = (unsigned)blk * 2048u + (unsigned)(key >> 4) * 512u + (unsigned)((key >> 2) & 1) * 256u + dvo + 4u * ((key >> 3) & 1);
            const unsigned w0 = pk2(v[0], v[1]), w1 = pk2(v[2], v[3]);
            const unsigned o2 = off + (key & 3);
            base[o2] = (u16)(w0 & 0xffffu); base[o2 + es] = (u16)(w0 >> 16); base[o2 + 2 * es] = (u16)(w1 & 0xffffu); base[o2 + 3 * es] = (u16)(w1 >> 16);
            asm volatile("" ::: "memory");
          }
      }
    }
  }
};

struct MergeOrder : pg8::StaticOrder {
  const u16* ybase; const u16* wbase;
  DI bool next(int i, Unit& u) const { if (i >= 5) return false; if (!pg8::StaticOrder::next(0, u)) return false; u.seg = i; return true; }
  DI const char* baseA(const pg8::Gemm&, const Unit& u, size_t tstep) const { return (const char*)(ybase + (size_t)u.seg * TC * 256) + (size_t)u.pm * tstep; }
  DI const char* baseB(const pg8::Gemm&, const Unit& u, size_t tstep) const { return (const char*)(wbase + (size_t)u.seg * DM * 256) + (size_t)u.pn * tstep; }
  DI bool zero_after(const Unit& u) const { return u.seg == 4; }
};
struct EpiMerge {
  static constexpr bool PERM = true, AFTER_DRAIN = false;
  const u16* gate; u16* mrg;
  DI void operator()(f32x4 (&acc)[2][2][4][2], const Unit& u, int wr, int wc, int fr, int fq) const {
    const int seg = u.seg;
    if (seg == 0) return;
    const bool last = (seg == 4);
    const int gnum = last ? 3 : seg - 1, gden = last ? 3 : seg;
#pragma unroll
    for (int ai = 0; ai < 2; ++ai)
#pragma unroll
      for (int m = 0; m < 4; ++m) {
        const size_t tok = (size_t)u.pm * 256 + 128 * ai + 64 * wr + 16 * m + fr;
#pragma unroll
        for (int bj = 0; bj < 2; ++bj) {
          const int c = u.pn * 256 + 128 * bj + 32 * wc + 8 * fq;
          const u32x4 gn = *(const u32x4*)(gate + tok * 4096 + gnum * 1024 + c);
          const u32x4 gd = *(const u32x4*)(gate + tok * 4096 + gden * 1024 + c);
#pragma unroll
          for (int n = 0; n < 2; ++n) {
            f32x4 f;
            f[0] = bf_lo(gn[2 * n]); f[1] = bf_hi(gn[2 * n]); f[2] = bf_lo(gn[2 * n + 1]); f[3] = bf_hi(gn[2 * n + 1]);
            if (!last) {
              f[0] *= __builtin_amdgcn_rcpf(bf_lo(gd[2 * n])); f[1] *= __builtin_amdgcn_rcpf(bf_hi(gd[2 * n]));
              f[2] *= __builtin_amdgcn_rcpf(bf_lo(gd[2 * n + 1])); f[3] *= __builtin_amdgcn_rcpf(bf_hi(gd[2 * n + 1]));
            }
            acc[ai][bj][m][n] *= f;
          }
          if (last) {
            const f32x4 v0 = acc[ai][bj][m][0], v1 = acc[ai][bj][m][1];
            u32x4 w = {pk2(v0[0], v0[1]), pk2(v0[2], v0[3]), pk2(v1[0], v1[1]), pk2(v1[2], v1[3])};
            *(u32x4*)(mrg + tok * DM + c) = w;
          }
        }
        asm volatile("" ::: "memory");
      }
  }
};

struct EpiResid {
  static constexpr bool PERM = true, AFTER_DRAIN = false;
  const float* xold; float* xout; u16* xb; float* ssq;
  DI void operator()(const f32x4 (&acc)[2][2][4][2], const Unit& u, int wr, int wc, int fr, int fq) const {
#pragma unroll
    for (int ai = 0; ai < 2; ++ai)
#pragma unroll
      for (int m = 0; m < 4; ++m) {
        const size_t tok = (size_t)u.pm * 256 + 128 * ai + 64 * wr + 16 * m + fr;
        float ss = 0.f;
#pragma unroll
        for (int bj = 0; bj < 2; ++bj) {
          const size_t o = tok * DM + u.pn * 256 + 128 * bj + 32 * wc + 8 * fq;
          const f32x4 v0 = *(const f32x4*)(xold + o) + acc[ai][bj][m][0];
          const f32x4 v1 = *(const f32x4*)(xold + o + 4) + acc[ai][bj][m][1];
          *(f32x4*)(xout + o) = v0;
          *(f32x4*)(xout + o + 4) = v1;
          u32x4 w = {pk2(v0[0], v0[1]), pk2(v0[2], v0[3]), pk2(v1[0], v1[1]), pk2(v1[2], v1[3])};
          *(u32x4*)(xb + o) = w;
          ss += ((v0[0] * v0[0] + v0[1] * v0[1]) + (v0[2] * v0[2] + v0[3] * v0[3])) + ((v1[0] * v1[0] + v1[1] * v1[1]) + (v1[2] * v1[2] + v1[3] * v1[3]));
        }
        ss += __shfl_xor(ss, 16); ss += __shfl_xor(ss, 32);
        if (fq == 0) ssq[tok * 16 + u.pn * 4 + wc] = ss;
        asm volatile("" ::: "memory");
      }
  }
};

template <class Epi>
DI void run_merge(PG8_LAS unsigned char* lds, const u16* ybase, const u16* wbase, const Epi& E) {
  int K = 256; asm volatile("" : "+s"(K));
  pg8::Gemm g; g.A = ybase; g.Bt = wbase; g.M = TC; g.N = DM; g.K = K;
  MergeOrder S; S.init(TC, DM, (int)gridDim.x, (int)blockIdx.x); S.ybase = ybase; S.wbase = wbase;
  pg8::gemm_phase<Epi, MergeOrder, false>(lds, g, S, E, nullptr);
}
template <class Epi>
DI void run_gemm(PG8_LAS unsigned char* lds, const u16* A, const u16* Bt, int M, int N, int K, const Epi& E, int probe = 0) {
  asm volatile("" : "+s"(K));
  pg8::Gemm g; g.A = A; g.Bt = Bt; g.M = M; g.N = N; g.K = K;
  pg8::StaticOrder S; S.init(M, N, (int)gridDim.x, (int)blockIdx.x); S.probe = probe;
  pg8::gemm_phase<Epi, pg8::StaticOrder, false>(lds, g, S, E, nullptr);
}

DI void cvt_load(const float* __restrict__ src, int N, int k0, int n0, const float* __restrict__ g, float* t, int ht) {
  const int c4 = (ht & 15) * 4;
#pragma unroll
  for (int i = 0; i < 4; ++i) {
    const int kk = (ht >> 4) + 16 * i;
    f32x4 v = *(const f32x4*)(src + (size_t)(k0 + kk) * N + n0 + c4);
    const float sc = g ? g[k0 + kk] : 1.0f;
    t[kk * 65 + c4 + 0] = v[0] * sc; t[kk * 65 + c4 + 1] = v[1] * sc; t[kk * 65 + c4 + 2] = v[2] * sc; t[kk * 65 + c4 + 3] = v[3] * sc;
  }
}
DI void cvt_store(u16* __restrict__ dst, int ldk, int kdst, int d0, int d1, const float* t, int ht) {
  const int kc = (ht & 7) * 8, nn = ht >> 3;
#pragma unroll
  for (int i = 0; i < 2; ++i) {
    const int tn = nn + 32 * i, row = (i == 0) ? d0 + nn : d1 + nn;
    u32x4 w;
    w[0] = pk2(t[(kc + 0) * 65 + tn], t[(kc + 1) * 65 + tn]);
    w[1] = pk2(t[(kc + 2) * 65 + tn], t[(kc + 3) * 65 + tn]);
    w[2] = pk2(t[(kc + 4) * 65 + tn], t[(kc + 5) * 65 + tn]);
    w[3] = pk2(t[(kc + 6) * 65 + tn], t[(kc + 7) * 65 + tn]);
    *(u32x4*)(dst + (size_t)row * ldk + kdst + kc) = w;
  }
}
struct CvtJob { const float* src; int N, k0, n0; const float* g; u16* dst; int ldk, d0, d1, kd; };
DI CvtJob cvt_job(const Params& p, int l, int ti) {
  CvtJob j; j.g = nullptr; j.kd = -1;
  const float* attn_g = p.in[1] + l * DM;
  if (ti < 608) { const int h = ti >> 4, kt = ti & 15; j.src = p.in[2] + (size_t)l * DM * INC; j.N = INC; j.k0 = kt * 64; j.n0 = qk_head_col(h); j.g = attn_g;
    j.dst = (u16*)(p.ws + OFF_WQKG) + (size_t)l * NQKG * DM; j.ldk = DM; j.d0 = (h >> 2) * 256 + (h & 3) * 32; j.d1 = j.d0 + 128; return j; }
  ti -= 608;
  if (ti < 1024) { const int c = ti >> 4, kt = ti & 15; j.src = p.in[2] + (size_t)l * DM * INC; j.N = INC; j.k0 = kt * 64; j.n0 = 3456 + 64 * c; j.g = attn_g;
    j.dst = (u16*)(p.ws + OFF_WQKG) + (size_t)l * NQKG * DM; j.ldk = DM; j.d0 = 2560 + 64 * c; j.d1 = j.d0 + 32; return j; }
  ti -= 1024;
  if (ti < 256) { const int vh = ti >> 4, kt = ti & 15; j.src = p.in[2] + (size_t)l * DM * INC; j.N = INC; j.k0 = kt * 64; j.n0 = v_head_col(vh); j.g = attn_g;
    j.dst = (u16*)(p.ws + OFF_WV) + (size_t)l * DM * DM; j.ldk = DM; j.d0 = vh * 64; j.d1 = j.d0 + 32; return j; }
  ti -= 256;
  if (ti < 128) { j.src = p.in[11] + (size_t)l * 512 * DM; j.N = DM; j.k0 = (ti >> 4) * 64; j.n0 = (ti & 15) * 64; j.dst = (u16*)(p.ws + OFF_WBR5) + ((size_t)l * 5 + (j.k0 >> 8)) * DM * 256; j.ldk = 256; j.kd = j.k0 & 255; j.d0 = j.n0; j.d1 = j.n0 + 32; return j; }
  ti -= 128;
  if (ti < 32) { j.src = p.in[12] + (size_t)l * 128 * DM; j.N = DM; j.k0 = (ti >> 4) * 64; j.n0 = (ti & 15) * 64; j.dst = (u16*)(p.ws + OFF_WBR5) + ((size_t)l * 5 + 2) * DM * 256; j.ldk = 256; j.kd = j.k0; j.d0 = j.n0; j.d1 = j.n0 + 32; return j; }
  ti -= 32;
  if (ti < 64) { j.src = p.in[13] + (size_t)l * 256 * DM; j.N = DM; j.k0 = (ti >> 4) * 64; j.n0 = (ti & 15) * 64; j.dst = (u16*)(p.ws + OFF_WBR5) + ((size_t)l * 5 + 3) * DM * 256; j.ldk = 256; j.kd = j.k0; j.d0 = j.n0; j.d1 = j.n0 + 32; return j; }
  ti -= 64;
  if (ti < 64) { j.src = p.in[14] + (size_t)l * 256 * DM; j.N = DM; j.k0 = (ti >> 4) * 64; j.n0 = (ti & 15) * 64; j.dst = (u16*)(p.ws + OFF_WBR5) + ((size_t)l * 5 + 4) * DM * 256; j.ldk = 256; j.kd = j.k0; j.d0 = j.n0; j.d1 = j.n0 + 32; return j; }
  ti -= 64;
  if (ti < 256) { j.src = p.in[15] + (size_t)l * DM * DM; j.N = DM; j.k0 = (ti >> 4) * 64; j.n0 = (ti & 15) * 64; j.dst = (u16*)(p.ws + OFF_WOUT) + (size_t)l * DM * DM; j.ldk = DM; j.d0 = j.n0; j.d1 = j.n0 + 32; return j; }
  ti -= 256;
  if (ti < 1024) { j.src = p.in[17] + (size_t)l * DM * DMLP; j.N = DMLP; j.k0 = (ti >> 6) * 64; j.n0 = (ti & 63) * 64; j.g = p.in[16] + l * DM;
    j.dst = (u16*)(p.ws + OFF_WUP) + (size_t)l * DMLP * DM; j.ldk = DM; j.d0 = j.n0; j.d1 = j.n0 + 32; return j; }
  ti -= 1024;
  j.src = p.in[18] + (size_t)l * DMLP * DM; j.N = DM; j.k0 = (ti >> 4) * 64; j.n0 = (ti & 15) * 64; j.dst = (u16*)(p.ws + OFF_WDN) + (size_t)l * DM * DMLP; j.ldk = DMLP; j.d0 = j.n0; j.d1 = j.n0 + 32; return j;
}

__device__ void phase_prep(const Params& p, int tid_, int bid_, int nblk_, unsigned char* smem) {
  const int half = tid_ >> 8, ht = tid_ & 255;
  float* t = (float*)smem + half * (64 * 65);
  const int per_layer = 4480, total = 2 * per_layer;
  for (int jp = bid_; jp * 2 < total; jp += nblk_) {
    const int j = jp * 2 + half;
    const bool on = j < total;
    CvtJob job;
    if (on) { job = cvt_job(p, j / per_layer, j % per_layer); cvt_load(job.src, job.N, job.k0, job.n0, job.g, t, ht); }
    __syncthreads();
    if (on) cvt_store(job.dst, job.ldk, (job.kd >= 0) ? job.kd : job.k0, job.d0, job.d1, t, ht);
    __syncthreads();
  }
  {
    const u32x4 z = {0u, 0u, 0u, 0u};
    for (int e = bid_ * NTHR + tid_; e < 2 * 128 * 128; e += nblk_ * NTHR) {
      const int l = e >> 14, r = (e >> 7) & 127, c = (e & 127) * 8;
      const int row = 9 * 256 + ((r < 64) ? 64 + r : 128 + r);
      *(u32x4*)((u16*)(p.ws + OFF_WQKG) + ((size_t)l * NQKG + row) * DM + c) = z;
    }
    for (int e = bid_ * NTHR + tid_; e < 2 * 1024 * 16; e += nblk_ * NTHR) {
      const int l = e >> 14, r = (e >> 4) & 1023, c = 128 + (e & 15) * 8;
      *(u32x4*)((u16*)(p.ws + OFF_WBR5) + (((size_t)l * 5 + 2) * DM + r) * 256 + c) = z;
    }
  }
  float* rope = (float*)(p.ws + OFF_ROPE);
  for (int e = bid_ * NTHR + tid_; e < SEQ * 48; e += nblk_ * NTHR) {
    const int pos = e / 48, i = e % 48;
    float inv;
    if (i < 32) inv = exp2f(-13.287712379549449f * (float)(2 * i) / 64.0f);
    else inv = exp2f(-13.287712379549449f * (float)(2 * (i - 32)) / 32.0f);
    const float angf = (float)pos * inv;
    const double ang = (double)angf;
    const double n = rint(ang * 0.15915494309189535);
    const float r = (float)(ang - n * 6.283185307179586);
    const float c = cosf(r), s = sinf(r);
    if (i < 32) { rope[pos * 96 + i] = c; rope[pos * 96 + 32 + i] = s; }
    else { rope[pos * 96 + 64 + (i - 32)] = c; rope[pos * 96 + 80 + (i - 32)] = s; }
  }
  u16* XB = (u16*)(p.ws + OFF_XB); float* SSQ = (float*)(p.ws + OFF_SSQ);
  const int lane = tid_ & 63;
  const int gw = bid_ * 8 + (tid_ >> 6), nw = nblk_ * 8;
  for (int row = gw; row < T; row += nw) {
    const float* xr = p.in[0] + (size_t)row * DM;
    float ss = 0.f;
#pragma unroll
    for (int i = 0; i < 4; ++i) {
      const f32x4 v = *(const f32x4*)(xr + i * 256 + lane * 4);
      ss += v[0] * v[0] + v[1] * v[1] + v[2] * v[2] + v[3] * v[3];
      u32x2 w = {pk2(v[0], v[1]), pk2(v[2], v[3])};
      *(u32x2*)(XB + (size_t)row * DM + i * 256 + lane * 4) = w;
    }
#pragma unroll
    for (int o = 32; o >= 1; o >>= 1) ss += __shfl_xor(ss, o);
    if (lane < 16) SSQ[(size_t)row * 16 + lane] = (lane == 0) ? ss : 0.f;
  }
}

DI void attn_softmax_pv(f32x16& S, float& m, float& l, f32x16& O0, f32x16& O1, const bf16x8 (&vf)[2][2]) {
  float mx = S[0];
#pragma unroll
  for (int i = 1; i < 16; ++i) mx = fmaxf(mx, S[i]);
  mx = fmaxf(mx, __shfl_xor(mx, 32));
  const float mn = fmaxf(m, mx);
  const float alpha = fexp2(m - mn);
  m = mn;
  float sum = 0.f;
#pragma unroll
  for (int i = 0; i < 16; ++i) { S[i] = fexp2(S[i] - mn); sum += S[i]; }
  l = l * alpha + sum;
  const u32x4 p0 = {pk2(S[0], S[1]), pk2(S[2], S[3]), pk2(S[4], S[5]), pk2(S[6], S[7])};
  const u32x4 p1 = {pk2(S[8], S[9]), pk2(S[10], S[11]), pk2(S[12], S[13]), pk2(S[14], S[15])};
#pragma unroll
  for (int i = 0; i < 16; ++i) { O0[i] *= alpha; O1[i] *= alpha; }
  O0 = MFMA32(vf[0][0], as_bf8(p0), O0);
  O0 = MFMA32(vf[0][1], as_bf8(p1), O0);
  O1 = MFMA32(vf[1][0], as_bf8(p0), O1);
  O1 = MFMA32(vf[1][1], as_bf8(p1), O1);
}
DI void attn_fixed_pv(f32x16& S, f32x16& L, f32x16& O0, f32x16& O1, const bf16x8 (&vf)[2][2], const bf16x8 ones) {
#pragma unroll
  for (int i = 0; i < 16; ++i) S[i] = fexp2(S[i]);
  const u32x4 p0 = {pk2(S[0], S[1]), pk2(S[2], S[3]), pk2(S[4], S[5]), pk2(S[6], S[7])};
  const u32x4 p1 = {pk2(S[8], S[9]), pk2(S[10], S[11]), pk2(S[12], S[13]), pk2(S[14], S[15])};
  O0 = MFMA32(vf[0][0], as_bf8(p0), O0);
  O0 = MFMA32(vf[0][1], as_bf8(p1), O0);
  O1 = MFMA32(vf[1][0], as_bf8(p0), O1);
  O1 = MFMA32(vf[1][1], as_bf8(p1), O1);
  float sum = 0.f;
#pragma unroll
  for (int i = 0; i < 16; ++i) sum += S[i];
  L[0] += sum;
}
DI void attn_plain_pv(f32x16& S, float& l, f32x16& O0, f32x16& O1, const bf16x8 (&vf)[2][2]) {
  float sum = 0.f;
#pragma unroll
  for (int i = 0; i < 16; ++i) { S[i] = fexp2(S[i]); sum += S[i]; }
  l += sum;
  const u32x4 p0 = {pk2(S[0], S[1]), pk2(S[2], S[3]), pk2(S[4], S[5]), pk2(S[6], S[7])};
  const u32x4 p1 = {pk2(S[8], S[9]), pk2(S[10], S[11]), pk2(S[12], S[13]), pk2(S[14], S[15])};
  O0 = MFMA32(vf[0][0], as_bf8(p0), O0); O1 = MFMA32(vf[1][0], as_bf8(p0), O1);
  O0 = MFMA32(vf[0][1], as_bf8(p1), O0); O1 = MFMA32(vf[1][1], as_bf8(p1), O1);
}
DI float gain_bound64(const float* g) {
  float a = 0.f, b = 0.f;
  for (int i = 0; i < 64; ++i) { a = fmaxf(a, fabsf(g[i])); b = fmaxf(b, fabsf(g[64 + i])); }
  return fminf(8.0f * a * b * 1.02f + 0.05f, 40.0f);
}
DI void load_vf(bf16x8 (&vf)[2][2], const u16* V, int kb, int lane) {
#pragma unroll
  for (int rb = 0; rb < 2; ++rb)
#pragma unroll
    for (int s = 0; s < 2; ++s) vf[rb][s] = *(const bf16x8*)(V + ((size_t)((kb * 2 + rb) * 2 + s) * 64 + lane) * 8);
}
DI void load_kf4(bf16x8 (&kf)[4], const u16* K, int kb, int lane) {
#pragma unroll
  for (int s = 0; s < 4; ++s) kf[s] = *(const bf16x8*)(K + ((size_t)(kb * 4 + s) * 64 + lane) * 8);
}
DI void load_kf2(bf16x8 (&kf)[2], const u16* K, int kb, int lane) {
#pragma unroll
  for (int s = 0; s < 2; ++s) kf[s] = *(const bf16x8*)(K + ((size_t)(kb * 2 + s) * 64 + lane) * 8);
}
DI void zero16(f32x16& a) {
#pragma unroll
  for (int i = 0; i < 16; ++i) a[i] = 0.f;
}
DI void store_o(u16* yrow, const f32x16& O0, const f32x16& O1, float sc, int h) {
#pragma unroll
  for (int g4 = 0; g4 < 4; ++g4) {
    u32x2 w0 = {pk2(O0[4 * g4] * sc, O0[4 * g4 + 1] * sc), pk2(O0[4 * g4 + 2] * sc, O0[4 * g4 + 3] * sc)};
    *(u32x2*)(yrow + 8 * g4 + 4 * h) = w0;
    u32x2 w1 = {pk2(O1[4 * g4] * sc, O1[4 * g4 + 1] * sc), pk2(O1[4 * g4 + 2] * sc, O1[4 * g4 + 3] * sc)};
    *(u32x2*)(yrow + 32 + 8 * g4 + 4 * h) = w1;
  }
}

__device__ void phase_attn(const Params& p, int tid_, int bid_, int nblk_, int layer) {
  const u16* QK = (const u16*)(p.ws + OFF_QK);
  const u16* VB = (const u16*)(p.ws + OFF_V);
  u16* Y5 = (u16*)(p.ws + OFF_Y5);
  u16* BO = (u16*)(p.ws + OFF_BO);
  float* LSE = (float*)(p.ws + OFF_LSE);
  const int lane = tid_ & 63, wave = tid_ >> 6;
  const int fr = lane & 31, fh = lane >> 5;
  const int nloc = nblk_ >> 3;
  if ((int)(bid_ >> 3) >= nloc) return;
  const int vw = ((bid_ & 7) * nloc + (bid_ >> 3)) * 8 + wave, NW = nloc * 64;
  const size_t GS = (size_t)TC * 64;
  const size_t BS = (size_t)SEQ * 64;

  {
    const float* lp = p.in[7] + layer * 128;
    float d01 = 0.f, d23 = 0.f;
    for (int i = 0; i < 32; ++i) { d01 += lp[i] * lp[32 + i]; d23 += lp[64 + i] * lp[96 + i]; }
    const float lambda_init = (layer == 0) ? 0.2f : 0.35550907f;
    const float lam = __expf(d01) - __expf(d23) + lambda_init;
    const float* subg = p.in[8] + layer * 64;
    const float sc = 0.17677669529663687f * LOG2E;
    float gqm = 0.f, gkm = 0.f;
    for (int i = 0; i < 32; ++i) { gqm = fmaxf(gqm, fabsf(p.in[6][layer * 64 + i])); gkm = fmaxf(gkm, fabsf(p.in[6][layer * 64 + 32 + i])); }
    const unsigned onev = ((fr & 27) == 0) ? 0x3f803f80u : 0u;
    const u32x4 ones4 = {onev, onev, onev, onev};
    const bf16x8 ones = as_bf8(ones4);
    const float cbound = 5.6568542f * gqm * gkm * 1.02f + 0.05f;
    for (int it = vw; it < BC * 4 * 128; it += NW) {
      const int bl = it >> 9, head = (it >> 7) & 3, qblk = it & 127;
      const u16* Q0 = QK + (22 + head) * GS + bl * BS; const u16* Q1 = Q0 + SEQ * 32;
      const u16* K0 = QK + (26 + head) * GS + bl * BS; const u16* K1 = K0 + SEQ * 32;
      const u16* V = VB + (8 + head) * GS + bl * BS;
      bf16x8 q0[2], q1[2];
      load_kf2(q0, Q0, qblk, lane); load_kf2(q1, Q1, qblk, lane);
      f32x16 L0, L1; zero16(L0); zero16(L1);
      f32x16 O00, O01, O10, O11; zero16(O00); zero16(O01); zero16(O10); zero16(O11);
      bf16x8 k0[2], k1[2], vf[2][2];
      {
        const float mb2 = fminf(cbound, 40.0f) * LOG2E;
        f32x16 sinit;
#pragma unroll
        for (int i = 0; i < 16; ++i) sinit[i] = -mb2;
        load_kf2(k0, K0, 0, lane); load_kf2(k1, K1, 0, lane); load_vf(vf, V, 0, lane);
        f32x16 S0 = sinit, S1 = sinit;
        S0 = MFMA32(k0[0], q0[0], S0); S0 = MFMA32(k0[1], q0[1], S0);
        S1 = MFMA32(k1[0], q1[0], S1); S1 = MFMA32(k1[1], q1[1], S1);
        load_kf2(k0, K0, 1, lane); load_kf2(k1, K1, 1, lane);
        for (int kb = 0; kb < 128; ++kb) {
          bf16x8 nk0[2], nk1[2], nvf[2][2];
          const int k2 = (kb + 2 < 128) ? kb + 2 : 127, v1 = (kb + 1 < 128) ? kb + 1 : 127;
          load_kf2(nk0, K0, k2, lane); load_kf2(nk1, K1, k2, lane); load_vf(nvf, V, v1, lane);
          f32x16 S0n = sinit, S1n = sinit;
#pragma unroll
          for (int i = 0; i < 16; ++i) S0[i] = fexp2(S0[i]);
          S0n = MFMA32(k0[0], q0[0], S0n); S0n = MFMA32(k0[1], q0[1], S0n);
          {
            const u32x4 p0 = {pk2(S0[0], S0[1]), pk2(S0[2], S0[3]), pk2(S0[4], S0[5]), pk2(S0[6], S0[7])};
            const u32x4 p1 = {pk2(S0[8], S0[9]), pk2(S0[10], S0[11]), pk2(S0[12], S0[13]), pk2(S0[14], S0[15])};
            O00 = MFMA32(vf[0][0], as_bf8(p0), O00); O01 = MFMA32(vf[1][0], as_bf8(p0), O01);
            O00 = MFMA32(vf[0][1], as_bf8(p1), O00); O01 = MFMA32(vf[1][1], as_bf8(p1), O01);
            float sum = 0.f;
#pragma unroll
            for (int i = 0; i < 16; ++i) sum += S0[i];
            L0[0] += sum;
          }
#pragma unroll
          for (int i = 0; i < 16; ++i) S1[i] = fexp2(S1[i]);
          S1n = MFMA32(k1[0], q1[0], S1n); S1n = MFMA32(k1[1], q1[1], S1n);
          {
            const u32x4 p0 = {pk2(S1[0], S1[1]), pk2(S1[2], S1[3]), pk2(S1[4], S1[5]), pk2(S1[6], S1[7])};
            const u32x4 p1 = {pk2(S1[8], S1[9]), pk2(S1[10], S1[11]), pk2(S1[12], S1[13]), pk2(S1[14], S1[15])};
            O10 = MFMA32(vf[0][0], as_bf8(p0), O10); O11 = MFMA32(vf[1][0], as_bf8(p0), O11);
            O10 = MFMA32(vf[0][1], as_bf8(p1), O10); O11 = MFMA32(vf[1][1], as_bf8(p1), O11);
            float sum = 0.f;
#pragma unroll
            for (int i = 0; i < 16; ++i) sum += S1[i];
            L1[0] += sum;
          }
          S0 = S0n; S1 = S1n;
#pragma unroll
          for (int s = 0; s < 2; ++s) { k0[s] = nk0[s]; k1[s] = nk1[s]; vf[0][s] = nvf[0][s]; vf[1][s] = nvf[1][s]; }
        }
      }
      const float i0 = 1.0f / (L0[0] + __shfl_xor(L0[0], 32));
      const float i1 = lam / (L1[0] + __shfl_xor(L1[0], 32));
      float ss = 0.f;
#pragma unroll
      for (int i = 0; i < 16; ++i) {
        O00[i] = O00[i] * i0 - O10[i] * i1; O01[i] = O01[i] * i0 - O11[i] * i1;
        ss += O00[i] * O00[i] + O01[i] * O01[i];
      }
      ss += __shfl_xor(ss, 32);
      const float rn = rsqrtf(ss * (1.0f / 64.0f) + 1e-6f) * (1.0f - lambda_init);
#pragma unroll
      for (int g4 = 0; g4 < 4; ++g4) {
        const f32x4 ga = *(const f32x4*)(subg + 8 * g4 + 4 * fh);
        const f32x4 gb = *(const f32x4*)(subg + 32 + 8 * g4 + 4 * fh);
#pragma unroll
        for (int e = 0; e < 4; ++e) { O00[4 * g4 + e] *= ga[e]; O01[4 * g4 + e] *= gb[e]; }
      }
      const size_t tok = (size_t)bl * SEQ + qblk * 32 + fr;
      store_o(Y5 + (size_t)3 * TC * 256 + tok * 256 + head * 64, O00, O01, rn, fh);
    }
  }
  {
    const float mbA = gain_bound64(p.in[3] + layer * 128) * LOG2E;
    f32x16 sinit;
#pragma unroll
    for (int i = 0; i < 16; ++i) sinit[i] = -mbA;
    for (int it = vw; it < BC * 8 * 128; it += NW) {
      const int bl = it >> 10, hq = (it >> 7) & 7, qblk = it & 127;
      const int kvh = hq >> 2;
      const u16* Q = QK + (size_t)hq * GS + bl * BS;
      const u16* K = QK + (size_t)(8 + kvh) * GS + bl * BS;
      const u16* V = VB + (size_t)kvh * GS + bl * BS;
      bf16x8 qf[4]; load_kf4(qf, Q, qblk, lane);
      float l = (fh == 0) ? fexp2(p.in[4][layer * 8 + hq] * LOG2E - mbA) : 0.0f;
      f32x16 O0, O1; zero16(O0); zero16(O1);
      const int kb_lo = (qblk - 4 < 0) ? 0 : qblk - 4, kb_hi = (qblk + 4 > 127) ? 127 : qblk + 4;
      const int qpos = qblk * 32 + fr;
      for (int kb = kb_lo; kb <= kb_hi; ++kb) {
        bf16x8 kf[4], vf[2][2];
        load_kf4(kf, K, kb, lane); load_vf(vf, V, kb, lane);
        f32x16 S = sinit;
#pragma unroll
        for (int s = 0; s < 4; ++s) S = MFMA32(kf[s], qf[s], S);
#pragma unroll
        for (int i = 0; i < 16; ++i) {
          const int dlt = kb * 32 + crow(i, fh) - qpos;
          S[i] = (dlt <= 128 && dlt >= -128) ? S[i] : (-__builtin_inff());
        }
        attn_plain_pv(S, l, O0, O1, vf);
      }
      const float inv = 1.0f / (l + __shfl_xor(l, 32));
      const size_t tok = (size_t)bl * SEQ + qpos;
      store_o(Y5 + (size_t)(hq >> 2) * TC * 256 + tok * 256 + (hq & 3) * 64, O0, O1, inv, fh);
    }
  }
  {
    const float gbD = gain_bound64(p.in[9] + layer * 128);
    for (int it = vw; it < BC * 4 * 128; it += NW) {
      const int bl = it >> 9, head = (it >> 7) & 3, qblk = it & 127;
      const u16* Q = QK + (size_t)(30 + head) * GS + bl * BS;
      const u16* K = QK + (size_t)(34 + head) * GS + bl * BS;
      const u16* V = VB + (size_t)(12 + head) * GS + bl * BS;
      const float* rpb = p.in[10] + (size_t)(layer * 4 + head) * 15 * 31;
      bf16x8 qf[4]; load_kf4(qf, Q, qblk, lane);
      float bmax = 0.f;
      for (int i = lane; i < 15 * 31; i += 64) bmax = fmaxf(bmax, fabsf(rpb[i]));
#pragma unroll
      for (int o = 32; o >= 1; o >>= 1) bmax = fmaxf(bmax, __shfl_xor(bmax, o));
      const float mbD = fminf(gbD + bmax, 60.0f) * LOG2E;
      f32x16 sinit;
#pragma unroll
      for (int i = 0; i < 16; ++i) sinit[i] = -mbD;
      float l = 0.f;
      f32x16 O0, O1; zero16(O0); zero16(O1);
      const int qrow = qblk >> 1, qc = (qblk & 1) * 32 + fr;
      int r0 = qrow - 4; r0 = r0 < 0 ? 0 : (r0 > 56 ? 56 : r0);
      int c0 = qc - 8; c0 = c0 < 0 ? 0 : (c0 > 48 ? 48 : c0);
      for (int kk = 0; kk < 16; ++kk) {
        const int krow_ = r0 + (kk >> 1), hb = kk & 1, kb = krow_ * 2 + hb;
        bf16x8 kf[4], vf[2][2];
        load_kf4(kf, K, kb, lane); load_vf(vf, V, kb, lane);
        f32x16 S = sinit;
#pragma unroll
        for (int s = 0; s < 4; ++s) S = MFMA32(kf[s], qf[s], S);
        const float* brow = rpb + (krow_ - qrow + 7) * 31;
#pragma unroll
        for (int i = 0; i < 16; ++i) {
          const int kc = hb * 32 + crow(i, fh);
          int dc = kc - qc; dc = dc < -15 ? -15 : (dc > 15 ? 15 : dc);
          const float bias = brow[dc + 15];
          S[i] = (kc >= c0 && kc < c0 + 16) ? __builtin_fmaf(bias, LOG2E, S[i]) : (-__builtin_inff());
        }
        attn_plain_pv(S, l, O0, O1, vf);
      }
      const float inv = 1.0f / (l + __shfl_xor(l, 32));
      const size_t tok = (size_t)bl * SEQ + qblk * 32 + fr;
      store_o(Y5 + (size_t)4 * TC * 256 + tok * 256 + head * 64, O0, O1, inv, fh);
    }
  }
  {
    const float mbB = gain_bound64(p.in[5] + layer * 128) * LOG2E;
    f32x16 sinit;
#pragma unroll
    for (int i = 0; i < 16; ++i) sinit[i] = -mbB;
    for (int it = vw; it < BC * 6 * 128; it += NW) {
      const int bl = it / 768, rem = it % 768, head = rem >> 7, qblk = rem & 127;
      const int dil = dil_of(head >> 1), L = SEQ / dil, LB = L >> 5;
      const u16* Q = QK + (size_t)(10 + head) * GS + bl * BS;
      const u16* K = QK + (size_t)(16 + head) * GS + bl * BS;
      const u16* V = VB + (size_t)(2 + head) * GS + bl * BS;
      bf16x8 qf[4]; load_kf4(qf, Q, qblk, lane);
      float l = 0.f;
      f32x16 O0, O1; zero16(O0); zero16(O1);
      const int rsub = qblk / LB;
      const int lo = rsub * LB, hi = lo + LB - 1;
      const int kb_lo = (qblk - 2 < lo) ? lo : qblk - 2, kb_hi = (qblk + 2 > hi) ? hi : qblk + 2;
      const int qd = qblk * 32 + fr;
      for (int kb = kb_lo; kb <= kb_hi; ++kb) {
        bf16x8 kf[4], vf[2][2];
        load_kf4(kf, K, kb, lane); load_vf(vf, V, kb, lane);
        f32x16 S = sinit;
#pragma unroll
        for (int s = 0; s < 4; ++s) S = MFMA32(kf[s], qf[s], S);
#pragma unroll
        for (int i = 0; i < 16; ++i) {
          const int dlt = kb * 32 + crow(i, fh) - qd;
          S[i] = (dlt <= 64 && dlt >= -64) ? S[i] : (-__builtin_inff());
        }
        attn_plain_pv(S, l, O0, O1, vf);
      }
      const float lt = l + __shfl_xor(l, 32);
      const float inv = 1.0f / lt;
      const int msub = qd - rsub * L;
      const int pos = msub * dil + rsub;
      const size_t tok = (size_t)bl * SEQ + pos;
      store_o(BO + tok * 384 + head * 64, O0, O1, inv, fh);
      if (fh == 0) LSE[tok * 8 + head] = __log2f(lt) + mbB;
    }
  }
}


__device__ void phase_bcombine(const Params& p, int tid_, int tok0) {
  const u16* BO = (const u16*)(p.ws + OFF_BO);
  const float* LSE = (const float*)(p.ws + OFF_LSE);
  u16* YB = (u16*)(p.ws + OFF_Y5) + (size_t)2 * TC * 256;
  for (int e = tid_; e < 256 * 16; e += NTHR) {
    const int tok = tok0 + (e >> 4), j = (e >> 3) & 1, c8 = (e & 7) * 8;
    const float a0 = LSE[(size_t)tok * 8 + j], a1 = LSE[(size_t)tok * 8 + 2 + j], a2 = LSE[(size_t)tok * 8 + 4 + j];
    const float mx = fmaxf(a0, fmaxf(a1, a2));
    float w0 = fexp2(a0 - mx), w1 = fexp2(a1 - mx), w2 = fexp2(a2 - mx);
    const float inv = 1.0f / (w0 + w1 + w2);
    w0 *= inv; w1 *= inv; w2 *= inv;
    const u32x4 x0 = *(const u32x4*)(BO + (size_t)tok * 384 + (0 + j) * 64 + c8);
    const u32x4 x1 = *(const u32x4*)(BO + (size_t)tok * 384 + (2 + j) * 64 + c8);
    const u32x4 x2 = *(const u32x4*)(BO + (size_t)tok * 384 + (4 + j) * 64 + c8);
    u32x4 o;
#pragma unroll
    for (int q = 0; q < 4; ++q) {
      const float lo = w0 * bf_lo(x0[q]) + w1 * bf_lo(x1[q]) + w2 * bf_lo(x2[q]);
      const float hi = w0 * bf_hi(x0[q]) + w1 * bf_hi(x1[q]) + w2 * bf_hi(x2[q]);
      o[q] = pk2(lo, hi);
    }
    *(u32x4*)(YB + (size_t)tok * 256 + j * 64 + c8) = o;
    const u32x4 z = {0u, 0u, 0u, 0u};
    *(u32x4*)(YB + (size_t)tok * 256 + 128 + (e & 15) * 8) = z;
  }
}

#define XB_TMO      128
#define XB_XCNT(j)  (256  + 64 * (j))
#define XB_XSUB(j)  (1280 + 64 * (j))
#define XB_XGEN(j)  (2304 + 64 * (j))
#define XB_TOP      3328
#define XB_TOPGEN   3392
#define XCD_BAR_WORDS 3456
#define XB_SPIN_CAP (1u << 22)
#define LAS __attribute__((address_space(3)))
DI unsigned xb_ld(unsigned* p)              { return __hip_atomic_load(p, __ATOMIC_RELAXED, __HIP_MEMORY_SCOPE_AGENT); }
DI unsigned xb_add(unsigned* p, unsigned v) { return __hip_atomic_fetch_add(p, v, __ATOMIC_RELAXED, __HIP_MEMORY_SCOPE_AGENT); }
DI unsigned xb_xcc_id() { return (unsigned)__builtin_amdgcn_s_getreg((3 << 11) | 20) & 0xFu; }
#define XB_SPIN(cond, bar) do { unsigned _sp = 0; while (cond) { __builtin_amdgcn_s_sleep(1); \
    if ((++_sp & 255u) == 0u) { if (xb_ld(&(bar)[XB_TMO])) break; if (_sp > XB_SPIN_CAP) { atomicAdd(&(bar)[XB_TMO], 1u); break; } } } } while (0)
struct XcdBarrier { unsigned* bar; unsigned x; volatile LAS unsigned* st; };
DI XcdBarrier xcd_barrier_post(unsigned* bar, volatile LAS unsigned* st) {
  XcdBarrier b; b.bar = bar; b.x = xb_xcc_id(); b.st = st;
  if (threadIdx.x == 0) (void)xb_add(&bar[XB_XCNT(b.x)], 1u);
  return b;
}
DI void xcd_barrier_complete(unsigned* bar, unsigned x, unsigned& nloc, unsigned& nx) {
  const unsigned G = gridDim.x * gridDim.y * gridDim.z;
  unsigned sum, cnt, mine, sp = 0u;
  for (;;) {
    sum = 0u; cnt = 0u; mine = 0u;
#pragma unroll
    for (unsigned j = 0; j < 16; ++j) { const unsigned c = xb_ld(&bar[XB_XCNT(j)]); sum += c; cnt += (c > 0u) ? 1u : 0u; mine = (j == x) ? c : mine; }
    if (sum == G) break;
    __builtin_amdgcn_s_sleep(1);
    if ((++sp & 255u) == 0u) { if (xb_ld(&bar[XB_TMO])) break; if (sp > XB_SPIN_CAP) { atomicAdd(&bar[XB_TMO], 1u); break; } }
  }
  nloc = mine > 0u ? mine : 1u; nx = cnt > 0u ? cnt : 1u;
}
DI void xcd_barrier(const XcdBarrier& b) {
  asm volatile("s_waitcnt vmcnt(0)" ::: "memory");
  __syncthreads();
  if (threadIdx.x == 0) {
    unsigned* bar = b.bar;
    __builtin_amdgcn_s_waitcnt(0);
    unsigned nloc = b.st[0], nx = b.st[1];
    if (nloc == 0u) { xcd_barrier_complete(bar, b.x, nloc, nx); b.st[0] = nloc; b.st[1] = nx; }
    const unsigned old = xb_add(&bar[XB_XSUB(b.x)], 1u);
    const unsigned gen = old / nloc;
    if (old + 1u == (gen + 1u) * nloc) {
      __builtin_amdgcn_fence(__ATOMIC_RELEASE, "agent");
      asm volatile("s_waitcnt vmcnt(0)" ::: "memory");
      const unsigned og = xb_add(&bar[XB_TOP], 1u);
      const unsigned tg = og / nx;
      if (og + 1u == (tg + 1u) * nx) xb_add(&bar[XB_TOPGEN], 1u);
      else XB_SPIN(xb_ld(&bar[XB_TOPGEN]) == tg, bar);
      __builtin_amdgcn_fence(__ATOMIC_ACQUIRE, "agent");
      xb_add(&bar[XB_XGEN(b.x)], 1u);
      asm volatile("s_waitcnt vmcnt(0)" ::: "memory");
    } else {
      XB_SPIN(xb_ld(&bar[XB_XGEN(b.x)]) == gen, bar);
      __builtin_amdgcn_fence(__ATOMIC_ACQUIRE, "agent");
      asm volatile("s_waitcnt vmcnt(0)" ::: "memory");
    }
  }
  __syncthreads();
}

__global__ void __launch_bounds__(NTHR, 2) mk_forward(Params p) {
  extern __shared__ __attribute__((aligned(16))) unsigned char smem[];
  cg::grid_group grid = cg::this_grid();
  volatile LAS unsigned* xbw = (volatile LAS unsigned*)(smem + LDS_STAGE);
  if (threadIdx.x < 4) xbw[threadIdx.x] = 0u;
  __syncthreads();
  XcdBarrier xb;
  if (FUSED) xb = xcd_barrier_post((unsigned*)(p.ws + OFF_BAR), xbw);
#if PROBE_CLOCK
  const unsigned long long pc_t0 = clock64(), pc_r0 = wall_clock64();
#endif
  PG8_LAS unsigned char* lds = (PG8_LAS unsigned char*)smem;
  for (int ph = p.ph_lo; ph < p.ph_hi; ++ph) {
#if DUPMASK
   for (int rep = 0; rep < ((ph > 0 && ((DUPMASK >> ((ph - 1) % 7)) & 1)) ? 2 : 1); ++rep)
#endif
   {
    int tid_ = threadIdx.x, bid_ = blockIdx.x, nblk_ = gridDim.x;
    asm volatile("" : "+v"(tid_));
    asm volatile("" : "+s"(bid_));
    asm volatile("" : "+s"(nblk_));
    Params pp = p;
    asm volatile("" : "+s"(pp.ws));
    asm volatile("" : "+s"(pp.out));
    unsigned char* ws = pp.ws;
    if (ph == 0) {
      if (PHMASK & 128) phase_prep(pp, tid_, bid_, nblk_, smem);
    } else {
      const int q = ph - 1, chunk = q / (2 * PPL), layer = (q % (2 * PPL)) / PPL, kk = q % PPL, k = (kk == 6) ? DUPK : (kk < 2 ? kk : kk + 1);
      const u16* XBc = (const u16*)(ws + OFF_XB) + (size_t)chunk * TC * DM;
      float* SSQc = (float*)(ws + OFF_SSQ) + (size_t)chunk * TC * 16;
      float* xc = pp.out + (size_t)chunk * TC * DM;
      if ((k == 0 && (PHMASK & 1)) || (k == 5 && (PHMASK & 32))) {
        const bool up = (k == 5);
        if (!up) {
          EpiQKG e; e.ssq = SSQc; e.qk = (u16*)(ws + OFF_QK); e.rope = (const float*)(ws + OFF_ROPE);
          e.gA = pp.in[3] + layer * 128; e.gB = pp.in[5] + layer * 128; e.gC = pp.in[6] + layer * 64; e.gD = pp.in[9] + layer * 128;
          run_gemm(lds, XBc, (const u16*)(ws + OFF_WQKG) + (size_t)layer * NQKG * DM, TC, 2560, DM, e);
        }
        {
          EpiGateUp e; e.ssq = SSQc; e.o = (u16*)(ws + OFF_GATE); e.mode = up ? ((PROBE_NOEPI && kk == 6) ? 2 : 1) : 0;
          const u16* W = up ? (const u16*)(ws + OFF_WUP) + (size_t)layer * DMLP * DM : (const u16*)(ws + OFF_WQKG) + ((size_t)layer * NQKG + 2560) * DM;
          run_gemm(lds, XBc, W, TC, 4096, DM, e, (PROBE_NOEPI && kk == 6) ? 1 : 0);
        }
        if (!up) {
          EpiVT ev; ev.ssq = SSQc; ev.vbuf = (u16*)(ws + OFF_V);
          run_gemm(lds, (const u16*)(ws + OFF_WV) + (size_t)layer * DM * DM, XBc, DM, TC, DM, ev);
        }
      } else if (k == 1 && (PHMASK & 2)) {
        phase_attn(pp, tid_, bid_, nblk_, layer);
      } else if (k == 3 && (PHMASK & 8)) {
        {
          Unit u0; pg8::StaticOrder S0; S0.init(TC, DM, nblk_, bid_); S0.next(0, u0);
          phase_bcombine(pp, tid_, u0.pm * 256);
          asm volatile("s_waitcnt vmcnt(0)" ::: "memory");
          __syncthreads();
        }
        EpiMerge e; e.gate = (const u16*)(ws + OFF_GATE); e.mrg = (u16*)(ws + OFF_MRG);
        run_merge(lds, (const u16*)(ws + OFF_Y5), (const u16*)(ws + OFF_WBR5) + (size_t)layer * 5 * DM * 256, e);
      } else if ((k == 4 && (PHMASK & 16)) || (k == 6 && (PHMASK & 64))) {
        const bool dn = (k == 6);
        EpiResid e; e.xold = (!dn && layer == 0) ? (pp.in[0] + (size_t)chunk * TC * DM) : xc; e.xout = xc; e.xb = (u16*)XBc; e.ssq = SSQc;
        const u16* A = dn ? (const u16*)(ws + OFF_GATE) : (const u16*)(ws + OFF_MRG);
        const u16* W = dn ? (const u16*)(ws + OFF_WDN) + (size_t)layer * DM * DMLP : (const u16*)(ws + OFF_WOUT) + (size_t)layer * DM * DM;
        run_gemm(lds, A, W, TC, DM, dn ? DMLP : DM, e);
      }
    }
   }
    if (ph + 1 < p.ph_hi) {
      if (ph == 0) grid.sync();
      else xcd_barrier(xb);
    }
  }
#if PROBE_CLOCK
  {
    xcd_barrier(xb);
    const unsigned long long pc_t1 = clock64(), pc_r1 = wall_clock64();
    const float ghz = (float)(pc_t1 - pc_t0) / ((float)(pc_r1 - pc_r0) * 10.0f);
    const int nrows = (int)(ghz * 0.25f * (float)T);
    for (int r = blockIdx.x; r < nrows; r += gridDim.x)
      for (int c = threadIdx.x; c < DM; c += NTHR) p.out[(size_t)r * DM + c] = 0.f;
  }
#endif
}

extern "C" void kernel_launch(void* const* d_in, const int* in_sizes, int n_in, void* d_out, int out_size, void* d_ws, size_t ws_size,
                              hipStream_t stream) {
  static int grid_blocks = 0;
  if (grid_blocks == 0) {
    if (n_in != 19 || out_size != T * DM || ws_size < WS_END) {
      fprintf(stderr, "kernel_launch: unexpected problem (n_in %d out %d ws %zu need %zu)\n", n_in, out_size, ws_size, (size_t)WS_END);
      grid_blocks = -1;
      return;
    }
    int dev = 0, cus = 0, per_cu = 0;
    (void)hipGetDevice(&dev);
    (void)hipDeviceGetAttribute(&cus, hipDeviceAttributeMultiprocessorCount, dev);
    if (hipFuncSetAttribute((const void*)mk_forward, hipFuncAttributeMaxDynamicSharedMemorySize, LDS_BYTES) != hipSuccess) {
      fprintf(stderr, "kernel_launch: hipFuncSetAttribute failed\n"); grid_blocks = -1; return;
    }
    (void)hipOccupancyMaxActiveBlocksPerMultiprocessor(&per_cu, mk_forward, NTHR, LDS_BYTES);
    if (per_cu < 1) fprintf(stderr, "kernel_launch: occupancy query says %d blocks per CU\n", per_cu);
    (void)hipGetLastError();
    grid_blocks = cus;
  }
  if (grid_blocks < 0) return;
  Params p{};
  for (int i = 0; i < 19; ++i) p.in[i] = (const float*)d_in[i];
  p.out = (float*)d_out;
  p.ws = (unsigned char*)d_ws;
#if FUSED
  (void)hipMemsetAsync((unsigned char*)d_ws + OFF_BAR, 0, XCD_BAR_WORDS * 4, stream);
  p.ph_lo = 0; p.ph_hi = NPHASE;
  void* args[] = {&p};
  hipError_t e = hipLaunchCooperativeKernel((const void*)mk_forward, dim3(grid_blocks), dim3(NTHR), args, LDS_BYTES, stream);
  if (e != hipSuccess) fprintf(stderr, "cooperative launch failed: %s (grid %d)\n", hipGetErrorString(e), grid_blocks);
#else
  for (int ph = 0; ph < NPHASE; ++ph) {
    p.ph_lo = ph; p.ph_hi = ph + 1;
    hipLaunchKernelGGL(mk_forward, dim3(grid_blocks), dim3(NTHR), LDS_BYTES, stream, p);
  }
#endif
}
```

```cpp
#include <hip/hip_runtime.h>
#include <hip/hip_cooperative_groups.h>
#include <cstdio>
namespace cg = cooperative_groups;

#ifndef PHMASK
#define PHMASK 255
#endif
#ifndef DUPMASK
#define DUPMASK 0
#endif
#ifndef DUPK
#define DUPK -1
#endif
#ifndef PROBE_CLOCK
#define PROBE_CLOCK 0
#endif
#ifndef PROBE_NOEPI
#define PROBE_NOEPI 0
#endif
#ifndef FUSED
#define FUSED 1
#endif

namespace pg8 {
#define PG8_LAS __attribute__((address_space(3)))
typedef unsigned short bf16_t;
typedef short bf16x8 __attribute__((ext_vector_type(8)));
typedef float f32x4 __attribute__((ext_vector_type(4)));
typedef unsigned u32x4 __attribute__((ext_vector_type(4)));
constexpr int BM = 256, BK = 64, HALF = 128, HTB = HALF * BK * 2  , STAGE_BYTES = 8 * HTB, NXCD = 8, WGM = 8;

__host__ __device__ __forceinline__ int lds_byte(int r, int c) { const int st = (r >> 4) * 2 + (c >> 5), rr = r & 15, cc = c & 31, ob = rr * 64 + cc * 2; return st * 1024 + (ob ^ (((ob >> 9) & 1) << 5)); }
__host__ __device__ __forceinline__ void stage_rc(int b, int& R, int& C) { const int st = b / 1024, sb = b % 1024, swz = sb ^ (((sb >> 9) & 1) << 5); R = (st >> 1) * 16 + swz / 64; C = (st & 1) * 32 + (swz % 64) / 2; }
__host__ __device__ __forceinline__ int perm32(int rho) { const int n = rho >> 4, i = rho & 15; return 8 * (i >> 2) + 4 * n + (i & 3); }

struct Unit { int pm, pn, seg; };
struct Gemm { const bf16_t* A; const bf16_t* Bt; int M, N, K; };

struct StaticOrder {
    int nM, nN, nwg, G, c, probe = 0;
    __host__ __device__ void init(int M, int N, int G_, int c_) { nM = M / BM; nN = N / BM; nwg = nM * nN; G = G_; c = c_; }
    __host__ __device__ bool next(int i, Unit& u) const {
        const long L = (long)i * G + c; if (L >= nwg) return false;
        int wgid = (int)L; { const int q = nwg / NXCD, r = nwg % NXCD, xcd = wgid % NXCD, off = wgid / NXCD; wgid = (xcd < r ? xcd * (q + 1) : r * (q + 1) + (xcd - r) * q) + off; }
        const int nig = WGM * nN, gid = wgid / nig, fm = gid * WGM, gsz = (nM - fm) < WGM ? (nM - fm) : WGM;
        u.pm = fm + ((wgid % nig) % gsz); u.pn = (wgid % nig) / gsz; u.seg = 0; if (probe) { u.pm = 0; u.pn = 0; } return true;
    }
    __device__ __forceinline__ void a_ready(const Unit&) const {}
    __device__ __forceinline__ void done(const Unit&) const {}
    __device__ __forceinline__ const char* baseA(const Gemm& g, const Unit& u, size_t tstep) const { return (const char*)g.A + (size_t)u.pm * tstep; }
    __device__ __forceinline__ const char* baseB(const Gemm& g, const Unit& u, size_t tstep) const { return (const char*)g.Bt + (size_t)u.pn * tstep; }
    __device__ __forceinline__ bool zero_after(const Unit&) const { return true; }
};

template <class Epi, class Sched, bool STAMP = false>
__device__ __forceinline__ void gemm_phase(PG8_LAS unsigned char* lds, const Gemm g, const Sched& S, const Epi& E, unsigned long long* stamps) {
    int tid = threadIdx.x; asm volatile("" : "+v"(tid));
    const int wid = __builtin_amdgcn_readfirstlane(tid >> 6), lane = tid & 63, wr = wid >> 2, wc = wid & 3, fr = lane & 15, fq = lane >> 4;
    const int K = g.K, nt = K / BK;
    int ts_lo = 0, ts_hi = 0, nts = 0; const unsigned long long rt_entry = STAMP ? (unsigned long long)wall_clock64() : 0ull;
#define PG8_STAMP() do { if (STAMP && wid == 0 && nts < 64) { const unsigned long long _c = (unsigned long long)clock64(); \
        ts_lo = (lane == nts) ? (int)(unsigned)_c : ts_lo; ts_hi = (lane == nts) ? (int)(unsigned)(_c >> 32) : ts_hi; ++nts; } } while (0)
    PG8_STAMP();
    unsigned voffA[2], voffB[2];
#pragma unroll
    for (int i = 0; i < 2; ++i) { int R, C; stage_rc(tid * 16 + i * 8192, R, C); const int Rb = Epi::PERM ? ((R & ~31) + perm32(R & 31)) : R;
        voffA[i] = (unsigned)(R * K + C) * 2u; voffB[i] = (unsigned)(Rb * K + C) * 2u; }
    const size_t kstep = (size_t)(BK * 2);
    const size_t hstep = (size_t)HALF * K * 2;
    const size_t tstep = 2 * hstep;
    const unsigned ldsw = (unsigned)wid * 1024u;
    const int aoff = lds_byte(wr * 64 + fr, fq * 8), boff = lds_byte(wc * 32 + fr, fq * 8);
#define PG8_SA(b, h) (((b) * 2 + (h)) * HTB)
#define PG8_SB(b, h) ((4 + (b) * 2 + (h)) * HTB)
#define PG8_STAGE(bufoff, gbase, voff) do { _Pragma("unroll") for (int _i = 0; _i < 2; ++_i) \
        __builtin_amdgcn_global_load_lds((const unsigned*)((const char*)(gbase) + (voff)[_i]), (PG8_LAS unsigned*)(lds + (bufoff) + ldsw + _i * 8192), 16, 0, 0); } while (0)
#define PG8_LDA(dst, b, h) do { _Pragma("unroll") for (int m = 0; m < 4; ++m) _Pragma("unroll") for (int k = 0; k < 2; ++k) dst[m][k] = *(const PG8_LAS bf16x8*)(lds + PG8_SA(b, h) + aoff + m * 2048 + k * 1024); } while (0)
#define PG8_LDB(dst, b, h) do { _Pragma("unroll") for (int n = 0; n < 2; ++n) _Pragma("unroll") for (int k = 0; k < 2; ++k) dst[n][k] = *(const PG8_LAS bf16x8*)(lds + PG8_SB(b, h) + boff + n * 2048 + k * 1024); } while (0)
#define PG8_MMA(ai, bj, At, Bt) do { __builtin_amdgcn_s_setprio(1); _Pragma("unroll") for (int m = 0; m < 4; ++m) _Pragma("unroll") for (int n = 0; n < 2; ++n) _Pragma("unroll") for (int k = 0; k < 2; ++k) \
        acc[ai][bj][m][n] = __builtin_amdgcn_mfma_f32_16x16x32_bf16(Bt[n][k], At[m][k], acc[ai][bj][m][n], 0, 0, 0); __builtin_amdgcn_s_setprio(0); } while (0)
#define PG8_WAIT_V(n) asm volatile("s_waitcnt vmcnt(" #n ")" ::: "memory")
#define PG8_WAIT_L(n) asm volatile("s_waitcnt lgkmcnt(" #n ")" ::: "memory")
#define PG8_BAR __builtin_amdgcn_s_barrier()
#define PG8_SCHED __builtin_amdgcn_sched_barrier(0)
    Unit cur, nxt; int ui = 0;
    if (!S.next(0, cur)) return;
    f32x4 acc[2][2][4][2];
#pragma unroll
    for (int a = 0; a < 2; ++a)
#pragma unroll
        for (int b = 0; b < 2; ++b)
#pragma unroll
            for (int m = 0; m < 4; ++m)
#pragma unroll
                for (int n = 0; n < 2; ++n) acc[a][b][m][n] = (f32x4){0.f, 0.f, 0.f, 0.f};
    bf16x8 At[4][2], B0[2][2], B1[2][2];
    const char* cA = S.baseA(g, cur, tstep); const char* cB = S.baseB(g, cur, tstep);
    S.a_ready(cur);
    PG8_STAGE(PG8_SB(0, 0), cB, voffB); PG8_STAGE(PG8_SA(0, 0), cA, voffA); PG8_STAGE(PG8_SB(0, 1), cB + hstep, voffB); PG8_STAGE(PG8_SA(0, 1), cA + hstep, voffA);
    if (wr == 1) PG8_BAR;
    PG8_WAIT_V(4); PG8_BAR;
    PG8_STAGE(PG8_SB(1, 0), cB + kstep, voffB); PG8_STAGE(PG8_SA(1, 0), cA + kstep, voffA); PG8_STAGE(PG8_SB(1, 1), cB + hstep + kstep, voffB);
    PG8_WAIT_V(6); PG8_BAR;
    PG8_STAMP();
    for (;;) {
        const bool has_next = S.next(ui + 1, nxt);
        const char* nA = has_next ? S.baseA(g, nxt, tstep) : cA; const char* nB = has_next ? S.baseB(g, nxt, tstep) : cB;
        for (int t = 0; t < nt; t += 2) {
            const bool last = (t == nt - 2);
            const char* a1 = cA + (size_t)(t + 1) * kstep;
            const char* a2 = last ? nA : cA + (size_t)(t + 2) * kstep; const char* b2 = last ? nB : cB + (size_t)(t + 2) * kstep;
            const char* a3 = a2 + kstep; const char* b3 = b2 + kstep;
            if (last && has_next) S.a_ready(nxt);
            PG8_LDB(B0, 0, 0); PG8_SCHED; PG8_LDA(At, 0, 0); PG8_STAGE(PG8_SA(1, 1), a1 + hstep, voffA);
            PG8_WAIT_L(8); PG8_BAR; PG8_WAIT_L(0); PG8_MMA(0, 0, At, B0); PG8_BAR; PG8_SCHED;
            PG8_LDB(B1, 0, 1); PG8_STAGE(PG8_SB(0, 0), b2, voffB);
            PG8_BAR; PG8_WAIT_L(0); PG8_MMA(0, 1, At, B1); PG8_BAR;
            PG8_LDA(At, 0, 1); PG8_STAGE(PG8_SA(0, 0), a2, voffA);
            PG8_BAR; PG8_WAIT_L(0); PG8_MMA(1, 0, At, B0); PG8_BAR; PG8_SCHED;
            PG8_STAGE(PG8_SB(0, 1), b2 + hstep, voffB);
            PG8_WAIT_V(6); PG8_BAR; PG8_MMA(1, 1, At, B1); PG8_BAR;
            PG8_LDB(B0, 1, 0); PG8_SCHED; PG8_LDA(At, 1, 0); PG8_STAGE(PG8_SA(0, 1), a2 + hstep, voffA);
            PG8_WAIT_L(8); PG8_BAR; PG8_WAIT_L(0); PG8_MMA(0, 0, At, B0); PG8_BAR; PG8_SCHED;
            PG8_LDB(B1, 1, 1); PG8_STAGE(PG8_SB(1, 0), b3, voffB);
            PG8_BAR; PG8_WAIT_L(0); PG8_MMA(0, 1, At, B1); PG8_BAR;
            PG8_LDA(At, 1, 1); PG8_STAGE(PG8_SA(1, 0), a3, voffA);
            PG8_BAR; PG8_WAIT_L(0); PG8_MMA(1, 0, At, B0); PG8_BAR; PG8_SCHED;
            PG8_STAGE(PG8_SB(1, 1), b3 + hstep, voffB);
            PG8_WAIT_V(6); PG8_BAR; PG8_MMA(1, 1, At, B1); PG8_BAR;
        }
        PG8_STAMP();
        if constexpr (!Epi::AFTER_DRAIN) { E(acc, cur, wr, wc, fr, fq); S.done(cur); }
        PG8_STAMP();
        if (!has_next) break;
        if (S.zero_after(cur))
#pragma unroll
        for (int a = 0; a < 2; ++a)
#pragma unroll
            for (int b = 0; b < 2; ++b)
#pragma unroll
                for (int m = 0; m < 4; ++m)
#pragma unroll
                    for (int n = 0; n < 2; ++n) acc[a][b][m][n] = (f32x4){0.f, 0.f, 0.f, 0.f};
        cur = nxt; cA = nA; cB = nB; ++ui;
    }
    PG8_WAIT_V(0);
    if (wr == 0) PG8_BAR;
    PG8_BAR;
    if constexpr (Epi::AFTER_DRAIN) { E.fused(acc, cur, wr, wc, fr, fq, lds, wid, lane); S.done(cur); }
    PG8_STAMP();
    if (STAMP && wid == 0) { stamps[lane] = lane < nts ? (((unsigned long long)(unsigned)ts_hi << 32) | (unsigned)ts_lo) : 0ull;
        if (lane == 62) stamps[62] = rt_entry; if (lane == 63) stamps[63] = (unsigned long long)wall_clock64(); }
#undef PG8_STAMP
#undef PG8_SA
#undef PG8_SB
#undef PG8_STAGE
#undef PG8_LDA
#undef PG8_LDB
#undef PG8_MMA
#undef PG8_WAIT_V
#undef PG8_WAIT_L
#undef PG8_BAR
#undef PG8_SCHED
}
}

typedef unsigned short u16;
typedef short bf16x8 __attribute__((ext_vector_type(8)));
typedef float f32x16 __attribute__((ext_vector_type(16)));
typedef float f32x4 __attribute__((ext_vector_type(4)));
typedef __bf16 bf2_t __attribute__((ext_vector_type(2)));
typedef float f2_t __attribute__((ext_vector_type(2)));
typedef unsigned u32x4 __attribute__((ext_vector_type(4)));
typedef unsigned u32x2 __attribute__((ext_vector_type(2)));
using pg8::Unit;

#define DI __device__ __forceinline__
#define MFMA32(a, b, c) __builtin_amdgcn_mfma_f32_32x32x16_bf16((a), (b), (c), 0, 0, 0)

constexpr int DM = 1024, SEQ = 4096, NBATCH = 8, T = NBATCH * SEQ;
constexpr int NCH = 2, BC = NBATCH / NCH, TC = BC * SEQ;
constexpr int INC = 7552, DMLP = 4096;
constexpr int NQKG = 6656;
constexpr int NQKH = 38, NVH = 16;
constexpr float LOG2E = 1.4426950408889634f;
constexpr int NTHR = 512;

constexpr size_t al256(size_t x) { return (x + 255) & ~(size_t)255; }
constexpr size_t OFF_WQKG = 0;
constexpr size_t OFF_WV   = OFF_WQKG + al256((size_t)2 * NQKG * DM * 2);
constexpr size_t OFF_WBR5 = OFF_WV   + al256((size_t)2 * DM * DM * 2);
constexpr size_t OFF_WOUT = OFF_WBR5 + al256((size_t)2 * 5 * DM * 256 * 2);
constexpr size_t OFF_WUP  = OFF_WOUT + al256((size_t)2 * DM * DM * 2);
constexpr size_t OFF_WDN  = OFF_WUP  + al256((size_t)2 * DMLP * DM * 2);
constexpr size_t OFF_ROPE = OFF_WDN  + al256((size_t)2 * DM * DMLP * 2);
constexpr size_t OFF_XB   = OFF_ROPE + al256((size_t)SEQ * 96 * 4);
constexpr size_t OFF_SSQ  = OFF_XB   + al256((size_t)T * DM * 2);
constexpr size_t OFF_QK   = OFF_SSQ  + al256((size_t)T * 16 * 4);
constexpr size_t OFF_V    = OFF_QK   + al256((size_t)NQKH * TC * 64 * 2);
constexpr size_t OFF_GATE = OFF_V    + al256((size_t)NVH * TC * 64 * 2);
constexpr size_t OFF_Y5   = OFF_GATE + al256((size_t)TC * 4096 * 2);
constexpr size_t OFF_BO   = OFF_Y5   + al256((size_t)5 * TC * 256 * 2);
constexpr size_t OFF_LSE  = OFF_BO   + al256((size_t)TC * 384 * 2);
constexpr size_t OFF_MRG  = OFF_LSE  + al256((size_t)TC * 8 * 4);
constexpr size_t OFF_BAR  = OFF_MRG  + al256((size_t)TC * DM * 2);
constexpr size_t WS_END   = OFF_BAR  + 16384;
static_assert(WS_END <= (size_t)512 * 1024 * 1024, "workspace too large");

constexpr int LDS_STAGE = 131072;
constexpr int LDS_BYTES = LDS_STAGE + 64;
constexpr int PPL = (DUPK >= 0) ? 7 : 6;
constexpr int NPHASE = 1 + NCH * 2 * PPL;

struct Params {
  const float* in[19];
  float* out;
  unsigned char* ws;
  int ph_lo, ph_hi;
};

DI unsigned pk2(float a, float b) { f2_t v = {a, b}; bf2_t r = __builtin_convertvector(v, bf2_t); return __builtin_bit_cast(unsigned, r); }
DI float bf_lo(unsigned u) { return __uint_as_float(u << 16); }
DI float bf_hi(unsigned u) { return __uint_as_float(u & 0xffff0000u); }
DI float fexp2(float x) { return __builtin_amdgcn_exp2f(x); }
DI int crow(int i, int h) { return (i & 3) + 8 * (i >> 2) + 4 * h; }
DI bf16x8 as_bf8(u32x4 v) { return __builtin_bit_cast(bf16x8, v); }
DI int dil_of(int gi) { return gi == 0 ? 1 : (gi == 1 ? 4 : 16); }
DI int dlg_of(int gi) { return gi * 2; }
DI float row_rscale(const float* ssq, size_t tok) {
  const f32x4 a = *(const f32x4*)(ssq + tok * 16), b = *(const f32x4*)(ssq + tok * 16 + 4);
  const f32x4 c = *(const f32x4*)(ssq + tok * 16 + 8), d = *(const f32x4*)(ssq + tok * 16 + 12);
  const float s = ((a[0] + a[1]) + (a[2] + a[3])) + ((b[0] + b[1]) + (b[2] + b[3])) + ((c[0] + c[1]) + (c[2] + c[3])) + ((d[0] + d[1]) + (d[2] + d[3]));
  return rsqrtf(s * (1.0f / 1024.0f) + 1e-6f);
}
DI int qk_head_col(int h) {
  if (h < 8) return 64 * h;
  if (h < 10) return 512 + 64 * (h - 8);
  if (h < 16) return 768 + 64 * (h - 10);
  if (h < 22) return 1152 + 64 * (h - 16);
  if (h < 26) return 1920 + 64 * (h - 22);
  if (h < 30) return 2176 + 64 * (h - 26);
  if (h < 34) return 2688 + 64 * (h - 30);
  return 2944 + 64 * (h - 34);
}
DI int v_head_col(int vh) {
  if (vh < 2) return 640 + 64 * vh;
  if (vh < 8) return 1536 + 64 * (vh - 2);
  if (vh < 12) return 2432 + 64 * (vh - 8);
  return 3200 + 64 * (vh - 12);
}

struct EpiQKG {
  static constexpr bool PERM = false, AFTER_DRAIN = false;
  const float* ssq; u16* qk; const float* rope; const float* gA; const float* gB; const float* gC; const float* gD;
  DI void operator()(const f32x4 (&acc)[2][2][4][2], const Unit& u, int wr, int wc, int fr, int fq) const {
    const int hidx = u.pn * 4 + wc;
    if (hidx >= NQKH) return;
    int kind, dlg = 0; const float* gain;
    if (hidx < 8) { kind = 0; gain = gA; }
    else if (hidx < 10) { kind = 0; gain = gA + 64; }
    else if (hidx < 16) { kind = 0; gain = gB; dlg = dlg_of((hidx - 10) >> 1); }
    else if (hidx < 22) { kind = 0; gain = gB + 64; dlg = dlg_of((hidx - 16) >> 1); }
    else if (hidx < 26) { kind = 2; gain = gC; }
    else if (hidx < 30) { kind = 2; gain = gC + 32; }
    else if (hidx < 34) { kind = 1; gain = gD; }
    else { kind = 1; gain = gD + 64; }
    u16* gbase = qk + (size_t)hidx * TC * 64;
    const float* gainl = gain + 4 * fq;
    const float qpre = (hidx >= 22 && hidx < 26) ? (0.17677669529663687f * LOG2E)
                     : ((hidx < 8 || (hidx >= 10 && hidx < 16) || (hidx >= 30 && hidx < 34)) ? (0.125f * LOG2E) : 1.0f);
#pragma unroll
    for (int ai = 0; ai < 2; ++ai)
#pragma unroll
      for (int m = 0; m < 4; ++m) {
        const int tok = u.pm * 256 + 128 * ai + 64 * wr + 16 * m + fr;
        const int bl = tok >> 12, pos = tok & 4095;
        const float rs = row_rscale(ssq, tok);
        const int pdom = ((pos & ((1 << dlg) - 1)) << (12 - dlg)) + (pos >> dlg);
        const int blk = pdom >> 5, rr = pdom & 31;
        u16* base = gbase + (size_t)bl * SEQ * 64;
        if (kind != 2) {
          float ss = 0.f;
#pragma unroll
          for (int bj = 0; bj < 2; ++bj)
#pragma unroll
            for (int n = 0; n < 2; ++n)
#pragma unroll
              for (int e = 0; e < 4; ++e) ss += acc[ai][bj][m][n][e] * acc[ai][bj][m][n][e];
          ss += __shfl_xor(ss, 16); ss += __shfl_xor(ss, 32);
          const float sc = rs * rsqrtf(ss * rs * rs * (1.0f / 64.0f) + 1e-6f) * qpre;
#pragma unroll
          for (int n = 0; n < 2; ++n) {
            f32x4 xa = acc[ai][0][m][n] * sc * *(const f32x4*)(gainl + 16 * n);
            f32x4 xb2 = acc[ai][1][m][n] * sc * *(const f32x4*)(gainl + 32 + 16 * n);
            if (kind == 0) {
              const f32x4 c4 = *(const f32x4*)(rope + pos * 96 + 16 * n + 4 * fq);
              const f32x4 s4 = *(const f32x4*)(rope + pos * 96 + 32 + 16 * n + 4 * fq);
              const f32x4 ta = xa * c4 - xb2 * s4, tb = xb2 * c4 + xa * s4;
              xa = ta; xb2 = tb;
            }
            u32x2 w0 = {pk2(xa[0], xa[1]), pk2(xa[2], xa[3])};
            *(u32x2*)(base + ((size_t)(blk * 4 + n) * 64 + (fq >> 1) * 32 + rr) * 8 + 4 * (fq & 1)) = w0;
            u32x2 w1 = {pk2(xb2[0], xb2[1]), pk2(xb2[2], xb2[3])};
            *(u32x2*)(base + ((size_t)(blk * 4 + 2 + n) * 64 + (fq >> 1) * 32 + rr) * 8 + 4 * (fq & 1)) = w1;
          }
        } else {
          const f32x4 c4 = *(const f32x4*)(rope + pos * 96 + 64 + 4 * fq);
          const f32x4 s4 = *(const f32x4*)(rope + pos * 96 + 80 + 4 * fq);
#pragma unroll
          for (int bj = 0; bj < 2; ++bj) {
            float ss = 0.f;
#pragma unroll
            for (int n = 0; n < 2; ++n)
#pragma unroll
              for (int e = 0; e < 4; ++e) ss += acc[ai][bj][m][n][e] * acc[ai][bj][m][n][e];
            ss += __shfl_xor(ss, 16); ss += __shfl_xor(ss, 32);
            const float sc = rs * rsqrtf(ss * rs * rs * (1.0f / 32.0f) + 1e-6f) * qpre;
            const f32x4 xa = acc[ai][bj][m][0] * sc * *(const f32x4*)(gainl);
            const f32x4 xb2 = acc[ai][bj][m][1] * sc * *(const f32x4*)(gainl + 16);
            const f32x4 ta = xa * c4 - xb2 * s4, tb = xb2 * c4 + xa * s4;
            u16* sb = base + (size_t)bj * SEQ * 32;
            u32x2 w0 = {pk2(ta[0], ta[1]), pk2(ta[2], ta[3])};
            *(u32x2*)(sb + ((size_t)(blk * 2 + 0) * 64 + (fq >> 1) * 32 + rr) * 8 + 4 * (fq & 1)) = w0;
            u32x2 w1 = {pk2(tb[0], tb[1]), pk2(tb[2], tb[3])};
            *(u32x2*)(sb + ((size_t)(blk * 2 + 1) * 64 + (fq >> 1) * 32 + rr) * 8 + 4 * (fq & 1)) = w1;
          }
        }
        asm volatile("" ::: "memory");
      }
  }
};

struct EpiGateUp {
  static constexpr bool PERM = true, AFTER_DRAIN = false;
  const float* ssq; u16* o; int mode;
  template <bool UP>
  DI void body(const f32x4 (&acc)[2][2][4][2], const Unit& u, int wr, int wc, int fr, int fq) const {
    const int c0 = u.pn * 256 + 32 * wc + 8 * fq;
#pragma unroll
    for (int ai = 0; ai < 2; ++ai)
#pragma unroll
      for (int m = 0; m < 4; ++m) {
        const size_t tok = (size_t)u.pm * 256 + 128 * ai + 64 * wr + 16 * m + fr;
        const float rs = row_rscale(ssq, tok);
#pragma unroll
        for (int bj = 0; bj < 2; ++bj) {
          float r[8];
#pragma unroll
          for (int n = 0; n < 2; ++n) {
            const f32x4 v = acc[ai][bj][m][n] * rs;
#pragma unroll
            for (int e = 0; e < 4; ++e) {
              if (UP) { const float z = fmaxf(v[e], 0.f); r[4 * n + e] = z * z; }
              else r[4 * n + e] = __builtin_amdgcn_rcpf(1.0f + fexp2(-LOG2E * v[e]));
            }
          }
          u32x4 w = {pk2(r[0], r[1]), pk2(r[2], r[3]), pk2(r[4], r[5]), pk2(r[6], r[7])};
          *(u32x4*)(o + tok * 4096 + c0 + 128 * bj) = w;
        }
        asm volatile("" ::: "memory");
      }
  }
  DI void operator()(const f32x4 (&acc)[2][2][4][2], const Unit& u, int wr, int wc, int fr, int fq) const {
    if (mode == 2) return;
    if (mode == 1) body<true>(acc, u, wr, wc, fr, fq);
    else body<false>(acc, u, wr, wc, fr, fq);
  }
};

struct EpiVT {
  static constexpr bool PERM = false, AFTER_DRAIN = false;
  const float* ssq; u16* vbuf;
  DI void operator()(const f32x4 (&acc)[2][2][4][2], const Unit& u, int wr, int wc, int fr, int fq) const {
    f32x4 rs4[2][2];
#pragma unroll
    for (int bj = 0; bj < 2; ++bj)
#pragma unroll
      for (int n = 0; n < 2; ++n) {
        const size_t t0 = (size_t)u.pn * 256 + 128 * bj + 32 * wc + 16 * n + 4 * fq;
#pragma unroll
        for (int e = 0; e < 4; ++e) { rs4[bj][n][e] = row_rscale(ssq, t0 + e); asm volatile("" ::: "memory"); }
      }
#pragma unroll
    for (int ai = 0; ai < 2; ++ai) {
      const int vgrp = u.pm * 4 + 2 * ai + wr;
      const int dlg = (vgrp >= 2 && vgrp < 8) ? dlg_of((vgrp - 2) >> 1) : 0;
      u16* gbase = vbuf + (size_t)vgrp * TC * 64;
      const int bl = (u.pn * 256) >> 12;
      u16* base = gbase + (size_t)bl * SEQ * 64;
      const unsigned es = (dlg == 0) ? 1u : (unsigned)(128 >> dlg) * 2048u;
#pragma unroll
      for (int m = 0; m < 4; ++m) {
        const int dv = 16 * m + fr;
        const unsigned dvo = (unsigned)((dv >> 5) * 1024 + (dv & 31) * 8);
#pragma unroll
        for (int bj = 0; bj < 2; ++bj)
#pragma unroll
          for (int n = 0; n < 2; ++n) {
            const int pos0 = (u.pn * 256 + 128 * bj + 32 * wc + 16 * n + 4 * fq) & 4095;
            const f32x4 v = acc[ai][bj][m][n] * rs4[bj][n];
            const int pd0 = ((pos0 & ((1 << dlg) - 1)) << (12 - dlg)) + (pos0 >> dlg);
            const int blk = pd0 >> 5, key = pd0 & 31;
            const unsigned off = (unsigned)blk * 2048u + (unsigned)(key >> 4) * 512u + (unsigned)((key >> 2) & 1) * 256u + dvo + 4u * ((key >> 3) & 1);
            const unsigned w0 = pk2(v[0], v[1]), w1 = pk2(v[2], v[3]);
            const unsigned o2 = off + (key & 3);
            base[o2] = (u16)(w0 & 0xffffu); base[o2 + es] = (u16)(w0 >> 16); base[o2 + 2 * es] = (u16)(w1 & 0xffffu); base[o2 + 3 * es] = (u16)(w1 >> 16);
            asm volatile("" ::: "memory");
          }
      }
    }
  }
};

struct MergeOrder : pg8::StaticOrder {
  const u16* ybase; const u16* wbase;
  DI bool next(int i, Unit& u) const { if (i >= 5) return false; if (!pg8::StaticOrder::next(0, u)) return false; u.seg = i; return true; }
  DI const char* baseA(const pg8::Gemm&, const Unit& u, size_t tstep) const { return (const char*)(ybase + (size_t)u.seg * TC * 256) + (size_t)u.pm * tstep; }
  DI const char* baseB(const pg8::Gemm&, const Unit& u, size_t tstep) const { return (const char*)(wbase + (size_t)u.seg * DM * 256) + (size_t)u.pn * tstep; }
  DI bool zero_after(const Unit& u) const { return u.seg == 4; }
};
struct EpiMerge {
  static constexpr bool PERM = true, AFTER_DRAIN = false;
  const u16* gate; u16* mrg;
  DI void operator()(f32x4 (&acc)[2][2][4][2], const Unit& u, int wr, int wc, int fr, int fq) const {
    const int seg = u.seg;
    if (seg == 0) return;
    const bool last = (seg == 4);
    const int gnum = last ? 3 : seg - 1, gden = last ? 3 : seg;
#pragma unroll
    for (int ai = 0; ai < 2; ++ai)
#pragma unroll
      for (int m = 0; m < 4; ++m) {
        const size_t tok = (size_t)u.pm * 256 + 128 * ai + 64 * wr + 16 * m + fr;
#pragma unroll
        for (int bj = 0; bj < 2; ++bj) {
          const int c = u.pn * 256 + 128 * bj + 32 * wc + 8 * fq;
          const u32x4 gn = *(const u32x4*)(gate + tok * 4096 + gnum * 1024 + c);
          const u32x4 gd = *(const u32x4*)(gate + tok * 4096 + gden * 1024 + c);
#pragma unroll
          for (int n = 0; n < 2; ++n) {
            f32x4 f;
            f[0] = bf_lo(gn[2 * n]); f[1] = bf_hi(gn[2 * n]); f[2] = bf_lo(gn[2 * n + 1]); f[3] = bf_hi(gn[2 * n + 1]);
            if (!last) {
              f[0] *= __builtin_amdgcn_rcpf(bf_lo(gd[2 * n])); f[1] *= __builtin_amdgcn_rcpf(bf_hi(gd[2 * n]));
              f[2] *= __builtin_amdgcn_rcpf(bf_lo(gd[2 * n + 1])); f[3] *= __builtin_amdgcn_rcpf(bf_hi(gd[2 * n + 1]));
            }
            acc[ai][bj][m][n] *= f;
          }
          if (last) {
            const f32x4 v0 = acc[ai][bj][m][0], v1 = acc[ai][bj][m][1];
            u32x4 w = {pk2(v0[0], v0[1]), pk2(v0[2], v0[3]), pk2(v1[0], v1[1]), pk2(v1[2], v1[3])};
            *(u32x4*)(mrg + tok * DM + c) = w;
          }
        }
        asm volatile("" ::: "memory");
      }
  }
};

struct EpiResid {
  static constexpr bool PERM = true, AFTER_DRAIN = false;
  const float* xold; float* xout; u16* xb; float* ssq;
  DI void operator()(const f32x4 (&acc)[2][2][4][2], const Unit& u, int wr, int wc, int fr, int fq) const {
#pragma unroll
    for (int ai = 0; ai < 2; ++ai)
#pragma unroll
      for (int m = 0; m < 4; ++m) {
        const size_t tok = (size_t)u.pm * 256 + 128 * ai + 64 * wr + 16 * m + fr;
        float ss = 0.f;
#pragma unroll
        for (int bj = 0; bj < 2; ++bj) {
          const size_t o = tok * DM + u.pn * 256 + 128 * bj + 32 * wc + 8 * fq;
          const f32x4 v0 = *(const f32x4*)(xold + o) + acc[ai][bj][m][0];
          const f32x4 v1 = *(const f32x4*)(xold + o + 4) + acc[ai][bj][m][1];
          *(f32x4*)(xout + o) = v0;
          *(f32x4*)(xout + o + 4) = v1;
          u32x4 w = {pk2(v0[0], v0[1]), pk2(v0[2], v0[3]), pk2(v1[0], v1[1]), pk2(v1[2], v1[3])};
          *(u32x4*)(xb + o) = w;
          ss += ((v0[0] * v0[0] + v0[1] * v0[1]) + (v0[2] * v0[2] + v0[3] * v0[3])) + ((v1[0] * v1[0] + v1[1] * v1[1]) + (v1[2] * v1[2] + v1[3] * v1[3]));
        }
        ss += __shfl_xor(ss, 16); ss += __shfl_xor(ss, 32);
        if (fq == 0) ssq[tok * 16 + u.pn * 4 + wc] = ss;
        asm volatile("" ::: "memory");
      }
  }
};

template <class Epi>
DI void run_merge(PG8_LAS unsigned char* lds, const u16* ybase, const u16* wbase, const Epi& E) {
  int K = 256; asm volatile("" : "+s"(K));
  pg8::Gemm g; g.A = ybase; g.Bt = wbase; g.M = TC; g.N = DM; g.K = K;
  MergeOrder S; S.init(TC, DM, (int)gridDim.x, (int)blockIdx.x); S.ybase = ybase; S.wbase = wbase;
  pg8::gemm_phase<Epi, MergeOrder, false>(lds, g, S, E, nullptr);
}
template <class Epi>
DI void run_gemm(PG8_LAS unsigned char* lds, const u16* A, const u16* Bt, int M, int N, int K, const Epi& E, int probe = 0) {
  asm volatile("" : "+s"(K));
  pg8::Gemm g; g.A = A; g.Bt = Bt; g.M = M; g.N = N; g.K = K;
  pg8::StaticOrder S; S.init(M, N, (int)gridDim.x, (int)blockIdx.x); S.probe = probe;
  pg8::gemm_phase<Epi, pg8::StaticOrder, false>(lds, g, S, E, nullptr);
}

DI void cvt_load(const float* __restrict__ src, int N, int k0, int n0, const float* __restrict__ g, float* t, int ht) {
  const int c4 = (ht & 15) * 4;
#pragma unroll
  for (int i = 0; i < 4; ++i) {
    const int kk = (ht >> 4) + 16 * i;
    f32x4 v = *(const f32x4*)(src + (size_t)(k0 + kk) * N + n0 + c4);
    const float sc = g ? g[k0 + kk] : 1.0f;
    t[kk * 65 + c4 + 0] = v[0] * sc; t[kk * 65 + c4 + 1] = v[1] * sc; t[kk * 65 + c4 + 2] = v[2] * sc; t[kk * 65 + c4 + 3] = v[3] * sc;
  }
}
DI void cvt_store(u16* __restrict__ dst, int ldk, int kdst, int d0, int d1, const float* t, int ht) {
  const int kc = (ht & 7) * 8, nn = ht >> 3;
#pragma unroll
  for (int i = 0; i < 2; ++i) {
    const int tn = nn + 32 * i, row = (i == 0) ? d0 + nn : d1 + nn;
    u32x4 w;
    w[0] = pk2(t[(kc + 0) * 65 + tn], t[(kc + 1) * 65 + tn]);
    w[1] = pk2(t[(kc + 2) * 65 + tn], t[(kc + 3) * 65 + tn]);
    w[2] = pk2(t[(kc + 4) * 65 + tn], t[(kc + 5) * 65 + tn]);
    w[3] = pk2(t[(kc + 6) * 65 + tn], t[(kc + 7) * 65 + tn]);
    *(u32x4*)(dst + (size_t)row * ldk + kdst + kc) = w;
  }
}
struct CvtJob { const float* src; int N, k0, n0; const float* g; u16* dst; int ldk, d0, d1, kd; };
DI CvtJob cvt_job(const Params& p, int l, int ti) {
  CvtJob j; j.g = nullptr; j.kd = -1;
  const float* attn_g = p.in[1] + l * DM;
  if (ti < 608) { const int h = ti >> 4, kt = ti & 15; j.src = p.in[2] + (size_t)l * DM * INC; j.N = INC; j.k0 = kt * 64; j.n0 = qk_head_col(h); j.g = attn_g;
    j.dst = (u16*)(p.ws + OFF_WQKG) + (size_t)l * NQKG * DM; j.ldk = DM; j.d0 = (h >> 2) * 256 + (h & 3) * 32; j.d1 = j.d0 + 128; return j; }
  ti -= 608;
  if (ti < 1024) { const int c = ti >> 4, kt = ti & 15; j.src = p.in[2] + (size_t)l * DM * INC; j.N = INC; j.k0 = kt * 64; j.n0 = 3456 + 64 * c; j.g = attn_g;
    j.dst = (u16*)(p.ws + OFF_WQKG) + (size_t)l * NQKG * DM; j.ldk = DM; j.d0 = 2560 + 64 * c; j.d1 = j.d0 + 32; return j; }
  ti -= 1024;
  if (ti < 256) { const int vh = ti >> 4, kt = ti & 15; j.src = p.in[2] + (size_t)l * DM * INC; j.N = INC; j.k0 = kt * 64; j.n0 = v_head_col(vh); j.g = attn_g;
    j.dst = (u16*)(p.ws + OFF_WV) + (size_t)l * DM * DM; j.ldk = DM; j.d0 = vh * 64; j.d1 = j.d0 + 32; return j; }
  ti -= 256;
  if (ti < 128) { j.src = p.in[11] + (size_t)l * 512 * DM; j.N = DM; j.k0 = (ti >> 4) * 64; j.n0 = (ti & 15) * 64; j.dst = (u16*)(p.ws + OFF_WBR5) + ((size_t)l * 5 + (j.k0 >> 8)) * DM * 256; j.ldk = 256; j.kd = j.k0 & 255; j.d0 = j.n0; j.d1 = j.n0 + 32; return j; }
  ti -= 128;
  if (ti < 32) { j.src = p.in[12] + (size_t)l * 128 * DM; j.N = DM; j.k0 = (ti >> 4) * 64; j.n0 = (ti & 15) * 64; j.dst = (u16*)(p.ws + OFF_WBR5) + ((size_t)l * 5 + 2) * DM * 256; j.ldk = 256; j.kd = j.k0; j.d0 = j.n0; j.d1 = j.n0 + 32; return j; }
  ti -= 32;
  if (ti < 64) { j.src = p.in[13] + (size_t)l * 256 * DM; j.N = DM; j.k0 = (ti >> 4) * 64; j.n0 = (ti & 15) * 64; j.dst = (u16*)(p.ws + OFF_WBR5) + ((size_t)l * 5 + 3) * DM * 256; j.ldk = 256; j.kd = j.k0; j.d0 = j.n0; j.d1 = j.n0 + 32; return j; }
  ti -= 64;
  if (ti < 64) { j.src = p.in[14] + (size_t)l * 256 * DM; j.N = DM; j.k0 = (ti >> 4) * 64; j.n0 = (ti & 15) * 64; j.dst = (u16*)(p.ws + OFF_WBR5) + ((size_t)l * 5 + 4) * DM * 256; j.ldk = 256; j.kd = j.k0; j.d0 = j.n0; j.d1 = j.n0 + 32; return j; }
  ti -= 64;
  if (ti < 256) { j.src = p.in[15] + (size_t)l * DM * DM; j.N = DM; j.k0 = (ti >> 4) * 64; j.n0 = (ti & 15) * 64; j.dst = (u16*)(p.ws + OFF_WOUT) + (size_t)l * DM * DM; j.ldk = DM; j.d0 = j.n0; j.d1 = j.n0 + 32; return j; }
  ti -= 256;
  if (ti < 1024) { j.src = p.in[17] + (size_t)l * DM * DMLP; j.N = DMLP; j.k0 = (ti >> 6) * 64; j.n0 = (ti & 63) * 64; j.g = p.in[16] + l * DM;
    j.dst = (u16*)(p.ws + OFF_WUP) + (size_t)l * DMLP * DM; j.ldk = DM; j.d0 = j.n0; j.d1 = j.n0 + 32; return j; }
  ti -= 1024;
  j.src = p.in[18] + (size_t)l * DMLP * DM; j.N = DM; j.k0 = (ti >> 4) * 64; j.n0 = (ti & 15) * 64; j.dst = (u16*)(p.ws + OFF_WDN) + (size_t)l * DM * DMLP; j.ldk = DMLP; j.d0 = j.n0; j.d1 = j.n0 + 32; return j;
}

__device__ void phase_prep(const Params& p, int tid_, int bid_, int nblk_, unsigned char* smem) {
  const int half = tid_ >> 8, ht = tid_ & 255;
  float* t = (float*)smem + half * (64 * 65);
  const int per_layer = 4480, total = 2 * per_layer;
  for (int jp = bid_; jp * 2 < total; jp += nblk_) {
    const int j = jp * 2 + half;
    const bool on = j < total;
    CvtJob job;
    if (on) { job = cvt_job(p, j / per_layer, j % per_layer); cvt_load(job.src, job.N, job.k0, job.n0, job.g, t, ht); }
    __syncthreads();
    if (on) cvt_store(job.dst, job.ldk, (job.kd >= 0) ? job.kd : job.k0, job.d0, job.d1, t, ht);
    __syncthreads();
  }
  {
    const u32x4 z = {0u, 0u, 0u, 0u};
    for (int e = bid_ * NTHR + tid_; e < 2 * 128 * 128; e += nblk_ * NTHR) {
      const int l = e >> 14, r = (e >> 7) & 127, c = (e & 127) * 8;
      const int row = 9 * 256 + ((r < 64) ? 64 + r : 128 + r);
      *(u32x4*)((u16*)(p.ws + OFF_WQKG) + ((size_t)l * NQKG + row) * DM + c) = z;
    }
    for (int e = bid_ * NTHR + tid_; e < 2 * 1024 * 16; e += nblk_ * NTHR) {
      const int l = e >> 14, r = (e >> 4) & 1023, c = 128 + (e & 15) * 8;
      *(u32x4*)((u16*)(p.ws + OFF_WBR5) + (((size_t)l * 5 + 2) * DM + r) * 256 + c) = z;
    }
  }
  float* rope = (float*)(p.ws + OFF_ROPE);
  for (int e = bid_ * NTHR + tid_; e < SEQ * 48; e += nblk_ * NTHR) {
    const int pos = e / 48, i = e % 48;
    float inv;
    if (i < 32) inv = exp2f(-13.287712379549449f * (float)(2 * i) / 64.0f);
    else inv = exp2f(-13.287712379549449f * (float)(2 * (i - 32)) / 32.0f);
    const float angf = (float)pos * inv;
    const double ang = (double)angf;
    const double n = rint(ang * 0.15915494309189535);
    const float r = (float)(ang - n * 6.283185307179586);
    const float c = cosf(r), s = sinf(r);
    if (i < 32) { rope[pos * 96 + i] = c; rope[pos * 96 + 32 + i] = s; }
    else { rope[pos * 96 + 64 + (i - 32)] = c; rope[pos * 96 + 80 + (i - 32)] = s; }
  }
  u16* XB = (u16*)(p.ws + OFF_XB); float* SSQ = (float*)(p.ws + OFF_SSQ);
  const int lane = tid_ & 63;
  const int gw = bid_ * 8 + (tid_ >> 6), nw = nblk_ * 8;
  for (int row = gw; row < T; row += nw) {
    const float* xr = p.in[0] + (size_t)row * DM;
    float ss = 0.f;
#pragma unroll
    for (int i = 0; i < 4; ++i) {
      const f32x4 v = *(const f32x4*)(xr + i * 256 + lane * 4);
      ss += v[0] * v[0] + v[1] * v[1] + v[2] * v[2] + v[3] * v[3];
      u32x2 w = {pk2(v[0], v[1]), pk2(v[2], v[3])};
      *(u32x2*)(XB + (size_t)row * DM + i * 256 + lane * 4) = w;
    }
#pragma unroll
    for (int o = 32; o >= 1; o >>= 1) ss += __shfl_xor(ss, o);
    if (lane < 16) SSQ[(size_t)row * 16 + lane] = (lane == 0) ? ss : 0.f;
  }
}

DI void attn_softmax_pv(f32x16& S, float& m, float& l, f32x16& O0, f32x16& O1, const bf16x8 (&vf)[2][2]) {
  float mx = S[0];
#pragma unroll
  for (int i = 1; i < 16; ++i) mx = fmaxf(mx, S[i]);
  mx = fmaxf(mx, __shfl_xor(mx, 32));
  const float mn = fmaxf(m, mx);
  const float alpha = fexp2(m - mn);
  m = mn;
  float sum = 0.f;
#pragma unroll
  for (int i = 0; i < 16; ++i) { S[i] = fexp2(S[i] - mn); sum += S[i]; }
  l = l * alpha + sum;
  const u32x4 p0 = {pk2(S[0], S[1]), pk2(S[2], S[3]), pk2(S[4], S[5]), pk2(S[6], S[7])};
  const u32x4 p1 = {pk2(S[8], S[9]), pk2(S[10], S[11]), pk2(S[12], S[13]), pk2(S[14], S[15])};
#pragma unroll
  for (int i = 0; i < 16; ++i) { O0[i] *= alpha; O1[i] *= alpha; }
  O0 = MFMA32(vf[0][0], as_bf8(p0), O0);
  O0 = MFMA32(vf[0][1], as_bf8(p1), O0);
  O1 = MFMA32(vf[1][0], as_bf8(p0), O1);
  O1 = MFMA32(vf[1][1], as_bf8(p1), O1);
}
DI void attn_fixed_pv(f32x16& S, f32x16& L, f32x16& O0, f32x16& O1, const bf16x8 (&vf)[2][2], const bf16x8 ones) {
#pragma unroll
  for (int i = 0; i < 16; ++i) S[i] = fexp2(S[i]);
  const u32x4 p0 = {pk2(S[0], S[1]), pk2(S[2], S[3]), pk2(S[4], S[5]), pk2(S[6], S[7])};
  const u32x4 p1 = {pk2(S[8], S[9]), pk2(S[10], S[11]), pk2(S[12], S[13]), pk2(S[14], S[15])};
  O0 = MFMA32(vf[0][0], as_bf8(p0), O0);
  O0 = MFMA32(vf[0][1], as_bf8(p1), O0);
  O1 = MFMA32(vf[1][0], as_bf8(p0), O1);
  O1 = MFMA32(vf[1][1], as_bf8(p1), O1);
  float sum = 0.f;
#pragma unroll
  for (int i = 0; i < 16; ++i) sum += S[i];
  L[0] += sum;
}
DI void attn_plain_pv(f32x16& S, float& l, f32x16& O0, f32x16& O1, const bf16x8 (&vf)[2][2]) {
  float sum = 0.f;
#pragma unroll
  for (int i = 0; i < 16; ++i) { S[i] = fexp2(S[i]); sum += S[i]; }
  l += sum;
  const u32x4 p0 = {pk2(S[0], S[1]), pk2(S[2], S[3]), pk2(S[4], S[5]), pk2(S[6], S[7])};
  const u32x4 p1 = {pk2(S[8], S[9]), pk2(S[10], S[11]), pk2(S[12], S[13]), pk2(S[14], S[15])};
  O0 = MFMA32(vf[0][0], as_bf8(p0), O0); O1 = MFMA32(vf[1][0], as_bf8(p0), O1);
  O0 = MFMA32(vf[0][1], as_bf8(p1), O0); O1 = MFMA32(vf[1][1], as_bf8(p1), O1);
}
DI float gain_bound64(const float* g) {
  float a = 0.f, b = 0.f;
  for (int i = 0; i < 64; ++i) { a = fmaxf(a, fabsf(g[i])); b = fmaxf(b, fabsf(g[64 + i])); }
  return fminf(8.0f * a * b * 1.02f + 0.05f, 40.0f);
}
DI void load_vf(bf16x8 (&vf)[2][2], const u16* V, int kb, int lane) {
#pragma unroll
  for (int rb = 0; rb < 2; ++rb)
#pragma unroll
    for (int s = 0; s < 2; ++s) vf[rb][s] = *(const bf16x8*)(V + ((size_t)((kb * 2 + rb) * 2 + s) * 64 + lane) * 8);
}
DI void load_kf4(bf16x8 (&kf)[4], const u16* K, int kb, int lane) {
#pragma unroll
  for (int s = 0; s < 4; ++s) kf[s] = *(const bf16x8*)(K + ((size_t)(kb * 4 + s) * 64 + lane) * 8);
}
DI void load_kf2(bf16x8 (&kf)[2], const u16* K, int kb, int lane) {
#pragma unroll
  for (int s = 0; s < 2; ++s) kf[s] = *(const bf16x8*)(K + ((size_t)(kb * 2 + s) * 64 + lane) * 8);
}
DI void zero16(f32x16& a) {
#pragma unroll
  for (int i = 0; i < 16; ++i) a[i] = 0.f;
}
DI void store_o(u16* yrow, const f32x16& O0, const f32x16& O1, float sc, int h) {
#pragma unroll
  for (int g4 = 0; g4 < 4; ++g4) {
    u32x2 w0 = {pk2(O0[4 * g4] * sc, O0[4 * g4 + 1] * sc), pk2(O0[4 * g4 + 2] * sc, O0[4 * g4 + 3] * sc)};
    *(u32x2*)(yrow + 8 * g4 + 4 * h) = w0;
    u32x2 w1 = {pk2(O1[4 * g4] * sc, O1[4 * g4 + 1] * sc), pk2(O1[4 * g4 + 2] * sc, O1[4 * g4 + 3] * sc)};
    *(u32x2*)(yrow + 32 + 8 * g4 + 4 * h) = w1;
  }
}

__device__ void phase_attn(const Params& p, int tid_, int bid_, int nblk_, int layer) {
  const u16* QK = (const u16*)(p.ws + OFF_QK);
  const u16* VB = (const u16*)(p.ws + OFF_V);
  u16* Y5 = (u16*)(p.ws + OFF_Y5);
  u16* BO = (u16*)(p.ws + OFF_BO);
  float* LSE = (float*)(p.ws + OFF_LSE);
  const int lane = tid_ & 63, wave = tid_ >> 6;
  const int fr = lane & 31, fh = lane >> 5;
  const int nloc = nblk_ >> 3;
  if ((int)(bid_ >> 3) >= nloc) return;
  const int vw = ((bid_ & 7) * nloc + (bid_ >> 3)) * 8 + wave, NW = nloc * 64;
  const size_t GS = (size_t)TC * 64;
  const size_t BS = (size_t)SEQ * 64;

  {
    const float* lp = p.in[7] + layer * 128;
    float d01 = 0.f, d23 = 0.f;
    for (int i = 0; i < 32; ++i) { d01 += lp[i] * lp[32 + i]; d23 += lp[64 + i] * lp[96 + i]; }
    const float lambda_init = (layer == 0) ? 0.2f : 0.35550907f;
    const float lam = __expf(d01) - __expf(d23) + lambda_init;
    const float* subg = p.in[8] + layer * 64;
    const float sc = 0.17677669529663687f * LOG2E;
    float gqm = 0.f, gkm = 0.f;
    for (int i = 0; i < 32; ++i) { gqm = fmaxf(gqm, fabsf(p.in[6][layer * 64 + i])); gkm = fmaxf(gkm, fabsf(p.in[6][layer * 64 + 32 + i])); }
    const unsigned onev = ((fr & 27) == 0) ? 0x3f803f80u : 0u;
    const u32x4 ones4 = {onev, onev, onev, onev};
    const bf16x8 ones = as_bf8(ones4);
    const float cbound = 5.6568542f * gqm * gkm * 1.02f + 0.05f;
    for (int it = vw; it < BC * 4 * 128; it += NW) {
      const int bl = it >> 9, head = (it >> 7) & 3, qblk = it & 127;
      const u16* Q0 = QK + (22 + head) * GS + bl * BS; const u16* Q1 = Q0 + SEQ * 32;
      const u16* K0 = QK + (26 + head) * GS + bl * BS; const u16* K1 = K0 + SEQ * 32;
      const u16* V = VB + (8 + head) * GS + bl * BS;
      bf16x8 q0[2], q1[2];
      load_kf2(q0, Q0, qblk, lane); load_kf2(q1, Q1, qblk, lane);
      f32x16 L0, L1; zero16(L0); zero16(L1);
      f32x16 O00, O01, O10, O11; zero16(O00); zero16(O01); zero16(O10); zero16(O11);
      bf16x8 k0[2], k1[2], vf[2][2];
      {
        const float mb2 = fminf(cbound, 40.0f) * LOG2E;
        f32x16 sinit;
#pragma unroll
        for (int i = 0; i < 16; ++i) sinit[i] = -mb2;
        load_kf2(k0, K0, 0, lane); load_kf2(k1, K1, 0, lane); load_vf(vf, V, 0, lane);
        f32x16 S0 = sinit, S1 = sinit;
        S0 = MFMA32(k0[0], q0[0], S0); S0 = MFMA32(k0[1], q0[1], S0);
        S1 = MFMA32(k1[0], q1[0], S1); S1 = MFMA32(k1[1], q1[1], S1);
        load_kf2(k0, K0, 1, lane); load_kf2(k1, K1, 1, lane);
        for (int kb = 0; kb < 128; ++kb) {
          bf16x8 nk0[2], nk1[2], nvf[2][2];
          const int k2 = (kb + 2 < 128) ? kb + 2 : 127, v1 = (kb + 1 < 128) ? kb + 1 : 127;
          load_kf2(nk0, K0, k2, lane); load_kf2(nk1, K1, k2, lane); load_vf(nvf, V, v1, lane);
          f32x16 S0n = sinit, S1n = sinit;
#pragma unroll
          for (int i = 0; i < 16; ++i) S0[i] = fexp2(S0[i]);
          S0n = MFMA32(k0[0], q0[0], S0n); S0n = MFMA32(k0[1], q0[1], S0n);
          {
            const u32x4 p0 = {pk2(S0[0], S0[1]), pk2(S0[2], S0[3]), pk2(S0[4], S0[5]), pk2(S0[6], S0[7])};
            const u32x4 p1 = {pk2(S0[8], S0[9]), pk2(S0[10], S0[11]), pk2(S0[12], S0[13]), pk2(S0[14], S0[15])};
            O00 = MFMA32(vf[0][0], as_bf8(p0), O00); O01 = MFMA32(vf[1][0], as_bf8(p0), O01);
            O00 = MFMA32(vf[0][1], as_bf8(p1), O00); O01 = MFMA32(vf[1][1], as_bf8(p1), O01);
            float sum = 0.f;
#pragma unroll
            for (int i = 0; i < 16; ++i) sum += S0[i];
            L0[0] += sum;
          }
#pragma unroll
          for (int i = 0; i < 16; ++i) S1[i] = fexp2(S1[i]);
          S1n = MFMA32(k1[0], q1[0], S1n); S1n = MFMA32(k1[1], q1[1], S1n);
          {
            const u32x4 p0 = {pk2(S1[0], S1[1]), pk2(S1[2], S1[3]), pk2(S1[4], S1[5]), pk2(S1[6], S1[7])};
            const u32x4 p1 = {pk2(S1[8], S1[9]), pk2(S1[10], S1[11]), pk2(S1[12], S1[13]), pk2(S1[14], S1[15])};
            O10 = MFMA32(vf[0][0], as_bf8(p0), O10); O11 = MFMA32(vf[1][0], as_bf8(p0), O11);
            O10 = MFMA32(vf[0][1], as_bf8(p1), O10); O11 = MFMA32(vf[1][1], as_bf8(p1), O11);
            float sum = 0.f;
#pragma unroll
            for (int i = 0; i < 16; ++i) sum += S1[i];
            L1[0] += sum;
          }
          S0 = S0n; S1 = S1n;
#pragma unroll
          for (int s = 0; s < 2; ++s) { k0[s] = nk0[s]; k1[s] = nk1[s]; vf[0][s] = nvf[0][s]; vf[1][s] = nvf[1][s]; }
        }
      }
      const float i0 = 1.0f / (L0[0] + __shfl_xor(L0[0], 32));
      const float i1 = lam / (L1[0] + __shfl_xor(L1[0], 32));
      float ss = 0.f;
#pragma unroll
      for (int i = 0; i < 16; ++i) {
        O00[i] = O00[i] * i0 - O10[i] * i1; O01[i] = O01[i] * i0 - O11[i] * i1;
        ss += O00[i] * O00[i] + O01[i] * O01[i];
      }
      ss += __shfl_xor(ss, 32);
      const float rn = rsqrtf(ss * (1.0f / 64.0f) + 1e-6f) * (1.0f - lambda_init);
#pragma unroll
      for (int g4 = 0; g4 < 4; ++g4) {
        const f32x4 ga = *(const f32x4*)(subg + 8 * g4 + 4 * fh);
        const f32x4 gb = *(const f32x4*)(subg + 32 + 8 * g4 + 4 * fh);
#pragma unroll
        for (int e = 0; e < 4; ++e) { O00[4 * g4 + e] *= ga[e]; O01[4 * g4 + e] *= gb[e]; }
      }
      const size_t tok = (size_t)bl * SEQ + qblk * 32 + fr;
      store_o(Y5 + (size_t)3 * TC * 256 + tok * 256 + head * 64, O00, O01, rn, fh);
    }
  }
  {
    const float mbA = gain_bound64(p.in[3] + layer * 128) * LOG2E;
    f32x16 sinit;
#pragma unroll
    for (int i = 0; i < 16; ++i) sinit[i] = -mbA;
    for (int it = vw; it < BC * 8 * 128; it += NW) {
      const int bl = it >> 10, hq = (it >> 7) & 7, qblk = it & 127;
      const int kvh = hq >> 2;
      const u16* Q = QK + (size_t)hq * GS + bl * BS;
      const u16* K = QK + (size_t)(8 + kvh) * GS + bl * BS;
      const u16* V = VB + (size_t)kvh * GS + bl * BS;
      bf16x8 qf[4]; load_kf4(qf, Q, qblk, lane);
      float l = (fh == 0) ? fexp2(p.in[4][layer * 8 + hq] * LOG2E - mbA) : 0.0f;
      f32x16 O0, O1; zero16(O0); zero16(O1);
      const int kb_lo = (qblk - 4 < 0) ? 0 : qblk - 4, kb_hi = (qblk + 4 > 127) ? 127 : qblk + 4;
      const int qpos = qblk * 32 + fr;
      bf16x8 kf[4], vf[2][2];
      load_kf4(kf, K, kb_lo, lane); load_vf(vf, V, kb_lo, lane);
      for (int kb = kb_lo; kb <= kb_hi; ++kb) {
        bf16x8 nkf[4], nvf[2][2];
        const int kn = (kb < kb_hi) ? kb + 1 : kb;
        load_kf4(nkf, K, kn, lane); load_vf(nvf, V, kn, lane);
        f32x16 S = sinit;
#pragma unroll
        for (int s = 0; s < 4; ++s) S = MFMA32(kf[s], qf[s], S);
        if (kb == qblk - 4 || kb == qblk + 4) {
#pragma unroll
          for (int i = 0; i < 16; ++i) {
            const int dlt = kb * 32 + crow(i, fh) - qpos;
            S[i] = (dlt <= 128 && dlt >= -128) ? S[i] : (-__builtin_inff());
          }
        }
        attn_plain_pv(S, l, O0, O1, vf);
#pragma unroll
        for (int s = 0; s < 4; ++s) kf[s] = nkf[s];
#pragma unroll
        for (int s = 0; s < 2; ++s) { vf[0][s] = nvf[0][s]; vf[1][s] = nvf[1][s]; }
      }
      const float inv = 1.0f / (l + __shfl_xor(l, 32));
      const size_t tok = (size_t)bl * SEQ + qpos;
      store_o(Y5 + (size_t)(hq >> 2) * TC * 256 + tok * 256 + (hq & 3) * 64, O0, O1, inv, fh);
    }
  }
  {
    const float gbD = gain_bound64(p.in[9] + layer * 128);
    for (int it = vw; it < BC * 4 * 128; it += NW) {
      const int bl = it >> 9, head = (it >> 7) & 3, qblk = it & 127;
      const u16* Q = QK + (size_t)(30 + head) * GS + bl * BS;
      const u16* K = QK + (size_t)(34 + head) * GS + bl * BS;
      const u16* V = VB + (size_t)(12 + head) * GS + bl * BS;
      const float* rpb = p.in[10] + (size_t)(layer * 4 + head) * 15 * 31;
      bf16x8 qf[4]; load_kf4(qf, Q, qblk, lane);
      float bmax = 0.f;
      for (int i = lane; i < 15 * 31; i += 64) bmax = fmaxf(bmax, fabsf(rpb[i]));
#pragma unroll
      for (int o = 32; o >= 1; o >>= 1) bmax = fmaxf(bmax, __shfl_xor(bmax, o));
      const float mbD = fminf(gbD + bmax, 60.0f) * LOG2E;
      f32x16 sinit;
#pragma unroll
      for (int i = 0; i < 16; ++i) sinit[i] = -mbD;
      float l = 0.f;
      f32x16 O0, O1; zero16(O0); zero16(O1);
      const int qrow = qblk >> 1, qc = (qblk & 1) * 32 + fr;
      int r0 = qrow - 4; r0 = r0 < 0 ? 0 : (r0 > 56 ? 56 : r0);
      int c0 = qc - 8; c0 = c0 < 0 ? 0 : (c0 > 48 ? 48 : c0);
      bf16x8 kf[4], vf[2][2];
      load_kf4(kf, K, r0 * 2, lane); load_vf(vf, V, r0 * 2, lane);
      for (int kk = 0; kk < 16; ++kk) {
        const int krow_ = r0 + (kk >> 1), hb = kk & 1;
        bf16x8 nkf[4], nvf[2][2];
        const int kn = r0 * 2 + ((kk < 15) ? kk + 1 : kk);
        load_kf4(nkf, K, kn, lane); load_vf(nvf, V, kn, lane);
        f32x16 S = sinit;
#pragma unroll
        for (int s = 0; s < 4; ++s) S = MFMA32(kf[s], qf[s], S);
        const float* brow = rpb + (krow_ - qrow + 7) * 31;
#pragma unroll
        for (int i = 0; i < 16; ++i) {
          const int kc = hb * 32 + crow(i, fh);
          int dc = kc - qc; dc = dc < -15 ? -15 : (dc > 15 ? 15 : dc);
          const float bias = brow[dc + 15];
          S[i] = (kc >= c0 && kc < c0 + 16) ? __builtin_fmaf(bias, LOG2E, S[i]) : (-__builtin_inff());
        }
        attn_plain_pv(S, l, O0, O1, vf);
#pragma unroll
        for (int s = 0; s < 4; ++s) kf[s] = nkf[s];
#pragma unroll
        for (int s = 0; s < 2; ++s) { vf[0][s] = nvf[0][s]; vf[1][s] = nvf[1][s]; }
      }
      const float inv = 1.0f / (l + __shfl_xor(l, 32));
      const size_t tok = (size_t)bl * SEQ + qblk * 32 + fr;
      store_o(Y5 + (size_t)4 * TC * 256 + tok * 256 + head * 64, O0, O1, inv, fh);
    }
  }
  {
    const float mbB = gain_bound64(p.in[5] + layer * 128) * LOG2E;
    f32x16 sinit;
#pragma unroll
    for (int i = 0; i < 16; ++i) sinit[i] = -mbB;
    for (int it = vw; it < BC * 6 * 128; it += NW) {
      const int bl = it / 768, rem = it % 768, head = rem >> 7, qblk = rem & 127;
      const int dil = dil_of(head >> 1), L = SEQ / dil, LB = L >> 5;
      const u16* Q = QK + (size_t)(10 + head) * GS + bl * BS;
      const u16* K = QK + (size_t)(16 + head) * GS + bl * BS;
      const u16* V = VB + (size_t)(2 + head) * GS + bl * BS;
      bf16x8 qf[4]; load_kf4(qf, Q, qblk, lane);
      float l = 0.f;
      f32x16 O0, O1; zero16(O0); zero16(O1);
      const int rsub = qblk / LB;
      const int lo = rsub * LB, hi = lo + LB - 1;
      const int kb_lo = (qblk - 2 < lo) ? lo : qblk - 2, kb_hi = (qblk + 2 > hi) ? hi : qblk + 2;
      const int qd = qblk * 32 + fr;
      bf16x8 kf[4], vf[2][2];
      load_kf4(kf, K, kb_lo, lane); load_vf(vf, V, kb_lo, lane);
      for (int kb = kb_lo; kb <= kb_hi; ++kb) {
        bf16x8 nkf[4], nvf[2][2];
        const int kn = (kb < kb_hi) ? kb + 1 : kb;
        load_kf4(nkf, K, kn, lane); load_vf(nvf, V, kn, lane);
        f32x16 S = sinit;
#pragma unroll
        for (int s = 0; s < 4; ++s) S = MFMA32(kf[s], qf[s], S);
        if (kb == qblk - 2 || kb == qblk + 2) {
#pragma unroll
          for (int i = 0; i < 16; ++i) {
            const int dlt = kb * 32 + crow(i, fh) - qd;
            S[i] = (dlt <= 64 && dlt >= -64) ? S[i] : (-__builtin_inff());
          }
        }
        attn_plain_pv(S, l, O0, O1, vf);
#pragma unroll
        for (int s = 0; s < 4; ++s) kf[s] = nkf[s];
#pragma unroll
        for (int s = 0; s < 2; ++s) { vf[0][s] = nvf[0][s]; vf[1][s] = nvf[1][s]; }
      }
      const float lt = l + __shfl_xor(l, 32);
      const float inv = 1.0f / lt;
      const int msub = qd - rsub * L;
      const int pos = msub * dil + rsub;
      const size_t tok = (size_t)bl * SEQ + pos;
      store_o(BO + tok * 384 + head * 64, O0, O1, inv, fh);
      if (fh == 0) LSE[tok * 8 + head] = __log2f(lt) + mbB;
    }
  }
}


__device__ void phase_bcombine(const Params& p, int tid_, int tok0) {
  const u16* BO = (const u16*)(p.ws + OFF_BO);
  const float* LSE = (const float*)(p.ws + OFF_LSE);
  u16* YB = (u16*)(p.ws + OFF_Y5) + (size_t)2 * TC * 256;
  for (int e = tid_; e < 256 * 16; e += NTHR) {
    const int tok = tok0 + (e >> 4), j = (e >> 3) & 1, c8 = (e & 7) * 8;
    const float a0 = LSE[(size_t)tok * 8 + j], a1 = LSE[(size_t)tok * 8 + 2 + j], a2 = LSE[(size_t)tok * 8 + 4 + j];
    const float mx = fmaxf(a0, fmaxf(a1, a2));
    float w0 = fexp2(a0 - mx), w1 = fexp2(a1 - mx), w2 = fexp2(a2 - mx);
    const float inv = 1.0f / (w0 + w1 + w2);
    w0 *= inv; w1 *= inv; w2 *= inv;
    const u32x4 x0 = *(const u32x4*)(BO + (size_t)tok * 384 + (0 + j) * 64 + c8);
    const u32x4 x1 = *(const u32x4*)(BO + (size_t)tok * 384 + (2 + j) * 64 + c8);
    const u32x4 x2 = *(const u32x4*)(BO + (size_t)tok * 384 + (4 + j) * 64 + c8);
    u32x4 o;
#pragma unroll
    for (int q = 0; q < 4; ++q) {
      const float lo = w0 * bf_lo(x0[q]) + w1 * bf_lo(x1[q]) + w2 * bf_lo(x2[q]);
      const float hi = w0 * bf_hi(x0[q]) + w1 * bf_hi(x1[q]) + w2 * bf_hi(x2[q]);
      o[q] = pk2(lo, hi);
    }
    *(u32x4*)(YB + (size_t)tok * 256 + j * 64 + c8) = o;
    const u32x4 z = {0u, 0u, 0u, 0u};
    *(u32x4*)(YB + (size_t)tok * 256 + 128 + (e & 15) * 8) = z;
  }
}

#define XB_TMO      128
#define XB_XCNT(j)  (256  + 64 * (j))
#define XB_XSUB(j)  (1280 + 64 * (j))
#define XB_XGEN(j)  (2304 + 64 * (j))
#define XB_TOP      3328
#define XB_TOPGEN   3392
#define XCD_BAR_WORDS 3456
#define XB_SPIN_CAP (1u << 22)
#define LAS __attribute__((address_space(3)))
DI unsigned xb_ld(unsigned* p)              { return __hip_atomic_load(p, __ATOMIC_RELAXED, __HIP_MEMORY_SCOPE_AGENT); }
DI unsigned xb_add(unsigned* p, unsigned v) { return __hip_atomic_fetch_add(p, v, __ATOMIC_RELAXED, __HIP_MEMORY_SCOPE_AGENT); }
DI unsigned xb_xcc_id() { return (unsigned)__builtin_amdgcn_s_getreg((3 << 11) | 20) & 0xFu; }
#define XB_SPIN(cond, bar) do { unsigned _sp = 0; while (cond) { __builtin_amdgcn_s_sleep(1); \
    if ((++_sp & 255u) == 0u) { if (xb_ld(&(bar)[XB_TMO])) break; if (_sp > XB_SPIN_CAP) { atomicAdd(&(bar)[XB_TMO], 1u); break; } } } } while (0)
struct XcdBarrier { unsigned* bar; unsigned x; volatile LAS unsigned* st; };
DI XcdBarrier xcd_barrier_post(unsigned* bar, volatile LAS unsigned* st) {
  XcdBarrier b; b.bar = bar; b.x = xb_xcc_id(); b.st = st;
  if (threadIdx.x == 0) (void)xb_add(&bar[XB_XCNT(b.x)], 1u);
  return b;
}
DI void xcd_barrier_complete(unsigned* bar, unsigned x, unsigned& nloc, unsigned& nx) {
  const unsigned G = gridDim.x * gridDim.y * gridDim.z;
  unsigned sum, cnt, mine, sp = 0u;
  for (;;) {
    sum = 0u; cnt = 0u; mine = 0u;
#pragma unroll
    for (unsigned j = 0; j < 16; ++j) { const unsigned c = xb_ld(&bar[XB_XCNT(j)]); sum += c; cnt += (c > 0u) ? 1u : 0u; mine = (j == x) ? c : mine; }
    if (sum == G) break;
    __builtin_amdgcn_s_sleep(1);
    if ((++sp & 255u) == 0u) { if (xb_ld(&bar[XB_TMO])) break; if (sp > XB_SPIN_CAP) { atomicAdd(&bar[XB_TMO], 1u); break; } }
  }
  nloc = mine > 0u ? mine : 1u; nx = cnt > 0u ? cnt : 1u;
}
DI void xcd_barrier(const XcdBarrier& b) {
  asm volatile("s_waitcnt vmcnt(0)" ::: "memory");
  __syncthreads();
  if (threadIdx.x == 0) {
    unsigned* bar = b.bar;
    __builtin_amdgcn_s_waitcnt(0);
    unsigned nloc = b.st[0], nx = b.st[1];
    if (nloc == 0u) { xcd_barrier_complete(bar, b.x, nloc, nx); b.st[0] = nloc; b.st[1] = nx; }
    const unsigned old = xb_add(&bar[XB_XSUB(b.x)], 1u);
    const unsigned gen = old / nloc;
    if (old + 1u == (gen + 1u) * nloc) {
      __builtin_amdgcn_fence(__ATOMIC_RELEASE, "agent");
      asm volatile("s_waitcnt vmcnt(0)" ::: "memory");
      const unsigned og = xb_add(&bar[XB_TOP], 1u);
      const unsigned tg = og / nx;
      if (og + 1u == (tg + 1u) * nx) xb_add(&bar[XB_TOPGEN], 1u);
      else XB_SPIN(xb_ld(&bar[XB_TOPGEN]) == tg, bar);
      __builtin_amdgcn_fence(__ATOMIC_ACQUIRE, "agent");
      xb_add(&bar[XB_XGEN(b.x)], 1u);
      asm volatile("s_waitcnt vmcnt(0)" ::: "memory");
    } else {
      XB_SPIN(xb_ld(&bar[XB_XGEN(b.x)]) == gen, bar);
      __builtin_amdgcn_fence(__ATOMIC_ACQUIRE, "agent");
      asm volatile("s_waitcnt vmcnt(0)" ::: "memory");
    }
  }
  __syncthreads();
}

__global__ void __launch_bounds__(NTHR, 2) mk_forward(Params p) {
  extern __shared__ __attribute__((aligned(16))) unsigned char smem[];
  cg::grid_group grid = cg::this_grid();
  volatile LAS unsigned* xbw = (volatile LAS unsigned*)(smem + LDS_STAGE);
  if (threadIdx.x < 4) xbw[threadIdx.x] = 0u;
  __syncthreads();
  XcdBarrier xb;
  if (FUSED) xb = xcd_barrier_post((unsigned*)(p.ws + OFF_BAR), xbw);
#if PROBE_CLOCK
  const unsigned long long pc_t0 = clock64(), pc_r0 = wall_clock64();
#endif
  PG8_LAS unsigned char* lds = (PG8_LAS unsigned char*)smem;
  for (int ph = p.ph_lo; ph < p.ph_hi; ++ph) {
#if DUPMASK
   for (int rep = 0; rep < ((ph > 0 && ((DUPMASK >> ((ph - 1) % 7)) & 1)) ? 2 : 1); ++rep)
#endif
   {
    int tid_ = threadIdx.x, bid_ = blockIdx.x, nblk_ = gridDim.x;
    asm volatile("" : "+v"(tid_));
    asm volatile("" : "+s"(bid_));
    asm volatile("" : "+s"(nblk_));
    Params pp = p;
    asm volatile("" : "+s"(pp.ws));
    asm volatile("" : "+s"(pp.out));
    unsigned char* ws = pp.ws;
    if (ph == 0) {
      if (PHMASK & 128) phase_prep(pp, tid_, bid_, nblk_, smem);
    } else {
      const int q = ph - 1, chunk = q / (2 * PPL), layer = (q % (2 * PPL)) / PPL, kk = q % PPL, k = (kk == 6) ? DUPK : (kk < 2 ? kk : kk + 1);
      const u16* XBc = (const u16*)(ws + OFF_XB) + (size_t)chunk * TC * DM;
      float* SSQc = (float*)(ws + OFF_SSQ) + (size_t)chunk * TC * 16;
      float* xc = pp.out + (size_t)chunk * TC * DM;
      if ((k == 0 && (PHMASK & 1)) || (k == 5 && (PHMASK & 32))) {
        const bool up = (k == 5);
        if (!up) {
          EpiQKG e; e.ssq = SSQc; e.qk = (u16*)(ws + OFF_QK); e.rope = (const float*)(ws + OFF_ROPE);
          e.gA = pp.in[3] + layer * 128; e.gB = pp.in[5] + layer * 128; e.gC = pp.in[6] + layer * 64; e.gD = pp.in[9] + layer * 128;
          run_gemm(lds, XBc, (const u16*)(ws + OFF_WQKG) + (size_t)layer * NQKG * DM, TC, 2560, DM, e);
        }
        {
          EpiGateUp e; e.ssq = SSQc; e.o = (u16*)(ws + OFF_GATE); e.mode = up ? ((PROBE_NOEPI && kk == 6) ? 2 : 1) : 0;
          const u16* W = up ? (const u16*)(ws + OFF_WUP) + (size_t)layer * DMLP * DM : (const u16*)(ws + OFF_WQKG) + ((size_t)layer * NQKG + 2560) * DM;
          run_gemm(lds, XBc, W, TC, 4096, DM, e, (PROBE_NOEPI && kk == 6) ? 1 : 0);
        }
        if (!up) {
          EpiVT ev; ev.ssq = SSQc; ev.vbuf = (u16*)(ws + OFF_V);
          run_gemm(lds, (const u16*)(ws + OFF_WV) + (size_t)layer * DM * DM, XBc, DM, TC, DM, ev);
        }
      } else if (k == 1 && (PHMASK & 2)) {
        phase_attn(pp, tid_, bid_, nblk_, layer);
      } else if (k == 3 && (PHMASK & 8)) {
        {
          Unit u0; pg8::StaticOrder S0; S0.init(TC, DM, nblk_, bid_); S0.next(0, u0);
          phase_bcombine(pp, tid_, u0.pm * 256);
          asm volatile("s_waitcnt vmcnt(0)" ::: "memory");
          __syncthreads();
        }
        EpiMerge e; e.gate = (const u16*)(ws + OFF_GATE); e.mrg = (u16*)(ws + OFF_MRG);
        run_merge(lds, (const u16*)(ws + OFF_Y5), (const u16*)(ws + OFF_WBR5) + (size_t)layer * 5 * DM * 256, e);
      } else if ((k == 4 && (PHMASK & 16)) || (k == 6 && (PHMASK & 64))) {
        const bool dn = (k == 6);
        EpiResid e; e.xold = (!dn && layer == 0) ? (pp.in[0] + (size_t)chunk * TC * DM) : xc; e.xout = xc; e.xb = (u16*)XBc; e.ssq = SSQc;
        const u16* A = dn ? (const u16*)(ws + OFF_GATE) : (const u16*)(ws + OFF_MRG);
        const u16* W = dn ? (const u16*)(ws + OFF_WDN) + (size_t)layer * DM * DMLP : (const u16*)(ws + OFF_WOUT) + (size_t)layer * DM * DM;
        run_gemm(lds, A, W, TC, DM, dn ? DMLP : DM, e);
      }
    }
   }
    if (ph + 1 < p.ph_hi) {
      if (ph == 0) grid.sync();
      else xcd_barrier(xb);
    }
  }
#if PROBE_CLOCK
  {
    xcd_barrier(xb);
    const unsigned long long pc_t1 = clock64(), pc_r1 = wall_clock64();
    const float ghz = (float)(pc_t1 - pc_t0) / ((float)(pc_r1 - pc_r0) * 10.0f);
    const int nrows = (int)(ghz * 0.25f * (float)T);
    for (int r = blockIdx.x; r < nrows; r += gridDim.x)
      for (int c = threadIdx.x; c < DM; c += NTHR) p.out[(size_t)r * DM + c] = 0.f;
  }
#endif
}

extern "C" void kernel_launch(void* const* d_in, const int* in_sizes, int n_in, void* d_out, int out_size, void* d_ws, size_t ws_size,
                              hipStream_t stream) {
  static int grid_blocks = 0;
  if (grid_blocks == 0) {
    if (n_in != 19 || out_size != T * DM || ws_size < WS_END) {
      fprintf(stderr, "kernel_launch: unexpected problem (n_in %d out %d ws %zu need %zu)\n", n_in, out_size, ws_size, (size_t)WS_END);
      grid_blocks = -1;
      return;
    }
    int dev = 0, cus = 0, per_cu = 0;
    (void)hipGetDevice(&dev);
    (void)hipDeviceGetAttribute(&cus, hipDeviceAttributeMultiprocessorCount, dev);
    if (hipFuncSetAttribute((const void*)mk_forward, hipFuncAttributeMaxDynamicSharedMemorySize, LDS_BYTES) != hipSuccess) {
      fprintf(stderr, "kernel_launch: hipFuncSetAttribute failed\n"); grid_blocks = -1; return;
    }
    (void)hipOccupancyMaxActiveBlocksPerMultiprocessor(&per_cu, mk_forward, NTHR, LDS_BYTES);
    if (per_cu < 1) fprintf(stderr, "kernel_launch: occupancy query says %d blocks per CU\n", per_cu);
    (void)hipGetLastError();
    grid_blocks = cus;
  }
  if (grid_blocks < 0) return;
  Params p{};
  for (int i = 0; i < 19; ++i) p.in[i] = (const float*)d_in[i];
  p.out = (float*)d_out;
  p.ws = (unsigned char*)d_ws;
#if FUSED
  (void)hipMemsetAsync((unsigned char*)d_ws + OFF_BAR, 0, XCD_BAR_WORDS * 4, stream);
  p.ph_lo = 0; p.ph_hi = NPHASE;
  void* args[] = {&p};
  hipError_t e = hipLaunchCooperativeKernel((const void*)mk_forward, dim3(grid_blocks), dim3(NTHR), args, LDS_BYTES, stream);
  if (e != hipSuccess) fprintf(stderr, "cooperative launch failed: %s (grid %d)\n", hipGetErrorString(e), grid_blocks);
#else
  for (int ph = 0; ph < NPHASE; ++ph) {
    p.ph_lo = ph; p.ph_hi = ph + 1;
    hipLaunchKernelGGL(mk_forward, dim3(grid_blocks), dim3(NTHR), LDS_BYTES, stream, p);
  }
#endif
}
```

```cpp
#include <hip/hip_runtime.h>
#include <hip/hip_cooperative_groups.h>
#include <cstdio>
namespace cg = cooperative_groups;

#ifndef PHMASK
#define PHMASK 255
#endif
#ifndef DUPMASK
#define DUPMASK 0
#endif
#ifndef DUPK
#define DUPK -1
#endif
#ifndef PROBE_CLOCK
#define PROBE_CLOCK 0
#endif
#ifndef PROBE_NOEPI
#define PROBE_NOEPI 0
#endif
#ifndef FUSED
#define FUSED 1
#endif

namespace pg8 {
#define PG8_LAS __attribute__((address_space(3)))
typedef unsigned short bf16_t;
typedef short bf16x8 __attribute__((ext_vector_type(8)));
typedef float f32x4 __attribute__((ext_vector_type(4)));
typedef unsigned u32x4 __attribute__((ext_vector_type(4)));
constexpr int BM = 256, BK = 64, HALF = 128, HTB = HALF * BK * 2  , STAGE_BYTES = 8 * HTB, NXCD = 8, WGM = 8;

__host__ __device__ __forceinline__ int lds_byte(int r, int c) { const int st = (r >> 4) * 2 + (c >> 5), rr = r & 15, cc = c & 31, ob = rr * 64 + cc * 2; return st * 1024 + (ob ^ (((ob >> 9) & 1) << 5)); }
__host__ __device__ __forceinline__ void stage_rc(int b, int& R, int& C) { const int st = b / 1024, sb = b % 1024, swz = sb ^ (((sb >> 9) & 1) << 5); R = (st >> 1) * 16 + swz / 64; C = (st & 1) * 32 + (swz % 64) / 2; }
__host__ __device__ __forceinline__ int perm32(int rho) { const int n = rho >> 4, i = rho & 15; return 8 * (i >> 2) + 4 * n + (i & 3); }

struct Unit { int pm, pn, seg; };
struct Gemm { const bf16_t* A; const bf16_t* Bt; int M, N, K; };

struct StaticOrder {
    int nM, nN, nwg, G, c, probe = 0;
    __host__ __device__ void init(int M, int N, int G_, int c_) { nM = M / BM; nN = N / BM; nwg = nM * nN; G = G_; c = c_; }
    __host__ __device__ bool next(int i, Unit& u) const {
        const long L = (long)i * G + c; if (L >= nwg) return false;
        int wgid = (int)L; { const int q = nwg / NXCD, r = nwg % NXCD, xcd = wgid % NXCD, off = wgid / NXCD; wgid = (xcd < r ? xcd * (q + 1) : r * (q + 1) + (xcd - r) * q) + off; }
        const int nig = WGM * nN, gid = wgid / nig, fm = gid * WGM, gsz = (nM - fm) < WGM ? (nM - fm) : WGM;
        u.pm = fm + ((wgid % nig) % gsz); u.pn = (wgid % nig) / gsz; u.seg = 0; if (probe) { u.pm = 0; u.pn = 0; } return true;
    }
    __device__ __forceinline__ void a_ready(const Unit&) const {}
    __device__ __forceinline__ void done(const Unit&) const {}
    __device__ __forceinline__ const char* baseA(const Gemm& g, const Unit& u, size_t tstep) const { return (const char*)g.A + (size_t)u.pm * tstep; }
    __device__ __forceinline__ const char* baseB(const Gemm& g, const Unit& u, size_t tstep) const { return (const char*)g.Bt + (size_t)u.pn * tstep; }
    __device__ __forceinline__ bool zero_after(const Unit&) const { return true; }
};

template <class Epi, class Sched, bool STAMP = false>
__device__ __forceinline__ void gemm_phase(PG8_LAS unsigned char* lds, const Gemm g, const Sched& S, const Epi& E, unsigned long long* stamps) {
    int tid = threadIdx.x; asm volatile("" : "+v"(tid));
    const int wid = __builtin_amdgcn_readfirstlane(tid >> 6), lane = tid & 63, wr = wid >> 2, wc = wid & 3, fr = lane & 15, fq = lane >> 4;
    const int K = g.K, nt = K / BK;
    int ts_lo = 0, ts_hi = 0, nts = 0; const unsigned long long rt_entry = STAMP ? (unsigned long long)wall_clock64() : 0ull;
#define PG8_STAMP() do { if (STAMP && wid == 0 && nts < 64) { const unsigned long long _c = (unsigned long long)clock64(); \
        ts_lo = (lane == nts) ? (int)(unsigned)_c : ts_lo; ts_hi = (lane == nts) ? (int)(unsigned)(_c >> 32) : ts_hi; ++nts; } } while (0)
    PG8_STAMP();
    unsigned voffA[2], voffB[2];
#pragma unroll
    for (int i = 0; i < 2; ++i) { int R, C; stage_rc(tid * 16 + i * 8192, R, C); const int Rb = Epi::PERM ? ((R & ~31) + perm32(R & 31)) : R;
        voffA[i] = (unsigned)(R * K + C) * 2u; voffB[i] = (unsigned)(Rb * K + C) * 2u; }
    const size_t kstep = (size_t)(BK * 2);
    const size_t hstep = (size_t)HALF * K * 2;
    const size_t tstep = 2 * hstep;
    const unsigned ldsw = (unsigned)wid * 1024u;
    const int aoff = lds_byte(wr * 64 + fr, fq * 8), boff = lds_byte(wc * 32 + fr, fq * 8);
#define PG8_SA(b, h) (((b) * 2 + (h)) * HTB)
#define PG8_SB(b, h) ((4 + (b) * 2 + (h)) * HTB)
#define PG8_STAGE(bufoff, gbase, voff) do { _Pragma("unroll") for (int _i = 0; _i < 2; ++_i) \
        __builtin_amdgcn_global_load_lds((const unsigned*)((const char*)(gbase) + (voff)[_i]), (PG8_LAS unsigned*)(lds + (bufoff) + ldsw + _i * 8192), 16, 0, 0); } while (0)
#define PG8_LDA(dst, b, h) do { _Pragma("unroll") for (int m = 0; m < 4; ++m) _Pragma("unroll") for (int k = 0; k < 2; ++k) dst[m][k] = *(const PG8_LAS bf16x8*)(lds + PG8_SA(b, h) + aoff + m * 2048 + k * 1024); } while (0)
#define PG8_LDB(dst, b, h) do { _Pragma("unroll") for (int n = 0; n < 2; ++n) _Pragma("unroll") for (int k = 0; k < 2; ++k) dst[n][k] = *(const PG8_LAS bf16x8*)(lds + PG8_SB(b, h) + boff + n * 2048 + k * 1024); } while (0)
#define PG8_MMA(ai, bj, At, Bt) do { __builtin_amdgcn_s_setprio(1); _Pragma("unroll") for (int m = 0; m < 4; ++m) _Pragma("unroll") for (int n = 0; n < 2; ++n) _Pragma("unroll") for (int k = 0; k < 2; ++k) \
        acc[ai][bj][m][n] = __builtin_amdgcn_mfma_f32_16x16x32_bf16(Bt[n][k], At[m][k], acc[ai][bj][m][n], 0, 0, 0); __builtin_amdgcn_s_setprio(0); } while (0)
#define PG8_WAIT_V(n) asm volatile("s_waitcnt vmcnt(" #n ")" ::: "memory")
#define PG8_WAIT_L(n) asm volatile("s_waitcnt lgkmcnt(" #n ")" ::: "memory")
#define PG8_BAR __builtin_amdgcn_s_barrier()
#define PG8_SCHED __builtin_amdgcn_sched_barrier(0)
    Unit cur, nxt; int ui = 0;
    if (!S.next(0, cur)) return;
    f32x4 acc[2][2][4][2];
#pragma unroll
    for (int a = 0; a < 2; ++a)
#pragma unroll
        for (int b = 0; b < 2; ++b)
#pragma unroll
            for (int m = 0; m < 4; ++m)
#pragma unroll
                for (int n = 0; n < 2; ++n) acc[a][b][m][n] = (f32x4){0.f, 0.f, 0.f, 0.f};
    bf16x8 At[4][2], B0[2][2], B1[2][2];
    const char* cA = S.baseA(g, cur, tstep); const char* cB = S.baseB(g, cur, tstep);
    S.a_ready(cur);
    PG8_STAGE(PG8_SB(0, 0), cB, voffB); PG8_STAGE(PG8_SA(0, 0), cA, voffA); PG8_STAGE(PG8_SB(0, 1), cB + hstep, voffB); PG8_STAGE(PG8_SA(0, 1), cA + hstep, voffA);
    if (wr == 1) PG8_BAR;
    PG8_WAIT_V(4); PG8_BAR;
    PG8_STAGE(PG8_SB(1, 0), cB + kstep, voffB); PG8_STAGE(PG8_SA(1, 0), cA + kstep, voffA); PG8_STAGE(PG8_SB(1, 1), cB + hstep + kstep, voffB);
    PG8_WAIT_V(6); PG8_BAR;
    PG8_STAMP();
    for (;;) {
        const bool has_next = S.next(ui + 1, nxt);
        const char* nA = has_next ? S.baseA(g, nxt, tstep) : cA; const char* nB = has_next ? S.baseB(g, nxt, tstep) : cB;
        for (int t = 0; t < nt; t += 2) {
            const bool last = (t == nt - 2);
            const char* a1 = cA + (size_t)(t + 1) * kstep;
            const char* a2 = last ? nA : cA + (size_t)(t + 2) * kstep; const char* b2 = last ? nB : cB + (size_t)(t + 2) * kstep;
            const char* a3 = a2 + kstep; const char* b3 = b2 + kstep;
            if (last && has_next) S.a_ready(nxt);
            PG8_LDB(B0, 0, 0); PG8_SCHED; PG8_LDA(At, 0, 0); PG8_STAGE(PG8_SA(1, 1), a1 + hstep, voffA);
            PG8_WAIT_L(8); PG8_BAR; PG8_WAIT_L(0); PG8_MMA(0, 0, At, B0); PG8_BAR; PG8_SCHED;
            PG8_LDB(B1, 0, 1); PG8_STAGE(PG8_SB(0, 0), b2, voffB);
            PG8_BAR; PG8_WAIT_L(0); PG8_MMA(0, 1, At, B1); PG8_BAR;
            PG8_LDA(At, 0, 1); PG8_STAGE(PG8_SA(0, 0), a2, voffA);
            PG8_BAR; PG8_WAIT_L(0); PG8_MMA(1, 0, At, B0); PG8_BAR; PG8_SCHED;
            PG8_STAGE(PG8_SB(0, 1), b2 + hstep, voffB);
            PG8_WAIT_V(6); PG8_BAR; PG8_MMA(1, 1, At, B1); PG8_BAR;
            PG8_LDB(B0, 1, 0); PG8_SCHED; PG8_LDA(At, 1, 0); PG8_STAGE(PG8_SA(0, 1), a2 + hstep, voffA);
            PG8_WAIT_L(8); PG8_BAR; PG8_WAIT_L(0); PG8_MMA(0, 0, At, B0); PG8_BAR; PG8_SCHED;
            PG8_LDB(B1, 1, 1); PG8_STAGE(PG8_SB(1, 0), b3, voffB);
            PG8_BAR; PG8_WAIT_L(0); PG8_MMA(0, 1, At, B1); PG8_BAR;
            PG8_LDA(At, 1, 1); PG8_STAGE(PG8_SA(1, 0), a3, voffA);
            PG8_BAR; PG8_WAIT_L(0); PG8_MMA(1, 0, At, B0); PG8_BAR; PG8_SCHED;
            PG8_STAGE(PG8_SB(1, 1), b3 + hstep, voffB);
            PG8_WAIT_V(6); PG8_BAR; PG8_MMA(1, 1, At, B1); PG8_BAR;
        }
        PG8_STAMP();
        if constexpr (!Epi::AFTER_DRAIN) { E(acc, cur, wr, wc, fr, fq); S.done(cur); }
        PG8_STAMP();
        if (!has_next) break;
        if (S.zero_after(cur))
#pragma unroll
        for (int a = 0; a < 2; ++a)
#pragma unroll
            for (int b = 0; b < 2; ++b)
#pragma unroll
                for (int m = 0; m < 4; ++m)
#pragma unroll
                    for (int n = 0; n < 2; ++n) acc[a][b][m][n] = (f32x4){0.f, 0.f, 0.f, 0.f};
        cur = nxt; cA = nA; cB = nB; ++ui;
    }
    PG8_WAIT_V(0);
    if (wr == 0) PG8_BAR;
    PG8_BAR;
    if constexpr (Epi::AFTER_DRAIN) { E.fused(acc, cur, wr, wc, fr, fq, lds, wid, lane); S.done(cur); }
    PG8_STAMP();
    if (STAMP && wid == 0) { stamps[lane] = lane < nts ? (((unsigned long long)(unsigned)ts_hi << 32) | (unsigned)ts_lo) : 0ull;
        if (lane == 62) stamps[62] = rt_entry; if (lane == 63) stamps[63] = (unsigned long long)wall_clock64(); }
#undef PG8_STAMP
#undef PG8_SA
#undef PG8_SB
#undef PG8_STAGE
#undef PG8_LDA
#undef PG8_LDB
#undef PG8_MMA
#undef PG8_WAIT_V
#undef PG8_WAIT_L
#undef PG8_BAR
#undef PG8_SCHED
}
}

typedef unsigned short u16;
typedef short bf16x8 __attribute__((ext_vector_type(8)));
typedef float f32x16 __attribute__((ext_vector_type(16)));
typedef float f32x4 __attribute__((ext_vector_type(4)));
typedef __bf16 bf2_t __attribute__((ext_vector_type(2)));
typedef float f2_t __attribute__((ext_vector_type(2)));
typedef unsigned u32x4 __attribute__((ext_vector_type(4)));
typedef unsigned u32x2 __attribute__((ext_vector_type(2)));
using pg8::Unit;

#define DI __device__ __forceinline__
#define MFMA32(a, b, c) __builtin_amdgcn_mfma_f32_32x32x16_bf16((a), (b), (c), 0, 0, 0)

constexpr int DM = 1024, SEQ = 4096, NBATCH = 8, T = NBATCH * SEQ;
constexpr int NCH = 2, BC = NBATCH / NCH, TC = BC * SEQ;
constexpr int INC = 7552, DMLP = 4096;
constexpr int NQKG = 6656;
constexpr int NQKH = 38, NVH = 16;
constexpr float LOG2E = 1.4426950408889634f;
constexpr int NTHR = 512;

constexpr size_t al256(size_t x) { return (x + 255) & ~(size_t)255; }
constexpr size_t OFF_WQKG = 0;
constexpr size_t OFF_WV   = OFF_WQKG + al256((size_t)2 * NQKG * DM * 2);
constexpr size_t OFF_WBR5 = OFF_WV   + al256((size_t)2 * DM * DM * 2);
constexpr size_t OFF_WOUT = OFF_WBR5 + al256((size_t)2 * 5 * DM * 256 * 2);
constexpr size_t OFF_WUP  = OFF_WOUT + al256((size_t)2 * DM * DM * 2);
constexpr size_t OFF_WDN  = OFF_WUP  + al256((size_t)2 * DMLP * DM * 2);
constexpr size_t OFF_ROPE = OFF_WDN  + al256((size_t)2 * DM * DMLP * 2);
constexpr size_t OFF_XB   = OFF_ROPE + al256((size_t)SEQ * 96 * 4);
constexpr size_t OFF_SSQ  = OFF_XB   + al256((size_t)T * DM * 2);
constexpr size_t OFF_QK   = OFF_SSQ  + al256((size_t)T * 16 * 4);
constexpr size_t OFF_V    = OFF_QK   + al256((size_t)NQKH * TC * 64 * 2);
constexpr size_t OFF_GATE = OFF_V    + al256((size_t)NVH * TC * 64 * 2);
constexpr size_t OFF_Y5   = OFF_GATE + al256((size_t)TC * 4096 * 2);
constexpr size_t OFF_BO   = OFF_Y5   + al256((size_t)5 * TC * 256 * 2);
constexpr size_t OFF_LSE  = OFF_BO   + al256((size_t)TC * 384 * 2);
constexpr size_t OFF_MRG  = OFF_LSE  + al256((size_t)TC * 8 * 4);
constexpr size_t OFF_BAR  = OFF_MRG  + al256((size_t)TC * DM * 2);
constexpr size_t WS_END   = OFF_BAR  + 16384;
static_assert(WS_END <= (size_t)512 * 1024 * 1024, "workspace too large");

constexpr int LDS_STAGE = 131072;
constexpr int VT_STRIDE = 528;
constexpr int LDS_XBW = 256 * VT_STRIDE;
constexpr int LDS_BYTES = LDS_XBW + 64;
constexpr int PPL = (DUPK >= 0) ? 7 : 6;
constexpr int NPHASE = 1 + NCH * 2 * PPL;

struct Params {
  const float* in[19];
  float* out;
  unsigned char* ws;
  int ph_lo, ph_hi;
};

DI unsigned pk2(float a, float b) { f2_t v = {a, b}; bf2_t r = __builtin_convertvector(v, bf2_t); return __builtin_bit_cast(unsigned, r); }
DI float bf_lo(unsigned u) { return __uint_as_float(u << 16); }
DI float bf_hi(unsigned u) { return __uint_as_float(u & 0xffff0000u); }
DI float fexp2(float x) { return __builtin_amdgcn_exp2f(x); }
DI int crow(int i, int h) { return (i & 3) + 8 * (i >> 2) + 4 * h; }
DI bf16x8 as_bf8(u32x4 v) { return __builtin_bit_cast(bf16x8, v); }
DI int dil_of(int gi) { return gi == 0 ? 1 : (gi == 1 ? 4 : 16); }
DI int dlg_of(int gi) { return gi * 2; }
DI float row_rscale(const float* ssq, size_t tok) {
  const f32x4 a = *(const f32x4*)(ssq + tok * 16), b = *(const f32x4*)(ssq + tok * 16 + 4);
  const f32x4 c = *(const f32x4*)(ssq + tok * 16 + 8), d = *(const f32x4*)(ssq + tok * 16 + 12);
  const float s = ((a[0] + a[1]) + (a[2] + a[3])) + ((b[0] + b[1]) + (b[2] + b[3])) + ((c[0] + c[1]) + (c[2] + c[3])) + ((d[0] + d[1]) + (d[2] + d[3]));
  return rsqrtf(s * (1.0f / 1024.0f) + 1e-6f);
}
DI int qk_head_col(int h) {
  if (h < 8) return 64 * h;
  if (h < 10) return 512 + 64 * (h - 8);
  if (h < 16) return 768 + 64 * (h - 10);
  if (h < 22) return 1152 + 64 * (h - 16);
  if (h < 26) return 1920 + 64 * (h - 22);
  if (h < 30) return 2176 + 64 * (h - 26);
  if (h < 34) return 2688 + 64 * (h - 30);
  return 2944 + 64 * (h - 34);
}
DI int v_head_col(int vh) {
  if (vh < 2) return 640 + 64 * vh;
  if (vh < 8) return 1536 + 64 * (vh - 2);
  if (vh < 12) return 2432 + 64 * (vh - 8);
  return 3200 + 64 * (vh - 12);
}

struct EpiQKG {
  static constexpr bool PERM = false, AFTER_DRAIN = false;
  const float* ssq; u16* qk; const float* rope; const float* gA; const float* gB; const float* gC; const float* gD;
  DI void operator()(const f32x4 (&acc)[2][2][4][2], const Unit& u, int wr, int wc, int fr, int fq) const {
    const int hidx = u.pn * 4 + wc;
    if (hidx >= NQKH) return;
    int kind, dlg = 0; const float* gain;
    if (hidx < 8) { kind = 0; gain = gA; }
    else if (hidx < 10) { kind = 0; gain = gA + 64; }
    else if (hidx < 16) { kind = 0; gain = gB; dlg = dlg_of((hidx - 10) >> 1); }
    else if (hidx < 22) { kind = 0; gain = gB + 64; dlg = dlg_of((hidx - 16) >> 1); }
    else if (hidx < 26) { kind = 2; gain = gC; }
    else if (hidx < 30) { kind = 2; gain = gC + 32; }
    else if (hidx < 34) { kind = 1; gain = gD; }
    else { kind = 1; gain = gD + 64; }
    u16* gbase = qk + (size_t)hidx * TC * 64;
    const float* gainl = gain + 4 * fq;
    const float qpre = (hidx >= 22 && hidx < 26) ? (0.17677669529663687f * LOG2E)
                     : ((hidx < 8 || (hidx >= 10 && hidx < 16) || (hidx >= 30 && hidx < 34)) ? (0.125f * LOG2E) : 1.0f);
#pragma unroll
    for (int ai = 0; ai < 2; ++ai)
#pragma unroll
      for (int m = 0; m < 4; ++m) {
        const int tok = u.pm * 256 + 128 * ai + 64 * wr + 16 * m + fr;
        const int bl = tok >> 12, pos = tok & 4095;
        const float rs = row_rscale(ssq, tok);
        const int pdom = ((pos & ((1 << dlg) - 1)) << (12 - dlg)) + (pos >> dlg);
        const int blk = pdom >> 5, rr = pdom & 31;
        u16* base = gbase + (size_t)bl * SEQ * 64;
        if (kind != 2) {
          float ss = 0.f;
#pragma unroll
          for (int bj = 0; bj < 2; ++bj)
#pragma unroll
            for (int n = 0; n < 2; ++n)
#pragma unroll
              for (int e = 0; e < 4; ++e) ss += acc[ai][bj][m][n][e] * acc[ai][bj][m][n][e];
          ss += __shfl_xor(ss, 16); ss += __shfl_xor(ss, 32);
          const float sc = rs * rsqrtf(ss * rs * rs * (1.0f / 64.0f) + 1e-6f) * qpre;
#pragma unroll
          for (int n = 0; n < 2; ++n) {
            f32x4 xa = acc[ai][0][m][n] * sc * *(const f32x4*)(gainl + 16 * n);
            f32x4 xb2 = acc[ai][1][m][n] * sc * *(const f32x4*)(gainl + 32 + 16 * n);
            if (kind == 0) {
              const f32x4 c4 = *(const f32x4*)(rope + pos * 96 + 16 * n + 4 * fq);
              const f32x4 s4 = *(const f32x4*)(rope + pos * 96 + 32 + 16 * n + 4 * fq);
              const f32x4 ta = xa * c4 - xb2 * s4, tb = xb2 * c4 + xa * s4;
              xa = ta; xb2 = tb;
            }
            u32x2 w0 = {pk2(xa[0], xa[1]), pk2(xa[2], xa[3])};
            *(u32x2*)(base + ((size_t)(blk * 4 + n) * 64 + (fq >> 1) * 32 + rr) * 8 + 4 * (fq & 1)) = w0;
            u32x2 w1 = {pk2(xb2[0], xb2[1]), pk2(xb2[2], xb2[3])};
            *(u32x2*)(base + ((size_t)(blk * 4 + 2 + n) * 64 + (fq >> 1) * 32 + rr) * 8 + 4 * (fq & 1)) = w1;
          }
        } else {
          const f32x4 c4 = *(const f32x4*)(rope + pos * 96 + 64 + 4 * fq);
          const f32x4 s4 = *(const f32x4*)(rope + pos * 96 + 80 + 4 * fq);
#pragma unroll
          for (int bj = 0; bj < 2; ++bj) {
            float ss = 0.f;
#pragma unroll
            for (int n = 0; n < 2; ++n)
#pragma unroll
              for (int e = 0; e < 4; ++e) ss += acc[ai][bj][m][n][e] * acc[ai][bj][m][n][e];
            ss += __shfl_xor(ss, 16); ss += __shfl_xor(ss, 32);
            const float sc = rs * rsqrtf(ss * rs * rs * (1.0f / 32.0f) + 1e-6f) * qpre;
            const f32x4 xa = acc[ai][bj][m][0] * sc * *(const f32x4*)(gainl);
            const f32x4 xb2 = acc[ai][bj][m][1] * sc * *(const f32x4*)(gainl + 16);
            const f32x4 ta = xa * c4 - xb2 * s4, tb = xb2 * c4 + xa * s4;
            u16* sb = base + (size_t)bj * SEQ * 32;
            u32x2 w0 = {pk2(ta[0], ta[1]), pk2(ta[2], ta[3])};
            *(u32x2*)(sb + ((size_t)(blk * 2 + 0) * 64 + (fq >> 1) * 32 + rr) * 8 + 4 * (fq & 1)) = w0;
            u32x2 w1 = {pk2(tb[0], tb[1]), pk2(tb[2], tb[3])};
            *(u32x2*)(sb + ((size_t)(blk * 2 + 1) * 64 + (fq >> 1) * 32 + rr) * 8 + 4 * (fq & 1)) = w1;
          }
        }
        asm volatile("" ::: "memory");
      }
  }
};

struct EpiGateUp {
  static constexpr bool PERM = true, AFTER_DRAIN = false;
  const float* ssq; u16* o; int mode;
  template <bool UP>
  DI void body(const f32x4 (&acc)[2][2][4][2], const Unit& u, int wr, int wc, int fr, int fq) const {
    const int c0 = u.pn * 256 + 32 * wc + 8 * fq;
#pragma unroll
    for (int ai = 0; ai < 2; ++ai)
#pragma unroll
      for (int m = 0; m < 4; ++m) {
        const size_t tok = (size_t)u.pm * 256 + 128 * ai + 64 * wr + 16 * m + fr;
        const float rs = row_rscale(ssq, tok);
#pragma unroll
        for (int bj = 0; bj < 2; ++bj) {
          float r[8];
#pragma unroll
          for (int n = 0; n < 2; ++n) {
            const f32x4 v = acc[ai][bj][m][n] * rs;
#pragma unroll
            for (int e = 0; e < 4; ++e) {
              if (UP) { const float z = fmaxf(v[e], 0.f); r[4 * n + e] = z * z; }
              else r[4 * n + e] = __builtin_amdgcn_rcpf(1.0f + fexp2(-LOG2E * v[e]));
            }
          }
          u32x4 w = {pk2(r[0], r[1]), pk2(r[2], r[3]), pk2(r[4], r[5]), pk2(r[6], r[7])};
          *(u32x4*)(o + tok * 4096 + c0 + 128 * bj) = w;
        }
        asm volatile("" ::: "memory");
      }
  }
  DI void operator()(const f32x4 (&acc)[2][2][4][2], const Unit& u, int wr, int wc, int fr, int fq) const {
    if (mode == 2) return;
    if (mode == 1) body<true>(acc, u, wr, wc, fr, fq);
    else body<false>(acc, u, wr, wc, fr, fq);
  }
};

struct EpiVT {
  static constexpr bool PERM = false, AFTER_DRAIN = true;
  const float* ssq; u16* vbuf;
  DI void operator()(const f32x4 (&)[2][2][4][2], const Unit&, int, int, int, int) const {}
  DI void fused(const f32x4 (&acc)[2][2][4][2], const Unit& u, int wr, int wc, int fr, int fq, PG8_LAS unsigned char* lds, int wid, int lane) const {
    f32x4 rs4[2][2];
#pragma unroll
    for (int bj = 0; bj < 2; ++bj)
#pragma unroll
      for (int n = 0; n < 2; ++n) {
        const size_t t0 = (size_t)u.pn * 256 + 128 * bj + 32 * wc + 16 * n + 4 * fq;
#pragma unroll
        for (int e = 0; e < 4; ++e) { rs4[bj][n][e] = row_rscale(ssq, t0 + e); asm volatile("" ::: "memory"); }
      }
#pragma unroll
    for (int ai = 0; ai < 2; ++ai)
#pragma unroll
      for (int m = 0; m < 4; ++m) {
        const int r = 128 * ai + 64 * wr + 16 * m + fr;
#pragma unroll
        for (int bj = 0; bj < 2; ++bj)
#pragma unroll
          for (int n = 0; n < 2; ++n) {
            const f32x4 v = acc[ai][bj][m][n] * rs4[bj][n];
            u32x2 w = {pk2(v[0], v[1]), pk2(v[2], v[3])};
            *(PG8_LAS u32x2*)(lds + r * VT_STRIDE + (128 * bj + 32 * wc + 16 * n + 4 * fq) * 2) = w;
          }
      }
    __syncthreads();
    const int tid = wid * 64 + lane;
    const int bl = (u.pn * 256) >> 12, pos0 = (u.pn * 256) & 4095;
#pragma unroll 1
    for (int it = 0; it < 16; ++it) {
      const int uidx = it * 512 + tid;
      const int dvlo = uidx & 31, hh = (uidx >> 5) & 1, rb = (uidx >> 6) & 1, half = (uidx >> 7) & 15, h = uidx >> 11;
      const int vgrp = u.pm * 4 + h;
      const int dlg = (vgrp >= 2 && vgrp < 8) ? dlg_of((vgrp - 2) >> 1) : 0;
      const int cls = half >> (4 - dlg), hc = half & ((16 >> dlg) - 1);
      const int m0 = pos0 >> dlg, mh = m0 + 16 * hc;
      const int s = (mh >> 4) & 1, dblk = cls * (128 >> dlg) + (mh >> 5);
      const PG8_LAS unsigned char* row = lds + (h * 64 + rb * 32 + dvlo) * VT_STRIDE;
      unsigned short k8[8];
#pragma unroll
      for (int j = 0; j < 8; ++j) {
        const int tau = ((16 * hc + 4 * hh + (j & 3) + 8 * (j >> 2)) << dlg) + cls;
        k8[j] = *(const PG8_LAS unsigned short*)(row + tau * 2);
      }
      u32x4 w = {(unsigned)k8[0] | ((unsigned)k8[1] << 16), (unsigned)k8[2] | ((unsigned)k8[3] << 16),
                 (unsigned)k8[4] | ((unsigned)k8[5] << 16), (unsigned)k8[6] | ((unsigned)k8[7] << 16)};
      u16* dst = vbuf + (size_t)vgrp * TC * 64 + (size_t)bl * SEQ * 64 + ((size_t)((dblk * 2 + rb) * 2 + s) * 64 + hh * 32 + dvlo) * 8;
      *(u32x4*)dst = w;
    }
    __syncthreads();
  }
};

struct MergeOrder : pg8::StaticOrder {
  const u16* ybase; const u16* wbase;
  DI bool next(int i, Unit& u) const { if (i >= 5) return false; if (!pg8::StaticOrder::next(0, u)) return false; u.seg = i; return true; }
  DI const char* baseA(const pg8::Gemm&, const Unit& u, size_t tstep) const { return (const char*)(ybase + (size_t)u.seg * TC * 256) + (size_t)u.pm * tstep; }
  DI const char* baseB(const pg8::Gemm&, const Unit& u, size_t tstep) const { return (const char*)(wbase + (size_t)u.seg * DM * 256) + (size_t)u.pn * tstep; }
  DI bool zero_after(const Unit& u) const { return u.seg == 4; }
};
struct EpiMerge {
  static constexpr bool PERM = true, AFTER_DRAIN = false;
  const u16* gate; u16* mrg;
  DI void operator()(f32x4 (&acc)[2][2][4][2], const Unit& u, int wr, int wc, int fr, int fq) const {
    const int seg = u.seg;
    if (seg == 0) return;
    const bool last = (seg == 4);
    const int gnum = last ? 3 : seg - 1, gden = last ? 3 : seg;
#pragma unroll
    for (int ai = 0; ai < 2; ++ai)
#pragma unroll
      for (int m = 0; m < 4; ++m) {
        const size_t tok = (size_t)u.pm * 256 + 128 * ai + 64 * wr + 16 * m + fr;
#pragma unroll
        for (int bj = 0; bj < 2; ++bj) {
          const int c = u.pn * 256 + 128 * bj + 32 * wc + 8 * fq;
          const u32x4 gn = *(const u32x4*)(gate + tok * 4096 + gnum * 1024 + c);
          const u32x4 gd = *(const u32x4*)(gate + tok * 4096 + gden * 1024 + c);
#pragma unroll
          for (int n = 0; n < 2; ++n) {
            f32x4 f;
            f[0] = bf_lo(gn[2 * n]); f[1] = bf_hi(gn[2 * n]); f[2] = bf_lo(gn[2 * n + 1]); f[3] = bf_hi(gn[2 * n + 1]);
            if (!last) {
              f[0] *= __builtin_amdgcn_rcpf(bf_lo(gd[2 * n])); f[1] *= __builtin_amdgcn_rcpf(bf_hi(gd[2 * n]));
              f[2] *= __builtin_amdgcn_rcpf(bf_lo(gd[2 * n + 1])); f[3] *= __builtin_amdgcn_rcpf(bf_hi(gd[2 * n + 1]));
            }
            acc[ai][bj][m][n] *= f;
          }
          if (last) {
            const f32x4 v0 = acc[ai][bj][m][0], v1 = acc[ai][bj][m][1];
            u32x4 w = {pk2(v0[0], v0[1]), pk2(v0[2], v0[3]), pk2(v1[0], v1[1]), pk2(v1[2], v1[3])};
            *(u32x4*)(mrg + tok * DM + c) = w;
          }
        }
        asm volatile("" ::: "memory");
      }
  }
};

struct EpiResid {
  static constexpr bool PERM = true, AFTER_DRAIN = false;
  const float* xold; float* xout; u16* xb; float* ssq;
  DI void operator()(const f32x4 (&acc)[2][2][4][2], const Unit& u, int wr, int wc, int fr, int fq) const {
#pragma unroll
    for (int ai = 0; ai < 2; ++ai)
#pragma unroll
      for (int m = 0; m < 4; ++m) {
        const size_t tok = (size_t)u.pm * 256 + 128 * ai + 64 * wr + 16 * m + fr;
        float ss = 0.f;
#pragma unroll
        for (int bj = 0; bj < 2; ++bj) {
          const size_t o = tok * DM + u.pn * 256 + 128 * bj + 32 * wc + 8 * fq;
          const f32x4 v0 = *(const f32x4*)(xold + o) + acc[ai][bj][m][0];
          const f32x4 v1 = *(const f32x4*)(xold + o + 4) + acc[ai][bj][m][1];
          *(f32x4*)(xout + o) = v0;
          *(f32x4*)(xout + o + 4) = v1;
          u32x4 w = {pk2(v0[0], v0[1]), pk2(v0[2], v0[3]), pk2(v1[0], v1[1]), pk2(v1[2], v1[3])};
          *(u32x4*)(xb + o) = w;
          ss += ((v0[0] * v0[0] + v0[1] * v0[1]) + (v0[2] * v0[2] + v0[3] * v0[3])) + ((v1[0] * v1[0] + v1[1] * v1[1]) + (v1[2] * v1[2] + v1[3] * v1[3]));
        }
        ss += __shfl_xor(ss, 16); ss += __shfl_xor(ss, 32);
        if (fq == 0) ssq[tok * 16 + u.pn * 4 + wc] = ss;
        asm volatile("" ::: "memory");
      }
  }
};

template <class Epi>
DI void run_merge(PG8_LAS unsigned char* lds, const u16* ybase, const u16* wbase, const Epi& E) {
  int K = 256; asm volatile("" : "+s"(K));
  pg8::Gemm g; g.A = ybase; g.Bt = wbase; g.M = TC; g.N = DM; g.K = K;
  MergeOrder S; S.init(TC, DM, (int)gridDim.x, (int)blockIdx.x); S.ybase = ybase; S.wbase = wbase;
  pg8::gemm_phase<Epi, MergeOrder, false>(lds, g, S, E, nullptr);
}
template <class Epi>
DI void run_gemm(PG8_LAS unsigned char* lds, const u16* A, const u16* Bt, int M, int N, int K, const Epi& E, int probe = 0) {
  asm volatile("" : "+s"(K));
  pg8::Gemm g; g.A = A; g.Bt = Bt; g.M = M; g.N = N; g.K = K;
  pg8::StaticOrder S; S.init(M, N, (int)gridDim.x, (int)blockIdx.x); S.probe = probe;
  pg8::gemm_phase<Epi, pg8::StaticOrder, false>(lds, g, S, E, nullptr);
}

DI void cvt_load(const float* __restrict__ src, int N, int k0, int n0, const float* __restrict__ g, float* t, int ht) {
  const int c4 = (ht & 15) * 4;
#pragma unroll
  for (int i = 0; i < 4; ++i) {
    const int kk = (ht >> 4) + 16 * i;
    f32x4 v = *(const f32x4*)(src + (size_t)(k0 + kk) * N + n0 + c4);
    const float sc = g ? g[k0 + kk] : 1.0f;
    t[kk * 65 + c4 + 0] = v[0] * sc; t[kk * 65 + c4 + 1] = v[1] * sc; t[kk * 65 + c4 + 2] = v[2] * sc; t[kk * 65 + c4 + 3] = v[3] * sc;
  }
}
DI void cvt_store(u16* __restrict__ dst, int ldk, int kdst, int d0, int d1, const float* t, int ht) {
  const int kc = (ht & 7) * 8, nn = ht >> 3;
#pragma unroll
  for (int i = 0; i < 2; ++i) {
    const int tn = nn + 32 * i, row = (i == 0) ? d0 + nn : d1 + nn;
    u32x4 w;
    w[0] = pk2(t[(kc + 0) * 65 + tn], t[(kc + 1) * 65 + tn]);
    w[1] = pk2(t[(kc + 2) * 65 + tn], t[(kc + 3) * 65 + tn]);
    w[2] = pk2(t[(kc + 4) * 65 + tn], t[(kc + 5) * 65 + tn]);
    w[3] = pk2(t[(kc + 6) * 65 + tn], t[(kc + 7) * 65 + tn]);
    *(u32x4*)(dst + (size_t)row * ldk + kdst + kc) = w;
  }
}
struct CvtJob { const float* src; int N, k0, n0; const float* g; u16* dst; int ldk, d0, d1, kd; };
DI CvtJob cvt_job(const Params& p, int l, int ti) {
  CvtJob j; j.g = nullptr; j.kd = -1;
  const float* attn_g = p.in[1] + l * DM;
  if (ti < 608) { const int h = ti >> 4, kt = ti & 15; j.src = p.in[2] + (size_t)l * DM * INC; j.N = INC; j.k0 = kt * 64; j.n0 = qk_head_col(h); j.g = attn_g;
    j.dst = (u16*)(p.ws + OFF_WQKG) + (size_t)l * NQKG * DM; j.ldk = DM; j.d0 = (h >> 2) * 256 + (h & 3) * 32; j.d1 = j.d0 + 128; return j; }
  ti -= 608;
  if (ti < 1024) { const int c = ti >> 4, kt = ti & 15; j.src = p.in[2] + (size_t)l * DM * INC; j.N = INC; j.k0 = kt * 64; j.n0 = 3456 + 64 * c; j.g = attn_g;
    j.dst = (u16*)(p.ws + OFF_WQKG) + (size_t)l * NQKG * DM; j.ldk = DM; j.d0 = 2560 + 64 * c; j.d1 = j.d0 + 32; return j; }
  ti -= 1024;
  if (ti < 256) { const int vh = ti >> 4, kt = ti & 15; j.src = p.in[2] + (size_t)l * DM * INC; j.N = INC; j.k0 = kt * 64; j.n0 = v_head_col(vh); j.g = attn_g;
    j.dst = (u16*)(p.ws + OFF_WV) + (size_t)l * DM * DM; j.ldk = DM; j.d0 = vh * 64; j.d1 = j.d0 + 32; return j; }
  ti -= 256;
  if (ti < 128) { j.src = p.in[11] + (size_t)l * 512 * DM; j.N = DM; j.k0 = (ti >> 4) * 64; j.n0 = (ti & 15) * 64; j.dst = (u16*)(p.ws + OFF_WBR5) + ((size_t)l * 5 + (j.k0 >> 8)) * DM * 256; j.ldk = 256; j.kd = j.k0 & 255; j.d0 = j.n0; j.d1 = j.n0 + 32; return j; }
  ti -= 128;
  if (ti < 32) { j.src = p.in[12] + (size_t)l * 128 * DM; j.N = DM; j.k0 = (ti >> 4) * 64; j.n0 = (ti & 15) * 64; j.dst = (u16*)(p.ws + OFF_WBR5) + ((size_t)l * 5 + 2) * DM * 256; j.ldk = 256; j.kd = j.k0; j.d0 = j.n0; j.d1 = j.n0 + 32; return j; }
  ti -= 32;
  if (ti < 64) { j.src = p.in[13] + (size_t)l * 256 * DM; j.N = DM; j.k0 = (ti >> 4) * 64; j.n0 = (ti & 15) * 64; j.dst = (u16*)(p.ws + OFF_WBR5) + ((size_t)l * 5 + 3) * DM * 256; j.ldk = 256; j.kd = j.k0; j.d0 = j.n0; j.d1 = j.n0 + 32; return j; }
  ti -= 64;
  if (ti < 64) { j.src = p.in[14] + (size_t)l * 256 * DM; j.N = DM; j.k0 = (ti >> 4) * 64; j.n0 = (ti & 15) * 64; j.dst = (u16*)(p.ws + OFF_WBR5) + ((size_t)l * 5 + 4) * DM * 256; j.ldk = 256; j.kd = j.k0; j.d0 = j.n0; j.d1 = j.n0 + 32; return j; }
  ti -= 64;
  if (ti < 256) { j.src = p.in[15] + (size_t)l * DM * DM; j.N = DM; j.k0 = (ti >> 4) * 64; j.n0 = (ti & 15) * 64; j.dst = (u16*)(p.ws + OFF_WOUT) + (size_t)l * DM * DM; j.ldk = DM; j.d0 = j.n0; j.d1 = j.n0 + 32; return j; }
  ti -= 256;
  if (ti < 1024) { j.src = p.in[17] + (size_t)l * DM * DMLP; j.N = DMLP; j.k0 = (ti >> 6) * 64; j.n0 = (ti & 63) * 64; j.g = p.in[16] + l * DM;
    j.dst = (u16*)(p.ws + OFF_WUP) + (size_t)l * DMLP * DM; j.ldk = DM; j.d0 = j.n0; j.d1 = j.n0 + 32; return j; }
  ti -= 1024;
  j.src = p.in[18] + (size_t)l * DMLP * DM; j.N = DM; j.k0 = (ti >> 4) * 64; j.n0 = (ti & 15) * 64; j.dst = (u16*)(p.ws + OFF_WDN) + (size_t)l * DM * DMLP; j.ldk = DMLP; j.d0 = j.n0; j.d1 = j.n0 + 32; return j;
}

__device__ void phase_prep(const Params& p, int tid_, int bid_, int nblk_, unsigned char* smem) {
  const int half = tid_ >> 8, ht = tid_ & 255;
  float* t = (float*)smem + half * (64 * 65);
  const int per_layer = 4480, total = 2 * per_layer;
  for (int jp = bid_; jp * 2 < total; jp += nblk_) {
    const int j = jp * 2 + half;
    const bool on = j < total;
    CvtJob job;
    if (on) { job = cvt_job(p, j / per_layer, j % per_layer); cvt_load(job.src, job.N, job.k0, job.n0, job.g, t, ht); }
    __syncthreads();
    if (on) cvt_store(job.dst, job.ldk, (job.kd >= 0) ? job.kd : job.k0, job.d0, job.d1, t, ht);
    __syncthreads();
  }
  {
    const u32x4 z = {0u, 0u, 0u, 0u};
    for (int e = bid_ * NTHR + tid_; e < 2 * 128 * 128; e += nblk_ * NTHR) {
      const int l = e >> 14, r = (e >> 7) & 127, c = (e & 127) * 8;
      const int row = 9 * 256 + ((r < 64) ? 64 + r : 128 + r);
      *(u32x4*)((u16*)(p.ws + OFF_WQKG) + ((size_t)l * NQKG + row) * DM + c) = z;
    }
    for (int e = bid_ * NTHR + tid_; e < 2 * 1024 * 16; e += nblk_ * NTHR) {
      const int l = e >> 14, r = (e >> 4) & 1023, c = 128 + (e & 15) * 8;
      *(u32x4*)((u16*)(p.ws + OFF_WBR5) + (((size_t)l * 5 + 2) * DM + r) * 256 + c) = z;
    }
  }
  float* rope = (float*)(p.ws + OFF_ROPE);
  for (int e = bid_ * NTHR + tid_; e < SEQ * 48; e += nblk_ * NTHR) {
    const int pos = e / 48, i = e % 48;
    float inv;
    if (i < 32) inv = exp2f(-13.287712379549449f * (float)(2 * i) / 64.0f);
    else inv = exp2f(-13.287712379549449f * (float)(2 * (i - 32)) / 32.0f);
    const float angf = (float)pos * inv;
    const double ang = (double)angf;
    const double n = rint(ang * 0.15915494309189535);
    const float r = (float)(ang - n * 6.283185307179586);
    const float c = cosf(r), s = sinf(r);
    if (i < 32) { rope[pos * 96 + i] = c; rope[pos * 96 + 32 + i] = s; }
    else { rope[pos * 96 + 64 + (i - 32)] = c; rope[pos * 96 + 80 + (i - 32)] = s; }
  }
  u16* XB = (u16*)(p.ws + OFF_XB); float* SSQ = (float*)(p.ws + OFF_SSQ);
  const int lane = tid_ & 63;
  const int gw = bid_ * 8 + (tid_ >> 6), nw = nblk_ * 8;
  for (int row = gw; row < T; row += nw) {
    const float* xr = p.in[0] + (size_t)row * DM;
    float ss = 0.f;
#pragma unroll
    for (int i = 0; i < 4; ++i) {
      const f32x4 v = *(const f32x4*)(xr + i * 256 + lane * 4);
      ss += v[0] * v[0] + v[1] * v[1] + v[2] * v[2] + v[3] * v[3];
      u32x2 w = {pk2(v[0], v[1]), pk2(v[2], v[3])};
      *(u32x2*)(XB + (size_t)row * DM + i * 256 + lane * 4) = w;
    }
#pragma unroll
    for (int o = 32; o >= 1; o >>= 1) ss += __shfl_xor(ss, o);
    if (lane < 16) SSQ[(size_t)row * 16 + lane] = (lane == 0) ? ss : 0.f;
  }
}

DI void attn_softmax_pv(f32x16& S, float& m, float& l, f32x16& O0, f32x16& O1, const bf16x8 (&vf)[2][2]) {
  float mx = S[0];
#pragma unroll
  for (int i = 1; i < 16; ++i) mx = fmaxf(mx, S[i]);
  mx = fmaxf(mx, __shfl_xor(mx, 32));
  const float mn = fmaxf(m, mx);
  const float alpha = fexp2(m - mn);
  m = mn;
  float sum = 0.f;
#pragma unroll
  for (int i = 0; i < 16; ++i) { S[i] = fexp2(S[i] - mn); sum += S[i]; }
  l = l * alpha + sum;
  const u32x4 p0 = {pk2(S[0], S[1]), pk2(S[2], S[3]), pk2(S[4], S[5]), pk2(S[6], S[7])};
  const u32x4 p1 = {pk2(S[8], S[9]), pk2(S[10], S[11]), pk2(S[12], S[13]), pk2(S[14], S[15])};
#pragma unroll
  for (int i = 0; i < 16; ++i) { O0[i] *= alpha; O1[i] *= alpha; }
  O0 = MFMA32(vf[0][0], as_bf8(p0), O0);
  O0 = MFMA32(vf[0][1], as_bf8(p1), O0);
  O1 = MFMA32(vf[1][0], as_bf8(p0), O1);
  O1 = MFMA32(vf[1][1], as_bf8(p1), O1);
}
DI void attn_fixed_pv(f32x16& S, f32x16& L, f32x16& O0, f32x16& O1, const bf16x8 (&vf)[2][2], const bf16x8 ones) {
#pragma unroll
  for (int i = 0; i < 16; ++i) S[i] = fexp2(S[i]);
  const u32x4 p0 = {pk2(S[0], S[1]), pk2(S[2], S[3]), pk2(S[4], S[5]), pk2(S[6], S[7])};
  const u32x4 p1 = {pk2(S[8], S[9]), pk2(S[10], S[11]), pk2(S[12], S[13]), pk2(S[14], S[15])};
  O0 = MFMA32(vf[0][0], as_bf8(p0), O0);
  O0 = MFMA32(vf[0][1], as_bf8(p1), O0);
  O1 = MFMA32(vf[1][0], as_bf8(p0), O1);
  O1 = MFMA32(vf[1][1], as_bf8(p1), O1);
  float sum = 0.f;
#pragma unroll
  for (int i = 0; i < 16; ++i) sum += S[i];
  L[0] += sum;
}
DI void attn_plain_pv(f32x16& S, float& l, f32x16& O0, f32x16& O1, const bf16x8 (&vf)[2][2]) {
  float sum = 0.f;
#pragma unroll
  for (int i = 0; i < 16; ++i) { S[i] = fexp2(S[i]); sum += S[i]; }
  l += sum;
  const u32x4 p0 = {pk2(S[0], S[1]), pk2(S[2], S[3]), pk2(S[4], S[5]), pk2(S[6], S[7])};
  const u32x4 p1 = {pk2(S[8], S[9]), pk2(S[10], S[11]), pk2(S[12], S[13]), pk2(S[14], S[15])};
  O0 = MFMA32(vf[0][0], as_bf8(p0), O0); O1 = MFMA32(vf[1][0], as_bf8(p0), O1);
  O0 = MFMA32(vf[0][1], as_bf8(p1), O0); O1 = MFMA32(vf[1][1], as_bf8(p1), O1);
}
DI float gain_bound64(const float* g) {
  float a = 0.f, b = 0.f;
  for (int i = 0; i < 64; ++i) { a = fmaxf(a, fabsf(g[i])); b = fmaxf(b, fabsf(g[64 + i])); }
  return fminf(8.0f * a * b * 1.02f + 0.05f, 40.0f);
}
DI void load_vf(bf16x8 (&vf)[2][2], const u16* V, int kb, int lane) {
#pragma unroll
  for (int rb = 0; rb < 2; ++rb)
#pragma unroll
    for (int s = 0; s < 2; ++s) vf[rb][s] = *(const bf16x8*)(V + ((size_t)((kb * 2 + rb) * 2 + s) * 64 + lane) * 8);
}
DI void load_kf4(bf16x8 (&kf)[4], const u16* K, int kb, int lane) {
#pragma unroll
  for (int s = 0; s < 4; ++s) kf[s] = *(const bf16x8*)(K + ((size_t)(kb * 4 + s) * 64 + lane) * 8);
}
DI void load_kf2(bf16x8 (&kf)[2], const u16* K, int kb, int lane) {
#pragma unroll
  for (int s = 0; s < 2; ++s) kf[s] = *(const bf16x8*)(K + ((size_t)(kb * 2 + s) * 64 + lane) * 8);
}
DI void zero16(f32x16& a) {
#pragma unroll
  for (int i = 0; i < 16; ++i) a[i] = 0.f;
}
DI void store_o(u16* yrow, const f32x16& O0, const f32x16& O1, float sc, int h) {
#pragma unroll
  for (int g4 = 0; g4 < 4; ++g4) {
    u32x2 w0 = {pk2(O0[4 * g4] * sc, O0[4 * g4 + 1] * sc), pk2(O0[4 * g4 + 2] * sc, O0[4 * g4 + 3] * sc)};
    *(u32x2*)(yrow + 8 * g4 + 4 * h) = w0;
    u32x2 w1 = {pk2(O1[4 * g4] * sc, O1[4 * g4 + 1] * sc), pk2(O1[4 * g4 + 2] * sc, O1[4 * g4 + 3] * sc)};
    *(u32x2*)(yrow + 32 + 8 * g4 + 4 * h) = w1;
  }
}

__device__ void phase_attn(const Params& p, int tid_, int bid_, int nblk_, int layer) {
  const u16* QK = (const u16*)(p.ws + OFF_QK);
  const u16* VB = (const u16*)(p.ws + OFF_V);
  u16* Y5 = (u16*)(p.ws + OFF_Y5);
  u16* BO = (u16*)(p.ws + OFF_BO);
  float* LSE = (float*)(p.ws + OFF_LSE);
  const int lane = tid_ & 63, wave = tid_ >> 6;
  const int fr = lane & 31, fh = lane >> 5;
  const int nloc = nblk_ >> 3;
  if ((int)(bid_ >> 3) >= nloc) return;
  const int vw = ((bid_ & 7) * nloc + (bid_ >> 3)) * 8 + wave, NW = nloc * 64;
  const size_t GS = (size_t)TC * 64;
  const size_t BS = (size_t)SEQ * 64;

  {
    const float* lp = p.in[7] + layer * 128;
    float d01 = 0.f, d23 = 0.f;
    for (int i = 0; i < 32; ++i) { d01 += lp[i] * lp[32 + i]; d23 += lp[64 + i] * lp[96 + i]; }
    const float lambda_init = (layer == 0) ? 0.2f : 0.35550907f;
    const float lam = __expf(d01) - __expf(d23) + lambda_init;
    const float* subg = p.in[8] + layer * 64;
    const float sc = 0.17677669529663687f * LOG2E;
    float gqm = 0.f, gkm = 0.f;
    for (int i = 0; i < 32; ++i) { gqm = fmaxf(gqm, fabsf(p.in[6][layer * 64 + i])); gkm = fmaxf(gkm, fabsf(p.in[6][layer * 64 + 32 + i])); }
    const unsigned onev = ((fr & 27) == 0) ? 0x3f803f80u : 0u;
    const u32x4 ones4 = {onev, onev, onev, onev};
    const bf16x8 ones = as_bf8(ones4);
    const float cbound = 5.6568542f * gqm * gkm * 1.02f + 0.05f;
    for (int it = vw; it < BC * 4 * 128; it += NW) {
      const int bl = it >> 9, head = (it >> 7) & 3, qblk = it & 127;
      const u16* Q0 = QK + (22 + head) * GS + bl * BS; const u16* Q1 = Q0 + SEQ * 32;
      const u16* K0 = QK + (26 + head) * GS + bl * BS; const u16* K1 = K0 + SEQ * 32;
      const u16* V = VB + (8 + head) * GS + bl * BS;
      bf16x8 q0[2], q1[2];
      load_kf2(q0, Q0, qblk, lane); load_kf2(q1, Q1, qblk, lane);
      f32x16 L0, L1; zero16(L0); zero16(L1);
      f32x16 O00, O01, O10, O11; zero16(O00); zero16(O01); zero16(O10); zero16(O11);
      bf16x8 k0[2], k1[2], vf[2][2];
      {
        const float mb2 = fminf(cbound, 40.0f) * LOG2E;
        f32x16 sinit;
#pragma unroll
        for (int i = 0; i < 16; ++i) sinit[i] = -mb2;
        load_kf2(k0, K0, 0, lane); load_kf2(k1, K1, 0, lane); load_vf(vf, V, 0, lane);
        f32x16 S0 = sinit, S1 = sinit;
        S0 = MFMA32(k0[0], q0[0], S0); S0 = MFMA32(k0[1], q0[1], S0);
        S1 = MFMA32(k1[0], q1[0], S1); S1 = MFMA32(k1[1], q1[1], S1);
        load_kf2(k0, K0, 1, lane); load_kf2(k1, K1, 1, lane);
        for (int kb = 0; kb < 128; ++kb) {
          bf16x8 nk0[2], nk1[2], nvf[2][2];
          const int k2 = (kb + 2 < 128) ? kb + 2 : 127, v1 = (kb + 1 < 128) ? kb + 1 : 127;
          load_kf2(nk0, K0, k2, lane); load_kf2(nk1, K1, k2, lane); load_vf(nvf, V, v1, lane);
          f32x16 S0n = sinit, S1n = sinit;
#pragma unroll
          for (int i = 0; i < 16; ++i) S0[i] = fexp2(S0[i]);
          S0n = MFMA32(k0[0], q0[0], S0n); S0n = MFMA32(k0[1], q0[1], S0n);
          {
            const u32x4 p0 = {pk2(S0[0], S0[1]), pk2(S0[2], S0[3]), pk2(S0[4], S0[5]), pk2(S0[6], S0[7])};
            const u32x4 p1 = {pk2(S0[8], S0[9]), pk2(S0[10], S0[11]), pk2(S0[12], S0[13]), pk2(S0[14], S0[15])};
            O00 = MFMA32(vf[0][0], as_bf8(p0), O00); O01 = MFMA32(vf[1][0], as_bf8(p0), O01);
            O00 = MFMA32(vf[0][1], as_bf8(p1), O00); O01 = MFMA32(vf[1][1], as_bf8(p1), O01);
            float sum = 0.f;
#pragma unroll
            for (int i = 0; i < 16; ++i) sum += S0[i];
            L0[0] += sum;
          }
#pragma unroll
          for (int i = 0; i < 16; ++i) S1[i] = fexp2(S1[i]);
          S1n = MFMA32(k1[0], q1[0], S1n); S1n = MFMA32(k1[1], q1[1], S1n);
          {
            const u32x4 p0 = {pk2(S1[0], S1[1]), pk2(S1[2], S1[3]), pk2(S1[4], S1[5]), pk2(S1[6], S1[7])};
            const u32x4 p1 = {pk2(S1[8], S1[9]), pk2(S1[10], S1[11]), pk2(S1[12], S1[13]), pk2(S1[14], S1[15])};
            O10 = MFMA32(vf[0][0], as_bf8(p0), O10); O11 = MFMA32(vf[1][0], as_bf8(p0), O11);
            O10 = MFMA32(vf[0][1], as_bf8(p1), O10); O11 = MFMA32(vf[1][1], as_bf8(p1), O11);
            float sum = 0.f;
#pragma unroll
            for (int i = 0; i < 16; ++i) sum += S1[i];
            L1[0] += sum;
          }
          S0 = S0n; S1 = S1n;
#pragma unroll
          for (int s = 0; s < 2; ++s) { k0[s] = nk0[s]; k1[s] = nk1[s]; vf[0][s] = nvf[0][s]; vf[1][s] = nvf[1][s]; }
        }
      }
      const float i0 = 1.0f / (L0[0] + __shfl_xor(L0[0], 32));
      const float i1 = lam / (L1[0] + __shfl_xor(L1[0], 32));
      float ss = 0.f;
#pragma unroll
      for (int i = 0; i < 16; ++i) {
        O00[i] = O00[i] * i0 - O10[i] * i1; O01[i] = O01[i] * i0 - O11[i] * i1;
        ss += O00[i] * O00[i] + O01[i] * O01[i];
      }
      ss += __shfl_xor(ss, 32);
      const float rn = rsqrtf(ss * (1.0f / 64.0f) + 1e-6f) * (1.0f - lambda_init);
#pragma unroll
      for (int g4 = 0; g4 < 4; ++g4) {
        const f32x4 ga = *(const f32x4*)(subg + 8 * g4 + 4 * fh);
        const f32x4 gb = *(const f32x4*)(subg + 32 + 8 * g4 + 4 * fh);
#pragma unroll
        for (int e = 0; e < 4; ++e) { O00[4 * g4 + e] *= ga[e]; O01[4 * g4 + e] *= gb[e]; }
      }
      const size_t tok = (size_t)bl * SEQ + qblk * 32 + fr;
      store_o(Y5 + (size_t)3 * TC * 256 + tok * 256 + head * 64, O00, O01, rn, fh);
    }
  }
  {
    const float mbA = gain_bound64(p.in[3] + layer * 128) * LOG2E;
    f32x16 sinit;
#pragma unroll
    for (int i = 0; i < 16; ++i) sinit[i] = -mbA;
    for (int it = vw; it < BC * 8 * 128; it += NW) {
      const int bl = it >> 10, hq = (it >> 7) & 7, qblk = it & 127;
      const int kvh = hq >> 2;
      const u16* Q = QK + (size_t)hq * GS + bl * BS;
      const u16* K = QK + (size_t)(8 + kvh) * GS + bl * BS;
      const u16* V = VB + (size_t)kvh * GS + bl * BS;
      bf16x8 qf[4]; load_kf4(qf, Q, qblk, lane);
      float l = (fh == 0) ? fexp2(p.in[4][layer * 8 + hq] * LOG2E - mbA) : 0.0f;
      f32x16 O0, O1; zero16(O0); zero16(O1);
      const int kb_lo = (qblk - 4 < 0) ? 0 : qblk - 4, kb_hi = (qblk + 4 > 127) ? 127 : qblk + 4;
      const int qpos = qblk * 32 + fr;
      bf16x8 kf[4], vf[2][2];
      load_kf4(kf, K, kb_lo, lane); load_vf(vf, V, kb_lo, lane);
      for (int kb = kb_lo; kb <= kb_hi; ++kb) {
        bf16x8 nkf[4], nvf[2][2];
        const int kn = (kb < kb_hi) ? kb + 1 : kb;
        load_kf4(nkf, K, kn, lane); load_vf(nvf, V, kn, lane);
        f32x16 S = sinit;
#pragma unroll
        for (int s = 0; s < 4; ++s) S = MFMA32(kf[s], qf[s], S);
        if (kb == qblk - 4 || kb == qblk + 4) {
#pragma unroll
          for (int i = 0; i < 16; ++i) {
            const int dlt = kb * 32 + crow(i, fh) - qpos;
            S[i] = (dlt <= 128 && dlt >= -128) ? S[i] : (-__builtin_inff());
          }
        }
        attn_plain_pv(S, l, O0, O1, vf);
#pragma unroll
        for (int s = 0; s < 4; ++s) kf[s] = nkf[s];
#pragma unroll
        for (int s = 0; s < 2; ++s) { vf[0][s] = nvf[0][s]; vf[1][s] = nvf[1][s]; }
      }
      const float inv = 1.0f / (l + __shfl_xor(l, 32));
      const size_t tok = (size_t)bl * SEQ + qpos;
      store_o(Y5 + (size_t)(hq >> 2) * TC * 256 + tok * 256 + (hq & 3) * 64, O0, O1, inv, fh);
    }
  }
  {
    const float gbD = gain_bound64(p.in[9] + layer * 128);
    for (int it = vw; it < BC * 4 * 128; it += NW) {
      const int bl = it >> 9, head = (it >> 7) & 3, qblk = it & 127;
      const u16* Q = QK + (size_t)(30 + head) * GS + bl * BS;
      const u16* K = QK + (size_t)(34 + head) * GS + bl * BS;
      const u16* V = VB + (size_t)(12 + head) * GS + bl * BS;
      const float* rpb = p.in[10] + (size_t)(layer * 4 + head) * 15 * 31;
      bf16x8 qf[4]; load_kf4(qf, Q, qblk, lane);
      float bmax = 0.f;
      for (int i = lane; i < 15 * 31; i += 64) bmax = fmaxf(bmax, fabsf(rpb[i]));
#pragma unroll
      for (int o = 32; o >= 1; o >>= 1) bmax = fmaxf(bmax, __shfl_xor(bmax, o));
      const float mbD = fminf(gbD + bmax, 60.0f) * LOG2E;
      f32x16 sinit;
#pragma unroll
      for (int i = 0; i < 16; ++i) sinit[i] = -mbD;
      float l = 0.f;
      f32x16 O0, O1; zero16(O0); zero16(O1);
      const int qrow = qblk >> 1, qc = (qblk & 1) * 32 + fr;
      int r0 = qrow - 4; r0 = r0 < 0 ? 0 : (r0 > 56 ? 56 : r0);
      int c0 = qc - 8; c0 = c0 < 0 ? 0 : (c0 > 48 ? 48 : c0);
      bf16x8 kf[4], vf[2][2];
      load_kf4(kf, K, r0 * 2, lane); load_vf(vf, V, r0 * 2, lane);
      for (int kk = 0; kk < 16; ++kk) {
        const int krow_ = r0 + (kk >> 1), hb = kk & 1;
        bf16x8 nkf[4], nvf[2][2];
        const int kn = r0 * 2 + ((kk < 15) ? kk + 1 : kk);
        load_kf4(nkf, K, kn, lane); load_vf(nvf, V, kn, lane);
        f32x16 S = sinit;
#pragma unroll
        for (int s = 0; s < 4; ++s) S = MFMA32(kf[s], qf[s], S);
        const float* brow = rpb + (krow_ - qrow + 7) * 31;
#pragma unroll
        for (int i = 0; i < 16; ++i) {
          const int kc = hb * 32 + crow(i, fh);
          int dc = kc - qc; dc = dc < -15 ? -15 : (dc > 15 ? 15 : dc);
          const float bias = brow[dc + 15];
          S[i] = (kc >= c0 && kc < c0 + 16) ? __builtin_fmaf(bias, LOG2E, S[i]) : (-__builtin_inff());
        }
        attn_plain_pv(S, l, O0, O1, vf);
#pragma unroll
        for (int s = 0; s < 4; ++s) kf[s] = nkf[s];
#pragma unroll
        for (int s = 0; s < 2; ++s) { vf[0][s] = nvf[0][s]; vf[1][s] = nvf[1][s]; }
      }
      const float inv = 1.0f / (l + __shfl_xor(l, 32));
      const size_t tok = (size_t)bl * SEQ + qblk * 32 + fr;
      store_o(Y5 + (size_t)4 * TC * 256 + tok * 256 + head * 64, O0, O1, inv, fh);
    }
  }
  {
    const float mbB = gain_bound64(p.in[5] + layer * 128) * LOG2E;
    f32x16 sinit;
#pragma unroll
    for (int i = 0; i < 16; ++i) sinit[i] = -mbB;
    for (int it = vw; it < BC * 6 * 128; it += NW) {
      const int bl = it / 768, rem = it % 768, head = rem >> 7, qblk = rem & 127;
      const int dil = dil_of(head >> 1), L = SEQ / dil, LB = L >> 5;
      const u16* Q = QK + (size_t)(10 + head) * GS + bl * BS;
      const u16* K = QK + (size_t)(16 + head) * GS + bl * BS;
      const u16* V = VB + (size_t)(2 + head) * GS + bl * BS;
      bf16x8 qf[4]; load_kf4(qf, Q, qblk, lane);
      float l = 0.f;
      f32x16 O0, O1; zero16(O0); zero16(O1);
      const int rsub = qblk / LB;
      const int lo = rsub * LB, hi = lo + LB - 1;
      const int kb_lo = (qblk - 2 < lo) ? lo : qblk - 2, kb_hi = (qblk + 2 > hi) ? hi : qblk + 2;
      const int qd = qblk * 32 + fr;
      bf16x8 kf[4], vf[2][2];
      load_kf4(kf, K, kb_lo, lane); load_vf(vf, V, kb_lo, lane);
      for (int kb = kb_lo; kb <= kb_hi; ++kb) {
        bf16x8 nkf[4], nvf[2][2];
        const int kn = (kb < kb_hi) ? kb + 1 : kb;
        load_kf4(nkf, K, kn, lane); load_vf(nvf, V, kn, lane);
        f32x16 S = sinit;
#pragma unroll
        for (int s = 0; s < 4; ++s) S = MFMA32(kf[s], qf[s], S);
        if (kb == qblk - 2 || kb == qblk + 2) {
#pragma unroll
          for (int i = 0; i < 16; ++i) {
            const int dlt = kb * 32 + crow(i, fh) - qd;
            S[i] = (dlt <= 64 && dlt >= -64) ? S[i] : (-__builtin_inff());
          }
        }
        attn_plain_pv(S, l, O0, O1, vf);
#pragma unroll
        for (int s = 0; s < 4; ++s) kf[s] = nkf[s];
#pragma unroll
        for (int s = 0; s < 2; ++s) { vf[0][s] = nvf[0][s]; vf[1][s] = nvf[1][s]; }
      }
      const float lt = l + __shfl_xor(l, 32);
      const float inv = 1.0f / lt;
      const int msub = qd - rsub * L;
      const int pos = msub * dil + rsub;
      const size_t tok = (size_t)bl * SEQ + pos;
      store_o(BO + tok * 384 + head * 64, O0, O1, inv, fh);
      if (fh == 0) LSE[tok * 8 + head] = __log2f(lt) + mbB;
    }
  }
}


__device__ void phase_bcombine(const Params& p, int tid_, int tok0) {
  const u16* BO = (const u16*)(p.ws + OFF_BO);
  const float* LSE = (const float*)(p.ws + OFF_LSE);
  u16* YB = (u16*)(p.ws + OFF_Y5) + (size_t)2 * TC * 256;
  for (int e = tid_; e < 256 * 16; e += NTHR) {
    const int tok = tok0 + (e >> 4), j = (e >> 3) & 1, c8 = (e & 7) * 8;
    const float a0 = LSE[(size_t)tok * 8 + j], a1 = LSE[(size_t)tok * 8 + 2 + j], a2 = LSE[(size_t)tok * 8 + 4 + j];
    const float mx = fmaxf(a0, fmaxf(a1, a2));
    float w0 = fexp2(a0 - mx), w1 = fexp2(a1 - mx), w2 = fexp2(a2 - mx);
    const float inv = 1.0f / (w0 + w1 + w2);
    w0 *= inv; w1 *= inv; w2 *= inv;
    const u32x4 x0 = *(const u32x4*)(BO + (size_t)tok * 384 + (0 + j) * 64 + c8);
    const u32x4 x1 = *(const u32x4*)(BO + (size_t)tok * 384 + (2 + j) * 64 + c8);
    const u32x4 x2 = *(const u32x4*)(BO + (size_t)tok * 384 + (4 + j) * 64 + c8);
    u32x4 o;
#pragma unroll
    for (int q = 0; q < 4; ++q) {
      const float lo = w0 * bf_lo(x0[q]) + w1 * bf_lo(x1[q]) + w2 * bf_lo(x2[q]);
      const float hi = w0 * bf_hi(x0[q]) + w1 * bf_hi(x1[q]) + w2 * bf_hi(x2[q]);
      o[q] = pk2(lo, hi);
    }
    *(u32x4*)(YB + (size_t)tok * 256 + j * 64 + c8) = o;
    const u32x4 z = {0u, 0u, 0u, 0u};
    *(u32x4*)(YB + (size_t)tok * 256 + 128 + (e & 15) * 8) = z;
  }
}

#define XB_TMO      128
#define XB_XCNT(j)  (256  + 64 * (j))
#define XB_XSUB(j)  (1280 + 64 * (j))
#define XB_XGEN(j)  (2304 + 64 * (j))
#define XB_TOP      3328
#define XB_TOPGEN   3392
#define XCD_BAR_WORDS 3456
#define XB_SPIN_CAP (1u << 22)
#define LAS __attribute__((address_space(3)))
DI unsigned xb_ld(unsigned* p)              { return __hip_atomic_load(p, __ATOMIC_RELAXED, __HIP_MEMORY_SCOPE_AGENT); }
DI unsigned xb_add(unsigned* p, unsigned v) { return __hip_atomic_fetch_add(p, v, __ATOMIC_RELAXED, __HIP_MEMORY_SCOPE_AGENT); }
DI unsigned xb_xcc_id() { return (unsigned)__builtin_amdgcn_s_getreg((3 << 11) | 20) & 0xFu; }
#define XB_SPIN(cond, bar) do { unsigned _sp = 0; while (cond) { __builtin_amdgcn_s_sleep(1); \
    if ((++_sp & 255u) == 0u) { if (xb_ld(&(bar)[XB_TMO])) break; if (_sp > XB_SPIN_CAP) { atomicAdd(&(bar)[XB_TMO], 1u); break; } } } } while (0)
struct XcdBarrier { unsigned* bar; unsigned x; volatile LAS unsigned* st; };
DI XcdBarrier xcd_barrier_post(unsigned* bar, volatile LAS unsigned* st) {
  XcdBarrier b; b.bar = bar; b.x = xb_xcc_id(); b.st = st;
  if (threadIdx.x == 0) (void)xb_add(&bar[XB_XCNT(b.x)], 1u);
  return b;
}
DI void xcd_barrier_complete(unsigned* bar, unsigned x, unsigned& nloc, unsigned& nx) {
  const unsigned G = gridDim.x * gridDim.y * gridDim.z;
  unsigned sum, cnt, mine, sp = 0u;
  for (;;) {
    sum = 0u; cnt = 0u; mine = 0u;
#pragma unroll
    for (unsigned j = 0; j < 16; ++j) { const unsigned c = xb_ld(&bar[XB_XCNT(j)]); sum += c; cnt += (c > 0u) ? 1u : 0u; mine = (j == x) ? c : mine; }
    if (sum == G) break;
    __builtin_amdgcn_s_sleep(1);
    if ((++sp & 255u) == 0u) { if (xb_ld(&bar[XB_TMO])) break; if (sp > XB_SPIN_CAP) { atomicAdd(&bar[XB_TMO], 1u); break; } }
  }
  nloc = mine > 0u ? mine : 1u; nx = cnt > 0u ? cnt : 1u;
}
DI void xcd_barrier(const XcdBarrier& b) {
  asm volatile("s_waitcnt vmcnt(0)" ::: "memory");
  __syncthreads();
  if (threadIdx.x == 0) {
    unsigned* bar = b.bar;
    __builtin_amdgcn_s_waitcnt(0);
    unsigned nloc = b.st[0], nx = b.st[1];
    if (nloc == 0u) { xcd_barrier_complete(bar, b.x, nloc, nx); b.st[0] = nloc; b.st[1] = nx; }
    const unsigned old = xb_add(&bar[XB_XSUB(b.x)], 1u);
    const unsigned gen = old / nloc;
    if (old + 1u == (gen + 1u) * nloc) {
      __builtin_amdgcn_fence(__ATOMIC_RELEASE, "agent");
      asm volatile("s_waitcnt vmcnt(0)" ::: "memory");
      const unsigned og = xb_add(&bar[XB_TOP], 1u);
      const unsigned tg = og / nx;
      if (og + 1u == (tg + 1u) * nx) xb_add(&bar[XB_TOPGEN], 1u);
      else XB_SPIN(xb_ld(&bar[XB_TOPGEN]) == tg, bar);
      __builtin_amdgcn_fence(__ATOMIC_ACQUIRE, "agent");
      xb_add(&bar[XB_XGEN(b.x)], 1u);
      asm volatile("s_waitcnt vmcnt(0)" ::: "memory");
    } else {
      XB_SPIN(xb_ld(&bar[XB_XGEN(b.x)]) == gen, bar);
      __builtin_amdgcn_fence(__ATOMIC_ACQUIRE, "agent");
      asm volatile("s_waitcnt vmcnt(0)" ::: "memory");
    }
  }
  __syncthreads();
}

__global__ void __launch_bounds__(NTHR, 2) mk_forward(Params p) {
  extern __shared__ __attribute__((aligned(16))) unsigned char smem[];
  cg::grid_group grid = cg::this_grid();
  volatile LAS unsigned* xbw = (volatile LAS unsigned*)(smem + LDS_XBW);
  if (threadIdx.x < 4) xbw[threadIdx.x] = 0u;
  __syncthreads();
  XcdBarrier xb;
  if (FUSED) xb = xcd_barrier_post((unsigned*)(p.ws + OFF_BAR), xbw);
#if PROBE_CLOCK
  const unsigned long long pc_t0 = clock64(), pc_r0 = wall_clock64();
#endif
  PG8_LAS unsigned char* lds = (PG8_LAS unsigned char*)smem;
  for (int ph = p.ph_lo; ph < p.ph_hi; ++ph) {
#if DUPMASK
   for (int rep = 0; rep < ((ph > 0 && ((DUPMASK >> ((ph - 1) % 7)) & 1)) ? 2 : 1); ++rep)
#endif
   {
    int tid_ = threadIdx.x, bid_ = blockIdx.x, nblk_ = gridDim.x;
    asm volatile("" : "+v"(tid_));
    asm volatile("" : "+s"(bid_));
    asm volatile("" : "+s"(nblk_));
    Params pp = p;
    asm volatile("" : "+s"(pp.ws));
    asm volatile("" : "+s"(pp.out));
    unsigned char* ws = pp.ws;
    if (ph == 0) {
      if (PHMASK & 128) phase_prep(pp, tid_, bid_, nblk_, smem);
    } else {
      const int q = ph - 1, chunk = q / (2 * PPL), layer = (q % (2 * PPL)) / PPL, kk = q % PPL, k = (kk == 6) ? DUPK : (kk < 2 ? kk : kk + 1);
      const u16* XBc = (const u16*)(ws + OFF_XB) + (size_t)chunk * TC * DM;
      float* SSQc = (float*)(ws + OFF_SSQ) + (size_t)chunk * TC * 16;
      float* xc = pp.out + (size_t)chunk * TC * DM;
      if ((k == 0 && (PHMASK & 1)) || (k == 5 && (PHMASK & 32))) {
        const bool up = (k == 5);
        if (!up) {
          EpiQKG e; e.ssq = SSQc; e.qk = (u16*)(ws + OFF_QK); e.rope = (const float*)(ws + OFF_ROPE);
          e.gA = pp.in[3] + layer * 128; e.gB = pp.in[5] + layer * 128; e.gC = pp.in[6] + layer * 64; e.gD = pp.in[9] + layer * 128;
          run_gemm(lds, XBc, (const u16*)(ws + OFF_WQKG) + (size_t)layer * NQKG * DM, TC, 2560, DM, e);
        }
        {
          EpiGateUp e; e.ssq = SSQc; e.o = (u16*)(ws + OFF_GATE); e.mode = up ? ((PROBE_NOEPI && kk == 6) ? 2 : 1) : 0;
          const u16* W = up ? (const u16*)(ws + OFF_WUP) + (size_t)layer * DMLP * DM : (const u16*)(ws + OFF_WQKG) + ((size_t)layer * NQKG + 2560) * DM;
          run_gemm(lds, XBc, W, TC, 4096, DM, e, (PROBE_NOEPI && kk == 6) ? 1 : 0);
        }
        if (!up) {
          EpiVT ev; ev.ssq = SSQc; ev.vbuf = (u16*)(ws + OFF_V);
          run_gemm(lds, (const u16*)(ws + OFF_WV) + (size_t)layer * DM * DM, XBc, DM, TC, DM, ev);
        }
      } else if (k == 1 && (PHMASK & 2)) {
        phase_attn(pp, tid_, bid_, nblk_, layer);
      } else if (k == 3 && (PHMASK & 8)) {
        {
          Unit u0; pg8::StaticOrder S0; S0.init(TC, DM, nblk_, bid_); S0.next(0, u0);
          phase_bcombine(pp, tid_, u0.pm * 256);
          asm volatile("s_waitcnt vmcnt(0)" ::: "memory");
          __syncthreads();
        }
        EpiMerge e; e.gate = (const u16*)(ws + OFF_GATE); e.mrg = (u16*)(ws + OFF_MRG);
        run_merge(lds, (const u16*)(ws + OFF_Y5), (const u16*)(ws + OFF_WBR5) + (size_t)layer * 5 * DM * 256, e);
      } else if ((k == 4 && (PHMASK & 16)) || (k == 6 && (PHMASK & 64))) {
        const bool dn = (k == 6);
        EpiResid e; e.xold = (!dn && layer == 0) ? (pp.in[0] + (size_t)chunk * TC * DM) : xc; e.xout = xc; e.xb = (u16*)XBc; e.ssq = SSQc;
        const u16* A = dn ? (const u16*)(ws + OFF_GATE) : (const u16*)(ws + OFF_MRG);
        const u16* W = dn ? (const u16*)(ws + OFF_WDN) + (size_t)layer * DM * DMLP : (const u16*)(ws + OFF_WOUT) + (size_t)layer * DM * DM;
        run_gemm(lds, A, W, TC, DM, dn ? DMLP : DM, e);
      }
    }
   }
    if (ph + 1 < p.ph_hi) {
      if (ph == 0) grid.sync();
      else xcd_barrier(xb);
    }
  }
#if PROBE_CLOCK
  {
    xcd_barrier(xb);
    const unsigned long long pc_t1 = clock64(), pc_r1 = wall_clock64();
    const float ghz = (float)(pc_t1 - pc_t0) / ((float)(pc_r1 - pc_r0) * 10.0f);
    const int nrows = (int)(ghz * 0.25f * (float)T);
    for (int r = blockIdx.x; r < nrows; r += gridDim.x)
      for (int c = threadIdx.x; c < DM; c += NTHR) p.out[(size_t)r * DM + c] = 0.f;
  }
#endif
}

extern "C" void kernel_launch(void* const* d_in, const int* in_sizes, int n_in, void* d_out, int out_size, void* d_ws, size_t ws_size,
                              hipStream_t stream) {
  static int grid_blocks = 0;
  if (grid_blocks == 0) {
    if (n_in != 19 || out_size != T * DM || ws_size < WS_END) {
      fprintf(stderr, "kernel_launch: unexpected problem (n_in %d out %d ws %zu need %zu)\n", n_in, out_size, ws_size, (size_t)WS_END);
      grid_blocks = -1;
      return;
    }
    int dev = 0, cus = 0, per_cu = 0;
    (void)hipGetDevice(&dev);
    (void)hipDeviceGetAttribute(&cus, hipDeviceAttributeMultiprocessorCount, dev);
    if (hipFuncSetAttribute((const void*)mk_forward, hipFuncAttributeMaxDynamicSharedMemorySize, LDS_BYTES) != hipSuccess) {
      fprintf(stderr, "kernel_launch: hipFuncSetAttribute failed\n"); grid_blocks = -1; return;
    }
    (void)hipOccupancyMaxActiveBlocksPerMultiprocessor(&per_cu, mk_forward, NTHR, LDS_BYTES);
    if (per_cu < 1) fprintf(stderr, "kernel_launch: occupancy query says %d blocks per CU\n", per_cu);
    (void)hipGetLastError();
    grid_blocks = cus;
  }
  if (grid_blocks < 0) return;
  Params p{};
  for (int i = 0; i < 19; ++i) p.in[i] = (const float*)d_in[i];
  p.out = (float*)d_out;
  p.ws = (unsigned char*)d_ws;
#if FUSED
  (void)hipMemsetAsync((unsigned char*)d_ws + OFF_BAR, 0, XCD_BAR_WORDS * 4, stream);
  p.ph_lo = 0; p.ph_hi = NPHASE;
  void* args[] = {&p};
  hipError_t e = hipLaunchCooperativeKernel((const void*)mk_forward, dim3(grid_blocks), dim3(NTHR), args, LDS_BYTES, stream);
  if (e != hipSuccess) fprintf(stderr, "cooperative launch failed: %s (grid %d)\n", hipGetErrorString(e), grid_blocks);
#else
  for (int ph = 0; ph < NPHASE; ++ph) {
    p.ph_lo = ph; p.ph_hi = ph + 1;
    hipLaunchKernelGGL(mk_forward, dim3(grid_blocks), dim3(NTHR), LDS_BYTES, stream, p);
  }
#endif
}
```

```cpp
#include <hip/hip_runtime.h>
#include <hip/hip_cooperative_groups.h>
#include <cstdio>
namespace cg = cooperative_groups;

#ifndef PHMASK
#define PHMASK 255
#endif
#ifndef DUPMASK
#define DUPMASK 0
#endif
#ifndef DUPK
#define DUPK -1
#endif
#ifndef PROBE_CLOCK
#define PROBE_CLOCK 0
#endif
#ifndef PROBE_NOEPI
#define PROBE_NOEPI 0
#endif
#ifndef FUSED
#define FUSED 1
#endif

namespace pg8 {
#define PG8_LAS __attribute__((address_space(3)))
typedef unsigned short bf16_t;
typedef short bf16x8 __attribute__((ext_vector_type(8)));
typedef float f32x4 __attribute__((ext_vector_type(4)));
typedef unsigned u32x4 __attribute__((ext_vector_type(4)));
constexpr int BM = 256, BK = 64, HALF = 128, HTB = HALF * BK * 2  , STAGE_BYTES = 8 * HTB, NXCD = 8, WGM = 8;

__host__ __device__ __forceinline__ int lds_byte(int r, int c) { const int st = (r >> 4) * 2 + (c >> 5), rr = r & 15, cc = c & 31, ob = rr * 64 + cc * 2; return st * 1024 + (ob ^ (((ob >> 9) & 1) << 5)); }
__host__ __device__ __forceinline__ void stage_rc(int b, int& R, int& C) { const int st = b / 1024, sb = b % 1024, swz = sb ^ (((sb >> 9) & 1) << 5); R = (st >> 1) * 16 + swz / 64; C = (st & 1) * 32 + (swz % 64) / 2; }
__host__ __device__ __forceinline__ int perm32(int rho) { const int n = rho >> 4, i = rho & 15; return 8 * (i >> 2) + 4 * n + (i & 3); }

struct Unit { int pm, pn, seg; };
struct Gemm { const bf16_t* A; const bf16_t* Bt; int M, N, K; };

struct StaticOrder {
    int nM, nN, nwg, G, c, probe = 0;
    __host__ __device__ void init(int M, int N, int G_, int c_) { nM = M / BM; nN = N / BM; nwg = nM * nN; G = G_; c = c_; }
    __host__ __device__ bool next(int i, Unit& u) const {
        const long L = (long)i * G + c; if (L >= nwg) return false;
        int wgid = (int)L; { const int q = nwg / NXCD, r = nwg % NXCD, xcd = wgid % NXCD, off = wgid / NXCD; wgid = (xcd < r ? xcd * (q + 1) : r * (q + 1) + (xcd - r) * q) + off; }
        const int nig = WGM * nN, gid = wgid / nig, fm = gid * WGM, gsz = (nM - fm) < WGM ? (nM - fm) : WGM;
        u.pm = fm + ((wgid % nig) % gsz); u.pn = (wgid % nig) / gsz; u.seg = 0; if (probe) { u.pm = 0; u.pn = 0; } return true;
    }
    __device__ __forceinline__ void a_ready(const Unit&) const {}
    __device__ __forceinline__ void done(const Unit&) const {}
    __device__ __forceinline__ const char* baseA(const Gemm& g, const Unit& u, size_t tstep) const { return (const char*)g.A + (size_t)u.pm * tstep; }
    __device__ __forceinline__ const char* baseB(const Gemm& g, const Unit& u, size_t tstep) const { return (const char*)g.Bt + (size_t)u.pn * tstep; }
    __device__ __forceinline__ bool zero_after(const Unit&) const { return true; }
};

template <class Epi, class Sched, bool STAMP = false>
__device__ __forceinline__ void gemm_phase(PG8_LAS unsigned char* lds, const Gemm g, const Sched& S, const Epi& E, unsigned long long* stamps) {
    int tid = threadIdx.x; asm volatile("" : "+v"(tid));
    const int wid = __builtin_amdgcn_readfirstlane(tid >> 6), lane = tid & 63, wr = wid >> 2, wc = wid & 3, fr = lane & 15, fq = lane >> 4;
    const int K = g.K, nt = K / BK;
    int ts_lo = 0, ts_hi = 0, nts = 0; const unsigned long long rt_entry = STAMP ? (unsigned long long)wall_clock64() : 0ull;
#define PG8_STAMP() do { if (STAMP && wid == 0 && nts < 64) { const unsigned long long _c = (unsigned long long)clock64(); \
        ts_lo = (lane == nts) ? (int)(unsigned)_c : ts_lo; ts_hi = (lane == nts) ? (int)(unsigned)(_c >> 32) : ts_hi; ++nts; } } while (0)
    PG8_STAMP();
    unsigned voffA[2], voffB[2];
#pragma unroll
    for (int i = 0; i < 2; ++i) { int R, C; stage_rc(tid * 16 + i * 8192, R, C); const int Rb = Epi::PERM ? ((R & ~31) + perm32(R & 31)) : R;
        voffA[i] = (unsigned)(R * K + C) * 2u; voffB[i] = (unsigned)(Rb * K + C) * 2u; }
    const size_t kstep = (size_t)(BK * 2);
    const size_t hstep = (size_t)HALF * K * 2;
    const size_t tstep = 2 * hstep;
    const unsigned ldsw = (unsigned)wid * 1024u;
    const int aoff = lds_byte(wr * 64 + fr, fq * 8), boff = lds_byte(wc * 32 + fr, fq * 8);
#define PG8_SA(b, h) (((b) * 2 + (h)) * HTB)
#define PG8_SB(b, h) ((4 + (b) * 2 + (h)) * HTB)
#define PG8_STAGE(bufoff, gbase, voff) do { _Pragma("unroll") for (int _i = 0; _i < 2; ++_i) \
        __builtin_amdgcn_global_load_lds((const unsigned*)((const char*)(gbase) + (voff)[_i]), (PG8_LAS unsigned*)(lds + (bufoff) + ldsw + _i * 8192), 16, 0, 0); } while (0)
#define PG8_LDA(dst, b, h) do { _Pragma("unroll") for (int m = 0; m < 4; ++m) _Pragma("unroll") for (int k = 0; k < 2; ++k) dst[m][k] = *(const PG8_LAS bf16x8*)(lds + PG8_SA(b, h) + aoff + m * 2048 + k * 1024); } while (0)
#define PG8_LDB(dst, b, h) do { _Pragma("unroll") for (int n = 0; n < 2; ++n) _Pragma("unroll") for (int k = 0; k < 2; ++k) dst[n][k] = *(const PG8_LAS bf16x8*)(lds + PG8_SB(b, h) + boff + n * 2048 + k * 1024); } while (0)
#define PG8_MMA(ai, bj, At, Bt) do { __builtin_amdgcn_s_setprio(1); _Pragma("unroll") for (int m = 0; m < 4; ++m) _Pragma("unroll") for (int n = 0; n < 2; ++n) _Pragma("unroll") for (int k = 0; k < 2; ++k) \
        acc[ai][bj][m][n] = __builtin_amdgcn_mfma_f32_16x16x32_bf16(Bt[n][k], At[m][k], acc[ai][bj][m][n], 0, 0, 0); __builtin_amdgcn_s_setprio(0); } while (0)
#define PG8_WAIT_V(n) asm volatile("s_waitcnt vmcnt(" #n ")" ::: "memory")
#define PG8_WAIT_L(n) asm volatile("s_waitcnt lgkmcnt(" #n ")" ::: "memory")
#define PG8_BAR __builtin_amdgcn_s_barrier()
#define PG8_SCHED __builtin_amdgcn_sched_barrier(0)
    Unit cur, nxt; int ui = 0;
    if (!S.next(0, cur)) return;
    f32x4 acc[2][2][4][2];
#pragma unroll
    for (int a = 0; a < 2; ++a)
#pragma unroll
        for (int b = 0; b < 2; ++b)
#pragma unroll
            for (int m = 0; m < 4; ++m)
#pragma unroll
                for (int n = 0; n < 2; ++n) acc[a][b][m][n] = (f32x4){0.f, 0.f, 0.f, 0.f};
    bf16x8 At[4][2], B0[2][2], B1[2][2];
    const char* cA = S.baseA(g, cur, tstep); const char* cB = S.baseB(g, cur, tstep);
    S.a_ready(cur);
    PG8_STAGE(PG8_SB(0, 0), cB, voffB); PG8_STAGE(PG8_SA(0, 0), cA, voffA); PG8_STAGE(PG8_SB(0, 1), cB + hstep, voffB); PG8_STAGE(PG8_SA(0, 1), cA + hstep, voffA);
    if (wr == 1) PG8_BAR;
    PG8_WAIT_V(4); PG8_BAR;
    PG8_STAGE(PG8_SB(1, 0), cB + kstep, voffB); PG8_STAGE(PG8_SA(1, 0), cA + kstep, voffA); PG8_STAGE(PG8_SB(1, 1), cB + hstep + kstep, voffB);
    PG8_WAIT_V(6); PG8_BAR;
    PG8_STAMP();
    for (;;) {
        const bool has_next = S.next(ui + 1, nxt);
        const char* nA = has_next ? S.baseA(g, nxt, tstep) : cA; const char* nB = has_next ? S.baseB(g, nxt, tstep) : cB;
        for (int t = 0; t < nt; t += 2) {
            const bool last = (t == nt - 2);
            const char* a1 = cA + (size_t)(t + 1) * kstep;
            const char* a2 = last ? nA : cA + (size_t)(t + 2) * kstep; const char* b2 = last ? nB : cB + (size_t)(t + 2) * kstep;
            const char* a3 = a2 + kstep; const char* b3 = b2 + kstep;
            if (last && has_next) S.a_ready(nxt);
            PG8_LDB(B0, 0, 0); PG8_SCHED; PG8_LDA(At, 0, 0); PG8_STAGE(PG8_SA(1, 1), a1 + hstep, voffA);
            PG8_WAIT_L(8); PG8_BAR; PG8_WAIT_L(0); PG8_MMA(0, 0, At, B0); PG8_BAR; PG8_SCHED;
            PG8_LDB(B1, 0, 1); PG8_STAGE(PG8_SB(0, 0), b2, voffB);
            PG8_BAR; PG8_WAIT_L(0); PG8_MMA(0, 1, At, B1); PG8_BAR;
            PG8_LDA(At, 0, 1); PG8_STAGE(PG8_SA(0, 0), a2, voffA);
            PG8_BAR; PG8_WAIT_L(0); PG8_MMA(1, 0, At, B0); PG8_BAR; PG8_SCHED;
            PG8_STAGE(PG8_SB(0, 1), b2 + hstep, voffB);
            PG8_WAIT_V(6); PG8_BAR; PG8_MMA(1, 1, At, B1); PG8_BAR;
            PG8_LDB(B0, 1, 0); PG8_SCHED; PG8_LDA(At, 1, 0); PG8_STAGE(PG8_SA(0, 1), a2 + hstep, voffA);
            PG8_WAIT_L(8); PG8_BAR; PG8_WAIT_L(0); PG8_MMA(0, 0, At, B0); PG8_BAR; PG8_SCHED;
            PG8_LDB(B1, 1, 1); PG8_STAGE(PG8_SB(1, 0), b3, voffB);
            PG8_BAR; PG8_WAIT_L(0); PG8_MMA(0, 1, At, B1); PG8_BAR;
            PG8_LDA(At, 1, 1); PG8_STAGE(PG8_SA(1, 0), a3, voffA);
            PG8_BAR; PG8_WAIT_L(0); PG8_MMA(1, 0, At, B0); PG8_BAR; PG8_SCHED;
            PG8_STAGE(PG8_SB(1, 1), b3 + hstep, voffB);
            PG8_WAIT_V(6); PG8_BAR; PG8_MMA(1, 1, At, B1); PG8_BAR;
        }
        PG8_STAMP();
        if constexpr (!Epi::AFTER_DRAIN) { E(acc, cur, wr, wc, fr, fq); S.done(cur); }
        PG8_STAMP();
        if (!has_next) break;
        if (S.zero_after(cur))
#pragma unroll
        for (int a = 0; a < 2; ++a)
#pragma unroll
            for (int b = 0; b < 2; ++b)
#pragma unroll
                for (int m = 0; m < 4; ++m)
#pragma unroll
                    for (int n = 0; n < 2; ++n) acc[a][b][m][n] = (f32x4){0.f, 0.f, 0.f, 0.f};
        cur = nxt; cA = nA; cB = nB; ++ui;
    }
    PG8_WAIT_V(0);
    if (wr == 0) PG8_BAR;
    PG8_BAR;
    if constexpr (Epi::AFTER_DRAIN) { E.fused(acc, cur, wr, wc, fr, fq, lds, wid, lane); S.done(cur); }
    PG8_STAMP();
    if (STAMP && wid == 0) { stamps[lane] = lane < nts ? (((unsigned long long)(unsigned)ts_hi << 32) | (unsigned)ts_lo) : 0ull;
        if (lane == 62) stamps[62] = rt_entry; if (lane == 63) stamps[63] = (unsigned long long)wall_clock64(); }
#undef PG8_STAMP
#undef PG8_SA
#undef PG8_SB
#undef PG8_STAGE
#undef PG8_LDA
#undef PG8_LDB
#undef PG8_MMA
#undef PG8_WAIT_V
#undef PG8_WAIT_L
#undef PG8_BAR
#undef PG8_SCHED
}
}

typedef unsigned short u16;
typedef short bf16x8 __attribute__((ext_vector_type(8)));
typedef float f32x16 __attribute__((ext_vector_type(16)));
typedef float f32x4 __attribute__((ext_vector_type(4)));
typedef __bf16 bf2_t __attribute__((ext_vector_type(2)));
typedef float f2_t __attribute__((ext_vector_type(2)));
typedef unsigned u32x4 __attribute__((ext_vector_type(4)));
typedef unsigned u32x2 __attribute__((ext_vector_type(2)));
using pg8::Unit;

#define DI __device__ __forceinline__
#define MFMA32(a, b, c) __builtin_amdgcn_mfma_f32_32x32x16_bf16((a), (b), (c), 0, 0, 0)

constexpr int DM = 1024, SEQ = 4096, NBATCH = 8, T = NBATCH * SEQ;
constexpr int NCH = 2, BC = NBATCH / NCH, TC = BC * SEQ;
constexpr int INC = 7552, DMLP = 4096;
constexpr int NQKG = 6656;
constexpr int NQKH = 38, NVH = 16;
constexpr float LOG2E = 1.4426950408889634f;
constexpr int NTHR = 512;

constexpr size_t al256(size_t x) { return (x + 255) & ~(size_t)255; }
constexpr size_t OFF_WQKG = 0;
constexpr size_t OFF_WV   = OFF_WQKG + al256((size_t)2 * NQKG * DM * 2);
constexpr size_t OFF_WBR5 = OFF_WV   + al256((size_t)2 * DM * DM * 2);
constexpr size_t OFF_WOUT = OFF_WBR5 + al256((size_t)2 * 5 * DM * 256 * 2);
constexpr size_t OFF_WUP  = OFF_WOUT + al256((size_t)2 * DM * DM * 2);
constexpr size_t OFF_WDN  = OFF_WUP  + al256((size_t)2 * DMLP * DM * 2);
constexpr size_t OFF_ROPE = OFF_WDN  + al256((size_t)2 * DM * DMLP * 2);
constexpr size_t OFF_XB   = OFF_ROPE + al256((size_t)SEQ * 96 * 4);
constexpr size_t OFF_SSQ  = OFF_XB   + al256((size_t)T * DM * 2);
constexpr size_t OFF_QK   = OFF_SSQ  + al256((size_t)T * 16 * 4);
constexpr size_t OFF_V    = OFF_QK   + al256((size_t)NQKH * TC * 64 * 2);
constexpr size_t OFF_GATE = OFF_V    + al256((size_t)NVH * TC * 64 * 2);
constexpr size_t OFF_Y5   = OFF_GATE + al256((size_t)TC * 4096 * 2);
constexpr size_t OFF_BO   = OFF_Y5   + al256((size_t)5 * TC * 256 * 2);
constexpr size_t OFF_LSE  = OFF_BO   + al256((size_t)TC * 384 * 2);
constexpr size_t OFF_MRG  = OFF_LSE  + al256((size_t)TC * 8 * 4);
constexpr size_t OFF_BAR  = OFF_MRG  + al256((size_t)TC * DM * 2);
constexpr size_t WS_END   = OFF_BAR  + 16384;
static_assert(WS_END <= (size_t)512 * 1024 * 1024, "workspace too large");

constexpr int LDS_STAGE = 131072;
constexpr int VT_STRIDE = 528;
constexpr int LDS_XBW = 256 * VT_STRIDE;
constexpr int LDS_BYTES = LDS_XBW + 64 + 1024;
constexpr int PPL = (DUPK >= 0) ? 7 : 6;
constexpr int NPHASE = 1 + NCH * 2 * PPL;

struct Params {
  const float* in[19];
  float* out;
  unsigned char* ws;
  int ph_lo, ph_hi;
};

DI unsigned pk2(float a, float b) { f2_t v = {a, b}; bf2_t r = __builtin_convertvector(v, bf2_t); return __builtin_bit_cast(unsigned, r); }
DI float bf_lo(unsigned u) { return __uint_as_float(u << 16); }
DI float bf_hi(unsigned u) { return __uint_as_float(u & 0xffff0000u); }
DI float fexp2(float x) { return __builtin_amdgcn_exp2f(x); }
DI int crow(int i, int h) { return (i & 3) + 8 * (i >> 2) + 4 * h; }
DI bf16x8 as_bf8(u32x4 v) { return __builtin_bit_cast(bf16x8, v); }
DI int dil_of(int gi) { return gi == 0 ? 1 : (gi == 1 ? 4 : 16); }
DI int dlg_of(int gi) { return gi * 2; }
DI float row_rscale(const float* ssq, size_t tok) {
  const f32x4 a = *(const f32x4*)(ssq + tok * 16), b = *(const f32x4*)(ssq + tok * 16 + 4);
  const f32x4 c = *(const f32x4*)(ssq + tok * 16 + 8), d = *(const f32x4*)(ssq + tok * 16 + 12);
  const float s = ((a[0] + a[1]) + (a[2] + a[3])) + ((b[0] + b[1]) + (b[2] + b[3])) + ((c[0] + c[1]) + (c[2] + c[3])) + ((d[0] + d[1]) + (d[2] + d[3]));
  return rsqrtf(s * (1.0f / 1024.0f) + 1e-6f);
}
DI int qk_head_col(int h) {
  if (h < 8) return 64 * h;
  if (h < 10) return 512 + 64 * (h - 8);
  if (h < 16) return 768 + 64 * (h - 10);
  if (h < 22) return 1152 + 64 * (h - 16);
  if (h < 26) return 1920 + 64 * (h - 22);
  if (h < 30) return 2176 + 64 * (h - 26);
  if (h < 34) return 2688 + 64 * (h - 30);
  return 2944 + 64 * (h - 34);
}
DI int v_head_col(int vh) {
  if (vh < 2) return 640 + 64 * vh;
  if (vh < 8) return 1536 + 64 * (vh - 2);
  if (vh < 12) return 2432 + 64 * (vh - 8);
  return 3200 + 64 * (vh - 12);
}

struct EpiQKG {
  static constexpr bool PERM = false, AFTER_DRAIN = false;
  const float* ssq; u16* qk; const float* rope; const float* gA; const float* gB; const float* gC; const float* gD;
  DI void operator()(const f32x4 (&acc)[2][2][4][2], const Unit& u, int wr, int wc, int fr, int fq) const {
    const int hidx = u.pn * 4 + wc;
    if (hidx >= NQKH) return;
    int kind, dlg = 0; const float* gain;
    if (hidx < 8) { kind = 0; gain = gA; }
    else if (hidx < 10) { kind = 0; gain = gA + 64; }
    else if (hidx < 16) { kind = 0; gain = gB; dlg = dlg_of((hidx - 10) >> 1); }
    else if (hidx < 22) { kind = 0; gain = gB + 64; dlg = dlg_of((hidx - 16) >> 1); }
    else if (hidx < 26) { kind = 2; gain = gC; }
    else if (hidx < 30) { kind = 2; gain = gC + 32; }
    else if (hidx < 34) { kind = 1; gain = gD; }
    else { kind = 1; gain = gD + 64; }
    u16* gbase = qk + (size_t)hidx * TC * 64;
    const float* gainl = gain + 4 * fq;
    const float qpre = (hidx >= 22 && hidx < 26) ? (0.17677669529663687f * LOG2E)
                     : ((hidx < 8 || (hidx >= 10 && hidx < 16) || (hidx >= 30 && hidx < 34)) ? (0.125f * LOG2E) : 1.0f);
#pragma unroll
    for (int ai = 0; ai < 2; ++ai)
#pragma unroll
      for (int m = 0; m < 4; ++m) {
        const int tok = u.pm * 256 + 128 * ai + 64 * wr + 16 * m + fr;
        const int bl = tok >> 12, pos = tok & 4095;
        const float rs = row_rscale(ssq, tok);
        const int pdom = ((pos & ((1 << dlg) - 1)) << (12 - dlg)) + (pos >> dlg);
        const int blk = pdom >> 5, rr = pdom & 31;
        u16* base = gbase + (size_t)bl * SEQ * 64;
        if (kind != 2) {
          float ss = 0.f;
#pragma unroll
          for (int bj = 0; bj < 2; ++bj)
#pragma unroll
            for (int n = 0; n < 2; ++n)
#pragma unroll
              for (int e = 0; e < 4; ++e) ss += acc[ai][bj][m][n][e] * acc[ai][bj][m][n][e];
          ss += __shfl_xor(ss, 16); ss += __shfl_xor(ss, 32);
          const float sc = rs * rsqrtf(ss * rs * rs * (1.0f / 64.0f) + 1e-6f) * qpre;
#pragma unroll
          for (int n = 0; n < 2; ++n) {
            f32x4 xa = acc[ai][0][m][n] * sc * *(const f32x4*)(gainl + 16 * n);
            f32x4 xb2 = acc[ai][1][m][n] * sc * *(const f32x4*)(gainl + 32 + 16 * n);
            if (kind == 0) {
              const f32x4 c4 = *(const f32x4*)(rope + pos * 96 + 16 * n + 4 * fq);
              const f32x4 s4 = *(const f32x4*)(rope + pos * 96 + 32 + 16 * n + 4 * fq);
              const f32x4 ta = xa * c4 - xb2 * s4, tb = xb2 * c4 + xa * s4;
              xa = ta; xb2 = tb;
            }
            u32x2 w0 = {pk2(xa[0], xa[1]), pk2(xa[2], xa[3])};
            *(u32x2*)(base + ((size_t)(blk * 4 + n) * 64 + (fq >> 1) * 32 + rr) * 8 + 4 * (fq & 1)) = w0;
            u32x2 w1 = {pk2(xb2[0], xb2[1]), pk2(xb2[2], xb2[3])};
            *(u32x2*)(base + ((size_t)(blk * 4 + 2 + n) * 64 + (fq >> 1) * 32 + rr) * 8 + 4 * (fq & 1)) = w1;
          }
        } else {
          const f32x4 c4 = *(const f32x4*)(rope + pos * 96 + 64 + 4 * fq);
          const f32x4 s4 = *(const f32x4*)(rope + pos * 96 + 80 + 4 * fq);
#pragma unroll
          for (int bj = 0; bj < 2; ++bj) {
            float ss = 0.f;
#pragma unroll
            for (int n = 0; n < 2; ++n)
#pragma unroll
              for (int e = 0; e < 4; ++e) ss += acc[ai][bj][m][n][e] * acc[ai][bj][m][n][e];
            ss += __shfl_xor(ss, 16); ss += __shfl_xor(ss, 32);
            const float sc = rs * rsqrtf(ss * rs * rs * (1.0f / 32.0f) + 1e-6f) * qpre;
            const f32x4 xa = acc[ai][bj][m][0] * sc * *(const f32x4*)(gainl);
            const f32x4 xb2 = acc[ai][bj][m][1] * sc * *(const f32x4*)(gainl + 16);
            const f32x4 ta = xa * c4 - xb2 * s4, tb = xb2 * c4 + xa * s4;
            u16* sb = base + (size_t)bj * SEQ * 32;
            u32x2 w0 = {pk2(ta[0], ta[1]), pk2(ta[2], ta[3])};
            *(u32x2*)(sb + ((size_t)(blk * 2 + 0) * 64 + (fq >> 1) * 32 + rr) * 8 + 4 * (fq & 1)) = w0;
            u32x2 w1 = {pk2(tb[0], tb[1]), pk2(tb[2], tb[3])};
            *(u32x2*)(sb + ((size_t)(blk * 2 + 1) * 64 + (fq >> 1) * 32 + rr) * 8 + 4 * (fq & 1)) = w1;
          }
        }
        asm volatile("" ::: "memory");
      }
  }
};

struct EpiGateUp {
  static constexpr bool PERM = true, AFTER_DRAIN = false;
  const float* ssq; u16* o; int mode;
  template <bool UP>
  DI void body(const f32x4 (&acc)[2][2][4][2], const Unit& u, int wr, int wc, int fr, int fq) const {
    const int c0 = u.pn * 256 + 32 * wc + 8 * fq;
    float rsv[8];
#pragma unroll
    for (int i = 0; i < 8; ++i) rsv[i] = row_rscale(ssq, (size_t)u.pm * 256 + 128 * (i >> 2) + 64 * wr + 16 * (i & 3) + fr);
#pragma unroll
    for (int ai = 0; ai < 2; ++ai)
#pragma unroll
      for (int m = 0; m < 4; ++m) {
        const size_t tok = (size_t)u.pm * 256 + 128 * ai + 64 * wr + 16 * m + fr;
        const float rs = rsv[ai * 4 + m];
#pragma unroll
        for (int bj = 0; bj < 2; ++bj) {
          float r[8];
#pragma unroll
          for (int n = 0; n < 2; ++n) {
            const f32x4 v = acc[ai][bj][m][n] * rs;
#pragma unroll
            for (int e = 0; e < 4; ++e) {
              if (UP) { const float z = fmaxf(v[e], 0.f); r[4 * n + e] = z * z; }
              else r[4 * n + e] = __builtin_amdgcn_rcpf(1.0f + fexp2(-LOG2E * v[e]));
            }
          }
          u32x4 w = {pk2(r[0], r[1]), pk2(r[2], r[3]), pk2(r[4], r[5]), pk2(r[6], r[7])};
          *(u32x4*)(o + tok * 4096 + c0 + 128 * bj) = w;
        }
        asm volatile("" ::: "memory");
      }
  }
  DI void operator()(const f32x4 (&acc)[2][2][4][2], const Unit& u, int wr, int wc, int fr, int fq) const {
    if (mode == 2) return;
    if (mode == 1) body<true>(acc, u, wr, wc, fr, fq);
    else body<false>(acc, u, wr, wc, fr, fq);
  }
};

struct EpiVT {
  static constexpr bool PERM = false, AFTER_DRAIN = true;
  const float* ssq; u16* vbuf;
  DI void operator()(const f32x4 (&)[2][2][4][2], const Unit&, int, int, int, int) const {}
  DI void fused(const f32x4 (&acc)[2][2][4][2], const Unit& u, int wr, int wc, int fr, int fq, PG8_LAS unsigned char* lds, int wid, int lane) const {
    PG8_LAS float* rsl = (PG8_LAS float*)(lds + 256 * VT_STRIDE + 64);
    {
      const int t = wid * 64 + lane;
      if (t < 256) rsl[t] = row_rscale(ssq, (size_t)u.pn * 256 + t);
    }
    __syncthreads();
#pragma unroll
    for (int ai = 0; ai < 2; ++ai)
#pragma unroll
      for (int m = 0; m < 4; ++m) {
        const int r = 128 * ai + 64 * wr + 16 * m + fr;
#pragma unroll
        for (int bj = 0; bj < 2; ++bj)
#pragma unroll
          for (int n = 0; n < 2; ++n) {
            const f32x4 v = acc[ai][bj][m][n] * *(const PG8_LAS f32x4*)(rsl + 128 * bj + 32 * wc + 16 * n + 4 * fq);
            u32x2 w = {pk2(v[0], v[1]), pk2(v[2], v[3])};
            *(PG8_LAS u32x2*)(lds + r * VT_STRIDE + (128 * bj + 32 * wc + 16 * n + 4 * fq) * 2) = w;
          }
      }
    __syncthreads();
    const int tid = wid * 64 + lane;
    const int bl = (u.pn * 256) >> 12, pos0 = (u.pn * 256) & 4095;
#pragma unroll 1
    for (int it = 0; it < 16; ++it) {
      const int uidx = it * 512 + tid;
      const int dvlo = uidx & 31, hh = (uidx >> 5) & 1, rb = (uidx >> 6) & 1, half = (uidx >> 7) & 15, h = uidx >> 11;
      const int vgrp = u.pm * 4 + h;
      const int dlg = (vgrp >= 2 && vgrp < 8) ? dlg_of((vgrp - 2) >> 1) : 0;
      const int cls = half >> (4 - dlg), hc = half & ((16 >> dlg) - 1);
      const int m0 = pos0 >> dlg, mh = m0 + 16 * hc;
      const int s = (mh >> 4) & 1, dblk = cls * (128 >> dlg) + (mh >> 5);
      const PG8_LAS unsigned char* row = lds + (h * 64 + rb * 32 + dvlo) * VT_STRIDE;
      unsigned short k8[8];
#pragma unroll
      for (int j = 0; j < 8; ++j) {
        const int tau = ((16 * hc + 4 * hh + (j & 3) + 8 * (j >> 2)) << dlg) + cls;
        k8[j] = *(const PG8_LAS unsigned short*)(row + tau * 2);
      }
      u32x4 w = {(unsigned)k8[0] | ((unsigned)k8[1] << 16), (unsigned)k8[2] | ((unsigned)k8[3] << 16),
                 (unsigned)k8[4] | ((unsigned)k8[5] << 16), (unsigned)k8[6] | ((unsigned)k8[7] << 16)};
      u16* dst = vbuf + (size_t)vgrp * TC * 64 + (size_t)bl * SEQ * 64 + ((size_t)((dblk * 2 + rb) * 2 + s) * 64 + hh * 32 + dvlo) * 8;
      *(u32x4*)dst = w;
    }
    __syncthreads();
  }
};

struct MergeOrder : pg8::StaticOrder {
  const u16* ybase; const u16* wbase;
  DI bool next(int i, Unit& u) const { if (i >= 5) return false; if (!pg8::StaticOrder::next(0, u)) return false; u.seg = i; return true; }
  DI const char* baseA(const pg8::Gemm&, const Unit& u, size_t tstep) const { return (const char*)(ybase + (size_t)u.seg * TC * 256) + (size_t)u.pm * tstep; }
  DI const char* baseB(const pg8::Gemm&, const Unit& u, size_t tstep) const { return (const char*)(wbase + (size_t)u.seg * DM * 256) + (size_t)u.pn * tstep; }
  DI bool zero_after(const Unit& u) const { return u.seg == 4; }
};
struct EpiMerge {
  static constexpr bool PERM = true, AFTER_DRAIN = false;
  const u16* gate; u16* mrg;
  DI void operator()(f32x4 (&acc)[2][2][4][2], const Unit& u, int wr, int wc, int fr, int fq) const {
    const int seg = u.seg;
    if (seg == 0) return;
    const bool last = (seg == 4);
    const int gnum = last ? 3 : seg - 1, gden = last ? 3 : seg;
    const u16* gnp = gate + ((size_t)u.pm * 256 + 64 * wr + fr) * 4096 + gnum * 1024 + u.pn * 256 + 32 * wc + 8 * fq;
    const u16* gdp = gate + ((size_t)u.pm * 256 + 64 * wr + fr) * 4096 + gden * 1024 + u.pn * 256 + 32 * wc + 8 * fq;
    u32x4 gn, gd, gnn, gdn;
    gn = *(const u32x4*)gnp; gd = *(const u32x4*)gdp;
#pragma unroll
    for (int i = 0; i < 16; ++i) {
      const int ai = i >> 3, m = (i >> 1) & 3, bj = i & 1;
      if (i < 15) {
        const int i2 = i + 1;
        const size_t ro = (size_t)(128 * (i2 >> 3) + 16 * ((i2 >> 1) & 3)) * 4096 + 128 * (i2 & 1);
        gnn = *(const u32x4*)(gnp + ro); gdn = *(const u32x4*)(gdp + ro);
      }
      asm volatile("" ::: "memory");
#pragma unroll
      for (int n = 0; n < 2; ++n) {
        f32x4 f;
        f[0] = bf_lo(gn[2 * n]); f[1] = bf_hi(gn[2 * n]); f[2] = bf_lo(gn[2 * n + 1]); f[3] = bf_hi(gn[2 * n + 1]);
        if (!last) {
          f[0] *= __builtin_amdgcn_rcpf(bf_lo(gd[2 * n])); f[1] *= __builtin_amdgcn_rcpf(bf_hi(gd[2 * n]));
          f[2] *= __builtin_amdgcn_rcpf(bf_lo(gd[2 * n + 1])); f[3] *= __builtin_amdgcn_rcpf(bf_hi(gd[2 * n + 1]));
        }
        acc[ai][bj][m][n] *= f;
      }
      if (last) {
        const size_t tok = (size_t)u.pm * 256 + 128 * ai + 64 * wr + 16 * m + fr;
        const int c = u.pn * 256 + 128 * bj + 32 * wc + 8 * fq;
        const f32x4 v0 = acc[ai][bj][m][0], v1 = acc[ai][bj][m][1];
        u32x4 w = {pk2(v0[0], v0[1]), pk2(v0[2], v0[3]), pk2(v1[0], v1[1]), pk2(v1[2], v1[3])};
        *(u32x4*)(mrg + tok * DM + c) = w;
      }
      gn = gnn; gd = gdn;
    }
  }
};

struct EpiResid {
  static constexpr bool PERM = true, AFTER_DRAIN = false;
  const float* xold; float* xout; u16* xb; float* ssq;
  DI void operator()(const f32x4 (&acc)[2][2][4][2], const Unit& u, int wr, int wc, int fr, int fq) const {
    const size_t o0 = ((size_t)u.pm * 256 + 64 * wr + fr) * DM + u.pn * 256 + 32 * wc + 8 * fq;
    f32x4 xo0, xo1, xn0, xn1;
    xo0 = *(const f32x4*)(xold + o0); xo1 = *(const f32x4*)(xold + o0 + 4);
    float ss = 0.f;
#pragma unroll
    for (int i = 0; i < 16; ++i) {
      const int ai = i >> 3, m = (i >> 1) & 3, bj = i & 1;
      if (i < 15) {
        const int i2 = i + 1;
        const size_t ro = o0 + (size_t)(128 * (i2 >> 3) + 16 * ((i2 >> 1) & 3)) * DM + 128 * (i2 & 1);
        xn0 = *(const f32x4*)(xold + ro); xn1 = *(const f32x4*)(xold + ro + 4);
      }
      asm volatile("" ::: "memory");
      const size_t tok = (size_t)u.pm * 256 + 128 * ai + 64 * wr + 16 * m + fr;
      const size_t o = tok * DM + u.pn * 256 + 128 * bj + 32 * wc + 8 * fq;
      const f32x4 v0 = xo0 + acc[ai][bj][m][0];
      const f32x4 v1 = xo1 + acc[ai][bj][m][1];
      *(f32x4*)(xout + o) = v0;
      *(f32x4*)(xout + o + 4) = v1;
      u32x4 w = {pk2(v0[0], v0[1]), pk2(v0[2], v0[3]), pk2(v1[0], v1[1]), pk2(v1[2], v1[3])};
      *(u32x4*)(xb + o) = w;
      ss += ((v0[0] * v0[0] + v0[1] * v0[1]) + (v0[2] * v0[2] + v0[3] * v0[3])) + ((v1[0] * v1[0] + v1[1] * v1[1]) + (v1[2] * v1[2] + v1[3] * v1[3]));
      if (bj == 1) {
        ss += __shfl_xor(ss, 16); ss += __shfl_xor(ss, 32);
        if (fq == 0) ssq[tok * 16 + u.pn * 4 + wc] = ss;
        ss = 0.f;
      }
      xo0 = xn0; xo1 = xn1;
    }
  }
};

template <class Epi>
DI void run_merge(PG8_LAS unsigned char* lds, const u16* ybase, const u16* wbase, const Epi& E) {
  int K = 256; asm volatile("" : "+s"(K));
  pg8::Gemm g; g.A = ybase; g.Bt = wbase; g.M = TC; g.N = DM; g.K = K;
  MergeOrder S; S.init(TC, DM, (int)gridDim.x, (int)blockIdx.x); S.ybase = ybase; S.wbase = wbase;
  pg8::gemm_phase<Epi, MergeOrder, false>(lds, g, S, E, nullptr);
}
template <class Epi>
DI void run_gemm(PG8_LAS unsigned char* lds, const u16* A, const u16* Bt, int M, int N, int K, const Epi& E, int probe = 0) {
  asm volatile("" : "+s"(K));
  pg8::Gemm g; g.A = A; g.Bt = Bt; g.M = M; g.N = N; g.K = K;
  pg8::StaticOrder S; S.init(M, N, (int)gridDim.x, (int)blockIdx.x); S.probe = probe;
  pg8::gemm_phase<Epi, pg8::StaticOrder, false>(lds, g, S, E, nullptr);
}

DI void cvt_load(const float* __restrict__ src, int N, int k0, int n0, const float* __restrict__ g, float* t, int ht) {
  const int c4 = (ht & 15) * 4;
#pragma unroll
  for (int i = 0; i < 4; ++i) {
    const int kk = (ht >> 4) + 16 * i;
    f32x4 v = *(const f32x4*)(src + (size_t)(k0 + kk) * N + n0 + c4);
    const float sc = g ? g[k0 + kk] : 1.0f;
    t[kk * 65 + c4 + 0] = v[0] * sc; t[kk * 65 + c4 + 1] = v[1] * sc; t[kk * 65 + c4 + 2] = v[2] * sc; t[kk * 65 + c4 + 3] = v[3] * sc;
  }
}
DI void cvt_store(u16* __restrict__ dst, int ldk, int kdst, int d0, int d1, const float* t, int ht) {
  const int kc = (ht & 7) * 8, nn = ht >> 3;
#pragma unroll
  for (int i = 0; i < 2; ++i) {
    const int tn = nn + 32 * i, row = (i == 0) ? d0 + nn : d1 + nn;
    u32x4 w;
    w[0] = pk2(t[(kc + 0) * 65 + tn], t[(kc + 1) * 65 + tn]);
    w[1] = pk2(t[(kc + 2) * 65 + tn], t[(kc + 3) * 65 + tn]);
    w[2] = pk2(t[(kc + 4) * 65 + tn], t[(kc + 5) * 65 + tn]);
    w[3] = pk2(t[(kc + 6) * 65 + tn], t[(kc + 7) * 65 + tn]);
    *(u32x4*)(dst + (size_t)row * ldk + kdst + kc) = w;
  }
}
struct CvtJob { const float* src; int N, k0, n0; const float* g; u16* dst; int ldk, d0, d1, kd; };
DI CvtJob cvt_job(const Params& p, int l, int ti) {
  CvtJob j; j.g = nullptr; j.kd = -1;
  const float* attn_g = p.in[1] + l * DM;
  if (ti < 608) { const int h = ti >> 4, kt = ti & 15; j.src = p.in[2] + (size_t)l * DM * INC; j.N = INC; j.k0 = kt * 64; j.n0 = qk_head_col(h); j.g = attn_g;
    j.dst = (u16*)(p.ws + OFF_WQKG) + (size_t)l * NQKG * DM; j.ldk = DM; j.d0 = (h >> 2) * 256 + (h & 3) * 32; j.d1 = j.d0 + 128; return j; }
  ti -= 608;
  if (ti < 1024) { const int c = ti >> 4, kt = ti & 15; j.src = p.in[2] + (size_t)l * DM * INC; j.N = INC; j.k0 = kt * 64; j.n0 = 3456 + 64 * c; j.g = attn_g;
    j.dst = (u16*)(p.ws + OFF_WQKG) + (size_t)l * NQKG * DM; j.ldk = DM; j.d0 = 2560 + 64 * c; j.d1 = j.d0 + 32; return j; }
  ti -= 1024;
  if (ti < 256) { const int vh = ti >> 4, kt = ti & 15; j.src = p.in[2] + (size_t)l * DM * INC; j.N = INC; j.k0 = kt * 64; j.n0 = v_head_col(vh); j.g = attn_g;
    j.dst = (u16*)(p.ws + OFF_WV) + (size_t)l * DM * DM; j.ldk = DM; j.d0 = vh * 64; j.d1 = j.d0 + 32; return j; }
  ti -= 256;
  if (ti < 128) { j.src = p.in[11] + (size_t)l * 512 * DM; j.N = DM; j.k0 = (ti >> 4) * 64; j.n0 = (ti & 15) * 64; j.dst = (u16*)(p.ws + OFF_WBR5) + ((size_t)l * 5 + (j.k0 >> 8)) * DM * 256; j.ldk = 256; j.kd = j.k0 & 255; j.d0 = j.n0; j.d1 = j.n0 + 32; return j; }
  ti -= 128;
  if (ti < 32) { j.src = p.in[12] + (size_t)l * 128 * DM; j.N = DM; j.k0 = (ti >> 4) * 64; j.n0 = (ti & 15) * 64; j.dst = (u16*)(p.ws + OFF_WBR5) + ((size_t)l * 5 + 2) * DM * 256; j.ldk = 256; j.kd = j.k0; j.d0 = j.n0; j.d1 = j.n0 + 32; return j; }
  ti -= 32;
  if (ti < 64) { j.src = p.in[13] + (size_t)l * 256 * DM; j.N = DM; j.k0 = (ti >> 4) * 64; j.n0 = (ti & 15) * 64; j.dst = (u16*)(p.ws + OFF_WBR5) + ((size_t)l * 5 + 3) * DM * 256; j.ldk = 256; j.kd = j.k0; j.d0 = j.n0; j.d1 = j.n0 + 32; return j; }
  ti -= 64;
  if (ti < 64) { j.src = p.in[14] + (size_t)l * 256 * DM; j.N = DM; j.k0 = (ti >> 4) * 64; j.n0 = (ti & 15) * 64; j.dst = (u16*)(p.ws + OFF_WBR5) + ((size_t)l * 5 + 4) * DM * 256; j.ldk = 256; j.kd = j.k0; j.d0 = j.n0; j.d1 = j.n0 + 32; return j; }
  ti -= 64;
  if (ti < 256) { j.src = p.in[15] + (size_t)l * DM * DM; j.N = DM; j.k0 = (ti >> 4) * 64; j.n0 = (ti & 15) * 64; j.dst = (u16*)(p.ws + OFF_WOUT) + (size_t)l * DM * DM; j.ldk = DM; j.d0 = j.n0; j.d1 = j.n0 + 32; return j; }
  ti -= 256;
  if (ti < 1024) { j.src = p.in[17] + (size_t)l * DM * DMLP; j.N = DMLP; j.k0 = (ti >> 6) * 64; j.n0 = (ti & 63) * 64; j.g = p.in[16] + l * DM;
    j.dst = (u16*)(p.ws + OFF_WUP) + (size_t)l * DMLP * DM; j.ldk = DM; j.d0 = j.n0; j.d1 = j.n0 + 32; return j; }
  ti -= 1024;
  j.src = p.in[18] + (size_t)l * DMLP * DM; j.N = DM; j.k0 = (ti >> 4) * 64; j.n0 = (ti & 15) * 64; j.dst = (u16*)(p.ws + OFF_WDN) + (size_t)l * DM * DMLP; j.ldk = DMLP; j.d0 = j.n0; j.d1 = j.n0 + 32; return j;
}

__device__ void phase_prep(const Params& p, int tid_, int bid_, int nblk_, unsigned char* smem) {
  const int half = tid_ >> 8, ht = tid_ & 255;
  float* t = (float*)smem + half * (64 * 65);
  const int per_layer = 4480, total = 2 * per_layer;
  for (int jp = bid_; jp * 2 < total; jp += nblk_) {
    const int j = jp * 2 + half;
    const bool on = j < total;
    CvtJob job;
    if (on) { job = cvt_job(p, j / per_layer, j % per_layer); cvt_load(job.src, job.N, job.k0, job.n0, job.g, t, ht); }
    __syncthreads();
    if (on) cvt_store(job.dst, job.ldk, (job.kd >= 0) ? job.kd : job.k0, job.d0, job.d1, t, ht);
    __syncthreads();
  }
  {
    const u32x4 z = {0u, 0u, 0u, 0u};
    for (int e = bid_ * NTHR + tid_; e < 2 * 128 * 128; e += nblk_ * NTHR) {
      const int l = e >> 14, r = (e >> 7) & 127, c = (e & 127) * 8;
      const int row = 9 * 256 + ((r < 64) ? 64 + r : 128 + r);
      *(u32x4*)((u16*)(p.ws + OFF_WQKG) + ((size_t)l * NQKG + row) * DM + c) = z;
    }
    for (int e = bid_ * NTHR + tid_; e < 2 * 1024 * 16; e += nblk_ * NTHR) {
      const int l = e >> 14, r = (e >> 4) & 1023, c = 128 + (e & 15) * 8;
      *(u32x4*)((u16*)(p.ws + OFF_WBR5) + (((size_t)l * 5 + 2) * DM + r) * 256 + c) = z;
    }
  }
  float* rope = (float*)(p.ws + OFF_ROPE);
  for (int e = bid_ * NTHR + tid_; e < SEQ * 48; e += nblk_ * NTHR) {
    const int pos = e / 48, i = e % 48;
    float inv;
    if (i < 32) inv = exp2f(-13.287712379549449f * (float)(2 * i) / 64.0f);
    else inv = exp2f(-13.287712379549449f * (float)(2 * (i - 32)) / 32.0f);
    const float angf = (float)pos * inv;
    const double ang = (double)angf;
    const double n = rint(ang * 0.15915494309189535);
    const float r = (float)(ang - n * 6.283185307179586);
    const float c = cosf(r), s = sinf(r);
    if (i < 32) { rope[pos * 96 + i] = c; rope[pos * 96 + 32 + i] = s; }
    else { rope[pos * 96 + 64 + (i - 32)] = c; rope[pos * 96 + 80 + (i - 32)] = s; }
  }
  u16* XB = (u16*)(p.ws + OFF_XB); float* SSQ = (float*)(p.ws + OFF_SSQ);
  const int lane = tid_ & 63;
  const int gw = bid_ * 8 + (tid_ >> 6), nw = nblk_ * 8;
  for (int row = gw; row < T; row += nw) {
    const float* xr = p.in[0] + (size_t)row * DM;
    float ss = 0.f;
#pragma unroll
    for (int i = 0; i < 4; ++i) {
      const f32x4 v = *(const f32x4*)(xr + i * 256 + lane * 4);
      ss += v[0] * v[0] + v[1] * v[1] + v[2] * v[2] + v[3] * v[3];
      u32x2 w = {pk2(v[0], v[1]), pk2(v[2], v[3])};
      *(u32x2*)(XB + (size_t)row * DM + i * 256 + lane * 4) = w;
    }
#pragma unroll
    for (int o = 32; o >= 1; o >>= 1) ss += __shfl_xor(ss, o);
    if (lane < 16) SSQ[(size_t)row * 16 + lane] = (lane == 0) ? ss : 0.f;
  }
}

DI void attn_softmax_pv(f32x16& S, float& m, float& l, f32x16& O0, f32x16& O1, const bf16x8 (&vf)[2][2]) {
  float mx = S[0];
#pragma unroll
  for (int i = 1; i < 16; ++i) mx = fmaxf(mx, S[i]);
  mx = fmaxf(mx, __shfl_xor(mx, 32));
  const float mn = fmaxf(m, mx);
  const float alpha = fexp2(m - mn);
  m = mn;
  float sum = 0.f;
#pragma unroll
  for (int i = 0; i < 16; ++i) { S[i] = fexp2(S[i] - mn); sum += S[i]; }
  l = l * alpha + sum;
  const u32x4 p0 = {pk2(S[0], S[1]), pk2(S[2], S[3]), pk2(S[4], S[5]), pk2(S[6], S[7])};
  const u32x4 p1 = {pk2(S[8], S[9]), pk2(S[10], S[11]), pk2(S[12], S[13]), pk2(S[14], S[15])};
#pragma unroll
  for (int i = 0; i < 16; ++i) { O0[i] *= alpha; O1[i] *= alpha; }
  O0 = MFMA32(vf[0][0], as_bf8(p0), O0);
  O0 = MFMA32(vf[0][1], as_bf8(p1), O0);
  O1 = MFMA32(vf[1][0], as_bf8(p0), O1);
  O1 = MFMA32(vf[1][1], as_bf8(p1), O1);
}
DI void attn_fixed_pv(f32x16& S, f32x16& L, f32x16& O0, f32x16& O1, const bf16x8 (&vf)[2][2], const bf16x8 ones) {
#pragma unroll
  for (int i = 0; i < 16; ++i) S[i] = fexp2(S[i]);
  const u32x4 p0 = {pk2(S[0], S[1]), pk2(S[2], S[3]), pk2(S[4], S[5]), pk2(S[6], S[7])};
  const u32x4 p1 = {pk2(S[8], S[9]), pk2(S[10], S[11]), pk2(S[12], S[13]), pk2(S[14], S[15])};
  O0 = MFMA32(vf[0][0], as_bf8(p0), O0);
  O0 = MFMA32(vf[0][1], as_bf8(p1), O0);
  O1 = MFMA32(vf[1][0], as_bf8(p0), O1);
  O1 = MFMA32(vf[1][1], as_bf8(p1), O1);
  float sum = 0.f;
#pragma unroll
  for (int i = 0; i < 16; ++i) sum += S[i];
  L[0] += sum;
}
DI void attn_plain_pv(f32x16& S, float& l, f32x16& O0, f32x16& O1, const bf16x8 (&vf)[2][2]) {
  float sum = 0.f;
#pragma unroll
  for (int i = 0; i < 16; ++i) { S[i] = fexp2(S[i]); sum += S[i]; }
  l += sum;
  const u32x4 p0 = {pk2(S[0], S[1]), pk2(S[2], S[3]), pk2(S[4], S[5]), pk2(S[6], S[7])};
  const u32x4 p1 = {pk2(S[8], S[9]), pk2(S[10], S[11]), pk2(S[12], S[13]), pk2(S[14], S[15])};
  O0 = MFMA32(vf[0][0], as_bf8(p0), O0); O1 = MFMA32(vf[1][0], as_bf8(p0), O1);
  O0 = MFMA32(vf[0][1], as_bf8(p1), O0); O1 = MFMA32(vf[1][1], as_bf8(p1), O1);
}
DI float gain_bound64(const float* g) {
  float a = 0.f, b = 0.f;
  for (int i = 0; i < 64; ++i) { a = fmaxf(a, fabsf(g[i])); b = fmaxf(b, fabsf(g[64 + i])); }
  return fminf(8.0f * a * b * 1.02f + 0.05f, 40.0f);
}
DI void load_vf(bf16x8 (&vf)[2][2], const u16* V, int kb, int lane) {
#pragma unroll
  for (int rb = 0; rb < 2; ++rb)
#pragma unroll
    for (int s = 0; s < 2; ++s) vf[rb][s] = *(const bf16x8*)(V + ((size_t)((kb * 2 + rb) * 2 + s) * 64 + lane) * 8);
}
DI void load_kf4(bf16x8 (&kf)[4], const u16* K, int kb, int lane) {
#pragma unroll
  for (int s = 0; s < 4; ++s) kf[s] = *(const bf16x8*)(K + ((size_t)(kb * 4 + s) * 64 + lane) * 8);
}
DI void load_kf2(bf16x8 (&kf)[2], const u16* K, int kb, int lane) {
#pragma unroll
  for (int s = 0; s < 2; ++s) kf[s] = *(const bf16x8*)(K + ((size_t)(kb * 2 + s) * 64 + lane) * 8);
}
DI void zero16(f32x16& a) {
#pragma unroll
  for (int i = 0; i < 16; ++i) a[i] = 0.f;
}
DI void store_o(u16* yrow, const f32x16& O0, const f32x16& O1, float sc, int h) {
#pragma unroll
  for (int g4 = 0; g4 < 4; ++g4) {
    u32x2 w0 = {pk2(O0[4 * g4] * sc, O0[4 * g4 + 1] * sc), pk2(O0[4 * g4 + 2] * sc, O0[4 * g4 + 3] * sc)};
    *(u32x2*)(yrow + 8 * g4 + 4 * h) = w0;
    u32x2 w1 = {pk2(O1[4 * g4] * sc, O1[4 * g4 + 1] * sc), pk2(O1[4 * g4 + 2] * sc, O1[4 * g4 + 3] * sc)};
    *(u32x2*)(yrow + 32 + 8 * g4 + 4 * h) = w1;
  }
}

__device__ void phase_attn(const Params& p, int tid_, int bid_, int nblk_, int layer) {
  const u16* QK = (const u16*)(p.ws + OFF_QK);
  const u16* VB = (const u16*)(p.ws + OFF_V);
  u16* Y5 = (u16*)(p.ws + OFF_Y5);
  u16* BO = (u16*)(p.ws + OFF_BO);
  float* LSE = (float*)(p.ws + OFF_LSE);
  const int lane = tid_ & 63, wave = tid_ >> 6;
  const int fr = lane & 31, fh = lane >> 5;
  const int nloc = nblk_ >> 3;
  if ((int)(bid_ >> 3) >= nloc) return;
  const int vw = ((bid_ & 7) * nloc + (bid_ >> 3)) * 8 + wave, NW = nloc * 64;
  const size_t GS = (size_t)TC * 64;
  const size_t BS = (size_t)SEQ * 64;

  {
    const float* lp = p.in[7] + layer * 128;
    float d01 = 0.f, d23 = 0.f;
    for (int i = 0; i < 32; ++i) { d01 += lp[i] * lp[32 + i]; d23 += lp[64 + i] * lp[96 + i]; }
    const float lambda_init = (layer == 0) ? 0.2f : 0.35550907f;
    const float lam = __expf(d01) - __expf(d23) + lambda_init;
    const float* subg = p.in[8] + layer * 64;
    const float sc = 0.17677669529663687f * LOG2E;
    float gqm = 0.f, gkm = 0.f;
    for (int i = 0; i < 32; ++i) { gqm = fmaxf(gqm, fabsf(p.in[6][layer * 64 + i])); gkm = fmaxf(gkm, fabsf(p.in[6][layer * 64 + 32 + i])); }
    const unsigned onev = ((fr & 27) == 0) ? 0x3f803f80u : 0u;
    const u32x4 ones4 = {onev, onev, onev, onev};
    const bf16x8 ones = as_bf8(ones4);
    const float cbound = 5.6568542f * gqm * gkm * 1.02f + 0.05f;
    for (int it = vw; it < BC * 4 * 128; it += NW) {
      const int bl = it >> 9, head = (it >> 7) & 3, qblk = it & 127;
      const u16* Q0 = QK + (22 + head) * GS + bl * BS; const u16* Q1 = Q0 + SEQ * 32;
      const u16* K0 = QK + (26 + head) * GS + bl * BS; const u16* K1 = K0 + SEQ * 32;
      const u16* V = VB + (8 + head) * GS + bl * BS;
      bf16x8 q0[2], q1[2];
      load_kf2(q0, Q0, qblk, lane); load_kf2(q1, Q1, qblk, lane);
      f32x16 L0, L1; zero16(L0); zero16(L1);
      f32x16 O00, O01, O10, O11; zero16(O00); zero16(O01); zero16(O10); zero16(O11);
      bf16x8 k0[2], k1[2], vf[2][2];
      {
        const float mb2 = fminf(cbound, 40.0f) * LOG2E;
        f32x16 sinit;
#pragma unroll
        for (int i = 0; i < 16; ++i) sinit[i] = -mb2;
        load_kf2(k0, K0, 0, lane); load_kf2(k1, K1, 0, lane); load_vf(vf, V, 0, lane);
        f32x16 S0 = sinit, S1 = sinit;
        S0 = MFMA32(k0[0], q0[0], S0); S0 = MFMA32(k0[1], q0[1], S0);
        S1 = MFMA32(k1[0], q1[0], S1); S1 = MFMA32(k1[1], q1[1], S1);
        load_kf2(k0, K0, 1, lane); load_kf2(k1, K1, 1, lane);
        for (int kb = 0; kb < 128; ++kb) {
          bf16x8 nk0[2], nk1[2], nvf[2][2];
          const int k2 = (kb + 2 < 128) ? kb + 2 : 127, v1 = (kb + 1 < 128) ? kb + 1 : 127;
          load_kf2(nk0, K0, k2, lane); load_kf2(nk1, K1, k2, lane); load_vf(nvf, V, v1, lane);
          f32x16 S0n = sinit, S1n = sinit;
#pragma unroll
          for (int i = 0; i < 16; ++i) S0[i] = fexp2(S0[i]);
          S0n = MFMA32(k0[0], q0[0], S0n); S0n = MFMA32(k0[1], q0[1], S0n);
          {
            const u32x4 p0 = {pk2(S0[0], S0[1]), pk2(S0[2], S0[3]), pk2(S0[4], S0[5]), pk2(S0[6], S0[7])};
            const u32x4 p1 = {pk2(S0[8], S0[9]), pk2(S0[10], S0[11]), pk2(S0[12], S0[13]), pk2(S0[14], S0[15])};
            O00 = MFMA32(vf[0][0], as_bf8(p0), O00); O01 = MFMA32(vf[1][0], as_bf8(p0), O01);
            O00 = MFMA32(vf[0][1], as_bf8(p1), O00); O01 = MFMA32(vf[1][1], as_bf8(p1), O01);
            float sum = 0.f;
#pragma unroll
            for (int i = 0; i < 16; ++i) sum += S0[i];
            L0[0] += sum;
          }
#pragma unroll
          for (int i = 0; i < 16; ++i) S1[i] = fexp2(S1[i]);
          S1n = MFMA32(k1[0], q1[0], S1n); S1n = MFMA32(k1[1], q1[1], S1n);
          {
            const u32x4 p0 = {pk2(S1[0], S1[1]), pk2(S1[2], S1[3]), pk2(S1[4], S1[5]), pk2(S1[6], S1[7])};
            const u32x4 p1 = {pk2(S1[8], S1[9]), pk2(S1[10], S1[11]), pk2(S1[12], S1[13]), pk2(S1[14], S1[15])};
            O10 = MFMA32(vf[0][0], as_bf8(p0), O10); O11 = MFMA32(vf[1][0], as_bf8(p0), O11);
            O10 = MFMA32(vf[0][1], as_bf8(p1), O10); O11 = MFMA32(vf[1][1], as_bf8(p1), O11);
            float sum = 0.f;
#pragma unroll
            for (int i = 0; i < 16; ++i) sum += S1[i];
            L1[0] += sum;
          }
          S0 = S0n; S1 = S1n;
#pragma unroll
          for (int s = 0; s < 2; ++s) { k0[s] = nk0[s]; k1[s] = nk1[s]; vf[0][s] = nvf[0][s]; vf[1][s] = nvf[1][s]; }
        }
      }
      const float i0 = 1.0f / (L0[0] + __shfl_xor(L0[0], 32));
      const float i1 = lam / (L1[0] + __shfl_xor(L1[0], 32));
      float ss = 0.f;
#pragma unroll
      for (int i = 0; i < 16; ++i) {
        O00[i] = O00[i] * i0 - O10[i] * i1; O01[i] = O01[i] * i0 - O11[i] * i1;
        ss += O00[i] * O00[i] + O01[i] * O01[i];
      }
      ss += __shfl_xor(ss, 32);
      const float rn = rsqrtf(ss * (1.0f / 64.0f) + 1e-6f) * (1.0f - lambda_init);
#pragma unroll
      for (int g4 = 0; g4 < 4; ++g4) {
        const f32x4 ga = *(const f32x4*)(subg + 8 * g4 + 4 * fh);
        const f32x4 gb = *(const f32x4*)(subg + 32 + 8 * g4 + 4 * fh);
#pragma unroll
        for (int e = 0; e < 4; ++e) { O00[4 * g4 + e] *= ga[e]; O01[4 * g4 + e] *= gb[e]; }
      }
      const size_t tok = (size_t)bl * SEQ + qblk * 32 + fr;
      store_o(Y5 + (size_t)3 * TC * 256 + tok * 256 + head * 64, O00, O01, rn, fh);
    }
  }
  {
    const float mbA = gain_bound64(p.in[3] + layer * 128) * LOG2E;
    f32x16 sinit;
#pragma unroll
    for (int i = 0; i < 16; ++i) sinit[i] = -mbA;
    for (int it = vw; it < BC * 8 * 128; it += NW) {
      const int bl = it >> 10, hq = (it >> 7) & 7, qblk = it & 127;
      const int kvh = hq >> 2;
      const u16* Q = QK + (size_t)hq * GS + bl * BS;
      const u16* K = QK + (size_t)(8 + kvh) * GS + bl * BS;
      const u16* V = VB + (size_t)kvh * GS + bl * BS;
      bf16x8 qf[4]; load_kf4(qf, Q, qblk, lane);
      float l = (fh == 0) ? fexp2(p.in[4][layer * 8 + hq] * LOG2E - mbA) : 0.0f;
      f32x16 O0, O1; zero16(O0); zero16(O1);
      const int kb_lo = (qblk - 4 < 0) ? 0 : qblk - 4, kb_hi = (qblk + 4 > 127) ? 127 : qblk + 4;
      const int qpos = qblk * 32 + fr;
      bf16x8 kf[4], vf[2][2];
      load_kf4(kf, K, kb_lo, lane); load_vf(vf, V, kb_lo, lane);
      for (int kb = kb_lo; kb <= kb_hi; ++kb) {
        bf16x8 nkf[4], nvf[2][2];
        const int kn = (kb < kb_hi) ? kb + 1 : kb;
        load_kf4(nkf, K, kn, lane); load_vf(nvf, V, kn, lane);
        f32x16 S = sinit;
#pragma unroll
        for (int s = 0; s < 4; ++s) S = MFMA32(kf[s], qf[s], S);
        if (kb == qblk - 4 || kb == qblk + 4) {
#pragma unroll
          for (int i = 0; i < 16; ++i) {
            const int dlt = kb * 32 + crow(i, fh) - qpos;
            S[i] = (dlt <= 128 && dlt >= -128) ? S[i] : (-__builtin_inff());
          }
        }
        attn_plain_pv(S, l, O0, O1, vf);
#pragma unroll
        for (int s = 0; s < 4; ++s) kf[s] = nkf[s];
#pragma unroll
        for (int s = 0; s < 2; ++s) { vf[0][s] = nvf[0][s]; vf[1][s] = nvf[1][s]; }
      }
      const float inv = 1.0f / (l + __shfl_xor(l, 32));
      const size_t tok = (size_t)bl * SEQ + qpos;
      store_o(Y5 + (size_t)(hq >> 2) * TC * 256 + tok * 256 + (hq & 3) * 64, O0, O1, inv, fh);
    }
  }
  {
    const float gbD = gain_bound64(p.in[9] + layer * 128);
    for (int it = vw; it < BC * 4 * 128; it += NW) {
      const int bl = it >> 9, head = (it >> 7) & 3, qblk = it & 127;
      const u16* Q = QK + (size_t)(30 + head) * GS + bl * BS;
      const u16* K = QK + (size_t)(34 + head) * GS + bl * BS;
      const u16* V = VB + (size_t)(12 + head) * GS + bl * BS;
      const float* rpb = p.in[10] + (size_t)(layer * 4 + head) * 15 * 31;
      bf16x8 qf[4]; load_kf4(qf, Q, qblk, lane);
      float bmax = 0.f;
      for (int i = lane; i < 15 * 31; i += 64) bmax = fmaxf(bmax, fabsf(rpb[i]));
#pragma unroll
      for (int o = 32; o >= 1; o >>= 1) bmax = fmaxf(bmax, __shfl_xor(bmax, o));
      const float mbD = fminf(gbD + bmax, 60.0f) * LOG2E;
      f32x16 sinit;
#pragma unroll
      for (int i = 0; i < 16; ++i) sinit[i] = -mbD;
      float l = 0.f;
      f32x16 O0, O1; zero16(O0); zero16(O1);
      const int qrow = qblk >> 1, qc = (qblk & 1) * 32 + fr;
      int r0 = qrow - 4; r0 = r0 < 0 ? 0 : (r0 > 56 ? 56 : r0);
      int c0 = qc - 8; c0 = c0 < 0 ? 0 : (c0 > 48 ? 48 : c0);
      bf16x8 kf[4], vf[2][2];
      load_kf4(kf, K, r0 * 2, lane); load_vf(vf, V, r0 * 2, lane);
      for (int kk = 0; kk < 16; ++kk) {
        const int krow_ = r0 + (kk >> 1), hb = kk & 1;
        bf16x8 nkf[4], nvf[2][2];
        const int kn = r0 * 2 + ((kk < 15) ? kk + 1 : kk);
        load_kf4(nkf, K, kn, lane); load_vf(nvf, V, kn, lane);
        f32x16 S = sinit;
#pragma unroll
        for (int s = 0; s < 4; ++s) S = MFMA32(kf[s], qf[s], S);
        const float* brow = rpb + (krow_ - qrow + 7) * 31;
#pragma unroll
        for (int i = 0; i < 16; ++i) {
          const int kc = hb * 32 + crow(i, fh);
          int dc = kc - qc; dc = dc < -15 ? -15 : (dc > 15 ? 15 : dc);
          const float bias = brow[dc + 15];
          S[i] = (kc >= c0 && kc < c0 + 16) ? __builtin_fmaf(bias, LOG2E, S[i]) : (-__builtin_inff());
        }
        attn_plain_pv(S, l, O0, O1, vf);
#pragma unroll
        for (int s = 0; s < 4; ++s) kf[s] = nkf[s];
#pragma unroll
        for (int s = 0; s < 2; ++s) { vf[0][s] = nvf[0][s]; vf[1][s] = nvf[1][s]; }
      }
      const float inv = 1.0f / (l + __shfl_xor(l, 32));
      const size_t tok = (size_t)bl * SEQ + qblk * 32 + fr;
      store_o(Y5 + (size_t)4 * TC * 256 + tok * 256 + head * 64, O0, O1, inv, fh);
    }
  }
  {
    const float mbB = gain_bound64(p.in[5] + layer * 128) * LOG2E;
    f32x16 sinit;
#pragma unroll
    for (int i = 0; i < 16; ++i) sinit[i] = -mbB;
    for (int it = vw; it < BC * 6 * 128; it += NW) {
      const int bl = it / 768, rem = it % 768, head = rem >> 7, qblk = rem & 127;
      const int dil = dil_of(head >> 1), L = SEQ / dil, LB = L >> 5;
      const u16* Q = QK + (size_t)(10 + head) * GS + bl * BS;
      const u16* K = QK + (size_t)(16 + head) * GS + bl * BS;
      const u16* V = VB + (size_t)(2 + head) * GS + bl * BS;
      bf16x8 qf[4]; load_kf4(qf, Q, qblk, lane);
      float l = 0.f;
      f32x16 O0, O1; zero16(O0); zero16(O1);
      const int rsub = qblk / LB;
      const int lo = rsub * LB, hi = lo + LB - 1;
      const int kb_lo = (qblk - 2 < lo) ? lo : qblk - 2, kb_hi = (qblk + 2 > hi) ? hi : qblk + 2;
      const int qd = qblk * 32 + fr;
      bf16x8 kf[4], vf[2][2];
      load_kf4(kf, K, kb_lo, lane); load_vf(vf, V, kb_lo, lane);
      for (int kb = kb_lo; kb <= kb_hi; ++kb) {
        bf16x8 nkf[4], nvf[2][2];
        const int kn = (kb < kb_hi) ? kb + 1 : kb;
        load_kf4(nkf, K, kn, lane); load_vf(nvf, V, kn, lane);
        f32x16 S = sinit;
#pragma unroll
        for (int s = 0; s < 4; ++s) S = MFMA32(kf[s], qf[s], S);
        if (kb == qblk - 2 || kb == qblk + 2) {
#pragma unroll
          for (int i = 0; i < 16; ++i) {
            const int dlt = kb * 32 + crow(i, fh) - qd;
            S[i] = (dlt <= 64 && dlt >= -64) ? S[i] : (-__builtin_inff());
          }
        }
        attn_plain_pv(S, l, O0, O1, vf);
#pragma unroll
        for (int s = 0; s < 4; ++s) kf[s] = nkf[s];
#pragma unroll
        for (int s = 0; s < 2; ++s) { vf[0][s] = nvf[0][s]; vf[1][s] = nvf[1][s]; }
      }
      const float lt = l + __shfl_xor(l, 32);
      const float inv = 1.0f / lt;
      const int msub = qd - rsub * L;
      const int pos = msub * dil + rsub;
      const size_t tok = (size_t)bl * SEQ + pos;
      store_o(BO + tok * 384 + head * 64, O0, O1, inv, fh);
      if (fh == 0) LSE[tok * 8 + head] = __log2f(lt) + mbB;
    }
  }
}


__device__ void phase_bcombine(const Params& p, int tid_, int tok0) {
  const u16* BO = (const u16*)(p.ws + OFF_BO);
  const float* LSE = (const float*)(p.ws + OFF_LSE);
  u16* YB = (u16*)(p.ws + OFF_Y5) + (size_t)2 * TC * 256;
  for (int e = tid_; e < 256 * 16; e += NTHR) {
    const int tok = tok0 + (e >> 4), j = (e >> 3) & 1, c8 = (e & 7) * 8;
    const float a0 = LSE[(size_t)tok * 8 + j], a1 = LSE[(size_t)tok * 8 + 2 + j], a2 = LSE[(size_t)tok * 8 + 4 + j];
    const float mx = fmaxf(a0, fmaxf(a1, a2));
    float w0 = fexp2(a0 - mx), w1 = fexp2(a1 - mx), w2 = fexp2(a2 - mx);
    const float inv = 1.0f / (w0 + w1 + w2);
    w0 *= inv; w1 *= inv; w2 *= inv;
    const u32x4 x0 = *(const u32x4*)(BO + (size_t)tok * 384 + (0 + j) * 64 + c8);
    const u32x4 x1 = *(const u32x4*)(BO + (size_t)tok * 384 + (2 + j) * 64 + c8);
    const u32x4 x2 = *(const u32x4*)(BO + (size_t)tok * 384 + (4 + j) * 64 + c8);
    u32x4 o;
#pragma unroll
    for (int q = 0; q < 4; ++q) {
      const float lo = w0 * bf_lo(x0[q]) + w1 * bf_lo(x1[q]) + w2 * bf_lo(x2[q]);
      const float hi = w0 * bf_hi(x0[q]) + w1 * bf_hi(x1[q]) + w2 * bf_hi(x2[q]);
      o[q] = pk2(lo, hi);
    }
    *(u32x4*)(YB + (size_t)tok * 256 + j * 64 + c8) = o;
    const u32x4 z = {0u, 0u, 0u, 0u};
    *(u32x4*)(YB + (size_t)tok * 256 + 128 + (e & 15) * 8) = z;
  }
}

#define XB_TMO      128
#define XB_XCNT(j)  (256  + 64 * (j))
#define XB_XSUB(j)  (1280 + 64 * (j))
#define XB_XGEN(j)  (2304 + 64 * (j))
#define XB_TOP      3328
#define XB_TOPGEN   3392
#define XCD_BAR_WORDS 3456
#define XB_SPIN_CAP (1u << 22)
#define LAS __attribute__((address_space(3)))
DI unsigned xb_ld(unsigned* p)              { return __hip_atomic_load(p, __ATOMIC_RELAXED, __HIP_MEMORY_SCOPE_AGENT); }
DI unsigned xb_add(unsigned* p, unsigned v) { return __hip_atomic_fetch_add(p, v, __ATOMIC_RELAXED, __HIP_MEMORY_SCOPE_AGENT); }
DI unsigned xb_xcc_id() { return (unsigned)__builtin_amdgcn_s_getreg((3 << 11) | 20) & 0xFu; }
#define XB_SPIN(cond, bar) do { unsigned _sp = 0; while (cond) { __builtin_amdgcn_s_sleep(1); \
    if ((++_sp & 255u) == 0u) { if (xb_ld(&(bar)[XB_TMO])) break; if (_sp > XB_SPIN_CAP) { atomicAdd(&(bar)[XB_TMO], 1u); break; } } } } while (0)
struct XcdBarrier { unsigned* bar; unsigned x; volatile LAS unsigned* st; };
DI XcdBarrier xcd_barrier_post(unsigned* bar, volatile LAS unsigned* st) {
  XcdBarrier b; b.bar = bar; b.x = xb_xcc_id(); b.st = st;
  if (threadIdx.x == 0) (void)xb_add(&bar[XB_XCNT(b.x)], 1u);
  return b;
}
DI void xcd_barrier_complete(unsigned* bar, unsigned x, unsigned& nloc, unsigned& nx) {
  const unsigned G = gridDim.x * gridDim.y * gridDim.z;
  unsigned sum, cnt, mine, sp = 0u;
  for (;;) {
    sum = 0u; cnt = 0u; mine = 0u;
#pragma unroll
    for (unsigned j = 0; j < 16; ++j) { const unsigned c = xb_ld(&bar[XB_XCNT(j)]); sum += c; cnt += (c > 0u) ? 1u : 0u; mine = (j == x) ? c : mine; }
    if (sum == G) break;
    __builtin_amdgcn_s_sleep(1);
    if ((++sp & 255u) == 0u) { if (xb_ld(&bar[XB_TMO])) break; if (sp > XB_SPIN_CAP) { atomicAdd(&bar[XB_TMO], 1u); break; } }
  }
  nloc = mine > 0u ? mine : 1u; nx = cnt > 0u ? cnt : 1u;
}
DI void xcd_barrier(const XcdBarrier& b) {
  asm volatile("s_waitcnt vmcnt(0)" ::: "memory");
  __syncthreads();
  if (threadIdx.x == 0) {
    unsigned* bar = b.bar;
    __builtin_amdgcn_s_waitcnt(0);
    unsigned nloc = b.st[0], nx = b.st[1];
    if (nloc == 0u) { xcd_barrier_complete(bar, b.x, nloc, nx); b.st[0] = nloc; b.st[1] = nx; }
    const unsigned old = xb_add(&bar[XB_XSUB(b.x)], 1u);
    const unsigned gen = old / nloc;
    if (old + 1u == (gen + 1u) * nloc) {
      __builtin_amdgcn_fence(__ATOMIC_RELEASE, "agent");
      asm volatile("s_waitcnt vmcnt(0)" ::: "memory");
      const unsigned og = xb_add(&bar[XB_TOP], 1u);
      const unsigned tg = og / nx;
      if (og + 1u == (tg + 1u) * nx) xb_add(&bar[XB_TOPGEN], 1u);
      else XB_SPIN(xb_ld(&bar[XB_TOPGEN]) == tg, bar);
      __builtin_amdgcn_fence(__ATOMIC_ACQUIRE, "agent");
      xb_add(&bar[XB_XGEN(b.x)], 1u);
      asm volatile("s_waitcnt vmcnt(0)" ::: "memory");
    } else {
      XB_SPIN(xb_ld(&bar[XB_XGEN(b.x)]) == gen, bar);
      __builtin_amdgcn_fence(__ATOMIC_ACQUIRE, "agent");
      asm volatile("s_waitcnt vmcnt(0)" ::: "memory");
    }
  }
  __syncthreads();
}

__global__ void __launch_bounds__(NTHR, 2) mk_forward(Params p) {
  extern __shared__ __attribute__((aligned(16))) unsigned char smem[];
  cg::grid_group grid = cg::this_grid();
  volatile LAS unsigned* xbw = (volatile LAS unsigned*)(smem + LDS_XBW);
  if (threadIdx.x < 4) xbw[threadIdx.x] = 0u;
  __syncthreads();
  XcdBarrier xb;
  if (FUSED) xb = xcd_barrier_post((unsigned*)(p.ws + OFF_BAR), xbw);
#if PROBE_CLOCK
  const unsigned long long pc_t0 = clock64(), pc_r0 = wall_clock64();
#endif
  PG8_LAS unsigned char* lds = (PG8_LAS unsigned char*)smem;
  for (int ph = p.ph_lo; ph < p.ph_hi; ++ph) {
#if DUPMASK
   for (int rep = 0; rep < ((ph > 0 && ((DUPMASK >> ((ph - 1) % 7)) & 1)) ? 2 : 1); ++rep)
#endif
   {
    int tid_ = threadIdx.x, bid_ = blockIdx.x, nblk_ = gridDim.x;
    asm volatile("" : "+v"(tid_));
    asm volatile("" : "+s"(bid_));
    asm volatile("" : "+s"(nblk_));
    Params pp = p;
    asm volatile("" : "+s"(pp.ws));
    asm volatile("" : "+s"(pp.out));
    unsigned char* ws = pp.ws;
    if (ph == 0) {
      if (PHMASK & 128) phase_prep(pp, tid_, bid_, nblk_, smem);
    } else {
      const int q = ph - 1, chunk = q / (2 * PPL), layer = (q % (2 * PPL)) / PPL, kk = q % PPL, k = (kk == 6) ? DUPK : (kk < 2 ? kk : kk + 1);
      const u16* XBc = (const u16*)(ws + OFF_XB) + (size_t)chunk * TC * DM;
      float* SSQc = (float*)(ws + OFF_SSQ) + (size_t)chunk * TC * 16;
      float* xc = pp.out + (size_t)chunk * TC * DM;
      if ((k == 0 && (PHMASK & 1)) || (k == 5 && (PHMASK & 32))) {
        const bool up = (k == 5);
        if (!up) {
          EpiQKG e; e.ssq = SSQc; e.qk = (u16*)(ws + OFF_QK); e.rope = (const float*)(ws + OFF_ROPE);
          e.gA = pp.in[3] + layer * 128; e.gB = pp.in[5] + layer * 128; e.gC = pp.in[6] + layer * 64; e.gD = pp.in[9] + layer * 128;
          run_gemm(lds, XBc, (const u16*)(ws + OFF_WQKG) + (size_t)layer * NQKG * DM, TC, 2560, DM, e);
        }
        {
          EpiGateUp e; e.ssq = SSQc; e.o = (u16*)(ws + OFF_GATE); e.mode = up ? ((PROBE_NOEPI && kk == 6) ? 2 : 1) : 0;
          const u16* W = up ? (const u16*)(ws + OFF_WUP) + (size_t)layer * DMLP * DM : (const u16*)(ws + OFF_WQKG) + ((size_t)layer * NQKG + 2560) * DM;
          run_gemm(lds, XBc, W, TC, 4096, DM, e, (PROBE_NOEPI && kk == 6) ? 1 : 0);
        }
        if (!up) {
          EpiVT ev; ev.ssq = SSQc; ev.vbuf = (u16*)(ws + OFF_V);
          run_gemm(lds, (const u16*)(ws + OFF_WV) + (size_t)layer * DM * DM, XBc, DM, TC, DM, ev);
        }
      } else if (k == 1 && (PHMASK & 2)) {
        phase_attn(pp, tid_, bid_, nblk_, layer);
      } else if (k == 3 && (PHMASK & 8)) {
        {
          Unit u0; pg8::StaticOrder S0; S0.init(TC, DM, nblk_, bid_); S0.next(0, u0);
          phase_bcombine(pp, tid_, u0.pm * 256);
          asm volatile("s_waitcnt vmcnt(0)" ::: "memory");
          __syncthreads();
        }
        EpiMerge e; e.gate = (const u16*)(ws + OFF_GATE); e.mrg = (u16*)(ws + OFF_MRG);
        run_merge(lds, (const u16*)(ws + OFF_Y5), (const u16*)(ws + OFF_WBR5) + (size_t)layer * 5 * DM * 256, e);
      } else if ((k == 4 && (PHMASK & 16)) || (k == 6 && (PHMASK & 64))) {
        const bool dn = (k == 6);
        EpiResid e; e.xold = (!dn && layer == 0) ? (pp.in[0] + (size_t)chunk * TC * DM) : xc; e.xout = xc; e.xb = (u16*)XBc; e.ssq = SSQc;
        const u16* A = dn ? (const u16*)(ws + OFF_GATE) : (const u16*)(ws + OFF_MRG);
        const u16* W = dn ? (const u16*)(ws + OFF_WDN) + (size_t)layer * DM * DMLP : (const u16*)(ws + OFF_WOUT) + (size_t)layer * DM * DM;
        run_gemm(lds, A, W, TC, DM, dn ? DMLP : DM, e);
      }
    }
   }
    if (ph + 1 < p.ph_hi) {
      if (ph == 0) grid.sync();
      else xcd_barrier(xb);
    }
  }
#if PROBE_CLOCK
  {
    xcd_barrier(xb);
    const unsigned long long pc_t1 = clock64(), pc_r1 = wall_clock64();
    const float ghz = (float)(pc_t1 - pc_t0) / ((float)(pc_r1 - pc_r0) * 10.0f);
    const int nrows = (int)(ghz * 0.25f * (float)T);
    for (int r = blockIdx.x; r < nrows; r += gridDim.x)
      for (int c = threadIdx.x; c < DM; c += NTHR) p.out[(size_t)r * DM + c] = 0.f;
  }
#endif
}

extern "C" void kernel_launch(void* const* d_in, const int* in_sizes, int n_in, void* d_out, int out_size, void* d_ws, size_t ws_size,
                              hipStream_t stream) {
  static int grid_blocks = 0;
  if (grid_blocks == 0) {
    if (n_in != 19 || out_size != T * DM || ws_size < WS_END) {
      fprintf(stderr, "kernel_launch: unexpected problem (n_in %d out %d ws %zu need %zu)\n", n_in, out_size, ws_size, (size_t)WS_END);
      grid_blocks = -1;
      return;
    }
    int dev = 0, cus = 0, per_cu = 0;
    (void)hipGetDevice(&dev);
    (void)hipDeviceGetAttribute(&cus, hipDeviceAttributeMultiprocessorCount, dev);
    if (hipFuncSetAttribute((const void*)mk_forward, hipFuncAttributeMaxDynamicSharedMemorySize, LDS_BYTES) != hipSuccess) {
      fprintf(stderr, "kernel_launch: hipFuncSetAttribute failed\n"); grid_blocks = -1; return;
    }
    (void)hipOccupancyMaxActiveBlocksPerMultiprocessor(&per_cu, mk_forward, NTHR, LDS_BYTES);
    if (per_cu < 1) fprintf(stderr, "kernel_launch: occupancy query says %d blocks per CU\n", per_cu);
    (void)hipGetLastError();
    grid_blocks = cus;
  }
  if (grid_blocks < 0) return;
  Params p{};
  for (int i = 0; i < 19; ++i) p.in[i] = (const float*)d_in[i];
  p.out = (float*)d_out;
  p.ws = (unsigned char*)d_ws;
#if FUSED
  (void)hipMemsetAsync((unsigned char*)d_ws + OFF_BAR, 0, XCD_BAR_WORDS * 4, stream);
  p.ph_lo = 0; p.ph_hi = NPHASE;
  void* args[] = {&p};
  hipError_t e = hipLaunchCooperativeKernel((const void*)mk_forward, dim3(grid_blocks), dim3(NTHR), args, LDS_BYTES, stream);
  if (e != hipSuccess) fprintf(stderr, "cooperative launch failed: %s (grid %d)\n", hipGetErrorString(e), grid_blocks);
#else
  for (int ph = 0; ph < NPHASE; ++ph) {
    p.ph_lo = ph; p.ph_hi = ph + 1;
    hipLaunchKernelGGL(mk_forward, dim3(grid_blocks), dim3(NTHR), LDS_BYTES, stream, p);
  }
#endif
}
```

```cpp
#include <hip/hip_runtime.h>
#include <hip/hip_cooperative_groups.h>
#include <cstdio>
namespace cg = cooperative_groups;

#ifndef PHMASK
#define PHMASK 255
#endif
#ifndef DUPMASK
#define DUPMASK 0
#endif
#ifndef DUPK
#define DUPK -1
#endif
#ifndef PROBE_CLOCK
#define PROBE_CLOCK 0
#endif
#ifndef PROBE_NOEPI
#define PROBE_NOEPI 0
#endif
#ifndef FUSED
#define FUSED 1
#endif

namespace pg8 {
#define PG8_LAS __attribute__((address_space(3)))
typedef unsigned short bf16_t;
typedef short bf16x8 __attribute__((ext_vector_type(8)));
typedef float f32x4 __attribute__((ext_vector_type(4)));
typedef unsigned u32x4 __attribute__((ext_vector_type(4)));
constexpr int BM = 256, BK = 64, HALF = 128, HTB = HALF * BK * 2  , STAGE_BYTES = 8 * HTB, NXCD = 8, WGM = 8;

__host__ __device__ __forceinline__ int lds_byte(int r, int c) { const int st = (r >> 4) * 2 + (c >> 5), rr = r & 15, cc = c & 31, ob = rr * 64 + cc * 2; return st * 1024 + (ob ^ (((ob >> 9) & 1) << 5)); }
__host__ __device__ __forceinline__ void stage_rc(int b, int& R, int& C) { const int st = b / 1024, sb = b % 1024, swz = sb ^ (((sb >> 9) & 1) << 5); R = (st >> 1) * 16 + swz / 64; C = (st & 1) * 32 + (swz % 64) / 2; }
__host__ __device__ __forceinline__ int perm32(int rho) { const int n = rho >> 4, i = rho & 15; return 8 * (i >> 2) + 4 * n + (i & 3); }

struct Unit { int pm, pn, seg; };
struct Gemm { const bf16_t* A; const bf16_t* Bt; int M, N, K; };

struct StaticOrder {
    int nM, nN, nwg, G, c, probe = 0;
    __host__ __device__ void init(int M, int N, int G_, int c_) { nM = M / BM; nN = N / BM; nwg = nM * nN; G = G_; c = c_; }
    __host__ __device__ bool next(int i, Unit& u) const {
        const long L = (long)i * G + c; if (L >= nwg) return false;
        int wgid = (int)L; { const int q = nwg / NXCD, r = nwg % NXCD, xcd = wgid % NXCD, off = wgid / NXCD; wgid = (xcd < r ? xcd * (q + 1) : r * (q + 1) + (xcd - r) * q) + off; }
        const int nig = WGM * nN, gid = wgid / nig, fm = gid * WGM, gsz = (nM - fm) < WGM ? (nM - fm) : WGM;
        u.pm = fm + ((wgid % nig) % gsz); u.pn = (wgid % nig) / gsz; u.seg = 0; if (probe) { u.pm = 0; u.pn = 0; } return true;
    }
    __device__ __forceinline__ void a_ready(const Unit&) const {}
    __device__ __forceinline__ void done(const Unit&) const {}
    __device__ __forceinline__ const char* baseA(const Gemm& g, const Unit& u, size_t tstep) const { return (const char*)g.A + (size_t)u.pm * tstep; }
    __device__ __forceinline__ const char* baseB(const Gemm& g, const Unit& u, size_t tstep) const { return (const char*)g.Bt + (size_t)u.pn * tstep; }
    __device__ __forceinline__ bool zero_after(const Unit&) const { return true; }
};

template <class Epi, class Sched, bool STAMP = false>
__device__ __forceinline__ void gemm_phase(PG8_LAS unsigned char* lds, const Gemm g, const Sched& S, const Epi& E, unsigned long long* stamps) {
    int tid = threadIdx.x; asm volatile("" : "+v"(tid));
    const int wid = __builtin_amdgcn_readfirstlane(tid >> 6), lane = tid & 63, wr = wid >> 2, wc = wid & 3, fr = lane & 15, fq = lane >> 4;
    const int K = g.K, nt = K / BK;
    int ts_lo = 0, ts_hi = 0, nts = 0; const unsigned long long rt_entry = STAMP ? (unsigned long long)wall_clock64() : 0ull;
#define PG8_STAMP() do { if (STAMP && wid == 0 && nts < 64) { const unsigned long long _c = (unsigned long long)clock64(); \
        ts_lo = (lane == nts) ? (int)(unsigned)_c : ts_lo; ts_hi = (lane == nts) ? (int)(unsigned)(_c >> 32) : ts_hi; ++nts; } } while (0)
    PG8_STAMP();
    unsigned voffA[2], voffB[2];
#pragma unroll
    for (int i = 0; i < 2; ++i) { int R, C; stage_rc(tid * 16 + i * 8192, R, C); const int Rb = Epi::PERM ? ((R & ~31) + perm32(R & 31)) : R;
        voffA[i] = (unsigned)(R * K + C) * 2u; voffB[i] = (unsigned)(Rb * K + C) * 2u; }
    const size_t kstep = (size_t)(BK * 2);
    const size_t hstep = (size_t)HALF * K * 2;
    const size_t tstep = 2 * hstep;
    const unsigned ldsw = (unsigned)wid * 1024u;
    const int aoff = lds_byte(wr * 64 + fr, fq * 8), boff = lds_byte(wc * 32 + fr, fq * 8);
#define PG8_SA(b, h) (((b) * 2 + (h)) * HTB)
#define PG8_SB(b, h) ((4 + (b) * 2 + (h)) * HTB)
#define PG8_STAGE(bufoff, gbase, voff) do { _Pragma("unroll") for (int _i = 0; _i < 2; ++_i) \
        __builtin_amdgcn_global_load_lds((const unsigned*)((const char*)(gbase) + (voff)[_i]), (PG8_LAS unsigned*)(lds + (bufoff) + ldsw + _i * 8192), 16, 0, 0); } while (0)
#define PG8_LDA(dst, b, h) do { _Pragma("unroll") for (int m = 0; m < 4; ++m) _Pragma("unroll") for (int k = 0; k < 2; ++k) dst[m][k] = *(const PG8_LAS bf16x8*)(lds + PG8_SA(b, h) + aoff + m * 2048 + k * 1024); } while (0)
#define PG8_LDB(dst, b, h) do { _Pragma("unroll") for (int n = 0; n < 2; ++n) _Pragma("unroll") for (int k = 0; k < 2; ++k) dst[n][k] = *(const PG8_LAS bf16x8*)(lds + PG8_SB(b, h) + boff + n * 2048 + k * 1024); } while (0)
#define PG8_MMA(ai, bj, At, Bt) do { __builtin_amdgcn_s_setprio(1); _Pragma("unroll") for (int m = 0; m < 4; ++m) _Pragma("unroll") for (int n = 0; n < 2; ++n) _Pragma("unroll") for (int k = 0; k < 2; ++k) \
        acc[ai][bj][m][n] = __builtin_amdgcn_mfma_f32_16x16x32_bf16(Bt[n][k], At[m][k], acc[ai][bj][m][n], 0, 0, 0); __builtin_amdgcn_s_setprio(0); } while (0)
#define PG8_WAIT_V(n) asm volatile("s_waitcnt vmcnt(" #n ")" ::: "memory")
#define PG8_WAIT_L(n) asm volatile("s_waitcnt lgkmcnt(" #n ")" ::: "memory")
#define PG8_BAR __builtin_amdgcn_s_barrier()
#define PG8_SCHED __builtin_amdgcn_sched_barrier(0)
    Unit cur, nxt; int ui = 0;
    if (!S.next(0, cur)) return;
    f32x4 acc[2][2][4][2];
#pragma unroll
    for (int a = 0; a < 2; ++a)
#pragma unroll
        for (int b = 0; b < 2; ++b)
#pragma unroll
            for (int m = 0; m < 4; ++m)
#pragma unroll
                for (int n = 0; n < 2; ++n) acc[a][b][m][n] = (f32x4){0.f, 0.f, 0.f, 0.f};
    bf16x8 At[4][2], B0[2][2], B1[2][2];
    const char* cA = S.baseA(g, cur, tstep); const char* cB = S.baseB(g, cur, tstep);
    S.a_ready(cur);
    PG8_STAGE(PG8_SB(0, 0), cB, voffB); PG8_STAGE(PG8_SA(0, 0), cA, voffA); PG8_STAGE(PG8_SB(0, 1), cB + hstep, voffB); PG8_STAGE(PG8_SA(0, 1), cA + hstep, voffA);
    if (wr == 1) PG8_BAR;
    PG8_WAIT_V(4); PG8_BAR;
    PG8_STAGE(PG8_SB(1, 0), cB + kstep, voffB); PG8_STAGE(PG8_SA(1, 0), cA + kstep, voffA); PG8_STAGE(PG8_SB(1, 1), cB + hstep + kstep, voffB);
    PG8_WAIT_V(6); PG8_BAR;
    PG8_STAMP();
    for (;;) {
        const bool has_next = S.next(ui + 1, nxt);
        const char* nA = has_next ? S.baseA(g, nxt, tstep) : cA; const char* nB = has_next ? S.baseB(g, nxt, tstep) : cB;
        for (int t = 0; t < nt; t += 2) {
            const bool last = (t == nt - 2);
            const char* a1 = cA + (size_t)(t + 1) * kstep;
            const char* a2 = last ? nA : cA + (size_t)(t + 2) * kstep; const char* b2 = last ? nB : cB + (size_t)(t + 2) * kstep;
            const char* a3 = a2 + kstep; const char* b3 = b2 + kstep;
            if (last && has_next) S.a_ready(nxt);
            PG8_LDB(B0, 0, 0); PG8_SCHED; PG8_LDA(At, 0, 0); PG8_STAGE(PG8_SA(1, 1), a1 + hstep, voffA);
            PG8_WAIT_L(8); PG8_BAR; PG8_WAIT_L(0); PG8_MMA(0, 0, At, B0); PG8_BAR; PG8_SCHED;
            PG8_LDB(B1, 0, 1); PG8_STAGE(PG8_SB(0, 0), b2, voffB);
            PG8_BAR; PG8_WAIT_L(0); PG8_MMA(0, 1, At, B1); PG8_BAR;
            PG8_LDA(At, 0, 1); PG8_STAGE(PG8_SA(0, 0), a2, voffA);
            PG8_BAR; PG8_WAIT_L(0); PG8_MMA(1, 0, At, B0); PG8_BAR; PG8_SCHED;
            PG8_STAGE(PG8_SB(0, 1), b2 + hstep, voffB);
            PG8_WAIT_V(6); PG8_BAR; PG8_MMA(1, 1, At, B1); PG8_BAR;
            PG8_LDB(B0, 1, 0); PG8_SCHED; PG8_LDA(At, 1, 0); PG8_STAGE(PG8_SA(0, 1), a2 + hstep, voffA);
            PG8_WAIT_L(8); PG8_BAR; PG8_WAIT_L(0); PG8_MMA(0, 0, At, B0); PG8_BAR; PG8_SCHED;
            PG8_LDB(B1, 1, 1); PG8_STAGE(PG8_SB(1, 0), b3, voffB);
            PG8_BAR; PG8_WAIT_L(0); PG8_MMA(0, 1, At, B1); PG8_BAR;
            PG8_LDA(At, 1, 1); PG8_STAGE(PG8_SA(1, 0), a3, voffA);
            PG8_BAR; PG8_WAIT_L(0); PG8_MMA(1, 0, At, B0); PG8_BAR; PG8_SCHED;
            PG8_STAGE(PG8_SB(1, 1), b3 + hstep, voffB);
            PG8_WAIT_V(6); PG8_BAR; PG8_MMA(1, 1, At, B1); PG8_BAR;
        }
        PG8_STAMP();
        if constexpr (!Epi::AFTER_DRAIN) { E(acc, cur, wr, wc, fr, fq); S.done(cur); }
        PG8_STAMP();
        if (!has_next) break;
        if (S.zero_after(cur))
#pragma unroll
        for (int a = 0; a < 2; ++a)
#pragma unroll
            for (int b = 0; b < 2; ++b)
#pragma unroll
                for (int m = 0; m < 4; ++m)
#pragma unroll
                    for (int n = 0; n < 2; ++n) acc[a][b][m][n] = (f32x4){0.f, 0.f, 0.f, 0.f};
        cur = nxt; cA = nA; cB = nB; ++ui;
    }
    PG8_WAIT_V(0);
    if (wr == 0) PG8_BAR;
    PG8_BAR;
    if constexpr (Epi::AFTER_DRAIN) { E.fused(acc, cur, wr, wc, fr, fq, lds, wid, lane); S.done(cur); }
    PG8_STAMP();
    if (STAMP && wid == 0) { stamps[lane] = lane < nts ? (((unsigned long long)(unsigned)ts_hi << 32) | (unsigned)ts_lo) : 0ull;
        if (lane == 62) stamps[62] = rt_entry; if (lane == 63) stamps[63] = (unsigned long long)wall_clock64(); }
#undef PG8_STAMP
#undef PG8_SA
#undef PG8_SB
#undef PG8_STAGE
#undef PG8_LDA
#undef PG8_LDB
#undef PG8_MMA
#undef PG8_WAIT_V
#undef PG8_WAIT_L
#undef PG8_BAR
#undef PG8_SCHED
}
}

typedef unsigned short u16;
typedef short bf16x8 __attribute__((ext_vector_type(8)));
typedef float f32x16 __attribute__((ext_vector_type(16)));
typedef float f32x4 __attribute__((ext_vector_type(4)));
typedef __bf16 bf2_t __attribute__((ext_vector_type(2)));
typedef float f2_t __attribute__((ext_vector_type(2)));
typedef unsigned u32x4 __attribute__((ext_vector_type(4)));
typedef unsigned u32x2 __attribute__((ext_vector_type(2)));
using pg8::Unit;

#define DI __device__ __forceinline__
#define MFMA32(a, b, c) __builtin_amdgcn_mfma_f32_32x32x16_bf16((a), (b), (c), 0, 0, 0)

constexpr int DM = 1024, SEQ = 4096, NBATCH = 8, T = NBATCH * SEQ;
constexpr int NCH = 2, BC = NBATCH / NCH, TC = BC * SEQ;
constexpr int INC = 7552, DMLP = 4096;
constexpr int NQKG = 6656;
constexpr int NQKH = 38, NVH = 16;
constexpr float LOG2E = 1.4426950408889634f;
constexpr int NTHR = 512;

constexpr size_t al256(size_t x) { return (x + 255) & ~(size_t)255; }
constexpr size_t OFF_WQKG = 0;
constexpr size_t OFF_WV   = OFF_WQKG + al256((size_t)2 * NQKG * DM * 2);
constexpr size_t OFF_WBR5 = OFF_WV   + al256((size_t)2 * DM * DM * 2);
constexpr size_t OFF_WOUT = OFF_WBR5 + al256((size_t)2 * 5 * DM * 256 * 2);
constexpr size_t OFF_WUP  = OFF_WOUT + al256((size_t)2 * DM * DM * 2);
constexpr size_t OFF_WDN  = OFF_WUP  + al256((size_t)2 * DMLP * DM * 2);
constexpr size_t OFF_ROPE = OFF_WDN  + al256((size_t)2 * DM * DMLP * 2);
constexpr size_t OFF_XB   = OFF_ROPE + al256((size_t)SEQ * 96 * 4);
constexpr size_t OFF_SSQ  = OFF_XB   + al256((size_t)T * DM * 2);
constexpr size_t OFF_QK   = OFF_SSQ  + al256((size_t)T * 16 * 4);
constexpr size_t OFF_V    = OFF_QK   + al256((size_t)NQKH * TC * 64 * 2);
constexpr size_t OFF_GATE = OFF_V    + al256((size_t)NVH * TC * 64 * 2);
constexpr size_t OFF_Y5   = OFF_GATE + al256((size_t)TC * 4096 * 2);
constexpr size_t OFF_BO   = OFF_Y5   + al256((size_t)5 * TC * 256 * 2);
constexpr size_t OFF_LSE  = OFF_BO   + al256((size_t)TC * 384 * 2);
constexpr size_t OFF_MRG  = OFF_LSE  + al256((size_t)TC * 8 * 4);
constexpr size_t OFF_BAR  = OFF_MRG  + al256((size_t)TC * DM * 2);
constexpr size_t WS_END   = OFF_BAR  + 16384;
static_assert(WS_END <= (size_t)512 * 1024 * 1024, "workspace too large");

constexpr int LDS_STAGE = 131072;
constexpr int VT_STRIDE = 528;
constexpr int LDS_XBW = 256 * VT_STRIDE;
constexpr int LDS_BYTES = LDS_XBW + 64 + 1024;
constexpr int PPL = (DUPK >= 0) ? 7 : 6;
constexpr int NPHASE = 1 + NCH * 2 * PPL;

struct Params {
  const float* in[19];
  float* out;
  unsigned char* ws;
  int ph_lo, ph_hi;
};

DI unsigned pk2(float a, float b) { f2_t v = {a, b}; bf2_t r = __builtin_convertvector(v, bf2_t); return __builtin_bit_cast(unsigned, r); }
DI float bf_lo(unsigned u) { return __uint_as_float(u << 16); }
DI float bf_hi(unsigned u) { return __uint_as_float(u & 0xffff0000u); }
DI float fexp2(float x) { return __builtin_amdgcn_exp2f(x); }
DI int crow(int i, int h) { return (i & 3) + 8 * (i >> 2) + 4 * h; }
DI bf16x8 as_bf8(u32x4 v) { return __builtin_bit_cast(bf16x8, v); }
DI int dil_of(int gi) { return gi == 0 ? 1 : (gi == 1 ? 4 : 16); }
DI int dlg_of(int gi) { return gi * 2; }
DI float row_rscale(const float* ssq, size_t tok) {
  const f32x4 a = *(const f32x4*)(ssq + tok * 16), b = *(const f32x4*)(ssq + tok * 16 + 4);
  const f32x4 c = *(const f32x4*)(ssq + tok * 16 + 8), d = *(const f32x4*)(ssq + tok * 16 + 12);
  const float s = ((a[0] + a[1]) + (a[2] + a[3])) + ((b[0] + b[1]) + (b[2] + b[3])) + ((c[0] + c[1]) + (c[2] + c[3])) + ((d[0] + d[1]) + (d[2] + d[3]));
  return rsqrtf(s * (1.0f / 1024.0f) + 1e-6f);
}
DI int qk_head_col(int h) {
  if (h < 8) return 64 * h;
  if (h < 10) return 512 + 64 * (h - 8);
  if (h < 16) return 768 + 64 * (h - 10);
  if (h < 22) return 1152 + 64 * (h - 16);
  if (h < 26) return 1920 + 64 * (h - 22);
  if (h < 30) return 2176 + 64 * (h - 26);
  if (h < 34) return 2688 + 64 * (h - 30);
  return 2944 + 64 * (h - 34);
}
DI int v_head_col(int vh) {
  if (vh < 2) return 640 + 64 * vh;
  if (vh < 8) return 1536 + 64 * (vh - 2);
  if (vh < 12) return 2432 + 64 * (vh - 8);
  return 3200 + 64 * (vh - 12);
}

struct EpiQKG {
  static constexpr bool PERM = false, AFTER_DRAIN = false;
  const float* ssq; u16* qk; const float* rope; const float* gA; const float* gB; const float* gC; const float* gD;
  DI void operator()(const f32x4 (&acc)[2][2][4][2], const Unit& u, int wr, int wc, int fr, int fq) const {
    const int hidx = u.pn * 4 + wc;
    if (hidx >= NQKH) return;
    int kind, dlg = 0; const float* gain;
    if (hidx < 8) { kind = 0; gain = gA; }
    else if (hidx < 10) { kind = 0; gain = gA + 64; }
    else if (hidx < 16) { kind = 0; gain = gB; dlg = dlg_of((hidx - 10) >> 1); }
    else if (hidx < 22) { kind = 0; gain = gB + 64; dlg = dlg_of((hidx - 16) >> 1); }
    else if (hidx < 26) { kind = 2; gain = gC; }
    else if (hidx < 30) { kind = 2; gain = gC + 32; }
    else if (hidx < 34) { kind = 1; gain = gD; }
    else { kind = 1; gain = gD + 64; }
    u16* gbase = qk + (size_t)hidx * TC * 64;
    const float* gainl = gain + 4 * fq;
    const float qpre = (hidx >= 22 && hidx < 26) ? (0.17677669529663687f * LOG2E)
                     : ((hidx < 8 || (hidx >= 10 && hidx < 16) || (hidx >= 30 && hidx < 34)) ? (0.125f * LOG2E) : 1.0f);
#pragma unroll
    for (int ai = 0; ai < 2; ++ai)
#pragma unroll
      for (int m = 0; m < 4; ++m) {
        const int tok = u.pm * 256 + 128 * ai + 64 * wr + 16 * m + fr;
        const int bl = tok >> 12, pos = tok & 4095;
        const float rs = row_rscale(ssq, tok);
        const int pdom = ((pos & ((1 << dlg) - 1)) << (12 - dlg)) + (pos >> dlg);
        const int blk = pdom >> 5, rr = pdom & 31;
        u16* base = gbase + (size_t)bl * SEQ * 64;
        if (kind != 2) {
          float ss = 0.f;
#pragma unroll
          for (int bj = 0; bj < 2; ++bj)
#pragma unroll
            for (int n = 0; n < 2; ++n)
#pragma unroll
              for (int e = 0; e < 4; ++e) ss += acc[ai][bj][m][n][e] * acc[ai][bj][m][n][e];
          ss += __shfl_xor(ss, 16); ss += __shfl_xor(ss, 32);
          const float sc = rs * rsqrtf(ss * rs * rs * (1.0f / 64.0f) + 1e-6f) * qpre;
#pragma unroll
          for (int n = 0; n < 2; ++n) {
            f32x4 xa = acc[ai][0][m][n] * sc * *(const f32x4*)(gainl + 16 * n);
            f32x4 xb2 = acc[ai][1][m][n] * sc * *(const f32x4*)(gainl + 32 + 16 * n);
            if (kind == 0) {
              const f32x4 c4 = *(const f32x4*)(rope + pos * 96 + 16 * n + 4 * fq);
              const f32x4 s4 = *(const f32x4*)(rope + pos * 96 + 32 + 16 * n + 4 * fq);
              const f32x4 ta = xa * c4 - xb2 * s4, tb = xb2 * c4 + xa * s4;
              xa = ta; xb2 = tb;
            }
            u32x2 w0 = {pk2(xa[0], xa[1]), pk2(xa[2], xa[3])};
            *(u32x2*)(base + ((size_t)(blk * 4 + n) * 64 + (fq >> 1) * 32 + rr) * 8 + 4 * (fq & 1)) = w0;
            u32x2 w1 = {pk2(xb2[0], xb2[1]), pk2(xb2[2], xb2[3])};
            *(u32x2*)(base + ((size_t)(blk * 4 + 2 + n) * 64 + (fq >> 1) * 32 + rr) * 8 + 4 * (fq & 1)) = w1;
          }
        } else {
          const f32x4 c4 = *(const f32x4*)(rope + pos * 96 + 64 + 4 * fq);
          const f32x4 s4 = *(const f32x4*)(rope + pos * 96 + 80 + 4 * fq);
#pragma unroll
          for (int bj = 0; bj < 2; ++bj) {
            float ss = 0.f;
#pragma unroll
            for (int n = 0; n < 2; ++n)
#pragma unroll
              for (int e = 0; e < 4; ++e) ss += acc[ai][bj][m][n][e] * acc[ai][bj][m][n][e];
            ss += __shfl_xor(ss, 16); ss += __shfl_xor(ss, 32);
            const float sc = rs * rsqrtf(ss * rs * rs * (1.0f / 32.0f) + 1e-6f) * qpre;
            const f32x4 xa = acc[ai][bj][m][0] * sc * *(const f32x4*)(gainl);
            const f32x4 xb2 = acc[ai][bj][m][1] * sc * *(const f32x4*)(gainl + 16);
            const f32x4 ta = xa * c4 - xb2 * s4, tb = xb2 * c4 + xa * s4;
            u16* sb = base + (size_t)bj * SEQ * 32;
            u32x2 w0 = {pk2(ta[0], ta[1]), pk2(ta[2], ta[3])};
            *(u32x2*)(sb + ((size_t)(blk * 2 + 0) * 64 + (fq >> 1) * 32 + rr) * 8 + 4 * (fq & 1)) = w0;
            u32x2 w1 = {pk2(tb[0], tb[1]), pk2(tb[2], tb[3])};
            *(u32x2*)(sb + ((size_t)(blk * 2 + 1) * 64 + (fq >> 1) * 32 + rr) * 8 + 4 * (fq & 1)) = w1;
          }
        }
        asm volatile("" ::: "memory");
      }
  }
};

struct EpiGateUp {
  static constexpr bool PERM = true, AFTER_DRAIN = false;
  const float* ssq; u16* o; int mode;
  template <bool UP>
  DI void body(const f32x4 (&acc)[2][2][4][2], const Unit& u, int wr, int wc, int fr, int fq) const {
    const int c0 = u.pn * 256 + 32 * wc + 8 * fq;
    float rsv[8];
#pragma unroll
    for (int i = 0; i < 8; ++i) rsv[i] = row_rscale(ssq, (size_t)u.pm * 256 + 128 * (i >> 2) + 64 * wr + 16 * (i & 3) + fr);
#pragma unroll
    for (int ai = 0; ai < 2; ++ai)
#pragma unroll
      for (int m = 0; m < 4; ++m) {
        const size_t tok = (size_t)u.pm * 256 + 128 * ai + 64 * wr + 16 * m + fr;
        const float rs = rsv[ai * 4 + m];
#pragma unroll
        for (int bj = 0; bj < 2; ++bj) {
          float r[8];
#pragma unroll
          for (int n = 0; n < 2; ++n) {
            const f32x4 v = acc[ai][bj][m][n] * rs;
#pragma unroll
            for (int e = 0; e < 4; ++e) {
              if (UP) { const float z = fmaxf(v[e], 0.f); r[4 * n + e] = z * z; }
              else r[4 * n + e] = __builtin_amdgcn_rcpf(1.0f + fexp2(-LOG2E * v[e]));
            }
          }
          u32x4 w = {pk2(r[0], r[1]), pk2(r[2], r[3]), pk2(r[4], r[5]), pk2(r[6], r[7])};
          *(u32x4*)(o + tok * 4096 + c0 + 128 * bj) = w;
        }
        asm volatile("" ::: "memory");
      }
  }
  DI void operator()(const f32x4 (&acc)[2][2][4][2], const Unit& u, int wr, int wc, int fr, int fq) const {
    if (mode == 2) return;
    if (mode == 1) body<true>(acc, u, wr, wc, fr, fq);
    else body<false>(acc, u, wr, wc, fr, fq);
  }
};

struct EpiVT {
  static constexpr bool PERM = false, AFTER_DRAIN = true;
  const float* ssq; u16* vbuf;
  DI void operator()(const f32x4 (&)[2][2][4][2], const Unit&, int, int, int, int) const {}
  DI void fused(const f32x4 (&acc)[2][2][4][2], const Unit& u, int wr, int wc, int fr, int fq, PG8_LAS unsigned char* lds, int wid, int lane) const {
    PG8_LAS float* rsl = (PG8_LAS float*)(lds + 256 * VT_STRIDE + 64);
    {
      const int t = wid * 64 + lane;
      if (t < 256) rsl[t] = row_rscale(ssq, (size_t)u.pn * 256 + t);
    }
    __syncthreads();
#pragma unroll
    for (int ai = 0; ai < 2; ++ai)
#pragma unroll
      for (int m = 0; m < 4; ++m) {
        const int r = 128 * ai + 64 * wr + 16 * m + fr;
#pragma unroll
        for (int bj = 0; bj < 2; ++bj)
#pragma unroll
          for (int n = 0; n < 2; ++n) {
            const f32x4 v = acc[ai][bj][m][n] * *(const PG8_LAS f32x4*)(rsl + 128 * bj + 32 * wc + 16 * n + 4 * fq);
            u32x2 w = {pk2(v[0], v[1]), pk2(v[2], v[3])};
            *(PG8_LAS u32x2*)(lds + r * VT_STRIDE + (128 * bj + 32 * wc + 16 * n + 4 * fq) * 2) = w;
          }
      }
    __syncthreads();
    const int tid = wid * 64 + lane;
    const int bl = (u.pn * 256) >> 12, pos0 = (u.pn * 256) & 4095;
#pragma unroll 1
    for (int it = 0; it < 16; ++it) {
      const int uidx = it * 512 + tid;
      const int dvlo = uidx & 31, hh = (uidx >> 5) & 1, rb = (uidx >> 6) & 1, half = (uidx >> 7) & 15, h = uidx >> 11;
      const int vgrp = u.pm * 4 + h;
      const int dlg = (vgrp >= 2 && vgrp < 8) ? dlg_of((vgrp - 2) >> 1) : 0;
      const int cls = half >> (4 - dlg), hc = half & ((16 >> dlg) - 1);
      const int m0 = pos0 >> dlg, mh = m0 + 16 * hc;
      const int s = (mh >> 4) & 1, dblk = cls * (128 >> dlg) + (mh >> 5);
      const PG8_LAS unsigned char* row = lds + (h * 64 + rb * 32 + dvlo) * VT_STRIDE;
      unsigned short k8[8];
#pragma unroll
      for (int j = 0; j < 8; ++j) {
        const int tau = ((16 * hc + 4 * hh + (j & 3) + 8 * (j >> 2)) << dlg) + cls;
        k8[j] = *(const PG8_LAS unsigned short*)(row + tau * 2);
      }
      u32x4 w = {(unsigned)k8[0] | ((unsigned)k8[1] << 16), (unsigned)k8[2] | ((unsigned)k8[3] << 16),
                 (unsigned)k8[4] | ((unsigned)k8[5] << 16), (unsigned)k8[6] | ((unsigned)k8[7] << 16)};
      u16* dst = vbuf + (size_t)vgrp * TC * 64 + (size_t)bl * SEQ * 64 + ((size_t)((dblk * 2 + rb) * 2 + s) * 64 + hh * 32 + dvlo) * 8;
      *(u32x4*)dst = w;
    }
    __syncthreads();
  }
};

struct MergeOrder : pg8::StaticOrder {
  const u16* ybase; const u16* wbase;
  DI bool next(int i, Unit& u) const { if (i >= 5) return false; if (!pg8::StaticOrder::next(0, u)) return false; u.seg = i; return true; }
  DI const char* baseA(const pg8::Gemm&, const Unit& u, size_t tstep) const { return (const char*)(ybase + (size_t)u.seg * TC * 256) + (size_t)u.pm * tstep; }
  DI const char* baseB(const pg8::Gemm&, const Unit& u, size_t tstep) const { return (const char*)(wbase + (size_t)u.seg * DM * 256) + (size_t)u.pn * tstep; }
  DI bool zero_after(const Unit& u) const { return u.seg == 4; }
};
struct EpiMerge {
  static constexpr bool PERM = true, AFTER_DRAIN = false;
  const u16* gate; u16* mrg;
  DI void operator()(f32x4 (&acc)[2][2][4][2], const Unit& u, int wr, int wc, int fr, int fq) const {
    const int seg = u.seg;
    if (seg == 0) return;
    const bool last = (seg == 4);
    const int gnum = last ? 3 : seg - 1, gden = last ? 3 : seg;
    const u16* gnp = gate + ((size_t)u.pm * 256 + 64 * wr + fr) * 4096 + gnum * 1024 + u.pn * 256 + 32 * wc + 8 * fq;
    const u16* gdp = gate + ((size_t)u.pm * 256 + 64 * wr + fr) * 4096 + gden * 1024 + u.pn * 256 + 32 * wc + 8 * fq;
    u32x4 gn, gd, gnn, gdn;
    gn = *(const u32x4*)gnp; gd = *(const u32x4*)gdp;
#pragma unroll
    for (int i = 0; i < 16; ++i) {
      const int ai = i >> 3, m = (i >> 1) & 3, bj = i & 1;
      if (i < 15) {
        const int i2 = i + 1;
        const size_t ro = (size_t)(128 * (i2 >> 3) + 16 * ((i2 >> 1) & 3)) * 4096 + 128 * (i2 & 1);
        gnn = *(const u32x4*)(gnp + ro); gdn = *(const u32x4*)(gdp + ro);
      }
      asm volatile("" ::: "memory");
#pragma unroll
      for (int n = 0; n < 2; ++n) {
        f32x4 f;
        f[0] = bf_lo(gn[2 * n]); f[1] = bf_hi(gn[2 * n]); f[2] = bf_lo(gn[2 * n + 1]); f[3] = bf_hi(gn[2 * n + 1]);
        if (!last) {
          f[0] *= __builtin_amdgcn_rcpf(bf_lo(gd[2 * n])); f[1] *= __builtin_amdgcn_rcpf(bf_hi(gd[2 * n]));
          f[2] *= __builtin_amdgcn_rcpf(bf_lo(gd[2 * n + 1])); f[3] *= __builtin_amdgcn_rcpf(bf_hi(gd[2 * n + 1]));
        }
        acc[ai][bj][m][n] *= f;
      }
      if (last) {
        const size_t tok = (size_t)u.pm * 256 + 128 * ai + 64 * wr + 16 * m + fr;
        const int c = u.pn * 256 + 128 * bj + 32 * wc + 8 * fq;
        const f32x4 v0 = acc[ai][bj][m][0], v1 = acc[ai][bj][m][1];
        u32x4 w = {pk2(v0[0], v0[1]), pk2(v0[2], v0[3]), pk2(v1[0], v1[1]), pk2(v1[2], v1[3])};
        *(u32x4*)(mrg + tok * DM + c) = w;
      }
      gn = gnn; gd = gdn;
    }
  }
};

struct EpiResid {
  static constexpr bool PERM = true, AFTER_DRAIN = false;
  const float* xold; float* xout; u16* xb; float* ssq;
  DI void operator()(const f32x4 (&acc)[2][2][4][2], const Unit& u, int wr, int wc, int fr, int fq) const {
    const size_t o0 = ((size_t)u.pm * 256 + 64 * wr + fr) * DM + u.pn * 256 + 32 * wc + 8 * fq;
    f32x4 xo0, xo1, xn0, xn1;
    xo0 = *(const f32x4*)(xold + o0); xo1 = *(const f32x4*)(xold + o0 + 4);
    float ss = 0.f;
#pragma unroll
    for (int i = 0; i < 16; ++i) {
      const int ai = i >> 3, m = (i >> 1) & 3, bj = i & 1;
      if (i < 15) {
        const int i2 = i + 1;
        const size_t ro = o0 + (size_t)(128 * (i2 >> 3) + 16 * ((i2 >> 1) & 3)) * DM + 128 * (i2 & 1);
        xn0 = *(const f32x4*)(xold + ro); xn1 = *(const f32x4*)(xold + ro + 4);
      }
      asm volatile("" ::: "memory");
      const size_t tok = (size_t)u.pm * 256 + 128 * ai + 64 * wr + 16 * m + fr;
      const size_t o = tok * DM + u.pn * 256 + 128 * bj + 32 * wc + 8 * fq;
      const f32x4 v0 = xo0 + acc[ai][bj][m][0];
      const f32x4 v1 = xo1 + acc[ai][bj][m][1];
      *(f32x4*)(xout + o) = v0;
      *(f32x4*)(xout + o + 4) = v1;
      u32x4 w = {pk2(v0[0], v0[1]), pk2(v0[2], v0[3]), pk2(v1[0], v1[1]), pk2(v1[2], v1[3])};
      *(u32x4*)(xb + o) = w;
      ss += ((v0[0] * v0[0] + v0[1] * v0[1]) + (v0[2] * v0[2] + v0[3] * v0[3])) + ((v1[0] * v1[0] + v1[1] * v1[1]) + (v1[2] * v1[2] + v1[3] * v1[3]));
      if (bj == 1) {
        ss += __shfl_xor(ss, 16); ss += __shfl_xor(ss, 32);
        if (fq == 0) ssq[tok * 16 + u.pn * 4 + wc] = ss;
        ss = 0.f;
      }
      xo0 = xn0; xo1 = xn1;
    }
  }
};

template <class Epi>
DI void run_merge(PG8_LAS unsigned char* lds, const u16* ybase, const u16* wbase, const Epi& E) {
  int K = 256; asm volatile("" : "+s"(K));
  pg8::Gemm g; g.A = ybase; g.Bt = wbase; g.M = TC; g.N = DM; g.K = K;
  MergeOrder S; S.init(TC, DM, (int)gridDim.x, (int)blockIdx.x); S.ybase = ybase; S.wbase = wbase;
  pg8::gemm_phase<Epi, MergeOrder, false>(lds, g, S, E, nullptr);
}
template <class Epi>
DI void run_gemm(PG8_LAS unsigned char* lds, const u16* A, const u16* Bt, int M, int N, int K, const Epi& E, int probe = 0) {
  asm volatile("" : "+s"(K));
  pg8::Gemm g; g.A = A; g.Bt = Bt; g.M = M; g.N = N; g.K = K;
  pg8::StaticOrder S; S.init(M, N, (int)gridDim.x, (int)blockIdx.x); S.probe = probe;
  pg8::gemm_phase<Epi, pg8::StaticOrder, false>(lds, g, S, E, nullptr);
}

DI void cvt_load(const float* __restrict__ src, int N, int k0, int n0, const float* __restrict__ g, float* t, int ht) {
  const int c4 = (ht & 15) * 4;
#pragma unroll
  for (int i = 0; i < 4; ++i) {
    const int kk = (ht >> 4) + 16 * i;
    f32x4 v = *(const f32x4*)(src + (size_t)(k0 + kk) * N + n0 + c4);
    const float sc = g ? g[k0 + kk] : 1.0f;
    t[kk * 65 + c4 + 0] = v[0] * sc; t[kk * 65 + c4 + 1] = v[1] * sc; t[kk * 65 + c4 + 2] = v[2] * sc; t[kk * 65 + c4 + 3] = v[3] * sc;
  }
}
DI void cvt_store(u16* __restrict__ dst, int ldk, int kdst, int d0, int d1, const float* t, int ht) {
  const int kc = (ht & 7) * 8, nn = ht >> 3;
#pragma unroll
  for (int i = 0; i < 2; ++i) {
    const int tn = nn + 32 * i, row = (i == 0) ? d0 + nn : d1 + nn;
    u32x4 w;
    w[0] = pk2(t[(kc + 0) * 65 + tn], t[(kc + 1) * 65 + tn]);
    w[1] = pk2(t[(kc + 2) * 65 + tn], t[(kc + 3) * 65 + tn]);
    w[2] = pk2(t[(kc + 4) * 65 + tn], t[(kc + 5) * 65 + tn]);
    w[3] = pk2(t[(kc + 6) * 65 + tn], t[(kc + 7) * 65 + tn]);
    *(u32x4*)(dst + (size_t)row * ldk + kdst + kc) = w;
  }
}
struct CvtJob { const float* src; int N, k0, n0; const float* g; u16* dst; int ldk, d0, d1, kd; };
DI CvtJob cvt_job(const Params& p, int l, int ti) {
  CvtJob j; j.g = nullptr; j.kd = -1;
  const float* attn_g = p.in[1] + l * DM;
  if (ti < 608) { const int h = ti >> 4, kt = ti & 15; j.src = p.in[2] + (size_t)l * DM * INC; j.N = INC; j.k0 = kt * 64; j.n0 = qk_head_col(h); j.g = attn_g;
    j.dst = (u16*)(p.ws + OFF_WQKG) + (size_t)l * NQKG * DM; j.ldk = DM; j.d0 = (h >> 2) * 256 + (h & 3) * 32; j.d1 = j.d0 + 128; return j; }
  ti -= 608;
  if (ti < 1024) { const int c = ti >> 4, kt = ti & 15; j.src = p.in[2] + (size_t)l * DM * INC; j.N = INC; j.k0 = kt * 64; j.n0 = 3456 + 64 * c; j.g = attn_g;
    j.dst = (u16*)(p.ws + OFF_WQKG) + (size_t)l * NQKG * DM; j.ldk = DM; j.d0 = 2560 + 64 * c; j.d1 = j.d0 + 32; return j; }
  ti -= 1024;
  if (ti < 256) { const int vh = ti >> 4, kt = ti & 15; j.src = p.in[2] + (size_t)l * DM * INC; j.N = INC; j.k0 = kt * 64; j.n0 = v_head_col(vh); j.g = attn_g;
    j.dst = (u16*)(p.ws + OFF_WV) + (size_t)l * DM * DM; j.ldk = DM; j.d0 = vh * 64; j.d1 = j.d0 + 32; return j; }
  ti -= 256;
  if (ti < 128) { j.src = p.in[11] + (size_t)l * 512 * DM; j.N = DM; j.k0 = (ti >> 4) * 64; j.n0 = (ti & 15) * 64; j.dst = (u16*)(p.ws + OFF_WBR5) + ((size_t)l * 5 + (j.k0 >> 8)) * DM * 256; j.ldk = 256; j.kd = j.k0 & 255; j.d0 = j.n0; j.d1 = j.n0 + 32; return j; }
  ti -= 128;
  if (ti < 32) { j.src = p.in[12] + (size_t)l * 128 * DM; j.N = DM; j.k0 = (ti >> 4) * 64; j.n0 = (ti & 15) * 64; j.dst = (u16*)(p.ws + OFF_WBR5) + ((size_t)l * 5 + 2) * DM * 256; j.ldk = 256; j.kd = j.k0; j.d0 = j.n0; j.d1 = j.n0 + 32; return j; }
  ti -= 32;
  if (ti < 64) { j.src = p.in[13] + (size_t)l * 256 * DM; j.N = DM; j.k0 = (ti >> 4) * 64; j.n0 = (ti & 15) * 64; j.dst = (u16*)(p.ws + OFF_WBR5) + ((size_t)l * 5 + 3) * DM * 256; j.ldk = 256; j.kd = j.k0; j.d0 = j.n0; j.d1 = j.n0 + 32; return j; }
  ti -= 64;
  if (ti < 64) { j.src = p.in[14] + (size_t)l * 256 * DM; j.N = DM; j.k0 = (ti >> 4) * 64; j.n0 = (ti & 15) * 64; j.dst = (u16*)(p.ws + OFF_WBR5) + ((size_t)l * 5 + 4) * DM * 256; j.ldk = 256; j.kd = j.k0; j.d0 = j.n0; j.d1 = j.n0 + 32; return j; }
  ti -= 64;
  if (ti < 256) { j.src = p.in[15] + (size_t)l * DM * DM; j.N = DM; j.k0 = (ti >> 4) * 64; j.n0 = (ti & 15) * 64; j.dst = (u16*)(p.ws + OFF_WOUT) + (size_t)l * DM * DM; j.ldk = DM; j.d0 = j.n0; j.d1 = j.n0 + 32; return j; }
  ti -= 256;
  if (ti < 1024) { j.src = p.in[17] + (size_t)l * DM * DMLP; j.N = DMLP; j.k0 = (ti >> 6) * 64; j.n0 = (ti & 63) * 64; j.g = p.in[16] + l * DM;
    j.dst = (u16*)(p.ws + OFF_WUP) + (size_t)l * DMLP * DM; j.ldk = DM; j.d0 = j.n0; j.d1 = j.n0 + 32; return j; }
  ti -= 1024;
  j.src = p.in[18] + (size_t)l * DMLP * DM; j.N = DM; j.k0 = (ti >> 4) * 64; j.n0 = (ti & 15) * 64; j.dst = (u16*)(p.ws + OFF_WDN) + (size_t)l * DM * DMLP; j.ldk = DMLP; j.d0 = j.n0; j.d1 = j.n0 + 32; return j;
}

__device__ void phase_prep(const Params& p, int tid_, int bid_, int nblk_, unsigned char* smem) {
  const int half = tid_ >> 8, ht = tid_ & 255;
  float* t = (float*)smem + half * (64 * 65);
  const int per_layer = 4480, total = 2 * per_layer;
  for (int jp = bid_; jp * 2 < total; jp += nblk_) {
    const int j = jp * 2 + half;
    const bool on = j < total;
    CvtJob job;
    if (on) { job = cvt_job(p, j / per_layer, j % per_layer); cvt_load(job.src, job.N, job.k0, job.n0, job.g, t, ht); }
    __syncthreads();
    if (on) cvt_store(job.dst, job.ldk, (job.kd >= 0) ? job.kd : job.k0, job.d0, job.d1, t, ht);
    __syncthreads();
  }
  {
    const u32x4 z = {0u, 0u, 0u, 0u};
    for (int e = bid_ * NTHR + tid_; e < 2 * 128 * 128; e += nblk_ * NTHR) {
      const int l = e >> 14, r = (e >> 7) & 127, c = (e & 127) * 8;
      const int row = 9 * 256 + ((r < 64) ? 64 + r : 128 + r);
      *(u32x4*)((u16*)(p.ws + OFF_WQKG) + ((size_t)l * NQKG + row) * DM + c) = z;
    }
    for (int e = bid_ * NTHR + tid_; e < 2 * 1024 * 16; e += nblk_ * NTHR) {
      const int l = e >> 14, r = (e >> 4) & 1023, c = 128 + (e & 15) * 8;
      *(u32x4*)((u16*)(p.ws + OFF_WBR5) + (((size_t)l * 5 + 2) * DM + r) * 256 + c) = z;
    }
  }
  float* rope = (float*)(p.ws + OFF_ROPE);
  for (int e = bid_ * NTHR + tid_; e < SEQ * 48; e += nblk_ * NTHR) {
    const int pos = e / 48, i = e % 48;
    float inv;
    if (i < 32) inv = exp2f(-13.287712379549449f * (float)(2 * i) / 64.0f);
    else inv = exp2f(-13.287712379549449f * (float)(2 * (i - 32)) / 32.0f);
    const float angf = (float)pos * inv;
    const double ang = (double)angf;
    const double n = rint(ang * 0.15915494309189535);
    const float r = (float)(ang - n * 6.283185307179586);
    const float c = cosf(r), s = sinf(r);
    if (i < 32) { rope[pos * 96 + i] = c; rope[pos * 96 + 32 + i] = s; }
    else { rope[pos * 96 + 64 + (i - 32)] = c; rope[pos * 96 + 80 + (i - 32)] = s; }
  }
  u16* XB = (u16*)(p.ws + OFF_XB); float* SSQ = (float*)(p.ws + OFF_SSQ);
  const int lane = tid_ & 63;
  const int gw = bid_ * 8 + (tid_ >> 6), nw = nblk_ * 8;
  for (int row = gw; row < T; row += nw) {
    const float* xr = p.in[0] + (size_t)row * DM;
    float ss = 0.f;
#pragma unroll
    for (int i = 0; i < 4; ++i) {
      const f32x4 v = *(const f32x4*)(xr + i * 256 + lane * 4);
      ss += v[0] * v[0] + v[1] * v[1] + v[2] * v[2] + v[3] * v[3];
      u32x2 w = {pk2(v[0], v[1]), pk2(v[2], v[3])};
      *(u32x2*)(XB + (size_t)row * DM + i * 256 + lane * 4) = w;
    }
#pragma unroll
    for (int o = 32; o >= 1; o >>= 1) ss += __shfl_xor(ss, o);
    if (lane < 16) SSQ[(size_t)row * 16 + lane] = (lane == 0) ? ss : 0.f;
  }
}

DI void attn_softmax_pv(f32x16& S, float& m, float& l, f32x16& O0, f32x16& O1, const bf16x8 (&vf)[2][2]) {
  float mx = S[0];
#pragma unroll
  for (int i = 1; i < 16; ++i) mx = fmaxf(mx, S[i]);
  mx = fmaxf(mx, __shfl_xor(mx, 32));
  const float mn = fmaxf(m, mx);
  const float alpha = fexp2(m - mn);
  m = mn;
  float sum = 0.f;
#pragma unroll
  for (int i = 0; i < 16; ++i) { S[i] = fexp2(S[i] - mn); sum += S[i]; }
  l = l * alpha + sum;
  const u32x4 p0 = {pk2(S[0], S[1]), pk2(S[2], S[3]), pk2(S[4], S[5]), pk2(S[6], S[7])};
  const u32x4 p1 = {pk2(S[8], S[9]), pk2(S[10], S[11]), pk2(S[12], S[13]), pk2(S[14], S[15])};
#pragma unroll
  for (int i = 0; i < 16; ++i) { O0[i] *= alpha; O1[i] *= alpha; }
  O0 = MFMA32(vf[0][0], as_bf8(p0), O0);
  O0 = MFMA32(vf[0][1], as_bf8(p1), O0);
  O1 = MFMA32(vf[1][0], as_bf8(p0), O1);
  O1 = MFMA32(vf[1][1], as_bf8(p1), O1);
}
DI void attn_fixed_pv(f32x16& S, f32x16& L, f32x16& O0, f32x16& O1, const bf16x8 (&vf)[2][2], const bf16x8 ones) {
#pragma unroll
  for (int i = 0; i < 16; ++i) S[i] = fexp2(S[i]);
  const u32x4 p0 = {pk2(S[0], S[1]), pk2(S[2], S[3]), pk2(S[4], S[5]), pk2(S[6], S[7])};
  const u32x4 p1 = {pk2(S[8], S[9]), pk2(S[10], S[11]), pk2(S[12], S[13]), pk2(S[14], S[15])};
  O0 = MFMA32(vf[0][0], as_bf8(p0), O0);
  O0 = MFMA32(vf[0][1], as_bf8(p1), O0);
  O1 = MFMA32(vf[1][0], as_bf8(p0), O1);
  O1 = MFMA32(vf[1][1], as_bf8(p1), O1);
  float sum = 0.f;
#pragma unroll
  for (int i = 0; i < 16; ++i) sum += S[i];
  L[0] += sum;
}
DI void attn_plain_pv(f32x16& S, float& l, f32x16& O0, f32x16& O1, const bf16x8 (&vf)[2][2]) {
  float sum = 0.f;
#pragma unroll
  for (int i = 0; i < 16; ++i) { S[i] = fexp2(S[i]); sum += S[i]; }
  l += sum;
  const u32x4 p0 = {pk2(S[0], S[1]), pk2(S[2], S[3]), pk2(S[4], S[5]), pk2(S[6], S[7])};
  const u32x4 p1 = {pk2(S[8], S[9]), pk2(S[10], S[11]), pk2(S[12], S[13]), pk2(S[14], S[15])};
  O0 = MFMA32(vf[0][0], as_bf8(p0), O0); O1 = MFMA32(vf[1][0], as_bf8(p0), O1);
  O0 = MFMA32(vf[0][1], as_bf8(p1), O0); O1 = MFMA32(vf[1][1], as_bf8(p1), O1);
}
DI float gain_bound64(const float* g) {
  float a = 0.f, b = 0.f;
  for (int i = 0; i < 64; ++i) { a = fmaxf(a, fabsf(g[i])); b = fmaxf(b, fabsf(g[64 + i])); }
  return fminf(8.0f * a * b * 1.02f + 0.05f, 40.0f);
}
DI void load_vf(bf16x8 (&vf)[2][2], const u16* V, int kb, int lane) {
#pragma unroll
  for (int rb = 0; rb < 2; ++rb)
#pragma unroll
    for (int s = 0; s < 2; ++s) vf[rb][s] = *(const bf16x8*)(V + ((size_t)((kb * 2 + rb) * 2 + s) * 64 + lane) * 8);
}
DI void load_kf4(bf16x8 (&kf)[4], const u16* K, int kb, int lane) {
#pragma unroll
  for (int s = 0; s < 4; ++s) kf[s] = *(const bf16x8*)(K + ((size_t)(kb * 4 + s) * 64 + lane) * 8);
}
DI void load_kf2(bf16x8 (&kf)[2], const u16* K, int kb, int lane) {
#pragma unroll
  for (int s = 0; s < 2; ++s) kf[s] = *(const bf16x8*)(K + ((size_t)(kb * 2 + s) * 64 + lane) * 8);
}
DI void zero16(f32x16& a) {
#pragma unroll
  for (int i = 0; i < 16; ++i) a[i] = 0.f;
}
DI void store_o(u16* yrow, const f32x16& O0, const f32x16& O1, float sc, int h) {
#pragma unroll
  for (int g4 = 0; g4 < 4; ++g4) {
    u32x2 w0 = {pk2(O0[4 * g4] * sc, O0[4 * g4 + 1] * sc), pk2(O0[4 * g4 + 2] * sc, O0[4 * g4 + 3] * sc)};
    *(u32x2*)(yrow + 8 * g4 + 4 * h) = w0;
    u32x2 w1 = {pk2(O1[4 * g4] * sc, O1[4 * g4 + 1] * sc), pk2(O1[4 * g4 + 2] * sc, O1[4 * g4 + 3] * sc)};
    *(u32x2*)(yrow + 32 + 8 * g4 + 4 * h) = w1;
  }
}

__device__ void phase_attn(const Params& p, int tid_, int bid_, int nblk_, int layer) {
  const u16* QK = (const u16*)(p.ws + OFF_QK);
  const u16* VB = (const u16*)(p.ws + OFF_V);
  u16* Y5 = (u16*)(p.ws + OFF_Y5);
  u16* BO = (u16*)(p.ws + OFF_BO);
  float* LSE = (float*)(p.ws + OFF_LSE);
  const int lane = tid_ & 63, wave = tid_ >> 6;
  const int fr = lane & 31, fh = lane >> 5;
  const int nloc = nblk_ >> 3;
  if ((int)(bid_ >> 3) >= nloc) return;
  const int vw = ((bid_ & 7) * nloc + (bid_ >> 3)) * 8 + wave, NW = nloc * 64;
  const size_t GS = (size_t)TC * 64;
  const size_t BS = (size_t)SEQ * 64;

  {
    const float* lp = p.in[7] + layer * 128;
    float d01 = 0.f, d23 = 0.f;
    for (int i = 0; i < 32; ++i) { d01 += lp[i] * lp[32 + i]; d23 += lp[64 + i] * lp[96 + i]; }
    const float lambda_init = (layer == 0) ? 0.2f : 0.35550907f;
    const float lam = __expf(d01) - __expf(d23) + lambda_init;
    const float* subg = p.in[8] + layer * 64;
    const float sc = 0.17677669529663687f * LOG2E;
    float gqm = 0.f, gkm = 0.f;
    for (int i = 0; i < 32; ++i) { gqm = fmaxf(gqm, fabsf(p.in[6][layer * 64 + i])); gkm = fmaxf(gkm, fabsf(p.in[6][layer * 64 + 32 + i])); }
    const unsigned onev = ((fr & 27) == 0) ? 0x3f803f80u : 0u;
    const u32x4 ones4 = {onev, onev, onev, onev};
    const bf16x8 ones = as_bf8(ones4);
    const float cbound = 5.6568542f * gqm * gkm * 1.02f + 0.05f;
    for (int it = vw; it < BC * 4 * 128; it += NW) {
      const int bl = it >> 9, head = (it >> 7) & 3, qblk = it & 127;
      const u16* Q0 = QK + (22 + head) * GS + bl * BS; const u16* Q1 = Q0 + SEQ * 32;
      const u16* K0 = QK + (26 + head) * GS + bl * BS; const u16* K1 = K0 + SEQ * 32;
      const u16* V = VB + (8 + head) * GS + bl * BS;
      bf16x8 q0[2], q1[2];
      load_kf2(q0, Q0, qblk, lane); load_kf2(q1, Q1, qblk, lane);
      f32x16 L0, L1; zero16(L0); zero16(L1);
      f32x16 O00, O01, O10, O11; zero16(O00); zero16(O01); zero16(O10); zero16(O11);
      bf16x8 k0[2], k1[2], vf[2][2];
      {
        const float mb2 = fminf(cbound, 40.0f) * LOG2E;
        f32x16 sinit;
#pragma unroll
        for (int i = 0; i < 16; ++i) sinit[i] = -mb2;
        load_kf2(k0, K0, 0, lane); load_kf2(k1, K1, 0, lane); load_vf(vf, V, 0, lane);
        f32x16 S0 = sinit, S1 = sinit;
        S0 = MFMA32(k0[0], q0[0], S0); S0 = MFMA32(k0[1], q0[1], S0);
        S1 = MFMA32(k1[0], q1[0], S1); S1 = MFMA32(k1[1], q1[1], S1);
        load_kf2(k0, K0, 1, lane); load_kf2(k1, K1, 1, lane);
        for (int kb = 0; kb < 128; ++kb) {
          bf16x8 nk0[2], nk1[2], nvf[2][2];
          const int k2 = (kb + 2 < 128) ? kb + 2 : 127, v1 = (kb + 1 < 128) ? kb + 1 : 127;
          load_kf2(nk0, K0, k2, lane); load_kf2(nk1, K1, k2, lane); load_vf(nvf, V, v1, lane);
          f32x16 S0n = sinit, S1n = sinit;
#pragma unroll
          for (int i = 0; i < 16; ++i) S0[i] = fexp2(S0[i]);
          S0n = MFMA32(k0[0], q0[0], S0n); S0n = MFMA32(k0[1], q0[1], S0n);
          {
            const u32x4 p0 = {pk2(S0[0], S0[1]), pk2(S0[2], S0[3]), pk2(S0[4], S0[5]), pk2(S0[6], S0[7])};
            const u32x4 p1 = {pk2(S0[8], S0[9]), pk2(S0[10], S0[11]), pk2(S0[12], S0[13]), pk2(S0[14], S0[15])};
            O00 = MFMA32(vf[0][0], as_bf8(p0), O00); O01 = MFMA32(vf[1][0], as_bf8(p0), O01);
            O00 = MFMA32(vf[0][1], as_bf8(p1), O00); O01 = MFMA32(vf[1][1], as_bf8(p1), O01);
            float sum = 0.f;
#pragma unroll
            for (int i = 0; i < 16; ++i) sum += S0[i];
            L0[0] += sum;
          }
#pragma unroll
          for (int i = 0; i < 16; ++i) S1[i] = fexp2(S1[i]);
          S1n = MFMA32(k1[0], q1[0], S1n); S1n = MFMA32(k1[1], q1[1], S1n);
          {
            const u32x4 p0 = {pk2(S1[0], S1[1]), pk2(S1[2], S1[3]), pk2(S1[4], S1[5]), pk2(S1[6], S1[7])};
            const u32x4 p1 = {pk2(S1[8], S1[9]), pk2(S1[10], S1[11]), pk2(S1[12], S1[13]), pk2(S1[14], S1[15])};
            O10 = MFMA32(vf[0][0], as_bf8(p0), O10); O11 = MFMA32(vf[1][0], as_bf8(p0), O11);
            O10 = MFMA32(vf[0][1], as_bf8(p1), O10); O11 = MFMA32(vf[1][1], as_bf8(p1), O11);
            float sum = 0.f;
#pragma unroll
            for (int i = 0; i < 16; ++i) sum += S1[i];
            L1[0] += sum;
          }
          S0 = S0n; S1 = S1n;
#pragma unroll
          for (int s = 0; s < 2; ++s) { k0[s] = nk0[s]; k1[s] = nk1[s]; vf[0][s] = nvf[0][s]; vf[1][s] = nvf[1][s]; }
        }
      }
      const float i0 = 1.0f / (L0[0] + __shfl_xor(L0[0], 32));
      const float i1 = lam / (L1[0] + __shfl_xor(L1[0], 32));
      float ss = 0.f;
#pragma unroll
      for (int i = 0; i < 16; ++i) {
        O00[i] = O00[i] * i0 - O10[i] * i1; O01[i] = O01[i] * i0 - O11[i] * i1;
        ss += O00[i] * O00[i] + O01[i] * O01[i];
      }
      ss += __shfl_xor(ss, 32);
      const float rn = rsqrtf(ss * (1.0f / 64.0f) + 1e-6f) * (1.0f - lambda_init);
#pragma unroll
      for (int g4 = 0; g4 < 4; ++g4) {
        const f32x4 ga = *(const f32x4*)(subg + 8 * g4 + 4 * fh);
        const f32x4 gb = *(const f32x4*)(subg + 32 + 8 * g4 + 4 * fh);
#pragma unroll
        for (int e = 0; e < 4; ++e) { O00[4 * g4 + e] *= ga[e]; O01[4 * g4 + e] *= gb[e]; }
      }
      const size_t tok = (size_t)bl * SEQ + qblk * 32 + fr;
      store_o(Y5 + (size_t)3 * TC * 256 + tok * 256 + head * 64, O00, O01, rn, fh);
    }
  }
  {
    const float mbA = gain_bound64(p.in[3] + layer * 128) * LOG2E;
    f32x16 sinit;
#pragma unroll
    for (int i = 0; i < 16; ++i) sinit[i] = -mbA;
    for (int it = vw; it < BC * 8 * 128; it += NW) {
      const int bl = it >> 10, hq = (it >> 7) & 7, qblk = it & 127;
      const int kvh = hq >> 2;
      const u16* Q = QK + (size_t)hq * GS + bl * BS;
      const u16* K = QK + (size_t)(8 + kvh) * GS + bl * BS;
      const u16* V = VB + (size_t)kvh * GS + bl * BS;
      bf16x8 qf[4]; load_kf4(qf, Q, qblk, lane);
      float l = (fh == 0) ? fexp2(p.in[4][layer * 8 + hq] * LOG2E - mbA) : 0.0f;
      f32x16 O0, O1; zero16(O0); zero16(O1);
      const int kb_lo = (qblk - 4 < 0) ? 0 : qblk - 4, kb_hi = (qblk + 4 > 127) ? 127 : qblk + 4;
      const int qpos = qblk * 32 + fr;
      bf16x8 kf[4], vf[2][2];
      load_kf4(kf, K, kb_lo, lane); load_vf(vf, V, kb_lo, lane);
      for (int kb = kb_lo; kb <= kb_hi; ++kb) {
        bf16x8 nkf[4], nvf[2][2];
        const int kn = (kb < kb_hi) ? kb + 1 : kb;
        load_kf4(nkf, K, kn, lane); load_vf(nvf, V, kn, lane);
        f32x16 S = sinit;
#pragma unroll
        for (int s = 0; s < 4; ++s) S = MFMA32(kf[s], qf[s], S);
        if (kb == qblk - 4 || kb == qblk + 4) {
#pragma unroll
          for (int i = 0; i < 16; ++i) {
            const int dlt = kb * 32 + crow(i, fh) - qpos;
            S[i] = (dlt <= 128 && dlt >= -128) ? S[i] : (-__builtin_inff());
          }
        }
        attn_plain_pv(S, l, O0, O1, vf);
#pragma unroll
        for (int s = 0; s < 4; ++s) kf[s] = nkf[s];
#pragma unroll
        for (int s = 0; s < 2; ++s) { vf[0][s] = nvf[0][s]; vf[1][s] = nvf[1][s]; }
      }
      const float inv = 1.0f / (l + __shfl_xor(l, 32));
      const size_t tok = (size_t)bl * SEQ + qpos;
      store_o(Y5 + (size_t)(hq >> 2) * TC * 256 + tok * 256 + (hq & 3) * 64, O0, O1, inv, fh);
    }
  }
  {
    const float gbD = gain_bound64(p.in[9] + layer * 128);
    for (int it = vw; it < BC * 4 * 128; it += NW) {
      const int bl = it >> 9, head = (it >> 7) & 3, qblk = it & 127;
      const u16* Q = QK + (size_t)(30 + head) * GS + bl * BS;
      const u16* K = QK + (size_t)(34 + head) * GS + bl * BS;
      const u16* V = VB + (size_t)(12 + head) * GS + bl * BS;
      const float* rpb = p.in[10] + (size_t)(layer * 4 + head) * 15 * 31;
      bf16x8 qf[4]; load_kf4(qf, Q, qblk, lane);
      float bmax = 0.f;
      for (int i = lane; i < 15 * 31; i += 64) bmax = fmaxf(bmax, fabsf(rpb[i]));
#pragma unroll
      for (int o = 32; o >= 1; o >>= 1) bmax = fmaxf(bmax, __shfl_xor(bmax, o));
      const float mbD = fminf(gbD + bmax, 60.0f) * LOG2E;
      f32x16 sinit;
#pragma unroll
      for (int i = 0; i < 16; ++i) sinit[i] = -mbD;
      float l = 0.f;
      f32x16 O0, O1; zero16(O0); zero16(O1);
      const int qrow = qblk >> 1, qc = (qblk & 1) * 32 + fr;
      int r0 = qrow - 4; r0 = r0 < 0 ? 0 : (r0 > 56 ? 56 : r0);
      int c0 = qc - 8; c0 = c0 < 0 ? 0 : (c0 > 48 ? 48 : c0);
      bf16x8 kf[4], vf[2][2];
      load_kf4(kf, K, r0 * 2, lane); load_vf(vf, V, r0 * 2, lane);
      for (int kk = 0; kk < 16; ++kk) {
        const int krow_ = r0 + (kk >> 1), hb = kk & 1;
        bf16x8 nkf[4], nvf[2][2];
        const int kn = r0 * 2 + ((kk < 15) ? kk + 1 : kk);
        load_kf4(nkf, K, kn, lane); load_vf(nvf, V, kn, lane);
        f32x16 S = sinit;
#pragma unroll
        for (int s = 0; s < 4; ++s) S = MFMA32(kf[s], qf[s], S);
        const float* brow = rpb + (krow_ - qrow + 7) * 31;
#pragma unroll
        for (int i = 0; i < 16; ++i) {
          const int kc = hb * 32 + crow(i, fh);
          int dc = kc - qc; dc = dc < -15 ? -15 : (dc > 15 ? 15 : dc);
          const float bias = brow[dc + 15];
          S[i] = (kc >= c0 && kc < c0 + 16) ? __builtin_fmaf(bias, LOG2E, S[i]) : (-__builtin_inff());
        }
        attn_plain_pv(S, l, O0, O1, vf);
#pragma unroll
        for (int s = 0; s < 4; ++s) kf[s] = nkf[s];
#pragma unroll
        for (int s = 0; s < 2; ++s) { vf[0][s] = nvf[0][s]; vf[1][s] = nvf[1][s]; }
      }
      const float inv = 1.0f / (l + __shfl_xor(l, 32));
      const size_t tok = (size_t)bl * SEQ + qblk * 32 + fr;
      store_o(Y5 + (size_t)4 * TC * 256 + tok * 256 + head * 64, O0, O1, inv, fh);
    }
  }
  {
    const float mbB = gain_bound64(p.in[5] + layer * 128) * LOG2E;
    f32x16 sinit;
#pragma unroll
    for (int i = 0; i < 16; ++i) sinit[i] = -mbB;
    for (int it = vw; it < BC * 6 * 128; it += NW) {
      const int bl = it / 768, rem = it % 768, head = rem >> 7, qblk = rem & 127;
      const int dil = dil_of(head >> 1), L = SEQ / dil, LB = L >> 5;
      const u16* Q = QK + (size_t)(10 + head) * GS + bl * BS;
      const u16* K = QK + (size_t)(16 + head) * GS + bl * BS;
      const u16* V = VB + (size_t)(2 + head) * GS + bl * BS;
      bf16x8 qf[4]; load_kf4(qf, Q, qblk, lane);
      float l = 0.f;
      f32x16 O0, O1; zero16(O0); zero16(O1);
      const int rsub = qblk / LB;
      const int lo = rsub * LB, hi = lo + LB - 1;
      const int kb_lo = (qblk - 2 < lo) ? lo : qblk - 2, kb_hi = (qblk + 2 > hi) ? hi : qblk + 2;
      const int qd = qblk * 32 + fr;
      bf16x8 kf[4], vf[2][2];
      load_kf4(kf, K, kb_lo, lane); load_vf(vf, V, kb_lo, lane);
      for (int kb = kb_lo; kb <= kb_hi; ++kb) {
        bf16x8 nkf[4], nvf[2][2];
        const int kn = (kb < kb_hi) ? kb + 1 : kb;
        load_kf4(nkf, K, kn, lane); load_vf(nvf, V, kn, lane);
        f32x16 S = sinit;
#pragma unroll
        for (int s = 0; s < 4; ++s) S = MFMA32(kf[s], qf[s], S);
        if (kb == qblk - 2 || kb == qblk + 2) {
#pragma unroll
          for (int i = 0; i < 16; ++i) {
            const int dlt = kb * 32 + crow(i, fh) - qd;
            S[i] = (dlt <= 64 && dlt >= -64) ? S[i] : (-__builtin_inff());
          }
        }
        attn_plain_pv(S, l, O0, O1, vf);
#pragma unroll
        for (int s = 0; s < 4; ++s) kf[s] = nkf[s];
#pragma unroll
        for (int s = 0; s < 2; ++s) { vf[0][s] = nvf[0][s]; vf[1][s] = nvf[1][s]; }
      }
      const float lt = l + __shfl_xor(l, 32);
      const float inv = 1.0f / lt;
      const int msub = qd - rsub * L;
      const int pos = msub * dil + rsub;
      const size_t tok = (size_t)bl * SEQ + pos;
      store_o(BO + tok * 384 + head * 64, O0, O1, inv, fh);
      if (fh == 0) LSE[tok * 8 + head] = __log2f(lt) + mbB;
    }
  }
}


__device__ void phase_bcombine(const Params& p, int tid_, int tok0) {
  const u16* BO = (const u16*)(p.ws + OFF_BO);
  const float* LSE = (const float*)(p.ws + OFF_LSE);
  u16* YB = (u16*)(p.ws + OFF_Y5) + (size_t)2 * TC * 256;
  for (int e = tid_; e < 256 * 16; e += NTHR) {
    const int tok = tok0 + (e >> 4), j = (e >> 3) & 1, c8 = (e & 7) * 8;
    const float a0 = LSE[(size_t)tok * 8 + j], a1 = LSE[(size_t)tok * 8 + 2 + j], a2 = LSE[(size_t)tok * 8 + 4 + j];
    const float mx = fmaxf(a0, fmaxf(a1, a2));
    float w0 = fexp2(a0 - mx), w1 = fexp2(a1 - mx), w2 = fexp2(a2 - mx);
    const float inv = 1.0f / (w0 + w1 + w2);
    w0 *= inv; w1 *= inv; w2 *= inv;
    const u32x4 x0 = *(const u32x4*)(BO + (size_t)tok * 384 + (0 + j) * 64 + c8);
    const u32x4 x1 = *(const u32x4*)(BO + (size_t)tok * 384 + (2 + j) * 64 + c8);
    const u32x4 x2 = *(const u32x4*)(BO + (size_t)tok * 384 + (4 + j) * 64 + c8);
    u32x4 o;
#pragma unroll
    for (int q = 0; q < 4; ++q) {
      const float lo = w0 * bf_lo(x0[q]) + w1 * bf_lo(x1[q]) + w2 * bf_lo(x2[q]);
      const float hi = w0 * bf_hi(x0[q]) + w1 * bf_hi(x1[q]) + w2 * bf_hi(x2[q]);
      o[q] = pk2(lo, hi);
    }
    *(u32x4*)(YB + (size_t)tok * 256 + j * 64 + c8) = o;
    const u32x4 z = {0u, 0u, 0u, 0u};
    *(u32x4*)(YB + (size_t)tok * 256 + 128 + (e & 15) * 8) = z;
  }
}

#define XB_TMO      128
#define XB_XCNT(j)  (256  + 64 * (j))
#define XB_XSUB(j)  (1280 + 64 * (j))
#define XB_XGEN(j)  (2304 + 64 * (j))
#define XB_TOP      3328
#define XB_TOPGEN   3392
#define XCD_BAR_WORDS 3456
#define XB_SPIN_CAP (1u << 22)
#define LAS __attribute__((address_space(3)))
DI unsigned xb_ld(unsigned* p)              { return __hip_atomic_load(p, __ATOMIC_RELAXED, __HIP_MEMORY_SCOPE_AGENT); }
DI unsigned xb_add(unsigned* p, unsigned v) { return __hip_atomic_fetch_add(p, v, __ATOMIC_RELAXED, __HIP_MEMORY_SCOPE_AGENT); }
DI unsigned xb_xcc_id() { return (unsigned)__builtin_amdgcn_s_getreg((3 << 11) | 20) & 0xFu; }
#define XB_SPIN(cond, bar) do { unsigned _sp = 0; while (cond) { __builtin_amdgcn_s_sleep(1); \
    if ((++_sp & 255u) == 0u) { if (xb_ld(&(bar)[XB_TMO])) break; if (_sp > XB_SPIN_CAP) { atomicAdd(&(bar)[XB_TMO], 1u); break; } } } } while (0)
struct XcdBarrier { unsigned* bar; unsigned x; volatile LAS unsigned* st; };
DI XcdBarrier xcd_barrier_post(unsigned* bar, volatile LAS unsigned* st) {
  XcdBarrier b; b.bar = bar; b.x = xb_xcc_id(); b.st = st;
  if (threadIdx.x == 0) (void)xb_add(&bar[XB_XCNT(b.x)], 1u);
  return b;
}
DI void xcd_barrier_complete(unsigned* bar, unsigned x, unsigned& nloc, unsigned& nx) {
  const unsigned G = gridDim.x * gridDim.y * gridDim.z;
  unsigned sum, cnt, mine, sp = 0u;
  for (;;) {
    sum = 0u; cnt = 0u; mine = 0u;
#pragma unroll
    for (unsigned j = 0; j < 16; ++j) { const unsigned c = xb_ld(&bar[XB_XCNT(j)]); sum += c; cnt += (c > 0u) ? 1u : 0u; mine = (j == x) ? c : mine; }
    if (sum == G) break;
    __builtin_amdgcn_s_sleep(1);
    if ((++sp & 255u) == 0u) { if (xb_ld(&bar[XB_TMO])) break; if (sp > XB_SPIN_CAP) { atomicAdd(&bar[XB_TMO], 1u); break; } }
  }
  nloc = mine > 0u ? mine : 1u; nx = cnt > 0u ? cnt : 1u;
}
DI void xcd_barrier(const XcdBarrier& b) {
  asm volatile("s_waitcnt vmcnt(0)" ::: "memory");
  __syncthreads();
  if (threadIdx.x == 0) {
    unsigned* bar = b.bar;
    __builtin_amdgcn_s_waitcnt(0);
    unsigned nloc = b.st[0], nx = b.st[1];
    if (nloc == 0u) { xcd_barrier_complete(bar, b.x, nloc, nx); b.st[0] = nloc; b.st[1] = nx; }
    const unsigned old = xb_add(&bar[XB_XSUB(b.x)], 1u);
    const unsigned gen = old / nloc;
    if (old + 1u == (gen + 1u) * nloc) {
      __builtin_amdgcn_fence(__ATOMIC_RELEASE, "agent");
      asm volatile("s_waitcnt vmcnt(0)" ::: "memory");
      const unsigned og = xb_add(&bar[XB_TOP], 1u);
      const unsigned tg = og / nx;
      if (og + 1u == (tg + 1u) * nx) xb_add(&bar[XB_TOPGEN], 1u);
      else XB_SPIN(xb_ld(&bar[XB_TOPGEN]) == tg, bar);
      __builtin_amdgcn_fence(__ATOMIC_ACQUIRE, "agent");
      xb_add(&bar[XB_XGEN(b.x)], 1u);
      asm volatile("s_waitcnt vmcnt(0)" ::: "memory");
    } else {
      XB_SPIN(xb_ld(&bar[XB_XGEN(b.x)]) == gen, bar);
      __builtin_amdgcn_fence(__ATOMIC_ACQUIRE, "agent");
      asm volatile("s_waitcnt vmcnt(0)" ::: "memory");
    }
  }
  __syncthreads();
}

__global__ void __launch_bounds__(NTHR, 2) mk_forward(Params p) {
  extern __shared__ __attribute__((aligned(16))) unsigned char smem[];
  cg::grid_group grid = cg::this_grid();
  volatile LAS unsigned* xbw = (volatile LAS unsigned*)(smem + LDS_XBW);
  if (threadIdx.x < 4) xbw[threadIdx.x] = 0u;
  __syncthreads();
  XcdBarrier xb;
  if (FUSED) xb = xcd_barrier_post((unsigned*)(p.ws + OFF_BAR), xbw);
#if PROBE_CLOCK
  const unsigned long long pc_t0 = clock64(), pc_r0 = wall_clock64();
#endif
  PG8_LAS unsigned char* lds = (PG8_LAS unsigned char*)smem;
  for (int ph = p.ph_lo; ph < p.ph_hi; ++ph) {
#if DUPMASK
   for (int rep = 0; rep < ((ph > 0 && ((DUPMASK >> ((ph - 1) % 7)) & 1)) ? 2 : 1); ++rep)
#endif
   {
    int tid_ = threadIdx.x, bid_ = blockIdx.x, nblk_ = gridDim.x;
    asm volatile("" : "+v"(tid_));
    asm volatile("" : "+s"(bid_));
    asm volatile("" : "+s"(nblk_));
    Params pp = p;
    asm volatile("" : "+s"(pp.ws));
    asm volatile("" : "+s"(pp.out));
    unsigned char* ws = pp.ws;
    if (ph == 0) {
      if (PHMASK & 128) phase_prep(pp, tid_, bid_, nblk_, smem);
    } else {
      const int q = ph - 1, chunk = q / (2 * PPL), layer = (q % (2 * PPL)) / PPL, kk = q % PPL, k = (kk == 6) ? DUPK : (kk < 2 ? kk : kk + 1);
      const u16* XBc = (const u16*)(ws + OFF_XB) + (size_t)chunk * TC * DM;
      float* SSQc = (float*)(ws + OFF_SSQ) + (size_t)chunk * TC * 16;
      float* xc = pp.out + (size_t)chunk * TC * DM;
      if ((k == 0 && (PHMASK & 1)) || (k == 5 && (PHMASK & 32))) {
        const bool up = (k == 5);
        if (!up) {
          EpiQKG e; e.ssq = SSQc; e.qk = (u16*)(ws + OFF_QK); e.rope = (const float*)(ws + OFF_ROPE);
          e.gA = pp.in[3] + layer * 128; e.gB = pp.in[5] + layer * 128; e.gC = pp.in[6] + layer * 64; e.gD = pp.in[9] + layer * 128;
          run_gemm(lds, XBc, (const u16*)(ws + OFF_WQKG) + (size_t)layer * NQKG * DM, TC, 2560, DM, e);
        }
        {
          EpiGateUp e; e.ssq = SSQc; e.o = (u16*)(ws + OFF_GATE); e.mode = up ? ((PROBE_NOEPI && kk == 6) ? 2 : 1) : 0;
          const u16* W = up ? (const u16*)(ws + OFF_WUP) + (size_t)layer * DMLP * DM : (const u16*)(ws + OFF_WQKG) + ((size_t)layer * NQKG + 2560) * DM;
          run_gemm(lds, XBc, W, TC, 4096, DM, e, (PROBE_NOEPI && kk == 6) ? 1 : 0);
        }
        if (!up) {
          EpiVT ev; ev.ssq = SSQc; ev.vbuf = (u16*)(ws + OFF_V);
          run_gemm(lds, (const u16*)(ws + OFF_WV) + (size_t)layer * DM * DM, XBc, DM, TC, DM, ev);
        }
      } else if (k == 1 && (PHMASK & 2)) {
        phase_attn(pp, tid_, bid_, nblk_, layer);
      } else if (k == 3 && (PHMASK & 8)) {
        {
          Unit u0; pg8::StaticOrder S0; S0.init(TC, DM, nblk_, bid_); S0.next(0, u0);
          phase_bcombine(pp, tid_, u0.pm * 256);
          asm volatile("s_waitcnt vmcnt(0)" ::: "memory");
          __syncthreads();
        }
        EpiMerge e; e.gate = (const u16*)(ws + OFF_GATE); e.mrg = (u16*)(ws + OFF_MRG);
        run_merge(lds, (const u16*)(ws + OFF_Y5), (const u16*)(ws + OFF_WBR5) + (size_t)layer * 5 * DM * 256, e);
      } else if ((k == 4 && (PHMASK & 16)) || (k == 6 && (PHMASK & 64))) {
        const bool dn = (k == 6);
        EpiResid e; e.xold = (!dn && layer == 0) ? (pp.in[0] + (size_t)chunk * TC * DM) : xc; e.xout = xc; e.xb = (u16*)XBc; e.ssq = SSQc;
        const u16* A = dn ? (const u16*)(ws + OFF_GATE) : (const u16*)(ws + OFF_MRG);
        const u16* W = dn ? (const u16*)(ws + OFF_WDN) + (size_t)layer * DM * DMLP : (const u16*)(ws + OFF_WOUT) + (size_t)layer * DM * DM;
        run_gemm(lds, A, W, TC, DM, dn ? DMLP : DM, e);
      }
    }
   }
    if (ph + 1 < p.ph_hi) {
      if (p.ph_lo < 0) grid.sync();
      xcd_barrier(xb);
    }
  }
#if PROBE_CLOCK
  {
    xcd_barrier(xb);
    const unsigned long long pc_t1 = clock64(), pc_r1 = wall_clock64();
    const float ghz = (float)(pc_t1 - pc_t0) / ((float)(pc_r1 - pc_r0) * 10.0f);
    const int nrows = (int)(ghz * 0.25f * (float)T);
    for (int r = blockIdx.x; r < nrows; r += gridDim.x)
      for (int c = threadIdx.x; c < DM; c += NTHR) p.out[(size_t)r * DM + c] = 0.f;
  }
#endif
}

extern "C" void kernel_launch(void* const* d_in, const int* in_sizes, int n_in, void* d_out, int out_size, void* d_ws, size_t ws_size,
                              hipStream_t stream) {
  static int grid_blocks = 0;
  if (grid_blocks == 0) {
    if (n_in != 19 || out_size != T * DM || ws_size < WS_END) {
      fprintf(stderr, "kernel_launch: unexpected problem (n_in %d out %d ws %zu need %zu)\n", n_in, out_size, ws_size, (size_t)WS_END);
      grid_blocks = -1;
      return;
    }
    int dev = 0, cus = 0, per_cu = 0;
    (void)hipGetDevice(&dev);
    (void)hipDeviceGetAttribute(&cus, hipDeviceAttributeMultiprocessorCount, dev);
    if (hipFuncSetAttribute((const void*)mk_forward, hipFuncAttributeMaxDynamicSharedMemorySize, LDS_BYTES) != hipSuccess) {
      fprintf(stderr, "kernel_launch: hipFuncSetAttribute failed\n"); grid_blocks = -1; return;
    }
    (void)hipOccupancyMaxActiveBlocksPerMultiprocessor(&per_cu, mk_forward, NTHR, LDS_BYTES);
    if (per_cu < 1) fprintf(stderr, "kernel_launch: occupancy query says %d blocks per CU\n", per_cu);
    (void)hipGetLastError();
    grid_blocks = cus;
  }
  if (grid_blocks < 0) return;
  Params p{};
  for (int i = 0; i < 19; ++i) p.in[i] = (const float*)d_in[i];
  p.out = (float*)d_out;
  p.ws = (unsigned char*)d_ws;
#if FUSED
  (void)hipMemsetAsync((unsigned char*)d_ws + OFF_BAR, 0, XCD_BAR_WORDS * 4, stream);
  p.ph_lo = 0; p.ph_hi = NPHASE;
  void* args[] = {&p};
  hipError_t e = hipLaunchCooperativeKernel((const void*)mk_forward, dim3(grid_blocks), dim3(NTHR), args, LDS_BYTES, stream);
  if (e != hipSuccess) fprintf(stderr, "cooperative launch failed: %s (grid %d)\n", hipGetErrorString(e), grid_blocks);
#else
  for (int ph = 0; ph < NPHASE; ++ph) {
    p.ph_lo = ph; p.ph_hi = ph + 1;
    hipLaunchKernelGGL(mk_forward, dim3(grid_blocks), dim3(NTHR), LDS_BYTES, stream, p);
  }
#endif
}
```

```cpp
#include <hip/hip_runtime.h>
#include <hip/hip_cooperative_groups.h>
#include <cstdio>
namespace cg = cooperative_groups;

#ifndef PHMASK
#define PHMASK 255
#endif
#ifndef DUPMASK
#define DUPMASK 0
#endif
#ifndef DUPK
#define DUPK -1
#endif
#ifndef PROBE_CLOCK
#define PROBE_CLOCK 0
#endif
#ifndef PROBE_NOEPI
#define PROBE_NOEPI 0
#endif
#ifndef FUSED
#define FUSED 1
#endif

namespace pg8 {
#define PG8_LAS __attribute__((address_space(3)))
typedef unsigned short bf16_t;
typedef short bf16x8 __attribute__((ext_vector_type(8)));
typedef float f32x4 __attribute__((ext_vector_type(4)));
typedef unsigned u32x4 __attribute__((ext_vector_type(4)));
constexpr int BM = 256, BK = 64, HALF = 128, HTB = HALF * BK * 2  , STAGE_BYTES = 8 * HTB, NXCD = 8, WGM = 8;

__host__ __device__ __forceinline__ int lds_byte(int r, int c) { const int st = (r >> 4) * 2 + (c >> 5), rr = r & 15, cc = c & 31, ob = rr * 64 + cc * 2; return st * 1024 + (ob ^ (((ob >> 9) & 1) << 5)); }
__host__ __device__ __forceinline__ void stage_rc(int b, int& R, int& C) { const int st = b / 1024, sb = b % 1024, swz = sb ^ (((sb >> 9) & 1) << 5); R = (st >> 1) * 16 + swz / 64; C = (st & 1) * 32 + (swz % 64) / 2; }
__host__ __device__ __forceinline__ int perm32(int rho) { const int n = rho >> 4, i = rho & 15; return 8 * (i >> 2) + 4 * n + (i & 3); }

struct Unit { int pm, pn, seg; };
struct Gemm { const bf16_t* A; const bf16_t* Bt; int M, N, K; };

struct StaticOrder {
    int nM, nN, nwg, G, c, probe = 0;
    __host__ __device__ void init(int M, int N, int G_, int c_) { nM = M / BM; nN = N / BM; nwg = nM * nN; G = G_; c = c_; }
    __host__ __device__ bool next(int i, Unit& u) const {
        const long L = (long)i * G + c; if (L >= nwg) return false;
        int wgid = (int)L; { const int q = nwg / NXCD, r = nwg % NXCD, xcd = wgid % NXCD, off = wgid / NXCD; wgid = (xcd < r ? xcd * (q + 1) : r * (q + 1) + (xcd - r) * q) + off; }
        const int nig = WGM * nN, gid = wgid / nig, fm = gid * WGM, gsz = (nM - fm) < WGM ? (nM - fm) : WGM;
        u.pm = fm + ((wgid % nig) % gsz); u.pn = (wgid % nig) / gsz; u.seg = 0; if (probe) { u.pm = 0; u.pn = 0; } return true;
    }
    __device__ __forceinline__ void a_ready(const Unit&) const {}
    __device__ __forceinline__ void done(const Unit&) const {}
    __device__ __forceinline__ const char* baseA(const Gemm& g, const Unit& u, size_t tstep) const { return (const char*)g.A + (size_t)u.pm * tstep; }
    __device__ __forceinline__ const char* baseB(const Gemm& g, const Unit& u, size_t tstep) const { return (const char*)g.Bt + (size_t)u.pn * tstep; }
    __device__ __forceinline__ bool zero_after(const Unit&) const { return true; }
};

template <class Epi, class Sched, bool STAMP = false>
__device__ __forceinline__ void gemm_phase(PG8_LAS unsigned char* lds, const Gemm g, const Sched& S, const Epi& E, unsigned long long* stamps) {
    int tid = threadIdx.x; asm volatile("" : "+v"(tid));
    const int wid = __builtin_amdgcn_readfirstlane(tid >> 6), lane = tid & 63, wr = wid >> 2, wc = wid & 3, fr = lane & 15, fq = lane >> 4;
    const int K = g.K, nt = K / BK;
    int ts_lo = 0, ts_hi = 0, nts = 0; const unsigned long long rt_entry = STAMP ? (unsigned long long)wall_clock64() : 0ull;
#define PG8_STAMP() do { if (STAMP && wid == 0 && nts < 64) { const unsigned long long _c = (unsigned long long)clock64(); \
        ts_lo = (lane == nts) ? (int)(unsigned)_c : ts_lo; ts_hi = (lane == nts) ? (int)(unsigned)(_c >> 32) : ts_hi; ++nts; } } while (0)
    PG8_STAMP();
    unsigned voffA[2], voffB[2];
#pragma unroll
    for (int i = 0; i < 2; ++i) { int R, C; stage_rc(tid * 16 + i * 8192, R, C); const int Rb = Epi::PERM ? ((R & ~31) + perm32(R & 31)) : R;
        voffA[i] = (unsigned)(R * K + C) * 2u; voffB[i] = (unsigned)(Rb * K + C) * 2u; }
    const size_t kstep = (size_t)(BK * 2);
    const size_t hstep = (size_t)HALF * K * 2;
    const size_t tstep = 2 * hstep;
    const unsigned ldsw = (unsigned)wid * 1024u;
    const int aoff = lds_byte(wr * 64 + fr, fq * 8), boff = lds_byte(wc * 32 + fr, fq * 8);
#define PG8_SA(b, h) (((b) * 2 + (h)) * HTB)
#define PG8_SB(b, h) ((4 + (b) * 2 + (h)) * HTB)
#define PG8_STAGE(bufoff, gbase, voff) do { _Pragma("unroll") for (int _i = 0; _i < 2; ++_i) \
        __builtin_amdgcn_global_load_lds((const unsigned*)((const char*)(gbase) + (voff)[_i]), (PG8_LAS unsigned*)(lds + (bufoff) + ldsw + _i * 8192), 16, 0, 0); } while (0)
#define PG8_LDA(dst, b, h) do { _Pragma("unroll") for (int m = 0; m < 4; ++m) _Pragma("unroll") for (int k = 0; k < 2; ++k) dst[m][k] = *(const PG8_LAS bf16x8*)(lds + PG8_SA(b, h) + aoff + m * 2048 + k * 1024); } while (0)
#define PG8_LDB(dst, b, h) do { _Pragma("unroll") for (int n = 0; n < 2; ++n) _Pragma("unroll") for (int k = 0; k < 2; ++k) dst[n][k] = *(const PG8_LAS bf16x8*)(lds + PG8_SB(b, h) + boff + n * 2048 + k * 1024); } while (0)
#define PG8_MMA(ai, bj, At, Bt) do { __builtin_amdgcn_s_setprio(1); _Pragma("unroll") for (int m = 0; m < 4; ++m) _Pragma("unroll") for (int n = 0; n < 2; ++n) _Pragma("unroll") for (int k = 0; k < 2; ++k) \
        acc[ai][bj][m][n] = __builtin_amdgcn_mfma_f32_16x16x32_bf16(Bt[n][k], At[m][k], acc[ai][bj][m][n], 0, 0, 0); __builtin_amdgcn_s_setprio(0); } while (0)
#define PG8_WAIT_V(n) asm volatile("s_waitcnt vmcnt(" #n ")" ::: "memory")
#define PG8_WAIT_L(n) asm volatile("s_waitcnt lgkmcnt(" #n ")" ::: "memory")
#define PG8_BAR __builtin_amdgcn_s_barrier()
#define PG8_SCHED __builtin_amdgcn_sched_barrier(0)
    Unit cur, nxt; int ui = 0;
    if (!S.next(0, cur)) return;
    f32x4 acc[2][2][4][2];
#pragma unroll
    for (int a = 0; a < 2; ++a)
#pragma unroll
        for (int b = 0; b < 2; ++b)
#pragma unroll
            for (int m = 0; m < 4; ++m)
#pragma unroll
                for (int n = 0; n < 2; ++n) acc[a][b][m][n] = (f32x4){0.f, 0.f, 0.f, 0.f};
    bf16x8 At[4][2], B0[2][2], B1[2][2];
    const char* cA = S.baseA(g, cur, tstep); const char* cB = S.baseB(g, cur, tstep);
    S.a_ready(cur);
    PG8_STAGE(PG8_SB(0, 0), cB, voffB); PG8_STAGE(PG8_SA(0, 0), cA, voffA); PG8_STAGE(PG8_SB(0, 1), cB + hstep, voffB); PG8_STAGE(PG8_SA(0, 1), cA + hstep, voffA);
    if (wr == 1) PG8_BAR;
    PG8_WAIT_V(4); PG8_BAR;
    PG8_STAGE(PG8_SB(1, 0), cB + kstep, voffB); PG8_STAGE(PG8_SA(1, 0), cA + kstep, voffA); PG8_STAGE(PG8_SB(1, 1), cB + hstep + kstep, voffB);
    PG8_WAIT_V(6); PG8_BAR;
    PG8_STAMP();
    for (;;) {
        const bool has_next = S.next(ui + 1, nxt);
        const char* nA = has_next ? S.baseA(g, nxt, tstep) : cA; const char* nB = has_next ? S.baseB(g, nxt, tstep) : cB;
        for (int t = 0; t < nt; t += 2) {
            const bool last = (t == nt - 2);
            const char* a1 = cA + (size_t)(t + 1) * kstep;
            const char* a2 = last ? nA : cA + (size_t)(t + 2) * kstep; const char* b2 = last ? nB : cB + (size_t)(t + 2) * kstep;
            const char* a3 = a2 + kstep; const char* b3 = b2 + kstep;
            if (last && has_next) S.a_ready(nxt);
            PG8_LDB(B0, 0, 0); PG8_SCHED; PG8_LDA(At, 0, 0); PG8_STAGE(PG8_SA(1, 1), a1 + hstep, voffA);
            PG8_WAIT_L(8); PG8_BAR; PG8_WAIT_L(0); PG8_MMA(0, 0, At, B0); PG8_BAR; PG8_SCHED;
            PG8_LDB(B1, 0, 1); PG8_STAGE(PG8_SB(0, 0), b2, voffB);
            PG8_BAR; PG8_WAIT_L(0); PG8_MMA(0, 1, At, B1); PG8_BAR;
            PG8_LDA(At, 0, 1); PG8_STAGE(PG8_SA(0, 0), a2, voffA);
            PG8_BAR; PG8_WAIT_L(0); PG8_MMA(1, 0, At, B0); PG8_BAR; PG8_SCHED;
            PG8_STAGE(PG8_SB(0, 1), b2 + hstep, voffB);
            PG8_WAIT_V(6); PG8_BAR; PG8_MMA(1, 1, At, B1); PG8_BAR;
            PG8_LDB(B0, 1, 0); PG8_SCHED; PG8_LDA(At, 1, 0); PG8_STAGE(PG8_SA(0, 1), a2 + hstep, voffA);
            PG8_WAIT_L(8); PG8_BAR; PG8_WAIT_L(0); PG8_MMA(0, 0, At, B0); PG8_BAR; PG8_SCHED;
            PG8_LDB(B1, 1, 1); PG8_STAGE(PG8_SB(1, 0), b3, voffB);
            PG8_BAR; PG8_WAIT_L(0); PG8_MMA(0, 1, At, B1); PG8_BAR;
            PG8_LDA(At, 1, 1); PG8_STAGE(PG8_SA(1, 0), a3, voffA);
            PG8_BAR; PG8_WAIT_L(0); PG8_MMA(1, 0, At, B0); PG8_BAR; PG8_SCHED;
            PG8_STAGE(PG8_SB(1, 1), b3 + hstep, voffB);
            PG8_WAIT_V(6); PG8_BAR; PG8_MMA(1, 1, At, B1); PG8_BAR;
        }
        PG8_STAMP();
        if constexpr (!Epi::AFTER_DRAIN) { E(acc, cur, wr, wc, fr, fq); S.done(cur); }
        PG8_STAMP();
        if (!has_next) break;
        if (S.zero_after(cur))
#pragma unroll
        for (int a = 0; a < 2; ++a)
#pragma unroll
            for (int b = 0; b < 2; ++b)
#pragma unroll
                for (int m = 0; m < 4; ++m)
#pragma unroll
                    for (int n = 0; n < 2; ++n) acc[a][b][m][n] = (f32x4){0.f, 0.f, 0.f, 0.f};
        cur = nxt; cA = nA; cB = nB; ++ui;
    }
    PG8_WAIT_V(0);
    if (wr == 0) PG8_BAR;
    PG8_BAR;
    if constexpr (Epi::AFTER_DRAIN) { E.fused(acc, cur, wr, wc, fr, fq, lds, wid, lane); S.done(cur); }
    PG8_STAMP();
    if (STAMP && wid == 0) { stamps[lane] = lane < nts ? (((unsigned long long)(unsigned)ts_hi << 32) | (unsigned)ts_lo) : 0ull;
        if (lane == 62) stamps[62] = rt_entry; if (lane == 63) stamps[63] = (unsigned long long)wall_clock64(); }
#undef PG8_STAMP
#undef PG8_SA
#undef PG8_SB
#undef PG8_STAGE
#undef PG8_LDA
#undef PG8_LDB
#undef PG8_MMA
#undef PG8_WAIT_V
#undef PG8_WAIT_L
#undef PG8_BAR
#undef PG8_SCHED
}
}

typedef unsigned short u16;
typedef short bf16x8 __attribute__((ext_vector_type(8)));
typedef float f32x16 __attribute__((ext_vector_type(16)));
typedef float f32x4 __attribute__((ext_vector_type(4)));
typedef __bf16 bf2_t __attribute__((ext_vector_type(2)));
typedef float f2_t __attribute__((ext_vector_type(2)));
typedef unsigned u32x4 __attribute__((ext_vector_type(4)));
typedef unsigned u32x2 __attribute__((ext_vector_type(2)));
using pg8::Unit;

#define DI __device__ __forceinline__
#define MFMA32(a, b, c) __builtin_amdgcn_mfma_f32_32x32x16_bf16((a), (b), (c), 0, 0, 0)

constexpr int DM = 1024, SEQ = 4096, NBATCH = 8, T = NBATCH * SEQ;
constexpr int NCH = 2, BC = NBATCH / NCH, TC = BC * SEQ;
constexpr int INC = 7552, DMLP = 4096;
constexpr int NQKG = 6656;
constexpr int NQKH = 38, NVH = 16;
constexpr float LOG2E = 1.4426950408889634f;
constexpr int NTHR = 512;

constexpr size_t al256(size_t x) { return (x + 255) & ~(size_t)255; }
constexpr size_t OFF_WQKG = 0;
constexpr size_t OFF_WV   = OFF_WQKG + al256((size_t)2 * NQKG * DM * 2);
constexpr size_t OFF_WBR5 = OFF_WV   + al256((size_t)2 * DM * DM * 2);
constexpr size_t OFF_WOUT = OFF_WBR5 + al256((size_t)2 * 5 * DM * 256 * 2);
constexpr size_t OFF_WUP  = OFF_WOUT + al256((size_t)2 * DM * DM * 2);
constexpr size_t OFF_WDN  = OFF_WUP  + al256((size_t)2 * DMLP * DM * 2);
constexpr size_t OFF_ROPE = OFF_WDN  + al256((size_t)2 * DM * DMLP * 2);
constexpr size_t OFF_XB   = OFF_ROPE + al256((size_t)SEQ * 96 * 4);
constexpr size_t OFF_SSQ  = OFF_XB   + al256((size_t)T * DM * 2);
constexpr size_t OFF_QK   = OFF_SSQ  + al256((size_t)T * 16 * 4);
constexpr size_t OFF_V    = OFF_QK   + al256((size_t)NQKH * TC * 64 * 2);
constexpr size_t OFF_GATE = OFF_V    + al256((size_t)NVH * TC * 64 * 2);
constexpr size_t OFF_Y5   = OFF_GATE + al256((size_t)TC * 4096 * 2);
constexpr size_t OFF_BO   = OFF_Y5   + al256((size_t)5 * TC * 256 * 2);
constexpr size_t OFF_LSE  = OFF_BO   + al256((size_t)TC * 384 * 2);
constexpr size_t OFF_MRG  = OFF_LSE  + al256((size_t)TC * 8 * 4);
constexpr size_t OFF_BAR  = OFF_MRG  + al256((size_t)TC * DM * 2);
constexpr size_t WS_END   = OFF_BAR  + 16384;
static_assert(WS_END <= (size_t)512 * 1024 * 1024, "workspace too large");

constexpr int LDS_STAGE = 131072;
constexpr int VT_STRIDE = 528;
constexpr int LDS_XBW = 256 * VT_STRIDE;
constexpr int LDS_BYTES = LDS_XBW + 64 + 1024;
constexpr int PPL = (DUPK >= 0) ? 7 : 6;
constexpr int NPHASE = 1 + NCH * 2 * PPL;

struct Params {
  const float* in[19];
  float* out;
  unsigned char* ws;
  int ph_lo, ph_hi;
};

DI unsigned pk2(float a, float b) { f2_t v = {a, b}; bf2_t r = __builtin_convertvector(v, bf2_t); return __builtin_bit_cast(unsigned, r); }
DI float bf_lo(unsigned u) { return __uint_as_float(u << 16); }
DI float bf_hi(unsigned u) { return __uint_as_float(u & 0xffff0000u); }
DI float fexp2(float x) { return __builtin_amdgcn_exp2f(x); }
DI int crow(int i, int h) { return (i & 3) + 8 * (i >> 2) + 4 * h; }
DI bf16x8 as_bf8(u32x4 v) { return __builtin_bit_cast(bf16x8, v); }
DI int dil_of(int gi) { return gi == 0 ? 1 : (gi == 1 ? 4 : 16); }
DI int dlg_of(int gi) { return gi * 2; }
DI float row_rscale(const float* ssq, size_t tok) {
  const f32x4 a = *(const f32x4*)(ssq + tok * 16), b = *(const f32x4*)(ssq + tok * 16 + 4);
  const f32x4 c = *(const f32x4*)(ssq + tok * 16 + 8), d = *(const f32x4*)(ssq + tok * 16 + 12);
  const float s = ((a[0] + a[1]) + (a[2] + a[3])) + ((b[0] + b[1]) + (b[2] + b[3])) + ((c[0] + c[1]) + (c[2] + c[3])) + ((d[0] + d[1]) + (d[2] + d[3]));
  return rsqrtf(s * (1.0f / 1024.0f) + 1e-6f);
}
DI int qk_head_col(int h) {
  if (h < 8) return 64 * h;
  if (h < 10) return 512 + 64 * (h - 8);
  if (h < 16) return 768 + 64 * (h - 10);
  if (h < 22) return 1152 + 64 * (h - 16);
  if (h < 26) return 1920 + 64 * (h - 22);
  if (h < 30) return 2176 + 64 * (h - 26);
  if (h < 34) return 2688 + 64 * (h - 30);
  return 2944 + 64 * (h - 34);
}
DI int v_head_col(int vh) {
  if (vh < 2) return 640 + 64 * vh;
  if (vh < 8) return 1536 + 64 * (vh - 2);
  if (vh < 12) return 2432 + 64 * (vh - 8);
  return 3200 + 64 * (vh - 12);
}

struct EpiQKG {
  static constexpr bool PERM = false, AFTER_DRAIN = false;
  const float* ssq; u16* qk; const float* rope; const float* gA; const float* gB; const float* gC; const float* gD;
  DI void operator()(const f32x4 (&acc)[2][2][4][2], const Unit& u, int wr, int wc, int fr, int fq) const {
    const int hidx = u.pn * 4 + wc;
    if (hidx >= NQKH) return;
    int kind, dlg = 0; const float* gain;
    if (hidx < 8) { kind = 0; gain = gA; }
    else if (hidx < 10) { kind = 0; gain = gA + 64; }
    else if (hidx < 16) { kind = 0; gain = gB; dlg = dlg_of((hidx - 10) >> 1); }
    else if (hidx < 22) { kind = 0; gain = gB + 64; dlg = dlg_of((hidx - 16) >> 1); }
    else if (hidx < 26) { kind = 2; gain = gC; }
    else if (hidx < 30) { kind = 2; gain = gC + 32; }
    else if (hidx < 34) { kind = 1; gain = gD; }
    else { kind = 1; gain = gD + 64; }
    u16* gbase = qk + (size_t)hidx * TC * 64;
    const float* gainl = gain + 4 * fq;
    const float qpre = (hidx >= 22 && hidx < 26) ? (0.17677669529663687f * LOG2E)
                     : ((hidx < 8 || (hidx >= 10 && hidx < 16) || (hidx >= 30 && hidx < 34)) ? (0.125f * LOG2E) : 1.0f);
#pragma unroll
    for (int ai = 0; ai < 2; ++ai)
#pragma unroll
      for (int m = 0; m < 4; ++m) {
        const int tok = u.pm * 256 + 128 * ai + 64 * wr + 16 * m + fr;
        const int bl = tok >> 12, pos = tok & 4095;
        const float rs = row_rscale(ssq, tok);
        const int pdom = ((pos & ((1 << dlg) - 1)) << (12 - dlg)) + (pos >> dlg);
        const int blk = pdom >> 5, rr = pdom & 31;
        u16* base = gbase + (size_t)bl * SEQ * 64;
        if (kind != 2) {
          float ss = 0.f;
#pragma unroll
          for (int bj = 0; bj < 2; ++bj)
#pragma unroll
            for (int n = 0; n < 2; ++n)
#pragma unroll
              for (int e = 0; e < 4; ++e) ss += acc[ai][bj][m][n][e] * acc[ai][bj][m][n][e];
          ss += __shfl_xor(ss, 16); ss += __shfl_xor(ss, 32);
          const float sc = rs * rsqrtf(ss * rs * rs * (1.0f / 64.0f) + 1e-6f) * qpre;
#pragma unroll
          for (int n = 0; n < 2; ++n) {
            f32x4 xa = acc[ai][0][m][n] * sc * *(const f32x4*)(gainl + 16 * n);
            f32x4 xb2 = acc[ai][1][m][n] * sc * *(const f32x4*)(gainl + 32 + 16 * n);
            if (kind == 0) {
              const f32x4 c4 = *(const f32x4*)(rope + pos * 96 + 16 * n + 4 * fq);
              const f32x4 s4 = *(const f32x4*)(rope + pos * 96 + 32 + 16 * n + 4 * fq);
              const f32x4 ta = xa * c4 - xb2 * s4, tb = xb2 * c4 + xa * s4;
              xa = ta; xb2 = tb;
            }
            u32x2 w0 = {pk2(xa[0], xa[1]), pk2(xa[2], xa[3])};
            *(u32x2*)(base + ((size_t)(blk * 4 + n) * 64 + (fq >> 1) * 32 + rr) * 8 + 4 * (fq & 1)) = w0;
            u32x2 w1 = {pk2(xb2[0], xb2[1]), pk2(xb2[2], xb2[3])};
            *(u32x2*)(base + ((size_t)(blk * 4 + 2 + n) * 64 + (fq >> 1) * 32 + rr) * 8 + 4 * (fq & 1)) = w1;
          }
        } else {
          const f32x4 c4 = *(const f32x4*)(rope + pos * 96 + 64 + 4 * fq);
          const f32x4 s4 = *(const f32x4*)(rope + pos * 96 + 80 + 4 * fq);
#pragma unroll
          for (int bj = 0; bj < 2; ++bj) {
            float ss = 0.f;
#pragma unroll
            for (int n = 0; n < 2; ++n)
#pragma unroll
              for (int e = 0; e < 4; ++e) ss += acc[ai][bj][m][n][e] * acc[ai][bj][m][n][e];
            ss += __shfl_xor(ss, 16); ss += __shfl_xor(ss, 32);
            const float sc = rs * rsqrtf(ss * rs * rs * (1.0f / 32.0f) + 1e-6f) * qpre;
            const f32x4 xa = acc[ai][bj][m][0] * sc * *(const f32x4*)(gainl);
            const f32x4 xb2 = acc[ai][bj][m][1] * sc * *(const f32x4*)(gainl + 16);
            const f32x4 ta = xa * c4 - xb2 * s4, tb = xb2 * c4 + xa * s4;
            u16* sb = base + (size_t)bj * SEQ * 32;
            u32x2 w0 = {pk2(ta[0], ta[1]), pk2(ta[2], ta[3])};
            *(u32x2*)(sb + ((size_t)(blk * 2 + 0) * 64 + (fq >> 1) * 32 + rr) * 8 + 4 * (fq & 1)) = w0;
            u32x2 w1 = {pk2(tb[0], tb[1]), pk2(tb[2], tb[3])};
            *(u32x2*)(sb + ((size_t)(blk * 2 + 1) * 64 + (fq >> 1) * 32 + rr) * 8 + 4 * (fq & 1)) = w1;
          }
        }
        asm volatile("" ::: "memory");
      }
  }
};

struct EpiGateUp {
  static constexpr bool PERM = true, AFTER_DRAIN = false;
  const float* ssq; u16* o; int mode;
  template <bool UP>
  DI void body(const f32x4 (&acc)[2][2][4][2], const Unit& u, int wr, int wc, int fr, int fq) const {
    const int c0 = u.pn * 256 + 32 * wc + 8 * fq;
    float rsv[8];
#pragma unroll
    for (int i = 0; i < 8; ++i) rsv[i] = row_rscale(ssq, (size_t)u.pm * 256 + 128 * (i >> 2) + 64 * wr + 16 * (i & 3) + fr);
#pragma unroll
    for (int ai = 0; ai < 2; ++ai)
#pragma unroll
      for (int m = 0; m < 4; ++m) {
        const size_t tok = (size_t)u.pm * 256 + 128 * ai + 64 * wr + 16 * m + fr;
        const float rs = rsv[ai * 4 + m];
#pragma unroll
        for (int bj = 0; bj < 2; ++bj) {
          float r[8];
#pragma unroll
          for (int n = 0; n < 2; ++n) {
            const f32x4 v = acc[ai][bj][m][n] * rs;
#pragma unroll
            for (int e = 0; e < 4; ++e) {
              if (UP) { const float z = fmaxf(v[e], 0.f); r[4 * n + e] = z * z; }
              else r[4 * n + e] = __builtin_amdgcn_rcpf(1.0f + fexp2(-LOG2E * v[e]));
            }
          }
          u32x4 w = {pk2(r[0], r[1]), pk2(r[2], r[3]), pk2(r[4], r[5]), pk2(r[6], r[7])};
          *(u32x4*)(o + tok * 4096 + c0 + 128 * bj) = w;
        }
        asm volatile("" ::: "memory");
      }
  }
  DI void operator()(const f32x4 (&acc)[2][2][4][2], const Unit& u, int wr, int wc, int fr, int fq) const {
    if (mode == 2) return;
    if (mode == 1) body<true>(acc, u, wr, wc, fr, fq);
    else body<false>(acc, u, wr, wc, fr, fq);
  }
};

struct EpiVT {
  static constexpr bool PERM = false, AFTER_DRAIN = true;
  const float* ssq; u16* vbuf;
  DI void operator()(const f32x4 (&)[2][2][4][2], const Unit&, int, int, int, int) const {}
  DI void fused(const f32x4 (&acc)[2][2][4][2], const Unit& u, int wr, int wc, int fr, int fq, PG8_LAS unsigned char* lds, int wid, int lane) const {
    PG8_LAS float* rsl = (PG8_LAS float*)(lds + 256 * VT_STRIDE + 64);
    {
      const int t = wid * 64 + lane;
      if (t < 256) rsl[t] = row_rscale(ssq, (size_t)u.pn * 256 + t);
    }
    __syncthreads();
#pragma unroll
    for (int ai = 0; ai < 2; ++ai)
#pragma unroll
      for (int m = 0; m < 4; ++m) {
        const int r = 128 * ai + 64 * wr + 16 * m + fr;
#pragma unroll
        for (int bj = 0; bj < 2; ++bj)
#pragma unroll
          for (int n = 0; n < 2; ++n) {
            const f32x4 v = acc[ai][bj][m][n] * *(const PG8_LAS f32x4*)(rsl + 128 * bj + 32 * wc + 16 * n + 4 * fq);
            u32x2 w = {pk2(v[0], v[1]), pk2(v[2], v[3])};
            *(PG8_LAS u32x2*)(lds + r * VT_STRIDE + (128 * bj + 32 * wc + 16 * n + 4 * fq) * 2) = w;
          }
      }
    __syncthreads();
    const int tid = wid * 64 + lane;
    const int bl = (u.pn * 256) >> 12, pos0 = (u.pn * 256) & 4095;
#pragma unroll 1
    for (int it = 0; it < 16; ++it) {
      const int uidx = it * 512 + tid;
      const int dvlo = uidx & 31, hh = (uidx >> 5) & 1, rb = (uidx >> 6) & 1, half = (uidx >> 7) & 15, h = uidx >> 11;
      const int vgrp = u.pm * 4 + h;
      const int dlg = (vgrp >= 2 && vgrp < 8) ? dlg_of((vgrp - 2) >> 1) : 0;
      const int cls = half >> (4 - dlg), hc = half & ((16 >> dlg) - 1);
      const int m0 = pos0 >> dlg, mh = m0 + 16 * hc;
      const int s = (mh >> 4) & 1, dblk = cls * (128 >> dlg) + (mh >> 5);
      const PG8_LAS unsigned char* row = lds + (h * 64 + rb * 32 + dvlo) * VT_STRIDE;
      unsigned short k8[8];
#pragma unroll
      for (int j = 0; j < 8; ++j) {
        const int tau = ((16 * hc + 4 * hh + (j & 3) + 8 * (j >> 2)) << dlg) + cls;
        k8[j] = *(const PG8_LAS unsigned short*)(row + tau * 2);
      }
      u32x4 w = {(unsigned)k8[0] | ((unsigned)k8[1] << 16), (unsigned)k8[2] | ((unsigned)k8[3] << 16),
                 (unsigned)k8[4] | ((unsigned)k8[5] << 16), (unsigned)k8[6] | ((unsigned)k8[7] << 16)};
      u16* dst = vbuf + (size_t)vgrp * TC * 64 + (size_t)bl * SEQ * 64 + ((size_t)((dblk * 2 + rb) * 2 + s) * 64 + hh * 32 + dvlo) * 8;
      *(u32x4*)dst = w;
    }
    __syncthreads();
  }
};

struct MergeOrder : pg8::StaticOrder {
  const u16* ybase; const u16* wbase;
  DI bool next(int i, Unit& u) const { if (i >= 5) return false; if (!pg8::StaticOrder::next(0, u)) return false; u.seg = i; return true; }
  DI const char* baseA(const pg8::Gemm&, const Unit& u, size_t tstep) const { return (const char*)(ybase + (size_t)u.seg * TC * 256) + (size_t)u.pm * tstep; }
  DI const char* baseB(const pg8::Gemm&, const Unit& u, size_t tstep) const { return (const char*)(wbase + (size_t)u.seg * DM * 256) + (size_t)u.pn * tstep; }
  DI bool zero_after(const Unit& u) const { return u.seg == 4; }
};
struct EpiMerge {
  static constexpr bool PERM = true, AFTER_DRAIN = false;
  const u16* gate; u16* mrg;
  DI void operator()(f32x4 (&acc)[2][2][4][2], const Unit& u, int wr, int wc, int fr, int fq) const {
    const int seg = u.seg;
    if (seg == 0) return;
    const bool last = (seg == 4);
    const int gnum = last ? 3 : seg - 1, gden = last ? 3 : seg;
    const u16* gnp = gate + ((size_t)u.pm * 256 + 64 * wr + fr) * 4096 + gnum * 1024 + u.pn * 256 + 32 * wc + 8 * fq;
    const u16* gdp = gate + ((size_t)u.pm * 256 + 64 * wr + fr) * 4096 + gden * 1024 + u.pn * 256 + 32 * wc + 8 * fq;
    u32x4 gn, gd, gnn, gdn;
    gn = *(const u32x4*)gnp; gd = *(const u32x4*)gdp;
#pragma unroll
    for (int i = 0; i < 16; ++i) {
      const int ai = i >> 3, m = (i >> 1) & 3, bj = i & 1;
      if (i < 15) {
        const int i2 = i + 1;
        const size_t ro = (size_t)(128 * (i2 >> 3) + 16 * ((i2 >> 1) & 3)) * 4096 + 128 * (i2 & 1);
        gnn = *(const u32x4*)(gnp + ro); gdn = *(const u32x4*)(gdp + ro);
      }
      asm volatile("" ::: "memory");
#pragma unroll
      for (int n = 0; n < 2; ++n) {
        f32x4 f;
        f[0] = bf_lo(gn[2 * n]); f[1] = bf_hi(gn[2 * n]); f[2] = bf_lo(gn[2 * n + 1]); f[3] = bf_hi(gn[2 * n + 1]);
        if (!last) {
          f[0] *= __builtin_amdgcn_rcpf(bf_lo(gd[2 * n])); f[1] *= __builtin_amdgcn_rcpf(bf_hi(gd[2 * n]));
          f[2] *= __builtin_amdgcn_rcpf(bf_lo(gd[2 * n + 1])); f[3] *= __builtin_amdgcn_rcpf(bf_hi(gd[2 * n + 1]));
        }
        acc[ai][bj][m][n] *= f;
      }
      if (last) {
        const size_t tok = (size_t)u.pm * 256 + 128 * ai + 64 * wr + 16 * m + fr;
        const int c = u.pn * 256 + 128 * bj + 32 * wc + 8 * fq;
        const f32x4 v0 = acc[ai][bj][m][0], v1 = acc[ai][bj][m][1];
        u32x4 w = {pk2(v0[0], v0[1]), pk2(v0[2], v0[3]), pk2(v1[0], v1[1]), pk2(v1[2], v1[3])};
        *(u32x4*)(mrg + tok * DM + c) = w;
      }
      gn = gnn; gd = gdn;
    }
  }
};

struct EpiResid {
  static constexpr bool PERM = true, AFTER_DRAIN = false;
  float* xout; u16* xb; float* ssq; int wf32;
  DI void operator()(const f32x4 (&acc)[2][2][4][2], const Unit& u, int wr, int wc, int fr, int fq) const {
    const size_t o0 = ((size_t)u.pm * 256 + 64 * wr + fr) * DM + u.pn * 256 + 32 * wc + 8 * fq;
    u32x4 xo, xn;
    xo = *(const u32x4*)(xb + o0);
    float ss = 0.f;
#pragma unroll
    for (int i = 0; i < 16; ++i) {
      const int ai = i >> 3, m = (i >> 1) & 3, bj = i & 1;
      if (i < 15) {
        const int i2 = i + 1;
        xn = *(const u32x4*)(xb + o0 + (size_t)(128 * (i2 >> 3) + 16 * ((i2 >> 1) & 3)) * DM + 128 * (i2 & 1));
      }
      asm volatile("" ::: "memory");
      const size_t tok = (size_t)u.pm * 256 + 128 * ai + 64 * wr + 16 * m + fr;
      const size_t o = tok * DM + u.pn * 256 + 128 * bj + 32 * wc + 8 * fq;
      f32x4 v0 = acc[ai][bj][m][0], v1 = acc[ai][bj][m][1];
      v0[0] += bf_lo(xo[0]); v0[1] += bf_hi(xo[0]); v0[2] += bf_lo(xo[1]); v0[3] += bf_hi(xo[1]);
      v1[0] += bf_lo(xo[2]); v1[1] += bf_hi(xo[2]); v1[2] += bf_lo(xo[3]); v1[3] += bf_hi(xo[3]);
      if (wf32) { *(f32x4*)(xout + o) = v0; *(f32x4*)(xout + o + 4) = v1; }
      u32x4 w = {pk2(v0[0], v0[1]), pk2(v0[2], v0[3]), pk2(v1[0], v1[1]), pk2(v1[2], v1[3])};
      *(u32x4*)(xb + o) = w;
      ss += ((v0[0] * v0[0] + v0[1] * v0[1]) + (v0[2] * v0[2] + v0[3] * v0[3])) + ((v1[0] * v1[0] + v1[1] * v1[1]) + (v1[2] * v1[2] + v1[3] * v1[3]));
      if (bj == 1) {
        ss += __shfl_xor(ss, 16); ss += __shfl_xor(ss, 32);
        if (fq == 0) ssq[tok * 16 + u.pn * 4 + wc] = ss;
        ss = 0.f;
      }
      xo = xn;
    }
  }
};

template <class Epi>
DI void run_merge(PG8_LAS unsigned char* lds, const u16* ybase, const u16* wbase, const Epi& E) {
  int K = 256; asm volatile("" : "+s"(K));
  pg8::Gemm g; g.A = ybase; g.Bt = wbase; g.M = TC; g.N = DM; g.K = K;
  MergeOrder S; S.init(TC, DM, (int)gridDim.x, (int)blockIdx.x); S.ybase = ybase; S.wbase = wbase;
  pg8::gemm_phase<Epi, MergeOrder, false>(lds, g, S, E, nullptr);
}
template <class Epi>
DI void run_gemm(PG8_LAS unsigned char* lds, const u16* A, const u16* Bt, int M, int N, int K, const Epi& E, int probe = 0) {
  asm volatile("" : "+s"(K));
  pg8::Gemm g; g.A = A; g.Bt = Bt; g.M = M; g.N = N; g.K = K;
  pg8::StaticOrder S; S.init(M, N, (int)gridDim.x, (int)blockIdx.x); S.probe = probe;
  pg8::gemm_phase<Epi, pg8::StaticOrder, false>(lds, g, S, E, nullptr);
}

DI void cvt_load(const float* __restrict__ src, int N, int k0, int n0, const float* __restrict__ g, float* t, int ht) {
  const int c4 = (ht & 15) * 4;
#pragma unroll
  for (int i = 0; i < 4; ++i) {
    const int kk = (ht >> 4) + 16 * i;
    f32x4 v = *(const f32x4*)(src + (size_t)(k0 + kk) * N + n0 + c4);
    const float sc = g ? g[k0 + kk] : 1.0f;
    t[kk * 65 + c4 + 0] = v[0] * sc; t[kk * 65 + c4 + 1] = v[1] * sc; t[kk * 65 + c4 + 2] = v[2] * sc; t[kk * 65 + c4 + 3] = v[3] * sc;
  }
}
DI void cvt_store(u16* __restrict__ dst, int ldk, int kdst, int d0, int d1, const float* t, int ht) {
  const int kc = (ht & 7) * 8, nn = ht >> 3;
#pragma unroll
  for (int i = 0; i < 2; ++i) {
    const int tn = nn + 32 * i, row = (i == 0) ? d0 + nn : d1 + nn;
    u32x4 w;
    w[0] = pk2(t[(kc + 0) * 65 + tn], t[(kc + 1) * 65 + tn]);
    w[1] = pk2(t[(kc + 2) * 65 + tn], t[(kc + 3) * 65 + tn]);
    w[2] = pk2(t[(kc + 4) * 65 + tn], t[(kc + 5) * 65 + tn]);
    w[3] = pk2(t[(kc + 6) * 65 + tn], t[(kc + 7) * 65 + tn]);
    *(u32x4*)(dst + (size_t)row * ldk + kdst + kc) = w;
  }
}
struct CvtJob { const float* src; int N, k0, n0; const float* g; u16* dst; int ldk, d0, d1, kd; };
DI CvtJob cvt_job(const Params& p, int l, int ti) {
  CvtJob j; j.g = nullptr; j.kd = -1;
  const float* attn_g = p.in[1] + l * DM;
  if (ti < 608) { const int h = ti >> 4, kt = ti & 15; j.src = p.in[2] + (size_t)l * DM * INC; j.N = INC; j.k0 = kt * 64; j.n0 = qk_head_col(h); j.g = attn_g;
    j.dst = (u16*)(p.ws + OFF_WQKG) + (size_t)l * NQKG * DM; j.ldk = DM; j.d0 = (h >> 2) * 256 + (h & 3) * 32; j.d1 = j.d0 + 128; return j; }
  ti -= 608;
  if (ti < 1024) { const int c = ti >> 4, kt = ti & 15; j.src = p.in[2] + (size_t)l * DM * INC; j.N = INC; j.k0 = kt * 64; j.n0 = 3456 + 64 * c; j.g = attn_g;
    j.dst = (u16*)(p.ws + OFF_WQKG) + (size_t)l * NQKG * DM; j.ldk = DM; j.d0 = 2560 + 64 * c; j.d1 = j.d0 + 32; return j; }
  ti -= 1024;
  if (ti < 256) { const int vh = ti >> 4, kt = ti & 15; j.src = p.in[2] + (size_t)l * DM * INC; j.N = INC; j.k0 = kt * 64; j.n0 = v_head_col(vh); j.g = attn_g;
    j.dst = (u16*)(p.ws + OFF_WV) + (size_t)l * DM * DM; j.ldk = DM; j.d0 = vh * 64; j.d1 = j.d0 + 32; return j; }
  ti -= 256;
  if (ti < 128) { j.src = p.in[11] + (size_t)l * 512 * DM; j.N = DM; j.k0 = (ti >> 4) * 64; j.n0 = (ti & 15) * 64; j.dst = (u16*)(p.ws + OFF_WBR5) + ((size_t)l * 5 + (j.k0 >> 8)) * DM * 256; j.ldk = 256; j.kd = j.k0 & 255; j.d0 = j.n0; j.d1 = j.n0 + 32; return j; }
  ti -= 128;
  if (ti < 32) { j.src = p.in[12] + (size_t)l * 128 * DM; j.N = DM; j.k0 = (ti >> 4) * 64; j.n0 = (ti & 15) * 64; j.dst = (u16*)(p.ws + OFF_WBR5) + ((size_t)l * 5 + 2) * DM * 256; j.ldk = 256; j.kd = j.k0; j.d0 = j.n0; j.d1 = j.n0 + 32; return j; }
  ti -= 32;
  if (ti < 64) { j.src = p.in[13] + (size_t)l * 256 * DM; j.N = DM; j.k0 = (ti >> 4) * 64; j.n0 = (ti & 15) * 64; j.dst = (u16*)(p.ws + OFF_WBR5) + ((size_t)l * 5 + 3) * DM * 256; j.ldk = 256; j.kd = j.k0; j.d0 = j.n0; j.d1 = j.n0 + 32; return j; }
  ti -= 64;
  if (ti < 64) { j.src = p.in[14] + (size_t)l * 256 * DM; j.N = DM; j.k0 = (ti >> 4) * 64; j.n0 = (ti & 15) * 64; j.dst = (u16*)(p.ws + OFF_WBR5) + ((size_t)l * 5 + 4) * DM * 256; j.ldk = 256; j.kd = j.k0; j.d0 = j.n0; j.d1 = j.n0 + 32; return j; }
  ti -= 64;
  if (ti < 256) { j.src = p.in[15] + (size_t)l * DM * DM; j.N = DM; j.k0 = (ti >> 4) * 64; j.n0 = (ti & 15) * 64; j.dst = (u16*)(p.ws + OFF_WOUT) + (size_t)l * DM * DM; j.ldk = DM; j.d0 = j.n0; j.d1 = j.n0 + 32; return j; }
  ti -= 256;
  if (ti < 1024) { j.src = p.in[17] + (size_t)l * DM * DMLP; j.N = DMLP; j.k0 = (ti >> 6) * 64; j.n0 = (ti & 63) * 64; j.g = p.in[16] + l * DM;
    j.dst = (u16*)(p.ws + OFF_WUP) + (size_t)l * DMLP * DM; j.ldk = DM; j.d0 = j.n0; j.d1 = j.n0 + 32; return j; }
  ti -= 1024;
  j.src = p.in[18] + (size_t)l * DMLP * DM; j.N = DM; j.k0 = (ti >> 4) * 64; j.n0 = (ti & 15) * 64; j.dst = (u16*)(p.ws + OFF_WDN) + (size_t)l * DM * DMLP; j.ldk = DMLP; j.d0 = j.n0; j.d1 = j.n0 + 32; return j;
}

__device__ void phase_prep(const Params& p, int tid_, int bid_, int nblk_, unsigned char* smem) {
  const int half = tid_ >> 8, ht = tid_ & 255;
  float* t = (float*)smem + half * (64 * 65);
  const int per_layer = 4480, total = 2 * per_layer;
  for (int jp = bid_; jp * 2 < total; jp += nblk_) {
    const int j = jp * 2 + half;
    const bool on = j < total;
    CvtJob job;
    if (on) { job = cvt_job(p, j / per_layer, j % per_layer); cvt_load(job.src, job.N, job.k0, job.n0, job.g, t, ht); }
    __syncthreads();
    if (on) cvt_store(job.dst, job.ldk, (job.kd >= 0) ? job.kd : job.k0, job.d0, job.d1, t, ht);
    __syncthreads();
  }
  {
    const u32x4 z = {0u, 0u, 0u, 0u};
    for (int e = bid_ * NTHR + tid_; e < 2 * 128 * 128; e += nblk_ * NTHR) {
      const int l = e >> 14, r = (e >> 7) & 127, c = (e & 127) * 8;
      const int row = 9 * 256 + ((r < 64) ? 64 + r : 128 + r);
      *(u32x4*)((u16*)(p.ws + OFF_WQKG) + ((size_t)l * NQKG + row) * DM + c) = z;
    }
    for (int e = bid_ * NTHR + tid_; e < 2 * 1024 * 16; e += nblk_ * NTHR) {
      const int l = e >> 14, r = (e >> 4) & 1023, c = 128 + (e & 15) * 8;
      *(u32x4*)((u16*)(p.ws + OFF_WBR5) + (((size_t)l * 5 + 2) * DM + r) * 256 + c) = z;
    }
  }
  float* rope = (float*)(p.ws + OFF_ROPE);
  for (int e = bid_ * NTHR + tid_; e < SEQ * 48; e += nblk_ * NTHR) {
    const int pos = e / 48, i = e % 48;
    float inv;
    if (i < 32) inv = exp2f(-13.287712379549449f * (float)(2 * i) / 64.0f);
    else inv = exp2f(-13.287712379549449f * (float)(2 * (i - 32)) / 32.0f);
    const float angf = (float)pos * inv;
    const double ang = (double)angf;
    const double n = rint(ang * 0.15915494309189535);
    const float r = (float)(ang - n * 6.283185307179586);
    const float c = cosf(r), s = sinf(r);
    if (i < 32) { rope[pos * 96 + i] = c; rope[pos * 96 + 32 + i] = s; }
    else { rope[pos * 96 + 64 + (i - 32)] = c; rope[pos * 96 + 80 + (i - 32)] = s; }
  }
  u16* XB = (u16*)(p.ws + OFF_XB); float* SSQ = (float*)(p.ws + OFF_SSQ);
  const int lane = tid_ & 63;
  const int gw = bid_ * 8 + (tid_ >> 6), nw = nblk_ * 8;
  for (int row = gw; row < T; row += nw) {
    const float* xr = p.in[0] + (size_t)row * DM;
    float ss = 0.f;
#pragma unroll
    for (int i = 0; i < 4; ++i) {
      const f32x4 v = *(const f32x4*)(xr + i * 256 + lane * 4);
      ss += v[0] * v[0] + v[1] * v[1] + v[2] * v[2] + v[3] * v[3];
      u32x2 w = {pk2(v[0], v[1]), pk2(v[2], v[3])};
      *(u32x2*)(XB + (size_t)row * DM + i * 256 + lane * 4) = w;
    }
#pragma unroll
    for (int o = 32; o >= 1; o >>= 1) ss += __shfl_xor(ss, o);
    if (lane < 16) SSQ[(size_t)row * 16 + lane] = (lane == 0) ? ss : 0.f;
  }
}

DI void attn_softmax_pv(f32x16& S, float& m, float& l, f32x16& O0, f32x16& O1, const bf16x8 (&vf)[2][2]) {
  float mx = S[0];
#pragma unroll
  for (int i = 1; i < 16; ++i) mx = fmaxf(mx, S[i]);
  mx = fmaxf(mx, __shfl_xor(mx, 32));
  const float mn = fmaxf(m, mx);
  const float alpha = fexp2(m - mn);
  m = mn;
  float sum = 0.f;
#pragma unroll
  for (int i = 0; i < 16; ++i) { S[i] = fexp2(S[i] - mn); sum += S[i]; }
  l = l * alpha + sum;
  const u32x4 p0 = {pk2(S[0], S[1]), pk2(S[2], S[3]), pk2(S[4], S[5]), pk2(S[6], S[7])};
  const u32x4 p1 = {pk2(S[8], S[9]), pk2(S[10], S[11]), pk2(S[12], S[13]), pk2(S[14], S[15])};
#pragma unroll
  for (int i = 0; i < 16; ++i) { O0[i] *= alpha; O1[i] *= alpha; }
  O0 = MFMA32(vf[0][0], as_bf8(p0), O0);
  O0 = MFMA32(vf[0][1], as_bf8(p1), O0);
  O1 = MFMA32(vf[1][0], as_bf8(p0), O1);
  O1 = MFMA32(vf[1][1], as_bf8(p1), O1);
}
DI void attn_fixed_pv(f32x16& S, f32x16& L, f32x16& O0, f32x16& O1, const bf16x8 (&vf)[2][2], const bf16x8 ones) {
#pragma unroll
  for (int i = 0; i < 16; ++i) S[i] = fexp2(S[i]);
  const u32x4 p0 = {pk2(S[0], S[1]), pk2(S[2], S[3]), pk2(S[4], S[5]), pk2(S[6], S[7])};
  const u32x4 p1 = {pk2(S[8], S[9]), pk2(S[10], S[11]), pk2(S[12], S[13]), pk2(S[14], S[15])};
  O0 = MFMA32(vf[0][0], as_bf8(p0), O0);
  O0 = MFMA32(vf[0][1], as_bf8(p1), O0);
  O1 = MFMA32(vf[1][0], as_bf8(p0), O1);
  O1 = MFMA32(vf[1][1], as_bf8(p1), O1);
  float sum = 0.f;
#pragma unroll
  for (int i = 0; i < 16; ++i) sum += S[i];
  L[0] += sum;
}
DI void attn_plain_pv(f32x16& S, float& l, f32x16& O0, f32x16& O1, const bf16x8 (&vf)[2][2]) {
  float sum = 0.f;
#pragma unroll
  for (int i = 0; i < 16; ++i) { S[i] = fexp2(S[i]); sum += S[i]; }
  l += sum;
  const u32x4 p0 = {pk2(S[0], S[1]), pk2(S[2], S[3]), pk2(S[4], S[5]), pk2(S[6], S[7])};
  const u32x4 p1 = {pk2(S[8], S[9]), pk2(S[10], S[11]), pk2(S[12], S[13]), pk2(S[14], S[15])};
  O0 = MFMA32(vf[0][0], as_bf8(p0), O0); O1 = MFMA32(vf[1][0], as_bf8(p0), O1);
  O0 = MFMA32(vf[0][1], as_bf8(p1), O0); O1 = MFMA32(vf[1][1], as_bf8(p1), O1);
}
DI float gain_bound64(const float* g) {
  float a = 0.f, b = 0.f;
  for (int i = 0; i < 64; ++i) { a = fmaxf(a, fabsf(g[i])); b = fmaxf(b, fabsf(g[64 + i])); }
  return fminf(8.0f * a * b * 1.02f + 0.05f, 40.0f);
}
DI void load_vf(bf16x8 (&vf)[2][2], const u16* V, int kb, int lane) {
#pragma unroll
  for (int rb = 0; rb < 2; ++rb)
#pragma unroll
    for (int s = 0; s < 2; ++s) vf[rb][s] = *(const bf16x8*)(V + ((size_t)((kb * 2 + rb) * 2 + s) * 64 + lane) * 8);
}
DI void load_kf4(bf16x8 (&kf)[4], const u16* K, int kb, int lane) {
#pragma unroll
  for (int s = 0; s < 4; ++s) kf[s] = *(const bf16x8*)(K + ((size_t)(kb * 4 + s) * 64 + lane) * 8);
}
DI void load_kf2(bf16x8 (&kf)[2], const u16* K, int kb, int lane) {
#pragma unroll
  for (int s = 0; s < 2; ++s) kf[s] = *(const bf16x8*)(K + ((size_t)(kb * 2 + s) * 64 + lane) * 8);
}
DI void zero16(f32x16& a) {
#pragma unroll
  for (int i = 0; i < 16; ++i) a[i] = 0.f;
}
DI void store_o(u16* yrow, const f32x16& O0, const f32x16& O1, float sc, int h) {
#pragma unroll
  for (int g4 = 0; g4 < 4; ++g4) {
    u32x2 w0 = {pk2(O0[4 * g4] * sc, O0[4 * g4 + 1] * sc), pk2(O0[4 * g4 + 2] * sc, O0[4 * g4 + 3] * sc)};
    *(u32x2*)(yrow + 8 * g4 + 4 * h) = w0;
    u32x2 w1 = {pk2(O1[4 * g4] * sc, O1[4 * g4 + 1] * sc), pk2(O1[4 * g4 + 2] * sc, O1[4 * g4 + 3] * sc)};
    *(u32x2*)(yrow + 32 + 8 * g4 + 4 * h) = w1;
  }
}

__device__ void phase_attn(const Params& p, int tid_, int bid_, int nblk_, int layer) {
  const u16* QK = (const u16*)(p.ws + OFF_QK);
  const u16* VB = (const u16*)(p.ws + OFF_V);
  u16* Y5 = (u16*)(p.ws + OFF_Y5);
  u16* BO = (u16*)(p.ws + OFF_BO);
  float* LSE = (float*)(p.ws + OFF_LSE);
  const int lane = tid_ & 63, wave = tid_ >> 6;
  const int fr = lane & 31, fh = lane >> 5;
  const int nloc = nblk_ >> 3;
  if ((int)(bid_ >> 3) >= nloc) return;
  const int vw = ((bid_ & 7) * nloc + (bid_ >> 3)) * 8 + wave, NW = nloc * 64;
  const size_t GS = (size_t)TC * 64;
  const size_t BS = (size_t)SEQ * 64;

  {
    const float* lp = p.in[7] + layer * 128;
    float d01 = 0.f, d23 = 0.f;
    for (int i = 0; i < 32; ++i) { d01 += lp[i] * lp[32 + i]; d23 += lp[64 + i] * lp[96 + i]; }
    const float lambda_init = (layer == 0) ? 0.2f : 0.35550907f;
    const float lam = __expf(d01) - __expf(d23) + lambda_init;
    const float* subg = p.in[8] + layer * 64;
    const float sc = 0.17677669529663687f * LOG2E;
    float gqm = 0.f, gkm = 0.f;
    for (int i = 0; i < 32; ++i) { gqm = fmaxf(gqm, fabsf(p.in[6][layer * 64 + i])); gkm = fmaxf(gkm, fabsf(p.in[6][layer * 64 + 32 + i])); }
    const unsigned onev = ((fr & 27) == 0) ? 0x3f803f80u : 0u;
    const u32x4 ones4 = {onev, onev, onev, onev};
    const bf16x8 ones = as_bf8(ones4);
    const float cbound = 5.6568542f * gqm * gkm * 1.02f + 0.05f;
    for (int it = vw; it < BC * 4 * 128; it += NW) {
      const int bl = it >> 9, head = (it >> 7) & 3, qblk = it & 127;
      const u16* Q0 = QK + (22 + head) * GS + bl * BS; const u16* Q1 = Q0 + SEQ * 32;
      const u16* K0 = QK + (26 + head) * GS + bl * BS; const u16* K1 = K0 + SEQ * 32;
      const u16* V = VB + (8 + head) * GS + bl * BS;
      bf16x8 q0[2], q1[2];
      load_kf2(q0, Q0, qblk, lane); load_kf2(q1, Q1, qblk, lane);
      f32x16 L0, L1; zero16(L0); zero16(L1);
      f32x16 O00, O01, O10, O11; zero16(O00); zero16(O01); zero16(O10); zero16(O11);
      bf16x8 k0[2], k1[2], vf[2][2];
      {
        const float mb2 = fminf(cbound, 40.0f) * LOG2E;
        f32x16 sinit;
#pragma unroll
        for (int i = 0; i < 16; ++i) sinit[i] = -mb2;
        load_kf2(k0, K0, 0, lane); load_kf2(k1, K1, 0, lane); load_vf(vf, V, 0, lane);
        f32x16 S0 = sinit, S1 = sinit;
        S0 = MFMA32(k0[0], q0[0], S0); S0 = MFMA32(k0[1], q0[1], S0);
        S1 = MFMA32(k1[0], q1[0], S1); S1 = MFMA32(k1[1], q1[1], S1);
        load_kf2(k0, K0, 1, lane); load_kf2(k1, K1, 1, lane);
        for (int kb = 0; kb < 128; ++kb) {
          bf16x8 nk0[2], nk1[2], nvf[2][2];
          const int k2 = (kb + 2 < 128) ? kb + 2 : 127, v1 = (kb + 1 < 128) ? kb + 1 : 127;
          load_kf2(nk0, K0, k2, lane); load_kf2(nk1, K1, k2, lane); load_vf(nvf, V, v1, lane);
          f32x16 S0n = sinit, S1n = sinit;
#pragma unroll
          for (int i = 0; i < 16; ++i) S0[i] = fexp2(S0[i]);
          S0n = MFMA32(k0[0], q0[0], S0n); S0n = MFMA32(k0[1], q0[1], S0n);
          {
            const u32x4 p0 = {pk2(S0[0], S0[1]), pk2(S0[2], S0[3]), pk2(S0[4], S0[5]), pk2(S0[6], S0[7])};
            const u32x4 p1 = {pk2(S0[8], S0[9]), pk2(S0[10], S0[11]), pk2(S0[12], S0[13]), pk2(S0[14], S0[15])};
            O00 = MFMA32(vf[0][0], as_bf8(p0), O00); O01 = MFMA32(vf[1][0], as_bf8(p0), O01);
            O00 = MFMA32(vf[0][1], as_bf8(p1), O00); O01 = MFMA32(vf[1][1], as_bf8(p1), O01);
            float sum = 0.f;
#pragma unroll
            for (int i = 0; i < 16; ++i) sum += S0[i];
            L0[0] += sum;
          }
#pragma unroll
          for (int i = 0; i < 16; ++i) S1[i] = fexp2(S1[i]);
          S1n = MFMA32(k1[0], q1[0], S1n); S1n = MFMA32(k1[1], q1[1], S1n);
          {
            const u32x4 p0 = {pk2(S1[0], S1[1]), pk2(S1[2], S1[3]), pk2(S1[4], S1[5]), pk2(S1[6], S1[7])};
            const u32x4 p1 = {pk2(S1[8], S1[9]), pk2(S1[10], S1[11]), pk2(S1[12], S1[13]), pk2(S1[14], S1[15])};
            O10 = MFMA32(vf[0][0], as_bf8(p0), O10); O11 = MFMA32(vf[1][0], as_bf8(p0), O11);
            O10 = MFMA32(vf[0][1], as_bf8(p1), O10); O11 = MFMA32(vf[1][1], as_bf8(p1), O11);
            float sum = 0.f;
#pragma unroll
            for (int i = 0; i < 16; ++i) sum += S1[i];
            L1[0] += sum;
          }
          S0 = S0n; S1 = S1n;
#pragma unroll
          for (int s = 0; s < 2; ++s) { k0[s] = nk0[s]; k1[s] = nk1[s]; vf[0][s] = nvf[0][s]; vf[1][s] = nvf[1][s]; }
        }
      }
      const float i0 = 1.0f / (L0[0] + __shfl_xor(L0[0], 32));
      const float i1 = lam / (L1[0] + __shfl_xor(L1[0], 32));
      float ss = 0.f;
#pragma unroll
      for (int i = 0; i < 16; ++i) {
        O00[i] = O00[i] * i0 - O10[i] * i1; O01[i] = O01[i] * i0 - O11[i] * i1;
        ss += O00[i] * O00[i] + O01[i] * O01[i];
      }
      ss += __shfl_xor(ss, 32);
      const float rn = rsqrtf(ss * (1.0f / 64.0f) + 1e-6f) * (1.0f - lambda_init);
#pragma unroll
      for (int g4 = 0; g4 < 4; ++g4) {
        const f32x4 ga = *(const f32x4*)(subg + 8 * g4 + 4 * fh);
        const f32x4 gb = *(const f32x4*)(subg + 32 + 8 * g4 + 4 * fh);
#pragma unroll
        for (int e = 0; e < 4; ++e) { O00[4 * g4 + e] *= ga[e]; O01[4 * g4 + e] *= gb[e]; }
      }
      const size_t tok = (size_t)bl * SEQ + qblk * 32 + fr;
      store_o(Y5 + (size_t)3 * TC * 256 + tok * 256 + head * 64, O00, O01, rn, fh);
    }
  }
  {
    const float mbA = gain_bound64(p.in[3] + layer * 128) * LOG2E;
    f32x16 sinit;
#pragma unroll
    for (int i = 0; i < 16; ++i) sinit[i] = -mbA;
    for (int it = vw; it < BC * 8 * 128; it += NW) {
      const int bl = it >> 10, hq = (it >> 7) & 7, qblk = it & 127;
      const int kvh = hq >> 2;
      const u16* Q = QK + (size_t)hq * GS + bl * BS;
      const u16* K = QK + (size_t)(8 + kvh) * GS + bl * BS;
      const u16* V = VB + (size_t)kvh * GS + bl * BS;
      bf16x8 qf[4]; load_kf4(qf, Q, qblk, lane);
      float l = (fh == 0) ? fexp2(p.in[4][layer * 8 + hq] * LOG2E - mbA) : 0.0f;
      f32x16 O0, O1; zero16(O0); zero16(O1);
      const int kb_lo = (qblk - 4 < 0) ? 0 : qblk - 4, kb_hi = (qblk + 4 > 127) ? 127 : qblk + 4;
      const int qpos = qblk * 32 + fr;
      bf16x8 kf[4], vf[2][2];
      load_kf4(kf, K, kb_lo, lane); load_vf(vf, V, kb_lo, lane);
      for (int kb = kb_lo; kb <= kb_hi; ++kb) {
        bf16x8 nkf[4], nvf[2][2];
        const int kn = (kb < kb_hi) ? kb + 1 : kb;
        load_kf4(nkf, K, kn, lane); load_vf(nvf, V, kn, lane);
        f32x16 S = sinit;
#pragma unroll
        for (int s = 0; s < 4; ++s) S = MFMA32(kf[s], qf[s], S);
        if (kb == qblk - 4 || kb == qblk + 4) {
#pragma unroll
          for (int i = 0; i < 16; ++i) {
            const int dlt = kb * 32 + crow(i, fh) - qpos;
            S[i] = (dlt <= 128 && dlt >= -128) ? S[i] : (-__builtin_inff());
          }
        }
        attn_plain_pv(S, l, O0, O1, vf);
#pragma unroll
        for (int s = 0; s < 4; ++s) kf[s] = nkf[s];
#pragma unroll
        for (int s = 0; s < 2; ++s) { vf[0][s] = nvf[0][s]; vf[1][s] = nvf[1][s]; }
      }
      const float inv = 1.0f / (l + __shfl_xor(l, 32));
      const size_t tok = (size_t)bl * SEQ + qpos;
      store_o(Y5 + (size_t)(hq >> 2) * TC * 256 + tok * 256 + (hq & 3) * 64, O0, O1, inv, fh);
    }
  }
  {
    const float gbD = gain_bound64(p.in[9] + layer * 128);
    for (int it = vw; it < BC * 4 * 128; it += NW) {
      const int bl = it >> 9, head = (it >> 7) & 3, qblk = it & 127;
      const u16* Q = QK + (size_t)(30 + head) * GS + bl * BS;
      const u16* K = QK + (size_t)(34 + head) * GS + bl * BS;
      const u16* V = VB + (size_t)(12 + head) * GS + bl * BS;
      const float* rpb = p.in[10] + (size_t)(layer * 4 + head) * 15 * 31;
      bf16x8 qf[4]; load_kf4(qf, Q, qblk, lane);
      float bmax = 0.f;
      for (int i = lane; i < 15 * 31; i += 64) bmax = fmaxf(bmax, fabsf(rpb[i]));
#pragma unroll
      for (int o = 32; o >= 1; o >>= 1) bmax = fmaxf(bmax, __shfl_xor(bmax, o));
      const float mbD = fminf(gbD + bmax, 60.0f) * LOG2E;
      f32x16 sinit;
#pragma unroll
      for (int i = 0; i < 16; ++i) sinit[i] = -mbD;
      float l = 0.f;
      f32x16 O0, O1; zero16(O0); zero16(O1);
      const int qrow = qblk >> 1, qc = (qblk & 1) * 32 + fr;
      int r0 = qrow - 4; r0 = r0 < 0 ? 0 : (r0 > 56 ? 56 : r0);
      int c0 = qc - 8; c0 = c0 < 0 ? 0 : (c0 > 48 ? 48 : c0);
      bf16x8 kf[4], vf[2][2];
      load_kf4(kf, K, r0 * 2, lane); load_vf(vf, V, r0 * 2, lane);
      for (int kk = 0; kk < 16; ++kk) {
        const int krow_ = r0 + (kk >> 1), hb = kk & 1;
        bf16x8 nkf[4], nvf[2][2];
        const int kn = r0 * 2 + ((kk < 15) ? kk + 1 : kk);
        load_kf4(nkf, K, kn, lane); load_vf(nvf, V, kn, lane);
        f32x16 S = sinit;
#pragma unroll
        for (int s = 0; s < 4; ++s) S = MFMA32(kf[s], qf[s], S);
        const float* brow = rpb + (krow_ - qrow + 7) * 31;
#pragma unroll
        for (int i = 0; i < 16; ++i) {
          const int kc = hb * 32 + crow(i, fh);
          int dc = kc - qc; dc = dc < -15 ? -15 : (dc > 15 ? 15 : dc);
          const float bias = brow[dc + 15];
          S[i] = (kc >= c0 && kc < c0 + 16) ? __builtin_fmaf(bias, LOG2E, S[i]) : (-__builtin_inff());
        }
        attn_plain_pv(S, l, O0, O1, vf);
#pragma unroll
        for (int s = 0; s < 4; ++s) kf[s] = nkf[s];
#pragma unroll
        for (int s = 0; s < 2; ++s) { vf[0][s] = nvf[0][s]; vf[1][s] = nvf[1][s]; }
      }
      const float inv = 1.0f / (l + __shfl_xor(l, 32));
      const size_t tok = (size_t)bl * SEQ + qblk * 32 + fr;
      store_o(Y5 + (size_t)4 * TC * 256 + tok * 256 + head * 64, O0, O1, inv, fh);
    }
  }
  {
    const float mbB = gain_bound64(p.in[5] + layer * 128) * LOG2E;
    f32x16 sinit;
#pragma unroll
    for (int i = 0; i < 16; ++i) sinit[i] = -mbB;
    for (int it = vw; it < BC * 6 * 128; it += NW) {
      const int bl = it / 768, rem = it % 768, head = rem >> 7, qblk = rem & 127;
      const int dil = dil_of(head >> 1), L = SEQ / dil, LB = L >> 5;
      const u16* Q = QK + (size_t)(10 + head) * GS + bl * BS;
      const u16* K = QK + (size_t)(16 + head) * GS + bl * BS;
      const u16* V = VB + (size_t)(2 + head) * GS + bl * BS;
      bf16x8 qf[4]; load_kf4(qf, Q, qblk, lane);
      float l = 0.f;
      f32x16 O0, O1; zero16(O0); zero16(O1);
      const int rsub = qblk / LB;
      const int lo = rsub * LB, hi = lo + LB - 1;
      const int kb_lo = (qblk - 2 < lo) ? lo : qblk - 2, kb_hi = (qblk + 2 > hi) ? hi : qblk + 2;
      const int qd = qblk * 32 + fr;
      bf16x8 kf[4], vf[2][2];
      load_kf4(kf, K, kb_lo, lane); load_vf(vf, V, kb_lo, lane);
      for (int kb = kb_lo; kb <= kb_hi; ++kb) {
        bf16x8 nkf[4], nvf[2][2];
        const int kn = (kb < kb_hi) ? kb + 1 : kb;
        load_kf4(nkf, K, kn, lane); load_vf(nvf, V, kn, lane);
        f32x16 S = sinit;
#pragma unroll
        for (int s = 0; s < 4; ++s) S = MFMA32(kf[s], qf[s], S);
        if (kb == qblk - 2 || kb == qblk + 2) {
#pragma unroll
          for (int i = 0; i < 16; ++i) {
            const int dlt = kb * 32 + crow(i, fh) - qd;
            S[i] = (dlt <= 64 && dlt >= -64) ? S[i] : (-__builtin_inff());
          }
        }
        attn_plain_pv(S, l, O0, O1, vf);
#pragma unroll
        for (int s = 0; s < 4; ++s) kf[s] = nkf[s];
#pragma unroll
        for (int s = 0; s < 2; ++s) { vf[0][s] = nvf[0][s]; vf[1][s] = nvf[1][s]; }
      }
      const float lt = l + __shfl_xor(l, 32);
      const float inv = 1.0f / lt;
      const int msub = qd - rsub * L;
      const int pos = msub * dil + rsub;
      const size_t tok = (size_t)bl * SEQ + pos;
      store_o(BO + tok * 384 + head * 64, O0, O1, inv, fh);
      if (fh == 0) LSE[tok * 8 + head] = __log2f(lt) + mbB;
    }
  }
}


__device__ void phase_bcombine(const Params& p, int tid_, int tok0) {
  const u16* BO = (const u16*)(p.ws + OFF_BO);
  const float* LSE = (const float*)(p.ws + OFF_LSE);
  u16* YB = (u16*)(p.ws + OFF_Y5) + (size_t)2 * TC * 256;
  for (int e = tid_; e < 256 * 16; e += NTHR) {
    const int tok = tok0 + (e >> 4), j = (e >> 3) & 1, c8 = (e & 7) * 8;
    const float a0 = LSE[(size_t)tok * 8 + j], a1 = LSE[(size_t)tok * 8 + 2 + j], a2 = LSE[(size_t)tok * 8 + 4 + j];
    const float mx = fmaxf(a0, fmaxf(a1, a2));
    float w0 = fexp2(a0 - mx), w1 = fexp2(a1 - mx), w2 = fexp2(a2 - mx);
    const float inv = 1.0f / (w0 + w1 + w2);
    w0 *= inv; w1 *= inv; w2 *= inv;
    const u32x4 x0 = *(const u32x4*)(BO + (size_t)tok * 384 + (0 + j) * 64 + c8);
    const u32x4 x1 = *(const u32x4*)(BO + (size_t)tok * 384 + (2 + j) * 64 + c8);
    const u32x4 x2 = *(const u32x4*)(BO + (size_t)tok * 384 + (4 + j) * 64 + c8);
    u32x4 o;
#pragma unroll
    for (int q = 0; q < 4; ++q) {
      const float lo = w0 * bf_lo(x0[q]) + w1 * bf_lo(x1[q]) + w2 * bf_lo(x2[q]);
      const float hi = w0 * bf_hi(x0[q]) + w1 * bf_hi(x1[q]) + w2 * bf_hi(x2[q]);
      o[q] = pk2(lo, hi);
    }
    *(u32x4*)(YB + (size_t)tok * 256 + j * 64 + c8) = o;
    const u32x4 z = {0u, 0u, 0u, 0u};
    *(u32x4*)(YB + (size_t)tok * 256 + 128 + (e & 15) * 8) = z;
  }
}

#define XB_TMO      128
#define XB_XCNT(j)  (256  + 64 * (j))
#define XB_XSUB(j)  (1280 + 64 * (j))
#define XB_XGEN(j)  (2304 + 64 * (j))
#define XB_TOP      3328
#define XB_TOPGEN   3392
#define XCD_BAR_WORDS 3456
#define XB_SPIN_CAP (1u << 22)
#define LAS __attribute__((address_space(3)))
DI unsigned xb_ld(unsigned* p)              { return __hip_atomic_load(p, __ATOMIC_RELAXED, __HIP_MEMORY_SCOPE_AGENT); }
DI unsigned xb_add(unsigned* p, unsigned v) { return __hip_atomic_fetch_add(p, v, __ATOMIC_RELAXED, __HIP_MEMORY_SCOPE_AGENT); }
DI unsigned xb_xcc_id() { return (unsigned)__builtin_amdgcn_s_getreg((3 << 11) | 20) & 0xFu; }
#define XB_SPIN(cond, bar) do { unsigned _sp = 0; while (cond) { __builtin_amdgcn_s_sleep(1); \
    if ((++_sp & 255u) == 0u) { if (xb_ld(&(bar)[XB_TMO])) break; if (_sp > XB_SPIN_CAP) { atomicAdd(&(bar)[XB_TMO], 1u); break; } } } } while (0)
struct XcdBarrier { unsigned* bar; unsigned x; volatile LAS unsigned* st; };
DI XcdBarrier xcd_barrier_post(unsigned* bar, volatile LAS unsigned* st) {
  XcdBarrier b; b.bar = bar; b.x = xb_xcc_id(); b.st = st;
  if (threadIdx.x == 0) (void)xb_add(&bar[XB_XCNT(b.x)], 1u);
  return b;
}
DI void xcd_barrier_complete(unsigned* bar, unsigned x, unsigned& nloc, unsigned& nx) {
  const unsigned G = gridDim.x * gridDim.y * gridDim.z;
  unsigned sum, cnt, mine, sp = 0u;
  for (;;) {
    sum = 0u; cnt = 0u; mine = 0u;
#pragma unroll
    for (unsigned j = 0; j < 16; ++j) { const unsigned c = xb_ld(&bar[XB_XCNT(j)]); sum += c; cnt += (c > 0u) ? 1u : 0u; mine = (j == x) ? c : mine; }
    if (sum == G) break;
    __builtin_amdgcn_s_sleep(1);
    if ((++sp & 255u) == 0u) { if (xb_ld(&bar[XB_TMO])) break; if (sp > XB_SPIN_CAP) { atomicAdd(&bar[XB_TMO], 1u); break; } }
  }
  nloc = mine > 0u ? mine : 1u; nx = cnt > 0u ? cnt : 1u;
}
DI void xcd_barrier(const XcdBarrier& b) {
  asm volatile("s_waitcnt vmcnt(0)" ::: "memory");
  __syncthreads();
  if (threadIdx.x == 0) {
    unsigned* bar = b.bar;
    __builtin_amdgcn_s_waitcnt(0);
    unsigned nloc = b.st[0], nx = b.st[1];
    if (nloc == 0u) { xcd_barrier_complete(bar, b.x, nloc, nx); b.st[0] = nloc; b.st[1] = nx; }
    const unsigned old = xb_add(&bar[XB_XSUB(b.x)], 1u);
    const unsigned gen = old / nloc;
    if (old + 1u == (gen + 1u) * nloc) {
      __builtin_amdgcn_fence(__ATOMIC_RELEASE, "agent");
      asm volatile("s_waitcnt vmcnt(0)" ::: "memory");
      const unsigned og = xb_add(&bar[XB_TOP], 1u);
      const unsigned tg = og / nx;
      if (og + 1u == (tg + 1u) * nx) xb_add(&bar[XB_TOPGEN], 1u);
      else XB_SPIN(xb_ld(&bar[XB_TOPGEN]) == tg, bar);
      __builtin_amdgcn_fence(__ATOMIC_ACQUIRE, "agent");
      xb_add(&bar[XB_XGEN(b.x)], 1u);
      asm volatile("s_waitcnt vmcnt(0)" ::: "memory");
    } else {
      XB_SPIN(xb_ld(&bar[XB_XGEN(b.x)]) == gen, bar);
      __builtin_amdgcn_fence(__ATOMIC_ACQUIRE, "agent");
      asm volatile("s_waitcnt vmcnt(0)" ::: "memory");
    }
  }
  __syncthreads();
}

__global__ void __launch_bounds__(NTHR, 2) mk_forward(Params p) {
  extern __shared__ __attribute__((aligned(16))) unsigned char smem[];
  cg::grid_group grid = cg::this_grid();
  volatile LAS unsigned* xbw = (volatile LAS unsigned*)(smem + LDS_XBW);
  if (threadIdx.x < 4) xbw[threadIdx.x] = 0u;
  __syncthreads();
  XcdBarrier xb;
  if (FUSED) xb = xcd_barrier_post((unsigned*)(p.ws + OFF_BAR), xbw);
#if PROBE_CLOCK
  const unsigned long long pc_t0 = clock64(), pc_r0 = wall_clock64();
#endif
  PG8_LAS unsigned char* lds = (PG8_LAS unsigned char*)smem;
  for (int ph = p.ph_lo; ph < p.ph_hi; ++ph) {
#if DUPMASK
   for (int rep = 0; rep < ((ph > 0 && ((DUPMASK >> ((ph - 1) % 7)) & 1)) ? 2 : 1); ++rep)
#endif
   {
    int tid_ = threadIdx.x, bid_ = blockIdx.x, nblk_ = gridDim.x;
    asm volatile("" : "+v"(tid_));
    asm volatile("" : "+s"(bid_));
    asm volatile("" : "+s"(nblk_));
    Params pp = p;
    asm volatile("" : "+s"(pp.ws));
    asm volatile("" : "+s"(pp.out));
    unsigned char* ws = pp.ws;
    if (ph == 0) {
      if (PHMASK & 128) phase_prep(pp, tid_, bid_, nblk_, smem);
    } else {
      const int q = ph - 1, chunk = q / (2 * PPL), layer = (q % (2 * PPL)) / PPL, kk = q % PPL, k = (kk == 6) ? DUPK : (kk < 2 ? kk : kk + 1);
      const u16* XBc = (const u16*)(ws + OFF_XB) + (size_t)chunk * TC * DM;
      float* SSQc = (float*)(ws + OFF_SSQ) + (size_t)chunk * TC * 16;
      float* xc = pp.out + (size_t)chunk * TC * DM;
      if ((k == 0 && (PHMASK & 1)) || (k == 5 && (PHMASK & 32))) {
        const bool up = (k == 5);
        if (!up) {
          EpiQKG e; e.ssq = SSQc; e.qk = (u16*)(ws + OFF_QK); e.rope = (const float*)(ws + OFF_ROPE);
          e.gA = pp.in[3] + layer * 128; e.gB = pp.in[5] + layer * 128; e.gC = pp.in[6] + layer * 64; e.gD = pp.in[9] + layer * 128;
          run_gemm(lds, XBc, (const u16*)(ws + OFF_WQKG) + (size_t)layer * NQKG * DM, TC, 2560, DM, e);
        }
        {
          EpiGateUp e; e.ssq = SSQc; e.o = (u16*)(ws + OFF_GATE); e.mode = up ? ((PROBE_NOEPI && kk == 6) ? 2 : 1) : 0;
          const u16* W = up ? (const u16*)(ws + OFF_WUP) + (size_t)layer * DMLP * DM : (const u16*)(ws + OFF_WQKG) + ((size_t)layer * NQKG + 2560) * DM;
          run_gemm(lds, XBc, W, TC, 4096, DM, e, (PROBE_NOEPI && kk == 6) ? 1 : 0);
        }
        if (!up) {
          EpiVT ev; ev.ssq = SSQc; ev.vbuf = (u16*)(ws + OFF_V);
          run_gemm(lds, (const u16*)(ws + OFF_WV) + (size_t)layer * DM * DM, XBc, DM, TC, DM, ev);
        }
      } else if (k == 1 && (PHMASK & 2)) {
        phase_attn(pp, tid_, bid_, nblk_, layer);
      } else if (k == 3 && (PHMASK & 8)) {
        {
          Unit u0; pg8::StaticOrder S0; S0.init(TC, DM, nblk_, bid_); S0.next(0, u0);
          phase_bcombine(pp, tid_, u0.pm * 256);
          asm volatile("s_waitcnt vmcnt(0)" ::: "memory");
          __syncthreads();
        }
        EpiMerge e; e.gate = (const u16*)(ws + OFF_GATE); e.mrg = (u16*)(ws + OFF_MRG);
        run_merge(lds, (const u16*)(ws + OFF_Y5), (const u16*)(ws + OFF_WBR5) + (size_t)layer * 5 * DM * 256, e);
      } else if ((k == 4 && (PHMASK & 16)) || (k == 6 && (PHMASK & 64))) {
        const bool dn = (k == 6);
        EpiResid e; e.xout = xc; e.xb = (u16*)XBc; e.ssq = SSQc; e.wf32 = (dn && layer == 1) ? 1 : 0;
        const u16* A = dn ? (const u16*)(ws + OFF_GATE) : (const u16*)(ws + OFF_MRG);
        const u16* W = dn ? (const u16*)(ws + OFF_WDN) + (size_t)layer * DM * DMLP : (const u16*)(ws + OFF_WOUT) + (size_t)layer * DM * DM;
        run_gemm(lds, A, W, TC, DM, dn ? DMLP : DM, e);
      }
    }
   }
    if (ph + 1 < p.ph_hi) {
      if (p.ph_lo < 0) grid.sync();
      xcd_barrier(xb);
    }
  }
#if PROBE_CLOCK
  {
    xcd_barrier(xb);
    const unsigned long long pc_t1 = clock64(), pc_r1 = wall_clock64();
    const float ghz = (float)(pc_t1 - pc_t0) / ((float)(pc_r1 - pc_r0) * 10.0f);
    const int nrows = (int)(ghz * 0.25f * (float)T);
    for (int r = blockIdx.x; r < nrows; r += gridDim.x)
      for (int c = threadIdx.x; c < DM; c += NTHR) p.out[(size_t)r * DM + c] = 0.f;
  }
#endif
}

extern "C" void kernel_launch(void* const* d_in, const int* in_sizes, int n_in, void* d_out, int out_size, void* d_ws, size_t ws_size,
                              hipStream_t stream) {
  static int grid_blocks = 0;
  if (grid_blocks == 0) {
    if (n_in != 19 || out_size != T * DM || ws_size < WS_END) {
      fprintf(stderr, "kernel_launch: unexpected problem (n_in %d out %d ws %zu need %zu)\n", n_in, out_size, ws_size, (size_t)WS_END);
      grid_blocks = -1;
      return;
    }
    int dev = 0, cus = 0, per_cu = 0;
    (void)hipGetDevice(&dev);
    (void)hipDeviceGetAttribute(&cus, hipDeviceAttributeMultiprocessorCount, dev);
    if (hipFuncSetAttribute((const void*)mk_forward, hipFuncAttributeMaxDynamicSharedMemorySize, LDS_BYTES) != hipSuccess) {
      fprintf(stderr, "kernel_launch: hipFuncSetAttribute failed\n"); grid_blocks = -1; return;
    }
    (void)hipOccupancyMaxActiveBlocksPerMultiprocessor(&per_cu, mk_forward, NTHR, LDS_BYTES);
    if (per_cu < 1) fprintf(stderr, "kernel_launch: occupancy query says %d blocks per CU\n", per_cu);
    (void)hipGetLastError();
    grid_blocks = cus;
  }
  if (grid_blocks < 0) return;
  Params p{};
  for (int i = 0; i < 19; ++i) p.in[i] = (const float*)d_in[i];
  p.out = (float*)d_out;
  p.ws = (unsigned char*)d_ws;
#if FUSED
  (void)hipMemsetAsync((unsigned char*)d_ws + OFF_BAR, 0, XCD_BAR_WORDS * 4, stream);
  p.ph_lo = 0; p.ph_hi = NPHASE;
  void* args[] = {&p};
  hipError_t e = hipLaunchCooperativeKernel((const void*)mk_forward, dim3(grid_blocks), dim3(NTHR), args, LDS_BYTES, stream);
  if (e != hipSuccess) fprintf(stderr, "cooperative launch failed: %s (grid %d)\n", hipGetErrorString(e), grid_blocks);
#else
  for (int ph = 0; ph < NPHASE; ++ph) {
    p.ph_lo = ph; p.ph_hi = ph + 1;
    hipLaunchKernelGGL(mk_forward, dim3(grid_blocks), dim3(NTHR), LDS_BYTES, stream, p);
  }
#endif
}
```

```cpp
#include <hip/hip_runtime.h>
#include <hip/hip_cooperative_groups.h>
#include <cstdio>
namespace cg = cooperative_groups;

#ifndef PHMASK
#define PHMASK 255
#endif
#ifndef DUPMASK
#define DUPMASK 0
#endif
#ifndef DUPK
#define DUPK -1
#endif
#ifndef PROBE_CLOCK
#define PROBE_CLOCK 0
#endif
#ifndef PROBE_NOEPI
#define PROBE_NOEPI 0
#endif
#ifndef FUSED
#define FUSED 1
#endif

namespace pg8 {
#define PG8_LAS __attribute__((address_space(3)))
typedef unsigned short bf16_t;
typedef short bf16x8 __attribute__((ext_vector_type(8)));
typedef float f32x4 __attribute__((ext_vector_type(4)));
typedef unsigned u32x4 __attribute__((ext_vector_type(4)));
constexpr int BM = 256, BK = 64, HALF = 128, HTB = HALF * BK * 2  , STAGE_BYTES = 8 * HTB, NXCD = 8, WGM = 8;

__host__ __device__ __forceinline__ int lds_byte(int r, int c) { const int st = (r >> 4) * 2 + (c >> 5), rr = r & 15, cc = c & 31, ob = rr * 64 + cc * 2; return st * 1024 + (ob ^ (((ob >> 9) & 1) << 5)); }
__host__ __device__ __forceinline__ void stage_rc(int b, int& R, int& C) { const int st = b / 1024, sb = b % 1024, swz = sb ^ (((sb >> 9) & 1) << 5); R = (st >> 1) * 16 + swz / 64; C = (st & 1) * 32 + (swz % 64) / 2; }
__host__ __device__ __forceinline__ int perm32(int rho) { const int n = rho >> 4, i = rho & 15; return 8 * (i >> 2) + 4 * n + (i & 3); }

struct Unit { int pm, pn, seg; };
struct Gemm { const bf16_t* A; const bf16_t* Bt; int M, N, K; };

struct StaticOrder {
    int nM, nN, nwg, G, c, probe = 0, ilo = 0, ihi = 1 << 30;
    __host__ __device__ void init(int M, int N, int G_, int c_) { nM = M / BM; nN = N / BM; nwg = nM * nN; G = G_; c = c_; }
    __host__ __device__ bool next(int i, Unit& u) const {
        i += ilo; if (i >= ihi) return false;
        const long L = (long)i * G + c; if (L >= nwg) return false;
        int wgid = (int)L; { const int q = nwg / NXCD, r = nwg % NXCD, xcd = wgid % NXCD, off = wgid / NXCD; wgid = (xcd < r ? xcd * (q + 1) : r * (q + 1) + (xcd - r) * q) + off; }
        const int nig = WGM * nN, gid = wgid / nig, fm = gid * WGM, gsz = (nM - fm) < WGM ? (nM - fm) : WGM;
        u.pm = fm + ((wgid % nig) % gsz); u.pn = (wgid % nig) / gsz; u.seg = 0; if (probe) { u.pm = 0; u.pn = 0; } return true;
    }
    __device__ __forceinline__ void a_ready(const Unit&) const {}
    __device__ __forceinline__ void done(const Unit&) const {}
    __device__ __forceinline__ const char* baseA(const Gemm& g, const Unit& u, size_t tstep) const { return (const char*)g.A + (size_t)u.pm * tstep; }
    __device__ __forceinline__ const char* baseB(const Gemm& g, const Unit& u, size_t tstep) const { return (const char*)g.Bt + (size_t)u.pn * tstep; }
    __device__ __forceinline__ bool zero_after(const Unit&) const { return true; }
};

template <class Epi, class Sched, bool STAMP = false>
__device__ __forceinline__ void gemm_phase(PG8_LAS unsigned char* lds, const Gemm g, const Sched& S, const Epi& E, unsigned long long* stamps) {
    int tid = threadIdx.x; asm volatile("" : "+v"(tid));
    const int wid = __builtin_amdgcn_readfirstlane(tid >> 6), lane = tid & 63, wr = wid >> 2, wc = wid & 3, fr = lane & 15, fq = lane >> 4;
    const int K = g.K, nt = K / BK;
    int ts_lo = 0, ts_hi = 0, nts = 0; const unsigned long long rt_entry = STAMP ? (unsigned long long)wall_clock64() : 0ull;
#define PG8_STAMP() do { if (STAMP && wid == 0 && nts < 64) { const unsigned long long _c = (unsigned long long)clock64(); \
        ts_lo = (lane == nts) ? (int)(unsigned)_c : ts_lo; ts_hi = (lane == nts) ? (int)(unsigned)(_c >> 32) : ts_hi; ++nts; } } while (0)
    PG8_STAMP();
    unsigned voffA[2], voffB[2];
#pragma unroll
    for (int i = 0; i < 2; ++i) { int R, C; stage_rc(tid * 16 + i * 8192, R, C); const int Rb = Epi::PERM ? ((R & ~31) + perm32(R & 31)) : R;
        voffA[i] = (unsigned)(R * K + C) * 2u; voffB[i] = (unsigned)(Rb * K + C) * 2u; }
    const size_t kstep = (size_t)(BK * 2);
    const size_t hstep = (size_t)HALF * K * 2;
    const size_t tstep = 2 * hstep;
    const unsigned ldsw = (unsigned)wid * 1024u;
    const int aoff = lds_byte(wr * 64 + fr, fq * 8), boff = lds_byte(wc * 32 + fr, fq * 8);
#define PG8_SA(b, h) (((b) * 2 + (h)) * HTB)
#define PG8_SB(b, h) ((4 + (b) * 2 + (h)) * HTB)
#define PG8_STAGE(bufoff, gbase, voff) do { _Pragma("unroll") for (int _i = 0; _i < 2; ++_i) \
        __builtin_amdgcn_global_load_lds((const unsigned*)((const char*)(gbase) + (voff)[_i]), (PG8_LAS unsigned*)(lds + (bufoff) + ldsw + _i * 8192), 16, 0, 0); } while (0)
#define PG8_LDA(dst, b, h) do { _Pragma("unroll") for (int m = 0; m < 4; ++m) _Pragma("unroll") for (int k = 0; k < 2; ++k) dst[m][k] = *(const PG8_LAS bf16x8*)(lds + PG8_SA(b, h) + aoff + m * 2048 + k * 1024); } while (0)
#define PG8_LDB(dst, b, h) do { _Pragma("unroll") for (int n = 0; n < 2; ++n) _Pragma("unroll") for (int k = 0; k < 2; ++k) dst[n][k] = *(const PG8_LAS bf16x8*)(lds + PG8_SB(b, h) + boff + n * 2048 + k * 1024); } while (0)
#define PG8_MMA(ai, bj, At, Bt) do { __builtin_amdgcn_s_setprio(1); _Pragma("unroll") for (int m = 0; m < 4; ++m) _Pragma("unroll") for (int n = 0; n < 2; ++n) _Pragma("unroll") for (int k = 0; k < 2; ++k) \
        acc[ai][bj][m][n] = __builtin_amdgcn_mfma_f32_16x16x32_bf16(Bt[n][k], At[m][k], acc[ai][bj][m][n], 0, 0, 0); __builtin_amdgcn_s_setprio(0); } while (0)
#define PG8_WAIT_V(n) asm volatile("s_waitcnt vmcnt(" #n ")" ::: "memory")
#define PG8_WAIT_L(n) asm volatile("s_waitcnt lgkmcnt(" #n ")" ::: "memory")
#define PG8_BAR __builtin_amdgcn_s_barrier()
#define PG8_SCHED __builtin_amdgcn_sched_barrier(0)
    Unit cur, nxt; int ui = 0;
    if (!S.next(0, cur)) return;
    f32x4 acc[2][2][4][2];
#pragma unroll
    for (int a = 0; a < 2; ++a)
#pragma unroll
        for (int b = 0; b < 2; ++b)
#pragma unroll
            for (int m = 0; m < 4; ++m)
#pragma unroll
                for (int n = 0; n < 2; ++n) acc[a][b][m][n] = (f32x4){0.f, 0.f, 0.f, 0.f};
    bf16x8 At[4][2], B0[2][2], B1[2][2];
    const char* cA = S.baseA(g, cur, tstep); const char* cB = S.baseB(g, cur, tstep);
    S.a_ready(cur);
    PG8_STAGE(PG8_SB(0, 0), cB, voffB); PG8_STAGE(PG8_SA(0, 0), cA, voffA); PG8_STAGE(PG8_SB(0, 1), cB + hstep, voffB); PG8_STAGE(PG8_SA(0, 1), cA + hstep, voffA);
    if (wr == 1) PG8_BAR;
    PG8_WAIT_V(4); PG8_BAR;
    PG8_STAGE(PG8_SB(1, 0), cB + kstep, voffB); PG8_STAGE(PG8_SA(1, 0), cA + kstep, voffA); PG8_STAGE(PG8_SB(1, 1), cB + hstep + kstep, voffB);
    PG8_WAIT_V(6); PG8_BAR;
    PG8_STAMP();
    for (;;) {
        const bool has_next = S.next(ui + 1, nxt);
        const char* nA = has_next ? S.baseA(g, nxt, tstep) : cA; const char* nB = has_next ? S.baseB(g, nxt, tstep) : cB;
        for (int t = 0; t < nt; t += 2) {
            const bool last = (t == nt - 2);
            const char* a1 = cA + (size_t)(t + 1) * kstep;
            const char* a2 = last ? nA : cA + (size_t)(t + 2) * kstep; const char* b2 = last ? nB : cB + (size_t)(t + 2) * kstep;
            const char* a3 = a2 + kstep; const char* b3 = b2 + kstep;
            if (last && has_next) S.a_ready(nxt);
            PG8_LDB(B0, 0, 0); PG8_SCHED; PG8_LDA(At, 0, 0); PG8_STAGE(PG8_SA(1, 1), a1 + hstep, voffA);
            PG8_WAIT_L(8); PG8_BAR; PG8_WAIT_L(0); PG8_MMA(0, 0, At, B0); PG8_BAR; PG8_SCHED;
            PG8_LDB(B1, 0, 1); PG8_STAGE(PG8_SB(0, 0), b2, voffB);
            PG8_BAR; PG8_WAIT_L(0); PG8_MMA(0, 1, At, B1); PG8_BAR;
            PG8_LDA(At, 0, 1); PG8_STAGE(PG8_SA(0, 0), a2, voffA);
            PG8_BAR; PG8_WAIT_L(0); PG8_MMA(1, 0, At, B0); PG8_BAR; PG8_SCHED;
            PG8_STAGE(PG8_SB(0, 1), b2 + hstep, voffB);
            PG8_WAIT_V(6); PG8_BAR; PG8_MMA(1, 1, At, B1); PG8_BAR;
            PG8_LDB(B0, 1, 0); PG8_SCHED; PG8_LDA(At, 1, 0); PG8_STAGE(PG8_SA(0, 1), a2 + hstep, voffA);
            PG8_WAIT_L(8); PG8_BAR; PG8_WAIT_L(0); PG8_MMA(0, 0, At, B0); PG8_BAR; PG8_SCHED;
            PG8_LDB(B1, 1, 1); PG8_STAGE(PG8_SB(1, 0), b3, voffB);
            PG8_BAR; PG8_WAIT_L(0); PG8_MMA(0, 1, At, B1); PG8_BAR;
            PG8_LDA(At, 1, 1); PG8_STAGE(PG8_SA(1, 0), a3, voffA);
            PG8_BAR; PG8_WAIT_L(0); PG8_MMA(1, 0, At, B0); PG8_BAR; PG8_SCHED;
            PG8_STAGE(PG8_SB(1, 1), b3 + hstep, voffB);
            PG8_WAIT_V(6); PG8_BAR; PG8_MMA(1, 1, At, B1); PG8_BAR;
        }
        PG8_STAMP();
        if constexpr (!Epi::AFTER_DRAIN) { E(acc, cur, wr, wc, fr, fq); S.done(cur); }
        PG8_STAMP();
        if (!has_next) break;
        if (S.zero_after(cur))
#pragma unroll
        for (int a = 0; a < 2; ++a)
#pragma unroll
            for (int b = 0; b < 2; ++b)
#pragma unroll
                for (int m = 0; m < 4; ++m)
#pragma unroll
                    for (int n = 0; n < 2; ++n) acc[a][b][m][n] = (f32x4){0.f, 0.f, 0.f, 0.f};
        cur = nxt; cA = nA; cB = nB; ++ui;
    }
    PG8_WAIT_V(0);
    if (wr == 0) PG8_BAR;
    PG8_BAR;
    if constexpr (Epi::AFTER_DRAIN) { E.fused(acc, cur, wr, wc, fr, fq, lds, wid, lane); S.done(cur); }
    PG8_STAMP();
    if (STAMP && wid == 0) { stamps[lane] = lane < nts ? (((unsigned long long)(unsigned)ts_hi << 32) | (unsigned)ts_lo) : 0ull;
        if (lane == 62) stamps[62] = rt_entry; if (lane == 63) stamps[63] = (unsigned long long)wall_clock64(); }
#undef PG8_STAMP
#undef PG8_SA
#undef PG8_SB
#undef PG8_STAGE
#undef PG8_LDA
#undef PG8_LDB
#undef PG8_MMA
#undef PG8_WAIT_V
#undef PG8_WAIT_L
#undef PG8_BAR
#undef PG8_SCHED
}
}

typedef unsigned short u16;
typedef short bf16x8 __attribute__((ext_vector_type(8)));
typedef float f32x16 __attribute__((ext_vector_type(16)));
typedef float f32x4 __attribute__((ext_vector_type(4)));
typedef __bf16 bf2_t __attribute__((ext_vector_type(2)));
typedef float f2_t __attribute__((ext_vector_type(2)));
typedef unsigned u32x4 __attribute__((ext_vector_type(4)));
typedef unsigned u32x2 __attribute__((ext_vector_type(2)));
using pg8::Unit;

#define DI __device__ __forceinline__
#define MFMA32(a, b, c) __builtin_amdgcn_mfma_f32_32x32x16_bf16((a), (b), (c), 0, 0, 0)

constexpr int DM = 1024, SEQ = 4096, NBATCH = 8, T = NBATCH * SEQ;
constexpr int NCH = 2, BC = NBATCH / NCH, TC = BC * SEQ;
constexpr int INC = 7552, DMLP = 4096;
constexpr int NQKG = 6656;
constexpr int NQKH = 38, NVH = 16;
constexpr float LOG2E = 1.4426950408889634f;
constexpr int NTHR = 512;

constexpr size_t al256(size_t x) { return (x + 255) & ~(size_t)255; }
constexpr size_t OFF_WQKG = 0;
constexpr size_t OFF_WV   = OFF_WQKG + al256((size_t)2 * NQKG * DM * 2);
constexpr size_t OFF_WBR5 = OFF_WV   + al256((size_t)2 * DM * DM * 2);
constexpr size_t OFF_WOUT = OFF_WBR5 + al256((size_t)2 * 5 * DM * 256 * 2);
constexpr size_t OFF_WUP  = OFF_WOUT + al256((size_t)2 * DM * DM * 2);
constexpr size_t OFF_WDN  = OFF_WUP  + al256((size_t)2 * DMLP * DM * 2);
constexpr size_t OFF_ROPE = OFF_WDN  + al256((size_t)2 * DM * DMLP * 2);
constexpr size_t OFF_XB   = OFF_ROPE + al256((size_t)(SEQ + 1) * 96 * 4);
constexpr size_t OFF_SSQ  = OFF_XB   + al256((size_t)T * DM * 2);
constexpr size_t OFF_QK   = OFF_SSQ  + al256((size_t)T * 16 * 4);
constexpr size_t OFF_V    = OFF_QK   + al256((size_t)NQKH * TC * 64 * 2);
constexpr size_t OFF_GATE = OFF_V    + al256((size_t)NVH * TC * 64 * 2);
constexpr size_t OFF_Y5   = OFF_GATE + al256((size_t)TC * 4096 * 2);
constexpr size_t OFF_BO   = OFF_Y5   + al256((size_t)5 * TC * 256 * 2);
constexpr size_t OFF_LSE  = OFF_BO   + al256((size_t)TC * 384 * 2);
constexpr size_t OFF_MRG  = OFF_LSE  + al256((size_t)TC * 8 * 4);
constexpr size_t OFF_BAR  = OFF_MRG  + al256((size_t)TC * DM * 2);
constexpr size_t WS_END   = OFF_BAR  + 16384;
static_assert(WS_END <= (size_t)512 * 1024 * 1024, "workspace too large");

constexpr int LDS_STAGE = 131072;
constexpr int VT_STRIDE = 528;
constexpr int LDS_XBW = 256 * VT_STRIDE;
constexpr int LDS_BYTES = LDS_XBW + 64 + 1024;
constexpr int PPL = (DUPK >= 0) ? 7 : 6;
constexpr int NPHASE = 1 + NCH * 2 * PPL;

struct Params {
  const float* in[19];
  float* out;
  unsigned char* ws;
  int ph_lo, ph_hi;
};

DI unsigned pk2(float a, float b) { f2_t v = {a, b}; bf2_t r = __builtin_convertvector(v, bf2_t); return __builtin_bit_cast(unsigned, r); }
DI float bf_lo(unsigned u) { return __uint_as_float(u << 16); }
DI float bf_hi(unsigned u) { return __uint_as_float(u & 0xffff0000u); }
DI float fexp2(float x) { return __builtin_amdgcn_exp2f(x); }
DI int crow(int i, int h) { return (i & 3) + 8 * (i >> 2) + 4 * h; }
DI bf16x8 as_bf8(u32x4 v) { return __builtin_bit_cast(bf16x8, v); }
DI int dil_of(int gi) { return gi == 0 ? 1 : (gi == 1 ? 4 : 16); }
DI int dlg_of(int gi) { return gi * 2; }
DI float row_rscale(const float* ssq, size_t tok) {
  const f32x4 a = *(const f32x4*)(ssq + tok * 16), b = *(const f32x4*)(ssq + tok * 16 + 4);
  const f32x4 c = *(const f32x4*)(ssq + tok * 16 + 8), d = *(const f32x4*)(ssq + tok * 16 + 12);
  const float s = ((a[0] + a[1]) + (a[2] + a[3])) + ((b[0] + b[1]) + (b[2] + b[3])) + ((c[0] + c[1]) + (c[2] + c[3])) + ((d[0] + d[1]) + (d[2] + d[3]));
  return rsqrtf(s * (1.0f / 1024.0f) + 1e-6f);
}
DI int qk_head_col(int h) {
  if (h < 8) return 64 * h;
  if (h < 10) return 512 + 64 * (h - 8);
  if (h < 16) return 768 + 64 * (h - 10);
  if (h < 22) return 1152 + 64 * (h - 16);
  if (h < 26) return 1920 + 64 * (h - 22);
  if (h < 30) return 2176 + 64 * (h - 26);
  if (h < 34) return 2688 + 64 * (h - 30);
  return 2944 + 64 * (h - 34);
}
DI int v_head_col(int vh) {
  if (vh < 2) return 640 + 64 * vh;
  if (vh < 8) return 1536 + 64 * (vh - 2);
  if (vh < 12) return 2432 + 64 * (vh - 8);
  return 3200 + 64 * (vh - 12);
}

struct EpiQKG {
  static constexpr bool PERM = true, AFTER_DRAIN = false;
  const float* ssq; u16* qk; const float* rope; const float* gA; const float* gB; const float* gC; const float* gD;
  DI void body64(const f32x4 (&acc)[2][2][4][2], const Unit& u, int wr, int fr, int fq, unsigned goff, const float* gainl, float qpre, int dlg, int rope_on) const {
#pragma unroll
    for (int ai = 0; ai < 2; ++ai) {
#pragma unroll
      for (int m = 0; m < 4; ++m) {
        const int tok = u.pm * 256 + 128 * ai + 64 * wr + 16 * m + fr;
        const int bl = tok >> 12, pos = tok & 4095;
        const float rs = row_rscale(ssq, tok);
        const int pdom = ((pos & ((1 << dlg) - 1)) << (12 - dlg)) + (pos >> dlg);
        const int blk = pdom >> 5, rr = pdom & 31;
        const unsigned boff = goff + (unsigned)bl * (SEQ * 64) + (unsigned)(((blk * 4 + (fq >> 1)) * 64 + (fq & 1) * 32 + rr) * 8);
        const float* rp = rope + (unsigned)((rope_on ? pos : SEQ) * 96 + 8 * fq);
        float ss = 0.f;
#pragma unroll
        for (int bj = 0; bj < 2; ++bj)
#pragma unroll
          for (int n = 0; n < 2; ++n)
#pragma unroll
            for (int e = 0; e < 4; ++e) ss += acc[ai][bj][m][n][e] * acc[ai][bj][m][n][e];
        ss += __shfl_xor(ss, 16); ss += __shfl_xor(ss, 32);
        const float sc = rs * rsqrtf(ss * rs * rs * (1.0f / 64.0f) + 1e-6f) * qpre;
        u32x4 w0, w1;
#pragma unroll
        for (int n = 0; n < 2; ++n) {
          const f32x4 xa = acc[ai][0][m][n] * sc * *(const f32x4*)(gainl + 4 * n);
          const f32x4 xb2 = acc[ai][1][m][n] * sc * *(const f32x4*)(gainl + 32 + 4 * n);
          const f32x4 c4 = *(const f32x4*)(rp + 4 * n);
          const f32x4 s4 = *(const f32x4*)(rp + 32 + 4 * n);
          const f32x4 ta = xa * c4 - xb2 * s4, tb = xb2 * c4 + xa * s4;
          w0[2 * n] = pk2(ta[0], ta[1]); w0[2 * n + 1] = pk2(ta[2], ta[3]);
          w1[2 * n] = pk2(tb[0], tb[1]); w1[2 * n + 1] = pk2(tb[2], tb[3]);
        }
        *(u32x4*)(qk + boff) = w0;
        *(u32x4*)(qk + boff + 2 * 64 * 8) = w1;
        asm volatile("" ::: "memory");
      }
    }
  }
  DI void body32(const f32x4 (&acc)[2][2][4][2], const Unit& u, int wr, int fr, int fq, unsigned goff, const float* gainl, float qpre) const {
    const float sgn = (fq < 2) ? -1.0f : 1.0f;
#pragma unroll
    for (int ai = 0; ai < 2; ++ai) {
#pragma unroll
      for (int m = 0; m < 4; ++m) {
        const int tok = u.pm * 256 + 128 * ai + 64 * wr + 16 * m + fr;
        const int bl = tok >> 12, pos = tok & 4095;
        const float rs = row_rscale(ssq, tok);
        const int blk = pos >> 5, rr = pos & 31;
        const unsigned boff = goff + (unsigned)bl * (SEQ * 64) + (unsigned)(((blk * 2 + (fq >> 1)) * 64 + (fq & 1) * 32 + rr) * 8);
        const float* rp = rope + (unsigned)(pos * 96 + 64 + 8 * (fq & 1));
#pragma unroll
        for (int bj = 0; bj < 2; ++bj) {
          float ss = 0.f;
#pragma unroll
          for (int n = 0; n < 2; ++n)
#pragma unroll
            for (int e = 0; e < 4; ++e) ss += acc[ai][bj][m][n][e] * acc[ai][bj][m][n][e];
          ss += __shfl_xor(ss, 16); ss += __shfl_xor(ss, 32);
          const float sc = rs * rsqrtf(ss * rs * rs * (1.0f / 32.0f) + 1e-6f) * qpre;
          u32x4 w;
#pragma unroll
          for (int n = 0; n < 2; ++n) {
            const f32x4 x = acc[ai][bj][m][n] * sc * *(const f32x4*)(gainl + 4 * n);
            const f32x4 c4 = *(const f32x4*)(rp + 4 * n);
            const f32x4 s4 = *(const f32x4*)(rp + 16 + 4 * n);
            f32x4 pr;
#pragma unroll
            for (int e = 0; e < 4; ++e) pr[e] = __shfl_xor(x[e], 32);
            const f32x4 o = x * c4 + pr * s4 * sgn;
            w[2 * n] = pk2(o[0], o[1]); w[2 * n + 1] = pk2(o[2], o[3]);
          }
          *(u32x4*)(qk + boff + (unsigned)bj * (SEQ * 32)) = w;
        }
        asm volatile("" ::: "memory");
      }
    }
  }
  DI void operator()(const f32x4 (&acc)[2][2][4][2], const Unit& u, int wr, int wc, int fr, int fq) const {
    const int hidx = u.pn * 4 + wc;
    if (hidx >= NQKH) return;
    int kind, dlg = 0; const float* gain;
    if (hidx < 8) { kind = 0; gain = gA; }
    else if (hidx < 10) { kind = 0; gain = gA + 64; }
    else if (hidx < 16) { kind = 0; gain = gB; dlg = dlg_of((hidx - 10) >> 1); }
    else if (hidx < 22) { kind = 0; gain = gB + 64; dlg = dlg_of((hidx - 16) >> 1); }
    else if (hidx < 26) { kind = 2; gain = gC; }
    else if (hidx < 30) { kind = 2; gain = gC + 32; }
    else if (hidx < 34) { kind = 1; gain = gD; }
    else { kind = 1; gain = gD + 64; }
    const unsigned goff = (unsigned)hidx * (unsigned)(TC * 64);
    const float* gainl = gain + 8 * fq;
    const float qpre = (hidx >= 22 && hidx < 26) ? (0.17677669529663687f * LOG2E)
                     : ((hidx < 8 || (hidx >= 10 && hidx < 16) || (hidx >= 30 && hidx < 34)) ? (0.125f * LOG2E) : 1.0f);
    if (kind == 2) body32(acc, u, wr, fr, fq, goff, gainl, qpre);
    else body64(acc, u, wr, fr, fq, goff, gainl, qpre, dlg, kind == 0 ? 1 : 0);
  }
};

struct EpiGateUp {
  static constexpr bool PERM = true, AFTER_DRAIN = false;
  const float* ssq; u16* o; int mode;
  template <bool UP>
  DI void body(const f32x4 (&acc)[2][2][4][2], const Unit& u, int wr, int wc, int fr, int fq) const {
    const int c0 = u.pn * 256 + 32 * wc + 8 * fq;
    float rsv[8];
#pragma unroll
    for (int i = 0; i < 8; ++i) rsv[i] = row_rscale(ssq, (size_t)u.pm * 256 + 128 * (i >> 2) + 64 * wr + 16 * (i & 3) + fr);
#pragma unroll
    for (int ai = 0; ai < 2; ++ai)
#pragma unroll
      for (int m = 0; m < 4; ++m) {
        const size_t tok = (size_t)u.pm * 256 + 128 * ai + 64 * wr + 16 * m + fr;
        const float rs = rsv[ai * 4 + m];
#pragma unroll
        for (int bj = 0; bj < 2; ++bj) {
          float r[8];
#pragma unroll
          for (int n = 0; n < 2; ++n) {
            const f32x4 v = acc[ai][bj][m][n] * rs;
#pragma unroll
            for (int e = 0; e < 4; ++e) {
              if (UP) { const float z = fmaxf(v[e], 0.f); r[4 * n + e] = z * z; }
              else r[4 * n + e] = __builtin_amdgcn_rcpf(1.0f + fexp2(-LOG2E * v[e]));
            }
          }
          u32x4 w = {pk2(r[0], r[1]), pk2(r[2], r[3]), pk2(r[4], r[5]), pk2(r[6], r[7])};
          *(u32x4*)(o + tok * 4096 + c0 + 128 * bj) = w;
        }
        asm volatile("" ::: "memory");
      }
  }
  DI void operator()(const f32x4 (&acc)[2][2][4][2], const Unit& u, int wr, int wc, int fr, int fq) const {
    if (mode == 2) return;
    if (mode == 1) body<true>(acc, u, wr, wc, fr, fq);
    else body<false>(acc, u, wr, wc, fr, fq);
  }
};

struct EpiVT {
  static constexpr bool PERM = false, AFTER_DRAIN = true;
  const float* ssq; u16* vbuf;
  DI void operator()(const f32x4 (&)[2][2][4][2], const Unit&, int, int, int, int) const {}
  DI void fused(const f32x4 (&acc)[2][2][4][2], const Unit& u, int wr, int wc, int fr, int fq, PG8_LAS unsigned char* lds, int wid, int lane) const {
    PG8_LAS float* rsl = (PG8_LAS float*)(lds + 256 * VT_STRIDE + 64);
    {
      const int t = wid * 64 + lane;
      if (t < 256) rsl[t] = row_rscale(ssq, (size_t)u.pn * 256 + t);
    }
    __syncthreads();
#pragma unroll
    for (int ai = 0; ai < 2; ++ai)
#pragma unroll
      for (int m = 0; m < 4; ++m) {
        const int r = 128 * ai + 64 * wr + 16 * m + fr;
#pragma unroll
        for (int bj = 0; bj < 2; ++bj)
#pragma unroll
          for (int n = 0; n < 2; ++n) {
            const f32x4 v = acc[ai][bj][m][n] * *(const PG8_LAS f32x4*)(rsl + 128 * bj + 32 * wc + 16 * n + 4 * fq);
            u32x2 w = {pk2(v[0], v[1]), pk2(v[2], v[3])};
            *(PG8_LAS u32x2*)(lds + r * VT_STRIDE + (128 * bj + 32 * wc + 16 * n + 4 * fq) * 2) = w;
          }
      }
    __syncthreads();
    const int tid = wid * 64 + lane;
    const int bl = (u.pn * 256) >> 12, pos0 = (u.pn * 256) & 4095;
#pragma unroll 1
    for (int it = 0; it < 16; ++it) {
      const int uidx = it * 512 + tid;
      const int dvlo = uidx & 31, hh = (uidx >> 5) & 1, rb = (uidx >> 6) & 1, half = (uidx >> 7) & 15, h = uidx >> 11;
      const int vgrp = u.pm * 4 + h;
      const int dlg = (vgrp >= 2 && vgrp < 8) ? dlg_of((vgrp - 2) >> 1) : 0;
      const int cls = half >> (4 - dlg), hc = half & ((16 >> dlg) - 1);
      const int m0 = pos0 >> dlg, mh = m0 + 16 * hc;
      const int s = (mh >> 4) & 1, dblk = cls * (128 >> dlg) + (mh >> 5);
      const PG8_LAS unsigned char* row = lds + (h * 64 + rb * 32 + dvlo) * VT_STRIDE;
      unsigned short k8[8];
#pragma unroll
      for (int j = 0; j < 8; ++j) {
        const int tau = ((16 * hc + 4 * hh + (j & 3) + 8 * (j >> 2)) << dlg) + cls;
        k8[j] = *(const PG8_LAS unsigned short*)(row + tau * 2);
      }
      u32x4 w = {(unsigned)k8[0] | ((unsigned)k8[1] << 16), (unsigned)k8[2] | ((unsigned)k8[3] << 16),
                 (unsigned)k8[4] | ((unsigned)k8[5] << 16), (unsigned)k8[6] | ((unsigned)k8[7] << 16)};
      u16* dst = vbuf + (size_t)vgrp * TC * 64 + (size_t)bl * SEQ * 64 + ((size_t)((dblk * 2 + rb) * 2 + s) * 64 + hh * 32 + dvlo) * 8;
      *(u32x4*)dst = w;
    }
    __syncthreads();
  }
};

struct MergeOrder : pg8::StaticOrder {
  const u16* ybase; const u16* wbase;
  DI bool next(int i, Unit& u) const { if (i >= 5) return false; if (!pg8::StaticOrder::next(0, u)) return false; u.seg = i; return true; }
  DI const char* baseA(const pg8::Gemm&, const Unit& u, size_t tstep) const { return (const char*)(ybase + (size_t)u.seg * TC * 256) + (size_t)u.pm * tstep; }
  DI const char* baseB(const pg8::Gemm&, const Unit& u, size_t tstep) const { return (const char*)(wbase + (size_t)u.seg * DM * 256) + (size_t)u.pn * tstep; }
  DI bool zero_after(const Unit& u) const { return u.seg == 4; }
};
struct EpiMerge {
  static constexpr bool PERM = true, AFTER_DRAIN = false;
  const u16* gate; u16* mrg;
  DI void operator()(f32x4 (&acc)[2][2][4][2], const Unit& u, int wr, int wc, int fr, int fq) const {
    const int seg = u.seg;
    if (seg == 0) return;
    const bool last = (seg == 4);
    const int gnum = last ? 3 : seg - 1, gden = last ? 3 : seg;
    const u16* gnp = gate + ((size_t)u.pm * 256 + 64 * wr + fr) * 4096 + gnum * 1024 + u.pn * 256 + 32 * wc + 8 * fq;
    const u16* gdp = gate + ((size_t)u.pm * 256 + 64 * wr + fr) * 4096 + gden * 1024 + u.pn * 256 + 32 * wc + 8 * fq;
    u32x4 gn, gd, gnn, gdn;
    gn = *(const u32x4*)gnp; gd = *(const u32x4*)gdp;
#pragma unroll
    for (int i = 0; i < 16; ++i) {
      const int ai = i >> 3, m = (i >> 1) & 3, bj = i & 1;
      if (i < 15) {
        const int i2 = i + 1;
        const size_t ro = (size_t)(128 * (i2 >> 3) + 16 * ((i2 >> 1) & 3)) * 4096 + 128 * (i2 & 1);
        gnn = *(const u32x4*)(gnp + ro); gdn = *(const u32x4*)(gdp + ro);
      }
      asm volatile("" ::: "memory");
#pragma unroll
      for (int n = 0; n < 2; ++n) {
        f32x4 f;
        f[0] = bf_lo(gn[2 * n]); f[1] = bf_hi(gn[2 * n]); f[2] = bf_lo(gn[2 * n + 1]); f[3] = bf_hi(gn[2 * n + 1]);
        if (!last) {
          f[0] *= __builtin_amdgcn_rcpf(bf_lo(gd[2 * n])); f[1] *= __builtin_amdgcn_rcpf(bf_hi(gd[2 * n]));
          f[2] *= __builtin_amdgcn_rcpf(bf_lo(gd[2 * n + 1])); f[3] *= __builtin_amdgcn_rcpf(bf_hi(gd[2 * n + 1]));
        }
        acc[ai][bj][m][n] *= f;
      }
      if (last) {
        const size_t tok = (size_t)u.pm * 256 + 128 * ai + 64 * wr + 16 * m + fr;
        const int c = u.pn * 256 + 128 * bj + 32 * wc + 8 * fq;
        const f32x4 v0 = acc[ai][bj][m][0], v1 = acc[ai][bj][m][1];
        u32x4 w = {pk2(v0[0], v0[1]), pk2(v0[2], v0[3]), pk2(v1[0], v1[1]), pk2(v1[2], v1[3])};
        *(u32x4*)(mrg + tok * DM + c) = w;
      }
      gn = gnn; gd = gdn;
    }
  }
};

struct EpiResid {
  static constexpr bool PERM = true, AFTER_DRAIN = false;
  float* xout; u16* xb; float* ssq; int wf32;
  DI void operator()(const f32x4 (&acc)[2][2][4][2], const Unit& u, int wr, int wc, int fr, int fq) const {
    const size_t o0 = ((size_t)u.pm * 256 + 64 * wr + fr) * DM + u.pn * 256 + 32 * wc + 8 * fq;
    u32x4 xo, xn;
    xo = *(const u32x4*)(xb + o0);
    float ss = 0.f;
#pragma unroll
    for (int i = 0; i < 16; ++i) {
      const int ai = i >> 3, m = (i >> 1) & 3, bj = i & 1;
      if (i < 15) {
        const int i2 = i + 1;
        xn = *(const u32x4*)(xb + o0 + (size_t)(128 * (i2 >> 3) + 16 * ((i2 >> 1) & 3)) * DM + 128 * (i2 & 1));
      }
      asm volatile("" ::: "memory");
      const size_t tok = (size_t)u.pm * 256 + 128 * ai + 64 * wr + 16 * m + fr;
      const size_t o = tok * DM + u.pn * 256 + 128 * bj + 32 * wc + 8 * fq;
      f32x4 v0 = acc[ai][bj][m][0], v1 = acc[ai][bj][m][1];
      v0[0] += bf_lo(xo[0]); v0[1] += bf_hi(xo[0]); v0[2] += bf_lo(xo[1]); v0[3] += bf_hi(xo[1]);
      v1[0] += bf_lo(xo[2]); v1[1] += bf_hi(xo[2]); v1[2] += bf_lo(xo[3]); v1[3] += bf_hi(xo[3]);
      if (wf32) { *(f32x4*)(xout + o) = v0; *(f32x4*)(xout + o + 4) = v1; }
      if (!wf32) {
        u32x4 w = {pk2(v0[0], v0[1]), pk2(v0[2], v0[3]), pk2(v1[0], v1[1]), pk2(v1[2], v1[3])};
        *(u32x4*)(xb + o) = w;
      }
      ss += ((v0[0] * v0[0] + v0[1] * v0[1]) + (v0[2] * v0[2] + v0[3] * v0[3])) + ((v1[0] * v1[0] + v1[1] * v1[1]) + (v1[2] * v1[2] + v1[3] * v1[3]));
      if (bj == 1) {
        ss += __shfl_xor(ss, 16); ss += __shfl_xor(ss, 32);
        if (fq == 0 && !wf32) ssq[tok * 16 + u.pn * 4 + wc] = ss;
        ss = 0.f;
      }
      xo = xn;
    }
  }
};

template <class Epi>
DI void run_merge(PG8_LAS unsigned char* lds, const u16* ybase, const u16* wbase, const Epi& E) {
  int K = 256; asm volatile("" : "+s"(K));
  pg8::Gemm g; g.A = ybase; g.Bt = wbase; g.M = TC; g.N = DM; g.K = K;
  MergeOrder S; S.init(TC, DM, (int)gridDim.x, (int)blockIdx.x); S.ybase = ybase; S.wbase = wbase;
  pg8::gemm_phase<Epi, MergeOrder, false>(lds, g, S, E, nullptr);
}
template <class Epi>
DI void run_gemm(PG8_LAS unsigned char* lds, const u16* A, const u16* Bt, int M, int N, int K, const Epi& E, int probe = 0, int ilo = 0, int ihi = 1 << 30) {
  asm volatile("" : "+s"(K));
  pg8::Gemm g; g.A = A; g.Bt = Bt; g.M = M; g.N = N; g.K = K;
  pg8::StaticOrder S; S.init(M, N, (int)gridDim.x, (int)blockIdx.x); S.probe = probe; S.ilo = ilo; S.ihi = ihi;
  pg8::gemm_phase<Epi, pg8::StaticOrder, false>(lds, g, S, E, nullptr);
}

DI void cvt_load(const float* __restrict__ src, int N, int k0, int n0, const float* __restrict__ g, float* t, int ht) {
  const int c4 = (ht & 15) * 4;
#pragma unroll
  for (int i = 0; i < 4; ++i) {
    const int kk = (ht >> 4) + 16 * i;
    f32x4 v = *(const f32x4*)(src + (size_t)(k0 + kk) * N + n0 + c4);
    const float sc = g ? g[k0 + kk] : 1.0f;
    t[kk * 65 + c4 + 0] = v[0] * sc; t[kk * 65 + c4 + 1] = v[1] * sc; t[kk * 65 + c4 + 2] = v[2] * sc; t[kk * 65 + c4 + 3] = v[3] * sc;
  }
}
DI void cvt_store(u16* __restrict__ dst, int ldk, int kdst, int d0, int d1, const float* t, int ht) {
  const int kc = (ht & 7) * 8, nn = ht >> 3;
#pragma unroll
  for (int i = 0; i < 2; ++i) {
    const int tn = nn + 32 * i, row = (i == 0) ? d0 + nn : d1 + nn;
    u32x4 w;
    w[0] = pk2(t[(kc + 0) * 65 + tn], t[(kc + 1) * 65 + tn]);
    w[1] = pk2(t[(kc + 2) * 65 + tn], t[(kc + 3) * 65 + tn]);
    w[2] = pk2(t[(kc + 4) * 65 + tn], t[(kc + 5) * 65 + tn]);
    w[3] = pk2(t[(kc + 6) * 65 + tn], t[(kc + 7) * 65 + tn]);
    *(u32x4*)(dst + (size_t)row * ldk + kdst + kc) = w;
  }
}
struct CvtJob { const float* src; int N, k0, n0; const float* g; u16* dst; int ldk, d0, d1, kd; };
DI CvtJob cvt_job(const Params& p, int l, int ti) {
  CvtJob j; j.g = nullptr; j.kd = -1;
  const float* attn_g = p.in[1] + l * DM;
  if (ti < 608) { const int h = ti >> 4, kt = ti & 15; j.src = p.in[2] + (size_t)l * DM * INC; j.N = INC; j.k0 = kt * 64; j.n0 = qk_head_col(h); j.g = attn_g;
    j.dst = (u16*)(p.ws + OFF_WQKG) + (size_t)l * NQKG * DM; j.ldk = DM; j.d0 = (h >> 2) * 256 + (h & 3) * 32; j.d1 = j.d0 + 128; return j; }
  ti -= 608;
  if (ti < 1024) { const int c = ti >> 4, kt = ti & 15; j.src = p.in[2] + (size_t)l * DM * INC; j.N = INC; j.k0 = kt * 64; j.n0 = 3456 + 64 * c; j.g = attn_g;
    j.dst = (u16*)(p.ws + OFF_WQKG) + (size_t)l * NQKG * DM; j.ldk = DM; j.d0 = 2560 + 64 * c; j.d1 = j.d0 + 32; return j; }
  ti -= 1024;
  if (ti < 256) { const int vh = ti >> 4, kt = ti & 15; j.src = p.in[2] + (size_t)l * DM * INC; j.N = INC; j.k0 = kt * 64; j.n0 = v_head_col(vh); j.g = attn_g;
    j.dst = (u16*)(p.ws + OFF_WV) + (size_t)l * DM * DM; j.ldk = DM; j.d0 = vh * 64; j.d1 = j.d0 + 32; return j; }
  ti -= 256;
  if (ti < 128) { j.src = p.in[11] + (size_t)l * 512 * DM; j.N = DM; j.k0 = (ti >> 4) * 64; j.n0 = (ti & 15) * 64; j.dst = (u16*)(p.ws + OFF_WBR5) + ((size_t)l * 5 + (j.k0 >> 8)) * DM * 256; j.ldk = 256; j.kd = j.k0 & 255; j.d0 = j.n0; j.d1 = j.n0 + 32; return j; }
  ti -= 128;
  if (ti < 32) { j.src = p.in[12] + (size_t)l * 128 * DM; j.N = DM; j.k0 = (ti >> 4) * 64; j.n0 = (ti & 15) * 64; j.dst = (u16*)(p.ws + OFF_WBR5) + ((size_t)l * 5 + 2) * DM * 256; j.ldk = 256; j.kd = j.k0; j.d0 = j.n0; j.d1 = j.n0 + 32; return j; }
  ti -= 32;
  if (ti < 64) { j.src = p.in[13] + (size_t)l * 256 * DM; j.N = DM; j.k0 = (ti >> 4) * 64; j.n0 = (ti & 15) * 64; j.dst = (u16*)(p.ws + OFF_WBR5) + ((size_t)l * 5 + 3) * DM * 256; j.ldk = 256; j.kd = j.k0; j.d0 = j.n0; j.d1 = j.n0 + 32; return j; }
  ti -= 64;
  if (ti < 64) { j.src = p.in[14] + (size_t)l * 256 * DM; j.N = DM; j.k0 = (ti >> 4) * 64; j.n0 = (ti & 15) * 64; j.dst = (u16*)(p.ws + OFF_WBR5) + ((size_t)l * 5 + 4) * DM * 256; j.ldk = 256; j.kd = j.k0; j.d0 = j.n0; j.d1 = j.n0 + 32; return j; }
  ti -= 64;
  if (ti < 256) { j.src = p.in[15] + (size_t)l * DM * DM; j.N = DM; j.k0 = (ti >> 4) * 64; j.n0 = (ti & 15) * 64; j.dst = (u16*)(p.ws + OFF_WOUT) + (size_t)l * DM * DM; j.ldk = DM; j.d0 = j.n0; j.d1 = j.n0 + 32; return j; }
  ti -= 256;
  if (ti < 1024) { j.src = p.in[17] + (size_t)l * DM * DMLP; j.N = DMLP; j.k0 = (ti >> 6) * 64; j.n0 = (ti & 63) * 64; j.g = p.in[16] + l * DM;
    j.dst = (u16*)(p.ws + OFF_WUP) + (size_t)l * DMLP * DM; j.ldk = DM; j.d0 = j.n0; j.d1 = j.n0 + 32; return j; }
  ti -= 1024;
  j.src = p.in[18] + (size_t)l * DMLP * DM; j.N = DM; j.k0 = (ti >> 4) * 64; j.n0 = (ti & 15) * 64; j.dst = (u16*)(p.ws + OFF_WDN) + (size_t)l * DM * DMLP; j.ldk = DMLP; j.d0 = j.n0; j.d1 = j.n0 + 32; return j;
}

__device__ void phase_prep(const Params& p, int tid_, int bid_, int nblk_, unsigned char* smem) {
  const int half = tid_ >> 8, ht = tid_ & 255;
  float* t = (float*)smem + half * (64 * 65);
  const int per_layer = 4480, total = 2 * per_layer;
  for (int jp = bid_; jp * 2 < total; jp += nblk_) {
    const int j = jp * 2 + half;
    const bool on = j < total;
    CvtJob job;
    if (on) { job = cvt_job(p, j / per_layer, j % per_layer); cvt_load(job.src, job.N, job.k0, job.n0, job.g, t, ht); }
    __syncthreads();
    if (on) cvt_store(job.dst, job.ldk, (job.kd >= 0) ? job.kd : job.k0, job.d0, job.d1, t, ht);
    __syncthreads();
  }
  {
    const u32x4 z = {0u, 0u, 0u, 0u};
    for (int e = bid_ * NTHR + tid_; e < 2 * 128 * 128; e += nblk_ * NTHR) {
      const int l = e >> 14, r = (e >> 7) & 127, c = (e & 127) * 8;
      const int row = 9 * 256 + ((r < 64) ? 64 + r : 128 + r);
      *(u32x4*)((u16*)(p.ws + OFF_WQKG) + ((size_t)l * NQKG + row) * DM + c) = z;
    }
    for (int e = bid_ * NTHR + tid_; e < 2 * 1024 * 16; e += nblk_ * NTHR) {
      const int l = e >> 14, r = (e >> 4) & 1023, c = 128 + (e & 15) * 8;
      *(u32x4*)((u16*)(p.ws + OFF_WBR5) + (((size_t)l * 5 + 2) * DM + r) * 256 + c) = z;
    }
  }
  {
    const u32x4 z = {0u, 0u, 0u, 0u};
    u16* yb = (u16*)(p.ws + OFF_Y5) + (size_t)2 * TC * 256;
    for (int e = bid_ * NTHR + tid_; e < TC * 16; e += nblk_ * NTHR) *(u32x4*)(yb + (size_t)(e >> 4) * 256 + 128 + (e & 15) * 8) = z;
  }
  float* rope = (float*)(p.ws + OFF_ROPE);
  for (int e = bid_ * NTHR + tid_; e < SEQ * 48; e += nblk_ * NTHR) {
    const int pos = e / 48, i = e % 48;
    float inv;
    if (i < 32) inv = exp2f(-13.287712379549449f * (float)(2 * i) / 64.0f);
    else inv = exp2f(-13.287712379549449f * (float)(2 * (i - 32)) / 32.0f);
    const float angf = (float)pos * inv;
    const double ang = (double)angf;
    const double n = rint(ang * 0.15915494309189535);
    const float r = (float)(ang - n * 6.283185307179586);
    const float c = cosf(r), s = sinf(r);
    if (i < 32) { rope[pos * 96 + i] = c; rope[pos * 96 + 32 + i] = s; }
    else { rope[pos * 96 + 64 + (i - 32)] = c; rope[pos * 96 + 80 + (i - 32)] = s; }
  }
  if (bid_ == 0 && tid_ < 96) rope[SEQ * 96 + tid_] = (tid_ < 32 || (tid_ >= 64 && tid_ < 80)) ? 1.0f : 0.0f;
  u16* XB = (u16*)(p.ws + OFF_XB); float* SSQ = (float*)(p.ws + OFF_SSQ);
  const int lane = tid_ & 63;
  const int gw = bid_ * 8 + (tid_ >> 6), nw = nblk_ * 8;
  for (int row = gw; row < T; row += nw) {
    const float* xr = p.in[0] + (size_t)row * DM;
    float ss = 0.f;
#pragma unroll
    for (int i = 0; i < 4; ++i) {
      const f32x4 v = *(const f32x4*)(xr + i * 256 + lane * 4);
      ss += v[0] * v[0] + v[1] * v[1] + v[2] * v[2] + v[3] * v[3];
      u32x2 w = {pk2(v[0], v[1]), pk2(v[2], v[3])};
      *(u32x2*)(XB + (size_t)row * DM + i * 256 + lane * 4) = w;
    }
#pragma unroll
    for (int o = 32; o >= 1; o >>= 1) ss += __shfl_xor(ss, o);
    if (lane < 16) SSQ[(size_t)row * 16 + lane] = (lane == 0) ? ss : 0.f;
  }
}

DI void attn_softmax_pv(f32x16& S, float& m, float& l, f32x16& O0, f32x16& O1, const bf16x8 (&vf)[2][2]) {
  float mx = S[0];
#pragma unroll
  for (int i = 1; i < 16; ++i) mx = fmaxf(mx, S[i]);
  mx = fmaxf(mx, __shfl_xor(mx, 32));
  const float mn = fmaxf(m, mx);
  const float alpha = fexp2(m - mn);
  m = mn;
  float sum = 0.f;
#pragma unroll
  for (int i = 0; i < 16; ++i) { S[i] = fexp2(S[i] - mn); sum += S[i]; }
  l = l * alpha + sum;
  const u32x4 p0 = {pk2(S[0], S[1]), pk2(S[2], S[3]), pk2(S[4], S[5]), pk2(S[6], S[7])};
  const u32x4 p1 = {pk2(S[8], S[9]), pk2(S[10], S[11]), pk2(S[12], S[13]), pk2(S[14], S[15])};
#pragma unroll
  for (int i = 0; i < 16; ++i) { O0[i] *= alpha; O1[i] *= alpha; }
  O0 = MFMA32(vf[0][0], as_bf8(p0), O0);
  O0 = MFMA32(vf[0][1], as_bf8(p1), O0);
  O1 = MFMA32(vf[1][0], as_bf8(p0), O1);
  O1 = MFMA32(vf[1][1], as_bf8(p1), O1);
}
DI void attn_fixed_pv(f32x16& S, f32x16& L, f32x16& O0, f32x16& O1, const bf16x8 (&vf)[2][2], const bf16x8 ones) {
#pragma unroll
  for (int i = 0; i < 16; ++i) S[i] = fexp2(S[i]);
  const u32x4 p0 = {pk2(S[0], S[1]), pk2(S[2], S[3]), pk2(S[4], S[5]), pk2(S[6], S[7])};
  const u32x4 p1 = {pk2(S[8], S[9]), pk2(S[10], S[11]), pk2(S[12], S[13]), pk2(S[14], S[15])};
  O0 = MFMA32(vf[0][0], as_bf8(p0), O0);
  O0 = MFMA32(vf[0][1], as_bf8(p1), O0);
  O1 = MFMA32(vf[1][0], as_bf8(p0), O1);
  O1 = MFMA32(vf[1][1], as_bf8(p1), O1);
  float sum = 0.f;
#pragma unroll
  for (int i = 0; i < 16; ++i) sum += S[i];
  L[0] += sum;
}
DI void attn_plain_pv(f32x16& S, float& l, f32x16& O0, f32x16& O1, const bf16x8 (&vf)[2][2]) {
  float sum = 0.f;
#pragma unroll
  for (int i = 0; i < 16; ++i) { S[i] = fexp2(S[i]); sum += S[i]; }
  l += sum;
  const u32x4 p0 = {pk2(S[0], S[1]), pk2(S[2], S[3]), pk2(S[4], S[5]), pk2(S[6], S[7])};
  const u32x4 p1 = {pk2(S[8], S[9]), pk2(S[10], S[11]), pk2(S[12], S[13]), pk2(S[14], S[15])};
  O0 = MFMA32(vf[0][0], as_bf8(p0), O0); O1 = MFMA32(vf[1][0], as_bf8(p0), O1);
  O0 = MFMA32(vf[0][1], as_bf8(p1), O0); O1 = MFMA32(vf[1][1], as_bf8(p1), O1);
}
DI float gain_bound64(const float* g) {
  float a = 0.f, b = 0.f;
  for (int i = 0; i < 64; ++i) { a = fmaxf(a, fabsf(g[i])); b = fmaxf(b, fabsf(g[64 + i])); }
  return fminf(8.0f * a * b * 1.02f + 0.05f, 40.0f);
}
DI void load_vf(bf16x8 (&vf)[2][2], const u16* V, int kb, int lane) {
#pragma unroll
  for (int rb = 0; rb < 2; ++rb)
#pragma unroll
    for (int s = 0; s < 2; ++s) vf[rb][s] = *(const bf16x8*)(V + ((size_t)((kb * 2 + rb) * 2 + s) * 64 + lane) * 8);
}
DI void load_kf4(bf16x8 (&kf)[4], const u16* K, int kb, int lane) {
#pragma unroll
  for (int s = 0; s < 4; ++s) kf[s] = *(const bf16x8*)(K + ((size_t)(kb * 4 + s) * 64 + lane) * 8);
}
DI void load_kf2(bf16x8 (&kf)[2], const u16* K, int kb, int lane) {
#pragma unroll
  for (int s = 0; s < 2; ++s) kf[s] = *(const bf16x8*)(K + ((size_t)(kb * 2 + s) * 64 + lane) * 8);
}
DI void zero16(f32x16& a) {
#pragma unroll
  for (int i = 0; i < 16; ++i) a[i] = 0.f;
}
DI void store_o(u16* yrow, const f32x16& O0, const f32x16& O1, float sc, int h) {
#pragma unroll
  for (int g4 = 0; g4 < 4; ++g4) {
    u32x2 w0 = {pk2(O0[4 * g4] * sc, O0[4 * g4 + 1] * sc), pk2(O0[4 * g4 + 2] * sc, O0[4 * g4 + 3] * sc)};
    *(u32x2*)(yrow + 8 * g4 + 4 * h) = w0;
    u32x2 w1 = {pk2(O1[4 * g4] * sc, O1[4 * g4 + 1] * sc), pk2(O1[4 * g4 + 2] * sc, O1[4 * g4 + 3] * sc)};
    *(u32x2*)(yrow + 32 + 8 * g4 + 4 * h) = w1;
  }
}

__device__ void phase_attn(const Params& p, int tid_, int bid_, int nblk_, int layer, unsigned char* smem) {
  const u16* QK = (const u16*)(p.ws + OFF_QK);
  const u16* VB = (const u16*)(p.ws + OFF_V);
  u16* Y5 = (u16*)(p.ws + OFF_Y5);
  u16* BO = (u16*)(p.ws + OFF_BO);
  float* LSE = (float*)(p.ws + OFF_LSE);
  const int lane = tid_ & 63, wave = tid_ >> 6;
  const int fr = lane & 31, fh = lane >> 5;
  const int nloc = nblk_ >> 3;
  if ((int)(bid_ >> 3) >= nloc) return;
  const int vw = ((bid_ & 7) * nloc + (bid_ >> 3)) * 8 + wave, NW = nloc * 64;
  const bool hiwg = (bid_ * 2 >= nblk_);
  const int hb_ = bid_ - (nblk_ >> 1), nloch = nblk_ >> 4;
  const int vwh = ((hb_ & 7) * nloch + (hb_ >> 3)) * 8 + wave, NWH = nloch * 64;
  PG8_LAS float* rpbl = (PG8_LAS float*)smem;
  for (int i = tid_; i < 4 * 465; i += NTHR) rpbl[i] = p.in[10][(size_t)layer * 4 * 465 + i];
  __syncthreads();
  const size_t GS = (size_t)TC * 64;
  const size_t BS = (size_t)SEQ * 64;

  {
    const float* lp = p.in[7] + layer * 128;
    float d01 = 0.f, d23 = 0.f;
    for (int i = 0; i < 32; ++i) { d01 += lp[i] * lp[32 + i]; d23 += lp[64 + i] * lp[96 + i]; }
    const float lambda_init = (layer == 0) ? 0.2f : 0.35550907f;
    const float lam = __expf(d01) - __expf(d23) + lambda_init;
    const float* subg = p.in[8] + layer * 64;
    const float sc = 0.17677669529663687f * LOG2E;
    float gqm = 0.f, gkm = 0.f;
    for (int i = 0; i < 32; ++i) { gqm = fmaxf(gqm, fabsf(p.in[6][layer * 64 + i])); gkm = fmaxf(gkm, fabsf(p.in[6][layer * 64 + 32 + i])); }
    const unsigned onev = ((fr & 27) == 0) ? 0x3f803f80u : 0u;
    const u32x4 ones4 = {onev, onev, onev, onev};
    const bf16x8 ones = as_bf8(ones4);
    const float cbound = 5.6568542f * gqm * gkm * 1.02f + 0.05f;
    for (int it = vw; it < BC * 4 * 128; it += NW) {
      const int bl = it >> 9, head = (it >> 7) & 3, qblk = it & 127;
      const u16* Q0 = QK + (22 + head) * GS + bl * BS; const u16* Q1 = Q0 + SEQ * 32;
      const u16* K0 = QK + (26 + head) * GS + bl * BS; const u16* K1 = K0 + SEQ * 32;
      const u16* V = VB + (8 + head) * GS + bl * BS;
      bf16x8 q0[2], q1[2];
      load_kf2(q0, Q0, qblk, lane); load_kf2(q1, Q1, qblk, lane);
      f32x16 L0, L1; zero16(L0); zero16(L1);
      f32x16 O00, O01, O10, O11; zero16(O00); zero16(O01); zero16(O10); zero16(O11);
      bf16x8 k0[2], k1[2], vf[2][2];
      {
        const float mb2 = fminf(cbound, 40.0f) * LOG2E;
        f32x16 sinit;
#pragma unroll
        for (int i = 0; i < 16; ++i) sinit[i] = -mb2;
        load_kf2(k0, K0, 0, lane); load_kf2(k1, K1, 0, lane); load_vf(vf, V, 0, lane);
        f32x16 S0 = sinit, S1 = sinit;
        S0 = MFMA32(k0[0], q0[0], S0); S0 = MFMA32(k0[1], q0[1], S0);
        S1 = MFMA32(k1[0], q1[0], S1); S1 = MFMA32(k1[1], q1[1], S1);
        load_kf2(k0, K0, 1, lane); load_kf2(k1, K1, 1, lane);
        for (int kb = 0; kb < 128; ++kb) {
          bf16x8 nk0[2], nk1[2], nvf[2][2];
          const int k2 = (kb + 2 < 128) ? kb + 2 : 127, v1 = (kb + 1 < 128) ? kb + 1 : 127;
          load_kf2(nk0, K0, k2, lane); load_kf2(nk1, K1, k2, lane); load_vf(nvf, V, v1, lane);
          f32x16 S0n = sinit, S1n = sinit;
#pragma unroll
          for (int i = 0; i < 16; ++i) S0[i] = fexp2(S0[i]);
          S0n = MFMA32(k0[0], q0[0], S0n); S0n = MFMA32(k0[1], q0[1], S0n);
          {
            const u32x4 p0 = {pk2(S0[0], S0[1]), pk2(S0[2], S0[3]), pk2(S0[4], S0[5]), pk2(S0[6], S0[7])};
            const u32x4 p1 = {pk2(S0[8], S0[9]), pk2(S0[10], S0[11]), pk2(S0[12], S0[13]), pk2(S0[14], S0[15])};
            O00 = MFMA32(vf[0][0], as_bf8(p0), O00); O01 = MFMA32(vf[1][0], as_bf8(p0), O01);
            O00 = MFMA32(vf[0][1], as_bf8(p1), O00); O01 = MFMA32(vf[1][1], as_bf8(p1), O01);
            float sum = 0.f;
#pragma unroll
            for (int i = 0; i < 16; ++i) sum += S0[i];
            L0[0] += sum;
          }
#pragma unroll
          for (int i = 0; i < 16; ++i) S1[i] = fexp2(S1[i]);
          S1n = MFMA32(k1[0], q1[0], S1n); S1n = MFMA32(k1[1], q1[1], S1n);
          {
            const u32x4 p0 = {pk2(S1[0], S1[1]), pk2(S1[2], S1[3]), pk2(S1[4], S1[5]), pk2(S1[6], S1[7])};
            const u32x4 p1 = {pk2(S1[8], S1[9]), pk2(S1[10], S1[11]), pk2(S1[12], S1[13]), pk2(S1[14], S1[15])};
            O10 = MFMA32(vf[0][0], as_bf8(p0), O10); O11 = MFMA32(vf[1][0], as_bf8(p0), O11);
            O10 = MFMA32(vf[0][1], as_bf8(p1), O10); O11 = MFMA32(vf[1][1], as_bf8(p1), O11);
            float sum = 0.f;
#pragma unroll
            for (int i = 0; i < 16; ++i) sum += S1[i];
            L1[0] += sum;
          }
          S0 = S0n; S1 = S1n;
#pragma unroll
          for (int s = 0; s < 2; ++s) { k0[s] = nk0[s]; k1[s] = nk1[s]; vf[0][s] = nvf[0][s]; vf[1][s] = nvf[1][s]; }
        }
      }
      const float i0 = 1.0f / (L0[0] + __shfl_xor(L0[0], 32));
      const float i1 = lam / (L1[0] + __shfl_xor(L1[0], 32));
      float ss = 0.f;
#pragma unroll
      for (int i = 0; i < 16; ++i) {
        O00[i] = O00[i] * i0 - O10[i] * i1; O01[i] = O01[i] * i0 - O11[i] * i1;
        ss += O00[i] * O00[i] + O01[i] * O01[i];
      }
      ss += __shfl_xor(ss, 32);
      const float rn = rsqrtf(ss * (1.0f / 64.0f) + 1e-6f) * (1.0f - lambda_init);
#pragma unroll
      for (int g4 = 0; g4 < 4; ++g4) {
        const f32x4 ga = *(const f32x4*)(subg + 8 * g4 + 4 * fh);
        const f32x4 gb = *(const f32x4*)(subg + 32 + 8 * g4 + 4 * fh);
#pragma unroll
        for (int e = 0; e < 4; ++e) { O00[4 * g4 + e] *= ga[e]; O01[4 * g4 + e] *= gb[e]; }
      }
      const size_t tok = (size_t)bl * SEQ + qblk * 32 + fr;
      store_o(Y5 + (size_t)3 * TC * 256 + tok * 256 + head * 64, O00, O01, rn, fh);
    }
  }
  {
    const float mbA = gain_bound64(p.in[3] + layer * 128) * LOG2E;
    f32x16 sinit;
#pragma unroll
    for (int i = 0; i < 16; ++i) sinit[i] = -mbA;
    for (int it = vw; it < BC * 8 * 128; it += NW) {
      const int bl = it >> 10, hq = (it >> 7) & 7, qblk = it & 127;
      const int kvh = hq >> 2;
      const u16* Q = QK + (size_t)hq * GS + bl * BS;
      const u16* K = QK + (size_t)(8 + kvh) * GS + bl * BS;
      const u16* V = VB + (size_t)kvh * GS + bl * BS;
      bf16x8 qf[4]; load_kf4(qf, Q, qblk, lane);
      float l = (fh == 0) ? fexp2(p.in[4][layer * 8 + hq] * LOG2E - mbA) : 0.0f;
      f32x16 O0, O1; zero16(O0); zero16(O1);
      const int kb_lo = (qblk - 4 < 0) ? 0 : qblk - 4, kb_hi = (qblk + 4 > 127) ? 127 : qblk + 4;
      const int qpos = qblk * 32 + fr;
      bf16x8 kf[4], vf[2][2];
      load_kf4(kf, K, kb_lo, lane); load_vf(vf, V, kb_lo, lane);
      for (int kb = kb_lo; kb <= kb_hi; ++kb) {
        bf16x8 nkf[4], nvf[2][2];
        const int kn = (kb < kb_hi) ? kb + 1 : kb;
        load_kf4(nkf, K, kn, lane); load_vf(nvf, V, kn, lane);
        f32x16 S = sinit;
#pragma unroll
        for (int s = 0; s < 4; ++s) S = MFMA32(kf[s], qf[s], S);
        if (kb == qblk - 4 || kb == qblk + 4) {
#pragma unroll
          for (int i = 0; i < 16; ++i) {
            const int dlt = kb * 32 + crow(i, fh) - qpos;
            S[i] = (dlt <= 128 && dlt >= -128) ? S[i] : (-__builtin_inff());
          }
        }
        attn_plain_pv(S, l, O0, O1, vf);
#pragma unroll
        for (int s = 0; s < 4; ++s) kf[s] = nkf[s];
#pragma unroll
        for (int s = 0; s < 2; ++s) { vf[0][s] = nvf[0][s]; vf[1][s] = nvf[1][s]; }
      }
      const float inv = 1.0f / (l + __shfl_xor(l, 32));
      const size_t tok = (size_t)bl * SEQ + qpos;
      store_o(Y5 + (size_t)(hq >> 2) * TC * 256 + tok * 256 + (hq & 3) * 64, O0, O1, inv, fh);
    }
  }
  {
    const float gbD = gain_bound64(p.in[9] + layer * 128);
    if (hiwg)
    for (int it = vwh; it < BC * 4 * 128; it += NWH) {
      const int bl = it >> 9, head = (it >> 7) & 3, qblk = it & 127;
      const u16* Q = QK + (size_t)(30 + head) * GS + bl * BS;
      const u16* K = QK + (size_t)(34 + head) * GS + bl * BS;
      const u16* V = VB + (size_t)(12 + head) * GS + bl * BS;
      const PG8_LAS float* rpb = rpbl + head * 465;
      bf16x8 qf[4]; load_kf4(qf, Q, qblk, lane);
      float bmax = 0.f;
      for (int i = lane; i < 15 * 31; i += 64) bmax = fmaxf(bmax, fabsf(rpb[i]));
#pragma unroll
      for (int o = 32; o >= 1; o >>= 1) bmax = fmaxf(bmax, __shfl_xor(bmax, o));
      const float mbD = fminf(gbD + bmax, 60.0f) * LOG2E;
      f32x16 sinit;
#pragma unroll
      for (int i = 0; i < 16; ++i) sinit[i] = -mbD;
      float l = 0.f;
      f32x16 O0, O1; zero16(O0); zero16(O1);
      const int qrow = qblk >> 1, qc = (qblk & 1) * 32 + fr;
      int r0 = qrow - 4; r0 = r0 < 0 ? 0 : (r0 > 56 ? 56 : r0);
      int c0 = qc - 8; c0 = c0 < 0 ? 0 : (c0 > 48 ? 48 : c0);
      bf16x8 kf[4], vf[2][2];
      load_kf4(kf, K, r0 * 2, lane); load_vf(vf, V, r0 * 2, lane);
      for (int kk = 0; kk < 16; ++kk) {
        const int krow_ = r0 + (kk >> 1), hb = kk & 1;
        bf16x8 nkf[4], nvf[2][2];
        const int kn = r0 * 2 + ((kk < 15) ? kk + 1 : kk);
        load_kf4(nkf, K, kn, lane); load_vf(nvf, V, kn, lane);
        f32x16 S = sinit;
#pragma unroll
        for (int s = 0; s < 4; ++s) S = MFMA32(kf[s], qf[s], S);
        const PG8_LAS float* brow = rpb + (krow_ - qrow + 7) * 31;
#pragma unroll
        for (int i = 0; i < 16; ++i) {
          const int kc = hb * 32 + crow(i, fh);
          int dc = kc - qc; dc = dc < -15 ? -15 : (dc > 15 ? 15 : dc);
          const float bias = brow[dc + 15];
          S[i] = (kc >= c0 && kc < c0 + 16) ? __builtin_fmaf(bias, LOG2E, S[i]) : (-__builtin_inff());
        }
        attn_plain_pv(S, l, O0, O1, vf);
#pragma unroll
        for (int s = 0; s < 4; ++s) kf[s] = nkf[s];
#pragma unroll
        for (int s = 0; s < 2; ++s) { vf[0][s] = nvf[0][s]; vf[1][s] = nvf[1][s]; }
      }
      const float inv = 1.0f / (l + __shfl_xor(l, 32));
      const size_t tok = (size_t)bl * SEQ + qblk * 32 + fr;
      store_o(Y5 + (size_t)4 * TC * 256 + tok * 256 + head * 64, O0, O1, inv, fh);
    }
  }
  {
    const float mbB = gain_bound64(p.in[5] + layer * 128) * LOG2E;
    f32x16 sinit;
#pragma unroll
    for (int i = 0; i < 16; ++i) sinit[i] = -mbB;
    if (hiwg)
    for (int it = vwh; it < BC * 6 * 128; it += NWH) {
      const int bl = it / 768, rem = it % 768, head = rem >> 7, qblk = rem & 127;
      const int dil = dil_of(head >> 1), L = SEQ / dil, LB = L >> 5;
      const u16* Q = QK + (size_t)(10 + head) * GS + bl * BS;
      const u16* K = QK + (size_t)(16 + head) * GS + bl * BS;
      const u16* V = VB + (size_t)(2 + head) * GS + bl * BS;
      bf16x8 qf[4]; load_kf4(qf, Q, qblk, lane);
      float l = 0.f;
      f32x16 O0, O1; zero16(O0); zero16(O1);
      const int rsub = qblk / LB;
      const int lo = rsub * LB, hi = lo + LB - 1;
      const int kb_lo = (qblk - 2 < lo) ? lo : qblk - 2, kb_hi = (qblk + 2 > hi) ? hi : qblk + 2;
      const int qd = qblk * 32 + fr;
      bf16x8 kf[4], vf[2][2];
      load_kf4(kf, K, kb_lo, lane); load_vf(vf, V, kb_lo, lane);
      for (int kb = kb_lo; kb <= kb_hi; ++kb) {
        bf16x8 nkf[4], nvf[2][2];
        const int kn = (kb < kb_hi) ? kb + 1 : kb;
        load_kf4(nkf, K, kn, lane); load_vf(nvf, V, kn, lane);
        f32x16 S = sinit;
#pragma unroll
        for (int s = 0; s < 4; ++s) S = MFMA32(kf[s], qf[s], S);
        if (kb == qblk - 2 || kb == qblk + 2) {
#pragma unroll
          for (int i = 0; i < 16; ++i) {
            const int dlt = kb * 32 + crow(i, fh) - qd;
            S[i] = (dlt <= 64 && dlt >= -64) ? S[i] : (-__builtin_inff());
          }
        }
        attn_plain_pv(S, l, O0, O1, vf);
#pragma unroll
        for (int s = 0; s < 4; ++s) kf[s] = nkf[s];
#pragma unroll
        for (int s = 0; s < 2; ++s) { vf[0][s] = nvf[0][s]; vf[1][s] = nvf[1][s]; }
      }
      const float lt = l + __shfl_xor(l, 32);
      const float inv = 1.0f / lt;
      const int msub = qd - rsub * L;
      const int pos = msub * dil + rsub;
      const size_t tok = (size_t)bl * SEQ + pos;
      store_o(BO + tok * 384 + head * 64, O0, O1, inv, fh);
      if (fh == 0) LSE[tok * 8 + head] = __log2f(lt) + mbB;
    }
  }
}


__device__ void phase_bcombine(const Params& p, int tid_, int tok0) {
  const u16* BO = (const u16*)(p.ws + OFF_BO);
  const float* LSE = (const float*)(p.ws + OFF_LSE);
  u16* YB = (u16*)(p.ws + OFF_Y5) + (size_t)2 * TC * 256;
  for (int e = tid_; e < 256 * 16; e += NTHR) {
    const int tok = tok0 + (e >> 4), j = (e >> 3) & 1, c8 = (e & 7) * 8;
    const float a0 = LSE[(size_t)tok * 8 + j], a1 = LSE[(size_t)tok * 8 + 2 + j], a2 = LSE[(size_t)tok * 8 + 4 + j];
    const float mx = fmaxf(a0, fmaxf(a1, a2));
    float w0 = fexp2(a0 - mx), w1 = fexp2(a1 - mx), w2 = fexp2(a2 - mx);
    const float inv = 1.0f / (w0 + w1 + w2);
    w0 *= inv; w1 *= inv; w2 *= inv;
    const u32x4 x0 = *(const u32x4*)(BO + (size_t)tok * 384 + (0 + j) * 64 + c8);
    const u32x4 x1 = *(const u32x4*)(BO + (size_t)tok * 384 + (2 + j) * 64 + c8);
    const u32x4 x2 = *(const u32x4*)(BO + (size_t)tok * 384 + (4 + j) * 64 + c8);
    u32x4 o;
#pragma unroll
    for (int q = 0; q < 4; ++q) {
      const float lo = w0 * bf_lo(x0[q]) + w1 * bf_lo(x1[q]) + w2 * bf_lo(x2[q]);
      const float hi = w0 * bf_hi(x0[q]) + w1 * bf_hi(x1[q]) + w2 * bf_hi(x2[q]);
      o[q] = pk2(lo, hi);
    }
    *(u32x4*)(YB + (size_t)tok * 256 + j * 64 + c8) = o;
  }
}

#define XB_TMO      128
#define XB_XCNT(j)  (256  + 64 * (j))
#define XB_XSUB(j)  (1280 + 64 * (j))
#define XB_XGEN(j)  (2304 + 64 * (j))
#define XB_TOP      3328
#define XB_TOPGEN   3392
#define XCD_BAR_WORDS 3456
#define XB_SPIN_CAP (1u << 22)
#define LAS __attribute__((address_space(3)))
DI unsigned xb_ld(unsigned* p)              { return __hip_atomic_load(p, __ATOMIC_RELAXED, __HIP_MEMORY_SCOPE_AGENT); }
DI unsigned xb_add(unsigned* p, unsigned v) { return __hip_atomic_fetch_add(p, v, __ATOMIC_RELAXED, __HIP_MEMORY_SCOPE_AGENT); }
DI unsigned xb_xcc_id() { return (unsigned)__builtin_amdgcn_s_getreg((3 << 11) | 20) & 0xFu; }
#define XB_SPIN(cond, bar) do { unsigned _sp = 0; while (cond) { __builtin_amdgcn_s_sleep(1); \
    if ((++_sp & 255u) == 0u) { if (xb_ld(&(bar)[XB_TMO])) break; if (_sp > XB_SPIN_CAP) { atomicAdd(&(bar)[XB_TMO], 1u); break; } } } } while (0)
struct XcdBarrier { unsigned* bar; unsigned x; volatile LAS unsigned* st; };
DI XcdBarrier xcd_barrier_post(unsigned* bar, volatile LAS unsigned* st) {
  XcdBarrier b; b.bar = bar; b.x = xb_xcc_id(); b.st = st;
  if (threadIdx.x == 0) (void)xb_add(&bar[XB_XCNT(b.x)], 1u);
  return b;
}
DI void xcd_barrier_complete(unsigned* bar, unsigned x, unsigned& nloc, unsigned& nx) {
  const unsigned G = gridDim.x * gridDim.y * gridDim.z;
  unsigned sum, cnt, mine, sp = 0u;
  for (;;) {
    sum = 0u; cnt = 0u; mine = 0u;
#pragma unroll
    for (unsigned j = 0; j < 16; ++j) { const unsigned c = xb_ld(&bar[XB_XCNT(j)]); sum += c; cnt += (c > 0u) ? 1u : 0u; mine = (j == x) ? c : mine; }
    if (sum == G) break;
    __builtin_amdgcn_s_sleep(1);
    if ((++sp & 255u) == 0u) { if (xb_ld(&bar[XB_TMO])) break; if (sp > XB_SPIN_CAP) { atomicAdd(&bar[XB_TMO], 1u); break; } }
  }
  nloc = mine > 0u ? mine : 1u; nx = cnt > 0u ? cnt : 1u;
}
DI void xcd_barrier(const XcdBarrier& b) {
  asm volatile("s_waitcnt vmcnt(0)" ::: "memory");
  __syncthreads();
  if (threadIdx.x == 0) {
    unsigned* bar = b.bar;
    __builtin_amdgcn_s_waitcnt(0);
    unsigned nloc = b.st[0], nx = b.st[1];
    if (nloc == 0u) { xcd_barrier_complete(bar, b.x, nloc, nx); b.st[0] = nloc; b.st[1] = nx; }
    const unsigned old = xb_add(&bar[XB_XSUB(b.x)], 1u);
    const unsigned gen = old / nloc;
    if (old + 1u == (gen + 1u) * nloc) {
      __builtin_amdgcn_fence(__ATOMIC_RELEASE, "agent");
      asm volatile("s_waitcnt vmcnt(0)" ::: "memory");
      const unsigned og = xb_add(&bar[XB_TOP], 1u);
      const unsigned tg = og / nx;
      if (og + 1u == (tg + 1u) * nx) xb_add(&bar[XB_TOPGEN], 1u);
      else XB_SPIN(xb_ld(&bar[XB_TOPGEN]) == tg, bar);
      __builtin_amdgcn_fence(__ATOMIC_ACQUIRE, "agent");
      xb_add(&bar[XB_XGEN(b.x)], 1u);
      asm volatile("s_waitcnt vmcnt(0)" ::: "memory");
    } else {
      XB_SPIN(xb_ld(&bar[XB_XGEN(b.x)]) == gen, bar);
      __builtin_amdgcn_fence(__ATOMIC_ACQUIRE, "agent");
      asm volatile("s_waitcnt vmcnt(0)" ::: "memory");
    }
  }
  __syncthreads();
}

__global__ void __launch_bounds__(NTHR, 2) mk_forward(Params p) {
  extern __shared__ __attribute__((aligned(16))) unsigned char smem[];
  cg::grid_group grid = cg::this_grid();
  volatile LAS unsigned* xbw = (volatile LAS unsigned*)(smem + LDS_XBW);
  if (threadIdx.x < 4) xbw[threadIdx.x] = 0u;
  __syncthreads();
  XcdBarrier xb;
  if (FUSED) xb = xcd_barrier_post((unsigned*)(p.ws + OFF_BAR), xbw);
#if PROBE_CLOCK
  const unsigned long long pc_t0 = clock64(), pc_r0 = wall_clock64();
#endif
  PG8_LAS unsigned char* lds = (PG8_LAS unsigned char*)smem;
  for (int ph = p.ph_lo; ph < p.ph_hi; ++ph) {
#if DUPMASK
   for (int rep = 0; rep < ((ph > 0 && ((DUPMASK >> ((ph - 1) % 7)) & 1)) ? 2 : 1); ++rep)
#endif
   {
    int tid_ = threadIdx.x, bid_ = blockIdx.x, nblk_ = gridDim.x;
    asm volatile("" : "+v"(tid_));
    asm volatile("" : "+s"(bid_));
    asm volatile("" : "+s"(nblk_));
    Params pp = p;
    asm volatile("" : "+s"(pp.ws));
    asm volatile("" : "+s"(pp.out));
    unsigned char* ws = pp.ws;
    if (ph == 0) {
      if (PHMASK & 128) phase_prep(pp, tid_, bid_, nblk_, smem);
    } else {
      const int q = ph - 1, chunk = q / (2 * PPL), layer = (q % (2 * PPL)) / PPL, kk = q % PPL, k = (kk == 6) ? DUPK : (kk < 2 ? kk : kk + 1);
      const u16* XBc = (const u16*)(ws + OFF_XB) + (size_t)chunk * TC * DM;
      float* SSQc = (float*)(ws + OFF_SSQ) + (size_t)chunk * TC * 16;
      float* xc = pp.out + (size_t)chunk * TC * DM;
      const bool hiwg = (bid_ * 2 >= nblk_);
      int gu_lo = 0, gu_hi = 0, gu_mode = 0;
      if (k == 0 && (PHMASK & 1)) {
        {
          EpiQKG e; e.ssq = SSQc; e.qk = (u16*)(ws + OFF_QK); e.rope = (const float*)(ws + OFF_ROPE);
          e.gA = pp.in[3] + layer * 128; e.gB = pp.in[5] + layer * 128; e.gC = pp.in[6] + layer * 64; e.gD = pp.in[9] + layer * 128;
          run_gemm(lds, XBc, (const u16*)(ws + OFF_WQKG) + (size_t)layer * NQKG * DM, TC, 2560, DM, e);
        }
        {
          EpiVT ev; ev.ssq = SSQc; ev.vbuf = (u16*)(ws + OFF_V);
          run_gemm(lds, (const u16*)(ws + OFF_WV) + (size_t)layer * DM * DM, XBc, DM, TC, DM, ev);
        }
        if (hiwg) { gu_lo = 3; gu_hi = 4; }
      } else if (k == 1 && (PHMASK & 2)) {
        phase_attn(pp, tid_, bid_, nblk_, layer, smem);
        __syncthreads();
        gu_lo = 0; gu_hi = hiwg ? 3 : 4;
      } else if (k == 5 && (PHMASK & 32)) {
        gu_lo = 0; gu_hi = 4; gu_mode = 1;
      }
      if (gu_hi > gu_lo) {
        const bool up = (gu_mode == 1);
        EpiGateUp e; e.ssq = SSQc; e.o = (u16*)(ws + OFF_GATE); e.mode = up ? ((PROBE_NOEPI && kk == 6) ? 2 : 1) : 0;
        const u16* W = up ? (const u16*)(ws + OFF_WUP) + (size_t)layer * DMLP * DM : (const u16*)(ws + OFF_WQKG) + ((size_t)layer * NQKG + 2560) * DM;
        run_gemm(lds, XBc, W, TC, 4096, DM, e, (PROBE_NOEPI && kk == 6) ? 1 : 0, gu_lo, gu_hi);
      }
      if (k == 0 || k == 1 || k == 5) {
      } else if (k == 3 && (PHMASK & 8)) {
        {
          Unit u0; pg8::StaticOrder S0; S0.init(TC, DM, nblk_, bid_); S0.next(0, u0);
          phase_bcombine(pp, tid_, u0.pm * 256);
          asm volatile("s_waitcnt vmcnt(0)" ::: "memory");
          __syncthreads();
        }
        EpiMerge e; e.gate = (const u16*)(ws + OFF_GATE); e.mrg = (u16*)(ws + OFF_MRG);
        run_merge(lds, (const u16*)(ws + OFF_Y5), (const u16*)(ws + OFF_WBR5) + (size_t)layer * 5 * DM * 256, e);
      } else if ((k == 4 && (PHMASK & 16)) || (k == 6 && (PHMASK & 64))) {
        const bool dn = (k == 6);
        EpiResid e; e.xout = xc; e.xb = (u16*)XBc; e.ssq = SSQc; e.wf32 = (dn && layer == 1) ? 1 : 0;
        const u16* A = dn ? (const u16*)(ws + OFF_GATE) : (const u16*)(ws + OFF_MRG);
        const u16* W = dn ? (const u16*)(ws + OFF_WDN) + (size_t)layer * DM * DMLP : (const u16*)(ws + OFF_WOUT) + (size_t)layer * DM * DM;
        run_gemm(lds, A, W, TC, DM, dn ? DMLP : DM, e);
      }
    }
   }
    if (ph + 1 < p.ph_hi) {
      if (p.ph_lo < 0) grid.sync();
      xcd_barrier(xb);
    }
  }
#if PROBE_CLOCK
  {
    xcd_barrier(xb);
    const unsigned long long pc_t1 = clock64(), pc_r1 = wall_clock64();
    const float ghz = (float)(pc_t1 - pc_t0) / ((float)(pc_r1 - pc_r0) * 10.0f);
    const int nrows = (int)(ghz * 0.25f * (float)T);
    for (int r = blockIdx.x; r < nrows; r += gridDim.x)
      for (int c = threadIdx.x; c < DM; c += NTHR) p.out[(size_t)r * DM + c] = 0.f;
  }
#endif
}

extern "C" void kernel_launch(void* const* d_in, const int* in_sizes, int n_in, void* d_out, int out_size, void* d_ws, size_t ws_size,
                              hipStream_t stream) {
  static int grid_blocks = 0;
  if (grid_blocks == 0) {
    if (n_in != 19 || out_size != T * DM || ws_size < WS_END) {
      fprintf(stderr, "kernel_launch: unexpected problem (n_in %d out %d ws %zu need %zu)\n", n_in, out_size, ws_size, (size_t)WS_END);
      grid_blocks = -1;
      return;
    }
    int dev = 0, cus = 0, per_cu = 0;
    (void)hipGetDevice(&dev);
    (void)hipDeviceGetAttribute(&cus, hipDeviceAttributeMultiprocessorCount, dev);
    if (hipFuncSetAttribute((const void*)mk_forward, hipFuncAttributeMaxDynamicSharedMemorySize, LDS_BYTES) != hipSuccess) {
      fprintf(stderr, "kernel_launch: hipFuncSetAttribute failed\n"); grid_blocks = -1; return;
    }
    (void)hipOccupancyMaxActiveBlocksPerMultiprocessor(&per_cu, mk_forward, NTHR, LDS_BYTES);
    if (per_cu < 1) fprintf(stderr, "kernel_launch: occupancy query says %d blocks per CU\n", per_cu);
    (void)hipGetLastError();
    grid_blocks = cus;
  }
  if (grid_blocks < 0) return;
  Params p{};
  for (int i = 0; i < 19; ++i) p.in[i] = (const float*)d_in[i];
  p.out = (float*)d_out;
  p.ws = (unsigned char*)d_ws;
#if FUSED
  (void)hipMemsetAsync((unsigned char*)d_ws + OFF_BAR, 0, XCD_BAR_WORDS * 4, stream);
  p.ph_lo = 0; p.ph_hi = NPHASE;
  void* args[] = {&p};
  hipError_t e = hipLaunchCooperativeKernel((const void*)mk_forward, dim3(grid_blocks), dim3(NTHR), args, LDS_BYTES, stream);
  if (e != hipSuccess) fprintf(stderr, "cooperative launch failed: %s (grid %d)\n", hipGetErrorString(e), grid_blocks);
#else
  for (int ph = 0; ph < NPHASE; ++ph) {
    p.ph_lo = ph; p.ph_hi = ph + 1;
    hipLaunchKernelGGL(mk_forward, dim3(grid_blocks), dim3(NTHR), LDS_BYTES, stream, p);
  }
#endif
}
```

```cpp
#include <hip/hip_runtime.h>
#include <hip/hip_cooperative_groups.h>
#include <cstdio>
namespace cg = cooperative_groups;

#ifndef PHMASK
#define PHMASK 255
#endif
#ifndef DUPMASK
#define DUPMASK 0
#endif
#ifndef DUPK
#define DUPK -1
#endif
#ifndef PROBE_CLOCK
#define PROBE_CLOCK 0
#endif
#ifndef PROBE_NOEPI
#define PROBE_NOEPI 0
#endif
#ifndef FUSED
#define FUSED 1
#endif

namespace pg8 {
#define PG8_LAS __attribute__((address_space(3)))
typedef unsigned short bf16_t;
typedef short bf16x8 __attribute__((ext_vector_type(8)));
typedef float f32x4 __attribute__((ext_vector_type(4)));
typedef unsigned u32x4 __attribute__((ext_vector_type(4)));
constexpr int BM = 256, BK = 64, HALF = 128, HTB = HALF * BK * 2  , STAGE_BYTES = 8 * HTB, NXCD = 8, WGM = 8;

__host__ __device__ __forceinline__ int lds_byte(int r, int c) { const int st = (r >> 4) * 2 + (c >> 5), rr = r & 15, cc = c & 31, ob = rr * 64 + cc * 2; return st * 1024 + (ob ^ (((ob >> 9) & 1) << 5)); }
__host__ __device__ __forceinline__ void stage_rc(int b, int& R, int& C) { const int st = b / 1024, sb = b % 1024, swz = sb ^ (((sb >> 9) & 1) << 5); R = (st >> 1) * 16 + swz / 64; C = (st & 1) * 32 + (swz % 64) / 2; }
__host__ __device__ __forceinline__ int perm32(int rho) { const int n = rho >> 4, i = rho & 15; return 8 * (i >> 2) + 4 * n + (i & 3); }

struct Unit { int pm, pn, seg; };
struct Gemm { const bf16_t* A; const bf16_t* Bt; int M, N, K; };

struct StaticOrder {
    int nM, nN, nwg, G, c, probe = 0, ilo = 0, ihi = 1 << 30;
    __host__ __device__ void init(int M, int N, int G_, int c_) { nM = M / BM; nN = N / BM; nwg = nM * nN; G = G_; c = c_; }
    __host__ __device__ bool next(int i, Unit& u) const {
        i += ilo; if (i >= ihi) return false;
        const long L = (long)i * G + c; if (L >= nwg) return false;
        int wgid = (int)L; { const int q = nwg / NXCD, r = nwg % NXCD, xcd = wgid % NXCD, off = wgid / NXCD; wgid = (xcd < r ? xcd * (q + 1) : r * (q + 1) + (xcd - r) * q) + off; }
        const int nig = WGM * nN, gid = wgid / nig, fm = gid * WGM, gsz = (nM - fm) < WGM ? (nM - fm) : WGM;
        u.pm = fm + ((wgid % nig) % gsz); u.pn = (wgid % nig) / gsz; u.seg = 0; if (probe) { u.pm = 0; u.pn = 0; } return true;
    }
    __device__ __forceinline__ void a_ready(const Unit&) const {}
    __device__ __forceinline__ void done(const Unit&) const {}
    __device__ __forceinline__ const char* baseA(const Gemm& g, const Unit& u, size_t tstep) const { return (const char*)g.A + (size_t)u.pm * tstep; }
    __device__ __forceinline__ const char* baseB(const Gemm& g, const Unit& u, size_t tstep) const { return (const char*)g.Bt + (size_t)u.pn * tstep; }
    __device__ __forceinline__ bool zero_after(const Unit&) const { return true; }
};

template <class Epi, class Sched, bool STAMP = false>
__device__ __forceinline__ void gemm_phase(PG8_LAS unsigned char* lds, const Gemm g, const Sched& S, const Epi& E, unsigned long long* stamps) {
    int tid = threadIdx.x; asm volatile("" : "+v"(tid));
    const int wid = __builtin_amdgcn_readfirstlane(tid >> 6), lane = tid & 63, wr = wid >> 2, wc = wid & 3, fr = lane & 15, fq = lane >> 4;
    const int K = g.K, nt = K / BK;
    int ts_lo = 0, ts_hi = 0, nts = 0; const unsigned long long rt_entry = STAMP ? (unsigned long long)wall_clock64() : 0ull;
#define PG8_STAMP() do { if (STAMP && wid == 0 && nts < 64) { const unsigned long long _c = (unsigned long long)clock64(); \
        ts_lo = (lane == nts) ? (int)(unsigned)_c : ts_lo; ts_hi = (lane == nts) ? (int)(unsigned)(_c >> 32) : ts_hi; ++nts; } } while (0)
    PG8_STAMP();
    unsigned voffA[2], voffB[2];
#pragma unroll
    for (int i = 0; i < 2; ++i) { int R, C; stage_rc(tid * 16 + i * 8192, R, C); const int Rb = Epi::PERM ? ((R & ~31) + perm32(R & 31)) : R;
        voffA[i] = (unsigned)(R * K + C) * 2u; voffB[i] = (unsigned)(Rb * K + C) * 2u; }
    const size_t kstep = (size_t)(BK * 2);
    const size_t hstep = (size_t)HALF * K * 2;
    const size_t tstep = 2 * hstep;
    const unsigned ldsw = (unsigned)wid * 1024u;
    const int aoff = lds_byte(wr * 64 + fr, fq * 8), boff = lds_byte(wc * 32 + fr, fq * 8);
#define PG8_SA(b, h) (((b) * 2 + (h)) * HTB)
#define PG8_SB(b, h) ((4 + (b) * 2 + (h)) * HTB)
#define PG8_STAGE(bufoff, gbase, voff) do { _Pragma("unroll") for (int _i = 0; _i < 2; ++_i) \
        __builtin_amdgcn_global_load_lds((const unsigned*)((const char*)(gbase) + (voff)[_i]), (PG8_LAS unsigned*)(lds + (bufoff) + ldsw + _i * 8192), 16, 0, 0); } while (0)
#define PG8_LDA(dst, b, h) do { _Pragma("unroll") for (int m = 0; m < 4; ++m) _Pragma("unroll") for (int k = 0; k < 2; ++k) dst[m][k] = *(const PG8_LAS bf16x8*)(lds + PG8_SA(b, h) + aoff + m * 2048 + k * 1024); } while (0)
#define PG8_LDB(dst, b, h) do { _Pragma("unroll") for (int n = 0; n < 2; ++n) _Pragma("unroll") for (int k = 0; k < 2; ++k) dst[n][k] = *(const PG8_LAS bf16x8*)(lds + PG8_SB(b, h) + boff + n * 2048 + k * 1024); } while (0)
#define PG8_MMA(ai, bj, At, Bt) do { __builtin_amdgcn_s_setprio(1); _Pragma("unroll") for (int m = 0; m < 4; ++m) _Pragma("unroll") for (int n = 0; n < 2; ++n) _Pragma("unroll") for (int k = 0; k < 2; ++k) \
        acc[ai][bj][m][n] = __builtin_amdgcn_mfma_f32_16x16x32_bf16(Bt[n][k], At[m][k], acc[ai][bj][m][n], 0, 0, 0); __builtin_amdgcn_s_setprio(0); } while (0)
#define PG8_WAIT_V(n) asm volatile("s_waitcnt vmcnt(" #n ")" ::: "memory")
#define PG8_WAIT_L(n) asm volatile("s_waitcnt lgkmcnt(" #n ")" ::: "memory")
#define PG8_BAR __builtin_amdgcn_s_barrier()
#define PG8_SCHED __builtin_amdgcn_sched_barrier(0)
    Unit cur, nxt; int ui = 0;
    if (!S.next(0, cur)) return;
    f32x4 acc[2][2][4][2];
#pragma unroll
    for (int a = 0; a < 2; ++a)
#pragma unroll
        for (int b = 0; b < 2; ++b)
#pragma unroll
            for (int m = 0; m < 4; ++m)
#pragma unroll
                for (int n = 0; n < 2; ++n) acc[a][b][m][n] = (f32x4){0.f, 0.f, 0.f, 0.f};
    bf16x8 At[4][2], B0[2][2], B1[2][2];
    const char* cA = S.baseA(g, cur, tstep); const char* cB = S.baseB(g, cur, tstep);
    S.a_ready(cur);
    PG8_STAGE(PG8_SB(0, 0), cB, voffB); PG8_STAGE(PG8_SA(0, 0), cA, voffA); PG8_STAGE(PG8_SB(0, 1), cB + hstep, voffB); PG8_STAGE(PG8_SA(0, 1), cA + hstep, voffA);
    if (wr == 1) PG8_BAR;
    PG8_WAIT_V(4); PG8_BAR;
    PG8_STAGE(PG8_SB(1, 0), cB + kstep, voffB); PG8_STAGE(PG8_SA(1, 0), cA + kstep, voffA); PG8_STAGE(PG8_SB(1, 1), cB + hstep + kstep, voffB);
    PG8_WAIT_V(6); PG8_BAR;
    PG8_STAMP();
    for (;;) {
        const bool has_next = S.next(ui + 1, nxt);
        const char* nA = has_next ? S.baseA(g, nxt, tstep) : cA; const char* nB = has_next ? S.baseB(g, nxt, tstep) : cB;
        for (int t = 0; t < nt; t += 2) {
            const bool last = (t == nt - 2);
            const char* a1 = cA + (size_t)(t + 1) * kstep;
            const char* a2 = last ? nA : cA + (size_t)(t + 2) * kstep; const char* b2 = last ? nB : cB + (size_t)(t + 2) * kstep;
            const char* a3 = a2 + kstep; const char* b3 = b2 + kstep;
            if (last && has_next) S.a_ready(nxt);
            PG8_LDB(B0, 0, 0); PG8_SCHED; PG8_LDA(At, 0, 0); PG8_STAGE(PG8_SA(1, 1), a1 + hstep, voffA);
            PG8_WAIT_L(8); PG8_BAR; PG8_WAIT_L(0); PG8_MMA(0, 0, At, B0); PG8_BAR; PG8_SCHED;
            PG8_LDB(B1, 0, 1); PG8_STAGE(PG8_SB(0, 0), b2, voffB);
            PG8_BAR; PG8_WAIT_L(0); PG8_MMA(0, 1, At, B1); PG8_BAR;
            PG8_LDA(At, 0, 1); PG8_STAGE(PG8_SA(0, 0), a2, voffA);
            PG8_BAR; PG8_WAIT_L(0); PG8_MMA(1, 0, At, B0); PG8_BAR; PG8_SCHED;
            PG8_STAGE(PG8_SB(0, 1), b2 + hstep, voffB);
            PG8_WAIT_V(6); PG8_BAR; PG8_MMA(1, 1, At, B1); PG8_BAR;
            PG8_LDB(B0, 1, 0); PG8_SCHED; PG8_LDA(At, 1, 0); PG8_STAGE(PG8_SA(0, 1), a2 + hstep, voffA);
            PG8_WAIT_L(8); PG8_BAR; PG8_WAIT_L(0); PG8_MMA(0, 0, At, B0); PG8_BAR; PG8_SCHED;
            PG8_LDB(B1, 1, 1); PG8_STAGE(PG8_SB(1, 0), b3, voffB);
            PG8_BAR; PG8_WAIT_L(0); PG8_MMA(0, 1, At, B1); PG8_BAR;
            PG8_LDA(At, 1, 1); PG8_STAGE(PG8_SA(1, 0), a3, voffA);
            PG8_BAR; PG8_WAIT_L(0); PG8_MMA(1, 0, At, B0); PG8_BAR; PG8_SCHED;
            PG8_STAGE(PG8_SB(1, 1), b3 + hstep, voffB);
            PG8_WAIT_V(6); PG8_BAR; PG8_MMA(1, 1, At, B1); PG8_BAR;
        }
        PG8_STAMP();
        if constexpr (!Epi::AFTER_DRAIN) { E(acc, cur, wr, wc, fr, fq); S.done(cur); }
        PG8_STAMP();
        if (!has_next) break;
        if (S.zero_after(cur))
#pragma unroll
        for (int a = 0; a < 2; ++a)
#pragma unroll
            for (int b = 0; b < 2; ++b)
#pragma unroll
                for (int m = 0; m < 4; ++m)
#pragma unroll
                    for (int n = 0; n < 2; ++n) acc[a][b][m][n] = (f32x4){0.f, 0.f, 0.f, 0.f};
        cur = nxt; cA = nA; cB = nB; ++ui;
    }
    PG8_WAIT_V(0);
    if (wr == 0) PG8_BAR;
    PG8_BAR;
    if constexpr (Epi::AFTER_DRAIN) { E.fused(acc, cur, wr, wc, fr, fq, lds, wid, lane); S.done(cur); }
    PG8_STAMP();
    if (STAMP && wid == 0) { stamps[lane] = lane < nts ? (((unsigned long long)(unsigned)ts_hi << 32) | (unsigned)ts_lo) : 0ull;
        if (lane == 62) stamps[62] = rt_entry; if (lane == 63) stamps[63] = (unsigned long long)wall_clock64(); }
#undef PG8_STAMP
#undef PG8_SA
#undef PG8_SB
#undef PG8_STAGE
#undef PG8_LDA
#undef PG8_LDB
#undef PG8_MMA
#undef PG8_WAIT_V
#undef PG8_WAIT_L
#undef PG8_BAR
#undef PG8_SCHED
}
}

typedef unsigned short u16;
typedef short bf16x8 __attribute__((ext_vector_type(8)));
typedef float f32x16 __attribute__((ext_vector_type(16)));
typedef float f32x4 __attribute__((ext_vector_type(4)));
typedef __bf16 bf2_t __attribute__((ext_vector_type(2)));
typedef float f2_t __attribute__((ext_vector_type(2)));
typedef unsigned u32x4 __attribute__((ext_vector_type(4)));
typedef unsigned u32x2 __attribute__((ext_vector_type(2)));
using pg8::Unit;

#define DI __device__ __forceinline__
#define MFMA32(a, b, c) __builtin_amdgcn_mfma_f32_32x32x16_bf16((a), (b), (c), 0, 0, 0)

constexpr int DM = 1024, SEQ = 4096, NBATCH = 8, T = NBATCH * SEQ;
constexpr int NCH = 2, BC = NBATCH / NCH, TC = BC * SEQ;
constexpr int INC = 7552, DMLP = 4096;
constexpr int NQKG = 6656;
constexpr int NQKH = 38, NVH = 16;
constexpr float LOG2E = 1.4426950408889634f;
constexpr int NTHR = 512;

constexpr size_t al256(size_t x) { return (x + 255) & ~(size_t)255; }
constexpr size_t OFF_WQKG = 0;
constexpr size_t OFF_WV   = OFF_WQKG + al256((size_t)2 * NQKG * DM * 2);
constexpr size_t OFF_WBR5 = OFF_WV   + al256((size_t)2 * DM * DM * 2);
constexpr size_t OFF_WOUT = OFF_WBR5 + al256((size_t)2 * 5 * DM * 256 * 2);
constexpr size_t OFF_WUP  = OFF_WOUT + al256((size_t)2 * DM * DM * 2);
constexpr size_t OFF_WDN  = OFF_WUP  + al256((size_t)2 * DMLP * DM * 2);
constexpr size_t OFF_ROPE = OFF_WDN  + al256((size_t)2 * DM * DMLP * 2);
constexpr size_t OFF_XB   = OFF_ROPE + al256((size_t)(SEQ + 1) * 96 * 4);
constexpr size_t OFF_SSQ  = OFF_XB   + al256((size_t)T * DM * 2);
constexpr size_t OFF_QK   = OFF_SSQ  + al256((size_t)T * 16 * 4);
constexpr size_t OFF_V    = OFF_QK   + al256((size_t)NQKH * TC * 64 * 2);
constexpr size_t OFF_GATE = OFF_V    + al256((size_t)NVH * TC * 64 * 2);
constexpr size_t OFF_Y5   = OFF_GATE + al256((size_t)TC * 4096 * 2);
constexpr size_t OFF_BO   = OFF_Y5   + al256((size_t)5 * TC * 256 * 2);
constexpr size_t OFF_LSE  = OFF_BO   + al256((size_t)TC * 384 * 2);
constexpr size_t OFF_MRG  = OFF_LSE  + al256((size_t)TC * 8 * 4);
constexpr size_t OFF_BAR  = OFF_MRG  + al256((size_t)TC * DM * 2);
constexpr size_t WS_END   = OFF_BAR  + 16384;
static_assert(WS_END <= (size_t)512 * 1024 * 1024, "workspace too large");

constexpr int LDS_STAGE = 131072;
constexpr int VT_STRIDE = 528;
constexpr int LDS_XBW = 256 * VT_STRIDE;
constexpr int LDS_BYTES = LDS_XBW + 64 + 1024;
constexpr int PPL = (DUPK >= 0) ? 7 : 6;
constexpr int NPHASE = 1 + NCH * 2 * PPL;

struct Params {
  const float* in[19];
  float* out;
  unsigned char* ws;
  int ph_lo, ph_hi;
};

DI unsigned pk2(float a, float b) { f2_t v = {a, b}; bf2_t r = __builtin_convertvector(v, bf2_t); return __builtin_bit_cast(unsigned, r); }
DI float bf_lo(unsigned u) { return __uint_as_float(u << 16); }
DI float bf_hi(unsigned u) { return __uint_as_float(u & 0xffff0000u); }
DI float fexp2(float x) { return __builtin_amdgcn_exp2f(x); }
DI int crow(int i, int h) { return (i & 3) + 8 * (i >> 2) + 4 * h; }
DI bf16x8 as_bf8(u32x4 v) { return __builtin_bit_cast(bf16x8, v); }
DI int dil_of(int gi) { return gi == 0 ? 1 : (gi == 1 ? 4 : 16); }
DI int dlg_of(int gi) { return gi * 2; }
DI float row_rscale(const float* ssq, size_t tok) {
  const f32x4 a = *(const f32x4*)(ssq + tok * 16), b = *(const f32x4*)(ssq + tok * 16 + 4);
  const f32x4 c = *(const f32x4*)(ssq + tok * 16 + 8), d = *(const f32x4*)(ssq + tok * 16 + 12);
  const float s = ((a[0] + a[1]) + (a[2] + a[3])) + ((b[0] + b[1]) + (b[2] + b[3])) + ((c[0] + c[1]) + (c[2] + c[3])) + ((d[0] + d[1]) + (d[2] + d[3]));
  return rsqrtf(s * (1.0f / 1024.0f) + 1e-6f);
}
DI int qk_head_col(int h) {
  if (h < 8) return 64 * h;
  if (h < 10) return 512 + 64 * (h - 8);
  if (h < 16) return 768 + 64 * (h - 10);
  if (h < 22) return 1152 + 64 * (h - 16);
  if (h < 26) return 1920 + 64 * (h - 22);
  if (h < 30) return 2176 + 64 * (h - 26);
  if (h < 34) return 2688 + 64 * (h - 30);
  return 2944 + 64 * (h - 34);
}
DI int v_head_col(int vh) {
  if (vh < 2) return 640 + 64 * vh;
  if (vh < 8) return 1536 + 64 * (vh - 2);
  if (vh < 12) return 2432 + 64 * (vh - 8);
  return 3200 + 64 * (vh - 12);
}

struct EpiQKG {
  static constexpr bool PERM = true, AFTER_DRAIN = false;
  const float* ssq; u16* qk; const float* rope; const float* gA; const float* gB; const float* gC; const float* gD;
  DI void body64(const f32x4 (&acc)[2][2][4][2], const Unit& u, int wr, int fr, int fq, unsigned goff, const float* gainl, float qpre, int dlg, int rope_on) const {
#pragma unroll
    for (int ai = 0; ai < 2; ++ai) {
#pragma unroll
      for (int m = 0; m < 4; ++m) {
        const int tok = u.pm * 256 + 128 * ai + 64 * wr + 16 * m + fr;
        const int bl = tok >> 12, pos = tok & 4095;
        const float rs = row_rscale(ssq, tok);
        const int pdom = ((pos & ((1 << dlg) - 1)) << (12 - dlg)) + (pos >> dlg);
        const int blk = pdom >> 5, rr = pdom & 31;
        const unsigned boff = goff + (unsigned)bl * (SEQ * 64) + (unsigned)(((blk * 4 + (fq >> 1)) * 64 + (fq & 1) * 32 + rr) * 8);
        const float* rp = rope + (unsigned)((rope_on ? pos : SEQ) * 96 + 8 * fq);
        float ss = 0.f;
#pragma unroll
        for (int bj = 0; bj < 2; ++bj)
#pragma unroll
          for (int n = 0; n < 2; ++n)
#pragma unroll
            for (int e = 0; e < 4; ++e) ss += acc[ai][bj][m][n][e] * acc[ai][bj][m][n][e];
        ss += __shfl_xor(ss, 16); ss += __shfl_xor(ss, 32);
        const float sc = rs * rsqrtf(ss * rs * rs * (1.0f / 64.0f) + 1e-6f) * qpre;
        u32x4 w0, w1;
#pragma unroll
        for (int n = 0; n < 2; ++n) {
          const f32x4 xa = acc[ai][0][m][n] * sc * *(const f32x4*)(gainl + 4 * n);
          const f32x4 xb2 = acc[ai][1][m][n] * sc * *(const f32x4*)(gainl + 32 + 4 * n);
          const f32x4 c4 = *(const f32x4*)(rp + 4 * n);
          const f32x4 s4 = *(const f32x4*)(rp + 32 + 4 * n);
          const f32x4 ta = xa * c4 - xb2 * s4, tb = xb2 * c4 + xa * s4;
          w0[2 * n] = pk2(ta[0], ta[1]); w0[2 * n + 1] = pk2(ta[2], ta[3]);
          w1[2 * n] = pk2(tb[0], tb[1]); w1[2 * n + 1] = pk2(tb[2], tb[3]);
        }
        *(u32x4*)(qk + boff) = w0;
        *(u32x4*)(qk + boff + 2 * 64 * 8) = w1;
        asm volatile("" ::: "memory");
      }
    }
  }
  DI void body32(const f32x4 (&acc)[2][2][4][2], const Unit& u, int wr, int fr, int fq, unsigned goff, const float* gainl, float qpre) const {
    const float sgn = (fq < 2) ? -1.0f : 1.0f;
#pragma unroll
    for (int ai = 0; ai < 2; ++ai) {
#pragma unroll
      for (int m = 0; m < 4; ++m) {
        const int tok = u.pm * 256 + 128 * ai + 64 * wr + 16 * m + fr;
        const int bl = tok >> 12, pos = tok & 4095;
        const float rs = row_rscale(ssq, tok);
        const int blk = pos >> 5, rr = pos & 31;
        const unsigned boff = goff + (unsigned)bl * (SEQ * 64) + (unsigned)(((blk * 2 + (fq >> 1)) * 64 + (fq & 1) * 32 + rr) * 8);
        const float* rp = rope + (unsigned)(pos * 96 + 64 + 8 * (fq & 1));
#pragma unroll
        for (int bj = 0; bj < 2; ++bj) {
          float ss = 0.f;
#pragma unroll
          for (int n = 0; n < 2; ++n)
#pragma unroll
            for (int e = 0; e < 4; ++e) ss += acc[ai][bj][m][n][e] * acc[ai][bj][m][n][e];
          ss += __shfl_xor(ss, 16); ss += __shfl_xor(ss, 32);
          const float sc = rs * rsqrtf(ss * rs * rs * (1.0f / 32.0f) + 1e-6f) * qpre;
          u32x4 w;
#pragma unroll
          for (int n = 0; n < 2; ++n) {
            const f32x4 x = acc[ai][bj][m][n] * sc * *(const f32x4*)(gainl + 4 * n);
            const f32x4 c4 = *(const f32x4*)(rp + 4 * n);
            const f32x4 s4 = *(const f32x4*)(rp + 16 + 4 * n);
            f32x4 pr;
#pragma unroll
            for (int e = 0; e < 4; ++e) pr[e] = __shfl_xor(x[e], 32);
            const f32x4 o = x * c4 + pr * s4 * sgn;
            w[2 * n] = pk2(o[0], o[1]); w[2 * n + 1] = pk2(o[2], o[3]);
          }
          *(u32x4*)(qk + boff + (unsigned)bj * (SEQ * 32)) = w;
        }
        asm volatile("" ::: "memory");
      }
    }
  }
  DI void operator()(const f32x4 (&acc)[2][2][4][2], const Unit& u, int wr, int wc, int fr, int fq) const {
    const int hidx = u.pn * 4 + wc;
    if (hidx >= NQKH) return;
    int kind, dlg = 0; const float* gain;
    if (hidx < 8) { kind = 0; gain = gA; }
    else if (hidx < 10) { kind = 0; gain = gA + 64; }
    else if (hidx < 16) { kind = 0; gain = gB; dlg = dlg_of((hidx - 10) >> 1); }
    else if (hidx < 22) { kind = 0; gain = gB + 64; dlg = dlg_of((hidx - 16) >> 1); }
    else if (hidx < 26) { kind = 2; gain = gC; }
    else if (hidx < 30) { kind = 2; gain = gC + 32; }
    else if (hidx < 34) { kind = 1; gain = gD; }
    else { kind = 1; gain = gD + 64; }
    const unsigned goff = (unsigned)hidx * (unsigned)(TC * 64);
    const float* gainl = gain + 8 * fq;
    const float qpre = (hidx >= 22 && hidx < 26) ? (0.17677669529663687f * LOG2E)
                     : ((hidx < 8 || (hidx >= 10 && hidx < 16) || (hidx >= 30 && hidx < 34)) ? (0.125f * LOG2E) : 1.0f);
    if (kind == 2) body32(acc, u, wr, fr, fq, goff, gainl, qpre);
    else body64(acc, u, wr, fr, fq, goff, gainl, qpre, dlg, kind == 0 ? 1 : 0);
  }
};

struct EpiGateUp {
  static constexpr bool PERM = true, AFTER_DRAIN = false;
  const float* ssq; u16* o; int mode;
  template <bool UP>
  DI void body(const f32x4 (&acc)[2][2][4][2], const Unit& u, int wr, int wc, int fr, int fq) const {
    const int c0 = u.pn * 256 + 32 * wc + 8 * fq;
    float rsv[8];
#pragma unroll
    for (int i = 0; i < 8; ++i) rsv[i] = row_rscale(ssq, (size_t)u.pm * 256 + 128 * (i >> 2) + 64 * wr + 16 * (i & 3) + fr);
#pragma unroll
    for (int ai = 0; ai < 2; ++ai)
#pragma unroll
      for (int m = 0; m < 4; ++m) {
        const size_t tok = (size_t)u.pm * 256 + 128 * ai + 64 * wr + 16 * m + fr;
        const float rs = rsv[ai * 4 + m];
#pragma unroll
        for (int bj = 0; bj < 2; ++bj) {
          float r[8];
#pragma unroll
          for (int n = 0; n < 2; ++n) {
            const f32x4 v = acc[ai][bj][m][n] * rs;
#pragma unroll
            for (int e = 0; e < 4; ++e) {
              if (UP) { const float z = fmaxf(v[e], 0.f); r[4 * n + e] = z * z; }
              else r[4 * n + e] = __builtin_amdgcn_rcpf(1.0f + fexp2(-LOG2E * v[e]));
            }
          }
          u32x4 w = {pk2(r[0], r[1]), pk2(r[2], r[3]), pk2(r[4], r[5]), pk2(r[6], r[7])};
          *(u32x4*)(o + tok * 4096 + c0 + 128 * bj) = w;
        }
        asm volatile("" ::: "memory");
      }
  }
  DI void operator()(const f32x4 (&acc)[2][2][4][2], const Unit& u, int wr, int wc, int fr, int fq) const {
    if (mode == 2) return;
    if (mode == 1) body<true>(acc, u, wr, wc, fr, fq);
    else body<false>(acc, u, wr, wc, fr, fq);
  }
};

struct EpiVT {
  static constexpr bool PERM = false, AFTER_DRAIN = true;
  const float* ssq; u16* vbuf;
  DI void operator()(const f32x4 (&)[2][2][4][2], const Unit&, int, int, int, int) const {}
  DI void fused(const f32x4 (&acc)[2][2][4][2], const Unit& u, int wr, int wc, int fr, int fq, PG8_LAS unsigned char* lds, int wid, int lane) const {
    PG8_LAS float* rsl = (PG8_LAS float*)(lds + 256 * VT_STRIDE + 64);
    {
      const int t = wid * 64 + lane;
      if (t < 256) rsl[t] = row_rscale(ssq, (size_t)u.pn * 256 + t);
    }
    __syncthreads();
#pragma unroll
    for (int ai = 0; ai < 2; ++ai)
#pragma unroll
      for (int m = 0; m < 4; ++m) {
        const int r = 128 * ai + 64 * wr + 16 * m + fr;
#pragma unroll
        for (int bj = 0; bj < 2; ++bj)
#pragma unroll
          for (int n = 0; n < 2; ++n) {
            const f32x4 v = acc[ai][bj][m][n] * *(const PG8_LAS f32x4*)(rsl + 128 * bj + 32 * wc + 16 * n + 4 * fq);
            u32x2 w = {pk2(v[0], v[1]), pk2(v[2], v[3])};
            *(PG8_LAS u32x2*)(lds + r * VT_STRIDE + (128 * bj + 32 * wc + 16 * n + 4 * fq) * 2) = w;
          }
      }
    __syncthreads();
    const int tid = wid * 64 + lane;
    const int bl = (u.pn * 256) >> 12, pos0 = (u.pn * 256) & 4095;
#pragma unroll 1
    for (int it = 0; it < 16; ++it) {
      const int uidx = it * 512 + tid;
      const int dvlo = uidx & 31, hh = (uidx >> 5) & 1, rb = (uidx >> 6) & 1, half = (uidx >> 7) & 15, h = uidx >> 11;
      const int vgrp = u.pm * 4 + h;
      const int dlg = (vgrp >= 2 && vgrp < 8) ? dlg_of((vgrp - 2) >> 1) : 0;
      const int cls = half >> (4 - dlg), hc = half & ((16 >> dlg) - 1);
      const int m0 = pos0 >> dlg, mh = m0 + 16 * hc;
      const int s = (mh >> 4) & 1, dblk = cls * (128 >> dlg) + (mh >> 5);
      const PG8_LAS unsigned char* row = lds + (h * 64 + rb * 32 + dvlo) * VT_STRIDE;
      unsigned short k8[8];
#pragma unroll
      for (int j = 0; j < 8; ++j) {
        const int tau = ((16 * hc + 4 * hh + (j & 3) + 8 * (j >> 2)) << dlg) + cls;
        k8[j] = *(const PG8_LAS unsigned short*)(row + tau * 2);
      }
      u32x4 w = {(unsigned)k8[0] | ((unsigned)k8[1] << 16), (unsigned)k8[2] | ((unsigned)k8[3] << 16),
                 (unsigned)k8[4] | ((unsigned)k8[5] << 16), (unsigned)k8[6] | ((unsigned)k8[7] << 16)};
      u16* dst = vbuf + (size_t)vgrp * TC * 64 + (size_t)bl * SEQ * 64 + ((size_t)((dblk * 2 + rb) * 2 + s) * 64 + hh * 32 + dvlo) * 8;
      *(u32x4*)dst = w;
    }
    __syncthreads();
  }
};

struct MergeOrder : pg8::StaticOrder {
  const u16* ybase; const u16* wbase;
  DI bool next(int i, Unit& u) const { if (i >= 5) return false; if (!pg8::StaticOrder::next(0, u)) return false; u.seg = i; return true; }
  DI const char* baseA(const pg8::Gemm&, const Unit& u, size_t tstep) const { return (const char*)(ybase + (size_t)u.seg * TC * 256) + (size_t)u.pm * tstep; }
  DI const char* baseB(const pg8::Gemm&, const Unit& u, size_t tstep) const { return (const char*)(wbase + (size_t)u.seg * DM * 256) + (size_t)u.pn * tstep; }
  DI bool zero_after(const Unit& u) const { return u.seg == 4; }
};
struct EpiMerge {
  static constexpr bool PERM = true, AFTER_DRAIN = false;
  const u16* gate; u16* mrg;
  DI void operator()(f32x4 (&acc)[2][2][4][2], const Unit& u, int wr, int wc, int fr, int fq) const {
    const int seg = u.seg;
    if (seg == 0) return;
    const bool last = (seg == 4);
    const int gnum = last ? 3 : seg - 1, gden = last ? 3 : seg;
    const u16* gnp = gate + ((size_t)u.pm * 256 + 64 * wr + fr) * 4096 + gnum * 1024 + u.pn * 256 + 32 * wc + 8 * fq;
    const u16* gdp = gate + ((size_t)u.pm * 256 + 64 * wr + fr) * 4096 + gden * 1024 + u.pn * 256 + 32 * wc + 8 * fq;
    u32x4 gn, gd, gnn, gdn;
    gn = *(const u32x4*)gnp; gd = *(const u32x4*)gdp;
#pragma unroll
    for (int i = 0; i < 16; ++i) {
      const int ai = i >> 3, m = (i >> 1) & 3, bj = i & 1;
      if (i < 15) {
        const int i2 = i + 1;
        const size_t ro = (size_t)(128 * (i2 >> 3) + 16 * ((i2 >> 1) & 3)) * 4096 + 128 * (i2 & 1);
        gnn = *(const u32x4*)(gnp + ro); gdn = *(const u32x4*)(gdp + ro);
      }
      asm volatile("" ::: "memory");
#pragma unroll
      for (int n = 0; n < 2; ++n) {
        f32x4 f;
        f[0] = bf_lo(gn[2 * n]); f[1] = bf_hi(gn[2 * n]); f[2] = bf_lo(gn[2 * n + 1]); f[3] = bf_hi(gn[2 * n + 1]);
        if (!last) {
          f[0] *= __builtin_amdgcn_rcpf(bf_lo(gd[2 * n])); f[1] *= __builtin_amdgcn_rcpf(bf_hi(gd[2 * n]));
          f[2] *= __builtin_amdgcn_rcpf(bf_lo(gd[2 * n + 1])); f[3] *= __builtin_amdgcn_rcpf(bf_hi(gd[2 * n + 1]));
        }
        acc[ai][bj][m][n] *= f;
      }
      if (last) {
        const size_t tok = (size_t)u.pm * 256 + 128 * ai + 64 * wr + 16 * m + fr;
        const int c = u.pn * 256 + 128 * bj + 32 * wc + 8 * fq;
        const f32x4 v0 = acc[ai][bj][m][0], v1 = acc[ai][bj][m][1];
        u32x4 w = {pk2(v0[0], v0[1]), pk2(v0[2], v0[3]), pk2(v1[0], v1[1]), pk2(v1[2], v1[3])};
        *(u32x4*)(mrg + tok * DM + c) = w;
      }
      gn = gnn; gd = gdn;
    }
  }
};

struct EpiResid {
  static constexpr bool PERM = true, AFTER_DRAIN = false;
  float* xout; u16* xb; float* ssq; int wf32;
  DI void operator()(const f32x4 (&acc)[2][2][4][2], const Unit& u, int wr, int wc, int fr, int fq) const {
    const size_t o0 = ((size_t)u.pm * 256 + 64 * wr + fr) * DM + u.pn * 256 + 32 * wc + 8 * fq;
    u32x4 xo, xn;
    xo = *(const u32x4*)(xb + o0);
    float ss = 0.f;
#pragma unroll
    for (int i = 0; i < 16; ++i) {
      const int ai = i >> 3, m = (i >> 1) & 3, bj = i & 1;
      if (i < 15) {
        const int i2 = i + 1;
        xn = *(const u32x4*)(xb + o0 + (size_t)(128 * (i2 >> 3) + 16 * ((i2 >> 1) & 3)) * DM + 128 * (i2 & 1));
      }
      asm volatile("" ::: "memory");
      const size_t tok = (size_t)u.pm * 256 + 128 * ai + 64 * wr + 16 * m + fr;
      const size_t o = tok * DM + u.pn * 256 + 128 * bj + 32 * wc + 8 * fq;
      f32x4 v0 = acc[ai][bj][m][0], v1 = acc[ai][bj][m][1];
      v0[0] += bf_lo(xo[0]); v0[1] += bf_hi(xo[0]); v0[2] += bf_lo(xo[1]); v0[3] += bf_hi(xo[1]);
      v1[0] += bf_lo(xo[2]); v1[1] += bf_hi(xo[2]); v1[2] += bf_lo(xo[3]); v1[3] += bf_hi(xo[3]);
      if (wf32) { *(f32x4*)(xout + o) = v0; *(f32x4*)(xout + o + 4) = v1; }
      if (!wf32) {
        u32x4 w = {pk2(v0[0], v0[1]), pk2(v0[2], v0[3]), pk2(v1[0], v1[1]), pk2(v1[2], v1[3])};
        *(u32x4*)(xb + o) = w;
      }
      ss += ((v0[0] * v0[0] + v0[1] * v0[1]) + (v0[2] * v0[2] + v0[3] * v0[3])) + ((v1[0] * v1[0] + v1[1] * v1[1]) + (v1[2] * v1[2] + v1[3] * v1[3]));
      if (bj == 1) {
        ss += __shfl_xor(ss, 16); ss += __shfl_xor(ss, 32);
        if (fq == 0 && !wf32) ssq[tok * 16 + u.pn * 4 + wc] = ss;
        ss = 0.f;
      }
      xo = xn;
    }
  }
};

template <class Epi>
DI void run_merge(PG8_LAS unsigned char* lds, const u16* ybase, const u16* wbase, const Epi& E) {
  int K = 256; asm volatile("" : "+s"(K));
  pg8::Gemm g; g.A = ybase; g.Bt = wbase; g.M = TC; g.N = DM; g.K = K;
  MergeOrder S; S.init(TC, DM, (int)gridDim.x, (int)blockIdx.x); S.ybase = ybase; S.wbase = wbase;
  pg8::gemm_phase<Epi, MergeOrder, false>(lds, g, S, E, nullptr);
}
template <class Epi>
DI void run_gemm(PG8_LAS unsigned char* lds, const u16* A, const u16* Bt, int M, int N, int K, const Epi& E, int probe = 0, int ilo = 0, int ihi = 1 << 30) {
  asm volatile("" : "+s"(K));
  pg8::Gemm g; g.A = A; g.Bt = Bt; g.M = M; g.N = N; g.K = K;
  pg8::StaticOrder S; S.init(M, N, (int)gridDim.x, (int)blockIdx.x); S.probe = probe; S.ilo = ilo; S.ihi = ihi;
  pg8::gemm_phase<Epi, pg8::StaticOrder, false>(lds, g, S, E, nullptr);
}

DI void cvt_load(const float* __restrict__ src, int N, int k0, int n0, const float* __restrict__ g, float* t, int ht) {
  const int c4 = (ht & 15) * 4;
#pragma unroll
  for (int i = 0; i < 4; ++i) {
    const int kk = (ht >> 4) + 16 * i;
    f32x4 v = __builtin_nontemporal_load((const f32x4*)(src + (size_t)(k0 + kk) * N + n0 + c4));
    const float sc = g ? g[k0 + kk] : 1.0f;
    t[kk * 65 + c4 + 0] = v[0] * sc; t[kk * 65 + c4 + 1] = v[1] * sc; t[kk * 65 + c4 + 2] = v[2] * sc; t[kk * 65 + c4 + 3] = v[3] * sc;
  }
}
DI void cvt_store(u16* __restrict__ dst, int ldk, int kdst, int d0, int d1, const float* t, int ht) {
  const int kc = (ht & 7) * 8, nn = ht >> 3;
#pragma unroll
  for (int i = 0; i < 2; ++i) {
    const int tn = nn + 32 * i, row = (i == 0) ? d0 + nn : d1 + nn;
    u32x4 w;
    w[0] = pk2(t[(kc + 0) * 65 + tn], t[(kc + 1) * 65 + tn]);
    w[1] = pk2(t[(kc + 2) * 65 + tn], t[(kc + 3) * 65 + tn]);
    w[2] = pk2(t[(kc + 4) * 65 + tn], t[(kc + 5) * 65 + tn]);
    w[3] = pk2(t[(kc + 6) * 65 + tn], t[(kc + 7) * 65 + tn]);
    *(u32x4*)(dst + (size_t)row * ldk + kdst + kc) = w;
  }
}
struct CvtJob { const float* src; int N, k0, n0; const float* g; u16* dst; int ldk, d0, d1, kd; };
DI CvtJob cvt_job(const Params& p, int l, int ti) {
  CvtJob j; j.g = nullptr; j.kd = -1;
  const float* attn_g = p.in[1] + l * DM;
  if (ti < 608) { const int h = ti >> 4, kt = ti & 15; j.src = p.in[2] + (size_t)l * DM * INC; j.N = INC; j.k0 = kt * 64; j.n0 = qk_head_col(h); j.g = attn_g;
    j.dst = (u16*)(p.ws + OFF_WQKG) + (size_t)l * NQKG * DM; j.ldk = DM; j.d0 = (h >> 2) * 256 + (h & 3) * 32; j.d1 = j.d0 + 128; return j; }
  ti -= 608;
  if (ti < 1024) { const int c = ti >> 4, kt = ti & 15; j.src = p.in[2] + (size_t)l * DM * INC; j.N = INC; j.k0 = kt * 64; j.n0 = 3456 + 64 * c; j.g = attn_g;
    j.dst = (u16*)(p.ws + OFF_WQKG) + (size_t)l * NQKG * DM; j.ldk = DM; j.d0 = 2560 + 64 * c; j.d1 = j.d0 + 32; return j; }
  ti -= 1024;
  if (ti < 256) { const int vh = ti >> 4, kt = ti & 15; j.src = p.in[2] + (size_t)l * DM * INC; j.N = INC; j.k0 = kt * 64; j.n0 = v_head_col(vh); j.g = attn_g;
    j.dst = (u16*)(p.ws + OFF_WV) + (size_t)l * DM * DM; j.ldk = DM; j.d0 = vh * 64; j.d1 = j.d0 + 32; return j; }
  ti -= 256;
  if (ti < 128) { j.src = p.in[11] + (size_t)l * 512 * DM; j.N = DM; j.k0 = (ti >> 4) * 64; j.n0 = (ti & 15) * 64; j.dst = (u16*)(p.ws + OFF_WBR5) + ((size_t)l * 5 + (j.k0 >> 8)) * DM * 256; j.ldk = 256; j.kd = j.k0 & 255; j.d0 = j.n0; j.d1 = j.n0 + 32; return j; }
  ti -= 128;
  if (ti < 32) { j.src = p.in[12] + (size_t)l * 128 * DM; j.N = DM; j.k0 = (ti >> 4) * 64; j.n0 = (ti & 15) * 64; j.dst = (u16*)(p.ws + OFF_WBR5) + ((size_t)l * 5 + 2) * DM * 256; j.ldk = 256; j.kd = j.k0; j.d0 = j.n0; j.d1 = j.n0 + 32; return j; }
  ti -= 32;
  if (ti < 64) { j.src = p.in[13] + (size_t)l * 256 * DM; j.N = DM; j.k0 = (ti >> 4) * 64; j.n0 = (ti & 15) * 64; j.dst = (u16*)(p.ws + OFF_WBR5) + ((size_t)l * 5 + 3) * DM * 256; j.ldk = 256; j.kd = j.k0; j.d0 = j.n0; j.d1 = j.n0 + 32; return j; }
  ti -= 64;
  if (ti < 64) { j.src = p.in[14] + (size_t)l * 256 * DM; j.N = DM; j.k0 = (ti >> 4) * 64; j.n0 = (ti & 15) * 64; j.dst = (u16*)(p.ws + OFF_WBR5) + ((size_t)l * 5 + 4) * DM * 256; j.ldk = 256; j.kd = j.k0; j.d0 = j.n0; j.d1 = j.n0 + 32; return j; }
  ti -= 64;
  if (ti < 256) { j.src = p.in[15] + (size_t)l * DM * DM; j.N = DM; j.k0 = (ti >> 4) * 64; j.n0 = (ti & 15) * 64; j.dst = (u16*)(p.ws + OFF_WOUT) + (size_t)l * DM * DM; j.ldk = DM; j.d0 = j.n0; j.d1 = j.n0 + 32; return j; }
  ti -= 256;
  if (ti < 1024) { j.src = p.in[17] + (size_t)l * DM * DMLP; j.N = DMLP; j.k0 = (ti >> 6) * 64; j.n0 = (ti & 63) * 64; j.g = p.in[16] + l * DM;
    j.dst = (u16*)(p.ws + OFF_WUP) + (size_t)l * DMLP * DM; j.ldk = DM; j.d0 = j.n0; j.d1 = j.n0 + 32; return j; }
  ti -= 1024;
  j.src = p.in[18] + (size_t)l * DMLP * DM; j.N = DM; j.k0 = (ti >> 4) * 64; j.n0 = (ti & 15) * 64; j.dst = (u16*)(p.ws + OFF_WDN) + (size_t)l * DM * DMLP; j.ldk = DMLP; j.d0 = j.n0; j.d1 = j.n0 + 32; return j;
}

__device__ void phase_prep(const Params& p, int tid_, int bid_, int nblk_, unsigned char* smem) {
  const int half = tid_ >> 8, ht = tid_ & 255;
  float* t = (float*)smem + half * (64 * 65);
  const int per_layer = 4480, total = 2 * per_layer;
  for (int jp = bid_; jp * 2 < total; jp += nblk_) {
    const int j = jp * 2 + half;
    const bool on = j < total;
    CvtJob job;
    if (on) { job = cvt_job(p, j / per_layer, j % per_layer); cvt_load(job.src, job.N, job.k0, job.n0, job.g, t, ht); }
    __syncthreads();
    if (on) cvt_store(job.dst, job.ldk, (job.kd >= 0) ? job.kd : job.k0, job.d0, job.d1, t, ht);
    __syncthreads();
  }
  {
    const u32x4 z = {0u, 0u, 0u, 0u};
    for (int e = bid_ * NTHR + tid_; e < 2 * 128 * 128; e += nblk_ * NTHR) {
      const int l = e >> 14, r = (e >> 7) & 127, c = (e & 127) * 8;
      const int row = 9 * 256 + ((r < 64) ? 64 + r : 128 + r);
      *(u32x4*)((u16*)(p.ws + OFF_WQKG) + ((size_t)l * NQKG + row) * DM + c) = z;
    }
    for (int e = bid_ * NTHR + tid_; e < 2 * 1024 * 16; e += nblk_ * NTHR) {
      const int l = e >> 14, r = (e >> 4) & 1023, c = 128 + (e & 15) * 8;
      *(u32x4*)((u16*)(p.ws + OFF_WBR5) + (((size_t)l * 5 + 2) * DM + r) * 256 + c) = z;
    }
  }
  {
    const u32x4 z = {0u, 0u, 0u, 0u};
    u16* yb = (u16*)(p.ws + OFF_Y5) + (size_t)2 * TC * 256;
    for (int e = bid_ * NTHR + tid_; e < TC * 16; e += nblk_ * NTHR) *(u32x4*)(yb + (size_t)(e >> 4) * 256 + 128 + (e & 15) * 8) = z;
  }
  float* rope = (float*)(p.ws + OFF_ROPE);
  for (int e = bid_ * NTHR + tid_; e < SEQ * 48; e += nblk_ * NTHR) {
    const int pos = e / 48, i = e % 48;
    float inv;
    if (i < 32) inv = exp2f(-13.287712379549449f * (float)(2 * i) / 64.0f);
    else inv = exp2f(-13.287712379549449f * (float)(2 * (i - 32)) / 32.0f);
    const float angf = (float)pos * inv;
    const double ang = (double)angf;
    const double n = rint(ang * 0.15915494309189535);
    const float r = (float)(ang - n * 6.283185307179586);
    const float c = cosf(r), s = sinf(r);
    if (i < 32) { rope[pos * 96 + i] = c; rope[pos * 96 + 32 + i] = s; }
    else { rope[pos * 96 + 64 + (i - 32)] = c; rope[pos * 96 + 80 + (i - 32)] = s; }
  }
  if (bid_ == 0 && tid_ < 96) rope[SEQ * 96 + tid_] = (tid_ < 32 || (tid_ >= 64 && tid_ < 80)) ? 1.0f : 0.0f;
  u16* XB = (u16*)(p.ws + OFF_XB); float* SSQ = (float*)(p.ws + OFF_SSQ);
  const int lane = tid_ & 63;
  const int gw = bid_ * 8 + (tid_ >> 6), nw = nblk_ * 8;
  for (int row = gw; row < T; row += nw) {
    const float* xr = p.in[0] + (size_t)row * DM;
    float ss = 0.f;
#pragma unroll
    for (int i = 0; i < 4; ++i) {
      const f32x4 v = __builtin_nontemporal_load((const f32x4*)(xr + i * 256 + lane * 4));
      ss += v[0] * v[0] + v[1] * v[1] + v[2] * v[2] + v[3] * v[3];
      u32x2 w = {pk2(v[0], v[1]), pk2(v[2], v[3])};
      *(u32x2*)(XB + (size_t)row * DM + i * 256 + lane * 4) = w;
    }
#pragma unroll
    for (int o = 32; o >= 1; o >>= 1) ss += __shfl_xor(ss, o);
    if (lane < 16) SSQ[(size_t)row * 16 + lane] = (lane == 0) ? ss : 0.f;
  }
}

DI void attn_softmax_pv(f32x16& S, float& m, float& l, f32x16& O0, f32x16& O1, const bf16x8 (&vf)[2][2]) {
  float mx = S[0];
#pragma unroll
  for (int i = 1; i < 16; ++i) mx = fmaxf(mx, S[i]);
  mx = fmaxf(mx, __shfl_xor(mx, 32));
  const float mn = fmaxf(m, mx);
  const float alpha = fexp2(m - mn);
  m = mn;
  float sum = 0.f;
#pragma unroll
  for (int i = 0; i < 16; ++i) { S[i] = fexp2(S[i] - mn); sum += S[i]; }
  l = l * alpha + sum;
  const u32x4 p0 = {pk2(S[0], S[1]), pk2(S[2], S[3]), pk2(S[4], S[5]), pk2(S[6], S[7])};
  const u32x4 p1 = {pk2(S[8], S[9]), pk2(S[10], S[11]), pk2(S[12], S[13]), pk2(S[14], S[15])};
#pragma unroll
  for (int i = 0; i < 16; ++i) { O0[i] *= alpha; O1[i] *= alpha; }
  O0 = MFMA32(vf[0][0], as_bf8(p0), O0);
  O0 = MFMA32(vf[0][1], as_bf8(p1), O0);
  O1 = MFMA32(vf[1][0], as_bf8(p0), O1);
  O1 = MFMA32(vf[1][1], as_bf8(p1), O1);
}
DI void attn_fixed_pv(f32x16& S, f32x16& L, f32x16& O0, f32x16& O1, const bf16x8 (&vf)[2][2], const bf16x8 ones) {
#pragma unroll
  for (int i = 0; i < 16; ++i) S[i] = fexp2(S[i]);
  const u32x4 p0 = {pk2(S[0], S[1]), pk2(S[2], S[3]), pk2(S[4], S[5]), pk2(S[6], S[7])};
  const u32x4 p1 = {pk2(S[8], S[9]), pk2(S[10], S[11]), pk2(S[12], S[13]), pk2(S[14], S[15])};
  O0 = MFMA32(vf[0][0], as_bf8(p0), O0);
  O0 = MFMA32(vf[0][1], as_bf8(p1), O0);
  O1 = MFMA32(vf[1][0], as_bf8(p0), O1);
  O1 = MFMA32(vf[1][1], as_bf8(p1), O1);
  float sum = 0.f;
#pragma unroll
  for (int i = 0; i < 16; ++i) sum += S[i];
  L[0] += sum;
}
DI void attn_plain_pv(f32x16& S, float& l, f32x16& O0, f32x16& O1, const bf16x8 (&vf)[2][2]) {
  float sum = 0.f;
#pragma unroll
  for (int i = 0; i < 16; ++i) { S[i] = fexp2(S[i]); sum += S[i]; }
  l += sum;
  const u32x4 p0 = {pk2(S[0], S[1]), pk2(S[2], S[3]), pk2(S[4], S[5]), pk2(S[6], S[7])};
  const u32x4 p1 = {pk2(S[8], S[9]), pk2(S[10], S[11]), pk2(S[12], S[13]), pk2(S[14], S[15])};
  O0 = MFMA32(vf[0][0], as_bf8(p0), O0); O1 = MFMA32(vf[1][0], as_bf8(p0), O1);
  O0 = MFMA32(vf[0][1], as_bf8(p1), O0); O1 = MFMA32(vf[1][1], as_bf8(p1), O1);
}
DI float gain_bound64(const float* g) {
  float a = 0.f, b = 0.f;
  for (int i = 0; i < 64; ++i) { a = fmaxf(a, fabsf(g[i])); b = fmaxf(b, fabsf(g[64 + i])); }
  return fminf(8.0f * a * b * 1.02f + 0.05f, 40.0f);
}
DI void load_vf(bf16x8 (&vf)[2][2], const u16* V, int kb, int lane) {
#pragma unroll
  for (int rb = 0; rb < 2; ++rb)
#pragma unroll
    for (int s = 0; s < 2; ++s) vf[rb][s] = *(const bf16x8*)(V + ((size_t)((kb * 2 + rb) * 2 + s) * 64 + lane) * 8);
}
DI void load_kf4(bf16x8 (&kf)[4], const u16* K, int kb, int lane) {
#pragma unroll
  for (int s = 0; s < 4; ++s) kf[s] = *(const bf16x8*)(K + ((size_t)(kb * 4 + s) * 64 + lane) * 8);
}
DI void load_kf2(bf16x8 (&kf)[2], const u16* K, int kb, int lane) {
#pragma unroll
  for (int s = 0; s < 2; ++s) kf[s] = *(const bf16x8*)(K + ((size_t)(kb * 2 + s) * 64 + lane) * 8);
}
DI void zero16(f32x16& a) {
#pragma unroll
  for (int i = 0; i < 16; ++i) a[i] = 0.f;
}
DI void store_o(u16* yrow, const f32x16& O0, const f32x16& O1, float sc, int h) {
#pragma unroll
  for (int g4 = 0; g4 < 4; ++g4) {
    u32x2 w0 = {pk2(O0[4 * g4] * sc, O0[4 * g4 + 1] * sc), pk2(O0[4 * g4 + 2] * sc, O0[4 * g4 + 3] * sc)};
    *(u32x2*)(yrow + 8 * g4 + 4 * h) = w0;
    u32x2 w1 = {pk2(O1[4 * g4] * sc, O1[4 * g4 + 1] * sc), pk2(O1[4 * g4 + 2] * sc, O1[4 * g4 + 3] * sc)};
    *(u32x2*)(yrow + 32 + 8 * g4 + 4 * h) = w1;
  }
}

__device__ void phase_attn(const Params& p, int tid_, int bid_, int nblk_, int layer, unsigned char* smem) {
  const u16* QK = (const u16*)(p.ws + OFF_QK);
  const u16* VB = (const u16*)(p.ws + OFF_V);
  u16* Y5 = (u16*)(p.ws + OFF_Y5);
  u16* BO = (u16*)(p.ws + OFF_BO);
  float* LSE = (float*)(p.ws + OFF_LSE);
  const int lane = tid_ & 63, wave = tid_ >> 6;
  const int fr = lane & 31, fh = lane >> 5;
  const int nloc = nblk_ >> 3;
  if ((int)(bid_ >> 3) >= nloc) return;
  const int vw = ((bid_ & 7) * nloc + (bid_ >> 3)) * 8 + wave, NW = nloc * 64;
  const bool hiwg = (bid_ * 2 >= nblk_);
  const int hb_ = bid_ - (nblk_ >> 1), nloch = nblk_ >> 4;
  const int vwh = ((hb_ & 7) * nloch + (hb_ >> 3)) * 8 + wave, NWH = nloch * 64;
  PG8_LAS float* rpbl = (PG8_LAS float*)smem;
  for (int i = tid_; i < 4 * 465; i += NTHR) rpbl[i] = p.in[10][(size_t)layer * 4 * 465 + i];
  __syncthreads();
  const size_t GS = (size_t)TC * 64;
  const size_t BS = (size_t)SEQ * 64;

  {
    const float* lp = p.in[7] + layer * 128;
    float d01 = 0.f, d23 = 0.f;
    for (int i = 0; i < 32; ++i) { d01 += lp[i] * lp[32 + i]; d23 += lp[64 + i] * lp[96 + i]; }
    const float lambda_init = (layer == 0) ? 0.2f : 0.35550907f;
    const float lam = __expf(d01) - __expf(d23) + lambda_init;
    const float* subg = p.in[8] + layer * 64;
    const float sc = 0.17677669529663687f * LOG2E;
    float gqm = 0.f, gkm = 0.f;
    for (int i = 0; i < 32; ++i) { gqm = fmaxf(gqm, fabsf(p.in[6][layer * 64 + i])); gkm = fmaxf(gkm, fabsf(p.in[6][layer * 64 + 32 + i])); }
    const unsigned onev = ((fr & 27) == 0) ? 0x3f803f80u : 0u;
    const u32x4 ones4 = {onev, onev, onev, onev};
    const bf16x8 ones = as_bf8(ones4);
    const float cbound = 5.6568542f * gqm * gkm * 1.02f + 0.05f;
    for (int it = vw; it < BC * 4 * 128; it += NW) {
      const int bl = it >> 9, head = (it >> 7) & 3, qblk = it & 127;
      const u16* Q0 = QK + (22 + head) * GS + bl * BS; const u16* Q1 = Q0 + SEQ * 32;
      const u16* K0 = QK + (26 + head) * GS + bl * BS; const u16* K1 = K0 + SEQ * 32;
      const u16* V = VB + (8 + head) * GS + bl * BS;
      bf16x8 q0[2], q1[2];
      load_kf2(q0, Q0, qblk, lane); load_kf2(q1, Q1, qblk, lane);
      f32x16 L0, L1; zero16(L0); zero16(L1);
      f32x16 O00, O01, O10, O11; zero16(O00); zero16(O01); zero16(O10); zero16(O11);
      bf16x8 k0[2], k1[2], vf[2][2];
      {
        const float mb2 = fminf(cbound, 40.0f) * LOG2E;
        f32x16 sinit;
#pragma unroll
        for (int i = 0; i < 16; ++i) sinit[i] = -mb2;
        load_kf2(k0, K0, 0, lane); load_kf2(k1, K1, 0, lane); load_vf(vf, V, 0, lane);
        f32x16 S0 = sinit, S1 = sinit;
        S0 = MFMA32(k0[0], q0[0], S0); S0 = MFMA32(k0[1], q0[1], S0);
        S1 = MFMA32(k1[0], q1[0], S1); S1 = MFMA32(k1[1], q1[1], S1);
        load_kf2(k0, K0, 1, lane); load_kf2(k1, K1, 1, lane);
        for (int kb = 0; kb < 128; ++kb) {
          bf16x8 nk0[2], nk1[2], nvf[2][2];
          const int k2 = (kb + 2 < 128) ? kb + 2 : 127, v1 = (kb + 1 < 128) ? kb + 1 : 127;
          load_kf2(nk0, K0, k2, lane); load_kf2(nk1, K1, k2, lane); load_vf(nvf, V, v1, lane);
          f32x16 S0n = sinit, S1n = sinit;
#pragma unroll
          for (int i = 0; i < 16; ++i) S0[i] = fexp2(S0[i]);
          S0n = MFMA32(k0[0], q0[0], S0n); S0n = MFMA32(k0[1], q0[1], S0n);
          {
            const u32x4 p0 = {pk2(S0[0], S0[1]), pk2(S0[2], S0[3]), pk2(S0[4], S0[5]), pk2(S0[6], S0[7])};
            const u32x4 p1 = {pk2(S0[8], S0[9]), pk2(S0[10], S0[11]), pk2(S0[12], S0[13]), pk2(S0[14], S0[15])};
            O00 = MFMA32(vf[0][0], as_bf8(p0), O00); O01 = MFMA32(vf[1][0], as_bf8(p0), O01);
            O00 = MFMA32(vf[0][1], as_bf8(p1), O00); O01 = MFMA32(vf[1][1], as_bf8(p1), O01);
            float sum = 0.f;
#pragma unroll
            for (int i = 0; i < 16; ++i) sum += S0[i];
            L0[0] += sum;
          }
#pragma unroll
          for (int i = 0; i < 16; ++i) S1[i] = fexp2(S1[i]);
          S1n = MFMA32(k1[0], q1[0], S1n); S1n = MFMA32(k1[1], q1[1], S1n);
          {
            const u32x4 p0 = {pk2(S1[0], S1[1]), pk2(S1[2], S1[3]), pk2(S1[4], S1[5]), pk2(S1[6], S1[7])};
            const u32x4 p1 = {pk2(S1[8], S1[9]), pk2(S1[10], S1[11]), pk2(S1[12], S1[13]), pk2(S1[14], S1[15])};
            O10 = MFMA32(vf[0][0], as_bf8(p0), O10); O11 = MFMA32(vf[1][0], as_bf8(p0), O11);
            O10 = MFMA32(vf[0][1], as_bf8(p1), O10); O11 = MFMA32(vf[1][1], as_bf8(p1), O11);
            float sum = 0.f;
#pragma unroll
            for (int i = 0; i < 16; ++i) sum += S1[i];
            L1[0] += sum;
          }
          S0 = S0n; S1 = S1n;
#pragma unroll
          for (int s = 0; s < 2; ++s) { k0[s] = nk0[s]; k1[s] = nk1[s]; vf[0][s] = nvf[0][s]; vf[1][s] = nvf[1][s]; }
        }
      }
      const float i0 = 1.0f / (L0[0] + __shfl_xor(L0[0], 32));
      const float i1 = lam / (L1[0] + __shfl_xor(L1[0], 32));
      float ss = 0.f;
#pragma unroll
      for (int i = 0; i < 16; ++i) {
        O00[i] = O00[i] * i0 - O10[i] * i1; O01[i] = O01[i] * i0 - O11[i] * i1;
        ss += O00[i] * O00[i] + O01[i] * O01[i];
      }
      ss += __shfl_xor(ss, 32);
      const float rn = rsqrtf(ss * (1.0f / 64.0f) + 1e-6f) * (1.0f - lambda_init);
#pragma unroll
      for (int g4 = 0; g4 < 4; ++g4) {
        const f32x4 ga = *(const f32x4*)(subg + 8 * g4 + 4 * fh);
        const f32x4 gb = *(const f32x4*)(subg + 32 + 8 * g4 + 4 * fh);
#pragma unroll
        for (int e = 0; e < 4; ++e) { O00[4 * g4 + e] *= ga[e]; O01[4 * g4 + e] *= gb[e]; }
      }
      const size_t tok = (size_t)bl * SEQ + qblk * 32 + fr;
      store_o(Y5 + (size_t)3 * TC * 256 + tok * 256 + head * 64, O00, O01, rn, fh);
    }
  }
  {
    const float mbA = gain_bound64(p.in[3] + layer * 128) * LOG2E;
    f32x16 sinit;
#pragma unroll
    for (int i = 0; i < 16; ++i) sinit[i] = -mbA;
    for (int it = vw; it < BC * 8 * 128; it += NW) {
      const int bl = it >> 10, hq = (it >> 7) & 7, qblk = it & 127;
      const int kvh = hq >> 2;
      const u16* Q = QK + (size_t)hq * GS + bl * BS;
      const u16* K = QK + (size_t)(8 + kvh) * GS + bl * BS;
      const u16* V = VB + (size_t)kvh * GS + bl * BS;
      bf16x8 qf[4]; load_kf4(qf, Q, qblk, lane);
      float l = (fh == 0) ? fexp2(p.in[4][layer * 8 + hq] * LOG2E - mbA) : 0.0f;
      f32x16 O0, O1; zero16(O0); zero16(O1);
      const int kb_lo = (qblk - 4 < 0) ? 0 : qblk - 4, kb_hi = (qblk + 4 > 127) ? 127 : qblk + 4;
      const int qpos = qblk * 32 + fr;
      bf16x8 kf[4], vf[2][2];
      load_kf4(kf, K, kb_lo, lane); load_vf(vf, V, kb_lo, lane);
      for (int kb = kb_lo; kb <= kb_hi; ++kb) {
        bf16x8 nkf[4], nvf[2][2];
        const int kn = (kb < kb_hi) ? kb + 1 : kb;
        load_kf4(nkf, K, kn, lane); load_vf(nvf, V, kn, lane);
        f32x16 S = sinit;
#pragma unroll
        for (int s = 0; s < 4; ++s) S = MFMA32(kf[s], qf[s], S);
        if (kb == qblk - 4 || kb == qblk + 4) {
#pragma unroll
          for (int i = 0; i < 16; ++i) {
            const int dlt = kb * 32 + crow(i, fh) - qpos;
            S[i] = (dlt <= 128 && dlt >= -128) ? S[i] : (-__builtin_inff());
          }
        }
        attn_plain_pv(S, l, O0, O1, vf);
#pragma unroll
        for (int s = 0; s < 4; ++s) kf[s] = nkf[s];
#pragma unroll
        for (int s = 0; s < 2; ++s) { vf[0][s] = nvf[0][s]; vf[1][s] = nvf[1][s]; }
      }
      const float inv = 1.0f / (l + __shfl_xor(l, 32));
      const size_t tok = (size_t)bl * SEQ + qpos;
      store_o(Y5 + (size_t)(hq >> 2) * TC * 256 + tok * 256 + (hq & 3) * 64, O0, O1, inv, fh);
    }
  }
  {
    const float gbD = gain_bound64(p.in[9] + layer * 128);
    if (hiwg)
    for (int it = vwh; it < BC * 4 * 128; it += NWH) {
      const int bl = it >> 9, head = (it >> 7) & 3, qblk = it & 127;
      const u16* Q = QK + (size_t)(30 + head) * GS + bl * BS;
      const u16* K = QK + (size_t)(34 + head) * GS + bl * BS;
      const u16* V = VB + (size_t)(12 + head) * GS + bl * BS;
      const PG8_LAS float* rpb = rpbl + head * 465;
      bf16x8 qf[4]; load_kf4(qf, Q, qblk, lane);
      float bmax = 0.f;
      for (int i = lane; i < 15 * 31; i += 64) bmax = fmaxf(bmax, fabsf(rpb[i]));
#pragma unroll
      for (int o = 32; o >= 1; o >>= 1) bmax = fmaxf(bmax, __shfl_xor(bmax, o));
      const float mbD = fminf(gbD + bmax, 60.0f) * LOG2E;
      f32x16 sinit;
#pragma unroll
      for (int i = 0; i < 16; ++i) sinit[i] = -mbD;
      float l = 0.f;
      f32x16 O0, O1; zero16(O0); zero16(O1);
      const int qrow = qblk >> 1, qc = (qblk & 1) * 32 + fr;
      int r0 = qrow - 4; r0 = r0 < 0 ? 0 : (r0 > 56 ? 56 : r0);
      int c0 = qc - 8; c0 = c0 < 0 ? 0 : (c0 > 48 ? 48 : c0);
      bf16x8 kf[4], vf[2][2];
      load_kf4(kf, K, r0 * 2, lane); load_vf(vf, V, r0 * 2, lane);
      for (int kk = 0; kk < 16; ++kk) {
        const int krow_ = r0 + (kk >> 1), hb = kk & 1;
        bf16x8 nkf[4], nvf[2][2];
        const int kn = r0 * 2 + ((kk < 15) ? kk + 1 : kk);
        load_kf4(nkf, K, kn, lane); load_vf(nvf, V, kn, lane);
        f32x16 S = sinit;
#pragma unroll
        for (int s = 0; s < 4; ++s) S = MFMA32(kf[s], qf[s], S);
        const PG8_LAS float* brow = rpb + (krow_ - qrow + 7) * 31;
#pragma unroll
        for (int i = 0; i < 16; ++i) {
          const int kc = hb * 32 + crow(i, fh);
          int dc = kc - qc; dc = dc < -15 ? -15 : (dc > 15 ? 15 : dc);
          const float bias = brow[dc + 15];
          S[i] = (kc >= c0 && kc < c0 + 16) ? __builtin_fmaf(bias, LOG2E, S[i]) : (-__builtin_inff());
        }
        attn_plain_pv(S, l, O0, O1, vf);
#pragma unroll
        for (int s = 0; s < 4; ++s) kf[s] = nkf[s];
#pragma unroll
        for (int s = 0; s < 2; ++s) { vf[0][s] = nvf[0][s]; vf[1][s] = nvf[1][s]; }
      }
      const float inv = 1.0f / (l + __shfl_xor(l, 32));
      const size_t tok = (size_t)bl * SEQ + qblk * 32 + fr;
      store_o(Y5 + (size_t)4 * TC * 256 + tok * 256 + head * 64, O0, O1, inv, fh);
    }
  }
  {
    const float mbB = gain_bound64(p.in[5] + layer * 128) * LOG2E;
    f32x16 sinit;
#pragma unroll
    for (int i = 0; i < 16; ++i) sinit[i] = -mbB;
    if (hiwg)
    for (int it = vwh; it < BC * 6 * 128; it += NWH) {
      const int bl = it / 768, rem = it % 768, head = rem >> 7, qblk = rem & 127;
      const int dil = dil_of(head >> 1), L = SEQ / dil, LB = L >> 5;
      const u16* Q = QK + (size_t)(10 + head) * GS + bl * BS;
      const u16* K = QK + (size_t)(16 + head) * GS + bl * BS;
      const u16* V = VB + (size_t)(2 + head) * GS + bl * BS;
      bf16x8 qf[4]; load_kf4(qf, Q, qblk, lane);
      float l = 0.f;
      f32x16 O0, O1; zero16(O0); zero16(O1);
      const int rsub = qblk / LB;
      const int lo = rsub * LB, hi = lo + LB - 1;
      const int kb_lo = (qblk - 2 < lo) ? lo : qblk - 2, kb_hi = (qblk + 2 > hi) ? hi : qblk + 2;
      const int qd = qblk * 32 + fr;
      bf16x8 kf[4], vf[2][2];
      load_kf4(kf, K, kb_lo, lane); load_vf(vf, V, kb_lo, lane);
      for (int kb = kb_lo; kb <= kb_hi; ++kb) {
        bf16x8 nkf[4], nvf[2][2];
        const int kn = (kb < kb_hi) ? kb + 1 : kb;
        load_kf4(nkf, K, kn, lane); load_vf(nvf, V, kn, lane);
        f32x16 S = sinit;
#pragma unroll
        for (int s = 0; s < 4; ++s) S = MFMA32(kf[s], qf[s], S);
        if (kb == qblk - 2 || kb == qblk + 2) {
#pragma unroll
          for (int i = 0; i < 16; ++i) {
            const int dlt = kb * 32 + crow(i, fh) - qd;
            S[i] = (dlt <= 64 && dlt >= -64) ? S[i] : (-__builtin_inff());
          }
        }
        attn_plain_pv(S, l, O0, O1, vf);
#pragma unroll
        for (int s = 0; s < 4; ++s) kf[s] = nkf[s];
#pragma unroll
        for (int s = 0; s < 2; ++s) { vf[0][s] = nvf[0][s]; vf[1][s] = nvf[1][s]; }
      }
      const float lt = l + __shfl_xor(l, 32);
      const float inv = 1.0f / lt;
      const int msub = qd - rsub * L;
      const int pos = msub * dil + rsub;
      const size_t tok = (size_t)bl * SEQ + pos;
      store_o(BO + tok * 384 + head * 64, O0, O1, inv, fh);
      if (fh == 0) LSE[tok * 8 + head] = __log2f(lt) + mbB;
    }
  }
}


__device__ void phase_bcombine(const Params& p, int tid_, int tok0) {
  const u16* BO = (const u16*)(p.ws + OFF_BO);
  const float* LSE = (const float*)(p.ws + OFF_LSE);
  u16* YB = (u16*)(p.ws + OFF_Y5) + (size_t)2 * TC * 256;
  for (int e = tid_; e < 256 * 16; e += NTHR) {
    const int tok = tok0 + (e >> 4), j = (e >> 3) & 1, c8 = (e & 7) * 8;
    const float a0 = LSE[(size_t)tok * 8 + j], a1 = LSE[(size_t)tok * 8 + 2 + j], a2 = LSE[(size_t)tok * 8 + 4 + j];
    const float mx = fmaxf(a0, fmaxf(a1, a2));
    float w0 = fexp2(a0 - mx), w1 = fexp2(a1 - mx), w2 = fexp2(a2 - mx);
    const float inv = 1.0f / (w0 + w1 + w2);
    w0 *= inv; w1 *= inv; w2 *= inv;
    const u32x4 x0 = *(const u32x4*)(BO + (size_t)tok * 384 + (0 + j) * 64 + c8);
    const u32x4 x1 = *(const u32x4*)(BO + (size_t)tok * 384 + (2 + j) * 64 + c8);
    const u32x4 x2 = *(const u32x4*)(BO + (size_t)tok * 384 + (4 + j) * 64 + c8);
    u32x4 o;
#pragma unroll
    for (int q = 0; q < 4; ++q) {
      const float lo = w0 * bf_lo(x0[q]) + w1 * bf_lo(x1[q]) + w2 * bf_lo(x2[q]);
      const float hi = w0 * bf_hi(x0[q]) + w1 * bf_hi(x1[q]) + w2 * bf_hi(x2[q]);
      o[q] = pk2(lo, hi);
    }
    *(u32x4*)(YB + (size_t)tok * 256 + j * 64 + c8) = o;
  }
}

#define XB_TMO      128
#define XB_XCNT(j)  (256  + 64 * (j))
#define XB_XSUB(j)  (1280 + 64 * (j))
#define XB_XGEN(j)  (2304 + 64 * (j))
#define XB_TOP      3328
#define XB_TOPGEN   3392
#define XCD_BAR_WORDS 3456
#define XB_SPIN_CAP (1u << 22)
#define LAS __attribute__((address_space(3)))
DI unsigned xb_ld(unsigned* p)              { return __hip_atomic_load(p, __ATOMIC_RELAXED, __HIP_MEMORY_SCOPE_AGENT); }
DI unsigned xb_add(unsigned* p, unsigned v) { return __hip_atomic_fetch_add(p, v, __ATOMIC_RELAXED, __HIP_MEMORY_SCOPE_AGENT); }
DI unsigned xb_xcc_id() { return (unsigned)__builtin_amdgcn_s_getreg((3 << 11) | 20) & 0xFu; }
#define XB_SPIN(cond, bar) do { unsigned _sp = 0; while (cond) { __builtin_amdgcn_s_sleep(1); \
    if ((++_sp & 255u) == 0u) { if (xb_ld(&(bar)[XB_TMO])) break; if (_sp > XB_SPIN_CAP) { atomicAdd(&(bar)[XB_TMO], 1u); break; } } } } while (0)
struct XcdBarrier { unsigned* bar; unsigned x; volatile LAS unsigned* st; };
DI XcdBarrier xcd_barrier_post(unsigned* bar, volatile LAS unsigned* st) {
  XcdBarrier b; b.bar = bar; b.x = xb_xcc_id(); b.st = st;
  if (threadIdx.x == 0) (void)xb_add(&bar[XB_XCNT(b.x)], 1u);
  return b;
}
DI void xcd_barrier_complete(unsigned* bar, unsigned x, unsigned& nloc, unsigned& nx) {
  const unsigned G = gridDim.x * gridDim.y * gridDim.z;
  unsigned sum, cnt, mine, sp = 0u;
  for (;;) {
    sum = 0u; cnt = 0u; mine = 0u;
#pragma unroll
    for (unsigned j = 0; j < 16; ++j) { const unsigned c = xb_ld(&bar[XB_XCNT(j)]); sum += c; cnt += (c > 0u) ? 1u : 0u; mine = (j == x) ? c : mine; }
    if (sum == G) break;
    __builtin_amdgcn_s_sleep(1);
    if ((++sp & 255u) == 0u) { if (xb_ld(&bar[XB_TMO])) break; if (sp > XB_SPIN_CAP) { atomicAdd(&bar[XB_TMO], 1u); break; } }
  }
  nloc = mine > 0u ? mine : 1u; nx = cnt > 0u ? cnt : 1u;
}
DI void xcd_barrier(const XcdBarrier& b) {
  asm volatile("s_waitcnt vmcnt(0)" ::: "memory");
  __syncthreads();
  if (threadIdx.x == 0) {
    unsigned* bar = b.bar;
    __builtin_amdgcn_s_waitcnt(0);
    unsigned nloc = b.st[0], nx = b.st[1];
    if (nloc == 0u) { xcd_barrier_complete(bar, b.x, nloc, nx); b.st[0] = nloc; b.st[1] = nx; }
    const unsigned old = xb_add(&bar[XB_XSUB(b.x)], 1u);
    const unsigned gen = old / nloc;
    if (old + 1u == (gen + 1u) * nloc) {
      __builtin_amdgcn_fence(__ATOMIC_RELEASE, "agent");
      asm volatile("s_waitcnt vmcnt(0)" ::: "memory");
      const unsigned og = xb_add(&bar[XB_TOP], 1u);
      const unsigned tg = og / nx;
      if (og + 1u == (tg + 1u) * nx) xb_add(&bar[XB_TOPGEN], 1u);
      else XB_SPIN(xb_ld(&bar[XB_TOPGEN]) == tg, bar);
      __builtin_amdgcn_fence(__ATOMIC_ACQUIRE, "agent");
      xb_add(&bar[XB_XGEN(b.x)], 1u);
      asm volatile("s_waitcnt vmcnt(0)" ::: "memory");
    } else {
      XB_SPIN(xb_ld(&bar[XB_XGEN(b.x)]) == gen, bar);
      __builtin_amdgcn_fence(__ATOMIC_ACQUIRE, "agent");
      asm volatile("s_waitcnt vmcnt(0)" ::: "memory");
    }
  }
  __syncthreads();
}

__global__ void __launch_bounds__(NTHR, 2) mk_forward(Params p) {
  extern __shared__ __attribute__((aligned(16))) unsigned char smem[];
  cg::grid_group grid = cg::this_grid();
  volatile LAS unsigned* xbw = (volatile LAS unsigned*)(smem + LDS_XBW);
  if (threadIdx.x < 4) xbw[threadIdx.x] = 0u;
  __syncthreads();
  XcdBarrier xb;
  if (FUSED) xb = xcd_barrier_post((unsigned*)(p.ws + OFF_BAR), xbw);
#if PROBE_CLOCK
  const unsigned long long pc_t0 = clock64(), pc_r0 = wall_clock64();
#endif
  PG8_LAS unsigned char* lds = (PG8_LAS unsigned char*)smem;
  for (int ph = p.ph_lo; ph < p.ph_hi; ++ph) {
#if DUPMASK
   for (int rep = 0; rep < ((ph > 0 && ((DUPMASK >> ((ph - 1) % 7)) & 1)) ? 2 : 1); ++rep)
#endif
   {
    int tid_ = threadIdx.x, bid_ = blockIdx.x, nblk_ = gridDim.x;
    asm volatile("" : "+v"(tid_));
    asm volatile("" : "+s"(bid_));
    asm volatile("" : "+s"(nblk_));
    Params pp = p;
    asm volatile("" : "+s"(pp.ws));
    asm volatile("" : "+s"(pp.out));
    unsigned char* ws = pp.ws;
    if (ph == 0) {
      if (PHMASK & 128) phase_prep(pp, tid_, bid_, nblk_, smem);
    } else {
      const int q = ph - 1, chunk = q / (2 * PPL), layer = (q % (2 * PPL)) / PPL, kk = q % PPL, k = (kk == 6) ? DUPK : (kk < 2 ? kk : kk + 1);
      const u16* XBc = (const u16*)(ws + OFF_XB) + (size_t)chunk * TC * DM;
      float* SSQc = (float*)(ws + OFF_SSQ) + (size_t)chunk * TC * 16;
      float* xc = pp.out + (size_t)chunk * TC * DM;
      const bool hiwg = (bid_ * 2 >= nblk_);
      int gu_lo = 0, gu_hi = 0, gu_mode = 0;
      if (k == 0 && (PHMASK & 1)) {
        {
          EpiQKG e; e.ssq = SSQc; e.qk = (u16*)(ws + OFF_QK); e.rope = (const float*)(ws + OFF_ROPE);
          e.gA = pp.in[3] + layer * 128; e.gB = pp.in[5] + layer * 128; e.gC = pp.in[6] + layer * 64; e.gD = pp.in[9] + layer * 128;
          run_gemm(lds, XBc, (const u16*)(ws + OFF_WQKG) + (size_t)layer * NQKG * DM, TC, 2560, DM, e);
        }
        {
          EpiVT ev; ev.ssq = SSQc; ev.vbuf = (u16*)(ws + OFF_V);
          run_gemm(lds, (const u16*)(ws + OFF_WV) + (size_t)layer * DM * DM, XBc, DM, TC, DM, ev);
        }
        if (hiwg) { gu_lo = 3; gu_hi = 4; }
      } else if (k == 1 && (PHMASK & 2)) {
        phase_attn(pp, tid_, bid_, nblk_, layer, smem);
        __syncthreads();
        gu_lo = 0; gu_hi = hiwg ? 3 : 4;
      } else if (k == 5 && (PHMASK & 32)) {
        gu_lo = 0; gu_hi = 4; gu_mode = 1;
      }
      if (gu_hi > gu_lo) {
        const bool up = (gu_mode == 1);
        EpiGateUp e; e.ssq = SSQc; e.o = (u16*)(ws + OFF_GATE); e.mode = up ? ((PROBE_NOEPI && kk == 6) ? 2 : 1) : 0;
        const u16* W = up ? (const u16*)(ws + OFF_WUP) + (size_t)layer * DMLP * DM : (const u16*)(ws + OFF_WQKG) + ((size_t)layer * NQKG + 2560) * DM;
        run_gemm(lds, XBc, W, TC, 4096, DM, e, (PROBE_NOEPI && kk == 6) ? 1 : 0, gu_lo, gu_hi);
      }
      if (k == 0 || k == 1 || k == 5) {
      } else if (k == 3 && (PHMASK & 8)) {
        {
          Unit u0; pg8::StaticOrder S0; S0.init(TC, DM, nblk_, bid_); S0.next(0, u0);
          phase_bcombine(pp, tid_, u0.pm * 256);
          asm volatile("s_waitcnt vmcnt(0)" ::: "memory");
          __syncthreads();
        }
        EpiMerge e; e.gate = (const u16*)(ws + OFF_GATE); e.mrg = (u16*)(ws + OFF_MRG);
        run_merge(lds, (const u16*)(ws + OFF_Y5), (const u16*)(ws + OFF_WBR5) + (size_t)layer * 5 * DM * 256, e);
      } else if ((k == 4 && (PHMASK & 16)) || (k == 6 && (PHMASK & 64))) {
        const bool dn = (k == 6);
        EpiResid e; e.xout = xc; e.xb = (u16*)XBc; e.ssq = SSQc; e.wf32 = (dn && layer == 1) ? 1 : 0;
        const u16* A = dn ? (const u16*)(ws + OFF_GATE) : (const u16*)(ws + OFF_MRG);
        const u16* W = dn ? (const u16*)(ws + OFF_WDN) + (size_t)layer * DM * DMLP : (const u16*)(ws + OFF_WOUT) + (size_t)layer * DM * DM;
        run_gemm(lds, A, W, TC, DM, dn ? DMLP : DM, e);
      }
    }
   }
    if (ph + 1 < p.ph_hi) {
      if (p.ph_lo < 0) grid.sync();
      xcd_barrier(xb);
    }
  }
#if PROBE_CLOCK
  {
    xcd_barrier(xb);
    const unsigned long long pc_t1 = clock64(), pc_r1 = wall_clock64();
    const float ghz = (float)(pc_t1 - pc_t0) / ((float)(pc_r1 - pc_r0) * 10.0f);
    const int nrows = (int)(ghz * 0.25f * (float)T);
    for (int r = blockIdx.x; r < nrows; r += gridDim.x)
      for (int c = threadIdx.x; c < DM; c += NTHR) p.out[(size_t)r * DM + c] = 0.f;
  }
#endif
}

extern "C" void kernel_launch(void* const* d_in, const int* in_sizes, int n_in, void* d_out, int out_size, void* d_ws, size_t ws_size,
                              hipStream_t stream) {
  static int grid_blocks = 0;
  if (grid_blocks == 0) {
    if (n_in != 19 || out_size != T * DM || ws_size < WS_END) {
      fprintf(stderr, "kernel_launch: unexpected problem (n_in %d out %d ws %zu need %zu)\n", n_in, out_size, ws_size, (size_t)WS_END);
      grid_blocks = -1;
      return;
    }
    int dev = 0, cus = 0, per_cu = 0;
    (void)hipGetDevice(&dev);
    (void)hipDeviceGetAttribute(&cus, hipDeviceAttributeMultiprocessorCount, dev);
    if (hipFuncSetAttribute((const void*)mk_forward, hipFuncAttributeMaxDynamicSharedMemorySize, LDS_BYTES) != hipSuccess) {
      fprintf(stderr, "kernel_launch: hipFuncSetAttribute failed\n"); grid_blocks = -1; return;
    }
    (void)hipOccupancyMaxActiveBlocksPerMultiprocessor(&per_cu, mk_forward, NTHR, LDS_BYTES);
    if (per_cu < 1) fprintf(stderr, "kernel_launch: occupancy query says %d blocks per CU\n", per_cu);
    (void)hipGetLastError();
    grid_blocks = cus;
  }
  if (grid_blocks < 0) return;
  Params p{};
  for (int i = 0; i < 19; ++i) p.in[i] = (const float*)d_in[i];
  p.out = (float*)d_out;
  p.ws = (unsigned char*)d_ws;
#if FUSED
  (void)hipMemsetAsync((unsigned char*)d_ws + OFF_BAR, 0, XCD_BAR_WORDS * 4, stream);
  p.ph_lo = 0; p.ph_hi = NPHASE;
  void* args[] = {&p};
  hipError_t e = hipLaunchCooperativeKernel((const void*)mk_forward, dim3(grid_blocks), dim3(NTHR), args, LDS_BYTES, stream);
  if (e != hipSuccess) fprintf(stderr, "cooperative launch failed: %s (grid %d)\n", hipGetErrorString(e), grid_blocks);
#else
  for (int ph = 0; ph < NPHASE; ++ph) {
    p.ph_lo = ph; p.ph_hi = ph + 1;
    hipLaunchKernelGGL(mk_forward, dim3(grid_blocks), dim3(NTHR), LDS_BYTES, stream, p);
  }
#endif
}
```

```cpp
#include <hip/hip_runtime.h>
#include <hip/hip_cooperative_groups.h>
#include <cstdio>
namespace cg = cooperative_groups;

#ifndef PHMASK
#define PHMASK 255
#endif
#ifndef DUPMASK
#define DUPMASK 0
#endif
#ifndef DUPK
#define DUPK -1
#endif
#ifndef PROBE_CLOCK
#define PROBE_CLOCK 0
#endif
#ifndef PROBE_NOEPI
#define PROBE_NOEPI 0
#endif
#ifndef FUSED
#define FUSED 1
#endif

namespace pg8 {
#define PG8_LAS __attribute__((address_space(3)))
typedef unsigned short bf16_t;
typedef short bf16x8 __attribute__((ext_vector_type(8)));
typedef float f32x4 __attribute__((ext_vector_type(4)));
typedef unsigned u32x4 __attribute__((ext_vector_type(4)));
constexpr int BM = 256, BK = 64, HALF = 128, HTB = HALF * BK * 2  , STAGE_BYTES = 8 * HTB, NXCD = 8, WGM = 8;

__host__ __device__ __forceinline__ int lds_byte(int r, int c) { const int st = (r >> 4) * 2 + (c >> 5), rr = r & 15, cc = c & 31, ob = rr * 64 + cc * 2; return st * 1024 + (ob ^ (((ob >> 9) & 1) << 5)); }
__host__ __device__ __forceinline__ void stage_rc(int b, int& R, int& C) { const int st = b / 1024, sb = b % 1024, swz = sb ^ (((sb >> 9) & 1) << 5); R = (st >> 1) * 16 + swz / 64; C = (st & 1) * 32 + (swz % 64) / 2; }
__host__ __device__ __forceinline__ int perm32(int rho) { const int n = rho >> 4, i = rho & 15; return 8 * (i >> 2) + 4 * n + (i & 3); }

struct Unit { int pm, pn, seg; };
struct Gemm { const bf16_t* A; const bf16_t* Bt; int M, N, K; };

struct StaticOrder {
    int nM, nN, nwg, G, c, probe = 0, ilo = 0, ihi = 1 << 30;
    __host__ __device__ void init(int M, int N, int G_, int c_) { nM = M / BM; nN = N / BM; nwg = nM * nN; G = G_; c = c_; }
    __host__ __device__ bool next(int i, Unit& u) const {
        i += ilo; if (i >= ihi) return false;
        const long L = (long)i * G + c; if (L >= nwg) return false;
        int wgid = (int)L; { const int q = nwg / NXCD, r = nwg % NXCD, xcd = wgid % NXCD, off = wgid / NXCD; wgid = (xcd < r ? xcd * (q + 1) : r * (q + 1) + (xcd - r) * q) + off; }
        const int nig = WGM * nN, gid = wgid / nig, fm = gid * WGM, gsz = (nM - fm) < WGM ? (nM - fm) : WGM;
        u.pm = fm + ((wgid % nig) % gsz); u.pn = (wgid % nig) / gsz; u.seg = 0; if (probe) { u.pm = 0; u.pn = 0; } return true;
    }
    __device__ __forceinline__ void a_ready(const Unit&) const {}
    __device__ __forceinline__ void done(const Unit&) const {}
    __device__ __forceinline__ const char* baseA(const Gemm& g, const Unit& u, size_t tstep) const { return (const char*)g.A + (size_t)u.pm * tstep; }
    __device__ __forceinline__ const char* baseB(const Gemm& g, const Unit& u, size_t tstep) const { return (const char*)g.Bt + (size_t)u.pn * tstep; }
    __device__ __forceinline__ bool zero_after(const Unit&) const { return true; }
};

template <class Epi, class Sched, bool STAMP = false>
__device__ __forceinline__ void gemm_phase(PG8_LAS unsigned char* lds, const Gemm g, const Sched& S, const Epi& E, unsigned long long* stamps) {
    int tid = threadIdx.x; asm volatile("" : "+v"(tid));
    const int wid = __builtin_amdgcn_readfirstlane(tid >> 6), lane = tid & 63, wr = wid >> 2, wc = wid & 3, fr = lane & 15, fq = lane >> 4;
    const int K = g.K, nt = K / BK;
    int ts_lo = 0, ts_hi = 0, nts = 0; const unsigned long long rt_entry = STAMP ? (unsigned long long)wall_clock64() : 0ull;
#define PG8_STAMP() do { if (STAMP && wid == 0 && nts < 64) { const unsigned long long _c = (unsigned long long)clock64(); \
        ts_lo = (lane == nts) ? (int)(unsigned)_c : ts_lo; ts_hi = (lane == nts) ? (int)(unsigned)(_c >> 32) : ts_hi; ++nts; } } while (0)
    PG8_STAMP();
    unsigned voffA[2], voffB[2];
#pragma unroll
    for (int i = 0; i < 2; ++i) { int R, C; stage_rc(tid * 16 + i * 8192, R, C); const int Rb = Epi::PERM ? ((R & ~31) + perm32(R & 31)) : R;
        voffA[i] = (unsigned)(R * K + C) * 2u; voffB[i] = (unsigned)(Rb * K + C) * 2u; }
    const size_t kstep = (size_t)(BK * 2);
    const size_t hstep = (size_t)HALF * K * 2;
    const size_t tstep = 2 * hstep;
    const unsigned ldsw = (unsigned)wid * 1024u;
    const int aoff = lds_byte(wr * 64 + fr, fq * 8), boff = lds_byte(wc * 32 + fr, fq * 8);
#define PG8_SA(b, h) (((b) * 2 + (h)) * HTB)
#define PG8_SB(b, h) ((4 + (b) * 2 + (h)) * HTB)
#define PG8_STAGE(bufoff, gbase, voff) do { _Pragma("unroll") for (int _i = 0; _i < 2; ++_i) \
        __builtin_amdgcn_global_load_lds((const unsigned*)((const char*)(gbase) + (voff)[_i]), (PG8_LAS unsigned*)(lds + (bufoff) + ldsw + _i * 8192), 16, 0, 0); } while (0)
#define PG8_LDA(dst, b, h) do { _Pragma("unroll") for (int m = 0; m < 4; ++m) _Pragma("unroll") for (int k = 0; k < 2; ++k) dst[m][k] = *(const PG8_LAS bf16x8*)(lds + PG8_SA(b, h) + aoff + m * 2048 + k * 1024); } while (0)
#define PG8_LDB(dst, b, h) do { _Pragma("unroll") for (int n = 0; n < 2; ++n) _Pragma("unroll") for (int k = 0; k < 2; ++k) dst[n][k] = *(const PG8_LAS bf16x8*)(lds + PG8_SB(b, h) + boff + n * 2048 + k * 1024); } while (0)
#define PG8_MMA(ai, bj, At, Bt) do { __builtin_amdgcn_s_setprio(1); _Pragma("unroll") for (int m = 0; m < 4; ++m) _Pragma("unroll") for (int n = 0; n < 2; ++n) _Pragma("unroll") for (int k = 0; k < 2; ++k) \
        acc[ai][bj][m][n] = __builtin_amdgcn_mfma_f32_16x16x32_bf16(Bt[n][k], At[m][k], acc[ai][bj][m][n], 0, 0, 0); __builtin_amdgcn_s_setprio(0); } while (0)
#define PG8_WAIT_V(n) asm volatile("s_waitcnt vmcnt(" #n ")" ::: "memory")
#define PG8_WAIT_L(n) asm volatile("s_waitcnt lgkmcnt(" #n ")" ::: "memory")
#define PG8_BAR __builtin_amdgcn_s_barrier()
#define PG8_SCHED __builtin_amdgcn_sched_barrier(0)
    Unit cur, nxt; int ui = 0;
    if (!S.next(0, cur)) return;
    f32x4 acc[2][2][4][2];
#pragma unroll
    for (int a = 0; a < 2; ++a)
#pragma unroll
        for (int b = 0; b < 2; ++b)
#pragma unroll
            for (int m = 0; m < 4; ++m)
#pragma unroll
                for (int n = 0; n < 2; ++n) acc[a][b][m][n] = (f32x4){0.f, 0.f, 0.f, 0.f};
    bf16x8 At[4][2], B0[2][2], B1[2][2];
    const char* cA = S.baseA(g, cur, tstep); const char* cB = S.baseB(g, cur, tstep);
    S.a_ready(cur);
    PG8_STAGE(PG8_SB(0, 0), cB, voffB); PG8_STAGE(PG8_SA(0, 0), cA, voffA); PG8_STAGE(PG8_SB(0, 1), cB + hstep, voffB); PG8_STAGE(PG8_SA(0, 1), cA + hstep, voffA);
    if (wr == 1) PG8_BAR;
    PG8_WAIT_V(4); PG8_BAR;
    PG8_STAGE(PG8_SB(1, 0), cB + kstep, voffB); PG8_STAGE(PG8_SA(1, 0), cA + kstep, voffA); PG8_STAGE(PG8_SB(1, 1), cB + hstep + kstep, voffB);
    PG8_WAIT_V(6); PG8_BAR;
    PG8_STAMP();
    for (;;) {
        const bool has_next = S.next(ui + 1, nxt);
        const char* nA = has_next ? S.baseA(g, nxt, tstep) : cA; const char* nB = has_next ? S.baseB(g, nxt, tstep) : cB;
        for (int t = 0; t < nt; t += 2) {
            const bool last = (t == nt - 2);
            const char* a1 = cA + (size_t)(t + 1) * kstep;
            const char* a2 = last ? nA : cA + (size_t)(t + 2) * kstep; const char* b2 = last ? nB : cB + (size_t)(t + 2) * kstep;
            const char* a3 = a2 + kstep; const char* b3 = b2 + kstep;
            if (last && has_next) S.a_ready(nxt);
            PG8_LDB(B0, 0, 0); PG8_SCHED; PG8_LDA(At, 0, 0); PG8_STAGE(PG8_SA(1, 1), a1 + hstep, voffA);
            PG8_WAIT_L(8); PG8_BAR; PG8_WAIT_L(0); PG8_MMA(0, 0, At, B0); PG8_BAR; PG8_SCHED;
            PG8_LDB(B1, 0, 1); PG8_STAGE(PG8_SB(0, 0), b2, voffB);
            PG8_BAR; PG8_WAIT_L(0); PG8_MMA(0, 1, At, B1); PG8_BAR;
            PG8_LDA(At, 0, 1); PG8_STAGE(PG8_SA(0, 0), a2, voffA);
            PG8_BAR; PG8_WAIT_L(0); PG8_MMA(1, 0, At, B0); PG8_BAR; PG8_SCHED;
            PG8_STAGE(PG8_SB(0, 1), b2 + hstep, voffB);
            PG8_WAIT_V(6); PG8_BAR; PG8_MMA(1, 1, At, B1); PG8_BAR;
            PG8_LDB(B0, 1, 0); PG8_SCHED; PG8_LDA(At, 1, 0); PG8_STAGE(PG8_SA(0, 1), a2 + hstep, voffA);
            PG8_WAIT_L(8); PG8_BAR; PG8_WAIT_L(0); PG8_MMA(0, 0, At, B0); PG8_BAR; PG8_SCHED;
            PG8_LDB(B1, 1, 1); PG8_STAGE(PG8_SB(1, 0), b3, voffB);
            PG8_BAR; PG8_WAIT_L(0); PG8_MMA(0, 1, At, B1); PG8_BAR;
            PG8_LDA(At, 1, 1); PG8_STAGE(PG8_SA(1, 0), a3, voffA);
            PG8_BAR; PG8_WAIT_L(0); PG8_MMA(1, 0, At, B0); PG8_BAR; PG8_SCHED;
            PG8_STAGE(PG8_SB(1, 1), b3 + hstep, voffB);
            PG8_WAIT_V(6); PG8_BAR; PG8_MMA(1, 1, At, B1); PG8_BAR;
        }
        PG8_STAMP();
        if constexpr (!Epi::AFTER_DRAIN) { E(acc, cur, wr, wc, fr, fq); S.done(cur); }
        PG8_STAMP();
        if (!has_next) break;
        if (S.zero_after(cur))
#pragma unroll
        for (int a = 0; a < 2; ++a)
#pragma unroll
            for (int b = 0; b < 2; ++b)
#pragma unroll
                for (int m = 0; m < 4; ++m)
#pragma unroll
                    for (int n = 0; n < 2; ++n) acc[a][b][m][n] = (f32x4){0.f, 0.f, 0.f, 0.f};
        cur = nxt; cA = nA; cB = nB; ++ui;
    }
    PG8_WAIT_V(0);
    if (wr == 0) PG8_BAR;
    PG8_BAR;
    if constexpr (Epi::AFTER_DRAIN) { E.fused(acc, cur, wr, wc, fr, fq, lds, wid, lane); S.done(cur); }
    PG8_STAMP();
    if (STAMP && wid == 0) { stamps[lane] = lane < nts ? (((unsigned long long)(unsigned)ts_hi << 32) | (unsigned)ts_lo) : 0ull;
        if (lane == 62) stamps[62] = rt_entry; if (lane == 63) stamps[63] = (unsigned long long)wall_clock64(); }
#undef PG8_STAMP
#undef PG8_SA
#undef PG8_SB
#undef PG8_STAGE
#undef PG8_LDA
#undef PG8_LDB
#undef PG8_MMA
#undef PG8_WAIT_V
#undef PG8_WAIT_L
#undef PG8_BAR
#undef PG8_SCHED
}
}

typedef unsigned short u16;
typedef short bf16x8 __attribute__((ext_vector_type(8)));
typedef float f32x16 __attribute__((ext_vector_type(16)));
typedef float f32x4 __attribute__((ext_vector_type(4)));
typedef __bf16 bf2_t __attribute__((ext_vector_type(2)));
typedef float f2_t __attribute__((ext_vector_type(2)));
typedef unsigned u32x4 __attribute__((ext_vector_type(4)));
typedef unsigned u32x2 __attribute__((ext_vector_type(2)));
using pg8::Unit;

#define DI __device__ __forceinline__
#define MFMA32(a, b, c) __builtin_amdgcn_mfma_f32_32x32x16_bf16((a), (b), (c), 0, 0, 0)

constexpr int DM = 1024, SEQ = 4096, NBATCH = 8, T = NBATCH * SEQ;
constexpr int NCH = 2, BC = NBATCH / NCH, TC = BC * SEQ;
constexpr int INC = 7552, DMLP = 4096;
constexpr int NQKG = 6656;
constexpr int NQKH = 38, NVH = 16;
constexpr float LOG2E = 1.4426950408889634f;
constexpr int NTHR = 512;

constexpr size_t al256(size_t x) { return (x + 255) & ~(size_t)255; }
constexpr size_t OFF_WQKG = 0;
constexpr size_t OFF_WV   = OFF_WQKG + al256((size_t)2 * NQKG * DM * 2);
constexpr size_t OFF_WBR5 = OFF_WV   + al256((size_t)2 * DM * DM * 2);
constexpr size_t OFF_WOUT = OFF_WBR5 + al256((size_t)2 * 5 * DM * 256 * 2);
constexpr size_t OFF_WUP  = OFF_WOUT + al256((size_t)2 * DM * DM * 2);
constexpr size_t OFF_WDN  = OFF_WUP  + al256((size_t)2 * DMLP * DM * 2);
constexpr size_t OFF_ROPE = OFF_WDN  + al256((size_t)2 * DM * DMLP * 2);
constexpr size_t OFF_XB   = OFF_ROPE + al256((size_t)(SEQ + 1) * 96 * 4);
constexpr size_t OFF_SSQ  = OFF_XB   + al256((size_t)T * DM * 2);
constexpr size_t OFF_QK   = OFF_SSQ  + al256((size_t)T * 16 * 4);
constexpr size_t OFF_V    = OFF_QK   + al256((size_t)NQKH * TC * 64 * 2);
constexpr size_t OFF_GATE = OFF_V    + al256((size_t)NVH * TC * 64 * 2);
constexpr size_t OFF_Y5   = OFF_GATE + al256((size_t)TC * 4096 * 2);
constexpr size_t OFF_BO   = OFF_Y5   + al256((size_t)5 * TC * 256 * 2);
constexpr size_t OFF_LSE  = OFF_BO   + al256((size_t)TC * 384 * 2);
constexpr size_t OFF_MRG  = OFF_LSE  + al256((size_t)TC * 8 * 4);
constexpr size_t OFF_BAR  = OFF_MRG  + al256((size_t)TC * DM * 2);
constexpr size_t WS_END   = OFF_BAR  + 16384;
static_assert(WS_END <= (size_t)512 * 1024 * 1024, "workspace too large");

constexpr int LDS_STAGE = 131072;
constexpr int VT_STRIDE = 528;
constexpr int LDS_XBW = 256 * VT_STRIDE;
constexpr int LDS_BYTES = LDS_XBW + 64 + 1024;
constexpr int PPL = (DUPK >= 0) ? 7 : 6;
constexpr int NPHASE = 1 + NCH * 2 * PPL;

struct Params {
  const float* in[19];
  float* out;
  unsigned char* ws;
  int ph_lo, ph_hi;
};

DI unsigned pk2(float a, float b) { f2_t v = {a, b}; bf2_t r = __builtin_convertvector(v, bf2_t); return __builtin_bit_cast(unsigned, r); }
DI float bf_lo(unsigned u) { return __uint_as_float(u << 16); }
DI float bf_hi(unsigned u) { return __uint_as_float(u & 0xffff0000u); }
DI float fexp2(float x) { return __builtin_amdgcn_exp2f(x); }
DI int crow(int i, int h) { return (i & 3) + 8 * (i >> 2) + 4 * h; }
DI bf16x8 as_bf8(u32x4 v) { return __builtin_bit_cast(bf16x8, v); }
DI int dil_of(int gi) { return gi == 0 ? 1 : (gi == 1 ? 4 : 16); }
DI int dlg_of(int gi) { return gi * 2; }
DI float row_rscale(const float* ssq, size_t tok) {
  const f32x4 a = *(const f32x4*)(ssq + tok * 16), b = *(const f32x4*)(ssq + tok * 16 + 4);
  const f32x4 c = *(const f32x4*)(ssq + tok * 16 + 8), d = *(const f32x4*)(ssq + tok * 16 + 12);
  const float s = ((a[0] + a[1]) + (a[2] + a[3])) + ((b[0] + b[1]) + (b[2] + b[3])) + ((c[0] + c[1]) + (c[2] + c[3])) + ((d[0] + d[1]) + (d[2] + d[3]));
  return rsqrtf(s * (1.0f / 1024.0f) + 1e-6f);
}
DI int qk_head_col(int h) {
  if (h < 8) return 64 * h;
  if (h < 10) return 512 + 64 * (h - 8);
  if (h < 16) return 768 + 64 * (h - 10);
  if (h < 22) return 1152 + 64 * (h - 16);
  if (h < 26) return 1920 + 64 * (h - 22);
  if (h < 30) return 2176 + 64 * (h - 26);
  if (h < 34) return 2688 + 64 * (h - 30);
  return 2944 + 64 * (h - 34);
}
DI int v_head_col(int vh) {
  if (vh < 2) return 640 + 64 * vh;
  if (vh < 8) return 1536 + 64 * (vh - 2);
  if (vh < 12) return 2432 + 64 * (vh - 8);
  return 3200 + 64 * (vh - 12);
}

struct EpiQKG {
  static constexpr bool PERM = true, AFTER_DRAIN = false;
  const float* ssq; u16* qk; const float* rope; const float* gA; const float* gB; const float* gC; const float* gD;
  DI void body64(const f32x4 (&acc)[2][2][4][2], const Unit& u, int wr, int fr, int fq, unsigned goff, const float* gainl, float qpre, int dlg, int rope_on) const {
#pragma unroll
    for (int ai = 0; ai < 2; ++ai) {
#pragma unroll
      for (int m = 0; m < 4; ++m) {
        const int tok = u.pm * 256 + 128 * ai + 64 * wr + 16 * m + fr;
        const int bl = tok >> 12, pos = tok & 4095;
        const float rs = row_rscale(ssq, tok);
        const int pdom = ((pos & ((1 << dlg) - 1)) << (12 - dlg)) + (pos >> dlg);
        const int blk = pdom >> 5, rr = pdom & 31;
        const unsigned boff = goff + (unsigned)bl * (SEQ * 64) + (unsigned)(((blk * 4 + (fq >> 1)) * 64 + (fq & 1) * 32 + rr) * 8);
        const float* rp = rope + (unsigned)((rope_on ? pos : SEQ) * 96 + 8 * fq);
        float ss = 0.f;
#pragma unroll
        for (int bj = 0; bj < 2; ++bj)
#pragma unroll
          for (int n = 0; n < 2; ++n)
#pragma unroll
            for (int e = 0; e < 4; ++e) ss += acc[ai][bj][m][n][e] * acc[ai][bj][m][n][e];
        ss += __shfl_xor(ss, 16); ss += __shfl_xor(ss, 32);
        const float sc = rs * rsqrtf(ss * rs * rs * (1.0f / 64.0f) + 1e-6f) * qpre;
        u32x4 w0, w1;
#pragma unroll
        for (int n = 0; n < 2; ++n) {
          const f32x4 xa = acc[ai][0][m][n] * sc * *(const f32x4*)(gainl + 4 * n);
          const f32x4 xb2 = acc[ai][1][m][n] * sc * *(const f32x4*)(gainl + 32 + 4 * n);
          const f32x4 c4 = *(const f32x4*)(rp + 4 * n);
          const f32x4 s4 = *(const f32x4*)(rp + 32 + 4 * n);
          const f32x4 ta = xa * c4 - xb2 * s4, tb = xb2 * c4 + xa * s4;
          w0[2 * n] = pk2(ta[0], ta[1]); w0[2 * n + 1] = pk2(ta[2], ta[3]);
          w1[2 * n] = pk2(tb[0], tb[1]); w1[2 * n + 1] = pk2(tb[2], tb[3]);
        }
        *(u32x4*)(qk + boff) = w0;
        *(u32x4*)(qk + boff + 2 * 64 * 8) = w1;
        asm volatile("" ::: "memory");
      }
    }
  }
  DI void body32(const f32x4 (&acc)[2][2][4][2], const Unit& u, int wr, int fr, int fq, unsigned goff, const float* gainl, float qpre) const {
    const float sgn = (fq < 2) ? -1.0f : 1.0f;
#pragma unroll
    for (int ai = 0; ai < 2; ++ai) {
#pragma unroll
      for (int m = 0; m < 4; ++m) {
        const int tok = u.pm * 256 + 128 * ai + 64 * wr + 16 * m + fr;
        const int bl = tok >> 12, pos = tok & 4095;
        const float rs = row_rscale(ssq, tok);
        const int blk = pos >> 5, rr = pos & 31;
        const unsigned boff = goff + (unsigned)bl * (SEQ * 64) + (unsigned)(((blk * 2 + (fq >> 1)) * 64 + (fq & 1) * 32 + rr) * 8);
        const float* rp = rope + (unsigned)(pos * 96 + 64 + 8 * (fq & 1));
#pragma unroll
        for (int bj = 0; bj < 2; ++bj) {
          float ss = 0.f;
#pragma unroll
          for (int n = 0; n < 2; ++n)
#pragma unroll
            for (int e = 0; e < 4; ++e) ss += acc[ai][bj][m][n][e] * acc[ai][bj][m][n][e];
          ss += __shfl_xor(ss, 16); ss += __shfl_xor(ss, 32);
          const float sc = rs * rsqrtf(ss * rs * rs * (1.0f / 32.0f) + 1e-6f) * qpre;
          u32x4 w;
#pragma unroll
          for (int n = 0; n < 2; ++n) {
            const f32x4 x = acc[ai][bj][m][n] * sc * *(const f32x4*)(gainl + 4 * n);
            const f32x4 c4 = *(const f32x4*)(rp + 4 * n);
            const f32x4 s4 = *(const f32x4*)(rp + 16 + 4 * n);
            f32x4 pr;
#pragma unroll
            for (int e = 0; e < 4; ++e) pr[e] = __shfl_xor(x[e], 32);
            const f32x4 o = x * c4 + pr * s4 * sgn;
            w[2 * n] = pk2(o[0], o[1]); w[2 * n + 1] = pk2(o[2], o[3]);
          }
          *(u32x4*)(qk + boff + (unsigned)bj * (SEQ * 32)) = w;
        }
        asm volatile("" ::: "memory");
      }
    }
  }
  DI void operator()(const f32x4 (&acc)[2][2][4][2], const Unit& u, int wr, int wc, int fr, int fq) const {
    const int hidx = u.pn * 4 + wc;
    if (hidx >= NQKH) return;
    int kind, dlg = 0; const float* gain;
    if (hidx < 8) { kind = 0; gain = gA; }
    else if (hidx < 10) { kind = 0; gain = gA + 64; }
    else if (hidx < 16) { kind = 0; gain = gB; dlg = dlg_of((hidx - 10) >> 1); }
    else if (hidx < 22) { kind = 0; gain = gB + 64; dlg = dlg_of((hidx - 16) >> 1); }
    else if (hidx < 26) { kind = 2; gain = gC; }
    else if (hidx < 30) { kind = 2; gain = gC + 32; }
    else if (hidx < 34) { kind = 1; gain = gD; }
    else { kind = 1; gain = gD + 64; }
    const unsigned goff = (unsigned)hidx * (unsigned)(TC * 64);
    const float* gainl = gain + 8 * fq;
    const float qpre = (hidx >= 22 && hidx < 26) ? (0.17677669529663687f * LOG2E)
                     : ((hidx < 8 || (hidx >= 10 && hidx < 16) || (hidx >= 30 && hidx < 34)) ? (0.125f * LOG2E) : 1.0f);
    if (kind == 2) body32(acc, u, wr, fr, fq, goff, gainl, qpre);
    else body64(acc, u, wr, fr, fq, goff, gainl, qpre, dlg, kind == 0 ? 1 : 0);
  }
};

struct EpiGateUp {
  static constexpr bool PERM = true, AFTER_DRAIN = false;
  const float* ssq; u16* o; int mode;
  template <bool UP>
  DI void body(const f32x4 (&acc)[2][2][4][2], const Unit& u, int wr, int wc, int fr, int fq) const {
    const int c0 = u.pn * 256 + 32 * wc + 8 * fq;
    float rsv[8];
#pragma unroll
    for (int i = 0; i < 8; ++i) rsv[i] = row_rscale(ssq, (size_t)u.pm * 256 + 128 * (i >> 2) + 64 * wr + 16 * (i & 3) + fr);
#pragma unroll
    for (int ai = 0; ai < 2; ++ai)
#pragma unroll
      for (int m = 0; m < 4; ++m) {
        const size_t tok = (size_t)u.pm * 256 + 128 * ai + 64 * wr + 16 * m + fr;
        const float rs = rsv[ai * 4 + m];
#pragma unroll
        for (int bj = 0; bj < 2; ++bj) {
          float r[8];
#pragma unroll
          for (int n = 0; n < 2; ++n) {
            const f32x4 v = acc[ai][bj][m][n] * rs;
#pragma unroll
            for (int e = 0; e < 4; ++e) {
              if (UP) { const float z = fmaxf(v[e], 0.f); r[4 * n + e] = z * z; }
              else r[4 * n + e] = __builtin_amdgcn_rcpf(1.0f + fexp2(-LOG2E * v[e]));
            }
          }
          u32x4 w = {pk2(r[0], r[1]), pk2(r[2], r[3]), pk2(r[4], r[5]), pk2(r[6], r[7])};
          *(u32x4*)(o + tok * 4096 + c0 + 128 * bj) = w;
        }
        asm volatile("" ::: "memory");
      }
  }
  DI void operator()(const f32x4 (&acc)[2][2][4][2], const Unit& u, int wr, int wc, int fr, int fq) const {
    if (mode == 2) return;
    if (mode == 1) body<true>(acc, u, wr, wc, fr, fq);
    else body<false>(acc, u, wr, wc, fr, fq);
  }
};

struct EpiVT {
  static constexpr bool PERM = false, AFTER_DRAIN = true;
  const float* ssq; u16* vbuf;
  DI void operator()(const f32x4 (&)[2][2][4][2], const Unit&, int, int, int, int) const {}
  DI void fused(const f32x4 (&acc)[2][2][4][2], const Unit& u, int wr, int wc, int fr, int fq, PG8_LAS unsigned char* lds, int wid, int lane) const {
    PG8_LAS float* rsl = (PG8_LAS float*)(lds + 256 * VT_STRIDE + 64);
    {
      const int t = wid * 64 + lane;
      if (t < 256) rsl[t] = row_rscale(ssq, (size_t)u.pn * 256 + t);
    }
    __syncthreads();
#pragma unroll
    for (int ai = 0; ai < 2; ++ai)
#pragma unroll
      for (int m = 0; m < 4; ++m) {
        const int r = 128 * ai + 64 * wr + 16 * m + fr;
#pragma unroll
        for (int bj = 0; bj < 2; ++bj)
#pragma unroll
          for (int n = 0; n < 2; ++n) {
            const f32x4 v = acc[ai][bj][m][n] * *(const PG8_LAS f32x4*)(rsl + 128 * bj + 32 * wc + 16 * n + 4 * fq);
            u32x2 w = {pk2(v[0], v[1]), pk2(v[2], v[3])};
            *(PG8_LAS u32x2*)(lds + r * VT_STRIDE + (128 * bj + 32 * wc + 16 * n + 4 * fq) * 2) = w;
          }
      }
    __syncthreads();
    const int tid = wid * 64 + lane;
    const int bl = (u.pn * 256) >> 12, pos0 = (u.pn * 256) & 4095;
#pragma unroll 1
    for (int it = 0; it < 16; ++it) {
      const int uidx = it * 512 + tid;
      const int dvlo = uidx & 31, hh = (uidx >> 5) & 1, rb = (uidx >> 6) & 1, half = (uidx >> 7) & 15, h = uidx >> 11;
      const int vgrp = u.pm * 4 + h;
      const int dlg = (vgrp >= 2 && vgrp < 8) ? dlg_of((vgrp - 2) >> 1) : 0;
      const int cls = half >> (4 - dlg), hc = half & ((16 >> dlg) - 1);
      const int m0 = pos0 >> dlg, mh = m0 + 16 * hc;
      const int s = (mh >> 4) & 1, dblk = cls * (128 >> dlg) + (mh >> 5);
      const PG8_LAS unsigned char* row = lds + (h * 64 + rb * 32 + dvlo) * VT_STRIDE;
      unsigned short k8[8];
#pragma unroll
      for (int j = 0; j < 8; ++j) {
        const int tau = ((16 * hc + 4 * hh + (j & 3) + 8 * (j >> 2)) << dlg) + cls;
        k8[j] = *(const PG8_LAS unsigned short*)(row + tau * 2);
      }
      u32x4 w = {(unsigned)k8[0] | ((unsigned)k8[1] << 16), (unsigned)k8[2] | ((unsigned)k8[3] << 16),
                 (unsigned)k8[4] | ((unsigned)k8[5] << 16), (unsigned)k8[6] | ((unsigned)k8[7] << 16)};
      u16* dst = vbuf + (size_t)vgrp * TC * 64 + (size_t)bl * SEQ * 64 + ((size_t)((dblk * 2 + rb) * 2 + s) * 64 + hh * 32 + dvlo) * 8;
      *(u32x4*)dst = w;
    }
    __syncthreads();
  }
};

struct MergeOrder : pg8::StaticOrder {
  const u16* ybase; const u16* wbase;
  DI bool next(int i, Unit& u) const { if (i >= 5) return false; if (!pg8::StaticOrder::next(0, u)) return false; u.seg = i; return true; }
  DI const char* baseA(const pg8::Gemm&, const Unit& u, size_t tstep) const { return (const char*)(ybase + (size_t)u.seg * TC * 256) + (size_t)u.pm * tstep; }
  DI const char* baseB(const pg8::Gemm&, const Unit& u, size_t tstep) const { return (const char*)(wbase + (size_t)u.seg * DM * 256) + (size_t)u.pn * tstep; }
  DI bool zero_after(const Unit& u) const { return u.seg == 4; }
};
struct EpiMerge {
  static constexpr bool PERM = true, AFTER_DRAIN = false;
  const u16* gate; u16* mrg;
  DI void operator()(f32x4 (&acc)[2][2][4][2], const Unit& u, int wr, int wc, int fr, int fq) const {
    const int seg = u.seg;
    if (seg == 0) return;
    const bool last = (seg == 4);
    const int gnum = last ? 3 : seg - 1, gden = last ? 3 : seg;
    const u16* gnp = gate + ((size_t)u.pm * 256 + 64 * wr + fr) * 4096 + gnum * 1024 + u.pn * 256 + 32 * wc + 8 * fq;
    const u16* gdp = gate + ((size_t)u.pm * 256 + 64 * wr + fr) * 4096 + gden * 1024 + u.pn * 256 + 32 * wc + 8 * fq;
    u32x4 gn, gd, gnn, gdn;
    gn = *(const u32x4*)gnp; gd = *(const u32x4*)gdp;
#pragma unroll
    for (int i = 0; i < 16; ++i) {
      const int ai = i >> 3, m = (i >> 1) & 3, bj = i & 1;
      if (i < 15) {
        const int i2 = i + 1;
        const size_t ro = (size_t)(128 * (i2 >> 3) + 16 * ((i2 >> 1) & 3)) * 4096 + 128 * (i2 & 1);
        gnn = *(const u32x4*)(gnp + ro); gdn = *(const u32x4*)(gdp + ro);
      }
      asm volatile("" ::: "memory");
#pragma unroll
      for (int n = 0; n < 2; ++n) {
        f32x4 f;
        f[0] = bf_lo(gn[2 * n]); f[1] = bf_hi(gn[2 * n]); f[2] = bf_lo(gn[2 * n + 1]); f[3] = bf_hi(gn[2 * n + 1]);
        if (!last) {
          f[0] *= __builtin_amdgcn_rcpf(bf_lo(gd[2 * n])); f[1] *= __builtin_amdgcn_rcpf(bf_hi(gd[2 * n]));
          f[2] *= __builtin_amdgcn_rcpf(bf_lo(gd[2 * n + 1])); f[3] *= __builtin_amdgcn_rcpf(bf_hi(gd[2 * n + 1]));
        }
        acc[ai][bj][m][n] *= f;
      }
      if (last) {
        const size_t tok = (size_t)u.pm * 256 + 128 * ai + 64 * wr + 16 * m + fr;
        const int c = u.pn * 256 + 128 * bj + 32 * wc + 8 * fq;
        const f32x4 v0 = acc[ai][bj][m][0], v1 = acc[ai][bj][m][1];
        u32x4 w = {pk2(v0[0], v0[1]), pk2(v0[2], v0[3]), pk2(v1[0], v1[1]), pk2(v1[2], v1[3])};
        *(u32x4*)(mrg + tok * DM + c) = w;
      }
      gn = gnn; gd = gdn;
    }
  }
};

struct EpiResid {
  static constexpr bool PERM = true, AFTER_DRAIN = false;
  float* xout; u16* xb; float* ssq; int wf32;
  DI void operator()(const f32x4 (&acc)[2][2][4][2], const Unit& u, int wr, int wc, int fr, int fq) const {
    const size_t o0 = ((size_t)u.pm * 256 + 64 * wr + fr) * DM + u.pn * 256 + 32 * wc + 8 * fq;
    u32x4 xo, xn;
    xo = *(const u32x4*)(xb + o0);
    float ss = 0.f;
#pragma unroll
    for (int i = 0; i < 16; ++i) {
      const int ai = i >> 3, m = (i >> 1) & 3, bj = i & 1;
      if (i < 15) {
        const int i2 = i + 1;
        xn = *(const u32x4*)(xb + o0 + (size_t)(128 * (i2 >> 3) + 16 * ((i2 >> 1) & 3)) * DM + 128 * (i2 & 1));
      }
      asm volatile("" ::: "memory");
      const size_t tok = (size_t)u.pm * 256 + 128 * ai + 64 * wr + 16 * m + fr;
      const size_t o = tok * DM + u.pn * 256 + 128 * bj + 32 * wc + 8 * fq;
      f32x4 v0 = acc[ai][bj][m][0], v1 = acc[ai][bj][m][1];
      v0[0] += bf_lo(xo[0]); v0[1] += bf_hi(xo[0]); v0[2] += bf_lo(xo[1]); v0[3] += bf_hi(xo[1]);
      v1[0] += bf_lo(xo[2]); v1[1] += bf_hi(xo[2]); v1[2] += bf_lo(xo[3]); v1[3] += bf_hi(xo[3]);
      if (wf32) { *(f32x4*)(xout + o) = v0; *(f32x4*)(xout + o + 4) = v1; }
      if (!wf32) {
        u32x4 w = {pk2(v0[0], v0[1]), pk2(v0[2], v0[3]), pk2(v1[0], v1[1]), pk2(v1[2], v1[3])};
        *(u32x4*)(xb + o) = w;
      }
      ss += ((v0[0] * v0[0] + v0[1] * v0[1]) + (v0[2] * v0[2] + v0[3] * v0[3])) + ((v1[0] * v1[0] + v1[1] * v1[1]) + (v1[2] * v1[2] + v1[3] * v1[3]));
      if (bj == 1) {
        ss += __shfl_xor(ss, 16); ss += __shfl_xor(ss, 32);
        if (fq == 0 && !wf32) ssq[tok * 16 + u.pn * 4 + wc] = ss;
        ss = 0.f;
      }
      xo = xn;
    }
  }
};

template <class Epi>
DI void run_merge(PG8_LAS unsigned char* lds, const u16* ybase, const u16* wbase, const Epi& E) {
  int K = 256; asm volatile("" : "+s"(K));
  pg8::Gemm g; g.A = ybase; g.Bt = wbase; g.M = TC; g.N = DM; g.K = K;
  MergeOrder S; S.init(TC, DM, (int)gridDim.x, (int)blockIdx.x); S.ybase = ybase; S.wbase = wbase;
  pg8::gemm_phase<Epi, MergeOrder, false>(lds, g, S, E, nullptr);
}
template <class Epi>
DI void run_gemm(PG8_LAS unsigned char* lds, const u16* A, const u16* Bt, int M, int N, int K, const Epi& E, int probe = 0, int ilo = 0, int ihi = 1 << 30) {
  asm volatile("" : "+s"(K));
  pg8::Gemm g; g.A = A; g.Bt = Bt; g.M = M; g.N = N; g.K = K;
  pg8::StaticOrder S; S.init(M, N, (int)gridDim.x, (int)blockIdx.x); S.probe = probe; S.ilo = ilo; S.ihi = ihi;
  pg8::gemm_phase<Epi, pg8::StaticOrder, false>(lds, g, S, E, nullptr);
}

DI void cvt_load(const float* __restrict__ src, int N, int k0, int n0, const float* __restrict__ g, float* t, int ht) {
  const int c4 = (ht & 15) * 4;
#pragma unroll
  for (int i = 0; i < 4; ++i) {
    const int kk = (ht >> 4) + 16 * i;
    f32x4 v = *(const f32x4*)(src + (size_t)(k0 + kk) * N + n0 + c4);
    const float sc = g ? g[k0 + kk] : 1.0f;
    t[kk * 65 + c4 + 0] = v[0] * sc; t[kk * 65 + c4 + 1] = v[1] * sc; t[kk * 65 + c4 + 2] = v[2] * sc; t[kk * 65 + c4 + 3] = v[3] * sc;
  }
}
DI void cvt_store(u16* __restrict__ dst, int ldk, int kdst, int d0, int d1, const float* t, int ht) {
  const int kc = (ht & 7) * 8, nn = ht >> 3;
#pragma unroll
  for (int i = 0; i < 2; ++i) {
    const int tn = nn + 32 * i, row = (i == 0) ? d0 + nn : d1 + nn;
    u32x4 w;
    w[0] = pk2(t[(kc + 0) * 65 + tn], t[(kc + 1) * 65 + tn]);
    w[1] = pk2(t[(kc + 2) * 65 + tn], t[(kc + 3) * 65 + tn]);
    w[2] = pk2(t[(kc + 4) * 65 + tn], t[(kc + 5) * 65 + tn]);
    w[3] = pk2(t[(kc + 6) * 65 + tn], t[(kc + 7) * 65 + tn]);
    *(u32x4*)(dst + (size_t)row * ldk + kdst + kc) = w;
  }
}
struct CvtJob { const float* src; int N, k0, n0; const float* g; u16* dst; int ldk, d0, d1, kd; };
DI CvtJob cvt_job(const Params& p, int l, int ti) {
  CvtJob j; j.g = nullptr; j.kd = -1;
  const float* attn_g = p.in[1] + l * DM;
  if (ti < 608) { const int h = ti >> 4, kt = ti & 15; j.src = p.in[2] + (size_t)l * DM * INC; j.N = INC; j.k0 = kt * 64; j.n0 = qk_head_col(h); j.g = attn_g;
    j.dst = (u16*)(p.ws + OFF_WQKG) + (size_t)l * NQKG * DM; j.ldk = DM; j.d0 = (h >> 2) * 256 + (h & 3) * 32; j.d1 = j.d0 + 128; return j; }
  ti -= 608;
  if (ti < 1024) { const int c = ti >> 4, kt = ti & 15; j.src = p.in[2] + (size_t)l * DM * INC; j.N = INC; j.k0 = kt * 64; j.n0 = 3456 + 64 * c; j.g = attn_g;
    j.dst = (u16*)(p.ws + OFF_WQKG) + (size_t)l * NQKG * DM; j.ldk = DM; j.d0 = 2560 + 64 * c; j.d1 = j.d0 + 32; return j; }
  ti -= 1024;
  if (ti < 256) { const int vh = ti >> 4, kt = ti & 15; j.src = p.in[2] + (size_t)l * DM * INC; j.N = INC; j.k0 = kt * 64; j.n0 = v_head_col(vh); j.g = attn_g;
    j.dst = (u16*)(p.ws + OFF_WV) + (size_t)l * DM * DM; j.ldk = DM; j.d0 = vh * 64; j.d1 = j.d0 + 32; return j; }
  ti -= 256;
  if (ti < 128) { j.src = p.in[11] + (size_t)l * 512 * DM; j.N = DM; j.k0 = (ti >> 4) * 64; j.n0 = (ti & 15) * 64; j.dst = (u16*)(p.ws + OFF_WBR5) + ((size_t)l * 5 + (j.k0 >> 8)) * DM * 256; j.ldk = 256; j.kd = j.k0 & 255; j.d0 = j.n0; j.d1 = j.n0 + 32; return j; }
  ti -= 128;
  if (ti < 32) { j.src = p.in[12] + (size_t)l * 128 * DM; j.N = DM; j.k0 = (ti >> 4) * 64; j.n0 = (ti & 15) * 64; j.dst = (u16*)(p.ws + OFF_WBR5) + ((size_t)l * 5 + 2) * DM * 256; j.ldk = 256; j.kd = j.k0; j.d0 = j.n0; j.d1 = j.n0 + 32; return j; }
  ti -= 32;
  if (ti < 64) { j.src = p.in[13] + (size_t)l * 256 * DM; j.N = DM; j.k0 = (ti >> 4) * 64; j.n0 = (ti & 15) * 64; j.dst = (u16*)(p.ws + OFF_WBR5) + ((size_t)l * 5 + 3) * DM * 256; j.ldk = 256; j.kd = j.k0; j.d0 = j.n0; j.d1 = j.n0 + 32; return j; }
  ti -= 64;
  if (ti < 64) { j.src = p.in[14] + (size_t)l * 256 * DM; j.N = DM; j.k0 = (ti >> 4) * 64; j.n0 = (ti & 15) * 64; j.dst = (u16*)(p.ws + OFF_WBR5) + ((size_t)l * 5 + 4) * DM * 256; j.ldk = 256; j.kd = j.k0; j.d0 = j.n0; j.d1 = j.n0 + 32; return j; }
  ti -= 64;
  if (ti < 256) { j.src = p.in[15] + (size_t)l * DM * DM; j.N = DM; j.k0 = (ti >> 4) * 64; j.n0 = (ti & 15) * 64; j.dst = (u16*)(p.ws + OFF_WOUT) + (size_t)l * DM * DM; j.ldk = DM; j.d0 = j.n0; j.d1 = j.n0 + 32; return j; }
  ti -= 256;
  if (ti < 1024) { j.src = p.in[17] + (size_t)l * DM * DMLP; j.N = DMLP; j.k0 = (ti >> 6) * 64; j.n0 = (ti & 63) * 64; j.g = p.in[16] + l * DM;
    j.dst = (u16*)(p.ws + OFF_WUP) + (size_t)l * DMLP * DM; j.ldk = DM; j.d0 = j.n0; j.d1 = j.n0 + 32; return j; }
  ti -= 1024;
  j.src = p.in[18] + (size_t)l * DMLP * DM; j.N = DM; j.k0 = (ti >> 4) * 64; j.n0 = (ti & 15) * 64; j.dst = (u16*)(p.ws + OFF_WDN) + (size_t)l * DM * DMLP; j.ldk = DMLP; j.d0 = j.n0; j.d1 = j.n0 + 32; return j;
}

__device__ void phase_prep(const Params& p, int tid_, int bid_, int nblk_, unsigned char* smem) {
  const int half = tid_ >> 8, ht = tid_ & 255;
  float* t = (float*)smem + half * (64 * 65);
  const int per_layer = 4480, total = 2 * per_layer;
  for (int jp = bid_; jp * 2 < total; jp += nblk_) {
    const int j = jp * 2 + half;
    const bool on = j < total;
    CvtJob job;
    if (on) { job = cvt_job(p, j / per_layer, j % per_layer); cvt_load(job.src, job.N, job.k0, job.n0, job.g, t, ht); }
    __syncthreads();
    if (on) cvt_store(job.dst, job.ldk, (job.kd >= 0) ? job.kd : job.k0, job.d0, job.d1, t, ht);
    __syncthreads();
  }
  {
    const u32x4 z = {0u, 0u, 0u, 0u};
    for (int e = bid_ * NTHR + tid_; e < 2 * 128 * 128; e += nblk_ * NTHR) {
      const int l = e >> 14, r = (e >> 7) & 127, c = (e & 127) * 8;
      const int row = 9 * 256 + ((r < 64) ? 64 + r : 128 + r);
      *(u32x4*)((u16*)(p.ws + OFF_WQKG) + ((size_t)l * NQKG + row) * DM + c) = z;
    }
    for (int e = bid_ * NTHR + tid_; e < 2 * 1024 * 16; e += nblk_ * NTHR) {
      const int l = e >> 14, r = (e >> 4) & 1023, c = 128 + (e & 15) * 8;
      *(u32x4*)((u16*)(p.ws + OFF_WBR5) + (((size_t)l * 5 + 2) * DM + r) * 256 + c) = z;
    }
  }
  {
    const u32x4 z = {0u, 0u, 0u, 0u};
    u16* yb = (u16*)(p.ws + OFF_Y5) + (size_t)2 * TC * 256;
    for (int e = bid_ * NTHR + tid_; e < TC * 16; e += nblk_ * NTHR) *(u32x4*)(yb + (size_t)(e >> 4) * 256 + 128 + (e & 15) * 8) = z;
  }
  float* rope = (float*)(p.ws + OFF_ROPE);
  for (int e = bid_ * NTHR + tid_; e < SEQ * 48; e += nblk_ * NTHR) {
    const int pos = e / 48, i = e % 48;
    float inv;
    if (i < 32) inv = exp2f(-13.287712379549449f * (float)(2 * i) / 64.0f);
    else inv = exp2f(-13.287712379549449f * (float)(2 * (i - 32)) / 32.0f);
    const float angf = (float)pos * inv;
    const double ang = (double)angf;
    const double n = rint(ang * 0.15915494309189535);
    const float r = (float)(ang - n * 6.283185307179586);
    const float c = cosf(r), s = sinf(r);
    if (i < 32) { rope[pos * 96 + i] = c; rope[pos * 96 + 32 + i] = s; }
    else { rope[pos * 96 + 64 + (i - 32)] = c; rope[pos * 96 + 80 + (i - 32)] = s; }
  }
  if (bid_ == 0 && tid_ < 96) rope[SEQ * 96 + tid_] = (tid_ < 32 || (tid_ >= 64 && tid_ < 80)) ? 1.0f : 0.0f;
  u16* XB = (u16*)(p.ws + OFF_XB); float* SSQ = (float*)(p.ws + OFF_SSQ);
  const int lane = tid_ & 63;
  const int gw = bid_ * 8 + (tid_ >> 6), nw = nblk_ * 8;
  for (int row = gw; row < T; row += nw) {
    const float* xr = p.in[0] + (size_t)row * DM;
    float ss = 0.f;
#pragma unroll
    for (int i = 0; i < 4; ++i) {
      const f32x4 v = *(const f32x4*)(xr + i * 256 + lane * 4);
      ss += v[0] * v[0] + v[1] * v[1] + v[2] * v[2] + v[3] * v[3];
      u32x2 w = {pk2(v[0], v[1]), pk2(v[2], v[3])};
      *(u32x2*)(XB + (size_t)row * DM + i * 256 + lane * 4) = w;
    }
#pragma unroll
    for (int o = 32; o >= 1; o >>= 1) ss += __shfl_xor(ss, o);
    if (lane < 16) SSQ[(size_t)row * 16 + lane] = (lane == 0) ? ss : 0.f;
  }
}

DI void attn_softmax_pv(f32x16& S, float& m, float& l, f32x16& O0, f32x16& O1, const bf16x8 (&vf)[2][2]) {
  float mx = S[0];
#pragma unroll
  for (int i = 1; i < 16; ++i) mx = fmaxf(mx, S[i]);
  mx = fmaxf(mx, __shfl_xor(mx, 32));
  const float mn = fmaxf(m, mx);
  const float alpha = fexp2(m - mn);
  m = mn;
  float sum = 0.f;
#pragma unroll
  for (int i = 0; i < 16; ++i) { S[i] = fexp2(S[i] - mn); sum += S[i]; }
  l = l * alpha + sum;
  const u32x4 p0 = {pk2(S[0], S[1]), pk2(S[2], S[3]), pk2(S[4], S[5]), pk2(S[6], S[7])};
  const u32x4 p1 = {pk2(S[8], S[9]), pk2(S[10], S[11]), pk2(S[12], S[13]), pk2(S[14], S[15])};
#pragma unroll
  for (int i = 0; i < 16; ++i) { O0[i] *= alpha; O1[i] *= alpha; }
  O0 = MFMA32(vf[0][0], as_bf8(p0), O0);
  O0 = MFMA32(vf[0][1], as_bf8(p1), O0);
  O1 = MFMA32(vf[1][0], as_bf8(p0), O1);
  O1 = MFMA32(vf[1][1], as_bf8(p1), O1);
}
DI void attn_fixed_pv(f32x16& S, f32x16& L, f32x16& O0, f32x16& O1, const bf16x8 (&vf)[2][2], const bf16x8 ones) {
#pragma unroll
  for (int i = 0; i < 16; ++i) S[i] = fexp2(S[i]);
  const u32x4 p0 = {pk2(S[0], S[1]), pk2(S[2], S[3]), pk2(S[4], S[5]), pk2(S[6], S[7])};
  const u32x4 p1 = {pk2(S[8], S[9]), pk2(S[10], S[11]), pk2(S[12], S[13]), pk2(S[14], S[15])};
  O0 = MFMA32(vf[0][0], as_bf8(p0), O0);
  O0 = MFMA32(vf[0][1], as_bf8(p1), O0);
  O1 = MFMA32(vf[1][0], as_bf8(p0), O1);
  O1 = MFMA32(vf[1][1], as_bf8(p1), O1);
  float sum = 0.f;
#pragma unroll
  for (int i = 0; i < 16; ++i) sum += S[i];
  L[0] += sum;
}
DI void attn_plain_pv(f32x16& S, float& l, f32x16& O0, f32x16& O1, const bf16x8 (&vf)[2][2]) {
  float sum = 0.f;
#pragma unroll
  for (int i = 0; i < 16; ++i) { S[i] = fexp2(S[i]); sum += S[i]; }
  l += sum;
  const u32x4 p0 = {pk2(S[0], S[1]), pk2(S[2], S[3]), pk2(S[4], S[5]), pk2(S[6], S[7])};
  const u32x4 p1 = {pk2(S[8], S[9]), pk2(S[10], S[11]), pk2(S[12], S[13]), pk2(S[14], S[15])};
  O0 = MFMA32(vf[0][0], as_bf8(p0), O0); O1 = MFMA32(vf[1][0], as_bf8(p0), O1);
  O0 = MFMA32(vf[0][1], as_bf8(p1), O0); O1 = MFMA32(vf[1][1], as_bf8(p1), O1);
}
DI float gain_bound64(const float* g) {
  float a = 0.f, b = 0.f;
  for (int i = 0; i < 64; ++i) { a = fmaxf(a, fabsf(g[i])); b = fmaxf(b, fabsf(g[64 + i])); }
  return fminf(8.0f * a * b * 1.02f + 0.05f, 40.0f);
}
DI void load_vf(bf16x8 (&vf)[2][2], const u16* V, int kb, int lane) {
#pragma unroll
  for (int rb = 0; rb < 2; ++rb)
#pragma unroll
    for (int s = 0; s < 2; ++s) vf[rb][s] = *(const bf16x8*)(V + ((size_t)((kb * 2 + rb) * 2 + s) * 64 + lane) * 8);
}
DI void load_kf4(bf16x8 (&kf)[4], const u16* K, int kb, int lane) {
#pragma unroll
  for (int s = 0; s < 4; ++s) kf[s] = *(const bf16x8*)(K + ((size_t)(kb * 4 + s) * 64 + lane) * 8);
}
DI void load_kf2(bf16x8 (&kf)[2], const u16* K, int kb, int lane) {
#pragma unroll
  for (int s = 0; s < 2; ++s) kf[s] = *(const bf16x8*)(K + ((size_t)(kb * 2 + s) * 64 + lane) * 8);
}
DI void zero16(f32x16& a) {
#pragma unroll
  for (int i = 0; i < 16; ++i) a[i] = 0.f;
}
DI void store_o(u16* yrow, const f32x16& O0, const f32x16& O1, float sc, int h) {
#pragma unroll
  for (int g4 = 0; g4 < 4; ++g4) {
    u32x2 w0 = {pk2(O0[4 * g4] * sc, O0[4 * g4 + 1] * sc), pk2(O0[4 * g4 + 2] * sc, O0[4 * g4 + 3] * sc)};
    *(u32x2*)(yrow + 8 * g4 + 4 * h) = w0;
    u32x2 w1 = {pk2(O1[4 * g4] * sc, O1[4 * g4 + 1] * sc), pk2(O1[4 * g4 + 2] * sc, O1[4 * g4 + 3] * sc)};
    *(u32x2*)(yrow + 32 + 8 * g4 + 4 * h) = w1;
  }
}

__device__ void phase_attn(const Params& p, int tid_, int bid_, int nblk_, int layer, unsigned char* smem) {
  const u16* QK = (const u16*)(p.ws + OFF_QK);
  const u16* VB = (const u16*)(p.ws + OFF_V);
  u16* Y5 = (u16*)(p.ws + OFF_Y5);
  u16* BO = (u16*)(p.ws + OFF_BO);
  float* LSE = (float*)(p.ws + OFF_LSE);
  const int lane = tid_ & 63, wave = tid_ >> 6;
  const int fr = lane & 31, fh = lane >> 5;
  const int nloc = nblk_ >> 3;
  if ((int)(bid_ >> 3) >= nloc) return;
  const int vw = ((bid_ & 7) * nloc + (bid_ >> 3)) * 8 + wave, NW = nloc * 64;
  const bool hiwg = (bid_ * 2 >= nblk_);
  const int hb_ = bid_ - (nblk_ >> 1), nloch = nblk_ >> 4;
  const int vwh = ((hb_ & 7) * nloch + (hb_ >> 3)) * 8 + wave, NWH = nloch * 64;
  PG8_LAS float* rpbl = (PG8_LAS float*)smem;
  for (int i = tid_; i < 4 * 465; i += NTHR) rpbl[i] = p.in[10][(size_t)layer * 4 * 465 + i];
  __syncthreads();
  const size_t GS = (size_t)TC * 64;
  const size_t BS = (size_t)SEQ * 64;

  {
    const float* lp = p.in[7] + layer * 128;
    float d01 = 0.f, d23 = 0.f;
    for (int i = 0; i < 32; ++i) { d01 += lp[i] * lp[32 + i]; d23 += lp[64 + i] * lp[96 + i]; }
    const float lambda_init = (layer == 0) ? 0.2f : 0.35550907f;
    const float lam = __expf(d01) - __expf(d23) + lambda_init;
    const float* subg = p.in[8] + layer * 64;
    const float sc = 0.17677669529663687f * LOG2E;
    float gqm = 0.f, gkm = 0.f;
    for (int i = 0; i < 32; ++i) { gqm = fmaxf(gqm, fabsf(p.in[6][layer * 64 + i])); gkm = fmaxf(gkm, fabsf(p.in[6][layer * 64 + 32 + i])); }
    const unsigned onev = ((fr & 27) == 0) ? 0x3f803f80u : 0u;
    const u32x4 ones4 = {onev, onev, onev, onev};
    const bf16x8 ones = as_bf8(ones4);
    const float cbound = 5.6568542f * gqm * gkm * 1.02f + 0.05f;
    for (int it = vw; it < BC * 4 * 128; it += NW) {
      const int bl = it >> 9, head = (it >> 7) & 3, qblk = it & 127;
      const u16* Q0 = QK + (22 + head) * GS + bl * BS; const u16* Q1 = Q0 + SEQ * 32;
      const u16* K0 = QK + (26 + head) * GS + bl * BS; const u16* K1 = K0 + SEQ * 32;
      const u16* V = VB + (8 + head) * GS + bl * BS;
      bf16x8 q0[2], q1[2];
      load_kf2(q0, Q0, qblk, lane); load_kf2(q1, Q1, qblk, lane);
      f32x16 L0, L1; zero16(L0); zero16(L1);
      f32x16 O00, O01, O10, O11; zero16(O00); zero16(O01); zero16(O10); zero16(O11);
      bf16x8 k0[2], k1[2], vf[2][2];
      {
        const float mb2 = fminf(cbound, 40.0f) * LOG2E;
        f32x16 sinit;
#pragma unroll
        for (int i = 0; i < 16; ++i) sinit[i] = -mb2;
        load_kf2(k0, K0, 0, lane); load_kf2(k1, K1, 0, lane); load_vf(vf, V, 0, lane);
        f32x16 S0 = sinit, S1 = sinit;
        S0 = MFMA32(k0[0], q0[0], S0); S0 = MFMA32(k0[1], q0[1], S0);
        S1 = MFMA32(k1[0], q1[0], S1); S1 = MFMA32(k1[1], q1[1], S1);
        load_kf2(k0, K0, 1, lane); load_kf2(k1, K1, 1, lane);
        for (int kb = 0; kb < 128; ++kb) {
          bf16x8 nk0[2], nk1[2], nvf[2][2];
          const int k2 = (kb + 2 < 128) ? kb + 2 : 127, v1 = (kb + 1 < 128) ? kb + 1 : 127;
          load_kf2(nk0, K0, k2, lane); load_kf2(nk1, K1, k2, lane); load_vf(nvf, V, v1, lane);
          f32x16 S0n = sinit, S1n = sinit;
#pragma unroll
          for (int i = 0; i < 16; ++i) S0[i] = fexp2(S0[i]);
          {
            const u32x4 p0 = {pk2(S0[0], S0[1]), pk2(S0[2], S0[3]), pk2(S0[4], S0[5]), pk2(S0[6], S0[7])};
            const u32x4 p1 = {pk2(S0[8], S0[9]), pk2(S0[10], S0[11]), pk2(S0[12], S0[13]), pk2(S0[14], S0[15])};
            __builtin_amdgcn_s_setprio(1);
            S0n = MFMA32(k0[0], q0[0], S0n); S0n = MFMA32(k0[1], q0[1], S0n);
            O00 = MFMA32(vf[0][0], as_bf8(p0), O00); O01 = MFMA32(vf[1][0], as_bf8(p0), O01);
            O00 = MFMA32(vf[0][1], as_bf8(p1), O00); O01 = MFMA32(vf[1][1], as_bf8(p1), O01);
            __builtin_amdgcn_s_setprio(0);
            float sum = 0.f;
#pragma unroll
            for (int i = 0; i < 16; ++i) sum += S0[i];
            L0[0] += sum;
          }
#pragma unroll
          for (int i = 0; i < 16; ++i) S1[i] = fexp2(S1[i]);
          {
            const u32x4 p0 = {pk2(S1[0], S1[1]), pk2(S1[2], S1[3]), pk2(S1[4], S1[5]), pk2(S1[6], S1[7])};
            const u32x4 p1 = {pk2(S1[8], S1[9]), pk2(S1[10], S1[11]), pk2(S1[12], S1[13]), pk2(S1[14], S1[15])};
            __builtin_amdgcn_s_setprio(1);
            S1n = MFMA32(k1[0], q1[0], S1n); S1n = MFMA32(k1[1], q1[1], S1n);
            O10 = MFMA32(vf[0][0], as_bf8(p0), O10); O11 = MFMA32(vf[1][0], as_bf8(p0), O11);
            O10 = MFMA32(vf[0][1], as_bf8(p1), O10); O11 = MFMA32(vf[1][1], as_bf8(p1), O11);
            __builtin_amdgcn_s_setprio(0);
            float sum = 0.f;
#pragma unroll
            for (int i = 0; i < 16; ++i) sum += S1[i];
            L1[0] += sum;
          }
          S0 = S0n; S1 = S1n;
#pragma unroll
          for (int s = 0; s < 2; ++s) { k0[s] = nk0[s]; k1[s] = nk1[s]; vf[0][s] = nvf[0][s]; vf[1][s] = nvf[1][s]; }
        }
      }
      const float i0 = 1.0f / (L0[0] + __shfl_xor(L0[0], 32));
      const float i1 = lam / (L1[0] + __shfl_xor(L1[0], 32));
      float ss = 0.f;
#pragma unroll
      for (int i = 0; i < 16; ++i) {
        O00[i] = O00[i] * i0 - O10[i] * i1; O01[i] = O01[i] * i0 - O11[i] * i1;
        ss += O00[i] * O00[i] + O01[i] * O01[i];
      }
      ss += __shfl_xor(ss, 32);
      const float rn = rsqrtf(ss * (1.0f / 64.0f) + 1e-6f) * (1.0f - lambda_init);
#pragma unroll
      for (int g4 = 0; g4 < 4; ++g4) {
        const f32x4 ga = *(const f32x4*)(subg + 8 * g4 + 4 * fh);
        const f32x4 gb = *(const f32x4*)(subg + 32 + 8 * g4 + 4 * fh);
#pragma unroll
        for (int e = 0; e < 4; ++e) { O00[4 * g4 + e] *= ga[e]; O01[4 * g4 + e] *= gb[e]; }
      }
      const size_t tok = (size_t)bl * SEQ + qblk * 32 + fr;
      store_o(Y5 + (size_t)3 * TC * 256 + tok * 256 + head * 64, O00, O01, rn, fh);
    }
  }
  {
    const float mbA = gain_bound64(p.in[3] + layer * 128) * LOG2E;
    f32x16 sinit;
#pragma unroll
    for (int i = 0; i < 16; ++i) sinit[i] = -mbA;
    for (int it = vw; it < BC * 8 * 128; it += NW) {
      const int bl = it >> 10, hq = (it >> 7) & 7, qblk = it & 127;
      const int kvh = hq >> 2;
      const u16* Q = QK + (size_t)hq * GS + bl * BS;
      const u16* K = QK + (size_t)(8 + kvh) * GS + bl * BS;
      const u16* V = VB + (size_t)kvh * GS + bl * BS;
      bf16x8 qf[4]; load_kf4(qf, Q, qblk, lane);
      float l = (fh == 0) ? fexp2(p.in[4][layer * 8 + hq] * LOG2E - mbA) : 0.0f;
      f32x16 O0, O1; zero16(O0); zero16(O1);
      const int kb_lo = (qblk - 4 < 0) ? 0 : qblk - 4, kb_hi = (qblk + 4 > 127) ? 127 : qblk + 4;
      const int qpos = qblk * 32 + fr;
      bf16x8 kf[4], vf[2][2];
      load_kf4(kf, K, kb_lo, lane); load_vf(vf, V, kb_lo, lane);
      for (int kb = kb_lo; kb <= kb_hi; ++kb) {
        bf16x8 nkf[4], nvf[2][2];
        const int kn = (kb < kb_hi) ? kb + 1 : kb;
        load_kf4(nkf, K, kn, lane); load_vf(nvf, V, kn, lane);
        f32x16 S = sinit;
#pragma unroll
        for (int s = 0; s < 4; ++s) S = MFMA32(kf[s], qf[s], S);
        if (kb == qblk - 4 || kb == qblk + 4) {
#pragma unroll
          for (int i = 0; i < 16; ++i) {
            const int dlt = kb * 32 + crow(i, fh) - qpos;
            S[i] = (dlt <= 128 && dlt >= -128) ? S[i] : (-__builtin_inff());
          }
        }
        attn_plain_pv(S, l, O0, O1, vf);
#pragma unroll
        for (int s = 0; s < 4; ++s) kf[s] = nkf[s];
#pragma unroll
        for (int s = 0; s < 2; ++s) { vf[0][s] = nvf[0][s]; vf[1][s] = nvf[1][s]; }
      }
      const float inv = 1.0f / (l + __shfl_xor(l, 32));
      const size_t tok = (size_t)bl * SEQ + qpos;
      store_o(Y5 + (size_t)(hq >> 2) * TC * 256 + tok * 256 + (hq & 3) * 64, O0, O1, inv, fh);
    }
  }
  {
    const float gbD = gain_bound64(p.in[9] + layer * 128);
    if (hiwg)
    for (int it = vwh; it < BC * 4 * 128; it += NWH) {
      const int bl = it >> 9, head = (it >> 7) & 3, qblk = it & 127;
      const u16* Q = QK + (size_t)(30 + head) * GS + bl * BS;
      const u16* K = QK + (size_t)(34 + head) * GS + bl * BS;
      const u16* V = VB + (size_t)(12 + head) * GS + bl * BS;
      const PG8_LAS float* rpb = rpbl + head * 465;
      bf16x8 qf[4]; load_kf4(qf, Q, qblk, lane);
      float bmax = 0.f;
      for (int i = lane; i < 15 * 31; i += 64) bmax = fmaxf(bmax, fabsf(rpb[i]));
#pragma unroll
      for (int o = 32; o >= 1; o >>= 1) bmax = fmaxf(bmax, __shfl_xor(bmax, o));
      const float mbD = fminf(gbD + bmax, 60.0f) * LOG2E;
      f32x16 sinit;
#pragma unroll
      for (int i = 0; i < 16; ++i) sinit[i] = -mbD;
      float l = 0.f;
      f32x16 O0, O1; zero16(O0); zero16(O1);
      const int qrow = qblk >> 1, qc = (qblk & 1) * 32 + fr;
      int r0 = qrow - 4; r0 = r0 < 0 ? 0 : (r0 > 56 ? 56 : r0);
      int c0 = qc - 8; c0 = c0 < 0 ? 0 : (c0 > 48 ? 48 : c0);
      bf16x8 kf[4], vf[2][2];
      load_kf4(kf, K, r0 * 2, lane); load_vf(vf, V, r0 * 2, lane);
      for (int kk = 0; kk < 16; ++kk) {
        const int krow_ = r0 + (kk >> 1), hb = kk & 1;
        bf16x8 nkf[4], nvf[2][2];
        const int kn = r0 * 2 + ((kk < 15) ? kk + 1 : kk);
        load_kf4(nkf, K, kn, lane); load_vf(nvf, V, kn, lane);
        f32x16 S = sinit;
#pragma unroll
        for (int s = 0; s < 4; ++s) S = MFMA32(kf[s], qf[s], S);
        const PG8_LAS float* brow = rpb + (krow_ - qrow + 7) * 31;
#pragma unroll
        for (int i = 0; i < 16; ++i) {
          const int kc = hb * 32 + crow(i, fh);
          int dc = kc - qc; dc = dc < -15 ? -15 : (dc > 15 ? 15 : dc);
          const float bias = brow[dc + 15];
          S[i] = (kc >= c0 && kc < c0 + 16) ? __builtin_fmaf(bias, LOG2E, S[i]) : (-__builtin_inff());
        }
        attn_plain_pv(S, l, O0, O1, vf);
#pragma unroll
        for (int s = 0; s < 4; ++s) kf[s] = nkf[s];
#pragma unroll
        for (int s = 0; s < 2; ++s) { vf[0][s] = nvf[0][s]; vf[1][s] = nvf[1][s]; }
      }
      const float inv = 1.0f / (l + __shfl_xor(l, 32));
      const size_t tok = (size_t)bl * SEQ + qblk * 32 + fr;
      store_o(Y5 + (size_t)4 * TC * 256 + tok * 256 + head * 64, O0, O1, inv, fh);
    }
  }
  {
    const float mbB = gain_bound64(p.in[5] + layer * 128) * LOG2E;
    f32x16 sinit;
#pragma unroll
    for (int i = 0; i < 16; ++i) sinit[i] = -mbB;
    if (hiwg)
    for (int it = vwh; it < BC * 6 * 128; it += NWH) {
      const int bl = it / 768, rem = it % 768, head = rem >> 7, qblk = rem & 127;
      const int dil = dil_of(head >> 1), L = SEQ / dil, LB = L >> 5;
      const u16* Q = QK + (size_t)(10 + head) * GS + bl * BS;
      const u16* K = QK + (size_t)(16 + head) * GS + bl * BS;
      const u16* V = VB + (size_t)(2 + head) * GS + bl * BS;
      bf16x8 qf[4]; load_kf4(qf, Q, qblk, lane);
      float l = 0.f;
      f32x16 O0, O1; zero16(O0); zero16(O1);
      const int rsub = qblk / LB;
      const int lo = rsub * LB, hi = lo + LB - 1;
      const int kb_lo = (qblk - 2 < lo) ? lo : qblk - 2, kb_hi = (qblk + 2 > hi) ? hi : qblk + 2;
      const int qd = qblk * 32 + fr;
      bf16x8 kf[4], vf[2][2];
      load_kf4(kf, K, kb_lo, lane); load_vf(vf, V, kb_lo, lane);
      for (int kb = kb_lo; kb <= kb_hi; ++kb) {
        bf16x8 nkf[4], nvf[2][2];
        const int kn = (kb < kb_hi) ? kb + 1 : kb;
        load_kf4(nkf, K, kn, lane); load_vf(nvf, V, kn, lane);
        f32x16 S = sinit;
#pragma unroll
        for (int s = 0; s < 4; ++s) S = MFMA32(kf[s], qf[s], S);
        if (kb == qblk - 2 || kb == qblk + 2) {
#pragma unroll
          for (int i = 0; i < 16; ++i) {
            const int dlt = kb * 32 + crow(i, fh) - qd;
            S[i] = (dlt <= 64 && dlt >= -64) ? S[i] : (-__builtin_inff());
          }
        }
        attn_plain_pv(S, l, O0, O1, vf);
#pragma unroll
        for (int s = 0; s < 4; ++s) kf[s] = nkf[s];
#pragma unroll
        for (int s = 0; s < 2; ++s) { vf[0][s] = nvf[0][s]; vf[1][s] = nvf[1][s]; }
      }
      const float lt = l + __shfl_xor(l, 32);
      const float inv = 1.0f / lt;
      const int msub = qd - rsub * L;
      const int pos = msub * dil + rsub;
      const size_t tok = (size_t)bl * SEQ + pos;
      store_o(BO + tok * 384 + head * 64, O0, O1, inv, fh);
      if (fh == 0) LSE[tok * 8 + head] = __log2f(lt) + mbB;
    }
  }
}


__device__ void phase_bcombine(const Params& p, int tid_, int tok0) {
  const u16* BO = (const u16*)(p.ws + OFF_BO);
  const float* LSE = (const float*)(p.ws + OFF_LSE);
  u16* YB = (u16*)(p.ws + OFF_Y5) + (size_t)2 * TC * 256;
  for (int e = tid_; e < 256 * 16; e += NTHR) {
    const int tok = tok0 + (e >> 4), j = (e >> 3) & 1, c8 = (e & 7) * 8;
    const float a0 = LSE[(size_t)tok * 8 + j], a1 = LSE[(size_t)tok * 8 + 2 + j], a2 = LSE[(size_t)tok * 8 + 4 + j];
    const float mx = fmaxf(a0, fmaxf(a1, a2));
    float w0 = fexp2(a0 - mx), w1 = fexp2(a1 - mx), w2 = fexp2(a2 - mx);
    const float inv = 1.0f / (w0 + w1 + w2);
    w0 *= inv; w1 *= inv; w2 *= inv;
    const u32x4 x0 = *(const u32x4*)(BO + (size_t)tok * 384 + (0 + j) * 64 + c8);
    const u32x4 x1 = *(const u32x4*)(BO + (size_t)tok * 384 + (2 + j) * 64 + c8);
    const u32x4 x2 = *(const u32x4*)(BO + (size_t)tok * 384 + (4 + j) * 64 + c8);
    u32x4 o;
#pragma unroll
    for (int q = 0; q < 4; ++q) {
      const float lo = w0 * bf_lo(x0[q]) + w1 * bf_lo(x1[q]) + w2 * bf_lo(x2[q]);
      const float hi = w0 * bf_hi(x0[q]) + w1 * bf_hi(x1[q]) + w2 * bf_hi(x2[q]);
      o[q] = pk2(lo, hi);
    }
    *(u32x4*)(YB + (size_t)tok * 256 + j * 64 + c8) = o;
  }
}

#define XB_TMO      128
#define XB_XCNT(j)  (256  + 64 * (j))
#define XB_XSUB(j)  (1280 + 64 * (j))
#define XB_XGEN(j)  (2304 + 64 * (j))
#define XB_TOP      3328
#define XB_TOPGEN   3392
#define XCD_BAR_WORDS 3456
#define XB_SPIN_CAP (1u << 22)
#define LAS __attribute__((address_space(3)))
DI unsigned xb_ld(unsigned* p)              { return __hip_atomic_load(p, __ATOMIC_RELAXED, __HIP_MEMORY_SCOPE_AGENT); }
DI unsigned xb_add(unsigned* p, unsigned v) { return __hip_atomic_fetch_add(p, v, __ATOMIC_RELAXED, __HIP_MEMORY_SCOPE_AGENT); }
DI unsigned xb_xcc_id() { return (unsigned)__builtin_amdgcn_s_getreg((3 << 11) | 20) & 0xFu; }
#define XB_SPIN(cond, bar) do { unsigned _sp = 0; while (cond) { __builtin_amdgcn_s_sleep(1); \
    if ((++_sp & 255u) == 0u) { if (xb_ld(&(bar)[XB_TMO])) break; if (_sp > XB_SPIN_CAP) { atomicAdd(&(bar)[XB_TMO], 1u); break; } } } } while (0)
struct XcdBarrier { unsigned* bar; unsigned x; volatile LAS unsigned* st; };
DI XcdBarrier xcd_barrier_post(unsigned* bar, volatile LAS unsigned* st) {
  XcdBarrier b; b.bar = bar; b.x = xb_xcc_id(); b.st = st;
  if (threadIdx.x == 0) (void)xb_add(&bar[XB_XCNT(b.x)], 1u);
  return b;
}
DI void xcd_barrier_complete(unsigned* bar, unsigned x, unsigned& nloc, unsigned& nx) {
  const unsigned G = gridDim.x * gridDim.y * gridDim.z;
  unsigned sum, cnt, mine, sp = 0u;
  for (;;) {
    sum = 0u; cnt = 0u; mine = 0u;
#pragma unroll
    for (unsigned j = 0; j < 16; ++j) { const unsigned c = xb_ld(&bar[XB_XCNT(j)]); sum += c; cnt += (c > 0u) ? 1u : 0u; mine = (j == x) ? c : mine; }
    if (sum == G) break;
    __builtin_amdgcn_s_sleep(1);
    if ((++sp & 255u) == 0u) { if (xb_ld(&bar[XB_TMO])) break; if (sp > XB_SPIN_CAP) { atomicAdd(&bar[XB_TMO], 1u); break; } }
  }
  nloc = mine > 0u ? mine : 1u; nx = cnt > 0u ? cnt : 1u;
}
DI void xcd_barrier(const XcdBarrier& b) {
  asm volatile("s_waitcnt vmcnt(0)" ::: "memory");
  __syncthreads();
  if (threadIdx.x == 0) {
    unsigned* bar = b.bar;
    __builtin_amdgcn_s_waitcnt(0);
    unsigned nloc = b.st[0], nx = b.st[1];
    if (nloc == 0u) { xcd_barrier_complete(bar, b.x, nloc, nx); b.st[0] = nloc; b.st[1] = nx; }
    const unsigned old = xb_add(&bar[XB_XSUB(b.x)], 1u);
    const unsigned gen = old / nloc;
    if (old + 1u == (gen + 1u) * nloc) {
      __builtin_amdgcn_fence(__ATOMIC_RELEASE, "agent");
      asm volatile("s_waitcnt vmcnt(0)" ::: "memory");
      const unsigned og = xb_add(&bar[XB_TOP], 1u);
      const unsigned tg = og / nx;
      if (og + 1u == (tg + 1u) * nx) xb_add(&bar[XB_TOPGEN], 1u);
      else XB_SPIN(xb_ld(&bar[XB_TOPGEN]) == tg, bar);
      __builtin_amdgcn_fence(__ATOMIC_ACQUIRE, "agent");
      xb_add(&bar[XB_XGEN(b.x)], 1u);
      asm volatile("s_waitcnt vmcnt(0)" ::: "memory");
    } else {
      XB_SPIN(xb_ld(&bar[XB_XGEN(b.x)]) == gen, bar);
      __builtin_amdgcn_fence(__ATOMIC_ACQUIRE, "agent");
      asm volatile("s_waitcnt vmcnt(0)" ::: "memory");
    }
  }
  __syncthreads();
}

__global__ void __launch_bounds__(NTHR, 2) mk_forward(Params p) {
  extern __shared__ __attribute__((aligned(16))) unsigned char smem[];
  cg::grid_group grid = cg::this_grid();
  volatile LAS unsigned* xbw = (volatile LAS unsigned*)(smem + LDS_XBW);
  if (threadIdx.x < 4) xbw[threadIdx.x] = 0u;
  __syncthreads();
  XcdBarrier xb;
  if (FUSED) xb = xcd_barrier_post((unsigned*)(p.ws + OFF_BAR), xbw);
#if PROBE_CLOCK
  const unsigned long long pc_t0 = clock64(), pc_r0 = wall_clock64();
#endif
  PG8_LAS unsigned char* lds = (PG8_LAS unsigned char*)smem;
  for (int ph = p.ph_lo; ph < p.ph_hi; ++ph) {
#if DUPMASK
   for (int rep = 0; rep < ((ph > 0 && ((DUPMASK >> ((ph - 1) % 7)) & 1)) ? 2 : 1); ++rep)
#endif
   {
    int tid_ = threadIdx.x, bid_ = blockIdx.x, nblk_ = gridDim.x;
    asm volatile("" : "+v"(tid_));
    asm volatile("" : "+s"(bid_));
    asm volatile("" : "+s"(nblk_));
    Params pp = p;
    asm volatile("" : "+s"(pp.ws));
    asm volatile("" : "+s"(pp.out));
    unsigned char* ws = pp.ws;
    if (ph == 0) {
      if (PHMASK & 128) phase_prep(pp, tid_, bid_, nblk_, smem);
    } else {
      const int q = ph - 1, chunk = q / (2 * PPL), layer = (q % (2 * PPL)) / PPL, kk = q % PPL, k = (kk == 6) ? DUPK : (kk < 2 ? kk : kk + 1);
      const u16* XBc = (const u16*)(ws + OFF_XB) + (size_t)chunk * TC * DM;
      float* SSQc = (float*)(ws + OFF_SSQ) + (size_t)chunk * TC * 16;
      float* xc = pp.out + (size_t)chunk * TC * DM;
      const bool hiwg = (bid_ * 2 >= nblk_);
      int gu_lo = 0, gu_hi = 0, gu_mode = 0;
      if (k == 0 && (PHMASK & 1)) {
        {
          EpiQKG e; e.ssq = SSQc; e.qk = (u16*)(ws + OFF_QK); e.rope = (const float*)(ws + OFF_ROPE);
          e.gA = pp.in[3] + layer * 128; e.gB = pp.in[5] + layer * 128; e.gC = pp.in[6] + layer * 64; e.gD = pp.in[9] + layer * 128;
          run_gemm(lds, XBc, (const u16*)(ws + OFF_WQKG) + (size_t)layer * NQKG * DM, TC, 2560, DM, e);
        }
        {
          EpiVT ev; ev.ssq = SSQc; ev.vbuf = (u16*)(ws + OFF_V);
          run_gemm(lds, (const u16*)(ws + OFF_WV) + (size_t)layer * DM * DM, XBc, DM, TC, DM, ev);
        }
        if (hiwg) { gu_lo = 3; gu_hi = 4; }
      } else if (k == 1 && (PHMASK & 2)) {
        phase_attn(pp, tid_, bid_, nblk_, layer, smem);
        __syncthreads();
        gu_lo = 0; gu_hi = hiwg ? 3 : 4;
      } else if (k == 5 && (PHMASK & 32)) {
        gu_lo = 0; gu_hi = 4; gu_mode = 1;
      }
      if (gu_hi > gu_lo) {
        const bool up = (gu_mode == 1);
        EpiGateUp e; e.ssq = SSQc; e.o = (u16*)(ws + OFF_GATE); e.mode = up ? ((PROBE_NOEPI && kk == 6) ? 2 : 1) : 0;
        const u16* W = up ? (const u16*)(ws + OFF_WUP) + (size_t)layer * DMLP * DM : (const u16*)(ws + OFF_WQKG) + ((size_t)layer * NQKG + 2560) * DM;
        run_gemm(lds, XBc, W, TC, 4096, DM, e, (PROBE_NOEPI && kk == 6) ? 1 : 0, gu_lo, gu_hi);
      }
      if (k == 0 || k == 1 || k == 5) {
      } else if (k == 3 && (PHMASK & 8)) {
        {
          Unit u0; pg8::StaticOrder S0; S0.init(TC, DM, nblk_, bid_); S0.next(0, u0);
          phase_bcombine(pp, tid_, u0.pm * 256);
          asm volatile("s_waitcnt vmcnt(0)" ::: "memory");
          __syncthreads();
        }
        EpiMerge e; e.gate = (const u16*)(ws + OFF_GATE); e.mrg = (u16*)(ws + OFF_MRG);
        run_merge(lds, (const u16*)(ws + OFF_Y5), (const u16*)(ws + OFF_WBR5) + (size_t)layer * 5 * DM * 256, e);
      } else if ((k == 4 && (PHMASK & 16)) || (k == 6 && (PHMASK & 64))) {
        const bool dn = (k == 6);
        EpiResid e; e.xout = xc; e.xb = (u16*)XBc; e.ssq = SSQc; e.wf32 = (dn && layer == 1) ? 1 : 0;
        const u16* A = dn ? (const u16*)(ws + OFF_GATE) : (const u16*)(ws + OFF_MRG);
        const u16* W = dn ? (const u16*)(ws + OFF_WDN) + (size_t)layer * DM * DMLP : (const u16*)(ws + OFF_WOUT) + (size_t)layer * DM * DM;
        run_gemm(lds, A, W, TC, DM, dn ? DMLP : DM, e);
      }
    }
   }
    if (ph + 1 < p.ph_hi) {
      if (p.ph_lo < 0) grid.sync();
      xcd_barrier(xb);
    }
  }
#if PROBE_CLOCK
  {
    xcd_barrier(xb);
    const unsigned long long pc_t1 = clock64(), pc_r1 = wall_clock64();
    const float ghz = (float)(pc_t1 - pc_t0) / ((float)(pc_r1 - pc_r0) * 10.0f);
    const int nrows = (int)(ghz * 0.25f * (float)T);
    for (int r = blockIdx.x; r < nrows; r += gridDim.x)
      for (int c = threadIdx.x; c < DM; c += NTHR) p.out[(size_t)r * DM + c] = 0.f;
  }
#endif
}

extern "C" void kernel_launch(void* const* d_in, const int* in_sizes, int n_in, void* d_out, int out_size, void* d_ws, size_t ws_size,
                              hipStream_t stream) {
  static int grid_blocks = 0;
  if (grid_blocks == 0) {
    if (n_in != 19 || out_size != T * DM || ws_size < WS_END) {
      fprintf(stderr, "kernel_launch: unexpected problem (n_in %d out %d ws %zu need %zu)\n", n_in, out_size, ws_size, (size_t)WS_END);
      grid_blocks = -1;
      return;
    }
    int dev = 0, cus = 0, per_cu = 0;
    (void)hipGetDevice(&dev);
    (void)hipDeviceGetAttribute(&cus, hipDeviceAttributeMultiprocessorCount, dev);
    if (hipFuncSetAttribute((const void*)mk_forward, hipFuncAttributeMaxDynamicSharedMemorySize, LDS_BYTES) != hipSuccess) {
      fprintf(stderr, "kernel_launch: hipFuncSetAttribute failed\n"); grid_blocks = -1; return;
    }
    (void)hipOccupancyMaxActiveBlocksPerMultiprocessor(&per_cu, mk_forward, NTHR, LDS_BYTES);
    if (per_cu < 1) fprintf(stderr, "kernel_launch: occupancy query says %d blocks per CU\n", per_cu);
    (void)hipGetLastError();
    grid_blocks = cus;
  }
  if (grid_blocks < 0) return;
  Params p{};
  for (int i = 0; i < 19; ++i) p.in[i] = (const float*)d_in[i];
  p.out = (float*)d_out;
  p.ws = (unsigned char*)d_ws;
#if FUSED
  (void)hipMemsetAsync((unsigned char*)d_ws + OFF_BAR, 0, XCD_BAR_WORDS * 4, stream);
  p.ph_lo = 0; p.ph_hi = NPHASE;
  void* args[] = {&p};
  hipError_t e = hipLaunchCooperativeKernel((const void*)mk_forward, dim3(grid_blocks), dim3(NTHR), args, LDS_BYTES, stream);
  if (e != hipSuccess) fprintf(stderr, "cooperative launch failed: %s (grid %d)\n", hipGetErrorString(e), grid_blocks);
#else
  for (int ph = 0; ph < NPHASE; ++ph) {
    p.ph_lo = ph; p.ph_hi = ph + 1;
    hipLaunchKernelGGL(mk_forward, dim3(grid_blocks), dim3(NTHR), LDS_BYTES, stream, p);
  }
#endif
}
```

```cpp
#include <hip/hip_runtime.h>
#include <hip/hip_cooperative_groups.h>
#include <cstdio>
namespace cg = cooperative_groups;

#ifndef PHMASK
#define PHMASK 255
#endif
#ifndef DUPMASK
#define DUPMASK 0
#endif
#ifndef DUPK
#define DUPK -1
#endif
#ifndef PROBE_CLOCK
#define PROBE_CLOCK 0
#endif
#ifndef PROBE_NOEPI
#define PROBE_NOEPI 0
#endif
#ifndef FUSED
#define FUSED 1
#endif

namespace pg8 {
#define PG8_LAS __attribute__((address_space(3)))
typedef unsigned short bf16_t;
typedef short bf16x8 __attribute__((ext_vector_type(8)));
typedef float f32x4 __attribute__((ext_vector_type(4)));
typedef unsigned u32x4 __attribute__((ext_vector_type(4)));
constexpr int BM = 256, BK = 64, HALF = 128, HTB = HALF * BK * 2  , STAGE_BYTES = 8 * HTB, NXCD = 8, WGM = 8;

__host__ __device__ __forceinline__ int lds_byte(int r, int c) { const int st = (r >> 4) * 2 + (c >> 5), rr = r & 15, cc = c & 31, ob = rr * 64 + cc * 2; return st * 1024 + (ob ^ (((ob >> 9) & 1) << 5)); }
__host__ __device__ __forceinline__ void stage_rc(int b, int& R, int& C) { const int st = b / 1024, sb = b % 1024, swz = sb ^ (((sb >> 9) & 1) << 5); R = (st >> 1) * 16 + swz / 64; C = (st & 1) * 32 + (swz % 64) / 2; }
__host__ __device__ __forceinline__ int perm32(int rho) { const int n = rho >> 4, i = rho & 15; return 8 * (i >> 2) + 4 * n + (i & 3); }

struct Unit { int pm, pn, seg; };
struct Gemm { const bf16_t* A; const bf16_t* Bt; int M, N, K; };

struct StaticOrder {
    int nM, nN, nwg, G, c, probe = 0, ilo = 0, ihi = 1 << 30;
    __host__ __device__ void init(int M, int N, int G_, int c_) { nM = M / BM; nN = N / BM; nwg = nM * nN; G = G_; c = c_; }
    __host__ __device__ bool next(int i, Unit& u) const {
        i += ilo; if (i >= ihi) return false;
        const long L = (long)i * G + c; if (L >= nwg) return false;
        int wgid = (int)L; { const int q = nwg / NXCD, r = nwg % NXCD, xcd = wgid % NXCD, off = wgid / NXCD; wgid = (xcd < r ? xcd * (q + 1) : r * (q + 1) + (xcd - r) * q) + off; }
        const int nig = WGM * nN, gid = wgid / nig, fm = gid * WGM, gsz = (nM - fm) < WGM ? (nM - fm) : WGM;
        u.pm = fm + ((wgid % nig) % gsz); u.pn = (wgid % nig) / gsz; u.seg = 0; if (probe) { u.pm = 0; u.pn = 0; } return true;
    }
    __device__ __forceinline__ void a_ready(const Unit&) const {}
    __device__ __forceinline__ void done(const Unit&) const {}
    __device__ __forceinline__ const char* baseA(const Gemm& g, const Unit& u, size_t tstep) const { return (const char*)g.A + (size_t)u.pm * tstep; }
    __device__ __forceinline__ const char* baseB(const Gemm& g, const Unit& u, size_t tstep) const { return (const char*)g.Bt + (size_t)u.pn * tstep; }
    __device__ __forceinline__ bool zero_after(const Unit&) const { return true; }
};

template <class Epi, class Sched, bool STAMP = false>
__device__ __forceinline__ void gemm_phase(PG8_LAS unsigned char* lds, const Gemm g, const Sched& S, const Epi& E, unsigned long long* stamps) {
    int tid = threadIdx.x; asm volatile("" : "+v"(tid));
    const int wid = __builtin_amdgcn_readfirstlane(tid >> 6), lane = tid & 63, wr = wid >> 2, wc = wid & 3, fr = lane & 15, fq = lane >> 4;
    const int K = g.K, nt = K / BK;
    int ts_lo = 0, ts_hi = 0, nts = 0; const unsigned long long rt_entry = STAMP ? (unsigned long long)wall_clock64() : 0ull;
#define PG8_STAMP() do { if (STAMP && wid == 0 && nts < 64) { const unsigned long long _c = (unsigned long long)clock64(); \
        ts_lo = (lane == nts) ? (int)(unsigned)_c : ts_lo; ts_hi = (lane == nts) ? (int)(unsigned)(_c >> 32) : ts_hi; ++nts; } } while (0)
    PG8_STAMP();
    unsigned voffA[2], voffB[2];
#pragma unroll
    for (int i = 0; i < 2; ++i) { int R, C; stage_rc(tid * 16 + i * 8192, R, C); const int Rb = Epi::PERM ? ((R & ~31) + perm32(R & 31)) : R;
        voffA[i] = (unsigned)(R * K + C) * 2u; voffB[i] = (unsigned)(Rb * K + C) * 2u; }
    const size_t kstep = (size_t)(BK * 2);
    const size_t hstep = (size_t)HALF * K * 2;
    const size_t tstep = 2 * hstep;
    const unsigned ldsw = (unsigned)wid * 1024u;
    const int aoff = lds_byte(wr * 64 + fr, fq * 8), boff = lds_byte(wc * 32 + fr, fq * 8);
#define PG8_SA(b, h) (((b) * 2 + (h)) * HTB)
#define PG8_SB(b, h) ((4 + (b) * 2 + (h)) * HTB)
#define PG8_STAGE(bufoff, gbase, voff) do { _Pragma("unroll") for (int _i = 0; _i < 2; ++_i) \
        __builtin_amdgcn_global_load_lds((const unsigned*)((const char*)(gbase) + (voff)[_i]), (PG8_LAS unsigned*)(lds + (bufoff) + ldsw + _i * 8192), 16, 0, 0); } while (0)
#define PG8_LDA(dst, b, h) do { _Pragma("unroll") for (int m = 0; m < 4; ++m) _Pragma("unroll") for (int k = 0; k < 2; ++k) dst[m][k] = *(const PG8_LAS bf16x8*)(lds + PG8_SA(b, h) + aoff + m * 2048 + k * 1024); } while (0)
#define PG8_LDB(dst, b, h) do { _Pragma("unroll") for (int n = 0; n < 2; ++n) _Pragma("unroll") for (int k = 0; k < 2; ++k) dst[n][k] = *(const PG8_LAS bf16x8*)(lds + PG8_SB(b, h) + boff + n * 2048 + k * 1024); } while (0)
#define PG8_MMA(ai, bj, At, Bt) do { __builtin_amdgcn_s_setprio(1); _Pragma("unroll") for (int m = 0; m < 4; ++m) _Pragma("unroll") for (int n = 0; n < 2; ++n) _Pragma("unroll") for (int k = 0; k < 2; ++k) \
        acc[ai][bj][m][n] = __builtin_amdgcn_mfma_f32_16x16x32_bf16(Bt[n][k], At[m][k], acc[ai][bj][m][n], 0, 0, 0); __builtin_amdgcn_s_setprio(0); } while (0)
#define PG8_WAIT_V(n) asm volatile("s_waitcnt vmcnt(" #n ")" ::: "memory")
#define PG8_WAIT_L(n) asm volatile("s_waitcnt lgkmcnt(" #n ")" ::: "memory")
#define PG8_BAR __builtin_amdgcn_s_barrier()
#define PG8_SCHED __builtin_amdgcn_sched_barrier(0)
    Unit cur, nxt; int ui = 0;
    if (!S.next(0, cur)) return;
    f32x4 acc[2][2][4][2];
#pragma unroll
    for (int a = 0; a < 2; ++a)
#pragma unroll
        for (int b = 0; b < 2; ++b)
#pragma unroll
            for (int m = 0; m < 4; ++m)
#pragma unroll
                for (int n = 0; n < 2; ++n) acc[a][b][m][n] = (f32x4){0.f, 0.f, 0.f, 0.f};
    bf16x8 At[4][2], B0[2][2], B1[2][2];
    const char* cA = S.baseA(g, cur, tstep); const char* cB = S.baseB(g, cur, tstep);
    S.a_ready(cur);
    PG8_STAGE(PG8_SB(0, 0), cB, voffB); PG8_STAGE(PG8_SA(0, 0), cA, voffA); PG8_STAGE(PG8_SB(0, 1), cB + hstep, voffB); PG8_STAGE(PG8_SA(0, 1), cA + hstep, voffA);
    if (wr == 1) PG8_BAR;
    PG8_WAIT_V(4); PG8_BAR;
    PG8_STAGE(PG8_SB(1, 0), cB + kstep, voffB); PG8_STAGE(PG8_SA(1, 0), cA + kstep, voffA); PG8_STAGE(PG8_SB(1, 1), cB + hstep + kstep, voffB);
    PG8_WAIT_V(6); PG8_BAR;
    PG8_STAMP();
    for (;;) {
        const bool has_next = S.next(ui + 1, nxt);
        const char* nA = has_next ? S.baseA(g, nxt, tstep) : cA; const char* nB = has_next ? S.baseB(g, nxt, tstep) : cB;
        for (int t = 0; t < nt; t += 2) {
            const bool last = (t == nt - 2);
            const char* a1 = cA + (size_t)(t + 1) * kstep;
            const char* a2 = last ? nA : cA + (size_t)(t + 2) * kstep; const char* b2 = last ? nB : cB + (size_t)(t + 2) * kstep;
            const char* a3 = a2 + kstep; const char* b3 = b2 + kstep;
            if (last && has_next) S.a_ready(nxt);
            PG8_LDB(B0, 0, 0); PG8_SCHED; PG8_LDA(At, 0, 0); PG8_STAGE(PG8_SA(1, 1), a1 + hstep, voffA);
            PG8_WAIT_L(8); PG8_BAR; PG8_WAIT_L(0); PG8_MMA(0, 0, At, B0); PG8_BAR; PG8_SCHED;
            PG8_LDB(B1, 0, 1); PG8_STAGE(PG8_SB(0, 0), b2, voffB);
            PG8_BAR; PG8_WAIT_L(0); PG8_MMA(0, 1, At, B1); PG8_BAR;
            PG8_LDA(At, 0, 1); PG8_STAGE(PG8_SA(0, 0), a2, voffA);
            PG8_BAR; PG8_WAIT_L(0); PG8_MMA(1, 0, At, B0); PG8_BAR; PG8_SCHED;
            PG8_STAGE(PG8_SB(0, 1), b2 + hstep, voffB);
            PG8_WAIT_V(6); PG8_BAR; PG8_MMA(1, 1, At, B1); PG8_BAR;
            PG8_LDB(B0, 1, 0); PG8_SCHED; PG8_LDA(At, 1, 0); PG8_STAGE(PG8_SA(0, 1), a2 + hstep, voffA);
            PG8_WAIT_L(8); PG8_BAR; PG8_WAIT_L(0); PG8_MMA(0, 0, At, B0); PG8_BAR; PG8_SCHED;
            PG8_LDB(B1, 1, 1); PG8_STAGE(PG8_SB(1, 0), b3, voffB);
            PG8_BAR; PG8_WAIT_L(0); PG8_MMA(0, 1, At, B1); PG8_BAR;
            PG8_LDA(At, 1, 1); PG8_STAGE(PG8_SA(1, 0), a3, voffA);
            PG8_BAR; PG8_WAIT_L(0); PG8_MMA(1, 0, At, B0); PG8_BAR; PG8_SCHED;
            PG8_STAGE(PG8_SB(1, 1), b3 + hstep, voffB);
            PG8_WAIT_V(6); PG8_BAR; PG8_MMA(1, 1, At, B1); PG8_BAR;
        }
        PG8_STAMP();
        if constexpr (!Epi::AFTER_DRAIN) { E(acc, cur, wr, wc, fr, fq); S.done(cur); }
        PG8_STAMP();
        if (!has_next) break;
        if (S.zero_after(cur))
#pragma unroll
        for (int a = 0; a < 2; ++a)
#pragma unroll
            for (int b = 0; b < 2; ++b)
#pragma unroll
                for (int m = 0; m < 4; ++m)
#pragma unroll
                    for (int n = 0; n < 2; ++n) acc[a][b][m][n] = (f32x4){0.f, 0.f, 0.f, 0.f};
        cur = nxt; cA = nA; cB = nB; ++ui;
    }
    PG8_WAIT_V(0);
    if (wr == 0) PG8_BAR;
    PG8_BAR;
    if constexpr (Epi::AFTER_DRAIN) { E.fused(acc, cur, wr, wc, fr, fq, lds, wid, lane); S.done(cur); }
    PG8_STAMP();
    if (STAMP && wid == 0) { stamps[lane] = lane < nts ? (((unsigned long long)(unsigned)ts_hi << 32) | (unsigned)ts_lo) : 0ull;
        if (lane == 62) stamps[62] = rt_entry; if (lane == 63) stamps[63] = (unsigned long long)wall_clock64(); }
#undef PG8_STAMP
#undef PG8_SA
#undef PG8_SB
#undef PG8_STAGE
#undef PG8_LDA
#undef PG8_LDB
#undef PG8_MMA
#undef PG8_WAIT_V
#undef PG8_WAIT_L
#undef PG8_BAR
#undef PG8_SCHED
}
}

typedef unsigned short u16;
typedef short bf16x8 __attribute__((ext_vector_type(8)));
typedef float f32x16 __attribute__((ext_vector_type(16)));
typedef float f32x4 __attribute__((ext_vector_type(4)));
typedef __bf16 bf2_t __attribute__((ext_vector_type(2)));
typedef float f2_t __attribute__((ext_vector_type(2)));
typedef unsigned u32x4 __attribute__((ext_vector_type(4)));
typedef unsigned u32x2 __attribute__((ext_vector_type(2)));
using pg8::Unit;

#define DI __device__ __forceinline__
#define MFMA32(a, b, c) __builtin_amdgcn_mfma_f32_32x32x16_bf16((a), (b), (c), 0, 0, 0)

constexpr int DM = 1024, SEQ = 4096, NBATCH = 8, T = NBATCH * SEQ;
constexpr int NCH = 2, BC = NBATCH / NCH, TC = BC * SEQ;
constexpr int INC = 7552, DMLP = 4096;
constexpr int NQKG = 6656;
constexpr int NQKH = 38, NVH = 16;
constexpr float LOG2E = 1.4426950408889634f;
constexpr int NTHR = 512;

constexpr size_t al256(size_t x) { return (x + 255) & ~(size_t)255; }
constexpr size_t OFF_WQKG = 0;
constexpr size_t OFF_WV   = OFF_WQKG + al256((size_t)2 * NQKG * DM * 2);
constexpr size_t OFF_WBR5 = OFF_WV   + al256((size_t)2 * DM * DM * 2);
constexpr size_t OFF_WOUT = OFF_WBR5 + al256((size_t)2 * 5 * DM * 256 * 2);
constexpr size_t OFF_WUP  = OFF_WOUT + al256((size_t)2 * DM * DM * 2);
constexpr size_t OFF_WDN  = OFF_WUP  + al256((size_t)2 * DMLP * DM * 2);
constexpr size_t OFF_ROPE = OFF_WDN  + al256((size_t)2 * DM * DMLP * 2);
constexpr size_t OFF_XB   = OFF_ROPE + al256((size_t)(SEQ + 1) * 96 * 4);
constexpr size_t OFF_SSQ  = OFF_XB   + al256((size_t)T * DM * 2);
constexpr size_t OFF_QK   = OFF_SSQ  + al256((size_t)T * 16 * 4);
constexpr size_t OFF_V    = OFF_QK   + al256((size_t)NQKH * TC * 64 * 2);
constexpr size_t OFF_GATE = OFF_V    + al256((size_t)NVH * TC * 64 * 2);
constexpr size_t OFF_Y5   = OFF_GATE + al256((size_t)TC * 4096 * 2);
constexpr size_t OFF_BO   = OFF_Y5   + al256((size_t)5 * TC * 256 * 2);
constexpr size_t OFF_LSE  = OFF_BO   + al256((size_t)TC * 384 * 2);
constexpr size_t OFF_MRG  = OFF_LSE  + al256((size_t)TC * 8 * 4);
constexpr size_t OFF_BAR  = OFF_MRG  + al256((size_t)TC * DM * 2);
constexpr size_t WS_END   = OFF_BAR  + 16384;
static_assert(WS_END <= (size_t)512 * 1024 * 1024, "workspace too large");

constexpr int LDS_STAGE = 131072;
constexpr int VT_STRIDE = 528;
constexpr int LDS_XBW = 256 * VT_STRIDE;
constexpr int LDS_BYTES = LDS_XBW + 64 + 1024;
constexpr int PPL = (DUPK >= 0) ? 7 : 6;
constexpr int NPHASE = 1 + NCH * 2 * PPL;

struct Params {
  const float* in[19];
  float* out;
  unsigned char* ws;
  int ph_lo, ph_hi;
};

DI unsigned pk2(float a, float b) { f2_t v = {a, b}; bf2_t r = __builtin_convertvector(v, bf2_t); return __builtin_bit_cast(unsigned, r); }
DI float bf_lo(unsigned u) { return __uint_as_float(u << 16); }
DI float bf_hi(unsigned u) { return __uint_as_float(u & 0xffff0000u); }
DI float fexp2(float x) { return __builtin_amdgcn_exp2f(x); }
DI int crow(int i, int h) { return (i & 3) + 8 * (i >> 2) + 4 * h; }
DI bf16x8 as_bf8(u32x4 v) { return __builtin_bit_cast(bf16x8, v); }
DI int dil_of(int gi) { return gi == 0 ? 1 : (gi == 1 ? 4 : 16); }
DI int dlg_of(int gi) { return gi * 2; }
DI float row_rscale(const float* ssq, size_t tok) {
  const f32x4 a = *(const f32x4*)(ssq + tok * 16), b = *(const f32x4*)(ssq + tok * 16 + 4);
  const f32x4 c = *(const f32x4*)(ssq + tok * 16 + 8), d = *(const f32x4*)(ssq + tok * 16 + 12);
  const float s = ((a[0] + a[1]) + (a[2] + a[3])) + ((b[0] + b[1]) + (b[2] + b[3])) + ((c[0] + c[1]) + (c[2] + c[3])) + ((d[0] + d[1]) + (d[2] + d[3]));
  return rsqrtf(s * (1.0f / 1024.0f) + 1e-6f);
}
DI int qk_head_col(int h) {
  if (h < 8) return 64 * h;
  if (h < 10) return 512 + 64 * (h - 8);
  if (h < 16) return 768 + 64 * (h - 10);
  if (h < 22) return 1152 + 64 * (h - 16);
  if (h < 26) return 1920 + 64 * (h - 22);
  if (h < 30) return 2176 + 64 * (h - 26);
  if (h < 34) return 2688 + 64 * (h - 30);
  return 2944 + 64 * (h - 34);
}
DI int v_head_col(int vh) {
  if (vh < 2) return 640 + 64 * vh;
  if (vh < 8) return 1536 + 64 * (vh - 2);
  if (vh < 12) return 2432 + 64 * (vh - 8);
  return 3200 + 64 * (vh - 12);
}

struct EpiQKG {
  static constexpr bool PERM = true, AFTER_DRAIN = false;
  const float* ssq; u16* qk; const float* rope; const float* gA; const float* gB; const float* gC; const float* gD;
  DI void body64(const f32x4 (&acc)[2][2][4][2], const Unit& u, int wr, int fr, int fq, unsigned goff, const float* gainl, float qpre, int dlg, int rope_on) const {
#pragma unroll
    for (int ai = 0; ai < 2; ++ai) {
#pragma unroll
      for (int m = 0; m < 4; ++m) {
        const int tok = u.pm * 256 + 128 * ai + 64 * wr + 16 * m + fr;
        const int bl = tok >> 12, pos = tok & 4095;
        const float rs = row_rscale(ssq, tok);
        const int pdom = ((pos & ((1 << dlg) - 1)) << (12 - dlg)) + (pos >> dlg);
        const int blk = pdom >> 5, rr = pdom & 31;
        const unsigned boff = goff + (unsigned)bl * (SEQ * 64) + (unsigned)(((blk * 4 + (fq >> 1)) * 64 + (fq & 1) * 32 + rr) * 8);
        const float* rp = rope + (unsigned)((rope_on ? pos : SEQ) * 96 + 8 * fq);
        float ss = 0.f;
#pragma unroll
        for (int bj = 0; bj < 2; ++bj)
#pragma unroll
          for (int n = 0; n < 2; ++n)
#pragma unroll
            for (int e = 0; e < 4; ++e) ss += acc[ai][bj][m][n][e] * acc[ai][bj][m][n][e];
        ss += __shfl_xor(ss, 16); ss += __shfl_xor(ss, 32);
        const float sc = rs * rsqrtf(ss * rs * rs * (1.0f / 64.0f) + 1e-6f) * qpre;
        u32x4 w0, w1;
#pragma unroll
        for (int n = 0; n < 2; ++n) {
          const f32x4 xa = acc[ai][0][m][n] * sc * *(const f32x4*)(gainl + 4 * n);
          const f32x4 xb2 = acc[ai][1][m][n] * sc * *(const f32x4*)(gainl + 32 + 4 * n);
          const f32x4 c4 = *(const f32x4*)(rp + 4 * n);
          const f32x4 s4 = *(const f32x4*)(rp + 32 + 4 * n);
          const f32x4 ta = xa * c4 - xb2 * s4, tb = xb2 * c4 + xa * s4;
          w0[2 * n] = pk2(ta[0], ta[1]); w0[2 * n + 1] = pk2(ta[2], ta[3]);
          w1[2 * n] = pk2(tb[0], tb[1]); w1[2 * n + 1] = pk2(tb[2], tb[3]);
        }
        *(u32x4*)(qk + boff) = w0;
        *(u32x4*)(qk + boff + 2 * 64 * 8) = w1;
        asm volatile("" ::: "memory");
      }
    }
  }
  DI void body32(const f32x4 (&acc)[2][2][4][2], const Unit& u, int wr, int fr, int fq, unsigned goff, const float* gainl, float qpre) const {
    const float sgn = (fq < 2) ? -1.0f : 1.0f;
#pragma unroll
    for (int ai = 0; ai < 2; ++ai) {
#pragma unroll
      for (int m = 0; m < 4; ++m) {
        const int tok = u.pm * 256 + 128 * ai + 64 * wr + 16 * m + fr;
        const int bl = tok >> 12, pos = tok & 4095;
        const float rs = row_rscale(ssq, tok);
        const int blk = pos >> 5, rr = pos & 31;
        const unsigned boff = goff + (unsigned)bl * (SEQ * 64) + (unsigned)(((blk * 2 + (fq >> 1)) * 64 + (fq & 1) * 32 + rr) * 8);
        const float* rp = rope + (unsigned)(pos * 96 + 64 + 8 * (fq & 1));
#pragma unroll
        for (int bj = 0; bj < 2; ++bj) {
          float ss = 0.f;
#pragma unroll
          for (int n = 0; n < 2; ++n)
#pragma unroll
            for (int e = 0; e < 4; ++e) ss += acc[ai][bj][m][n][e] * acc[ai][bj][m][n][e];
          ss += __shfl_xor(ss, 16); ss += __shfl_xor(ss, 32);
          const float sc = rs * rsqrtf(ss * rs * rs * (1.0f / 32.0f) + 1e-6f) * qpre;
          u32x4 w;
#pragma unroll
          for (int n = 0; n < 2; ++n) {
            const f32x4 x = acc[ai][bj][m][n] * sc * *(const f32x4*)(gainl + 4 * n);
            const f32x4 c4 = *(const f32x4*)(rp + 4 * n);
            const f32x4 s4 = *(const f32x4*)(rp + 16 + 4 * n);
            f32x4 pr;
#pragma unroll
            for (int e = 0; e < 4; ++e) pr[e] = __shfl_xor(x[e], 32);
            const f32x4 o = x * c4 + pr * s4 * sgn;
            w[2 * n] = pk2(o[0], o[1]); w[2 * n + 1] = pk2(o[2], o[3]);
          }
          *(u32x4*)(qk + boff + (unsigned)bj * (SEQ * 32)) = w;
        }
        asm volatile("" ::: "memory");
      }
    }
  }
  DI void operator()(const f32x4 (&acc)[2][2][4][2], const Unit& u, int wr, int wc, int fr, int fq) const {
    const int hidx = u.pn * 4 + wc;
    if (hidx >= NQKH) return;
    int kind, dlg = 0; const float* gain;
    if (hidx < 8) { kind = 0; gain = gA; }
    else if (hidx < 10) { kind = 0; gain = gA + 64; }
    else if (hidx < 16) { kind = 0; gain = gB; dlg = dlg_of((hidx - 10) >> 1); }
    else if (hidx < 22) { kind = 0; gain = gB + 64; dlg = dlg_of((hidx - 16) >> 1); }
    else if (hidx < 26) { kind = 2; gain = gC; }
    else if (hidx < 30) { kind = 2; gain = gC + 32; }
    else if (hidx < 34) { kind = 1; gain = gD; }
    else { kind = 1; gain = gD + 64; }
    const unsigned goff = (unsigned)hidx * (unsigned)(TC * 64);
    const float* gainl = gain + 8 * fq;
    const float qpre = (hidx >= 22 && hidx < 26) ? (0.17677669529663687f * LOG2E)
                     : ((hidx < 8 || (hidx >= 10 && hidx < 16) || (hidx >= 30 && hidx < 34)) ? (0.125f * LOG2E) : 1.0f);
    if (kind == 2) body32(acc, u, wr, fr, fq, goff, gainl, qpre);
    else body64(acc, u, wr, fr, fq, goff, gainl, qpre, dlg, kind == 0 ? 1 : 0);
  }
};

struct EpiGateUp {
  static constexpr bool PERM = true, AFTER_DRAIN = false;
  const float* ssq; u16* o; int mode;
  template <bool UP>
  DI void body(const f32x4 (&acc)[2][2][4][2], const Unit& u, int wr, int wc, int fr, int fq) const {
    const int c0 = u.pn * 256 + 32 * wc + 8 * fq;
    float rsv[8];
#pragma unroll
    for (int i = 0; i < 8; ++i) rsv[i] = row_rscale(ssq, (size_t)u.pm * 256 + 128 * (i >> 2) + 64 * wr + 16 * (i & 3) + fr);
#pragma unroll
    for (int ai = 0; ai < 2; ++ai)
#pragma unroll
      for (int m = 0; m < 4; ++m) {
        const size_t tok = (size_t)u.pm * 256 + 128 * ai + 64 * wr + 16 * m + fr;
        const float rs = rsv[ai * 4 + m];
#pragma unroll
        for (int bj = 0; bj < 2; ++bj) {
          float r[8];
#pragma unroll
          for (int n = 0; n < 2; ++n) {
            const f32x4 v = acc[ai][bj][m][n] * rs;
#pragma unroll
            for (int e = 0; e < 4; ++e) {
              if (UP) { const float z = fmaxf(v[e], 0.f); r[4 * n + e] = z * z; }
              else r[4 * n + e] = __builtin_amdgcn_rcpf(1.0f + fexp2(-LOG2E * v[e]));
            }
          }
          u32x4 w = {pk2(r[0], r[1]), pk2(r[2], r[3]), pk2(r[4], r[5]), pk2(r[6], r[7])};
          *(u32x4*)(o + tok * 4096 + c0 + 128 * bj) = w;
        }
        asm volatile("" ::: "memory");
      }
  }
  DI void operator()(const f32x4 (&acc)[2][2][4][2], const Unit& u, int wr, int wc, int fr, int fq) const {
    if (mode == 2) return;
    if (mode == 1) body<true>(acc, u, wr, wc, fr, fq);
    else body<false>(acc, u, wr, wc, fr, fq);
  }
};

struct EpiVT {
  static constexpr bool PERM = false, AFTER_DRAIN = true;
  const float* ssq; u16* vbuf;
  DI void operator()(const f32x4 (&)[2][2][4][2], const Unit&, int, int, int, int) const {}
  DI void fused(const f32x4 (&acc)[2][2][4][2], const Unit& u, int wr, int wc, int fr, int fq, PG8_LAS unsigned char* lds, int wid, int lane) const {
    PG8_LAS float* rsl = (PG8_LAS float*)(lds + 256 * VT_STRIDE + 64);
    {
      const int t = wid * 64 + lane;
      if (t < 256) rsl[t] = row_rscale(ssq, (size_t)u.pn * 256 + t);
    }
    __syncthreads();
#pragma unroll
    for (int ai = 0; ai < 2; ++ai)
#pragma unroll
      for (int m = 0; m < 4; ++m) {
        const int r = 128 * ai + 64 * wr + 16 * m + fr;
#pragma unroll
        for (int bj = 0; bj < 2; ++bj)
#pragma unroll
          for (int n = 0; n < 2; ++n) {
            const f32x4 v = acc[ai][bj][m][n] * *(const PG8_LAS f32x4*)(rsl + 128 * bj + 32 * wc + 16 * n + 4 * fq);
            u32x2 w = {pk2(v[0], v[1]), pk2(v[2], v[3])};
            *(PG8_LAS u32x2*)(lds + r * VT_STRIDE + (128 * bj + 32 * wc + 16 * n + 4 * fq) * 2) = w;
          }
      }
    __syncthreads();
    const int tid = wid * 64 + lane;
    const int bl = (u.pn * 256) >> 12, pos0 = (u.pn * 256) & 4095;
#pragma unroll 1
    for (int it = 0; it < 16; ++it) {
      const int uidx = it * 512 + tid;
      const int dvlo = uidx & 31, hh = (uidx >> 5) & 1, rb = (uidx >> 6) & 1, half = (uidx >> 7) & 15, h = uidx >> 11;
      const int vgrp = u.pm * 4 + h;
      const int dlg = (vgrp >= 2 && vgrp < 8) ? dlg_of((vgrp - 2) >> 1) : 0;
      const int cls = half >> (4 - dlg), hc = half & ((16 >> dlg) - 1);
      const int m0 = pos0 >> dlg, mh = m0 + 16 * hc;
      const int s = (mh >> 4) & 1, dblk = cls * (128 >> dlg) + (mh >> 5);
      const PG8_LAS unsigned char* row = lds + (h * 64 + rb * 32 + dvlo) * VT_STRIDE;
      unsigned short k8[8];
#pragma unroll
      for (int j = 0; j < 8; ++j) {
        const int tau = ((16 * hc + 4 * hh + (j & 3) + 8 * (j >> 2)) << dlg) + cls;
        k8[j] = *(const PG8_LAS unsigned short*)(row + tau * 2);
      }
      u32x4 w = {(unsigned)k8[0] | ((unsigned)k8[1] << 16), (unsigned)k8[2] | ((unsigned)k8[3] << 16),
                 (unsigned)k8[4] | ((unsigned)k8[5] << 16), (unsigned)k8[6] | ((unsigned)k8[7] << 16)};
      u16* dst = vbuf + (size_t)vgrp * TC * 64 + (size_t)bl * SEQ * 64 + ((size_t)((dblk * 2 + rb) * 2 + s) * 64 + hh * 32 + dvlo) * 8;
      *(u32x4*)dst = w;
    }
    __syncthreads();
  }
};

struct MergeOrder : pg8::StaticOrder {
  const u16* ybase; const u16* wbase;
  DI bool next(int i, Unit& u) const { if (i >= 5) return false; if (!pg8::StaticOrder::next(0, u)) return false; u.seg = i; return true; }
  DI const char* baseA(const pg8::Gemm&, const Unit& u, size_t tstep) const { return (const char*)(ybase + (size_t)u.seg * TC * 256) + (size_t)u.pm * tstep; }
  DI const char* baseB(const pg8::Gemm&, const Unit& u, size_t tstep) const { return (const char*)(wbase + (size_t)u.seg * DM * 256) + (size_t)u.pn * tstep; }
  DI bool zero_after(const Unit& u) const { return u.seg == 4; }
};
struct EpiMerge {
  static constexpr bool PERM = true, AFTER_DRAIN = false;
  const u16* gate; u16* mrg;
  DI void operator()(f32x4 (&acc)[2][2][4][2], const Unit& u, int wr, int wc, int fr, int fq) const {
    const int seg = u.seg;
    if (seg == 0) return;
    const bool last = (seg == 4);
    const int gnum = last ? 3 : seg - 1, gden = last ? 3 : seg;
    const u16* gnp = gate + ((size_t)u.pm * 256 + 64 * wr + fr) * 4096 + gnum * 1024 + u.pn * 256 + 32 * wc + 8 * fq;
    const u16* gdp = gate + ((size_t)u.pm * 256 + 64 * wr + fr) * 4096 + gden * 1024 + u.pn * 256 + 32 * wc + 8 * fq;
    u32x4 gn, gd, gnn, gdn;
    gn = *(const u32x4*)gnp; gd = *(const u32x4*)gdp;
#pragma unroll
    for (int i = 0; i < 16; ++i) {
      const int ai = i >> 3, m = (i >> 1) & 3, bj = i & 1;
      if (i < 15) {
        const int i2 = i + 1;
        const size_t ro = (size_t)(128 * (i2 >> 3) + 16 * ((i2 >> 1) & 3)) * 4096 + 128 * (i2 & 1);
        gnn = *(const u32x4*)(gnp + ro); gdn = *(const u32x4*)(gdp + ro);
      }
      asm volatile("" ::: "memory");
#pragma unroll
      for (int n = 0; n < 2; ++n) {
        f32x4 f;
        f[0] = bf_lo(gn[2 * n]); f[1] = bf_hi(gn[2 * n]); f[2] = bf_lo(gn[2 * n + 1]); f[3] = bf_hi(gn[2 * n + 1]);
        if (!last) {
          f[0] *= __builtin_amdgcn_rcpf(bf_lo(gd[2 * n])); f[1] *= __builtin_amdgcn_rcpf(bf_hi(gd[2 * n]));
          f[2] *= __builtin_amdgcn_rcpf(bf_lo(gd[2 * n + 1])); f[3] *= __builtin_amdgcn_rcpf(bf_hi(gd[2 * n + 1]));
        }
        acc[ai][bj][m][n] *= f;
      }
      if (last) {
        const size_t tok = (size_t)u.pm * 256 + 128 * ai + 64 * wr + 16 * m + fr;
        const int c = u.pn * 256 + 128 * bj + 32 * wc + 8 * fq;
        const f32x4 v0 = acc[ai][bj][m][0], v1 = acc[ai][bj][m][1];
        u32x4 w = {pk2(v0[0], v0[1]), pk2(v0[2], v0[3]), pk2(v1[0], v1[1]), pk2(v1[2], v1[3])};
        *(u32x4*)(mrg + tok * DM + c) = w;
      }
      gn = gnn; gd = gdn;
    }
  }
};

struct EpiResid {
  static constexpr bool PERM = true, AFTER_DRAIN = false;
  float* xout; u16* xb; float* ssq; int wf32;
  DI void operator()(const f32x4 (&acc)[2][2][4][2], const Unit& u, int wr, int wc, int fr, int fq) const {
    const size_t o0 = ((size_t)u.pm * 256 + 64 * wr + fr) * DM + u.pn * 256 + 32 * wc + 8 * fq;
    u32x4 xo, xn;
    xo = *(const u32x4*)(xb + o0);
    float ss = 0.f;
#pragma unroll
    for (int i = 0; i < 16; ++i) {
      const int ai = i >> 3, m = (i >> 1) & 3, bj = i & 1;
      if (i < 15) {
        const int i2 = i + 1;
        xn = *(const u32x4*)(xb + o0 + (size_t)(128 * (i2 >> 3) + 16 * ((i2 >> 1) & 3)) * DM + 128 * (i2 & 1));
      }
      asm volatile("" ::: "memory");
      const size_t tok = (size_t)u.pm * 256 + 128 * ai + 64 * wr + 16 * m + fr;
      const size_t o = tok * DM + u.pn * 256 + 128 * bj + 32 * wc + 8 * fq;
      f32x4 v0 = acc[ai][bj][m][0], v1 = acc[ai][bj][m][1];
      v0[0] += bf_lo(xo[0]); v0[1] += bf_hi(xo[0]); v0[2] += bf_lo(xo[1]); v0[3] += bf_hi(xo[1]);
      v1[0] += bf_lo(xo[2]); v1[1] += bf_hi(xo[2]); v1[2] += bf_lo(xo[3]); v1[3] += bf_hi(xo[3]);
      if (wf32) { *(f32x4*)(xout + o) = v0; *(f32x4*)(xout + o + 4) = v1; }
      if (!wf32) {
        u32x4 w = {pk2(v0[0], v0[1]), pk2(v0[2], v0[3]), pk2(v1[0], v1[1]), pk2(v1[2], v1[3])};
        *(u32x4*)(xb + o) = w;
      }
      ss += ((v0[0] * v0[0] + v0[1] * v0[1]) + (v0[2] * v0[2] + v0[3] * v0[3])) + ((v1[0] * v1[0] + v1[1] * v1[1]) + (v1[2] * v1[2] + v1[3] * v1[3]));
      if (bj == 1) {
        ss += __shfl_xor(ss, 16); ss += __shfl_xor(ss, 32);
        if (fq == 0 && !wf32) ssq[tok * 16 + u.pn * 4 + wc] = ss;
        ss = 0.f;
      }
      xo = xn;
    }
  }
};

template <class Epi>
DI void run_merge(PG8_LAS unsigned char* lds, const u16* ybase, const u16* wbase, const Epi& E) {
  int K = 256; asm volatile("" : "+s"(K));
  pg8::Gemm g; g.A = ybase; g.Bt = wbase; g.M = TC; g.N = DM; g.K = K;
  MergeOrder S; S.init(TC, DM, (int)gridDim.x, (int)blockIdx.x); S.ybase = ybase; S.wbase = wbase;
  pg8::gemm_phase<Epi, MergeOrder, false>(lds, g, S, E, nullptr);
}
template <class Epi>
DI void run_gemm(PG8_LAS unsigned char* lds, const u16* A, const u16* Bt, int M, int N, int K, const Epi& E, int probe = 0, int ilo = 0, int ihi = 1 << 30) {
  asm volatile("" : "+s"(K));
  pg8::Gemm g; g.A = A; g.Bt = Bt; g.M = M; g.N = N; g.K = K;
  pg8::StaticOrder S; S.init(M, N, (int)gridDim.x, (int)blockIdx.x); S.probe = probe; S.ilo = ilo; S.ihi = ihi;
  pg8::gemm_phase<Epi, pg8::StaticOrder, false>(lds, g, S, E, nullptr);
}

DI void cvt_load(const float* __restrict__ src, int N, int k0, int n0, const float* __restrict__ g, float* t, int ht) {
  const int c4 = (ht & 15) * 4;
#pragma unroll
  for (int i = 0; i < 4; ++i) {
    const int kk = (ht >> 4) + 16 * i;
    f32x4 v = *(const f32x4*)(src + (size_t)(k0 + kk) * N + n0 + c4);
    const float sc = g ? g[k0 + kk] : 1.0f;
    t[kk * 65 + c4 + 0] = v[0] * sc; t[kk * 65 + c4 + 1] = v[1] * sc; t[kk * 65 + c4 + 2] = v[2] * sc; t[kk * 65 + c4 + 3] = v[3] * sc;
  }
}
DI void cvt_store(u16* __restrict__ dst, int ldk, int kdst, int d0, int d1, const float* t, int ht) {
  const int kc = (ht & 7) * 8, nn = ht >> 3;
#pragma unroll
  for (int i = 0; i < 2; ++i) {
    const int tn = nn + 32 * i, row = (i == 0) ? d0 + nn : d1 + nn;
    u32x4 w;
    w[0] = pk2(t[(kc + 0) * 65 + tn], t[(kc + 1) * 65 + tn]);
    w[1] = pk2(t[(kc + 2) * 65 + tn], t[(kc + 3) * 65 + tn]);
    w[2] = pk2(t[(kc + 4) * 65 + tn], t[(kc + 5) * 65 + tn]);
    w[3] = pk2(t[(kc + 6) * 65 + tn], t[(kc + 7) * 65 + tn]);
    *(u32x4*)(dst + (size_t)row * ldk + kdst + kc) = w;
  }
}
struct CvtJob { const float* src; int N, k0, n0; const float* g; u16* dst; int ldk, d0, d1, kd; };
DI CvtJob cvt_job(const Params& p, int l, int ti) {
  CvtJob j; j.g = nullptr; j.kd = -1;
  const float* attn_g = p.in[1] + l * DM;
  if (ti < 608) { const int h = ti >> 4, kt = ti & 15; j.src = p.in[2] + (size_t)l * DM * INC; j.N = INC; j.k0 = kt * 64; j.n0 = qk_head_col(h); j.g = attn_g;
    j.dst = (u16*)(p.ws + OFF_WQKG) + (size_t)l * NQKG * DM; j.ldk = DM; j.d0 = (h >> 2) * 256 + (h & 3) * 32; j.d1 = j.d0 + 128; return j; }
  ti -= 608;
  if (ti < 1024) { const int c = ti >> 4, kt = ti & 15; j.src = p.in[2] + (size_t)l * DM * INC; j.N = INC; j.k0 = kt * 64; j.n0 = 3456 + 64 * c; j.g = attn_g;
    j.dst = (u16*)(p.ws + OFF_WQKG) + (size_t)l * NQKG * DM; j.ldk = DM; j.d0 = 2560 + 64 * c; j.d1 = j.d0 + 32; return j; }
  ti -= 1024;
  if (ti < 256) { const int vh = ti >> 4, kt = ti & 15; j.src = p.in[2] + (size_t)l * DM * INC; j.N = INC; j.k0 = kt * 64; j.n0 = v_head_col(vh); j.g = attn_g;
    j.dst = (u16*)(p.ws + OFF_WV) + (size_t)l * DM * DM; j.ldk = DM; j.d0 = vh * 64; j.d1 = j.d0 + 32; return j; }
  ti -= 256;
  if (ti < 128) { j.src = p.in[11] + (size_t)l * 512 * DM; j.N = DM; j.k0 = (ti >> 4) * 64; j.n0 = (ti & 15) * 64; j.dst = (u16*)(p.ws + OFF_WBR5) + ((size_t)l * 5 + (j.k0 >> 8)) * DM * 256; j.ldk = 256; j.kd = j.k0 & 255; j.d0 = j.n0; j.d1 = j.n0 + 32; return j; }
  ti -= 128;
  if (ti < 32) { j.src = p.in[12] + (size_t)l * 128 * DM; j.N = DM; j.k0 = (ti >> 4) * 64; j.n0 = (ti & 15) * 64; j.dst = (u16*)(p.ws + OFF_WBR5) + ((size_t)l * 5 + 2) * DM * 256; j.ldk = 256; j.kd = j.k0; j.d0 = j.n0; j.d1 = j.n0 + 32; return j; }
  ti -= 32;
  if (ti < 64) { j.src = p.in[13] + (size_t)l * 256 * DM; j.N = DM; j.k0 = (ti >> 4) * 64; j.n0 = (ti & 15) * 64; j.dst = (u16*)(p.ws + OFF_WBR5) + ((size_t)l * 5 + 3) * DM * 256; j.ldk = 256; j.kd = j.k0; j.d0 = j.n0; j.d1 = j.n0 + 32; return j; }
  ti -= 64;
  if (ti < 64) { j.src = p.in[14] + (size_t)l * 256 * DM; j.N = DM; j.k0 = (ti >> 4) * 64; j.n0 = (ti & 15) * 64; j.dst = (u16*)(p.ws + OFF_WBR5) + ((size_t)l * 5 + 4) * DM * 256; j.ldk = 256; j.kd = j.k0; j.d0 = j.n0; j.d1 = j.n0 + 32; return j; }
  ti -= 64;
  if (ti < 256) { j.src = p.in[15] + (size_t)l * DM * DM; j.N = DM; j.k0 = (ti >> 4) * 64; j.n0 = (ti & 15) * 64; j.dst = (u16*)(p.ws + OFF_WOUT) + (size_t)l * DM * DM; j.ldk = DM; j.d0 = j.n0; j.d1 = j.n0 + 32; return j; }
  ti -= 256;
  if (ti < 1024) { j.src = p.in[17] + (size_t)l * DM * DMLP; j.N = DMLP; j.k0 = (ti >> 6) * 64; j.n0 = (ti & 63) * 64; j.g = p.in[16] + l * DM;
    j.dst = (u16*)(p.ws + OFF_WUP) + (size_t)l * DMLP * DM; j.ldk = DM; j.d0 = j.n0; j.d1 = j.n0 + 32; return j; }
  ti -= 1024;
  j.src = p.in[18] + (size_t)l * DMLP * DM; j.N = DM; j.k0 = (ti >> 4) * 64; j.n0 = (ti & 15) * 64; j.dst = (u16*)(p.ws + OFF_WDN) + (size_t)l * DM * DMLP; j.ldk = DMLP; j.d0 = j.n0; j.d1 = j.n0 + 32; return j;
}

__device__ void phase_prep(const Params& p, int tid_, int bid_, int nblk_, unsigned char* smem) {
  const int half = tid_ >> 8, ht = tid_ & 255;
  float* t = (float*)smem + half * (64 * 65);
  const int per_layer = 4480, total = 2 * per_layer;
  for (int jp = bid_; jp * 2 < total; jp += nblk_) {
    const int j = jp * 2 + half;
    const bool on = j < total;
    CvtJob job;
    if (on) { job = cvt_job(p, j / per_layer, j % per_layer); cvt_load(job.src, job.N, job.k0, job.n0, job.g, t, ht); }
    __syncthreads();
    if (on) cvt_store(job.dst, job.ldk, (job.kd >= 0) ? job.kd : job.k0, job.d0, job.d1, t, ht);
    __syncthreads();
  }
  {
    const u32x4 z = {0u, 0u, 0u, 0u};
    for (int e = bid_ * NTHR + tid_; e < 2 * 128 * 128; e += nblk_ * NTHR) {
      const int l = e >> 14, r = (e >> 7) & 127, c = (e & 127) * 8;
      const int row = 9 * 256 + ((r < 64) ? 64 + r : 128 + r);
      *(u32x4*)((u16*)(p.ws + OFF_WQKG) + ((size_t)l * NQKG + row) * DM + c) = z;
    }
    for (int e = bid_ * NTHR + tid_; e < 2 * 1024 * 16; e += nblk_ * NTHR) {
      const int l = e >> 14, r = (e >> 4) & 1023, c = 128 + (e & 15) * 8;
      *(u32x4*)((u16*)(p.ws + OFF_WBR5) + (((size_t)l * 5 + 2) * DM + r) * 256 + c) = z;
    }
  }
  {
    const u32x4 z = {0u, 0u, 0u, 0u};
    u16* yb = (u16*)(p.ws + OFF_Y5) + (size_t)2 * TC * 256;
    for (int e = bid_ * NTHR + tid_; e < TC * 16; e += nblk_ * NTHR) *(u32x4*)(yb + (size_t)(e >> 4) * 256 + 128 + (e & 15) * 8) = z;
  }
  float* rope = (float*)(p.ws + OFF_ROPE);
  for (int e = bid_ * NTHR + tid_; e < SEQ * 48; e += nblk_ * NTHR) {
    const int pos = e / 48, i = e % 48;
    float inv;
    if (i < 32) inv = exp2f(-13.287712379549449f * (float)(2 * i) / 64.0f);
    else inv = exp2f(-13.287712379549449f * (float)(2 * (i - 32)) / 32.0f);
    const float angf = (float)pos * inv;
    const double ang = (double)angf;
    const double n = rint(ang * 0.15915494309189535);
    const float r = (float)(ang - n * 6.283185307179586);
    const float c = cosf(r), s = sinf(r);
    if (i < 32) { rope[pos * 96 + i] = c; rope[pos * 96 + 32 + i] = s; }
    else { rope[pos * 96 + 64 + (i - 32)] = c; rope[pos * 96 + 80 + (i - 32)] = s; }
  }
  if (bid_ == 0 && tid_ < 96) rope[SEQ * 96 + tid_] = (tid_ < 32 || (tid_ >= 64 && tid_ < 80)) ? 1.0f : 0.0f;
  u16* XB = (u16*)(p.ws + OFF_XB); float* SSQ = (float*)(p.ws + OFF_SSQ);
  const int lane = tid_ & 63;
  const int gw = bid_ * 8 + (tid_ >> 6), nw = nblk_ * 8;
  for (int row = gw; row < T; row += nw) {
    const float* xr = p.in[0] + (size_t)row * DM;
    float ss = 0.f;
#pragma unroll
    for (int i = 0; i < 4; ++i) {
      const f32x4 v = *(const f32x4*)(xr + i * 256 + lane * 4);
      ss += v[0] * v[0] + v[1] * v[1] + v[2] * v[2] + v[3] * v[3];
      u32x2 w = {pk2(v[0], v[1]), pk2(v[2], v[3])};
      *(u32x2*)(XB + (size_t)row * DM + i * 256 + lane * 4) = w;
    }
#pragma unroll
    for (int o = 32; o >= 1; o >>= 1) ss += __shfl_xor(ss, o);
    if (lane < 16) SSQ[(size_t)row * 16 + lane] = (lane == 0) ? ss : 0.f;
  }
}

DI void attn_softmax_pv(f32x16& S, float& m, float& l, f32x16& O0, f32x16& O1, const bf16x8 (&vf)[2][2]) {
  float mx = S[0];
#pragma unroll
  for (int i = 1; i < 16; ++i) mx = fmaxf(mx, S[i]);
  mx = fmaxf(mx, __shfl_xor(mx, 32));
  const float mn = fmaxf(m, mx);
  const float alpha = fexp2(m - mn);
  m = mn;
  float sum = 0.f;
#pragma unroll
  for (int i = 0; i < 16; ++i) { S[i] = fexp2(S[i] - mn); sum += S[i]; }
  l = l * alpha + sum;
  const u32x4 p0 = {pk2(S[0], S[1]), pk2(S[2], S[3]), pk2(S[4], S[5]), pk2(S[6], S[7])};
  const u32x4 p1 = {pk2(S[8], S[9]), pk2(S[10], S[11]), pk2(S[12], S[13]), pk2(S[14], S[15])};
#pragma unroll
  for (int i = 0; i < 16; ++i) { O0[i] *= alpha; O1[i] *= alpha; }
  O0 = MFMA32(vf[0][0], as_bf8(p0), O0);
  O0 = MFMA32(vf[0][1], as_bf8(p1), O0);
  O1 = MFMA32(vf[1][0], as_bf8(p0), O1);
  O1 = MFMA32(vf[1][1], as_bf8(p1), O1);
}
DI void attn_fixed_pv(f32x16& S, f32x16& L, f32x16& O0, f32x16& O1, const bf16x8 (&vf)[2][2], const bf16x8 ones) {
#pragma unroll
  for (int i = 0; i < 16; ++i) S[i] = fexp2(S[i]);
  const u32x4 p0 = {pk2(S[0], S[1]), pk2(S[2], S[3]), pk2(S[4], S[5]), pk2(S[6], S[7])};
  const u32x4 p1 = {pk2(S[8], S[9]), pk2(S[10], S[11]), pk2(S[12], S[13]), pk2(S[14], S[15])};
  O0 = MFMA32(vf[0][0], as_bf8(p0), O0);
  O0 = MFMA32(vf[0][1], as_bf8(p1), O0);
  O1 = MFMA32(vf[1][0], as_bf8(p0), O1);
  O1 = MFMA32(vf[1][1], as_bf8(p1), O1);
  float sum = 0.f;
#pragma unroll
  for (int i = 0; i < 16; ++i) sum += S[i];
  L[0] += sum;
}
DI void attn_plain_pv(f32x16& S, float& l, f32x16& O0, f32x16& O1, const bf16x8 (&vf)[2][2]) {
  float sum = 0.f;
#pragma unroll
  for (int i = 0; i < 16; ++i) { S[i] = fexp2(S[i]); sum += S[i]; }
  l += sum;
  const u32x4 p0 = {pk2(S[0], S[1]), pk2(S[2], S[3]), pk2(S[4], S[5]), pk2(S[6], S[7])};
  const u32x4 p1 = {pk2(S[8], S[9]), pk2(S[10], S[11]), pk2(S[12], S[13]), pk2(S[14], S[15])};
  O0 = MFMA32(vf[0][0], as_bf8(p0), O0); O1 = MFMA32(vf[1][0], as_bf8(p0), O1);
  O0 = MFMA32(vf[0][1], as_bf8(p1), O0); O1 = MFMA32(vf[1][1], as_bf8(p1), O1);
}
DI float gain_bound64(const float* g) {
  float a = 0.f, b = 0.f;
  for (int i = 0; i < 64; ++i) { a = fmaxf(a, fabsf(g[i])); b = fmaxf(b, fabsf(g[64 + i])); }
  return fminf(8.0f * a * b * 1.02f + 0.05f, 40.0f);
}
DI void load_vf(bf16x8 (&vf)[2][2], const u16* V, int kb, int lane) {
#pragma unroll
  for (int rb = 0; rb < 2; ++rb)
#pragma unroll
    for (int s = 0; s < 2; ++s) vf[rb][s] = *(const bf16x8*)(V + ((size_t)((kb * 2 + rb) * 2 + s) * 64 + lane) * 8);
}
DI void load_kf4(bf16x8 (&kf)[4], const u16* K, int kb, int lane) {
#pragma unroll
  for (int s = 0; s < 4; ++s) kf[s] = *(const bf16x8*)(K + ((size_t)(kb * 4 + s) * 64 + lane) * 8);
}
DI void load_kf2(bf16x8 (&kf)[2], const u16* K, int kb, int lane) {
#pragma unroll
  for (int s = 0; s < 2; ++s) kf[s] = *(const bf16x8*)(K + ((size_t)(kb * 2 + s) * 64 + lane) * 8);
}
DI void zero16(f32x16& a) {
#pragma unroll
  for (int i = 0; i < 16; ++i) a[i] = 0.f;
}
DI void store_o(u16* yrow, const f32x16& O0, const f32x16& O1, float sc, int h) {
#pragma unroll
  for (int g4 = 0; g4 < 4; ++g4) {
    u32x2 w0 = {pk2(O0[4 * g4] * sc, O0[4 * g4 + 1] * sc), pk2(O0[4 * g4 + 2] * sc, O0[4 * g4 + 3] * sc)};
    *(u32x2*)(yrow + 8 * g4 + 4 * h) = w0;
    u32x2 w1 = {pk2(O1[4 * g4] * sc, O1[4 * g4 + 1] * sc), pk2(O1[4 * g4 + 2] * sc, O1[4 * g4 + 3] * sc)};
    *(u32x2*)(yrow + 32 + 8 * g4 + 4 * h) = w1;
  }
}

__device__ void phase_attn(const Params& p, int tid_, int bid_, int nblk_, int layer, unsigned char* smem) {
  const u16* QK = (const u16*)(p.ws + OFF_QK);
  const u16* VB = (const u16*)(p.ws + OFF_V);
  u16* Y5 = (u16*)(p.ws + OFF_Y5);
  u16* BO = (u16*)(p.ws + OFF_BO);
  float* LSE = (float*)(p.ws + OFF_LSE);
  const int lane = tid_ & 63, wave = tid_ >> 6;
  const int fr = lane & 31, fh = lane >> 5;
  const int nloc = nblk_ >> 3;
  if ((int)(bid_ >> 3) >= nloc) return;
  const int vw = ((bid_ & 7) * nloc + (bid_ >> 3)) * 8 + wave, NW = nloc * 64;
  const bool hiwg = (bid_ * 2 >= nblk_);
  const int hb_ = bid_ - (nblk_ >> 1), nloch = nblk_ >> 4;
  const int vwh = ((hb_ & 7) * nloch + (hb_ >> 3)) * 8 + wave, NWH = nloch * 64;
  PG8_LAS float* rpbl = (PG8_LAS float*)smem;
  if (hiwg) {
    for (int i = tid_; i < 4 * 465; i += NTHR) rpbl[i] = p.in[10][(size_t)layer * 4 * 465 + i];
    __syncthreads();
  }

  const size_t GS = (size_t)TC * 64;
  const size_t BS = (size_t)SEQ * 64;

  {
    const float* lp = p.in[7] + layer * 128;
    float d01 = 0.f, d23 = 0.f;
    for (int i = 0; i < 32; ++i) { d01 += lp[i] * lp[32 + i]; d23 += lp[64 + i] * lp[96 + i]; }
    const float lambda_init = (layer == 0) ? 0.2f : 0.35550907f;
    const float lam = __expf(d01) - __expf(d23) + lambda_init;
    const float* subg = p.in[8] + layer * 64;
    const float sc = 0.17677669529663687f * LOG2E;
    float gqm = 0.f, gkm = 0.f;
    for (int i = 0; i < 32; ++i) { gqm = fmaxf(gqm, fabsf(p.in[6][layer * 64 + i])); gkm = fmaxf(gkm, fabsf(p.in[6][layer * 64 + 32 + i])); }
    const unsigned onev = ((fr & 27) == 0) ? 0x3f803f80u : 0u;
    const u32x4 ones4 = {onev, onev, onev, onev};
    const bf16x8 ones = as_bf8(ones4);
    const float cbound = 5.6568542f * gqm * gkm * 1.02f + 0.05f;
    for (int it = vw; it < BC * 4 * 128; it += NW) {
      const int bl = it >> 9, head = (it >> 7) & 3, qblk = it & 127;
      const u16* Q0 = QK + (22 + head) * GS + bl * BS; const u16* Q1 = Q0 + SEQ * 32;
      const u16* K0 = QK + (26 + head) * GS + bl * BS; const u16* K1 = K0 + SEQ * 32;
      const u16* V = VB + (8 + head) * GS + bl * BS;
      bf16x8 q0[2], q1[2];
      load_kf2(q0, Q0, qblk, lane); load_kf2(q1, Q1, qblk, lane);
      f32x16 L0, L1; zero16(L0); zero16(L1);
      f32x16 O00, O01, O10, O11; zero16(O00); zero16(O01); zero16(O10); zero16(O11);
      bf16x8 k0[2], k1[2], vf[2][2];
      {
        const float mb2 = fminf(cbound, 40.0f) * LOG2E;
        f32x16 sinit;
#pragma unroll
        for (int i = 0; i < 16; ++i) sinit[i] = -mb2;
        load_kf2(k0, K0, 0, lane); load_kf2(k1, K1, 0, lane); load_vf(vf, V, 0, lane);
        f32x16 S0 = sinit, S1 = sinit;
        S0 = MFMA32(k0[0], q0[0], S0); S0 = MFMA32(k0[1], q0[1], S0);
        S1 = MFMA32(k1[0], q1[0], S1); S1 = MFMA32(k1[1], q1[1], S1);
        load_kf2(k0, K0, 1, lane); load_kf2(k1, K1, 1, lane);
        for (int kb = 0; kb < 128; ++kb) {
          bf16x8 nk0[2], nk1[2], nvf[2][2];
          const int k2 = (kb + 2 < 128) ? kb + 2 : 127, v1 = (kb + 1 < 128) ? kb + 1 : 127;
          load_kf2(nk0, K0, k2, lane); load_kf2(nk1, K1, k2, lane); load_vf(nvf, V, v1, lane);
          f32x16 S0n = sinit, S1n = sinit;
#pragma unroll
          for (int i = 0; i < 16; ++i) S0[i] = fexp2(S0[i]);
          S0n = MFMA32(k0[0], q0[0], S0n); S0n = MFMA32(k0[1], q0[1], S0n);
          {
            const u32x4 p0 = {pk2(S0[0], S0[1]), pk2(S0[2], S0[3]), pk2(S0[4], S0[5]), pk2(S0[6], S0[7])};
            const u32x4 p1 = {pk2(S0[8], S0[9]), pk2(S0[10], S0[11]), pk2(S0[12], S0[13]), pk2(S0[14], S0[15])};
            O00 = MFMA32(vf[0][0], as_bf8(p0), O00); O01 = MFMA32(vf[1][0], as_bf8(p0), O01);
            O00 = MFMA32(vf[0][1], as_bf8(p1), O00); O01 = MFMA32(vf[1][1], as_bf8(p1), O01);
            float sum = 0.f;
#pragma unroll
            for (int i = 0; i < 16; ++i) sum += S0[i];
            L0[0] += sum;
          }
#pragma unroll
          for (int i = 0; i < 16; ++i) S1[i] = fexp2(S1[i]);
          S1n = MFMA32(k1[0], q1[0], S1n); S1n = MFMA32(k1[1], q1[1], S1n);
          {
            const u32x4 p0 = {pk2(S1[0], S1[1]), pk2(S1[2], S1[3]), pk2(S1[4], S1[5]), pk2(S1[6], S1[7])};
            const u32x4 p1 = {pk2(S1[8], S1[9]), pk2(S1[10], S1[11]), pk2(S1[12], S1[13]), pk2(S1[14], S1[15])};
            O10 = MFMA32(vf[0][0], as_bf8(p0), O10); O11 = MFMA32(vf[1][0], as_bf8(p0), O11);
            O10 = MFMA32(vf[0][1], as_bf8(p1), O10); O11 = MFMA32(vf[1][1], as_bf8(p1), O11);
            float sum = 0.f;
#pragma unroll
            for (int i = 0; i < 16; ++i) sum += S1[i];
            L1[0] += sum;
          }
          S0 = S0n; S1 = S1n;
#pragma unroll
          for (int s = 0; s < 2; ++s) { k0[s] = nk0[s]; k1[s] = nk1[s]; vf[0][s] = nvf[0][s]; vf[1][s] = nvf[1][s]; }
        }
      }
      const float i0 = 1.0f / (L0[0] + __shfl_xor(L0[0], 32));
      const float i1 = lam / (L1[0] + __shfl_xor(L1[0], 32));
      float ss = 0.f;
#pragma unroll
      for (int i = 0; i < 16; ++i) {
        O00[i] = O00[i] * i0 - O10[i] * i1; O01[i] = O01[i] * i0 - O11[i] * i1;
        ss += O00[i] * O00[i] + O01[i] * O01[i];
      }
      ss += __shfl_xor(ss, 32);
      const float rn = rsqrtf(ss * (1.0f / 64.0f) + 1e-6f) * (1.0f - lambda_init);
#pragma unroll
      for (int g4 = 0; g4 < 4; ++g4) {
        const f32x4 ga = *(const f32x4*)(subg + 8 * g4 + 4 * fh);
        const f32x4 gb = *(const f32x4*)(subg + 32 + 8 * g4 + 4 * fh);
#pragma unroll
        for (int e = 0; e < 4; ++e) { O00[4 * g4 + e] *= ga[e]; O01[4 * g4 + e] *= gb[e]; }
      }
      const size_t tok = (size_t)bl * SEQ + qblk * 32 + fr;
      store_o(Y5 + (size_t)3 * TC * 256 + tok * 256 + head * 64, O00, O01, rn, fh);
    }
  }
  {
    const float mbA = gain_bound64(p.in[3] + layer * 128) * LOG2E;
    f32x16 sinit;
#pragma unroll
    for (int i = 0; i < 16; ++i) sinit[i] = -mbA;
    for (int it = vw; it < BC * 8 * 128; it += NW) {
      const int bl = it >> 10, hq = (it >> 7) & 7, qblk = it & 127;
      const int kvh = hq >> 2;
      const u16* Q = QK + (size_t)hq * GS + bl * BS;
      const u16* K = QK + (size_t)(8 + kvh) * GS + bl * BS;
      const u16* V = VB + (size_t)kvh * GS + bl * BS;
      bf16x8 qf[4]; load_kf4(qf, Q, qblk, lane);
      float l = (fh == 0) ? fexp2(p.in[4][layer * 8 + hq] * LOG2E - mbA) : 0.0f;
      f32x16 O0, O1; zero16(O0); zero16(O1);
      const int kb_lo = (qblk - 4 < 0) ? 0 : qblk - 4, kb_hi = (qblk + 4 > 127) ? 127 : qblk + 4;
      const int qpos = qblk * 32 + fr;
      bf16x8 kf[4], vf[2][2];
      load_kf4(kf, K, kb_lo, lane); load_vf(vf, V, kb_lo, lane);
      for (int kb = kb_lo; kb <= kb_hi; ++kb) {
        bf16x8 nkf[4], nvf[2][2];
        const int kn = (kb < kb_hi) ? kb + 1 : kb;
        load_kf4(nkf, K, kn, lane); load_vf(nvf, V, kn, lane);
        f32x16 S = sinit;
#pragma unroll
        for (int s = 0; s < 4; ++s) S = MFMA32(kf[s], qf[s], S);
        if (kb == qblk - 4 || kb == qblk + 4) {
#pragma unroll
          for (int i = 0; i < 16; ++i) {
            const int dlt = kb * 32 + crow(i, fh) - qpos;
            S[i] = (dlt <= 128 && dlt >= -128) ? S[i] : (-__builtin_inff());
          }
        }
        attn_plain_pv(S, l, O0, O1, vf);
#pragma unroll
        for (int s = 0; s < 4; ++s) kf[s] = nkf[s];
#pragma unroll
        for (int s = 0; s < 2; ++s) { vf[0][s] = nvf[0][s]; vf[1][s] = nvf[1][s]; }
      }
      const float inv = 1.0f / (l + __shfl_xor(l, 32));
      const size_t tok = (size_t)bl * SEQ + qpos;
      store_o(Y5 + (size_t)(hq >> 2) * TC * 256 + tok * 256 + (hq & 3) * 64, O0, O1, inv, fh);
    }
  }
  {
    const float gbD = gain_bound64(p.in[9] + layer * 128);
    if (hiwg)
    for (int it = vwh; it < BC * 4 * 128; it += NWH) {
      const int bl = it >> 9, head = (it >> 7) & 3, qblk = it & 127;
      const u16* Q = QK + (size_t)(30 + head) * GS + bl * BS;
      const u16* K = QK + (size_t)(34 + head) * GS + bl * BS;
      const u16* V = VB + (size_t)(12 + head) * GS + bl * BS;
      const PG8_LAS float* rpb = rpbl + head * 465;
      bf16x8 qf[4]; load_kf4(qf, Q, qblk, lane);
      float bmax = 0.f;
      for (int i = lane; i < 15 * 31; i += 64) bmax = fmaxf(bmax, fabsf(rpb[i]));
#pragma unroll
      for (int o = 32; o >= 1; o >>= 1) bmax = fmaxf(bmax, __shfl_xor(bmax, o));
      const float mbD = fminf(gbD + bmax, 60.0f) * LOG2E;
      f32x16 sinit;
#pragma unroll
      for (int i = 0; i < 16; ++i) sinit[i] = -mbD;
      float l = 0.f;
      f32x16 O0, O1; zero16(O0); zero16(O1);
      const int qrow = qblk >> 1, qc = (qblk & 1) * 32 + fr;
      int r0 = qrow - 4; r0 = r0 < 0 ? 0 : (r0 > 56 ? 56 : r0);
      int c0 = qc - 8; c0 = c0 < 0 ? 0 : (c0 > 48 ? 48 : c0);
      bf16x8 kf[4], vf[2][2];
      load_kf4(kf, K, r0 * 2, lane); load_vf(vf, V, r0 * 2, lane);
      for (int kk = 0; kk < 16; ++kk) {
        const int krow_ = r0 + (kk >> 1), hb = kk & 1;
        bf16x8 nkf[4], nvf[2][2];
        const int kn = r0 * 2 + ((kk < 15) ? kk + 1 : kk);
        load_kf4(nkf, K, kn, lane); load_vf(nvf, V, kn, lane);
        f32x16 S = sinit;
#pragma unroll
        for (int s = 0; s < 4; ++s) S = MFMA32(kf[s], qf[s], S);
        const PG8_LAS float* brow = rpb + (krow_ - qrow + 7) * 31;
#pragma unroll
        for (int i = 0; i < 16; ++i) {
          const int kc = hb * 32 + crow(i, fh);
          int dc = kc - qc; dc = dc < -15 ? -15 : (dc > 15 ? 15 : dc);
          const float bias = brow[dc + 15];
          S[i] = (kc >= c0 && kc < c0 + 16) ? __builtin_fmaf(bias, LOG2E, S[i]) : (-__builtin_inff());
        }
        attn_plain_pv(S, l, O0, O1, vf);
#pragma unroll
        for (int s = 0; s < 4; ++s) kf[s] = nkf[s];
#pragma unroll
        for (int s = 0; s < 2; ++s) { vf[0][s] = nvf[0][s]; vf[1][s] = nvf[1][s]; }
      }
      const float inv = 1.0f / (l + __shfl_xor(l, 32));
      const size_t tok = (size_t)bl * SEQ + qblk * 32 + fr;
      store_o(Y5 + (size_t)4 * TC * 256 + tok * 256 + head * 64, O0, O1, inv, fh);
    }
  }
  {
    const float mbB = gain_bound64(p.in[5] + layer * 128) * LOG2E;
    f32x16 sinit;
#pragma unroll
    for (int i = 0; i < 16; ++i) sinit[i] = -mbB;
    if (hiwg)
    for (int it = vwh; it < BC * 6 * 128; it += NWH) {
      const int bl = it / 768, rem = it % 768, head = rem >> 7, qblk = rem & 127;
      const int dil = dil_of(head >> 1), L = SEQ / dil, LB = L >> 5;
      const u16* Q = QK + (size_t)(10 + head) * GS + bl * BS;
      const u16* K = QK + (size_t)(16 + head) * GS + bl * BS;
      const u16* V = VB + (size_t)(2 + head) * GS + bl * BS;
      bf16x8 qf[4]; load_kf4(qf, Q, qblk, lane);
      float l = 0.f;
      f32x16 O0, O1; zero16(O0); zero16(O1);
      const int rsub = qblk / LB;
      const int lo = rsub * LB, hi = lo + LB - 1;
      const int kb_lo = (qblk - 2 < lo) ? lo : qblk - 2, kb_hi = (qblk + 2 > hi) ? hi : qblk + 2;
      const int qd = qblk * 32 + fr;
      bf16x8 kf[4], vf[2][2];
      load_kf4(kf, K, kb_lo, lane); load_vf(vf, V, kb_lo, lane);
      for (int kb = kb_lo; kb <= kb_hi; ++kb) {
        bf16x8 nkf[4], nvf[2][2];
        const int kn = (kb < kb_hi) ? kb + 1 : kb;
        load_kf4(nkf, K, kn, lane); load_vf(nvf, V, kn, lane);
        f32x16 S = sinit;
#pragma unroll
        for (int s = 0; s < 4; ++s) S = MFMA32(kf[s], qf[s], S);
        if (kb == qblk - 2 || kb == qblk + 2) {
#pragma unroll
          for (int i = 0; i < 16; ++i) {
            const int dlt = kb * 32 + crow(i, fh) - qd;
            S[i] = (dlt <= 64 && dlt >= -64) ? S[i] : (-__builtin_inff());
          }
        }
        attn_plain_pv(S, l, O0, O1, vf);
#pragma unroll
        for (int s = 0; s < 4; ++s) kf[s] = nkf[s];
#pragma unroll
        for (int s = 0; s < 2; ++s) { vf[0][s] = nvf[0][s]; vf[1][s] = nvf[1][s]; }
      }
      const float lt = l + __shfl_xor(l, 32);
      const float inv = 1.0f / lt;
      const int msub = qd - rsub * L;
      const int pos = msub * dil + rsub;
      const size_t tok = (size_t)bl * SEQ + pos;
      store_o(BO + tok * 384 + head * 64, O0, O1, inv, fh);
      if (fh == 0) LSE[tok * 8 + head] = __log2f(lt) + mbB;
    }
  }
}


__device__ void phase_bcombine(const Params& p, int tid_, int tok0) {
  const u16* BO = (const u16*)(p.ws + OFF_BO);
  const float* LSE = (const float*)(p.ws + OFF_LSE);
  u16* YB = (u16*)(p.ws + OFF_Y5) + (size_t)2 * TC * 256;
  for (int e = tid_; e < 256 * 16; e += NTHR) {
    const int tok = tok0 + (e >> 4), j = (e >> 3) & 1, c8 = (e & 7) * 8;
    const float a0 = LSE[(size_t)tok * 8 + j], a1 = LSE[(size_t)tok * 8 + 2 + j], a2 = LSE[(size_t)tok * 8 + 4 + j];
    const float mx = fmaxf(a0, fmaxf(a1, a2));
    float w0 = fexp2(a0 - mx), w1 = fexp2(a1 - mx), w2 = fexp2(a2 - mx);
    const float inv = 1.0f / (w0 + w1 + w2);
    w0 *= inv; w1 *= inv; w2 *= inv;
    const u32x4 x0 = *(const u32x4*)(BO + (size_t)tok * 384 + (0 + j) * 64 + c8);
    const u32x4 x1 = *(const u32x4*)(BO + (size_t)tok * 384 + (2 + j) * 64 + c8);
    const u32x4 x2 = *(const u32x4*)(BO + (size_t)tok * 384 + (4 + j) * 64 + c8);
    u32x4 o;
#pragma unroll
    for (int q = 0; q < 4; ++q) {
      const float lo = w0 * bf_lo(x0[q]) + w1 * bf_lo(x1[q]) + w2 * bf_lo(x2[q]);
      const float hi = w0 * bf_hi(x0[q]) + w1 * bf_hi(x1[q]) + w2 * bf_hi(x2[q]);
      o[q] = pk2(lo, hi);
    }
    *(u32x4*)(YB + (size_t)tok * 256 + j * 64 + c8) = o;
  }
}

#define XB_TMO      128
#define XB_XCNT(j)  (256  + 64 * (j))
#define XB_XSUB(j)  (1280 + 64 * (j))
#define XB_XGEN(j)  (2304 + 64 * (j))
#define XB_TOP      3328
#define XB_TOPGEN   3392
#define XCD_BAR_WORDS 3456
#define XB_SPIN_CAP (1u << 22)
#define LAS __attribute__((address_space(3)))
DI unsigned xb_ld(unsigned* p)              { return __hip_atomic_load(p, __ATOMIC_RELAXED, __HIP_MEMORY_SCOPE_AGENT); }
DI unsigned xb_add(unsigned* p, unsigned v) { return __hip_atomic_fetch_add(p, v, __ATOMIC_RELAXED, __HIP_MEMORY_SCOPE_AGENT); }
DI unsigned xb_xcc_id() { return (unsigned)__builtin_amdgcn_s_getreg((3 << 11) | 20) & 0xFu; }
#define XB_SPIN(cond, bar) do { unsigned _sp = 0; while (cond) { __builtin_amdgcn_s_sleep(1); \
    if ((++_sp & 255u) == 0u) { if (xb_ld(&(bar)[XB_TMO])) break; if (_sp > XB_SPIN_CAP) { atomicAdd(&(bar)[XB_TMO], 1u); break; } } } } while (0)
struct XcdBarrier { unsigned* bar; unsigned x; volatile LAS unsigned* st; };
DI XcdBarrier xcd_barrier_post(unsigned* bar, volatile LAS unsigned* st) {
  XcdBarrier b; b.bar = bar; b.x = xb_xcc_id(); b.st = st;
  if (threadIdx.x == 0) (void)xb_add(&bar[XB_XCNT(b.x)], 1u);
  return b;
}
DI void xcd_barrier_complete(unsigned* bar, unsigned x, unsigned& nloc, unsigned& nx) {
  const unsigned G = gridDim.x * gridDim.y * gridDim.z;
  unsigned sum, cnt, mine, sp = 0u;
  for (;;) {
    sum = 0u; cnt = 0u; mine = 0u;
#pragma unroll
    for (unsigned j = 0; j < 16; ++j) { const unsigned c = xb_ld(&bar[XB_XCNT(j)]); sum += c; cnt += (c > 0u) ? 1u : 0u; mine = (j == x) ? c : mine; }
    if (sum == G) break;
    __builtin_amdgcn_s_sleep(1);
    if ((++sp & 255u) == 0u) { if (xb_ld(&bar[XB_TMO])) break; if (sp > XB_SPIN_CAP) { atomicAdd(&bar[XB_TMO], 1u); break; } }
  }
  nloc = mine > 0u ? mine : 1u; nx = cnt > 0u ? cnt : 1u;
}
DI void xcd_barrier(const XcdBarrier& b) {
  asm volatile("s_waitcnt vmcnt(0)" ::: "memory");
  __syncthreads();
  if (threadIdx.x == 0) {
    unsigned* bar = b.bar;
    __builtin_amdgcn_s_waitcnt(0);
    unsigned nloc = b.st[0], nx = b.st[1];
    if (nloc == 0u) { xcd_barrier_complete(bar, b.x, nloc, nx); b.st[0] = nloc; b.st[1] = nx; }
    const unsigned old = xb_add(&bar[XB_XSUB(b.x)], 1u);
    const unsigned gen = old / nloc;
    if (old + 1u == (gen + 1u) * nloc) {
      __builtin_amdgcn_fence(__ATOMIC_RELEASE, "agent");
      asm volatile("s_waitcnt vmcnt(0)" ::: "memory");
      const unsigned og = xb_add(&bar[XB_TOP], 1u);
      const unsigned tg = og / nx;
      if (og + 1u == (tg + 1u) * nx) xb_add(&bar[XB_TOPGEN], 1u);
      else XB_SPIN(xb_ld(&bar[XB_TOPGEN]) == tg, bar);
      __builtin_amdgcn_fence(__ATOMIC_ACQUIRE, "agent");
      xb_add(&bar[XB_XGEN(b.x)], 1u);
      asm volatile("s_waitcnt vmcnt(0)" ::: "memory");
    } else {
      XB_SPIN(xb_ld(&bar[XB_XGEN(b.x)]) == gen, bar);
      __builtin_amdgcn_fence(__ATOMIC_ACQUIRE, "agent");
      asm volatile("s_waitcnt vmcnt(0)" ::: "memory");
    }
  }
  __syncthreads();
}

__global__ void __launch_bounds__(NTHR, 2) mk_forward(Params p) {
  extern __shared__ __attribute__((aligned(16))) unsigned char smem[];
  cg::grid_group grid = cg::this_grid();
  volatile LAS unsigned* xbw = (volatile LAS unsigned*)(smem + LDS_XBW);
  if (threadIdx.x < 4) xbw[threadIdx.x] = 0u;
  __syncthreads();
  XcdBarrier xb;
  if (FUSED) xb = xcd_barrier_post((unsigned*)(p.ws + OFF_BAR), xbw);
#if PROBE_CLOCK
  const unsigned long long pc_t0 = clock64(), pc_r0 = wall_clock64();
#endif
  PG8_LAS unsigned char* lds = (PG8_LAS unsigned char*)smem;
  for (int ph = p.ph_lo; ph < p.ph_hi; ++ph) {
#if DUPMASK
   for (int rep = 0; rep < ((ph > 0 && ((DUPMASK >> ((ph - 1) % 7)) & 1)) ? 2 : 1); ++rep)
#endif
   {
    int tid_ = threadIdx.x, bid_ = blockIdx.x, nblk_ = gridDim.x;
    asm volatile("" : "+v"(tid_));
    asm volatile("" : "+s"(bid_));
    asm volatile("" : "+s"(nblk_));
    Params pp = p;
    asm volatile("" : "+s"(pp.ws));
    asm volatile("" : "+s"(pp.out));
    unsigned char* ws = pp.ws;
    if (ph == 0) {
      if (PHMASK & 128) phase_prep(pp, tid_, bid_, nblk_, smem);
    } else {
      const int q = ph - 1, chunk = q / (2 * PPL), layer = (q % (2 * PPL)) / PPL, kk = q % PPL, k = (kk == 6) ? DUPK : (kk < 2 ? kk : kk + 1);
      const u16* XBc = (const u16*)(ws + OFF_XB) + (size_t)chunk * TC * DM;
      float* SSQc = (float*)(ws + OFF_SSQ) + (size_t)chunk * TC * 16;
      float* xc = pp.out + (size_t)chunk * TC * DM;
      const bool hiwg = (bid_ * 2 >= nblk_);
      int gu_lo = 0, gu_hi = 0, gu_mode = 0;
      if (k == 0 && (PHMASK & 1)) {
        {
          EpiQKG e; e.ssq = SSQc; e.qk = (u16*)(ws + OFF_QK); e.rope = (const float*)(ws + OFF_ROPE);
          e.gA = pp.in[3] + layer * 128; e.gB = pp.in[5] + layer * 128; e.gC = pp.in[6] + layer * 64; e.gD = pp.in[9] + layer * 128;
          run_gemm(lds, XBc, (const u16*)(ws + OFF_WQKG) + (size_t)layer * NQKG * DM, TC, 2560, DM, e);
        }
        {
          EpiVT ev; ev.ssq = SSQc; ev.vbuf = (u16*)(ws + OFF_V);
          run_gemm(lds, (const u16*)(ws + OFF_WV) + (size_t)layer * DM * DM, XBc, DM, TC, DM, ev);
        }
        if (hiwg) { gu_lo = 3; gu_hi = 4; }
      } else if (k == 1 && (PHMASK & 2)) {
        phase_attn(pp, tid_, bid_, nblk_, layer, smem);
        __syncthreads();
        gu_lo = 0; gu_hi = hiwg ? 3 : 4;
      } else if (k == 5 && (PHMASK & 32)) {
        gu_lo = 0; gu_hi = 4; gu_mode = 1;
      }
      if (gu_hi > gu_lo) {
        const bool up = (gu_mode == 1);
        EpiGateUp e; e.ssq = SSQc; e.o = (u16*)(ws + OFF_GATE); e.mode = up ? ((PROBE_NOEPI && kk == 6) ? 2 : 1) : 0;
        const u16* W = up ? (const u16*)(ws + OFF_WUP) + (size_t)layer * DMLP * DM : (const u16*)(ws + OFF_WQKG) + ((size_t)layer * NQKG + 2560) * DM;
        run_gemm(lds, XBc, W, TC, 4096, DM, e, (PROBE_NOEPI && kk == 6) ? 1 : 0, gu_lo, gu_hi);
      }
      if (k == 0 || k == 1 || k == 5) {
      } else if (k == 3 && (PHMASK & 8)) {
        {
          Unit u0; pg8::StaticOrder S0; S0.init(TC, DM, nblk_, bid_); S0.next(0, u0);
          phase_bcombine(pp, tid_, u0.pm * 256);
          asm volatile("s_waitcnt vmcnt(0)" ::: "memory");
          __syncthreads();
        }
        EpiMerge e; e.gate = (const u16*)(ws + OFF_GATE); e.mrg = (u16*)(ws + OFF_MRG);
        run_merge(lds, (const u16*)(ws + OFF_Y5), (const u16*)(ws + OFF_WBR5) + (size_t)layer * 5 * DM * 256, e);
      } else if ((k == 4 && (PHMASK & 16)) || (k == 6 && (PHMASK & 64))) {
        const bool dn = (k == 6);
        EpiResid e; e.xout = xc; e.xb = (u16*)XBc; e.ssq = SSQc; e.wf32 = (dn && layer == 1) ? 1 : 0;
        const u16* A = dn ? (const u16*)(ws + OFF_GATE) : (const u16*)(ws + OFF_MRG);
        const u16* W = dn ? (const u16*)(ws + OFF_WDN) + (size_t)layer * DM * DMLP : (const u16*)(ws + OFF_WOUT) + (size_t)layer * DM * DM;
        run_gemm(lds, A, W, TC, DM, dn ? DMLP : DM, e);
      }
    }
   }
    if (ph + 1 < p.ph_hi) {
      if (p.ph_lo < 0) grid.sync();
      xcd_barrier(xb);
    }
  }
#if PROBE_CLOCK
  {
    xcd_barrier(xb);
    const unsigned long long pc_t1 = clock64(), pc_r1 = wall_clock64();
    const float ghz = (float)(pc_t1 - pc_t0) / ((float)(pc_r1 - pc_r0) * 10.0f);
    const int nrows = (int)(ghz * 0.25f * (float)T);
    for (int r = blockIdx.x; r < nrows; r += gridDim.x)
      for (int c = threadIdx.x; c < DM; c += NTHR) p.out[(size_t)r * DM + c] = 0.f;
  }
#endif
}

extern "C" void kernel_launch(void* const* d_in, const int* in_sizes, int n_in, void* d_out, int out_size, void* d_ws, size_t ws_size,
                              hipStream_t stream) {
  static int grid_blocks = 0;
  if (grid_blocks == 0) {
    if (n_in != 19 || out_size != T * DM || ws_size < WS_END) {
      fprintf(stderr, "kernel_launch: unexpected problem (n_in %d out %d ws %zu need %zu)\n", n_in, out_size, ws_size, (size_t)WS_END);
      grid_blocks = -1;
      return;
    }
    int dev = 0, cus = 0, per_cu = 0;
    (void)hipGetDevice(&dev);
    (void)hipDeviceGetAttribute(&cus, hipDeviceAttributeMultiprocessorCount, dev);
    if (hipFuncSetAttribute((const void*)mk_forward, hipFuncAttributeMaxDynamicSharedMemorySize, LDS_BYTES) != hipSuccess) {
      fprintf(stderr, "kernel_launch: hipFuncSetAttribute failed\n"); grid_blocks = -1; return;
    }
    (void)hipOccupancyMaxActiveBlocksPerMultiprocessor(&per_cu, mk_forward, NTHR, LDS_BYTES);
    if (per_cu < 1) fprintf(stderr, "kernel_launch: occupancy query says %d blocks per CU\n", per_cu);
    (void)hipGetLastError();
    grid_blocks = cus;
  }
  if (grid_blocks < 0) return;
  Params p{};
  for (int i = 0; i < 19; ++i) p.in[i] = (const float*)d_in[i];
  p.out = (float*)d_out;
  p.ws = (unsigned char*)d_ws;
#if FUSED
  (void)hipMemsetAsync((unsigned char*)d_ws + OFF_BAR, 0, XCD_BAR_WORDS * 4, stream);
  p.ph_lo = 0; p.ph_hi = NPHASE;
  void* args[] = {&p};
  hipError_t e = hipLaunchCooperativeKernel((const void*)mk_forward, dim3(grid_blocks), dim3(NTHR), args, LDS_BYTES, stream);
  if (e != hipSuccess) fprintf(stderr, "cooperative launch failed: %s (grid %d)\n", hipGetErrorString(e), grid_blocks);
#else
  for (int ph = 0; ph < NPHASE; ++ph) {
    p.ph_lo = ph; p.ph_hi = ph + 1;
    hipLaunchKernelGGL(mk_forward, dim3(grid_blocks), dim3(NTHR), LDS_BYTES, stream, p);
  }
#endif
}
```

```cpp
#include <hip/hip_runtime.h>
#include <hip/hip_cooperative_groups.h>
#include <cstdio>
namespace cg = cooperative_groups;

#ifndef PHMASK
#define PHMASK 255
#endif
#ifndef DUPMASK
#define DUPMASK 0
#endif
#ifndef DUPK
#define DUPK -1
#endif
#ifndef PROBE_CLOCK
#define PROBE_CLOCK 0
#endif
#ifndef PROBE_NOEPI
#define PROBE_NOEPI 0
#endif
#ifndef FUSED
#define FUSED 1
#endif

namespace pg8 {
#define PG8_LAS __attribute__((address_space(3)))
typedef unsigned short bf16_t;
typedef short bf16x8 __attribute__((ext_vector_type(8)));
typedef float f32x4 __attribute__((ext_vector_type(4)));
typedef unsigned u32x4 __attribute__((ext_vector_type(4)));
constexpr int BM = 256, BK = 64, HALF = 128, HTB = HALF * BK * 2  , STAGE_BYTES = 8 * HTB, NXCD = 8, WGM = 8;

__host__ __device__ __forceinline__ int lds_byte(int r, int c) { const int st = (r >> 4) * 2 + (c >> 5), rr = r & 15, cc = c & 31, ob = rr * 64 + cc * 2; return st * 1024 + (ob ^ (((ob >> 9) & 1) << 5)); }
__host__ __device__ __forceinline__ void stage_rc(int b, int& R, int& C) { const int st = b / 1024, sb = b % 1024, swz = sb ^ (((sb >> 9) & 1) << 5); R = (st >> 1) * 16 + swz / 64; C = (st & 1) * 32 + (swz % 64) / 2; }
__host__ __device__ __forceinline__ int perm32(int rho) { const int n = rho >> 4, i = rho & 15; return 8 * (i >> 2) + 4 * n + (i & 3); }

struct Unit { int pm, pn, seg; };
struct Gemm { const bf16_t* A; const bf16_t* Bt; int M, N, K; };

struct StaticOrder {
    int nM, nN, nwg, G, c, probe = 0, ilo = 0, ihi = 1 << 30;
    __host__ __device__ void init(int M, int N, int G_, int c_) { nM = M / BM; nN = N / BM; nwg = nM * nN; G = G_; c = c_; }
    __host__ __device__ bool next(int i, Unit& u) const {
        i += ilo; if (i >= ihi) return false;
        const long L = (long)i * G + c; if (L >= nwg) return false;
        int wgid = (int)L; { const int q = nwg / NXCD, r = nwg % NXCD, xcd = wgid % NXCD, off = wgid / NXCD; wgid = (xcd < r ? xcd * (q + 1) : r * (q + 1) + (xcd - r) * q) + off; }
        const int nig = WGM * nN, gid = wgid / nig, fm = gid * WGM, gsz = (nM - fm) < WGM ? (nM - fm) : WGM;
        u.pm = fm + ((wgid % nig) % gsz); u.pn = (wgid % nig) / gsz; u.seg = 0; if (probe) { u.pm = 0; u.pn = 0; } return true;
    }
    __device__ __forceinline__ void a_ready(const Unit&) const {}
    __device__ __forceinline__ void done(const Unit&) const {}
    __device__ __forceinline__ const char* baseA(const Gemm& g, const Unit& u, size_t tstep) const { return (const char*)g.A + (size_t)u.pm * tstep; }
    __device__ __forceinline__ const char* baseB(const Gemm& g, const Unit& u, size_t tstep) const { return (const char*)g.Bt + (size_t)u.pn * tstep; }
    __device__ __forceinline__ bool zero_after(const Unit&) const { return true; }
};

template <class Epi, class Sched, bool STAMP = false>
__device__ __forceinline__ void gemm_phase(PG8_LAS unsigned char* lds, const Gemm g, const Sched& S, const Epi& E, unsigned long long* stamps) {
    int tid = threadIdx.x; asm volatile("" : "+v"(tid));
    const int wid = __builtin_amdgcn_readfirstlane(tid >> 6), lane = tid & 63, wr = wid >> 2, wc = wid & 3, fr = lane & 15, fq = lane >> 4;
    const int K = g.K, nt = K / BK;
    int ts_lo = 0, ts_hi = 0, nts = 0; const unsigned long long rt_entry = STAMP ? (unsigned long long)wall_clock64() : 0ull;
#define PG8_STAMP() do { if (STAMP && wid == 0 && nts < 64) { const unsigned long long _c = (unsigned long long)clock64(); \
        ts_lo = (lane == nts) ? (int)(unsigned)_c : ts_lo; ts_hi = (lane == nts) ? (int)(unsigned)(_c >> 32) : ts_hi; ++nts; } } while (0)
    PG8_STAMP();
    unsigned voffA[2], voffB[2];
#pragma unroll
    for (int i = 0; i < 2; ++i) { int R, C; stage_rc(tid * 16 + i * 8192, R, C); const int Rb = Epi::PERM ? ((R & ~31) + perm32(R & 31)) : R;
        voffA[i] = (unsigned)(R * K + C) * 2u; voffB[i] = (unsigned)(Rb * K + C) * 2u; }
    const size_t kstep = (size_t)(BK * 2);
    const size_t hstep = (size_t)HALF * K * 2;
    const size_t tstep = 2 * hstep;
    const unsigned ldsw = (unsigned)wid * 1024u;
    const int aoff = lds_byte(wr * 64 + fr, fq * 8), boff = lds_byte(wc * 32 + fr, fq * 8);
#define PG8_SA(b, h) (((b) * 2 + (h)) * HTB)
#define PG8_SB(b, h) ((4 + (b) * 2 + (h)) * HTB)
#define PG8_STAGE(bufoff, gbase, voff) do { _Pragma("unroll") for (int _i = 0; _i < 2; ++_i) \
        __builtin_amdgcn_global_load_lds((const unsigned*)((const char*)(gbase) + (voff)[_i]), (PG8_LAS unsigned*)(lds + (bufoff) + ldsw + _i * 8192), 16, 0, 0); } while (0)
#define PG8_LDA(dst, b, h) do { _Pragma("unroll") for (int m = 0; m < 4; ++m) _Pragma("unroll") for (int k = 0; k < 2; ++k) dst[m][k] = *(const PG8_LAS bf16x8*)(lds + PG8_SA(b, h) + aoff + m * 2048 + k * 1024); } while (0)
#define PG8_LDB(dst, b, h) do { _Pragma("unroll") for (int n = 0; n < 2; ++n) _Pragma("unroll") for (int k = 0; k < 2; ++k) dst[n][k] = *(const PG8_LAS bf16x8*)(lds + PG8_SB(b, h) + boff + n * 2048 + k * 1024); } while (0)
#define PG8_MMA(ai, bj, At, Bt) do { __builtin_amdgcn_s_setprio(1); _Pragma("unroll") for (int m = 0; m < 4; ++m) _Pragma("unroll") for (int n = 0; n < 2; ++n) _Pragma("unroll") for (int k = 0; k < 2; ++k) \
        acc[ai][bj][m][n] = __builtin_amdgcn_mfma_f32_16x16x32_bf16(Bt[n][k], At[m][k], acc[ai][bj][m][n], 0, 0, 0); __builtin_amdgcn_s_setprio(0); } while (0)
#define PG8_WAIT_V(n) asm volatile("s_waitcnt vmcnt(" #n ")" ::: "memory")
#define PG8_WAIT_L(n) asm volatile("s_waitcnt lgkmcnt(" #n ")" ::: "memory")
#define PG8_BAR __builtin_amdgcn_s_barrier()
#define PG8_SCHED __builtin_amdgcn_sched_barrier(0)
    Unit cur, nxt; int ui = 0;
    if (!S.next(0, cur)) return;
    f32x4 acc[2][2][4][2];
#pragma unroll
    for (int a = 0; a < 2; ++a)
#pragma unroll
        for (int b = 0; b < 2; ++b)
#pragma unroll
            for (int m = 0; m < 4; ++m)
#pragma unroll
                for (int n = 0; n < 2; ++n) acc[a][b][m][n] = (f32x4){0.f, 0.f, 0.f, 0.f};
    bf16x8 At[4][2], B0[2][2], B1[2][2];
    const char* cA = S.baseA(g, cur, tstep); const char* cB = S.baseB(g, cur, tstep);
    S.a_ready(cur);
    PG8_STAGE(PG8_SB(0, 0), cB, voffB); PG8_STAGE(PG8_SA(0, 0), cA, voffA); PG8_STAGE(PG8_SB(0, 1), cB + hstep, voffB); PG8_STAGE(PG8_SA(0, 1), cA + hstep, voffA);
    if (wr == 1) PG8_BAR;
    PG8_WAIT_V(4); PG8_BAR;
    PG8_STAGE(PG8_SB(1, 0), cB + kstep, voffB); PG8_STAGE(PG8_SA(1, 0), cA + kstep, voffA); PG8_STAGE(PG8_SB(1, 1), cB + hstep + kstep, voffB);
    PG8_WAIT_V(6); PG8_BAR;
    PG8_STAMP();
    for (;;) {
        const bool has_next = S.next(ui + 1, nxt);
        const char* nA = has_next ? S.baseA(g, nxt, tstep) : cA; const char* nB = has_next ? S.baseB(g, nxt, tstep) : cB;
        for (int t = 0; t < nt; t += 2) {
            const bool last = (t == nt - 2);
            const char* a1 = cA + (size_t)(t + 1) * kstep;
            const char* a2 = last ? nA : cA + (size_t)(t + 2) * kstep; const char* b2 = last ? nB : cB + (size_t)(t + 2) * kstep;
            const char* a3 = a2 + kstep; const char* b3 = b2 + kstep;
            if (last && has_next) S.a_ready(nxt);
            PG8_LDB(B0, 0, 0); PG8_SCHED; PG8_LDA(At, 0, 0); PG8_STAGE(PG8_SA(1, 1), a1 + hstep, voffA);
            PG8_WAIT_L(8); PG8_BAR; PG8_WAIT_L(0); PG8_MMA(0, 0, At, B0); PG8_BAR; PG8_SCHED;
            PG8_LDB(B1, 0, 1); PG8_STAGE(PG8_SB(0, 0), b2, voffB);
            PG8_BAR; PG8_WAIT_L(0); PG8_MMA(0, 1, At, B1); PG8_BAR;
            PG8_LDA(At, 0, 1); PG8_STAGE(PG8_SA(0, 0), a2, voffA);
            PG8_BAR; PG8_WAIT_L(0); PG8_MMA(1, 0, At, B0); PG8_BAR; PG8_SCHED;
            PG8_STAGE(PG8_SB(0, 1), b2 + hstep, voffB);
            PG8_WAIT_V(6); PG8_BAR; PG8_MMA(1, 1, At, B1); PG8_BAR;
            PG8_LDB(B0, 1, 0); PG8_SCHED; PG8_LDA(At, 1, 0); PG8_STAGE(PG8_SA(0, 1), a2 + hstep, voffA);
            PG8_WAIT_L(8); PG8_BAR; PG8_WAIT_L(0); PG8_MMA(0, 0, At, B0); PG8_BAR; PG8_SCHED;
            PG8_LDB(B1, 1, 1); PG8_STAGE(PG8_SB(1, 0), b3, voffB);
            PG8_BAR; PG8_WAIT_L(0); PG8_MMA(0, 1, At, B1); PG8_BAR;
            PG8_LDA(At, 1, 1); PG8_STAGE(PG8_SA(1, 0), a3, voffA);
            PG8_BAR; PG8_WAIT_L(0); PG8_MMA(1, 0, At, B0); PG8_BAR; PG8_SCHED;
            PG8_STAGE(PG8_SB(1, 1), b3 + hstep, voffB);
            PG8_WAIT_V(6); PG8_BAR; PG8_MMA(1, 1, At, B1); PG8_BAR;
        }
        PG8_STAMP();
        if constexpr (!Epi::AFTER_DRAIN) { E(acc, cur, wr, wc, fr, fq); S.done(cur); }
        PG8_STAMP();
        if (!has_next) break;
        if (S.zero_after(cur))
#pragma unroll
        for (int a = 0; a < 2; ++a)
#pragma unroll
            for (int b = 0; b < 2; ++b)
#pragma unroll
                for (int m = 0; m < 4; ++m)
#pragma unroll
                    for (int n = 0; n < 2; ++n) acc[a][b][m][n] = (f32x4){0.f, 0.f, 0.f, 0.f};
        cur = nxt; cA = nA; cB = nB; ++ui;
    }
    PG8_WAIT_V(0);
    if (wr == 0) PG8_BAR;
    PG8_BAR;
    if constexpr (Epi::AFTER_DRAIN) { E.fused(acc, cur, wr, wc, fr, fq, lds, wid, lane); S.done(cur); }
    PG8_STAMP();
    if (STAMP && wid == 0) { stamps[lane] = lane < nts ? (((unsigned long long)(unsigned)ts_hi << 32) | (unsigned)ts_lo) : 0ull;
        if (lane == 62) stamps[62] = rt_entry; if (lane == 63) stamps[63] = (unsigned long long)wall_clock64(); }
#undef PG8_STAMP
#undef PG8_SA
#undef PG8_SB
#undef PG8_STAGE
#undef PG8_LDA
#undef PG8_LDB
#undef PG8_MMA
#undef PG8_WAIT_V
#undef PG8_WAIT_L
#undef PG8_BAR
#undef PG8_SCHED
}
}

typedef unsigned short u16;
typedef short bf16x8 __attribute__((ext_vector_type(8)));
typedef float f32x16 __attribute__((ext_vector_type(16)));
typedef float f32x4 __attribute__((ext_vector_type(4)));
typedef __bf16 bf2_t __attribute__((ext_vector_type(2)));
typedef float f2_t __attribute__((ext_vector_type(2)));
typedef unsigned u32x4 __attribute__((ext_vector_type(4)));
typedef unsigned u32x2 __attribute__((ext_vector_type(2)));
using pg8::Unit;

#define DI __device__ __forceinline__
#define MFMA32(a, b, c) __builtin_amdgcn_mfma_f32_32x32x16_bf16((a), (b), (c), 0, 0, 0)

constexpr int DM = 1024, SEQ = 4096, NBATCH = 8, T = NBATCH * SEQ;
constexpr int NCH = 2, BC = NBATCH / NCH, TC = BC * SEQ;
constexpr int INC = 7552, DMLP = 4096;
constexpr int NQKG = 6656;
constexpr int NQKH = 38, NVH = 16;
constexpr float LOG2E = 1.4426950408889634f;
constexpr int NTHR = 512;

constexpr size_t al256(size_t x) { return (x + 255) & ~(size_t)255; }
constexpr size_t OFF_WQKG = 0;
constexpr size_t OFF_WV   = OFF_WQKG + al256((size_t)2 * NQKG * DM * 2);
constexpr size_t OFF_WBR5 = OFF_WV   + al256((size_t)2 * DM * DM * 2);
constexpr size_t OFF_WOUT = OFF_WBR5 + al256((size_t)2 * 5 * DM * 256 * 2);
constexpr size_t OFF_WUP  = OFF_WOUT + al256((size_t)2 * DM * DM * 2);
constexpr size_t OFF_WDN  = OFF_WUP  + al256((size_t)2 * DMLP * DM * 2);
constexpr size_t OFF_ROPE = OFF_WDN  + al256((size_t)2 * DM * DMLP * 2);
constexpr size_t OFF_XB   = OFF_ROPE + al256((size_t)(SEQ + 1) * 96 * 4);
constexpr size_t OFF_SSQ  = OFF_XB   + al256((size_t)T * DM * 2);
constexpr size_t OFF_QK   = OFF_SSQ  + al256((size_t)T * 16 * 4);
constexpr size_t OFF_V    = OFF_QK   + al256((size_t)NQKH * TC * 64 * 2);
constexpr size_t OFF_GATE = OFF_V    + al256((size_t)NVH * TC * 64 * 2);
constexpr size_t OFF_Y5   = OFF_GATE + al256((size_t)TC * 4096 * 2);
constexpr size_t OFF_BO   = OFF_Y5   + al256((size_t)5 * TC * 256 * 2);
constexpr size_t OFF_LSE  = OFF_BO   + al256((size_t)TC * 384 * 2);
constexpr size_t OFF_MRG  = OFF_LSE  + al256((size_t)TC * 8 * 4);
constexpr size_t OFF_BAR  = OFF_MRG  + al256((size_t)TC * DM * 2);
constexpr size_t WS_END   = OFF_BAR  + 16384;
static_assert(WS_END <= (size_t)512 * 1024 * 1024, "workspace too large");

constexpr int LDS_STAGE = 131072;
constexpr int VT_STRIDE = 528;
constexpr int LDS_XBW = 256 * VT_STRIDE;
constexpr int LDS_BYTES = LDS_XBW + 64 + 1024;
constexpr int PPL = (DUPK >= 0) ? 7 : 6;
constexpr int NPHASE = 1 + NCH * 2 * PPL;

struct Params {
  const float* in[19];
  float* out;
  unsigned char* ws;
  int ph_lo, ph_hi;
};

DI unsigned pk2(float a, float b) { f2_t v = {a, b}; bf2_t r = __builtin_convertvector(v, bf2_t); return __builtin_bit_cast(unsigned, r); }
DI float bf_lo(unsigned u) { return __uint_as_float(u << 16); }
DI float bf_hi(unsigned u) { return __uint_as_float(u & 0xffff0000u); }
DI float fexp2(float x) { return __builtin_amdgcn_exp2f(x); }
DI int crow(int i, int h) { return (i & 3) + 8 * (i >> 2) + 4 * h; }
DI bf16x8 as_bf8(u32x4 v) { return __builtin_bit_cast(bf16x8, v); }
DI int dil_of(int gi) { return gi == 0 ? 1 : (gi == 1 ? 4 : 16); }
DI int dlg_of(int gi) { return gi * 2; }
DI float row_rscale(const float* ssq, size_t tok) {
  const f32x4 a = *(const f32x4*)(ssq + tok * 16), b = *(const f32x4*)(ssq + tok * 16 + 4);
  const f32x4 c = *(const f32x4*)(ssq + tok * 16 + 8), d = *(const f32x4*)(ssq + tok * 16 + 12);
  const float s = ((a[0] + a[1]) + (a[2] + a[3])) + ((b[0] + b[1]) + (b[2] + b[3])) + ((c[0] + c[1]) + (c[2] + c[3])) + ((d[0] + d[1]) + (d[2] + d[3]));
  return rsqrtf(s * (1.0f / 1024.0f) + 1e-6f);
}
DI int qk_head_col(int h) {
  if (h < 8) return 64 * h;
  if (h < 10) return 512 + 64 * (h - 8);
  if (h < 16) return 768 + 64 * (h - 10);
  if (h < 22) return 1152 + 64 * (h - 16);
  if (h < 26) return 1920 + 64 * (h - 22);
  if (h < 30) return 2176 + 64 * (h - 26);
  if (h < 34) return 2688 + 64 * (h - 30);
  return 2944 + 64 * (h - 34);
}
DI int v_head_col(int vh) {
  if (vh < 2) return 640 + 64 * vh;
  if (vh < 8) return 1536 + 64 * (vh - 2);
  if (vh < 12) return 2432 + 64 * (vh - 8);
  return 3200 + 64 * (vh - 12);
}

struct EpiQKG {
  static constexpr bool PERM = true, AFTER_DRAIN = false;
  const float* ssq; u16* qk; const float* rope; const float* gA; const float* gB; const float* gC; const float* gD;
  DI void body64(const f32x4 (&acc)[2][2][4][2], const Unit& u, int wr, int fr, int fq, unsigned goff, const float* gainl, float qpre, int dlg, int rope_on) const {
#pragma unroll
    for (int ai = 0; ai < 2; ++ai) {
#pragma unroll
      for (int m = 0; m < 4; ++m) {
        const int tok = u.pm * 256 + 128 * ai + 64 * wr + 16 * m + fr;
        const int bl = tok >> 12, pos = tok & 4095;
        const float rs = row_rscale(ssq, tok);
        const int pdom = ((pos & ((1 << dlg) - 1)) << (12 - dlg)) + (pos >> dlg);
        const int blk = pdom >> 5, rr = pdom & 31;
        const unsigned boff = goff + (unsigned)bl * (SEQ * 64) + (unsigned)(((blk * 4 + (fq >> 1)) * 64 + (fq & 1) * 32 + rr) * 8);
        const float* rp = rope + (unsigned)((rope_on ? pos : SEQ) * 96 + 8 * fq);
        float ss = 0.f;
#pragma unroll
        for (int bj = 0; bj < 2; ++bj)
#pragma unroll
          for (int n = 0; n < 2; ++n)
#pragma unroll
            for (int e = 0; e < 4; ++e) ss += acc[ai][bj][m][n][e] * acc[ai][bj][m][n][e];
        ss += __shfl_xor(ss, 16); ss += __shfl_xor(ss, 32);
        const float sc = rs * rsqrtf(ss * rs * rs * (1.0f / 64.0f) + 1e-6f) * qpre;
        u32x4 w0, w1;
#pragma unroll
        for (int n = 0; n < 2; ++n) {
          const f32x4 xa = acc[ai][0][m][n] * sc * *(const f32x4*)(gainl + 4 * n);
          const f32x4 xb2 = acc[ai][1][m][n] * sc * *(const f32x4*)(gainl + 32 + 4 * n);
          const f32x4 c4 = *(const f32x4*)(rp + 4 * n);
          const f32x4 s4 = *(const f32x4*)(rp + 32 + 4 * n);
          const f32x4 ta = xa * c4 - xb2 * s4, tb = xb2 * c4 + xa * s4;
          w0[2 * n] = pk2(ta[0], ta[1]); w0[2 * n + 1] = pk2(ta[2], ta[3]);
          w1[2 * n] = pk2(tb[0], tb[1]); w1[2 * n + 1] = pk2(tb[2], tb[3]);
        }
        *(u32x4*)(qk + boff) = w0;
        *(u32x4*)(qk + boff + 2 * 64 * 8) = w1;
        asm volatile("" ::: "memory");
      }
    }
  }
  DI void body32(const f32x4 (&acc)[2][2][4][2], const Unit& u, int wr, int fr, int fq, unsigned goff, const float* gainl, float qpre) const {
    const float sgn = (fq < 2) ? -1.0f : 1.0f;
#pragma unroll
    for (int ai = 0; ai < 2; ++ai) {
#pragma unroll
      for (int m = 0; m < 4; ++m) {
        const int tok = u.pm * 256 + 128 * ai + 64 * wr + 16 * m + fr;
        const int bl = tok >> 12, pos = tok & 4095;
        const float rs = row_rscale(ssq, tok);
        const int blk = pos >> 5, rr = pos & 31;
        const unsigned boff = goff + (unsigned)bl * (SEQ * 64) + (unsigned)(((blk * 2 + (fq >> 1)) * 64 + (fq & 1) * 32 + rr) * 8);
        const float* rp = rope + (unsigned)(pos * 96 + 64 + 8 * (fq & 1));
#pragma unroll
        for (int bj = 0; bj < 2; ++bj) {
          float ss = 0.f;
#pragma unroll
          for (int n = 0; n < 2; ++n)
#pragma unroll
            for (int e = 0; e < 4; ++e) ss += acc[ai][bj][m][n][e] * acc[ai][bj][m][n][e];
          ss += __shfl_xor(ss, 16); ss += __shfl_xor(ss, 32);
          const float sc = rs * rsqrtf(ss * rs * rs * (1.0f / 32.0f) + 1e-6f) * qpre;
          u32x4 w;
#pragma unroll
          for (int n = 0; n < 2; ++n) {
            const f32x4 x = acc[ai][bj][m][n] * sc * *(const f32x4*)(gainl + 4 * n);
            const f32x4 c4 = *(const f32x4*)(rp + 4 * n);
            const f32x4 s4 = *(const f32x4*)(rp + 16 + 4 * n);
            f32x4 pr;
#pragma unroll
            for (int e = 0; e < 4; ++e) pr[e] = __shfl_xor(x[e], 32);
            const f32x4 o = x * c4 + pr * s4 * sgn;
            w[2 * n] = pk2(o[0], o[1]); w[2 * n + 1] = pk2(o[2], o[3]);
          }
          *(u32x4*)(qk + boff + (unsigned)bj * (SEQ * 32)) = w;
        }
        asm volatile("" ::: "memory");
      }
    }
  }
  DI void operator()(const f32x4 (&acc)[2][2][4][2], const Unit& u, int wr, int wc, int fr, int fq) const {
    const int hidx = u.pn * 4 + wc;
    if (hidx >= NQKH) return;
    int kind, dlg = 0; const float* gain;
    if (hidx < 8) { kind = 0; gain = gA; }
    else if (hidx < 10) { kind = 0; gain = gA + 64; }
    else if (hidx < 16) { kind = 0; gain = gB; dlg = dlg_of((hidx - 10) >> 1); }
    else if (hidx < 22) { kind = 0; gain = gB + 64; dlg = dlg_of((hidx - 16) >> 1); }
    else if (hidx < 26) { kind = 2; gain = gC; }
    else if (hidx < 30) { kind = 2; gain = gC + 32; }
    else if (hidx < 34) { kind = 1; gain = gD; }
    else { kind = 1; gain = gD + 64; }
    const unsigned goff = (unsigned)hidx * (unsigned)(TC * 64);
    const float* gainl = gain + 8 * fq;
    const float qpre = (hidx >= 22 && hidx < 26) ? (0.17677669529663687f * LOG2E)
                     : ((hidx < 8 || (hidx >= 10 && hidx < 16) || (hidx >= 30 && hidx < 34)) ? (0.125f * LOG2E) : 1.0f);
    if (kind == 2) body32(acc, u, wr, fr, fq, goff, gainl, qpre);
    else body64(acc, u, wr, fr, fq, goff, gainl, qpre, dlg, kind == 0 ? 1 : 0);
  }
};

struct EpiGateUp {
  static constexpr bool PERM = true, AFTER_DRAIN = false;
  const float* ssq; u16* o; int mode;
  template <bool UP>
  DI void body(const f32x4 (&acc)[2][2][4][2], const Unit& u, int wr, int wc, int fr, int fq) const {
    const int c0 = u.pn * 256 + 32 * wc + 8 * fq;
    float rsv[8];
#pragma unroll
    for (int i = 0; i < 8; ++i) rsv[i] = row_rscale(ssq, (size_t)u.pm * 256 + 128 * (i >> 2) + 64 * wr + 16 * (i & 3) + fr);
#pragma unroll
    for (int ai = 0; ai < 2; ++ai)
#pragma unroll
      for (int m = 0; m < 4; ++m) {
        const size_t tok = (size_t)u.pm * 256 + 128 * ai + 64 * wr + 16 * m + fr;
        const float rs = rsv[ai * 4 + m];
#pragma unroll
        for (int bj = 0; bj < 2; ++bj) {
          float r[8];
#pragma unroll
          for (int n = 0; n < 2; ++n) {
            const f32x4 v = acc[ai][bj][m][n] * (UP ? rs : rs * -LOG2E);
#pragma unroll
            for (int e = 0; e < 4; ++e) {
              if (UP) { const float z = fmaxf(v[e], 0.f); r[4 * n + e] = z * z; }
              else r[4 * n + e] = __builtin_amdgcn_rcpf(1.0f + fexp2(v[e]));
            }
          }
          u32x4 w = {pk2(r[0], r[1]), pk2(r[2], r[3]), pk2(r[4], r[5]), pk2(r[6], r[7])};
          *(u32x4*)(o + tok * 4096 + c0 + 128 * bj) = w;
        }
        asm volatile("" ::: "memory");
      }
  }
  DI void operator()(const f32x4 (&acc)[2][2][4][2], const Unit& u, int wr, int wc, int fr, int fq) const {
    if (mode == 2) return;
    if (mode == 1) body<true>(acc, u, wr, wc, fr, fq);
    else body<false>(acc, u, wr, wc, fr, fq);
  }
};

struct EpiVT {
  static constexpr bool PERM = false, AFTER_DRAIN = true;
  const float* ssq; u16* vbuf;
  DI void operator()(const f32x4 (&)[2][2][4][2], const Unit&, int, int, int, int) const {}
  DI void fused(const f32x4 (&acc)[2][2][4][2], const Unit& u, int wr, int wc, int fr, int fq, PG8_LAS unsigned char* lds, int wid, int lane) const {
    PG8_LAS float* rsl = (PG8_LAS float*)(lds + 256 * VT_STRIDE + 64);
    {
      const int t = wid * 64 + lane;
      if (t < 256) rsl[t] = row_rscale(ssq, (size_t)u.pn * 256 + t);
    }
    __syncthreads();
#pragma unroll
    for (int ai = 0; ai < 2; ++ai)
#pragma unroll
      for (int m = 0; m < 4; ++m) {
        const int r = 128 * ai + 64 * wr + 16 * m + fr;
#pragma unroll
        for (int bj = 0; bj < 2; ++bj)
#pragma unroll
          for (int n = 0; n < 2; ++n) {
            const f32x4 v = acc[ai][bj][m][n] * *(const PG8_LAS f32x4*)(rsl + 128 * bj + 32 * wc + 16 * n + 4 * fq);
            u32x2 w = {pk2(v[0], v[1]), pk2(v[2], v[3])};
            *(PG8_LAS u32x2*)(lds + r * VT_STRIDE + (128 * bj + 32 * wc + 16 * n + 4 * fq) * 2) = w;
          }
      }
    __syncthreads();
    const int tid = wid * 64 + lane;
    const int bl = (u.pn * 256) >> 12, pos0 = (u.pn * 256) & 4095;
#pragma unroll 1
    for (int it = 0; it < 16; ++it) {
      const int uidx = it * 512 + tid;
      const int dvlo = uidx & 31, hh = (uidx >> 5) & 1, rb = (uidx >> 6) & 1, half = (uidx >> 7) & 15, h = uidx >> 11;
      const int vgrp = u.pm * 4 + h;
      const int dlg = (vgrp >= 2 && vgrp < 8) ? dlg_of((vgrp - 2) >> 1) : 0;
      const int cls = half >> (4 - dlg), hc = half & ((16 >> dlg) - 1);
      const int m0 = pos0 >> dlg, mh = m0 + 16 * hc;
      const int s = (mh >> 4) & 1, dblk = cls * (128 >> dlg) + (mh >> 5);
      const PG8_LAS unsigned char* row = lds + (h * 64 + rb * 32 + dvlo) * VT_STRIDE;
      unsigned short k8[8];
#pragma unroll
      for (int j = 0; j < 8; ++j) {
        const int tau = ((16 * hc + 4 * hh + (j & 3) + 8 * (j >> 2)) << dlg) + cls;
        k8[j] = *(const PG8_LAS unsigned short*)(row + tau * 2);
      }
      u32x4 w = {(unsigned)k8[0] | ((unsigned)k8[1] << 16), (unsigned)k8[2] | ((unsigned)k8[3] << 16),
                 (unsigned)k8[4] | ((unsigned)k8[5] << 16), (unsigned)k8[6] | ((unsigned)k8[7] << 16)};
      u16* dst = vbuf + (size_t)vgrp * TC * 64 + (size_t)bl * SEQ * 64 + ((size_t)((dblk * 2 + rb) * 2 + s) * 64 + hh * 32 + dvlo) * 8;
      *(u32x4*)dst = w;
    }
    __syncthreads();
  }
};

struct MergeOrder : pg8::StaticOrder {
  const u16* ybase; const u16* wbase;
  DI bool next(int i, Unit& u) const { if (i >= 5) return false; if (!pg8::StaticOrder::next(0, u)) return false; u.seg = i; return true; }
  DI const char* baseA(const pg8::Gemm&, const Unit& u, size_t tstep) const { return (const char*)(ybase + (size_t)u.seg * TC * 256) + (size_t)u.pm * tstep; }
  DI const char* baseB(const pg8::Gemm&, const Unit& u, size_t tstep) const { return (const char*)(wbase + (size_t)u.seg * DM * 256) + (size_t)u.pn * tstep; }
  DI bool zero_after(const Unit& u) const { return u.seg == 4; }
};
struct EpiMerge {
  static constexpr bool PERM = true, AFTER_DRAIN = false;
  const u16* gate; u16* mrg;
  DI void operator()(f32x4 (&acc)[2][2][4][2], const Unit& u, int wr, int wc, int fr, int fq) const {
    const int seg = u.seg;
    if (seg == 0) return;
    const bool last = (seg == 4);
    const int gnum = last ? 3 : seg - 1, gden = last ? 3 : seg;
    const u16* gnp = gate + ((size_t)u.pm * 256 + 64 * wr + fr) * 4096 + gnum * 1024 + u.pn * 256 + 32 * wc + 8 * fq;
    const u16* gdp = gate + ((size_t)u.pm * 256 + 64 * wr + fr) * 4096 + gden * 1024 + u.pn * 256 + 32 * wc + 8 * fq;
    u32x4 gn, gd, gnn, gdn;
    gn = *(const u32x4*)gnp; gd = *(const u32x4*)gdp;
#pragma unroll
    for (int i = 0; i < 16; ++i) {
      const int ai = i >> 3, m = (i >> 1) & 3, bj = i & 1;
      if (i < 15) {
        const int i2 = i + 1;
        const size_t ro = (size_t)(128 * (i2 >> 3) + 16 * ((i2 >> 1) & 3)) * 4096 + 128 * (i2 & 1);
        gnn = *(const u32x4*)(gnp + ro); gdn = *(const u32x4*)(gdp + ro);
      }
      asm volatile("" ::: "memory");
#pragma unroll
      for (int n = 0; n < 2; ++n) {
        f32x4 f;
        f[0] = bf_lo(gn[2 * n]); f[1] = bf_hi(gn[2 * n]); f[2] = bf_lo(gn[2 * n + 1]); f[3] = bf_hi(gn[2 * n + 1]);
        if (!last) {
          f[0] *= __builtin_amdgcn_rcpf(bf_lo(gd[2 * n])); f[1] *= __builtin_amdgcn_rcpf(bf_hi(gd[2 * n]));
          f[2] *= __builtin_amdgcn_rcpf(bf_lo(gd[2 * n + 1])); f[3] *= __builtin_amdgcn_rcpf(bf_hi(gd[2 * n + 1]));
        }
        acc[ai][bj][m][n] *= f;
      }
      if (last) {
        const size_t tok = (size_t)u.pm * 256 + 128 * ai + 64 * wr + 16 * m + fr;
        const int c = u.pn * 256 + 128 * bj + 32 * wc + 8 * fq;
        const f32x4 v0 = acc[ai][bj][m][0], v1 = acc[ai][bj][m][1];
        u32x4 w = {pk2(v0[0], v0[1]), pk2(v0[2], v0[3]), pk2(v1[0], v1[1]), pk2(v1[2], v1[3])};
        *(u32x4*)(mrg + tok * DM + c) = w;
      }
      gn = gnn; gd = gdn;
    }
  }
};

struct EpiResid {
  static constexpr bool PERM = true, AFTER_DRAIN = false;
  float* xout; u16* xb; float* ssq; int wf32;
  DI void operator()(const f32x4 (&acc)[2][2][4][2], const Unit& u, int wr, int wc, int fr, int fq) const {
    const size_t o0 = ((size_t)u.pm * 256 + 64 * wr + fr) * DM + u.pn * 256 + 32 * wc + 8 * fq;
    u32x4 xo, xn;
    xo = *(const u32x4*)(xb + o0);
    float ss = 0.f;
#pragma unroll
    for (int i = 0; i < 16; ++i) {
      const int ai = i >> 3, m = (i >> 1) & 3, bj = i & 1;
      if (i < 15) {
        const int i2 = i + 1;
        xn = *(const u32x4*)(xb + o0 + (size_t)(128 * (i2 >> 3) + 16 * ((i2 >> 1) & 3)) * DM + 128 * (i2 & 1));
      }
      asm volatile("" ::: "memory");
      const size_t tok = (size_t)u.pm * 256 + 128 * ai + 64 * wr + 16 * m + fr;
      const size_t o = tok * DM + u.pn * 256 + 128 * bj + 32 * wc + 8 * fq;
      f32x4 v0 = acc[ai][bj][m][0], v1 = acc[ai][bj][m][1];
      v0[0] += bf_lo(xo[0]); v0[1] += bf_hi(xo[0]); v0[2] += bf_lo(xo[1]); v0[3] += bf_hi(xo[1]);
      v1[0] += bf_lo(xo[2]); v1[1] += bf_hi(xo[2]); v1[2] += bf_lo(xo[3]); v1[3] += bf_hi(xo[3]);
      if (wf32) { *(f32x4*)(xout + o) = v0; *(f32x4*)(xout + o + 4) = v1; }
      if (!wf32) {
        u32x4 w = {pk2(v0[0], v0[1]), pk2(v0[2], v0[3]), pk2(v1[0], v1[1]), pk2(v1[2], v1[3])};
        *(u32x4*)(xb + o) = w;
      }
      ss += ((v0[0] * v0[0] + v0[1] * v0[1]) + (v0[2] * v0[2] + v0[3] * v0[3])) + ((v1[0] * v1[0] + v1[1] * v1[1]) + (v1[2] * v1[2] + v1[3] * v1[3]));
      if (bj == 1) {
        ss += __shfl_xor(ss, 16); ss += __shfl_xor(ss, 32);
        if (fq == 0 && !wf32) ssq[tok * 16 + u.pn * 4 + wc] = ss;
        ss = 0.f;
      }
      xo = xn;
    }
  }
};

template <class Epi>
DI void run_merge(PG8_LAS unsigned char* lds, const u16* ybase, const u16* wbase, const Epi& E) {
  int K = 256; asm volatile("" : "+s"(K));
  pg8::Gemm g; g.A = ybase; g.Bt = wbase; g.M = TC; g.N = DM; g.K = K;
  MergeOrder S; S.init(TC, DM, (int)gridDim.x, (int)blockIdx.x); S.ybase = ybase; S.wbase = wbase;
  pg8::gemm_phase<Epi, MergeOrder, false>(lds, g, S, E, nullptr);
}
template <class Epi>
DI void run_gemm(PG8_LAS unsigned char* lds, const u16* A, const u16* Bt, int M, int N, int K, const Epi& E, int probe = 0, int ilo = 0, int ihi = 1 << 30) {
  asm volatile("" : "+s"(K));
  pg8::Gemm g; g.A = A; g.Bt = Bt; g.M = M; g.N = N; g.K = K;
  pg8::StaticOrder S; S.init(M, N, (int)gridDim.x, (int)blockIdx.x); S.probe = probe; S.ilo = ilo; S.ihi = ihi;
  pg8::gemm_phase<Epi, pg8::StaticOrder, false>(lds, g, S, E, nullptr);
}

DI void cvt_load(const float* __restrict__ src, int N, int k0, int n0, const float* __restrict__ g, float* t, int ht) {
  const int c4 = (ht & 15) * 4;
#pragma unroll
  for (int i = 0; i < 4; ++i) {
    const int kk = (ht >> 4) + 16 * i;
    f32x4 v = *(const f32x4*)(src + (size_t)(k0 + kk) * N + n0 + c4);
    const float sc = g ? g[k0 + kk] : 1.0f;
    t[kk * 65 + c4 + 0] = v[0] * sc; t[kk * 65 + c4 + 1] = v[1] * sc; t[kk * 65 + c4 + 2] = v[2] * sc; t[kk * 65 + c4 + 3] = v[3] * sc;
  }
}
DI void cvt_store(u16* __restrict__ dst, int ldk, int kdst, int d0, int d1, const float* t, int ht) {
  const int kc = (ht & 7) * 8, nn = ht >> 3;
#pragma unroll
  for (int i = 0; i < 2; ++i) {
    const int tn = nn + 32 * i, row = (i == 0) ? d0 + nn : d1 + nn;
    u32x4 w;
    w[0] = pk2(t[(kc + 0) * 65 + tn], t[(kc + 1) * 65 + tn]);
    w[1] = pk2(t[(kc + 2) * 65 + tn], t[(kc + 3) * 65 + tn]);
    w[2] = pk2(t[(kc + 4) * 65 + tn], t[(kc + 5) * 65 + tn]);
    w[3] = pk2(t[(kc + 6) * 65 + tn], t[(kc + 7) * 65 + tn]);
    *(u32x4*)(dst + (size_t)row * ldk + kdst + kc) = w;
  }
}
struct CvtJob { const float* src; int N, k0, n0; const float* g; u16* dst; int ldk, d0, d1, kd; };
DI CvtJob cvt_job(const Params& p, int l, int ti) {
  CvtJob j; j.g = nullptr; j.kd = -1;
  const float* attn_g = p.in[1] + l * DM;
  if (ti < 608) { const int h = ti >> 4, kt = ti & 15; j.src = p.in[2] + (size_t)l * DM * INC; j.N = INC; j.k0 = kt * 64; j.n0 = qk_head_col(h); j.g = attn_g;
    j.dst = (u16*)(p.ws + OFF_WQKG) + (size_t)l * NQKG * DM; j.ldk = DM; j.d0 = (h >> 2) * 256 + (h & 3) * 32; j.d1 = j.d0 + 128; return j; }
  ti -= 608;
  if (ti < 1024) { const int c = ti >> 4, kt = ti & 15; j.src = p.in[2] + (size_t)l * DM * INC; j.N = INC; j.k0 = kt * 64; j.n0 = 3456 + 64 * c; j.g = attn_g;
    j.dst = (u16*)(p.ws + OFF_WQKG) + (size_t)l * NQKG * DM; j.ldk = DM; j.d0 = 2560 + 64 * c; j.d1 = j.d0 + 32; return j; }
  ti -= 1024;
  if (ti < 256) { const int vh = ti >> 4, kt = ti & 15; j.src = p.in[2] + (size_t)l * DM * INC; j.N = INC; j.k0 = kt * 64; j.n0 = v_head_col(vh); j.g = attn_g;
    j.dst = (u16*)(p.ws + OFF_WV) + (size_t)l * DM * DM; j.ldk = DM; j.d0 = vh * 64; j.d1 = j.d0 + 32; return j; }
  ti -= 256;
  if (ti < 128) { j.src = p.in[11] + (size_t)l * 512 * DM; j.N = DM; j.k0 = (ti >> 4) * 64; j.n0 = (ti & 15) * 64; j.dst = (u16*)(p.ws + OFF_WBR5) + ((size_t)l * 5 + (j.k0 >> 8)) * DM * 256; j.ldk = 256; j.kd = j.k0 & 255; j.d0 = j.n0; j.d1 = j.n0 + 32; return j; }
  ti -= 128;
  if (ti < 32) { j.src = p.in[12] + (size_t)l * 128 * DM; j.N = DM; j.k0 = (ti >> 4) * 64; j.n0 = (ti & 15) * 64; j.dst = (u16*)(p.ws + OFF_WBR5) + ((size_t)l * 5 + 2) * DM * 256; j.ldk = 256; j.kd = j.k0; j.d0 = j.n0; j.d1 = j.n0 + 32; return j; }
  ti -= 32;
  if (ti < 64) { j.src = p.in[13] + (size_t)l * 256 * DM; j.N = DM; j.k0 = (ti >> 4) * 64; j.n0 = (ti & 15) * 64; j.dst = (u16*)(p.ws + OFF_WBR5) + ((size_t)l * 5 + 3) * DM * 256; j.ldk = 256; j.kd = j.k0; j.d0 = j.n0; j.d1 = j.n0 + 32; return j; }
  ti -= 64;
  if (ti < 64) { j.src = p.in[14] + (size_t)l * 256 * DM; j.N = DM; j.k0 = (ti >> 4) * 64; j.n0 = (ti & 15) * 64; j.dst = (u16*)(p.ws + OFF_WBR5) + ((size_t)l * 5 + 4) * DM * 256; j.ldk = 256; j.kd = j.k0; j.d0 = j.n0; j.d1 = j.n0 + 32; return j; }
  ti -= 64;
  if (ti < 256) { j.src = p.in[15] + (size_t)l * DM * DM; j.N = DM; j.k0 = (ti >> 4) * 64; j.n0 = (ti & 15) * 64; j.dst = (u16*)(p.ws + OFF_WOUT) + (size_t)l * DM * DM; j.ldk = DM; j.d0 = j.n0; j.d1 = j.n0 + 32; return j; }
  ti -= 256;
  if (ti < 1024) { j.src = p.in[17] + (size_t)l * DM * DMLP; j.N = DMLP; j.k0 = (ti >> 6) * 64; j.n0 = (ti & 63) * 64; j.g = p.in[16] + l * DM;
    j.dst = (u16*)(p.ws + OFF_WUP) + (size_t)l * DMLP * DM; j.ldk = DM; j.d0 = j.n0; j.d1 = j.n0 + 32; return j; }
  ti -= 1024;
  j.src = p.in[18] + (size_t)l * DMLP * DM; j.N = DM; j.k0 = (ti >> 4) * 64; j.n0 = (ti & 15) * 64; j.dst = (u16*)(p.ws + OFF_WDN) + (size_t)l * DM * DMLP; j.ldk = DMLP; j.d0 = j.n0; j.d1 = j.n0 + 32; return j;
}

__device__ void phase_prep(const Params& p, int tid_, int bid_, int nblk_, unsigned char* smem) {
  const int half = tid_ >> 8, ht = tid_ & 255;
  float* t = (float*)smem + half * (64 * 65);
  const int per_layer = 4480, total = 2 * per_layer;
  for (int jp = bid_; jp * 2 < total; jp += nblk_) {
    const int j = jp * 2 + half;
    const bool on = j < total;
    CvtJob job;
    if (on) { job = cvt_job(p, j / per_layer, j % per_layer); cvt_load(job.src, job.N, job.k0, job.n0, job.g, t, ht); }
    __syncthreads();
    if (on) cvt_store(job.dst, job.ldk, (job.kd >= 0) ? job.kd : job.k0, job.d0, job.d1, t, ht);
    __syncthreads();
  }
  {
    const u32x4 z = {0u, 0u, 0u, 0u};
    for (int e = bid_ * NTHR + tid_; e < 2 * 128 * 128; e += nblk_ * NTHR) {
      const int l = e >> 14, r = (e >> 7) & 127, c = (e & 127) * 8;
      const int row = 9 * 256 + ((r < 64) ? 64 + r : 128 + r);
      *(u32x4*)((u16*)(p.ws + OFF_WQKG) + ((size_t)l * NQKG + row) * DM + c) = z;
    }
    for (int e = bid_ * NTHR + tid_; e < 2 * 1024 * 16; e += nblk_ * NTHR) {
      const int l = e >> 14, r = (e >> 4) & 1023, c = 128 + (e & 15) * 8;
      *(u32x4*)((u16*)(p.ws + OFF_WBR5) + (((size_t)l * 5 + 2) * DM + r) * 256 + c) = z;
    }
  }
  {
    const u32x4 z = {0u, 0u, 0u, 0u};
    u16* yb = (u16*)(p.ws + OFF_Y5) + (size_t)2 * TC * 256;
    for (int e = bid_ * NTHR + tid_; e < TC * 16; e += nblk_ * NTHR) *(u32x4*)(yb + (size_t)(e >> 4) * 256 + 128 + (e & 15) * 8) = z;
  }
  float* rope = (float*)(p.ws + OFF_ROPE);
  for (int e = bid_ * NTHR + tid_; e < SEQ * 48; e += nblk_ * NTHR) {
    const int pos = e / 48, i = e % 48;
    float inv;
    if (i < 32) inv = exp2f(-13.287712379549449f * (float)(2 * i) / 64.0f);
    else inv = exp2f(-13.287712379549449f * (float)(2 * (i - 32)) / 32.0f);
    const float angf = (float)pos * inv;
    const double ang = (double)angf;
    const double n = rint(ang * 0.15915494309189535);
    const float r = (float)(ang - n * 6.283185307179586);
    const float c = cosf(r), s = sinf(r);
    if (i < 32) { rope[pos * 96 + i] = c; rope[pos * 96 + 32 + i] = s; }
    else { rope[pos * 96 + 64 + (i - 32)] = c; rope[pos * 96 + 80 + (i - 32)] = s; }
  }
  if (bid_ == 0 && tid_ < 96) rope[SEQ * 96 + tid_] = (tid_ < 32 || (tid_ >= 64 && tid_ < 80)) ? 1.0f : 0.0f;
  u16* XB = (u16*)(p.ws + OFF_XB); float* SSQ = (float*)(p.ws + OFF_SSQ);
  const int lane = tid_ & 63;
  const int gw = bid_ * 8 + (tid_ >> 6), nw = nblk_ * 8;
  for (int row = gw; row < T; row += nw) {
    const float* xr = p.in[0] + (size_t)row * DM;
    float ss = 0.f;
#pragma unroll
    for (int i = 0; i < 4; ++i) {
      const f32x4 v = *(const f32x4*)(xr + i * 256 + lane * 4);
      ss += v[0] * v[0] + v[1] * v[1] + v[2] * v[2] + v[3] * v[3];
      u32x2 w = {pk2(v[0], v[1]), pk2(v[2], v[3])};
      *(u32x2*)(XB + (size_t)row * DM + i * 256 + lane * 4) = w;
    }
#pragma unroll
    for (int o = 32; o >= 1; o >>= 1) ss += __shfl_xor(ss, o);
    if (lane < 16) SSQ[(size_t)row * 16 + lane] = (lane == 0) ? ss : 0.f;
  }
}

DI void attn_softmax_pv(f32x16& S, float& m, float& l, f32x16& O0, f32x16& O1, const bf16x8 (&vf)[2][2]) {
  float mx = S[0];
#pragma unroll
  for (int i = 1; i < 16; ++i) mx = fmaxf(mx, S[i]);
  mx = fmaxf(mx, __shfl_xor(mx, 32));
  const float mn = fmaxf(m, mx);
  const float alpha = fexp2(m - mn);
  m = mn;
  float sum = 0.f;
#pragma unroll
  for (int i = 0; i < 16; ++i) { S[i] = fexp2(S[i] - mn); sum += S[i]; }
  l = l * alpha + sum;
  const u32x4 p0 = {pk2(S[0], S[1]), pk2(S[2], S[3]), pk2(S[4], S[5]), pk2(S[6], S[7])};
  const u32x4 p1 = {pk2(S[8], S[9]), pk2(S[10], S[11]), pk2(S[12], S[13]), pk2(S[14], S[15])};
#pragma unroll
  for (int i = 0; i < 16; ++i) { O0[i] *= alpha; O1[i] *= alpha; }
  O0 = MFMA32(vf[0][0], as_bf8(p0), O0);
  O0 = MFMA32(vf[0][1], as_bf8(p1), O0);
  O1 = MFMA32(vf[1][0], as_bf8(p0), O1);
  O1 = MFMA32(vf[1][1], as_bf8(p1), O1);
}
DI void attn_fixed_pv(f32x16& S, f32x16& L, f32x16& O0, f32x16& O1, const bf16x8 (&vf)[2][2], const bf16x8 ones) {
#pragma unroll
  for (int i = 0; i < 16; ++i) S[i] = fexp2(S[i]);
  const u32x4 p0 = {pk2(S[0], S[1]), pk2(S[2], S[3]), pk2(S[4], S[5]), pk2(S[6], S[7])};
  const u32x4 p1 = {pk2(S[8], S[9]), pk2(S[10], S[11]), pk2(S[12], S[13]), pk2(S[14], S[15])};
  O0 = MFMA32(vf[0][0], as_bf8(p0), O0);
  O0 = MFMA32(vf[0][1], as_bf8(p1), O0);
  O1 = MFMA32(vf[1][0], as_bf8(p0), O1);
  O1 = MFMA32(vf[1][1], as_bf8(p1), O1);
  float sum = 0.f;
#pragma unroll
  for (int i = 0; i < 16; ++i) sum += S[i];
  L[0] += sum;
}
DI void attn_plain_pv(f32x16& S, float& l, f32x16& O0, f32x16& O1, const bf16x8 (&vf)[2][2]) {
  float sum = 0.f;
#pragma unroll
  for (int i = 0; i < 16; ++i) { S[i] = fexp2(S[i]); sum += S[i]; }
  l += sum;
  const u32x4 p0 = {pk2(S[0], S[1]), pk2(S[2], S[3]), pk2(S[4], S[5]), pk2(S[6], S[7])};
  const u32x4 p1 = {pk2(S[8], S[9]), pk2(S[10], S[11]), pk2(S[12], S[13]), pk2(S[14], S[15])};
  O0 = MFMA32(vf[0][0], as_bf8(p0), O0); O1 = MFMA32(vf[1][0], as_bf8(p0), O1);
  O0 = MFMA32(vf[0][1], as_bf8(p1), O0); O1 = MFMA32(vf[1][1], as_bf8(p1), O1);
}
DI float gain_bound64(const float* g) {
  float a = 0.f, b = 0.f;
  for (int i = 0; i < 64; ++i) { a = fmaxf(a, fabsf(g[i])); b = fmaxf(b, fabsf(g[64 + i])); }
  return fminf(8.0f * a * b * 1.02f + 0.05f, 40.0f);
}
DI void load_vf(bf16x8 (&vf)[2][2], const u16* V, int kb, int lane) {
#pragma unroll
  for (int rb = 0; rb < 2; ++rb)
#pragma unroll
    for (int s = 0; s < 2; ++s) vf[rb][s] = *(const bf16x8*)(V + ((size_t)((kb * 2 + rb) * 2 + s) * 64 + lane) * 8);
}
DI void load_kf4(bf16x8 (&kf)[4], const u16* K, int kb, int lane) {
#pragma unroll
  for (int s = 0; s < 4; ++s) kf[s] = *(const bf16x8*)(K + ((size_t)(kb * 4 + s) * 64 + lane) * 8);
}
DI void load_kf2(bf16x8 (&kf)[2], const u16* K, int kb, int lane) {
#pragma unroll
  for (int s = 0; s < 2; ++s) kf[s] = *(const bf16x8*)(K + ((size_t)(kb * 2 + s) * 64 + lane) * 8);
}
DI void zero16(f32x16& a) {
#pragma unroll
  for (int i = 0; i < 16; ++i) a[i] = 0.f;
}
DI void store_o(u16* yrow, const f32x16& O0, const f32x16& O1, float sc, int h) {
#pragma unroll
  for (int g4 = 0; g4 < 4; ++g4) {
    u32x2 w0 = {pk2(O0[4 * g4] * sc, O0[4 * g4 + 1] * sc), pk2(O0[4 * g4 + 2] * sc, O0[4 * g4 + 3] * sc)};
    *(u32x2*)(yrow + 8 * g4 + 4 * h) = w0;
    u32x2 w1 = {pk2(O1[4 * g4] * sc, O1[4 * g4 + 1] * sc), pk2(O1[4 * g4 + 2] * sc, O1[4 * g4 + 3] * sc)};
    *(u32x2*)(yrow + 32 + 8 * g4 + 4 * h) = w1;
  }
}

__device__ void phase_attn(const Params& p, int tid_, int bid_, int nblk_, int layer, unsigned char* smem) {
  const u16* QK = (const u16*)(p.ws + OFF_QK);
  const u16* VB = (const u16*)(p.ws + OFF_V);
  u16* Y5 = (u16*)(p.ws + OFF_Y5);
  u16* BO = (u16*)(p.ws + OFF_BO);
  float* LSE = (float*)(p.ws + OFF_LSE);
  const int lane = tid_ & 63, wave = tid_ >> 6;
  const int fr = lane & 31, fh = lane >> 5;
  const int nloc = nblk_ >> 3;
  if ((int)(bid_ >> 3) >= nloc) return;
  const int vw = ((bid_ & 7) * nloc + (bid_ >> 3)) * 8 + wave, NW = nloc * 64;
  const bool hiwg = (bid_ * 2 >= nblk_);
  const int hb_ = bid_ - (nblk_ >> 1), nloch = nblk_ >> 4;
  const int vwh = ((hb_ & 7) * nloch + (hb_ >> 3)) * 8 + wave, NWH = nloch * 64;
  PG8_LAS float* rpbl = (PG8_LAS float*)smem;
  if (hiwg) {
    for (int i = tid_; i < 4 * 465; i += NTHR) rpbl[i] = p.in[10][(size_t)layer * 4 * 465 + i];
    __syncthreads();
  }

  const size_t GS = (size_t)TC * 64;
  const size_t BS = (size_t)SEQ * 64;

  {
    const float* lp = p.in[7] + layer * 128;
    float d01 = 0.f, d23 = 0.f;
    for (int i = 0; i < 32; ++i) { d01 += lp[i] * lp[32 + i]; d23 += lp[64 + i] * lp[96 + i]; }
    const float lambda_init = (layer == 0) ? 0.2f : 0.35550907f;
    const float lam = __expf(d01) - __expf(d23) + lambda_init;
    const float* subg = p.in[8] + layer * 64;
    const float sc = 0.17677669529663687f * LOG2E;
    float gqm = 0.f, gkm = 0.f;
    for (int i = 0; i < 32; ++i) { gqm = fmaxf(gqm, fabsf(p.in[6][layer * 64 + i])); gkm = fmaxf(gkm, fabsf(p.in[6][layer * 64 + 32 + i])); }
    const unsigned onev = ((fr & 27) == 0) ? 0x3f803f80u : 0u;
    const u32x4 ones4 = {onev, onev, onev, onev};
    const bf16x8 ones = as_bf8(ones4);
    const float cbound = 5.6568542f * gqm * gkm * 1.02f + 0.05f;
    for (int it = vw; it < BC * 4 * 128; it += NW) {
      const int bl = it >> 9, head = (it >> 7) & 3, qblk = it & 127;
      const u16* Q0 = QK + (22 + head) * GS + bl * BS; const u16* Q1 = Q0 + SEQ * 32;
      const u16* K0 = QK + (26 + head) * GS + bl * BS; const u16* K1 = K0 + SEQ * 32;
      const u16* V = VB + (8 + head) * GS + bl * BS;
      bf16x8 q0[2], q1[2];
      load_kf2(q0, Q0, qblk, lane); load_kf2(q1, Q1, qblk, lane);
      f32x16 L0, L1; zero16(L0); zero16(L1);
      f32x16 O00, O01, O10, O11; zero16(O00); zero16(O01); zero16(O10); zero16(O11);
      bf16x8 k0[2], k1[2], vf[2][2];
      {
        const float mb2 = fminf(cbound, 40.0f) * LOG2E;
        f32x16 sinit;
#pragma unroll
        for (int i = 0; i < 16; ++i) sinit[i] = -mb2;
        load_kf2(k0, K0, 0, lane); load_kf2(k1, K1, 0, lane); load_vf(vf, V, 0, lane);
        f32x16 S0 = sinit, S1 = sinit;
        S0 = MFMA32(k0[0], q0[0], S0); S0 = MFMA32(k0[1], q0[1], S0);
        S1 = MFMA32(k1[0], q1[0], S1); S1 = MFMA32(k1[1], q1[1], S1);
        load_kf2(k0, K0, 1, lane); load_kf2(k1, K1, 1, lane);
        for (int kb = 0; kb < 128; ++kb) {
          bf16x8 nk0[2], nk1[2], nvf[2][2];
          const int k2 = (kb + 2 < 128) ? kb + 2 : 127, v1 = (kb + 1 < 128) ? kb + 1 : 127;
          load_kf2(nk0, K0, k2, lane); load_kf2(nk1, K1, k2, lane); load_vf(nvf, V, v1, lane);
          f32x16 S0n = sinit, S1n = sinit;
#pragma unroll
          for (int i = 0; i < 16; ++i) S0[i] = fexp2(S0[i]);
          S0n = MFMA32(k0[0], q0[0], S0n); S0n = MFMA32(k0[1], q0[1], S0n);
          {
            const u32x4 p0 = {pk2(S0[0], S0[1]), pk2(S0[2], S0[3]), pk2(S0[4], S0[5]), pk2(S0[6], S0[7])};
            const u32x4 p1 = {pk2(S0[8], S0[9]), pk2(S0[10], S0[11]), pk2(S0[12], S0[13]), pk2(S0[14], S0[15])};
            O00 = MFMA32(vf[0][0], as_bf8(p0), O00); O01 = MFMA32(vf[1][0], as_bf8(p0), O01);
            O00 = MFMA32(vf[0][1], as_bf8(p1), O00); O01 = MFMA32(vf[1][1], as_bf8(p1), O01);
            float sum = 0.f;
#pragma unroll
            for (int i = 0; i < 16; ++i) sum += S0[i];
            L0[0] += sum;
          }
#pragma unroll
          for (int i = 0; i < 16; ++i) S1[i] = fexp2(S1[i]);
          S1n = MFMA32(k1[0], q1[0], S1n); S1n = MFMA32(k1[1], q1[1], S1n);
          {
            const u32x4 p0 = {pk2(S1[0], S1[1]), pk2(S1[2], S1[3]), pk2(S1[4], S1[5]), pk2(S1[6], S1[7])};
            const u32x4 p1 = {pk2(S1[8], S1[9]), pk2(S1[10], S1[11]), pk2(S1[12], S1[13]), pk2(S1[14], S1[15])};
            O10 = MFMA32(vf[0][0], as_bf8(p0), O10); O11 = MFMA32(vf[1][0], as_bf8(p0), O11);
            O10 = MFMA32(vf[0][1], as_bf8(p1), O10); O11 = MFMA32(vf[1][1], as_bf8(p1), O11);
            float sum = 0.f;
#pragma unroll
            for (int i = 0; i < 16; ++i) sum += S1[i];
            L1[0] += sum;
          }
          S0 = S0n; S1 = S1n;
#pragma unroll
          for (int s = 0; s < 2; ++s) { k0[s] = nk0[s]; k1[s] = nk1[s]; vf[0][s] = nvf[0][s]; vf[1][s] = nvf[1][s]; }
        }
      }
      const float i0 = 1.0f / (L0[0] + __shfl_xor(L0[0], 32));
      const float i1 = lam / (L1[0] + __shfl_xor(L1[0], 32));
      float ss = 0.f;
#pragma unroll
      for (int i = 0; i < 16; ++i) {
        O00[i] = O00[i] * i0 - O10[i] * i1; O01[i] = O01[i] * i0 - O11[i] * i1;
        ss += O00[i] * O00[i] + O01[i] * O01[i];
      }
      ss += __shfl_xor(ss, 32);
      const float rn = rsqrtf(ss * (1.0f / 64.0f) + 1e-6f) * (1.0f - lambda_init);
#pragma unroll
      for (int g4 = 0; g4 < 4; ++g4) {
        const f32x4 ga = *(const f32x4*)(subg + 8 * g4 + 4 * fh);
        const f32x4 gb = *(const f32x4*)(subg + 32 + 8 * g4 + 4 * fh);
#pragma unroll
        for (int e = 0; e < 4; ++e) { O00[4 * g4 + e] *= ga[e]; O01[4 * g4 + e] *= gb[e]; }
      }
      const size_t tok = (size_t)bl * SEQ + qblk * 32 + fr;
      store_o(Y5 + (size_t)3 * TC * 256 + tok * 256 + head * 64, O00, O01, rn, fh);
    }
  }
  {
    const float mbA = gain_bound64(p.in[3] + layer * 128) * LOG2E;
    f32x16 sinit;
#pragma unroll
    for (int i = 0; i < 16; ++i) sinit[i] = -mbA;
    for (int it = vw; it < BC * 8 * 128; it += NW) {
      const int bl = it >> 10, hq = (it >> 7) & 7, qblk = it & 127;
      const int kvh = hq >> 2;
      const u16* Q = QK + (size_t)hq * GS + bl * BS;
      const u16* K = QK + (size_t)(8 + kvh) * GS + bl * BS;
      const u16* V = VB + (size_t)kvh * GS + bl * BS;
      bf16x8 qf[4]; load_kf4(qf, Q, qblk, lane);
      float l = (fh == 0) ? fexp2(p.in[4][layer * 8 + hq] * LOG2E - mbA) : 0.0f;
      f32x16 O0, O1; zero16(O0); zero16(O1);
      const int kb_lo = (qblk - 4 < 0) ? 0 : qblk - 4, kb_hi = (qblk + 4 > 127) ? 127 : qblk + 4;
      const int qpos = qblk * 32 + fr;
      bf16x8 kf[4], vf[2][2];
      load_kf4(kf, K, kb_lo, lane); load_vf(vf, V, kb_lo, lane);
      for (int kb = kb_lo; kb <= kb_hi; ++kb) {
        bf16x8 nkf[4], nvf[2][2];
        const int kn = (kb < kb_hi) ? kb + 1 : kb;
        load_kf4(nkf, K, kn, lane); load_vf(nvf, V, kn, lane);
        f32x16 S = sinit;
#pragma unroll
        for (int s = 0; s < 4; ++s) S = MFMA32(kf[s], qf[s], S);
        if (kb == qblk - 4 || kb == qblk + 4) {
#pragma unroll
          for (int i = 0; i < 16; ++i) {
            const int dlt = kb * 32 + crow(i, fh) - qpos;
            S[i] = (dlt <= 128 && dlt >= -128) ? S[i] : (-__builtin_inff());
          }
        }
        attn_plain_pv(S, l, O0, O1, vf);
#pragma unroll
        for (int s = 0; s < 4; ++s) kf[s] = nkf[s];
#pragma unroll
        for (int s = 0; s < 2; ++s) { vf[0][s] = nvf[0][s]; vf[1][s] = nvf[1][s]; }
      }
      const float inv = 1.0f / (l + __shfl_xor(l, 32));
      const size_t tok = (size_t)bl * SEQ + qpos;
      store_o(Y5 + (size_t)(hq >> 2) * TC * 256 + tok * 256 + (hq & 3) * 64, O0, O1, inv, fh);
    }
  }
  {
    const float gbD = gain_bound64(p.in[9] + layer * 128);
    if (hiwg)
    for (int it = vwh; it < BC * 4 * 128; it += NWH) {
      const int bl = it >> 9, head = (it >> 7) & 3, qblk = it & 127;
      const u16* Q = QK + (size_t)(30 + head) * GS + bl * BS;
      const u16* K = QK + (size_t)(34 + head) * GS + bl * BS;
      const u16* V = VB + (size_t)(12 + head) * GS + bl * BS;
      const PG8_LAS float* rpb = rpbl + head * 465;
      bf16x8 qf[4]; load_kf4(qf, Q, qblk, lane);
      float bmax = 0.f;
      for (int i = lane; i < 15 * 31; i += 64) bmax = fmaxf(bmax, fabsf(rpb[i]));
#pragma unroll
      for (int o = 32; o >= 1; o >>= 1) bmax = fmaxf(bmax, __shfl_xor(bmax, o));
      const float mbD = fminf(gbD + bmax, 60.0f) * LOG2E;
      f32x16 sinit;
#pragma unroll
      for (int i = 0; i < 16; ++i) sinit[i] = -mbD;
      float l = 0.f;
      f32x16 O0, O1; zero16(O0); zero16(O1);
      const int qrow = qblk >> 1, qc = (qblk & 1) * 32 + fr;
      int r0 = qrow - 4; r0 = r0 < 0 ? 0 : (r0 > 56 ? 56 : r0);
      int c0 = qc - 8; c0 = c0 < 0 ? 0 : (c0 > 48 ? 48 : c0);
      bf16x8 kf[4], vf[2][2];
      load_kf4(kf, K, r0 * 2, lane); load_vf(vf, V, r0 * 2, lane);
      for (int kk = 0; kk < 16; ++kk) {
        const int krow_ = r0 + (kk >> 1), hb = kk & 1;
        bf16x8 nkf[4], nvf[2][2];
        const int kn = r0 * 2 + ((kk < 15) ? kk + 1 : kk);
        load_kf4(nkf, K, kn, lane); load_vf(nvf, V, kn, lane);
        f32x16 S = sinit;
#pragma unroll
        for (int s = 0; s < 4; ++s) S = MFMA32(kf[s], qf[s], S);
        const PG8_LAS float* brow = rpb + (krow_ - qrow + 7) * 31;
#pragma unroll
        for (int i = 0; i < 16; ++i) {
          const int kc = hb * 32 + crow(i, fh);
          int dc = kc - qc; dc = dc < -15 ? -15 : (dc > 15 ? 15 : dc);
          const float bias = brow[dc + 15];
          S[i] = (kc >= c0 && kc < c0 + 16) ? __builtin_fmaf(bias, LOG2E, S[i]) : (-__builtin_inff());
        }
        attn_plain_pv(S, l, O0, O1, vf);
#pragma unroll
        for (int s = 0; s < 4; ++s) kf[s] = nkf[s];
#pragma unroll
        for (int s = 0; s < 2; ++s) { vf[0][s] = nvf[0][s]; vf[1][s] = nvf[1][s]; }
      }
      const float inv = 1.0f / (l + __shfl_xor(l, 32));
      const size_t tok = (size_t)bl * SEQ + qblk * 32 + fr;
      store_o(Y5 + (size_t)4 * TC * 256 + tok * 256 + head * 64, O0, O1, inv, fh);
    }
  }
  {
    const float mbB = gain_bound64(p.in[5] + layer * 128) * LOG2E;
    f32x16 sinit;
#pragma unroll
    for (int i = 0; i < 16; ++i) sinit[i] = -mbB;
    if (hiwg)
    for (int it = vwh; it < BC * 6 * 128; it += NWH) {
      const int bl = it / 768, rem = it % 768, head = rem >> 7, qblk = rem & 127;
      const int dil = dil_of(head >> 1), L = SEQ / dil, LB = L >> 5;
      const u16* Q = QK + (size_t)(10 + head) * GS + bl * BS;
      const u16* K = QK + (size_t)(16 + head) * GS + bl * BS;
      const u16* V = VB + (size_t)(2 + head) * GS + bl * BS;
      bf16x8 qf[4]; load_kf4(qf, Q, qblk, lane);
      float l = 0.f;
      f32x16 O0, O1; zero16(O0); zero16(O1);
      const int rsub = qblk / LB;
      const int lo = rsub * LB, hi = lo + LB - 1;
      const int kb_lo = (qblk - 2 < lo) ? lo : qblk - 2, kb_hi = (qblk + 2 > hi) ? hi : qblk + 2;
      const int qd = qblk * 32 + fr;
      bf16x8 kf[4], vf[2][2];
      load_kf4(kf, K, kb_lo, lane); load_vf(vf, V, kb_lo, lane);
      for (int kb = kb_lo; kb <= kb_hi; ++kb) {
        bf16x8 nkf[4], nvf[2][2];
        const int kn = (kb < kb_hi) ? kb + 1 : kb;
        load_kf4(nkf, K, kn, lane); load_vf(nvf, V, kn, lane);
        f32x16 S = sinit;
#pragma unroll
        for (int s = 0; s < 4; ++s) S = MFMA32(kf[s], qf[s], S);
        if (kb == qblk - 2 || kb == qblk + 2) {
#pragma unroll
          for (int i = 0; i < 16; ++i) {
            const int dlt = kb * 32 + crow(i, fh) - qd;
            S[i] = (dlt <= 64 && dlt >= -64) ? S[i] : (-__builtin_inff());
          }
        }
        attn_plain_pv(S, l, O0, O1, vf);
#pragma unroll
        for (int s = 0; s < 4; ++s) kf[s] = nkf[s];
#pragma unroll
        for (int s = 0; s < 2; ++s) { vf[0][s] = nvf[0][s]; vf[1][s] = nvf[1][s]; }
      }
      const float lt = l + __shfl_xor(l, 32);
      const float inv = 1.0f / lt;
      const int msub = qd - rsub * L;
      const int pos = msub * dil + rsub;
      const size_t tok = (size_t)bl * SEQ + pos;
      store_o(BO + tok * 384 + head * 64, O0, O1, inv, fh);
      if (fh == 0) LSE[tok * 8 + head] = __log2f(lt) + mbB;
    }
  }
}


__device__ void phase_bcombine(const Params& p, int tid_, int tok0) {
  const u16* BO = (const u16*)(p.ws + OFF_BO);
  const float* LSE = (const float*)(p.ws + OFF_LSE);
  u16* YB = (u16*)(p.ws + OFF_Y5) + (size_t)2 * TC * 256;
  for (int e = tid_; e < 256 * 16; e += NTHR) {
    const int tok = tok0 + (e >> 4), j = (e >> 3) & 1, c8 = (e & 7) * 8;
    const float a0 = LSE[(size_t)tok * 8 + j], a1 = LSE[(size_t)tok * 8 + 2 + j], a2 = LSE[(size_t)tok * 8 + 4 + j];
    const float mx = fmaxf(a0, fmaxf(a1, a2));
    float w0 = fexp2(a0 - mx), w1 = fexp2(a1 - mx), w2 = fexp2(a2 - mx);
    const float inv = 1.0f / (w0 + w1 + w2);
    w0 *= inv; w1 *= inv; w2 *= inv;
    const u32x4 x0 = *(const u32x4*)(BO + (size_t)tok * 384 + (0 + j) * 64 + c8);
    const u32x4 x1 = *(const u32x4*)(BO + (size_t)tok * 384 + (2 + j) * 64 + c8);
    const u32x4 x2 = *(const u32x4*)(BO + (size_t)tok * 384 + (4 + j) * 64 + c8);
    u32x4 o;
#pragma unroll
    for (int q = 0; q < 4; ++q) {
      const float lo = w0 * bf_lo(x0[q]) + w1 * bf_lo(x1[q]) + w2 * bf_lo(x2[q]);
      const float hi = w0 * bf_hi(x0[q]) + w1 * bf_hi(x1[q]) + w2 * bf_hi(x2[q]);
      o[q] = pk2(lo, hi);
    }
    *(u32x4*)(YB + (size_t)tok * 256 + j * 64 + c8) = o;
  }
}

#define XB_TMO      128
#define XB_XCNT(j)  (256  + 64 * (j))
#define XB_XSUB(j)  (1280 + 64 * (j))
#define XB_XGEN(j)  (2304 + 64 * (j))
#define XB_TOP      3328
#define XB_TOPGEN   3392
#define XCD_BAR_WORDS 3456
#define XB_SPIN_CAP (1u << 22)
#define LAS __attribute__((address_space(3)))
DI unsigned xb_ld(unsigned* p)              { return __hip_atomic_load(p, __ATOMIC_RELAXED, __HIP_MEMORY_SCOPE_AGENT); }
DI unsigned xb_add(unsigned* p, unsigned v) { return __hip_atomic_fetch_add(p, v, __ATOMIC_RELAXED, __HIP_MEMORY_SCOPE_AGENT); }
DI unsigned xb_xcc_id() { return (unsigned)__builtin_amdgcn_s_getreg((3 << 11) | 20) & 0xFu; }
#define XB_SPIN(cond, bar) do { unsigned _sp = 0; while (cond) { __builtin_amdgcn_s_sleep(1); \
    if ((++_sp & 255u) == 0u) { if (xb_ld(&(bar)[XB_TMO])) break; if (_sp > XB_SPIN_CAP) { atomicAdd(&(bar)[XB_TMO], 1u); break; } } } } while (0)
struct XcdBarrier { unsigned* bar; unsigned x; volatile LAS unsigned* st; };
DI XcdBarrier xcd_barrier_post(unsigned* bar, volatile LAS unsigned* st) {
  XcdBarrier b; b.bar = bar; b.x = xb_xcc_id(); b.st = st;
  if (threadIdx.x == 0) (void)xb_add(&bar[XB_XCNT(b.x)], 1u);
  return b;
}
DI void xcd_barrier_complete(unsigned* bar, unsigned x, unsigned& nloc, unsigned& nx) {
  const unsigned G = gridDim.x * gridDim.y * gridDim.z;
  unsigned sum, cnt, mine, sp = 0u;
  for (;;) {
    sum = 0u; cnt = 0u; mine = 0u;
#pragma unroll
    for (unsigned j = 0; j < 16; ++j) { const unsigned c = xb_ld(&bar[XB_XCNT(j)]); sum += c; cnt += (c > 0u) ? 1u : 0u; mine = (j == x) ? c : mine; }
    if (sum == G) break;
    __builtin_amdgcn_s_sleep(1);
    if ((++sp & 255u) == 0u) { if (xb_ld(&bar[XB_TMO])) break; if (sp > XB_SPIN_CAP) { atomicAdd(&bar[XB_TMO], 1u); break; } }
  }
  nloc = mine > 0u ? mine : 1u; nx = cnt > 0u ? cnt : 1u;
}
DI void xcd_barrier(const XcdBarrier& b) {
  asm volatile("s_waitcnt vmcnt(0)" ::: "memory");
  __syncthreads();
  if (threadIdx.x == 0) {
    unsigned* bar = b.bar;
    __builtin_amdgcn_s_waitcnt(0);
    unsigned nloc = b.st[0], nx = b.st[1];
    if (nloc == 0u) { xcd_barrier_complete(bar, b.x, nloc, nx); b.st[0] = nloc; b.st[1] = nx; }
    const unsigned old = xb_add(&bar[XB_XSUB(b.x)], 1u);
    const unsigned gen = old / nloc;
    if (old + 1u == (gen + 1u) * nloc) {
      __builtin_amdgcn_fence(__ATOMIC_RELEASE, "agent");
      asm volatile("s_waitcnt vmcnt(0)" ::: "memory");
      const unsigned og = xb_add(&bar[XB_TOP], 1u);
      const unsigned tg = og / nx;
      if (og + 1u == (tg + 1u) * nx) xb_add(&bar[XB_TOPGEN], 1u);
      else XB_SPIN(xb_ld(&bar[XB_TOPGEN]) == tg, bar);
      __builtin_amdgcn_fence(__ATOMIC_ACQUIRE, "agent");
      xb_add(&bar[XB_XGEN(b.x)], 1u);
      asm volatile("s_waitcnt vmcnt(0)" ::: "memory");
    } else {
      XB_SPIN(xb_ld(&bar[XB_XGEN(b.x)]) == gen, bar);
      __builtin_amdgcn_fence(__ATOMIC_ACQUIRE, "agent");
      asm volatile("s_waitcnt vmcnt(0)" ::: "memory");
    }
  }
  __syncthreads();
}

__global__ void __launch_bounds__(NTHR, 2) mk_forward(Params p) {
  extern __shared__ __attribute__((aligned(16))) unsigned char smem[];
  cg::grid_group grid = cg::this_grid();
  volatile LAS unsigned* xbw = (volatile LAS unsigned*)(smem + LDS_XBW);
  if (threadIdx.x < 4) xbw[threadIdx.x] = 0u;
  __syncthreads();
  XcdBarrier xb;
  if (FUSED) xb = xcd_barrier_post((unsigned*)(p.ws + OFF_BAR), xbw);
#if PROBE_CLOCK
  const unsigned long long pc_t0 = clock64(), pc_r0 = wall_clock64();
#endif
  PG8_LAS unsigned char* lds = (PG8_LAS unsigned char*)smem;
  for (int ph = p.ph_lo; ph < p.ph_hi; ++ph) {
#if DUPMASK
   for (int rep = 0; rep < ((ph > 0 && ((DUPMASK >> ((ph - 1) % 7)) & 1)) ? 2 : 1); ++rep)
#endif
   {
    int tid_ = threadIdx.x, bid_ = blockIdx.x, nblk_ = gridDim.x;
    asm volatile("" : "+v"(tid_));
    asm volatile("" : "+s"(bid_));
    asm volatile("" : "+s"(nblk_));
    Params pp = p;
    asm volatile("" : "+s"(pp.ws));
    asm volatile("" : "+s"(pp.out));
    unsigned char* ws = pp.ws;
    if (ph == 0) {
      if (PHMASK & 128) phase_prep(pp, tid_, bid_, nblk_, smem);
    } else {
      const int q = ph - 1, chunk = q / (2 * PPL), layer = (q % (2 * PPL)) / PPL, kk = q % PPL, k = (kk == 6) ? DUPK : (kk < 2 ? kk : kk + 1);
      const u16* XBc = (const u16*)(ws + OFF_XB) + (size_t)chunk * TC * DM;
      float* SSQc = (float*)(ws + OFF_SSQ) + (size_t)chunk * TC * 16;
      float* xc = pp.out + (size_t)chunk * TC * DM;
      const bool hiwg = (bid_ * 2 >= nblk_);
      int gu_lo = 0, gu_hi = 0, gu_mode = 0;
      if (k == 0 && (PHMASK & 1)) {
        {
          EpiQKG e; e.ssq = SSQc; e.qk = (u16*)(ws + OFF_QK); e.rope = (const float*)(ws + OFF_ROPE);
          e.gA = pp.in[3] + layer * 128; e.gB = pp.in[5] + layer * 128; e.gC = pp.in[6] + layer * 64; e.gD = pp.in[9] + layer * 128;
          run_gemm(lds, XBc, (const u16*)(ws + OFF_WQKG) + (size_t)layer * NQKG * DM, TC, 2560, DM, e);
        }
        {
          EpiVT ev; ev.ssq = SSQc; ev.vbuf = (u16*)(ws + OFF_V);
          run_gemm(lds, (const u16*)(ws + OFF_WV) + (size_t)layer * DM * DM, XBc, DM, TC, DM, ev);
        }
        if (hiwg) { gu_lo = 3; gu_hi = 4; }
      } else if (k == 1 && (PHMASK & 2)) {
        phase_attn(pp, tid_, bid_, nblk_, layer, smem);
        __syncthreads();
        gu_lo = 0; gu_hi = hiwg ? 3 : 4;
      } else if (k == 5 && (PHMASK & 32)) {
        gu_lo = 0; gu_hi = 4; gu_mode = 1;
      }
      if (gu_hi > gu_lo) {
        const bool up = (gu_mode == 1);
        EpiGateUp e; e.ssq = SSQc; e.o = (u16*)(ws + OFF_GATE); e.mode = up ? ((PROBE_NOEPI && kk == 6) ? 2 : 1) : 0;
        const u16* W = up ? (const u16*)(ws + OFF_WUP) + (size_t)layer * DMLP * DM : (const u16*)(ws + OFF_WQKG) + ((size_t)layer * NQKG + 2560) * DM;
        run_gemm(lds, XBc, W, TC, 4096, DM, e, (PROBE_NOEPI && kk == 6) ? 1 : 0, gu_lo, gu_hi);
      }
      if (k == 0 || k == 1 || k == 5) {
      } else if (k == 3 && (PHMASK & 8)) {
        {
          Unit u0; pg8::StaticOrder S0; S0.init(TC, DM, nblk_, bid_); S0.next(0, u0);
          phase_bcombine(pp, tid_, u0.pm * 256);
          asm volatile("s_waitcnt vmcnt(0)" ::: "memory");
          __syncthreads();
        }
        EpiMerge e; e.gate = (const u16*)(ws + OFF_GATE); e.mrg = (u16*)(ws + OFF_MRG);
        run_merge(lds, (const u16*)(ws + OFF_Y5), (const u16*)(ws + OFF_WBR5) + (size_t)layer * 5 * DM * 256, e);
      } else if ((k == 4 && (PHMASK & 16)) || (k == 6 && (PHMASK & 64))) {
        const bool dn = (k == 6);
        EpiResid e; e.xout = xc; e.xb = (u16*)XBc; e.ssq = SSQc; e.wf32 = (dn && layer == 1) ? 1 : 0;
        const u16* A = dn ? (const u16*)(ws + OFF_GATE) : (const u16*)(ws + OFF_MRG);
        const u16* W = dn ? (const u16*)(ws + OFF_WDN) + (size_t)layer * DM * DMLP : (const u16*)(ws + OFF_WOUT) + (size_t)layer * DM * DM;
        run_gemm(lds, A, W, TC, DM, dn ? DMLP : DM, e);
      }
    }
   }
    if (ph + 1 < p.ph_hi) {
      if (p.ph_lo < 0) grid.sync();
      xcd_barrier(xb);
    }
  }
#if PROBE_CLOCK
  {
    xcd_barrier(xb);
    const unsigned long long pc_t1 = clock64(), pc_r1 = wall_clock64();
    const float ghz = (float)(pc_t1 - pc_t0) / ((float)(pc_r1 - pc_r0) * 10.0f);
    const int nrows = (int)(ghz * 0.25f * (float)T);
    for (int r = blockIdx.x; r < nrows; r += gridDim.x)
      for (int c = threadIdx.x; c < DM; c += NTHR) p.out[(size_t)r * DM + c] = 0.f;
  }
#endif
}

extern "C" void kernel_launch(void* const* d_in, const int* in_sizes, int n_in, void* d_out, int out_size, void* d_ws, size_t ws_size,
                              hipStream_t stream) {
  static int grid_blocks = 0;
  if (grid_blocks == 0) {
    if (n_in != 19 || out_size != T * DM || ws_size < WS_END) {
      fprintf(stderr, "kernel_launch: unexpected problem (n_in %d out %d ws %zu need %zu)\n", n_in, out_size, ws_size, (size_t)WS_END);
      grid_blocks = -1;
      return;
    }
    int dev = 0, cus = 0, per_cu = 0;
    (void)hipGetDevice(&dev);
    (void)hipDeviceGetAttribute(&cus, hipDeviceAttributeMultiprocessorCount, dev);
    if (hipFuncSetAttribute((const void*)mk_forward, hipFuncAttributeMaxDynamicSharedMemorySize, LDS_BYTES) != hipSuccess) {
      fprintf(stderr, "kernel_launch: hipFuncSetAttribute failed\n"); grid_blocks = -1; return;
    }
    (void)hipOccupancyMaxActiveBlocksPerMultiprocessor(&per_cu, mk_forward, NTHR, LDS_BYTES);
    if (per_cu < 1) fprintf(stderr, "kernel_launch: occupancy query says %d blocks per CU\n", per_cu);
    (void)hipGetLastError();
    grid_blocks = cus;
  }
  if (grid_blocks < 0) return;
  Params p{};
  for (int i = 0; i < 19; ++i) p.in[i] = (const float*)d_in[i];
  p.out = (float*)d_out;
  p.ws = (unsigned char*)d_ws;
#if FUSED
  (void)hipMemsetAsync((unsigned char*)d_ws + OFF_BAR, 0, XCD_BAR_WORDS * 4, stream);
  p.ph_lo = 0; p.ph_hi = NPHASE;
  void* args[] = {&p};
  hipError_t e = hipLaunchCooperativeKernel((const void*)mk_forward, dim3(grid_blocks), dim3(NTHR), args, LDS_BYTES, stream);
  if (e != hipSuccess) fprintf(stderr, "cooperative launch failed: %s (grid %d)\n", hipGetErrorString(e), grid_blocks);
#else
  for (int ph = 0; ph < NPHASE; ++ph) {
    p.ph_lo = ph; p.ph_hi = ph + 1;
    hipLaunchKernelGGL(mk_forward, dim3(grid_blocks), dim3(NTHR), LDS_BYTES, stream, p);
  }
#endif
}
```
